# Optimizing an MI355X kernel written in HIP

```python
import math
import jax, jax.numpy as jnp
from jax import lax
import numpy as np

D_MODEL = 1024
BATCH = 8
SEQ = 2048
DEPTH = 4

CTX_LEN = 256
GRID_W = 64
NORM_EPS = 1e-6
N_MOD = 6

D_HYENA = D_MODEL // 2
D_HGRN = D_MODEL // 2
D_MIX = D_HYENA + D_HGRN
D_IN = 3 * D_HYENA + 5 * D_HGRN

HY_ORDER = 2
SHORT_CONV = 3
HY_BANDS = 16
HY_FEAT = 2 * HY_BANDS + 1
HY_FILTER_HIDDEN = 64
HY_TARGET = 1e-2
HY_FAST_PCT = 0.3
HY_SLOW_PCT = 1.5

HGRN_HEAD_DIM = 128
HGRN_HEADS = D_HGRN // HGRN_HEAD_DIM
HGRN_CHUNK = 64

N_EXPERTS = 16
N_GROUPS = 4
EXPERTS_PER_GROUP = N_EXPERTS // N_GROUPS
TOP_K = 2
D_EXPERT = D_MODEL // 4

kernel_name = "hyena_hgrn2_grouped_moe_prefix_trunk"


def _rms(x, w=None):
    xf = x.astype(jnp.float32)
    y = xf * lax.rsqrt(jnp.mean(xf * xf, axis=-1, keepdims=True) + NORM_EPS)
    if w is not None:
        y = y * w.astype(jnp.float32)
    return y.astype(x.dtype)


def _short_conv(u, w, b):
    up = jnp.pad(u, ((0, 0), (1, 1), (0, 0)))
    return up[:, :-2] * w[0] + up[:, 1:-1] * w[1] + up[:, 2:] * w[2] + b


def _short_conv_grid(u, w, b):
    bsz, n, ch = u.shape
    rows = n // GRID_W
    return _short_conv(u.reshape(bsz * rows, GRID_W, ch), w, b).reshape(bsz, n, ch)


def _hyena_filters(L, w1, b1, w2, b2, w3, b3):
    t = jnp.linspace(0.0, 1.0, L, dtype=jnp.float32)
    n = jnp.arange(L, dtype=jnp.float32)
    freqs = jnp.linspace(1e-4, HY_BANDS - 1, HY_BANDS, dtype=jnp.float32)
    ang = (2.0 * math.pi / L) * n[:, None] * freqs[None, :]
    z = jnp.concatenate([t[:, None], jnp.cos(ang), -jnp.sin(ang)], axis=-1)
    h = jnp.sin(z @ w1 + b1)
    h = jnp.sin(h @ w2 + b2)
    h = (h @ w3 + b3).astype(jnp.float32).reshape(L, HY_ORDER, 2, D_HYENA)
    deltas = jnp.linspace(math.log(HY_TARGET) / HY_FAST_PCT, math.log(HY_TARGET) / HY_SLOW_PCT,
                          D_HYENA, dtype=jnp.float32)
    window = jnp.exp(-t[:, None] * jnp.abs(deltas)[None, :])
    h = h * window[:, None, None, :]
    return h / jnp.sum(jnp.abs(h), axis=(0, 2), keepdims=True)


def _bidir_fftconv(u, h, d):
    L = u.shape[1]
    k = jnp.concatenate([h[:, 0], jnp.zeros_like(h[:1, 0]), h[:0:-1, 1]], axis=0)
    uf = jnp.fft.rfft(u.astype(jnp.float32), n=2 * L, axis=1)
    kf = jnp.fft.rfft(k, n=2 * L, axis=0)
    y = jnp.fft.irfft(uf * kf[None], n=2 * L, axis=1)[:, :L]
    return (y + u.astype(jnp.float32) * d.astype(jnp.float32)).astype(u.dtype)


def _hyena(p, conv_w, conv_b, w1, b1, w2, b2, w3, b3, d, grid):
    L = p.shape[1]
    u = _short_conv_grid(p, conv_w, conv_b) if grid else _short_conv(p, conv_w, conv_b)
    v, x1, x2 = jnp.split(u, 3, axis=-1)
    h = _hyena_filters(L, w1, b1, w2, b2, w3, b3)
    z = x1 * _bidir_fftconv(v, h[:, 0], d[0])
    return x2 * _bidir_fftconv(z, h[:, 1], d[1])


def _heads(a):
    bsz, L, _ = a.shape
    return a.reshape(bsz, L, HGRN_HEADS, HGRN_HEAD_DIM).transpose(0, 2, 1, 3).astype(jnp.float32)


def _forget(logit, lb):
    lb = lb[None, :, None, :]
    f = lb + (1.0 - lb) * jax.nn.sigmoid(logit)
    return 1.0 - f, jnp.log(f)


def _hgrn_scan(q, k, logf, v, s0):
    bsz, nh, L, dk = q.shape
    dv = v.shape[-1]
    nc = L // HGRN_CHUNK

    def chunks(a):
        return a.reshape(bsz, nh, nc, HGRN_CHUNK, a.shape[-1]).transpose(2, 0, 1, 3, 4)

    lower = jnp.tril(jnp.ones((HGRN_CHUNK, HGRN_CHUNK), dtype=bool))[:, :, None]

    def step(s, inp):
        qc, kc, gc, vc = inp
        b = jnp.cumsum(gc, axis=2)
        o_inter = jnp.einsum("bhtk,bhkv->bhtv", qc * jnp.exp(b), s)
        rel = b[:, :, :, None, :] - b[:, :, None, :, :]
        decay = jnp.exp(jnp.where(lower, rel, -jnp.inf))
        scores = jnp.einsum("bhtk,bhtsk,bhsk->bhts", qc, decay, kc)
        o = o_inter + jnp.einsum("bhts,bhsv->bhtv", scores, vc)
        b_end = b[:, :, -1:, :]
        s_new = (jnp.exp(b_end[:, :, 0, :, None]) * s
                 + jnp.einsum("bhsk,bhsv->bhkv", kc * jnp.exp(b_end - b), vc))
        return s_new, o

    s_fin, o = lax.scan(step, s0, (chunks(q), chunks(k), chunks(logf), chunks(v)))
    return o.transpose(1, 2, 0, 3, 4).reshape(bsz, nh, L, dv), s_fin


def _hgrn_mixer(p, lb_f, lb_b, s_f0, s_b0):
    q, i, g, ff, fb = jnp.split(p, 5, axis=-1)
    q = jax.nn.silu(_heads(q))
    v = _heads(i)
    k_f, logf_f = _forget(_heads(ff), lb_f)
    k_b, logf_b = _forget(_heads(fb), lb_b)
    o_f, s_f = _hgrn_scan(q, k_f, logf_f, v, s_f0)
    o_b, s_b = _hgrn_scan(q[:, :, ::-1], k_b[:, :, ::-1], logf_b[:, :, ::-1], v[:, :, ::-1], s_b0)
    return o_f + o_b[:, :, ::-1], g, s_f, s_b


def _hgrn_out(o, g, norm_w):
    bsz, nh, L, dv = o.shape
    o = _rms(o.transpose(0, 2, 1, 3), norm_w).reshape(bsz, L, nh * dv)
    return (o * jax.nn.silu(g.astype(jnp.float32))).astype(g.dtype)


def _moe(h, router_w, router_bias, w_gate, w_up, w_down):
    bsz, L, d = h.shape
    t = h.reshape(bsz * L, d)
    scores = jax.nn.softmax((t @ router_w).astype(jnp.float32), axis=-1)
    sel = (scores + router_bias.astype(jnp.float32)).reshape(-1, N_GROUPS, EXPERTS_PER_GROUP)
    group_score = jnp.sum(lax.top_k(sel, TOP_K)[0], axis=-1)
    best = jnp.argmax(group_score, axis=-1)
    in_group = (jnp.arange(N_GROUPS)[None, :] == best[:, None])[:, :, None]
    sel = jnp.where(in_group, sel, -jnp.inf).reshape(-1, N_EXPERTS)
    _, idx = lax.top_k(sel, TOP_K)
    w = jnp.take_along_axis(scores, idx, axis=-1)
    w = w / jnp.sum(w, axis=-1, keepdims=True)
    gates = jnp.sum(jax.nn.one_hot(idx, N_EXPERTS, dtype=jnp.float32) * w[..., None], axis=1)
    act = jax.nn.silu(jnp.einsum("nd,edf->nef", t, w_gate)) * jnp.einsum("nd,edf->nef", t, w_up)
    act = act * gates.astype(h.dtype)[..., None]
    return jnp.einsum("nef,efd->nd", act, w_down).reshape(bsz, L, d)


def setup_inputs(seed: int = 0) -> dict:
    key = jax.random.key(seed)
    ks = jax.random.split(key, 26)
    D = D_MODEL

    def nrm(k, shape, s):
        return jax.random.normal(k, shape, jnp.float32) * s

    return {
        "x": nrm(ks[0], (BATCH, SEQ, D), 1.0),
        "c": nrm(ks[1], (BATCH, D), 1.0),
        "ctx": nrm(ks[2], (BATCH, CTX_LEN, D), 1.0),
        "c_ctx": nrm(ks[3], (D,), 1.0),
        "w_mod": nrm(ks[4], (DEPTH, D, N_MOD * D), 0.5 * D ** -0.5),
        "b_mod": nrm(ks[5], (DEPTH, N_MOD * D), 0.02),
        "w_in": nrm(ks[6], (DEPTH, D, D_IN), D ** -0.5),
        "w_out": nrm(ks[7], (DEPTH, D_MIX, D), D_MIX ** -0.5),
        "hy_conv_w": nrm(ks[8], (DEPTH, SHORT_CONV, 3 * D_HYENA), SHORT_CONV ** -0.5),
        "hy_conv_b": nrm(ks[9], (DEPTH, 3 * D_HYENA), 0.02),
        "hy_w1": nrm(ks[10], (DEPTH, HY_FEAT, HY_FILTER_HIDDEN), HY_FEAT ** -0.5),
        "hy_b1": nrm(ks[11], (DEPTH, HY_FILTER_HIDDEN), 0.1),
        "hy_w2": nrm(ks[12], (DEPTH, HY_FILTER_HIDDEN, HY_FILTER_HIDDEN), HY_FILTER_HIDDEN ** -0.5),
        "hy_b2": nrm(ks[13], (DEPTH, HY_FILTER_HIDDEN), 0.1),
        "hy_w3": nrm(ks[14], (DEPTH, HY_FILTER_HIDDEN, HY_ORDER * 2 * D_HYENA), HY_FILTER_HIDDEN ** -0.5),
        "hy_b3": nrm(ks[15], (DEPTH, HY_ORDER * 2 * D_HYENA), 0.02),
        "hy_bias": nrm(ks[16], (DEPTH, HY_ORDER, D_HYENA), 0.5),
        "hgrn_lower_bounds": nrm(ks[17], (2, DEPTH, D_HGRN), 0.5),
        "hgrn_norm_w": 1.0 + nrm(ks[18], (DEPTH, HGRN_HEAD_DIM), 0.02),
        "router_w": nrm(ks[19], (D, N_EXPERTS), D ** -0.5),
        "router_bias": nrm(ks[20], (N_EXPERTS,), 0.01),
        "moe_w_gate": nrm(ks[21], (DEPTH, N_EXPERTS, D, D_EXPERT), D ** -0.5),
        "moe_w_up": nrm(ks[22], (DEPTH, N_EXPERTS, D, D_EXPERT), D ** -0.5),
        "moe_w_down": nrm(ks[23], (DEPTH, N_EXPERTS, D_EXPERT, D), D_EXPERT ** -0.5),
        "final_norm_w": 1.0 + nrm(ks[24], (D,), 0.02),
    }


def reference(x, c, ctx, c_ctx, w_mod, b_mod, w_in, w_out, hy_conv_w, hy_conv_b,
              hy_w1, hy_b1, hy_w2, hy_b2, hy_w3, hy_b3, hy_bias, hgrn_lower_bounds,
              hgrn_norm_w, router_w, router_bias, moe_w_gate, moe_w_up, moe_w_down,
              final_norm_w):
    bsz = x.shape[0]
    lb_soft = jax.nn.softmax(hgrn_lower_bounds.astype(jnp.float32), axis=1)
    lower = jnp.cumsum(lb_soft, axis=1) - lb_soft[:, :1]
    zero_state = jnp.zeros((bsz, HGRN_HEADS, HGRN_HEAD_DIM, HGRN_HEAD_DIM), jnp.float32)

    xc = ctx
    for l in range(DEPTH):
        last = l == DEPTH - 1
        mod_lat = jax.nn.silu(c) @ w_mod[l] + b_mod[l]
        mod_ctx = jax.nn.silu(c_ctx) @ w_mod[l] + b_mod[l]
        sh1, sc1, g1, sh2, sc2, g2 = jnp.split(mod_lat[:, None, :], N_MOD, axis=-1)
        sh1c, sc1c, g1c, sh2c, sc2c, g2c = jnp.split(mod_ctx, N_MOD, axis=-1)

        p_lat = (_rms(x) * (1.0 + sc1) + sh1) @ w_in[l]
        p_ctx = (_rms(xc) * (1.0 + sc1c) + sh1c) @ w_in[l]
        hy_lat, hg_lat = p_lat[..., :3 * D_HYENA], p_lat[..., 3 * D_HYENA:]
        hy_ctx, hg_ctx = p_ctx[..., :3 * D_HYENA], p_ctx[..., 3 * D_HYENA:]

        lb_f = lower[0, l].reshape(HGRN_HEADS, HGRN_HEAD_DIM)
        lb_b = lower[1, l].reshape(HGRN_HEADS, HGRN_HEAD_DIM)

        o_ctx, g_ctx, s_f, s_b = _hgrn_mixer(hg_ctx, lb_f, lb_b, zero_state, zero_state)
        o_lat, g_lat, _, _ = _hgrn_mixer(hg_lat, lb_f, lb_b, s_f, s_b)
        hg_out_lat = _hgrn_out(o_lat, g_lat, hgrn_norm_w[l])

        hy_out_lat = _hyena(hy_lat, hy_conv_w[l], hy_conv_b[l], hy_w1[l], hy_b1[l], hy_w2[l],
                            hy_b2[l], hy_w3[l], hy_b3[l], hy_bias[l], grid=True)

        x = x + g1 * (jnp.concatenate([hy_out_lat, hg_out_lat], axis=-1) @ w_out[l])
        x = x + g2 * _moe(_rms(x) * (1.0 + sc2) + sh2, router_w, router_bias,
                          moe_w_gate[l], moe_w_up[l], moe_w_down[l])

        if not last:
            hy_out_ctx = _hyena(hy_ctx, hy_conv_w[l], hy_conv_b[l], hy_w1[l], hy_b1[l], hy_w2[l],
                                hy_b2[l], hy_w3[l], hy_b3[l], hy_bias[l], grid=False)
            hg_out_ctx = _hgrn_out(o_ctx, g_ctx, hgrn_norm_w[l])
            xc = xc + g1c * (jnp.concatenate([hy_out_ctx, hg_out_ctx], axis=-1) @ w_out[l])
            xc = xc + g2c * _moe(_rms(xc) * (1.0 + sc2c) + sh2c, router_w, router_bias,
                                 moe_w_gate[l], moe_w_up[l], moe_w_down[l])

    return _rms(x, final_norm_w)
```

```cpp
#include <hip/hip_runtime.h>
#include <cstdio>
#include <cstdint>

#ifndef MK_PER_PHASE
#define MK_PER_PHASE 1
#endif

#define LAS __attribute__((address_space(3)))
typedef unsigned short bf16_t;
typedef short bf16x8 __attribute__((ext_vector_type(8)));
typedef float f32x4 __attribute__((ext_vector_type(4)));
typedef float f32x2 __attribute__((ext_vector_type(2)));
typedef unsigned u32x4 __attribute__((ext_vector_type(4)));
typedef unsigned u32x2 __attribute__((ext_vector_type(2)));

constexpr int NB = 8, SEQ = 2048, D = 1024, DEPTH = 4, CTXL = 256;
constexpr int NLAT = NB * SEQ, NCTX = NB * CTXL, NTOK = NLAT + NCTX;
constexpr int DH = 512, NHY = 1536, NHG = 2560, DIN = 4096;
constexpr int NE = 16, DE = 256, NBIN = 24, SROWS = 24576;
constexpr float EPS = 1e-6f;
constexpr int NTHR = 512, NWAVES = 8;
enum { IN_X = 0, IN_C, IN_CTX, IN_CCTX, IN_WMOD, IN_BMOD, IN_WIN, IN_WOUT, IN_CONVW, IN_CONVB, IN_W1, IN_B1, IN_W2, IN_B2, IN_W3, IN_B3,
       IN_HYBIAS, IN_LB, IN_NORMW, IN_RW, IN_RB, IN_WG, IN_WU, IN_WD, IN_FNW, N_IN };

constexpr size_t MiB = 1u << 20;
constexpr size_t WS_CTL = 0, CTL_ZERO_BYTES = 1 * MiB;
constexpr size_t WS_MODS = 1 * MiB;
constexpr size_t WS_LOWER = 2 * MiB;
constexpr size_t WS_H2L = 3 * MiB;
constexpr size_t WS_H2C = 5 * MiB;
constexpr size_t WS_TOKINFO = 6 * MiB;
constexpr size_t WS_ROWTOK = 6 * MiB + 512 * 1024;
constexpr size_t WS_ROWW = 7 * MiB;
constexpr size_t WS_WIN = 8 * MiB;
constexpr size_t WS_WOUT = 16 * MiB;
constexpr size_t WS_WG = 18 * MiB;
constexpr size_t WS_WU = 26 * MiB;
constexpr size_t WS_WD = 34 * MiB;
constexpr size_t WS_KSPEC = 42 * MiB;
constexpr size_t WS_XBUF = 74 * MiB;
constexpr size_t WS_R1 = 146 * MiB;
constexpr size_t WS_PHG = 182 * MiB;
constexpr size_t WS_PHYT = 272 * MiB;
constexpr size_t WS_ODIR = 326 * MiB;
constexpr size_t WS_END = 362 * MiB;
constexpr int CW_BAR = 4096;
constexpr int CW_CNT = 16384;

constexpr int LDS_BYTES = 147456;
constexpr int LDSCTL_OFF = 143 * 1024;
constexpr int LC_BAR = 0;
constexpr int LC_T = 8;
constexpr int LC_OFFS = 16;
constexpr int LC_TILEBIN = 48;

__device__ __forceinline__ unsigned f2bf(float f) { unsigned u = __builtin_bit_cast(unsigned, f); return (u + 0x7fffu + ((u >> 16) & 1u)) >> 16; }
__device__ __forceinline__ unsigned pk2(float lo, float hi) { return f2bf(lo) | (f2bf(hi) << 16); }
__device__ __forceinline__ float bf2f(unsigned b) { return __builtin_bit_cast(float, (b & 0xffffu) << 16); }
__device__ __forceinline__ float bflo(unsigned w) { return __builtin_bit_cast(float, w << 16); }
__device__ __forceinline__ float bfhi(unsigned w) { return __builtin_bit_cast(float, w & 0xffff0000u); }
__device__ __forceinline__ float sigmoidf_(float x) { return 1.0f / (1.0f + __expf(-x)); }
__device__ __forceinline__ float siluf_(float x) { return x / (1.0f + __expf(-x)); }
#define DPP_ADD(v, ctrl, rmask) v += __builtin_bit_cast(float, __builtin_amdgcn_update_dpp(0, __builtin_bit_cast(int, v), ctrl, rmask, 0xF, false))
__device__ __forceinline__ float row16_sum(float v) {
    DPP_ADD(v, 0xB1, 0xF);
    DPP_ADD(v, 0x4E, 0xF);
    DPP_ADD(v, 0x141, 0xF);
    DPP_ADD(v, 0x140, 0xF);
    return v;
}
__device__ __forceinline__ float wave_sum(float v) {
    v = row16_sum(v);
    DPP_ADD(v, 0x142, 0xA);
    DPP_ADD(v, 0x143, 0xC);
    return __builtin_bit_cast(float, __builtin_amdgcn_readlane(__builtin_bit_cast(int, v), 63));
}
__device__ __forceinline__ int bidx(int row) { return row < NLAT ? (row >> 11) : 8; }
#define LDS_WAIT() asm volatile("s_waitcnt lgkmcnt(0)" ::: "memory")

#define XB_TMO      128
#define XB_XCNT(j)  (256  + 64 * (j))
#define XB_XSUB(j)  (1280 + 64 * (j))
#define XB_XGEN(j)  (2304 + 64 * (j))
#define XB_TOP      3328
#define XB_TOPGEN   3392
#define XCD_BAR_WORDS 3456
#define XB_SPIN_CAP (1u << 18)
__device__ __forceinline__ unsigned xb_ld(unsigned* p)              { return __hip_atomic_load(p, __ATOMIC_RELAXED, __HIP_MEMORY_SCOPE_AGENT); }
__device__ __forceinline__ unsigned xb_add(unsigned* p, unsigned v) { return __hip_atomic_fetch_add(p, v, __ATOMIC_RELAXED, __HIP_MEMORY_SCOPE_AGENT); }
__device__ __forceinline__ unsigned xb_xcc_id() { return (unsigned)__builtin_amdgcn_s_getreg((3 << 11) | 20) & 0xFu; }
#define XB_SPIN(cond, bar) do { unsigned _sp = 0; while (cond) { __builtin_amdgcn_s_sleep(1); \
    if ((++_sp & 255u) == 0u) { if (xb_ld(&(bar)[XB_TMO])) break; if (_sp > XB_SPIN_CAP) { atomicAdd(&(bar)[XB_TMO], 1u); break; } } } } while (0)
struct XcdBarrier { unsigned* bar; unsigned x; volatile LAS unsigned* st; };
__device__ __forceinline__ XcdBarrier xcd_barrier_post(unsigned* bar, volatile LAS unsigned* st) {
    XcdBarrier b; b.bar = bar; b.x = xb_xcc_id(); b.st = st;
    if (threadIdx.x == 0) (void)xb_add(&bar[XB_XCNT(b.x)], 1u);
    return b;
}
__device__ __forceinline__ void xcd_barrier_complete(unsigned* bar, unsigned x, unsigned& nloc, unsigned& nx) {
    const unsigned G = gridDim.x * gridDim.y * gridDim.z;
    unsigned sum, cnt, mine, sp = 0u;
    for (;;) {
        sum = 0u; cnt = 0u; mine = 0u;
#pragma unroll
        for (unsigned j = 0; j < 16; ++j) { const unsigned c = xb_ld(&bar[XB_XCNT(j)]); sum += c; cnt += (c > 0u) ? 1u : 0u; mine = (j == x) ? c : mine; }
        if (sum == G) break;
        __builtin_amdgcn_s_sleep(1);
        if ((++sp & 255u) == 0u) { if (xb_ld(&bar[XB_TMO])) break; if (sp > XB_SPIN_CAP) { atomicAdd(&bar[XB_TMO], 1u); break; } }
    }
    nloc = mine > 0u ? mine : 1u; nx = cnt > 0u ? cnt : 1u;
}
__device__ __forceinline__ void xcd_barrier(const XcdBarrier& b) {
    asm volatile("s_waitcnt vmcnt(0)" ::: "memory");
    __syncthreads();
    if (threadIdx.x == 0) {
        unsigned* bar = b.bar; unsigned bx = b.x;
        asm volatile("" : "+s"(bar), "+s"(bx));
        __builtin_amdgcn_s_waitcnt(0);
        unsigned nloc = b.st[0], nx = b.st[1];
        if (nloc == 0u) { xcd_barrier_complete(bar, bx, nloc, nx); b.st[0] = nloc; b.st[1] = nx; }
        const unsigned old = xb_add(&bar[XB_XSUB(bx)], 1u);
        const unsigned gen = old / nloc;
        if (old + 1u == (gen + 1u) * nloc) {
            __builtin_amdgcn_fence(__ATOMIC_RELEASE, "agent");
            asm volatile("s_waitcnt vmcnt(0)" ::: "memory");
            const unsigned og = xb_add(&bar[XB_TOP], 1u);
            const unsigned tg = og / nx;
            if (og + 1u == (tg + 1u) * nx) xb_add(&bar[XB_TOPGEN], 1u);
            else XB_SPIN(xb_ld(&bar[XB_TOPGEN]) == tg, bar);
            __builtin_amdgcn_fence(__ATOMIC_ACQUIRE, "agent");
            xb_add(&bar[XB_XGEN(bx)], 1u);
            asm volatile("s_waitcnt vmcnt(0)" ::: "memory");
        } else {
            XB_SPIN(xb_ld(&bar[XB_XGEN(bx)]) == gen, bar);
            __builtin_amdgcn_fence(__ATOMIC_ACQUIRE, "agent");
            asm volatile("s_waitcnt vmcnt(0)" ::: "memory");
        }
    }
    __syncthreads();
}

namespace pg8 {
constexpr int BM = 256, BK = 64, HALF = 128, HTB = HALF * BK * 2, STAGE_BYTES = 8 * HTB, NXCD = 8, WGM = 8;
__host__ __device__ __forceinline__ int lds_byte(int r, int c) { const int st = (r >> 4) * 2 + (c >> 5), rr = r & 15, cc = c & 31, ob = rr * 64 + cc * 2; return st * 1024 + (ob ^ (((ob >> 9) & 1) << 5)); }
__host__ __device__ __forceinline__ void stage_rc(int b, int& R, int& C) { const int st = b / 1024, sb = b % 1024, swz = sb ^ (((sb >> 9) & 1) << 5); R = (st >> 1) * 16 + swz / 64; C = (st & 1) * 32 + (swz % 64) / 2; }
__host__ __device__ __forceinline__ int perm32(int rho) { const int n = rho >> 4, i = rho & 15; return 8 * (i >> 2) + 4 * n + (i & 3); }

struct GUnit { unsigned a, b; int last, i0, i1; };

template <bool SUB, class Epi, class Sched>
__device__ __forceinline__ void gemm_phase(LAS unsigned char* lds, const Sched& S, const Epi& E, const char* Abase, const char* Bbase, const int lda, const int ldb, const unsigned ahalf, const unsigned bhalf, const int nt) {
    int tid_ = threadIdx.x; asm volatile("" : "+v"(tid_));
    const int tid = tid_, wid = __builtin_amdgcn_readfirstlane(tid >> 6), lane = tid & 63, wr = wid >> 2, wc = wid & 3, fr = lane & 15, fq = lane >> 4;
    unsigned voffA[2], voffB[2];
#pragma unroll
    for (int i = 0; i < 2; ++i) { int R, C; stage_rc(tid * 16 + i * 8192, R, C); const int Rb = Epi::PERM ? ((R & ~31) + perm32(R & 31)) : R;
        voffA[i] = (unsigned)(R * lda + C) * 2u; voffB[i] = (unsigned)(Rb * ldb + C) * 2u; }
    constexpr unsigned kstep = BK * 2;
    const unsigned ldsw = (unsigned)wid * 1024u;
    const int aoff = lds_byte(wr * 64 + fr, fq * 8), boff = lds_byte(wc * 32 + fr, fq * 8);
#define PG8_SA(b, h) (((b) * 2 + (h)) * HTB)
#define PG8_SB(b, h) ((4 + (b) * 2 + (h)) * HTB)
#define PG8_STAGE(bufoff, gbase, voff) do { _Pragma("unroll") for (int _i = 0; _i < 2; ++_i) \
        __builtin_amdgcn_global_load_lds((const unsigned*)((const char*)(gbase) + (voff)[_i]), (LAS unsigned*)(lds + (bufoff) + ldsw + _i * 8192), 16, 0, 0); } while (0)
#define PG8_LDA(dst, b, h) do { _Pragma("unroll") for (int m = 0; m < 4; ++m) _Pragma("unroll") for (int k = 0; k < 2; ++k) dst[m][k] = *(const LAS bf16x8*)(lds + PG8_SA(b, h) + aoff + m * 2048 + k * 1024); } while (0)
#define PG8_LDB(dst, b, h) do { _Pragma("unroll") for (int n = 0; n < 2; ++n) _Pragma("unroll") for (int k = 0; k < 2; ++k) dst[n][k] = *(const LAS bf16x8*)(lds + PG8_SB(b, h) + boff + n * 2048 + k * 1024); } while (0)
#define PG8_MMA(ai, bj, At, Bt) do { __builtin_amdgcn_s_setprio(1); _Pragma("unroll") for (int m = 0; m < 4; ++m) _Pragma("unroll") for (int n = 0; n < 2; ++n) _Pragma("unroll") for (int k = 0; k < 2; ++k) \
        acc[ai][bj][m][n] = __builtin_amdgcn_mfma_f32_16x16x32_bf16(Bt[n][k], At[m][k], acc[ai][bj][m][n], 0, 0, 0); __builtin_amdgcn_s_setprio(0); } while (0)
#define PG8_WAIT_V(n) asm volatile("s_waitcnt vmcnt(" #n ")" ::: "memory")
#define PG8_WAIT_L(n) asm volatile("s_waitcnt lgkmcnt(" #n ")" ::: "memory")
#define PG8_BAR __builtin_amdgcn_s_barrier()
#define PG8_SCHED __builtin_amdgcn_sched_barrier(0)
    GUnit cur, nxt; int ui = 0;
    if (!S.next(0, cur)) return;
    f32x4 acc[2][2][4][2];
#pragma unroll
    for (int a = 0; a < 2; ++a)
#pragma unroll
        for (int b = 0; b < 2; ++b)
#pragma unroll
            for (int m = 0; m < 4; ++m)
#pragma unroll
                for (int n = 0; n < 2; ++n) acc[a][b][m][n] = (f32x4){0.f, 0.f, 0.f, 0.f};
    bf16x8 At[4][2], B0[2][2], B1[2][2];
    { const char* cA = Abase + cur.a; const char* cB = Bbase + cur.b;
      PG8_STAGE(PG8_SB(0, 0), cB, voffB); PG8_STAGE(PG8_SB(0, 1), cB + bhalf, voffB); PG8_STAGE(PG8_SA(0, 0), cA, voffA); PG8_STAGE(PG8_SA(0, 1), cA + ahalf, voffA);
      if (wr == 1) PG8_BAR;
      PG8_WAIT_V(2); PG8_BAR;
      PG8_STAGE(PG8_SB(1, 0), cB + kstep, voffB); PG8_STAGE(PG8_SA(1, 0), cA + kstep, voffA); PG8_STAGE(PG8_SB(1, 1), cB + bhalf + kstep, voffB);
      PG8_WAIT_V(6); PG8_BAR; }
    for (;;) {
        const bool has_next = S.next(ui + 1, nxt);
        const char* cA = Abase + cur.a; const char* cB = Bbase + cur.b;
        const char* nA = Abase + (has_next ? nxt.a : cur.a); const char* nB = Bbase + (has_next ? nxt.b : cur.b);
        for (int t = 0; t < nt; t += 2) {
            const bool last = (t == nt - 2);
            const char* a1 = cA + (unsigned)(t + 1) * kstep;
            const char* a2 = last ? nA : cA + (unsigned)(t + 2) * kstep; const char* b2 = last ? nB : cB + (unsigned)(t + 2) * kstep;
            const char* a3 = a2 + kstep; const char* b3 = b2 + kstep;
            PG8_LDB(B0, 0, 0); PG8_LDB(B1, 0, 1); PG8_SCHED; PG8_LDA(At, 0, 0); PG8_STAGE(PG8_SA(1, 1), a1 + ahalf, voffA);
            PG8_WAIT_V(8); PG8_WAIT_L(0); PG8_BAR; PG8_MMA(0, 0, At, B0); PG8_MMA(0, 1, At, B1); PG8_BAR; PG8_SCHED;
            PG8_LDA(At, 0, 1); PG8_STAGE(PG8_SB(0, 0), b2, voffB); PG8_STAGE(PG8_SB(0, 1), b2 + bhalf, voffB); PG8_STAGE(PG8_SA(0, 0), a2, voffA);
            PG8_WAIT_V(8); PG8_WAIT_L(0); PG8_BAR; PG8_MMA(1, 0, At, B0); PG8_MMA(1, 1, At, B1); PG8_BAR; PG8_SCHED;
            PG8_LDB(B0, 1, 0); PG8_LDB(B1, 1, 1); PG8_SCHED; PG8_LDA(At, 1, 0); PG8_STAGE(PG8_SA(0, 1), a2 + ahalf, voffA);
            PG8_WAIT_V(8); PG8_WAIT_L(0); PG8_BAR; PG8_MMA(0, 0, At, B0); PG8_MMA(0, 1, At, B1); PG8_BAR; PG8_SCHED;
            PG8_LDA(At, 1, 1); PG8_STAGE(PG8_SB(1, 0), b3, voffB); PG8_STAGE(PG8_SB(1, 1), b3 + bhalf, voffB); PG8_STAGE(PG8_SA(1, 0), a3, voffA);
            PG8_WAIT_V(8); PG8_WAIT_L(0); PG8_BAR; PG8_MMA(1, 0, At, B0); PG8_MMA(1, 1, At, B1); PG8_BAR; PG8_SCHED;
        }
        const bool fin = SUB ? (cur.last != 0) : true;
        if (fin) { if (wr == 0) PG8_BAR; E(acc, cur, wr, wc, fr, fq); }
        if (!has_next) break;
        if (fin) {
#pragma unroll
            for (int a = 0; a < 2; ++a)
#pragma unroll
                for (int b = 0; b < 2; ++b)
#pragma unroll
                    for (int m = 0; m < 4; ++m)
#pragma unroll
                        for (int n = 0; n < 2; ++n) acc[a][b][m][n] = (f32x4){0.f, 0.f, 0.f, 0.f};
        }
        cur = nxt; ++ui;
        if (fin) { if (wr == 1) PG8_BAR; }
    }
    PG8_WAIT_V(0);
    PG8_BAR;
#undef PG8_SA
#undef PG8_SB
#undef PG8_STAGE
#undef PG8_LDA
#undef PG8_LDB
#undef PG8_MMA
#undef PG8_WAIT_V
#undef PG8_WAIT_L
#undef PG8_BAR
#undef PG8_SCHED
}

struct SchedDense {
    int nM, nN, nwg, G, c; unsigned atile, btile;
    __device__ __forceinline__ void init(int nM_, int nN_, int G_, int c_, int lda, int ldb) {
        nM = nM_; nN = nN_; nwg = nM * nN; G = G_; c = c_; atile = 256u * lda * 2u; btile = 256u * ldb * 2u; }
    __device__ __forceinline__ bool next(int i, GUnit& u) const {
        const int L = i * G + c; if (L >= nwg) return false;
        int wgid = L; { const int q = nwg / NXCD, r = nwg % NXCD, xcd = wgid % NXCD, off = wgid / NXCD; wgid = (xcd < r ? xcd * (q + 1) : r * (q + 1) + (xcd - r) * q) + off; }
        const int nig = WGM * nN, gid = wgid / nig, fm = gid * WGM, gsz = (nM - fm) < WGM ? (nM - fm) : WGM;
        const int pm = fm + ((wgid % nig) % gsz), pn = (wgid % nig) / gsz;
        u.a = (unsigned)pm * atile; u.b = (unsigned)pn * btile; u.last = 1; u.i0 = pm; u.i1 = pn; return true;
    }
};
}

struct Args { const float* in[N_IN]; float* out; unsigned char* ws; int ph_lo, ph_hi; };
static_assert(sizeof(Args) == N_IN * 8 + 8 + 8 + 8, "Args has no padding");

#define CAS __attribute__((address_space(4)))
typedef const float* fptr_t;
struct Ctx {
    const CAS fptr_t* in; float* out; unsigned char* ws; LAS unsigned char* lds; int tid, lane, wave, G, bid;
};
#define WSP(T, off) ((T*)(C.ws + (off)))

__device__ __forceinline__ void build_tiletab(const Ctx& C, int l) {
    volatile LAS int* lc = (volatile LAS int*)(C.lds + LDSCTL_OFF);
    __syncthreads();
    if (C.tid == 0) {
        const unsigned* cnt = WSP(const unsigned, WS_CTL) + CW_CNT + l * 64;
        int off = 0, t = 0;
        for (int b = 0; b < NBIN; ++b) {
            const int n = (int)__hip_atomic_load(cnt + b, __ATOMIC_RELAXED, __HIP_MEMORY_SCOPE_AGENT);
            lc[LC_OFFS + b] = off;
            const int nt = (n + 255) >> 8;
            for (int k = 0; k < nt; ++k) lc[LC_TILEBIN + t + k] = b;
            t += nt; off += nt * 256;
        }
        lc[LC_OFFS + NBIN] = off; lc[LC_T] = t;
    }
    __syncthreads();
}
__device__ __forceinline__ int expert_of(int bin, int es) {
    const int g = bin / 6, p = bin - g * 6;
    const int lo = p < 3 ? 0 : (p < 5 ? 1 : 2), hi = p < 3 ? p + 1 : (p < 5 ? p - 1 : 3);
    return 4 * g + (es ? hi : lo);
}

struct SchedUp {
    int T, G, c; const volatile LAS int* tilebin;
    __device__ __forceinline__ bool next(int i, pg8::GUnit& u) const {
        const int idx = i * G + c; if (idx >= 4 * T) return false;
        const int rt = idx >> 2, q = idx & 3, es = q >> 1, fb = q & 1;
        const int bin = __builtin_amdgcn_readfirstlane(tilebin[rt]);
        const int e = expert_of(bin, es);
        u.a = (unsigned)rt * 256u * 2048u; u.b = (unsigned)(e * 256 + fb * 128) * 2048u;
        u.last = 1; u.i0 = rt; u.i1 = q; return true;
    }
};
struct SchedDown {
    int T, G, c; const volatile LAS int* tilebin;
    __device__ __forceinline__ bool next(int i, pg8::GUnit& u) const {
        const int idx = (i >> 1) * G + c, sub = i & 1; if (idx >= 4 * T) return false;
        const int rt = idx >> 2, pn = idx & 3;
        const int bin = __builtin_amdgcn_readfirstlane(tilebin[rt]);
        const int e = expert_of(bin, sub);
        u.a = (unsigned)rt * 256u * 1024u + (unsigned)sub * 512u; u.b = (unsigned)(e * 1024 + pn * 256) * 512u;
        u.last = sub; u.i0 = rt; u.i1 = pn; return true;
    }
};

struct EpiHG {
    static constexpr bool PERM = true;
    bf16_t* O; const float* lower;
    __device__ __forceinline__ void operator()(const f32x4 (&acc)[2][2][4][2], const pg8::GUnit& u, int wr, int wc, int fr, int fq) const {
        const int kind = u.i1 >> 1;
        const int row0 = u.i0 * 256 + wr * 64 + fr, colt = u.i1 * 256 + wc * 32 + 8 * fq;
#pragma unroll
        for (int bj = 0; bj < 2; ++bj) {
            const int col = colt + bj * 128;
            float om[8];
#pragma unroll
            for (int j = 0; j < 8; ++j) om[j] = 1.f;
            if (kind >= 3) { const float* lb = lower + (kind - 3) * 2048 + (col & 511);
#pragma unroll
                for (int j = 0; j < 8; ++j) om[j] = 1.f - lb[j]; }
#pragma unroll
            for (int ai = 0; ai < 2; ++ai)
#pragma unroll
                for (int m = 0; m < 4; ++m) {
                    float v[8];
#pragma unroll
                    for (int j = 0; j < 8; ++j) v[j] = acc[ai][bj][m][j >> 2][j & 3];
                    if (kind == 0) {
#pragma unroll
                        for (int j = 0; j < 8; ++j) v[j] = siluf_(v[j]);
                    } else if (kind >= 3) {
#pragma unroll
                        for (int j = 0; j < 8; ++j) v[j] = om[j] * sigmoidf_(-v[j]);
                    }
                    u32x4 w; w.x = pk2(v[0], v[1]); w.y = pk2(v[2], v[3]); w.z = pk2(v[4], v[5]); w.w = pk2(v[6], v[7]);
                    *(u32x4*)(O + (size_t)(row0 + ai * 128 + m * 16) * NHG + col) = w;
                }
        }
    }
};
struct EpiHY {
    static constexpr bool PERM = true;
    bf16_t* O;
    __device__ __forceinline__ void operator()(const f32x4 (&acc)[2][2][4][2], const pg8::GUnit& u, int wr, int wc, int fr, int fq) const {
        const int row0 = u.i0 * 256 + wr * 64 + fr, colt = u.i1 * 256 + wc * 32 + 8 * fq;
#pragma unroll
        for (int ai = 0; ai < 2; ++ai)
#pragma unroll
            for (int m = 0; m < 4; ++m)
#pragma unroll
                for (int bj = 0; bj < 2; ++bj) {
                    const f32x4 v0 = acc[ai][bj][m][0], v1 = acc[ai][bj][m][1];
                    u32x4 w; w.x = pk2(v0[0], v0[1]); w.y = pk2(v0[2], v0[3]); w.z = pk2(v1[0], v1[1]); w.w = pk2(v1[2], v1[3]);
                    *(u32x4*)(O + (size_t)(row0 + ai * 128 + m * 16) * NTOK + colt + bj * 128) = w;
                }
    }
};
struct EpiOut {
    static constexpr bool PERM = false;
    const float* xlat; const float* xctx; float* xo; const float* mods; int first;
    __device__ __forceinline__ void operator()(const f32x4 (&acc)[2][2][4][2], const pg8::GUnit& u, int wr, int wc, int fr, int fq) const {
        const int row0 = u.i0 * 256 + wr * 64 + fr, col0 = u.i1 * 256 + wc * 32 + 4 * fq;
#pragma unroll
        for (int ai = 0; ai < 2; ++ai)
#pragma unroll
            for (int m = 0; m < 4; ++m) {
                const int row = row0 + ai * 128 + m * 16;
                const float* src = first ? (row < NLAT ? xlat + (size_t)row * D : xctx + (size_t)(row - NLAT) * D) : xo + (size_t)row * D;
                const float* g1 = mods + bidx(row) * 6144 + 2048;
#pragma unroll
                for (int bj = 0; bj < 2; ++bj)
#pragma unroll
                    for (int n = 0; n < 2; ++n) { const int col = col0 + bj * 128 + n * 16;
                        const f32x4 xv = *(const f32x4*)(src + col), gv = *(const f32x4*)(g1 + col);
                        *(f32x4*)(xo + (size_t)row * D + col) = xv + gv * acc[ai][bj][m][n]; }
            }
    }
};
struct EpiAct {
    static constexpr bool PERM = true;
    bf16_t* O; const float* roww;
    __device__ __forceinline__ void operator()(const f32x4 (&acc)[2][2][4][2], const pg8::GUnit& u, int wr, int wc, int fr, int fq) const {
        const int es = u.i1 >> 1; const int pos0 = u.i0 * 256 + wr * 64 + fr, col = u.i1 * 128 + wc * 32 + 8 * fq;
#pragma unroll
        for (int ai = 0; ai < 2; ++ai)
#pragma unroll
            for (int m = 0; m < 4; ++m) {
                const int pos = pos0 + ai * 128 + m * 16;
                const float wgt = roww[pos * 2 + es];
                float v[8];
#pragma unroll
                for (int j = 0; j < 8; ++j) v[j] = siluf_(acc[ai][0][m][j >> 2][j & 3]) * acc[ai][1][m][j >> 2][j & 3] * wgt;
                u32x4 w; w.x = pk2(v[0], v[1]); w.y = pk2(v[2], v[3]); w.z = pk2(v[4], v[5]); w.w = pk2(v[6], v[7]);
                *(u32x4*)(O + (size_t)pos * 512 + col) = w;
            }
    }
};
struct EpiDown {
    static constexpr bool PERM = false;
    float* xo; const int* rowtok; const float* mods;
    __device__ __forceinline__ void operator()(const f32x4 (&acc)[2][2][4][2], const pg8::GUnit& u, int wr, int wc, int fr, int fq) const {
        const int pos0 = u.i0 * 256 + wr * 64 + fr, col0 = u.i1 * 256 + wc * 32 + 4 * fq;
#pragma unroll
        for (int ai = 0; ai < 2; ++ai)
#pragma unroll
            for (int m = 0; m < 4; ++m) {
                const int tok = rowtok[pos0 + ai * 128 + m * 16];
                if (tok >= 0) {
                    const float* g2 = mods + bidx(tok) * 6144 + 5120;
                    float* xr = xo + (size_t)tok * D;
#pragma unroll
                    for (int bj = 0; bj < 2; ++bj)
#pragma unroll
                        for (int n = 0; n < 2; ++n) { const int col = col0 + bj * 128 + n * 16;
                            const f32x4 xv = *(const f32x4*)(xr + col), gv = *(const f32x4*)(g2 + col);
                            *(f32x4*)(xr + col) = xv + gv * acc[ai][bj][m][n]; }
                }
            }
    }
};

__device__ __forceinline__ int padx(int i) { return i + (i >> 3); }
__device__ __forceinline__ f32x2 cmul(f32x2 a, f32x2 b) { return (f32x2){a.x * b.x - a.y * b.y, a.x * b.y + a.y * b.x}; }
__device__ __forceinline__ f32x2 cmulc(f32x2 a, f32x2 b) { return (f32x2){a.x * b.x + a.y * b.y, a.y * b.x - a.x * b.y}; }
constexpr int XPAD = 2048 + 256;

__device__ __forceinline__ void fft_p1_dif(f32x2 (&v)[8], int tt, const LAS f32x2* T) {
#pragma unroll
    for (int g = 0; g < 2; ++g) { const int u = tt + 256 * g;
#pragma unroll
        for (int j = 0; j < 2; ++j) { const f32x2 a = v[g + 2 * j], b = v[g + 2 * j + 4]; v[g + 2 * j] = a + b; v[g + 2 * j + 4] = cmul(a - b, T[2 * (u + 512 * j)]); }
        const f32x2 tw = T[4 * u];
        { const f32x2 a = v[g], b = v[g + 2]; v[g] = a + b; v[g + 2] = cmul(a - b, tw); }
        { const f32x2 a = v[g + 4], b = v[g + 6]; v[g + 4] = a + b; v[g + 6] = cmul(a - b, tw); } }
}
__device__ __forceinline__ void fft_p1_dit(f32x2 (&v)[8], int tt, const LAS f32x2* T) {
#pragma unroll
    for (int g = 0; g < 2; ++g) { const int u = tt + 256 * g;
        const f32x2 tw = T[4 * u];
        { const f32x2 a = v[g], b = cmulc(v[g + 2], tw); v[g] = a + b; v[g + 2] = a - b; }
        { const f32x2 a = v[g + 4], b = cmulc(v[g + 6], tw); v[g + 4] = a + b; v[g + 6] = a - b; }
#pragma unroll
        for (int j = 0; j < 2; ++j) { const f32x2 a = v[g + 2 * j], b = cmulc(v[g + 2 * j + 4], T[2 * (u + 512 * j)]); v[g + 2 * j] = a + b; v[g + 2 * j + 4] = a - b; } }
}
template <int Q> __device__ __forceinline__ void r8_dif(f32x2 (&e)[8], int r, const LAS f32x2* T) {
    constexpr int S2 = 512 / Q;
#pragma unroll
    for (int j = 0; j < 4; ++j) { const f32x2 a = e[j], b = e[j + 4]; e[j] = a + b; e[j + 4] = cmul(a - b, T[S2 * (r + Q * j)]); }
#pragma unroll
    for (int jj = 0; jj < 4; ++jj) { const int j = (jj & 1) + 4 * (jj >> 1); const f32x2 a = e[j], b = e[j + 2]; e[j] = a + b; e[j + 2] = cmul(a - b, T[2 * S2 * (r + Q * (j & 1))]); }
    const f32x2 tw = T[4 * S2 * r];
#pragma unroll
    for (int j = 0; j < 8; j += 2) { const f32x2 a = e[j], b = e[j + 1]; e[j] = a + b; e[j + 1] = cmul(a - b, tw); }
}
template <int Q> __device__ __forceinline__ void r8_dit(f32x2 (&e)[8], int r, const LAS f32x2* T) {
    constexpr int S2 = 512 / Q;
    const f32x2 tw = T[4 * S2 * r];
#pragma unroll
    for (int j = 0; j < 8; j += 2) { const f32x2 a = e[j], b = cmulc(e[j + 1], tw); e[j] = a + b; e[j + 1] = a - b; }
#pragma unroll
    for (int jj = 0; jj < 4; ++jj) { const int j = (jj & 1) + 4 * (jj >> 1); const f32x2 a = e[j], b = cmulc(e[j + 2], T[2 * S2 * (r + Q * (j & 1))]); e[j] = a + b; e[j + 2] = a - b; }
#pragma unroll
    for (int j = 0; j < 4; ++j) { const f32x2 a = e[j], b = cmulc(e[j + 4], T[S2 * (r + Q * j)]); e[j] = a + b; e[j + 4] = a - b; }
}
template <int Q, bool INV> __device__ __forceinline__ void fft_mid(LAS f32x2* X, int tt, const LAS f32x2* T) {
    const int blk = tt / Q, r = tt % Q, base = blk * 8 * Q + r;
    f32x2 e[8];
#pragma unroll
    for (int j = 0; j < 8; ++j) e[j] = X[padx(base + Q * j)];
    if (INV) r8_dit<Q>(e, r, T); else r8_dif<Q>(e, r, T);
#pragma unroll
    for (int j = 0; j < 8; ++j) X[padx(base + Q * j)] = e[j];
}
__device__ __forceinline__ void fft_conv_half(f32x2 (&v)[8], LAS f32x2* X, const LAS f32x2* T, const f32x2* K, int tt) {
    f32x2 kv[8];
#pragma unroll
    for (int j = 0; j < 8; ++j) kv[j] = K[8 * tt + j];
    fft_p1_dif(v, tt, T);
#pragma unroll
    for (int m = 0; m < 8; ++m) X[padx(tt + 256 * m)] = v[m];
    __syncthreads();
    fft_mid<64, false>(X, tt, T); __syncthreads();
    fft_mid<8, false>(X, tt, T); __syncthreads();
    f32x2 e[8];
#pragma unroll
    for (int j = 0; j < 8; ++j) e[j] = X[padx(8 * tt + j)];
    r8_dif<1>(e, 0, T);
#pragma unroll
    for (int j = 0; j < 8; ++j) e[j] = cmul(e[j], kv[j]);
    r8_dit<1>(e, 0, T);
#pragma unroll
    for (int j = 0; j < 8; ++j) X[padx(8 * tt + j)] = e[j];
    __syncthreads();
    fft_mid<8, true>(X, tt, T); __syncthreads();
    fft_mid<64, true>(X, tt, T); __syncthreads();
#pragma unroll
    for (int m = 0; m < 8; ++m) v[m] = X[padx(tt + 256 * m)];
    fft_p1_dit(v, tt, T);
}
__device__ __forceinline__ void fft_fwd_store(f32x2 (&v)[8], LAS f32x2* X, const LAS f32x2* T, f32x2* Kout, int tt) {
    fft_p1_dif(v, tt, T);
#pragma unroll
    for (int m = 0; m < 8; ++m) X[padx(tt + 256 * m)] = v[m];
    __syncthreads();
    fft_mid<64, false>(X, tt, T); __syncthreads();
    fft_mid<8, false>(X, tt, T); __syncthreads();
    f32x2 e[8];
#pragma unroll
    for (int j = 0; j < 8; ++j) e[j] = X[padx(8 * tt + j)];
    r8_dif<1>(e, 0, T);
#pragma unroll
    for (int j = 0; j < 8; ++j) Kout[8 * tt + j] = e[j];
    __syncthreads();
}
__device__ __forceinline__ void build_twiddles(const Ctx& C, LAS f32x2* T) {
    for (int k = C.tid; k < 2048; k += NTHR) { float s, c; sincospif((float)k * (1.0f / 2048.0f), &s, &c); T[k] = (f32x2){c, -s}; }
}

__device__ __forceinline__ void phase0(const Ctx& C) {
    LAS float* sil = (LAS float*)C.lds;
    LAS float* red = sil + 9 * 1024;
    LAS float* zs = red + 8 * 9 * 64;
    LAS float* h1s = zs + 8 * 40;
    const float* cin = C.in[IN_C]; const float* cctx = C.in[IN_CCTX];
    for (int i = C.tid; i < 9 * 1024; i += NTHR) { const int r = i >> 10, k = i & 1023; const float v = r < 8 ? cin[r * 1024 + k] : cctx[k]; sil[i] = v / (1.0f + expf(-v)); }
    __syncthreads();
    float* mods = WSP(float, WS_MODS);
    const float* wmod = C.in[IN_WMOD]; const float* bmod = C.in[IN_BMOD];
    for (int item = C.bid; item < 4 * 96; item += C.G) {
        const int l = item / 96, cb = item % 96, cc = C.tid & 63, kg = C.tid >> 6;
        const float* w = wmod + ((size_t)l * 1024 + kg * 128) * 6144 + cb * 64 + cc;
        const LAS float* sk = sil + kg * 128;
        float acc[9];
#pragma unroll
        for (int r = 0; r < 9; ++r) acc[r] = 0.f;
#pragma unroll 4
        for (int k = 0; k < 128; ++k) { const float wv = w[(size_t)k * 6144];
#pragma unroll
            for (int r = 0; r < 9; ++r) acc[r] += sk[r * 1024 + k] * wv; }
#pragma unroll
        for (int r = 0; r < 9; ++r) red[(kg * 9 + r) * 64 + cc] = acc[r];
        __syncthreads();
        for (int o = C.tid; o < 576; o += NTHR) { const int r = o >> 6, c2 = o & 63; float s = 0.f;
#pragma unroll
            for (int g = 0; g < 8; ++g) s += red[(g * 9 + r) * 64 + c2];
            mods[(size_t)(l * 9 + r) * 6144 + cb * 64 + c2] = s + bmod[l * 6144 + cb * 64 + c2]; }
        __syncthreads();
    }
    for (int item = C.bid; item < 4 * 288; item += C.G) {
        const int l = item / 288, r = item % 288, isctx = r >= 256;
        const int L = isctx ? 256 : 2048, t0 = (isctx ? r - 256 : r) * 8, tl = C.tid >> 6, j = C.tid & 63, t = t0 + tl;
        if (j < 33) { float z;
            if (j == 0) z = (float)t / (float)(L - 1);
            else { const int fi = (j - 1) & 15; const float freq = 1e-4f + (float)fi * ((15.0f - 1e-4f) / 15.0f);
                const float ang = ((float)(2.0 * 3.14159265358979323846 / L) * (float)t) * freq; z = (j <= 16) ? cosf(ang) : -sinf(ang); }
            zs[tl * 40 + j] = z; }
        __syncthreads();
        { const float* w1 = C.in[IN_W1] + (size_t)l * 33 * 64; float s = C.in[IN_B1][l * 64 + j];
            for (int i = 0; i < 33; ++i) s += zs[tl * 40 + i] * w1[i * 64 + j];
            h1s[tl * 64 + j] = sinf(s); }
        __syncthreads();
        { const float* w2 = C.in[IN_W2] + (size_t)l * 64 * 64; float s = C.in[IN_B2][l * 64 + j];
            for (int i = 0; i < 64; ++i) s += h1s[tl * 64 + i] * w2[i * 64 + j];
            float* dst = isctx ? WSP(float, WS_H2C) + ((size_t)l * 256 + t) * 64 : WSP(float, WS_H2L) + ((size_t)l * 2048 + t) * 64;
            dst[j] = sinf(s); }
        __syncthreads();
    }
    if (C.bid == C.G - 1) {
        const float* lb = C.in[IN_LB]; float* lower = WSP(float, WS_LOWER);
        for (int i = C.tid; i < 1024; i += NTHR) { const int d = i >> 9, c = i & 511; float v[4], mx = -3.4e38f, s = 0.f;
#pragma unroll
            for (int l = 0; l < 4; ++l) { v[l] = lb[(d * 4 + l) * 512 + c]; mx = fmaxf(mx, v[l]); }
#pragma unroll
            for (int l = 0; l < 4; ++l) { v[l] = expf(v[l] - mx); s += v[l]; }
            float cum = 0.f;
#pragma unroll
            for (int l = 0; l < 4; ++l) { if (l > 0) cum += v[l] / s; lower[(d * 4 + l) * 512 + c] = cum; } }
    }
}

__device__ __forceinline__ const float* xrow_src(const Ctx& C, int l, int row) {
    return l == 0 ? (row < NLAT ? C.in[IN_X] + (size_t)row * D : C.in[IN_CTX] + (size_t)(row - NLAT) * D) : WSP(const float, WS_XBUF) + (size_t)row * D;
}
__device__ __forceinline__ void transpose_item(const float* W, int K, int N, bf16_t* WT, LAS float* scr, int item, int lane) {
    const int nblk = N / 32, kb = item / nblk, nb = item % nblk, k0 = 64 * kb, n0 = 32 * nb;
#pragma unroll 8
    for (int i = 0; i < 32; ++i) { const int kk = 2 * i + (lane >> 5); scr[kk * 33 + (lane & 31)] = W[(size_t)(k0 + kk) * N + n0 + (lane & 31)]; }
    LDS_WAIT(); asm volatile("" ::: "memory");
    const int c = lane & 7;
#pragma unroll
    for (int j = 0; j < 4; ++j) { const int n = (lane >> 3) + 8 * j; const LAS float* s = scr + (8 * c) * 33 + n;
        u32x4 o; o.x = pk2(s[0 * 33], s[1 * 33]); o.y = pk2(s[2 * 33], s[3 * 33]); o.z = pk2(s[4 * 33], s[5 * 33]); o.w = pk2(s[6 * 33], s[7 * 33]);
        *(u32x4*)(WT + (size_t)(n0 + n) * K + k0 + 8 * c) = o; }
    LDS_WAIT(); asm volatile("" ::: "memory");
}
__device__ __forceinline__ void phase_l1(const Ctx& C, int l) {
    const int gw = C.bid * NWAVES + C.wave, NGW = C.G * NWAVES;
    const float* mods = WSP(const float, WS_MODS) + (size_t)l * 9 * 6144;
    bf16_t* an = WSP(bf16_t, WS_R1);
    for (int row = gw; row < NTOK; row += NGW) {
        const float* src = xrow_src(C, l, row); const float* md = mods + bidx(row) * 6144;
        f32x4 v[4]; float ss = 0.f;
#pragma unroll
        for (int j = 0; j < 4; ++j) { v[j] = *(const f32x4*)(src + C.lane * 4 + 256 * j); ss += (v[j].x * v[j].x + v[j].y * v[j].y) + (v[j].z * v[j].z + v[j].w * v[j].w); }
        ss = wave_sum(ss); const float rinv = 1.0f / sqrtf(ss * (1.0f / D) + EPS);
#pragma unroll
        for (int j = 0; j < 4; ++j) { const int k = C.lane * 4 + 256 * j; const f32x4 sh = *(const f32x4*)(md + k), sc = *(const f32x4*)(md + 1024 + k);
            const f32x4 o = v[j] * rinv * (sc + 1.0f) + sh; u32x2 w; w.x = pk2(o.x, o.y); w.y = pk2(o.z, o.w);
            *(u32x2*)(an + (size_t)row * D + k) = w; }
    }
    {
        LAS float* scr = (LAS float*)(C.lds + C.wave * 16384);
        constexpr int I_IN = 16 * 128, I_OUT = 16 * 32, I_E = 128;
        constexpr int NIT = I_IN + I_OUT + 3 * 16 * I_E;
        for (int it = gw; it < NIT; it += NGW) {
            int r = it;
            if (r < I_IN) { transpose_item(C.in[IN_WIN] + (size_t)l * D * DIN, D, DIN, WSP(bf16_t, WS_WIN), scr, r, C.lane); continue; } r -= I_IN;
            if (r < I_OUT) { transpose_item(C.in[IN_WOUT] + (size_t)l * D * D, D, D, WSP(bf16_t, WS_WOUT), scr, r, C.lane); continue; } r -= I_OUT;
            if (r < 16 * I_E) { const int e = r / I_E; transpose_item(C.in[IN_WG] + ((size_t)l * NE + e) * D * DE, D, DE, WSP(bf16_t, WS_WG) + (size_t)e * DE * D, scr, r % I_E, C.lane); continue; } r -= 16 * I_E;
            if (r < 16 * I_E) { const int e = r / I_E; transpose_item(C.in[IN_WU] + ((size_t)l * NE + e) * D * DE, D, DE, WSP(bf16_t, WS_WU) + (size_t)e * DE * D, scr, r % I_E, C.lane); continue; } r -= 16 * I_E;
            { const int e = r / I_E; transpose_item(C.in[IN_WD] + ((size_t)l * NE + e) * DE * D, DE, D, WSP(bf16_t, WS_WD) + (size_t)e * D * DE, scr, r % I_E, C.lane); }
        }
    }
    __syncthreads();
    {
        LAS f32x2* T = (LAS f32x2*)C.lds;
        const int team = C.tid >> 8, tt = C.tid & 255;
        LAS f32x2* X = (LAS f32x2*)(C.lds + 16384) + team * XPAD;
        LAS float* hbs = (LAS float*)(C.lds + 16384 + 2 * XPAD * 8) + team * 2048;
        LAS float* w3s = (LAS float*)(C.lds + 16384 + 2 * XPAD * 8 + 16384) + team * 128;
        LAS float* reds = (LAS float*)(C.lds + 16384 + 2 * XPAD * 8 + 16384 + 1024);
        build_twiddles(C, T);
        __syncthreads();
        const float* h2 = WSP(const float, WS_H2L) + (size_t)l * 2048 * 64;
        const float* w3 = C.in[IN_W3] + (size_t)l * 64 * 2048; const float* b3 = C.in[IN_B3] + l * 2048;
        f32x2* kspec = WSP(f32x2, WS_KSPEC);
        for (int item = C.bid; item < 512; item += C.G) {
            const int idx = item * 2 + team, o = idx >> 9, c = idx & 511;
            const int colf = o * 1024 + c, colb = colf + 512;
            if (tt < 128) w3s[tt] = w3[(size_t)(tt & 63) * 2048 + ((tt >> 6) ? colb : colf)];
            __syncthreads();
            const float delta = fabsf(logf(1e-2f) / 0.3f + (float)c * ((logf(1e-2f) / 1.5f - logf(1e-2f) / 0.3f) / 511.0f));
            float hf[8], hb[8], s = 0.f;
#pragma unroll
            for (int j = 0; j < 8; ++j) { const int t = tt + 256 * j; const f32x4* hr = (const f32x4*)(h2 + (size_t)t * 64);
                float af = b3[colf], ab = b3[colb];
#pragma unroll
                for (int i4 = 0; i4 < 16; ++i4) { const f32x4 h = hr[i4];
                    af += h.x * w3s[i4 * 4] + h.y * w3s[i4 * 4 + 1] + h.z * w3s[i4 * 4 + 2] + h.w * w3s[i4 * 4 + 3];
                    ab += h.x * w3s[64 + i4 * 4] + h.y * w3s[64 + i4 * 4 + 1] + h.z * w3s[64 + i4 * 4 + 2] + h.w * w3s[64 + i4 * 4 + 3]; }
                const float win = expf(-((float)t / 2047.0f) * delta);
                hf[j] = af * win; hb[j] = ab * win; s += fabsf(hf[j]) + fabsf(hb[j]); }
            s = wave_sum(s);
            if (C.lane == 0) reds[C.wave] = s;
            __syncthreads();
            const float tot = reds[team * 4] + reds[team * 4 + 1] + reds[team * 4 + 2] + reds[team * 4 + 3];
            const float inv = 1.0f / (tot * 4096.0f);
#pragma unroll
            for (int j = 0; j < 8; ++j) { hf[j] *= inv; hb[j] *= inv; hbs[tt + 256 * j] = hb[j]; }
            __syncthreads();
            f32x2 ve[8], vo[8];
#pragma unroll
            for (int j = 0; j < 8; ++j) { const int n = tt + 256 * j; const float kb = n > 0 ? hbs[2048 - n] : 0.f;
                ve[j] = (f32x2){hf[j] + kb, 0.f}; const float dd = hf[j] - kb; const f32x2 tw = T[n]; vo[j] = (f32x2){dd * tw.x, dd * tw.y}; }
            f32x2* kout = kspec + ((size_t)(o * 512 + c) * 2) * 2048;
            fft_fwd_store(ve, X, T, kout, tt);
            fft_fwd_store(vo, X, T, kout + 2048, tt);
        }
    }
}

__device__ __forceinline__ float shortconv(const LAS bf16_t* raw, int t, int mask, int tmax, float w0, float w1, float w2, float bias) {
    const float pm = ((t & mask) != 0) ? bf2f(raw[t - 1]) : 0.f;
    const float pc = bf2f(raw[t]);
    const float pp = ((t & mask) != mask && t < tmax) ? bf2f(raw[t + 1]) : 0.f;
    return w0 * pm + w1 * pc + w2 * pp + bias;
}
__device__ __forceinline__ void hyena_lat(const Ctx& C, int l, int item) {
    const int bp = item >> 6, cg = item & 63, team = C.tid >> 8, tt = C.tid & 255;
    LAS f32x2* T = (LAS f32x2*)C.lds;
    LAS f32x2* X = (LAS f32x2*)(C.lds + 16384) + team * XPAD;
    LAS bf16_t* raw = (LAS bf16_t*)(C.lds + 16384 + 2 * XPAD * 8) + team * 4096;
    LAS bf16_t* outs = (LAS bf16_t*)(C.lds + 16384 + 2 * XPAD * 8 + 16384);
    const bf16_t* phyt = WSP(const bf16_t, WS_PHYT);
    const float* cw = C.in[IN_CONVW] + (size_t)l * 3 * NHY; const float* cb = C.in[IN_CONVB] + (size_t)l * NHY;
    const float* hyb = C.in[IN_HYBIAS] + (size_t)l * 2 * DH;
    const f32x2* kspec = WSP(const f32x2, WS_KSPEC);
    const int ba = 2 * bp;
    for (int round = 0; round < 4; ++round) {
        const int c = cg * 8 + round * 2 + team;
        f32x2 z[8], acc[8], v[8];
#pragma unroll 1
        for (int stage = 0; stage < 3; ++stage) {
            const int ch = stage * 512 + c;
            __syncthreads();
#pragma unroll
            for (int k = 0; k < 2; ++k) { const int q = tt + 256 * k, rr = q >> 8, cc = q & 255;
                *(LAS u32x4*)(raw + rr * 2048 + cc * 8) = *(const u32x4*)(phyt + (size_t)ch * NTOK + (size_t)(ba + rr) * 2048 + cc * 8); }
            __syncthreads();
            const float w0 = cw[ch], w1 = cw[NHY + ch], w2 = cw[2 * NHY + ch], bs = cb[ch];
            if (stage == 0) {
#pragma unroll
                for (int j = 0; j < 8; ++j) { const int t = tt + 256 * j; z[j] = (f32x2){shortconv(raw, t, 63, 4096, w0, w1, w2, bs), shortconv(raw + 2048, t, 63, 4096, w0, w1, w2, bs)}; }
            } else {
                const float dsk = hyb[(stage - 1) * DH + c];
#pragma unroll
                for (int j = 0; j < 8; ++j) { const int t = tt + 256 * j; const f32x2 cv = acc[j] + z[j] * dsk;
                    z[j] = (f32x2){shortconv(raw, t, 63, 4096, w0, w1, w2, bs) * cv.x, shortconv(raw + 2048, t, 63, 4096, w0, w1, w2, bs) * cv.y}; }
            }
            if (stage == 2) {
#pragma unroll
                for (int j = 0; j < 8; ++j) { const int t = tt + 256 * j; outs[(size_t)t * 8 + round * 2 + team] = (bf16_t)f2bf(z[j].x); outs[(size_t)(2048 + t) * 8 + round * 2 + team] = (bf16_t)f2bf(z[j].y); }
                break;
            }
            const f32x2* K = kspec + ((size_t)(stage * 512 + c) * 2) * 2048;
#pragma unroll
            for (int j = 0; j < 8; ++j) v[j] = z[j];
            fft_conv_half(v, X, T, K, tt);
#pragma unroll
            for (int j = 0; j < 8; ++j) acc[j] = v[j];
#pragma unroll
            for (int j = 0; j < 8; ++j) v[j] = cmul(z[j], T[tt + 256 * j]);
            fft_conv_half(v, X, T, K + 2048, tt);
#pragma unroll
            for (int j = 0; j < 8; ++j) acc[j] += cmulc(v[j], T[tt + 256 * j]);
        }
    }
    __syncthreads();
    bf16_t* Y = WSP(bf16_t, WS_R1);
    for (int i = C.tid; i < 4096; i += NTHR) { const int b = i >> 11, t = i & 2047;
        *(u32x4*)(Y + ((size_t)(ba + b) * 2048 + t) * D + cg * 8) = *(const LAS u32x4*)(outs + (size_t)i * 8); }
    __syncthreads();
}
__device__ __forceinline__ void hyena_ctx(const Ctx& C, int l, int c) {
    LAS float* hf = (LAS float*)(C.lds + 16384);
    LAS float* hb = hf + 512;
    LAS float* us = hb + 512;
    LAS float* z2 = us + 3 * 2048;
    LAS float* reds = z2 + 2048;
    LAS float* w3s = reds + 8;
    const float* h2 = WSP(const float, WS_H2C) + (size_t)l * 256 * 64;
    const float* w3 = C.in[IN_W3] + (size_t)l * 64 * 2048; const float* b3 = C.in[IN_B3] + l * 2048;
    const bf16_t* phyt = WSP(const bf16_t, WS_PHYT);
    const float* cw = C.in[IN_CONVW] + (size_t)l * 3 * NHY; const float* cb = C.in[IN_CONVB] + (size_t)l * NHY;
    const float* hyb = C.in[IN_HYBIAS] + (size_t)l * 2 * DH;
    __syncthreads();
    if (C.tid < 256) { const int i = C.tid & 63, which = C.tid >> 6;   w3s[C.tid] = w3[(size_t)i * 2048 + (which >> 1) * 1024 + (which & 1) * 512 + c]; }
    __syncthreads();
    { const int t = C.tid & 255, o = C.tid >> 8;
        const f32x4* hr = (const f32x4*)(h2 + (size_t)t * 64);
        float af = b3[o * 1024 + c], ab = b3[o * 1024 + 512 + c];
        const LAS float* wf = w3s + (o * 2) * 64; const LAS float* wb = w3s + (o * 2 + 1) * 64;
#pragma unroll
        for (int i4 = 0; i4 < 16; ++i4) { const f32x4 h = hr[i4];
            af += h.x * wf[i4 * 4] + h.y * wf[i4 * 4 + 1] + h.z * wf[i4 * 4 + 2] + h.w * wf[i4 * 4 + 3];
            ab += h.x * wb[i4 * 4] + h.y * wb[i4 * 4 + 1] + h.z * wb[i4 * 4 + 2] + h.w * wb[i4 * 4 + 3]; }
        const float delta = fabsf(logf(1e-2f) / 0.3f + (float)c * ((logf(1e-2f) / 1.5f - logf(1e-2f) / 0.3f) / 511.0f));
        const float win = expf(-((float)t / 255.0f) * delta);
        af *= win; ab *= win;
        float s = wave_sum(fabsf(af) + fabsf(ab));
        if (C.lane == 0) reds[C.wave] = s;
        __syncthreads();
        const float tot = reds[o * 4] + reds[o * 4 + 1] + reds[o * 4 + 2] + reds[o * 4 + 3];
        hf[o * 256 + t] = af / tot; hb[o * 256 + t] = ab / tot; }
    for (int i = C.tid; i < 3 * 2048; i += NTHR) { const int grp = i >> 11, b = (i >> 8) & 7, t = i & 255, ch = grp * 512 + c;
        const bf16_t* p = phyt + (size_t)ch * NTOK + NLAT + b * 256;
        const float pm = t > 0 ? bf2f(p[t - 1]) : 0.f, pc = bf2f(p[t]), pp = t < 255 ? bf2f(p[t + 1]) : 0.f;
        us[i] = cw[ch] * pm + cw[NHY + ch] * pc + cw[2 * NHY + ch] * pp + cb[ch]; }
    __syncthreads();
    const int b = C.tid >> 6, t0 = C.tid & 63;
    bf16_t* Y = WSP(bf16_t, WS_R1);
#pragma unroll 1
    for (int o = 0; o < 2; ++o) {
        const LAS float* uin = o == 0 ? us + b * 256 : z2 + b * 256;
        const LAS float* f = hf + o * 256; const LAS float* g = hb + o * 256;
        float a[4] = {0.f, 0.f, 0.f, 0.f};
        for (int s = 0; s < 256; ++s) { const float uv = uin[s];
#pragma unroll
            for (int jj = 0; jj < 4; ++jj) { const int d = t0 + 64 * jj - s; a[jj] += uv * (d >= 0 ? f[d] : g[-d]); } }
        const float dsk = hyb[o * DH + c];
        __syncthreads();
#pragma unroll
        for (int jj = 0; jj < 4; ++jj) { const int t = t0 + 64 * jj; const float cv = a[jj] + uin[t] * dsk;
            if (o == 0) z2[b * 256 + t] = us[2048 + b * 256 + t] * cv;
            else Y[(size_t)(NLAT + b * 256 + t) * D + c] = (bf16_t)f2bf(us[4096 + b * 256 + t] * cv); }
        __syncthreads();
    }
}
__device__ __forceinline__ void hgrn_scan(const Ctx& C, int item) {
    const int dvq = item & 3, dir = (item >> 2) & 1, h = (item >> 3) & 3, b = item >> 5;
    LAS float* qs = (LAS float*)C.lds;
    LAS float* ks = qs + 2 * 4096;
    LAS float* vs = ks + 2 * 4096;
    LAS float* os = vs + 2 * 1024;
    const bf16_t* phg = WSP(const bf16_t, WS_PHG);
    bf16_t* odir = WSP(bf16_t, WS_ODIR) + (size_t)dir * NTOK * 512;
    const int kg = C.lane & 15, j = C.wave * 4 + (C.lane >> 4);
    const int ltok = C.tid >> 4, lpart = C.tid & 15;
    float S[8];
#pragma unroll
    for (int i = 0; i < 8; ++i) S[i] = 0.f;
    auto rowof = [&](int sg) -> int { if (sg < 256) { const int t = dir ? 255 - sg : sg; return NLAT + b * 256 + t; } const int s2 = sg - 256; const int t = dir ? 2047 - s2 : s2; return b * 2048 + t; };
    u32x4 rq, rk, rv;
    { const int row = rowof(ltok); rq = *(const u32x4*)(phg + (size_t)row * NHG + h * 128 + lpart * 8); rk = *(const u32x4*)(phg + (size_t)row * NHG + 1536 + dir * 512 + h * 128 + lpart * 8);
      if (C.tid < 128) { const int r2 = rowof(C.tid >> 2); rv = *(const u32x4*)(phg + (size_t)r2 * NHG + 512 + h * 128 + dvq * 32 + (C.tid & 3) * 8); } }
    __syncthreads();
    { LAS float* q = qs + ltok * 128 + lpart * 8; LAS float* k = ks + ltok * 128 + lpart * 8;
      q[0] = bflo(rq.x); q[1] = bfhi(rq.x); q[2] = bflo(rq.y); q[3] = bfhi(rq.y); q[4] = bflo(rq.z); q[5] = bfhi(rq.z); q[6] = bflo(rq.w); q[7] = bfhi(rq.w);
      k[0] = bflo(rk.x); k[1] = bfhi(rk.x); k[2] = bflo(rk.y); k[3] = bfhi(rk.y); k[4] = bflo(rk.z); k[5] = bfhi(rk.z); k[6] = bflo(rk.w); k[7] = bfhi(rk.w);
      if (C.tid < 128) { LAS float* vv = vs + (C.tid >> 2) * 32 + (C.tid & 3) * 8;
        vv[0] = bflo(rv.x); vv[1] = bfhi(rv.x); vv[2] = bflo(rv.y); vv[3] = bfhi(rv.y); vv[4] = bflo(rv.z); vv[5] = bfhi(rv.z); vv[6] = bflo(rv.w); vv[7] = bfhi(rv.w); } }
    __syncthreads();
    constexpr int NCH = (CTXL + SEQ) / 32;
#pragma unroll 1
    for (int ch = 0; ch < NCH; ++ch) {
        const int buf = ch & 1;
        if (ch + 1 < NCH) { const int row = rowof((ch + 1) * 32 + ltok);
            rq = *(const u32x4*)(phg + (size_t)row * NHG + h * 128 + lpart * 8); rk = *(const u32x4*)(phg + (size_t)row * NHG + 1536 + dir * 512 + h * 128 + lpart * 8);
            if (C.tid < 128) { const int r2 = rowof((ch + 1) * 32 + (C.tid >> 2)); rv = *(const u32x4*)(phg + (size_t)r2 * NHG + 512 + h * 128 + dvq * 32 + (C.tid & 3) * 8); } }
        const LAS float* qb = qs + buf * 4096 + kg * 8; const LAS float* kb = ks + buf * 4096 + kg * 8; const LAS float* vb = vs + buf * 1024 + j; LAS float* ob = os + buf * 1024 + j;
#pragma unroll 4
        for (int s = 0; s < 32; ++s) {
            const f32x4 q0 = *(const LAS f32x4*)(qb + s * 128), q1 = *(const LAS f32x4*)(qb + s * 128 + 4), k0 = *(const LAS f32x4*)(kb + s * 128), k1 = *(const LAS f32x4*)(kb + s * 128 + 4);
            const float vv = vb[s * 32];
            float o = 0.f;
#pragma unroll
            for (int i = 0; i < 4; ++i) { S[i] += k0[i] * (vv - S[i]); o += q0[i] * S[i]; S[4 + i] += k1[i] * (vv - S[4 + i]); o += q1[i] * S[4 + i]; }
            o = row16_sum(o);
            if (kg == 0) ob[s * 32] = o;
        }
        if (ch + 1 < NCH) { LAS float* q = qs + (buf ^ 1) * 4096 + ltok * 128 + lpart * 8; LAS float* k = ks + (buf ^ 1) * 4096 + ltok * 128 + lpart * 8;
            q[0] = bflo(rq.x); q[1] = bfhi(rq.x); q[2] = bflo(rq.y); q[3] = bfhi(rq.y); q[4] = bflo(rq.z); q[5] = bfhi(rq.z); q[6] = bflo(rq.w); q[7] = bfhi(rq.w);
            k[0] = bflo(rk.x); k[1] = bfhi(rk.x); k[2] = bflo(rk.y); k[3] = bfhi(rk.y); k[4] = bflo(rk.z); k[5] = bfhi(rk.z); k[6] = bflo(rk.w); k[7] = bfhi(rk.w);
            if (C.tid < 128) { LAS float* vv = vs + (buf ^ 1) * 1024 + (C.tid >> 2) * 32 + (C.tid & 3) * 8;
                vv[0] = bflo(rv.x); vv[1] = bfhi(rv.x); vv[2] = bflo(rv.y); vv[3] = bfhi(rv.y); vv[4] = bflo(rv.z); vv[5] = bfhi(rv.z); vv[6] = bflo(rv.w); vv[7] = bfhi(rv.w); } }
        __syncthreads();
        { const int i2 = C.tid * 2, tok = i2 >> 5, jx = i2 & 31; const int row = rowof(ch * 32 + tok);
            const LAS float* op = os + buf * 1024 + tok * 32 + jx;
            *(unsigned*)(odir + (size_t)row * 512 + h * 128 + dvq * 32 + jx) = pk2(op[0], op[1]); }
    }
    __syncthreads();
}
__device__ __forceinline__ void phase_l3(const Ctx& C, int l) {
    build_twiddles(C, (LAS f32x2*)C.lds);
    __syncthreads();
    for (int item = C.bid; item < 256; item += C.G) hyena_lat(C, l, item);
    if (l < DEPTH - 1) for (int c = C.bid; c < 512; c += C.G) hyena_ctx(C, l, c);
    __syncthreads();
    for (int item = C.bid; item < 256; item += C.G) hgrn_scan(C, item);
}
__device__ __forceinline__ void phase_l3b(const Ctx& C, int l) {
    const int gw = C.bid * NWAVES + C.wave, NGW = C.G * NWAVES;
    const bf16_t* od0 = WSP(const bf16_t, WS_ODIR); const bf16_t* od1 = od0 + (size_t)NTOK * 512;
    const bf16_t* phg = WSP(const bf16_t, WS_PHG); bf16_t* Y = WSP(bf16_t, WS_R1);
    const float* nw = C.in[IN_NORMW] + l * 128;
    const int nrows = (l < DEPTH - 1) ? NTOK : NLAT;
    for (int row = gw; row < nrows; row += NGW) {
        const int idx = C.lane * 8;
        const u32x4 a = *(const u32x4*)(od0 + (size_t)row * 512 + idx), b = *(const u32x4*)(od1 + (size_t)row * 512 + idx), g = *(const u32x4*)(phg + (size_t)row * NHG + 1024 + idx);
        float o[8] = {bflo(a.x) + bflo(b.x), bfhi(a.x) + bfhi(b.x), bflo(a.y) + bflo(b.y), bfhi(a.y) + bfhi(b.y), bflo(a.z) + bflo(b.z), bfhi(a.z) + bfhi(b.z), bflo(a.w) + bflo(b.w), bfhi(a.w) + bfhi(b.w)};
        const float gg[8] = {bflo(g.x), bfhi(g.x), bflo(g.y), bfhi(g.y), bflo(g.z), bfhi(g.z), bflo(g.w), bfhi(g.w)};
        float ss = 0.f;
#pragma unroll
        for (int i = 0; i < 8; ++i) ss += o[i] * o[i];
        ss = row16_sum(ss);
        const float rinv = 1.0f / sqrtf(ss * (1.0f / 128.0f) + EPS);
        float y[8];
#pragma unroll
        for (int i = 0; i < 8; ++i) y[i] = o[i] * rinv * nw[(idx + i) & 127] * siluf_(gg[i]);
        u32x4 w; w.x = pk2(y[0], y[1]); w.y = pk2(y[2], y[3]); w.z = pk2(y[4], y[5]); w.w = pk2(y[6], y[7]);
        *(u32x4*)(Y + (size_t)row * D + 512 + idx) = w;
    }
}

__device__ __forceinline__ void phase_l5a(const Ctx& C, int l) {
    LAS float* rwT = (LAS float*)C.lds;
    const float* rw = C.in[IN_RW];
    for (int i = C.tid; i < 16 * 1024; i += NTHR) { const int k = i >> 4, e = i & 15; rwT[e * 1024 + k] = rw[i]; }
    __syncthreads();
    const int gw = C.bid * NWAVES + C.wave, NGW = C.G * NWAVES;
    const float* mods = WSP(const float, WS_MODS) + (size_t)l * 9 * 6144;
    const float* xb = WSP(const float, WS_XBUF);
    const float* rbias = C.in[IN_RB];
    unsigned* cnt = WSP(unsigned, WS_CTL) + CW_CNT + l * 64;
    int* tokinfo = WSP(int, WS_TOKINFO);
    const int nrows = (l < DEPTH - 1) ? NTOK : NLAT;
    for (int row = gw; row < nrows; row += NGW) {
        const float* src = xb + (size_t)row * D; const float* md = mods + bidx(row) * 6144;
        f32x4 v[4]; float ss = 0.f;
#pragma unroll
        for (int j = 0; j < 4; ++j) { v[j] = *(const f32x4*)(src + C.lane * 4 + 256 * j); ss += (v[j].x * v[j].x + v[j].y * v[j].y) + (v[j].z * v[j].z + v[j].w * v[j].w); }
        ss = wave_sum(ss); const float rinv = 1.0f / sqrtf(ss * (1.0f / D) + EPS);
        float lg[16];
#pragma unroll
        for (int e = 0; e < 16; ++e) lg[e] = 0.f;
#pragma unroll
        for (int j = 0; j < 4; ++j) { const int k = C.lane * 4 + 256 * j; const f32x4 sh = *(const f32x4*)(md + 3072 + k), sc = *(const f32x4*)(md + 4096 + k);
            const f32x4 hh = v[j] * rinv * (sc + 1.0f) + sh;
#pragma unroll
            for (int e = 0; e < 16; ++e) { const f32x4 w = *(const LAS f32x4*)(rwT + e * 1024 + k); lg[e] += hh.x * w.x + hh.y * w.y + hh.z * w.z + hh.w * w.w; } }
#pragma unroll
        for (int e = 0; e < 16; ++e) lg[e] = wave_sum(lg[e]);
        float mx = lg[0];
#pragma unroll
        for (int e = 1; e < 16; ++e) mx = fmaxf(mx, lg[e]);
        float sc[16], se = 0.f;
#pragma unroll
        for (int e = 0; e < 16; ++e) { sc[e] = expf(lg[e] - mx); se += sc[e]; }
        float sel[16];
#pragma unroll
        for (int e = 0; e < 16; ++e) { sc[e] = sc[e] / se; sel[e] = sc[e] + rbias[e]; }
        float bestgs = -3.4e38f; int bg = 0; float bs[4], bsc[4];
#pragma unroll
        for (int g = 0; g < 4; ++g) {
            float m1 = -3.4e38f, m2 = -3.4e38f;
#pragma unroll
            for (int i = 0; i < 4; ++i) { const float x = sel[4 * g + i]; if (x > m1) { m2 = m1; m1 = x; } else if (x > m2) m2 = x; }
            const float gs = m1 + m2;
            if (gs > bestgs) { bestgs = gs; bg = g;
#pragma unroll
                for (int i = 0; i < 4; ++i) { bs[i] = sel[4 * g + i]; bsc[i] = sc[4 * g + i]; } }
        }
        int i0 = 0; float b0 = bs[0];
#pragma unroll
        for (int i = 1; i < 4; ++i) if (bs[i] > b0) { b0 = bs[i]; i0 = i; }
        int i1 = -1; float b1 = -3.4e38f;
#pragma unroll
        for (int i = 0; i < 4; ++i) if (i != i0 && bs[i] > b1) { b1 = bs[i]; i1 = i; }
        float w0 = 0.f, w1 = 0.f;
#pragma unroll
        for (int i = 0; i < 4; ++i) { if (i == i0) w0 = bsc[i]; if (i == i1) w1 = bsc[i]; }
        const float wn = w0 + w1; w0 /= wn; w1 /= wn;
        const int lo = i0 < i1 ? i0 : i1, hi = i0 < i1 ? i1 : i0;
        const float wlo = i0 < i1 ? w0 : w1, whi = i0 < i1 ? w1 : w0;
        const int bin = bg * 6 + (lo * (7 - lo)) / 2 + (hi - lo - 1);
        if (C.lane == 0) { const unsigned slot = atomicAdd(cnt + bin, 1u);
            *(int4*)(tokinfo + (size_t)row * 4) = make_int4(bin, (int)slot, __float_as_int(wlo), __float_as_int(whi)); }
    }
}
__device__ __forceinline__ void phase_l5b(const Ctx& C, int l) {
    build_tiletab(C, l);
    const volatile LAS int* lc = (const volatile LAS int*)(C.lds + LDSCTL_OFF);
    const int gw = C.bid * NWAVES + C.wave, NGW = C.G * NWAVES;
    const float* mods = WSP(const float, WS_MODS) + (size_t)l * 9 * 6144;
    const float* xb = WSP(const float, WS_XBUF);
    const int* tokinfo = WSP(const int, WS_TOKINFO);
    bf16_t* hs = WSP(bf16_t, WS_PHG); int* rowtok = WSP(int, WS_ROWTOK); float* roww = WSP(float, WS_ROWW);
    const int nrows = (l < DEPTH - 1) ? NTOK : NLAT;
    for (int row = gw; row < nrows; row += NGW) {
        const int4 ti = *(const int4*)(tokinfo + (size_t)row * 4);
        const int pos = lc[LC_OFFS + ti.x] + ti.y;
        const float* src = xb + (size_t)row * D; const float* md = mods + bidx(row) * 6144;
        f32x4 v[4]; float ss = 0.f;
#pragma unroll
        for (int j = 0; j < 4; ++j) { v[j] = *(const f32x4*)(src + C.lane * 4 + 256 * j); ss += (v[j].x * v[j].x + v[j].y * v[j].y) + (v[j].z * v[j].z + v[j].w * v[j].w); }
        ss = wave_sum(ss); const float rinv = 1.0f / sqrtf(ss * (1.0f / D) + EPS);
#pragma unroll
        for (int j = 0; j < 4; ++j) { const int k = C.lane * 4 + 256 * j; const f32x4 sh = *(const f32x4*)(md + 3072 + k), sc = *(const f32x4*)(md + 4096 + k);
            const f32x4 o = v[j] * rinv * (sc + 1.0f) + sh; u32x2 w; w.x = pk2(o.x, o.y); w.y = pk2(o.z, o.w);
            *(u32x2*)(hs + (size_t)pos * D + k) = w; }
        if (C.lane == 0) { rowtok[pos] = row; roww[pos * 2] = __int_as_float(ti.z); roww[pos * 2 + 1] = __int_as_float(ti.w); }
    }
    if (C.bid < NBIN) { const int b = C.bid; const int start = lc[LC_OFFS + b], end = lc[LC_OFFS + b + 1];
        const int n = (int)__hip_atomic_load(WSP(unsigned, WS_CTL) + CW_CNT + l * 64 + b, __ATOMIC_RELAXED, __HIP_MEMORY_SCOPE_AGENT);
        for (int p = start + n + C.tid; p < end; p += NTHR) { rowtok[p] = -1; roww[p * 2] = 0.f; roww[p * 2 + 1] = 0.f; } }
}

__device__ __forceinline__ void phase_final(const Ctx& C) {
    const int gw = C.bid * NWAVES + C.wave, NGW = C.G * NWAVES;
    const float* xb = WSP(const float, WS_XBUF); const float* fw = C.in[IN_FNW];
    for (int row = gw; row < NLAT; row += NGW) {
        const float* src = xb + (size_t)row * D;
        f32x4 v[4]; float ss = 0.f;
#pragma unroll
        for (int j = 0; j < 4; ++j) { v[j] = *(const f32x4*)(src + C.lane * 4 + 256 * j); ss += (v[j].x * v[j].x + v[j].y * v[j].y) + (v[j].z * v[j].z + v[j].w * v[j].w); }
        ss = wave_sum(ss); const float rinv = 1.0f / sqrtf(ss * (1.0f / D) + EPS);
#pragma unroll
        for (int j = 0; j < 4; ++j) { const int k = C.lane * 4 + 256 * j; const f32x4 w = *(const f32x4*)(fw + k);
            *(f32x4*)(C.out + (size_t)row * D + k) = v[j] * rinv * w; }
    }
}

constexpr int PH_PER_LAYER = 9, N_PHASES = 1 + DEPTH * PH_PER_LAYER + 1;
__global__ void __launch_bounds__(NTHR, 2) trunk_fwd(Args args) {
    extern __shared__ __attribute__((aligned(16))) unsigned char lds[];
    Ctx C; C.in = (const CAS fptr_t*)__builtin_amdgcn_kernarg_segment_ptr(); C.out = args.out; C.ws = args.ws; C.lds = (LAS unsigned char*)lds;
    C.tid = threadIdx.x; C.lane = C.tid & 63; C.wave = __builtin_amdgcn_readfirstlane(C.tid >> 6); C.G = gridDim.x; C.bid = blockIdx.x;
    LAS unsigned char* ldsl0 = (LAS unsigned char*)lds;
    if (C.tid < 64) ((LAS unsigned*)(ldsl0 + LDSCTL_OFF))[C.tid] = 0u;
    __syncthreads();
    const int lo = args.ph_lo, hi = args.ph_hi;
    XcdBarrier bar; bar.bar = WSP(unsigned, WS_CTL) + CW_BAR; bar.x = 0; bar.st = (volatile LAS unsigned*)(ldsl0 + LDSCTL_OFF + LC_BAR);
    if (hi - lo > 1) bar = xcd_barrier_post(WSP(unsigned, WS_CTL) + CW_BAR, (volatile LAS unsigned*)(ldsl0 + LDSCTL_OFF + LC_BAR));
#define IN(k) (lo <= (k) && (k) < hi)
#define SEAM(k) do { if (IN(k) && IN((k) + 1)) xcd_barrier(bar); } while (0)
#ifndef EN
#define EN 0xFFFF
#endif
    if ((EN & 1) && IN(0)) { phase0(C); SEAM(0); }
    const Ctx C0 = C;
#pragma unroll 1
    for (int l = 0; l < DEPTH; ++l) {
        const int p0 = 1 + l * PH_PER_LAYER;
        Ctx C = C0; { int t_ = C0.tid; asm volatile("" : "+v"(t_)); C.tid = t_; C.lane = t_ & 63; C.wave = __builtin_amdgcn_readfirstlane(t_ >> 6);
                      int b_ = C0.bid; asm volatile("" : "+s"(b_)); C.bid = b_; int g_ = C0.G; asm volatile("" : "+s"(g_)); C.G = g_; unsigned char* w_ = C0.ws; asm volatile("" : "+s"(w_)); C.ws = w_;
                      const CAS fptr_t* i_ = C0.in; asm volatile("" : "+s"(i_)); C.in = i_;
                      LAS unsigned char* l_ = C0.lds; asm volatile("" : "+s"(l_)); C.lds = l_; }
        LAS unsigned char* const ldsl = C.lds;
        const float* modl = WSP(const float, WS_MODS) + (size_t)l * 9 * 6144;
        if ((EN & 2) && IN(p0 + 0)) { phase_l1(C, l); SEAM(p0 + 0); }
        if ((EN & 4) && IN(p0 + 1)) {
            { pg8::SchedDense S; S.init(NTOK / 256, NHG / 256, C.G, C.bid, D, D);
              EpiHG E{WSP(bf16_t, WS_PHG), WSP(const float, WS_LOWER) + l * 512};
              pg8::gemm_phase<false>(ldsl, S, E, (const char*)WSP(bf16_t, WS_R1), (const char*)(WSP(bf16_t, WS_WIN) + (size_t)NHY * D), D, D, 128u * D * 2u, 128u * D * 2u, D / 64); }
            { pg8::SchedDense S; S.init(NHY / 256, NTOK / 256, C.G, C.bid, D, D);
              EpiHY E{WSP(bf16_t, WS_PHYT)};
              pg8::gemm_phase<false>(ldsl, S, E, (const char*)WSP(bf16_t, WS_WIN), (const char*)WSP(bf16_t, WS_R1), D, D, 128u * D * 2u, 128u * D * 2u, D / 64); }
            SEAM(p0 + 1);
        }
        if ((EN & 8) && IN(p0 + 2)) { phase_l3(C, l); SEAM(p0 + 2); }
        if ((EN & 16) && IN(p0 + 3)) { phase_l3b(C, l); SEAM(p0 + 3); }
        if ((EN & 32) && IN(p0 + 4)) {
            pg8::SchedDense S; S.init(NTOK / 256, D / 256, C.G, C.bid, D, D);
            EpiOut E{C.in[IN_X], C.in[IN_CTX], WSP(float, WS_XBUF), modl, l == 0 ? 1 : 0};
            pg8::gemm_phase<false>(ldsl, S, E, (const char*)WSP(bf16_t, WS_R1), (const char*)WSP(bf16_t, WS_WOUT), D, D, 128u * D * 2u, 128u * D * 2u, D / 64);
            SEAM(p0 + 4);
        }
        if ((EN & 64) && IN(p0 + 5)) { phase_l5a(C, l); SEAM(p0 + 5); }
        if ((EN & 128) && IN(p0 + 6)) { phase_l5b(C, l); SEAM(p0 + 6); }
        if ((EN & 256) && IN(p0 + 7)) {
            build_tiletab(C, l);
            const volatile LAS int* lc = (const volatile LAS int*)(ldsl + LDSCTL_OFF);
            SchedUp S{lc[LC_T], C.G, C.bid, lc + LC_TILEBIN};
            EpiAct E{WSP(bf16_t, WS_R1), WSP(const float, WS_ROWW)};
            pg8::gemm_phase<false>(ldsl, S, E, (const char*)WSP(bf16_t, WS_PHG), (const char*)WSP(bf16_t, WS_WG), D, D, 128u * D * 2u, (unsigned)(WS_WU - WS_WG), D / 64);
            SEAM(p0 + 7);
        }
        if ((EN & 512) && IN(p0 + 8)) {
            build_tiletab(C, l);
            const volatile LAS int* lc = (const volatile LAS int*)(ldsl + LDSCTL_OFF);
            SchedDown S{lc[LC_T], C.G, C.bid, lc + LC_TILEBIN};
            EpiDown E{WSP(float, WS_XBUF), WSP(const int, WS_ROWTOK), modl};
            pg8::gemm_phase<true>(ldsl, S, E, (const char*)WSP(bf16_t, WS_R1), (const char*)WSP(bf16_t, WS_WD), 512, 256, 128u * 512u * 2u, 128u * 256u * 2u, 4);
            SEAM(p0 + 8);
        }
    }
    if ((EN & 1024) && IN(N_PHASES - 1)) phase_final(C);
#undef IN
#undef SEAM
}

extern "C" void kernel_launch(void* const* d_in, const int* in_sizes, int n_in, void* d_out, int out_size, void* d_ws, size_t ws_size, hipStream_t stream) {
    static int grid = 0;
    if (grid == 0) {
        if (n_in != N_IN || in_sizes[0] != NLAT * D || out_size != NLAT * D || ws_size < WS_END) { fprintf(stderr, "kernel_launch: unexpected shapes / workspace (%d inputs, ws %zu < %zu)\n", n_in, ws_size, (size_t)WS_END); grid = -1; return; }
        int dev = 0, cus = 0, per_cu = 0;
        if (hipGetDevice(&dev) != hipSuccess || hipDeviceGetAttribute(&cus, hipDeviceAttributeMultiprocessorCount, dev) != hipSuccess) { grid = -1; return; }
        if (hipFuncSetAttribute((const void*)trunk_fwd, hipFuncAttributeMaxDynamicSharedMemorySize, LDS_BYTES) != hipSuccess) { fprintf(stderr, "kernel_launch: hipFuncSetAttribute failed\n"); grid = -1; return; }
        if (hipOccupancyMaxActiveBlocksPerMultiprocessor(&per_cu, (const void*)trunk_fwd, NTHR, LDS_BYTES) != hipSuccess || per_cu < 1) { fprintf(stderr, "kernel_launch: occupancy query says %d\n", per_cu); }
        (void)hipGetLastError();
        grid = cus;
    }
    if (grid < 0) return;
    (void)hipMemsetAsync((char*)d_ws + WS_CTL, 0, CTL_ZERO_BYTES, stream);
    Args a{};
    for (int i = 0; i < N_IN; ++i) a.in[i] = (const float*)d_in[i];
    a.out = (float*)d_out; a.ws = (unsigned char*)d_ws;
#if MK_PER_PHASE
    for (int p = 0; p < N_PHASES; ++p) { a.ph_lo = p; a.ph_hi = p + 1; hipLaunchKernelGGL(trunk_fwd, dim3(grid), dim3(NTHR), LDS_BYTES, stream, a); }
#else
    a.ph_lo = 0; a.ph_hi = N_PHASES;
    hipLaunchKernelGGL(trunk_fwd, dim3(grid), dim3(NTHR), LDS_BYTES, stream, a);
#endif
}
```

```cpp
#include <hip/hip_runtime.h>
#include <cstdio>
#include <cstdint>

#ifndef MK_PER_PHASE
#define MK_PER_PHASE 0
#endif

#define LAS __attribute__((address_space(3)))
typedef unsigned short bf16_t;
typedef short bf16x8 __attribute__((ext_vector_type(8)));
typedef float f32x4 __attribute__((ext_vector_type(4)));
typedef float f32x2 __attribute__((ext_vector_type(2)));
typedef unsigned u32x4 __attribute__((ext_vector_type(4)));
typedef unsigned u32x2 __attribute__((ext_vector_type(2)));

constexpr int NB = 8, SEQ = 2048, D = 1024, DEPTH = 4, CTXL = 256;
constexpr int NLAT = NB * SEQ, NCTX = NB * CTXL, NTOK = NLAT + NCTX;
constexpr int DH = 512, NHY = 1536, NHG = 2560, DIN = 4096;
constexpr int NE = 16, DE = 256, NBIN = 24, SROWS = 24576;
constexpr float EPS = 1e-6f;
constexpr int NTHR = 512, NWAVES = 8;
enum { IN_X = 0, IN_C, IN_CTX, IN_CCTX, IN_WMOD, IN_BMOD, IN_WIN, IN_WOUT, IN_CONVW, IN_CONVB, IN_W1, IN_B1, IN_W2, IN_B2, IN_W3, IN_B3,
       IN_HYBIAS, IN_LB, IN_NORMW, IN_RW, IN_RB, IN_WG, IN_WU, IN_WD, IN_FNW, N_IN };

constexpr size_t MiB = 1u << 20;
constexpr size_t WS_CTL = 0, CTL_ZERO_BYTES = 1 * MiB;
constexpr size_t WS_MODS = 1 * MiB;
constexpr size_t WS_LOWER = 2 * MiB;
constexpr size_t WS_H2L = 3 * MiB;
constexpr size_t WS_H2C = 5 * MiB;
constexpr size_t WS_TOKINFO = 6 * MiB;
constexpr size_t WS_ROWTOK = 6 * MiB + 512 * 1024;
constexpr size_t WS_ROWW = 7 * MiB;
constexpr size_t WS_WIN = 8 * MiB;
constexpr size_t WS_WOUT = 16 * MiB;
constexpr size_t WS_WG = 18 * MiB;
constexpr size_t WS_WU = 26 * MiB;
constexpr size_t WS_WD = 34 * MiB;
constexpr size_t WS_KSPEC = 42 * MiB;
constexpr size_t WS_XBUF = 74 * MiB;
constexpr size_t WS_R1 = 146 * MiB;
constexpr size_t WS_PHG = 182 * MiB;
constexpr size_t WS_PHYT = 272 * MiB;
constexpr size_t WS_ODIR = 326 * MiB;
constexpr size_t WS_END = 362 * MiB;
constexpr int CW_BAR = 4096;
constexpr int CW_CNT = 16384;

constexpr int LDS_BYTES = 147456;
constexpr int LDSCTL_OFF = 143 * 1024;
constexpr int LC_BAR = 0;
constexpr int LC_T = 8;
constexpr int LC_OFFS = 16;
constexpr int LC_TILEBIN = 48;

__device__ __forceinline__ unsigned f2bf(float f) { unsigned u = __builtin_bit_cast(unsigned, f); return (u + 0x7fffu + ((u >> 16) & 1u)) >> 16; }
__device__ __forceinline__ unsigned pk2(float lo, float hi) { return f2bf(lo) | (f2bf(hi) << 16); }
__device__ __forceinline__ float bf2f(unsigned b) { return __builtin_bit_cast(float, (b & 0xffffu) << 16); }
__device__ __forceinline__ float bflo(unsigned w) { return __builtin_bit_cast(float, w << 16); }
__device__ __forceinline__ float bfhi(unsigned w) { return __builtin_bit_cast(float, w & 0xffff0000u); }
__device__ __forceinline__ float sigmoidf_(float x) { return 1.0f / (1.0f + __expf(-x)); }
__device__ __forceinline__ float siluf_(float x) { return x / (1.0f + __expf(-x)); }
#define DPP_ADD(v, ctrl, rmask) v += __builtin_bit_cast(float, __builtin_amdgcn_update_dpp(0, __builtin_bit_cast(int, v), ctrl, rmask, 0xF, false))
__device__ __forceinline__ float row16_sum(float v) {
    DPP_ADD(v, 0xB1, 0xF);
    DPP_ADD(v, 0x4E, 0xF);
    DPP_ADD(v, 0x141, 0xF);
    DPP_ADD(v, 0x140, 0xF);
    return v;
}
__device__ __forceinline__ float wave_sum(float v) {
    v = row16_sum(v);
    DPP_ADD(v, 0x142, 0xA);
    DPP_ADD(v, 0x143, 0xC);
    return __builtin_bit_cast(float, __builtin_amdgcn_readlane(__builtin_bit_cast(int, v), 63));
}
__device__ __forceinline__ int bidx(int row) { return row < NLAT ? (row >> 11) : 8; }
#define LDS_WAIT() asm volatile("s_waitcnt lgkmcnt(0)" ::: "memory")

#define XB_TMO      128
#define XB_XCNT(j)  (256  + 64 * (j))
#define XB_XSUB(j)  (1280 + 64 * (j))
#define XB_XGEN(j)  (2304 + 64 * (j))
#define XB_TOP      3328
#define XB_TOPGEN   3392
#define XCD_BAR_WORDS 3456
#define XB_SPIN_CAP (1u << 18)
__device__ __forceinline__ unsigned xb_ld(unsigned* p)              { return __hip_atomic_load(p, __ATOMIC_RELAXED, __HIP_MEMORY_SCOPE_AGENT); }
__device__ __forceinline__ unsigned xb_add(unsigned* p, unsigned v) { return __hip_atomic_fetch_add(p, v, __ATOMIC_RELAXED, __HIP_MEMORY_SCOPE_AGENT); }
__device__ __forceinline__ unsigned xb_xcc_id() { return (unsigned)__builtin_amdgcn_s_getreg((3 << 11) | 20) & 0xFu; }
#define XB_SPIN(cond, bar) do { unsigned _sp = 0; while (cond) { __builtin_amdgcn_s_sleep(1); \
    if ((++_sp & 255u) == 0u) { if (xb_ld(&(bar)[XB_TMO])) break; if (_sp > XB_SPIN_CAP) { atomicAdd(&(bar)[XB_TMO], 1u); break; } } } } while (0)
struct XcdBarrier { unsigned* bar; unsigned x; volatile LAS unsigned* st; };
__device__ __forceinline__ XcdBarrier xcd_barrier_post(unsigned* bar, volatile LAS unsigned* st) {
    XcdBarrier b; b.bar = bar; b.x = xb_xcc_id(); b.st = st;
    if (threadIdx.x == 0) (void)xb_add(&bar[XB_XCNT(b.x)], 1u);
    return b;
}
__device__ __forceinline__ void xcd_barrier_complete(unsigned* bar, unsigned x, unsigned& nloc, unsigned& nx) {
    const unsigned G = gridDim.x * gridDim.y * gridDim.z;
    unsigned sum, cnt, mine, sp = 0u;
    for (;;) {
        sum = 0u; cnt = 0u; mine = 0u;
#pragma unroll
        for (unsigned j = 0; j < 16; ++j) { const unsigned c = xb_ld(&bar[XB_XCNT(j)]); sum += c; cnt += (c > 0u) ? 1u : 0u; mine = (j == x) ? c : mine; }
        if (sum == G) break;
        __builtin_amdgcn_s_sleep(1);
        if ((++sp & 255u) == 0u) { if (xb_ld(&bar[XB_TMO])) break; if (sp > XB_SPIN_CAP) { atomicAdd(&bar[XB_TMO], 1u); break; } }
    }
    nloc = mine > 0u ? mine : 1u; nx = cnt > 0u ? cnt : 1u;
}
__device__ __forceinline__ void xcd_barrier(const XcdBarrier& b) {
    asm volatile("s_waitcnt vmcnt(0)" ::: "memory");
    __syncthreads();
    if (threadIdx.x == 0) {
        unsigned* bar = b.bar; unsigned bx = b.x;
        asm volatile("" : "+s"(bar), "+s"(bx));
        __builtin_amdgcn_s_waitcnt(0);
        unsigned nloc = b.st[0], nx = b.st[1];
        if (nloc == 0u) { xcd_barrier_complete(bar, bx, nloc, nx); b.st[0] = nloc; b.st[1] = nx; }
        const unsigned old = xb_add(&bar[XB_XSUB(bx)], 1u);
        const unsigned gen = old / nloc;
        if (old + 1u == (gen + 1u) * nloc) {
            __builtin_amdgcn_fence(__ATOMIC_RELEASE, "agent");
            asm volatile("s_waitcnt vmcnt(0)" ::: "memory");
            const unsigned og = xb_add(&bar[XB_TOP], 1u);
            const unsigned tg = og / nx;
            if (og + 1u == (tg + 1u) * nx) xb_add(&bar[XB_TOPGEN], 1u);
            else XB_SPIN(xb_ld(&bar[XB_TOPGEN]) == tg, bar);
            __builtin_amdgcn_fence(__ATOMIC_ACQUIRE, "agent");
            xb_add(&bar[XB_XGEN(bx)], 1u);
            asm volatile("s_waitcnt vmcnt(0)" ::: "memory");
        } else {
            XB_SPIN(xb_ld(&bar[XB_XGEN(bx)]) == gen, bar);
            __builtin_amdgcn_fence(__ATOMIC_ACQUIRE, "agent");
            asm volatile("s_waitcnt vmcnt(0)" ::: "memory");
        }
    }
    __syncthreads();
}

namespace pg8 {
constexpr int BM = 256, BK = 64, HALF = 128, HTB = HALF * BK * 2, STAGE_BYTES = 8 * HTB, NXCD = 8, WGM = 8;
__host__ __device__ __forceinline__ int lds_byte(int r, int c) { const int st = (r >> 4) * 2 + (c >> 5), rr = r & 15, cc = c & 31, ob = rr * 64 + cc * 2; return st * 1024 + (ob ^ (((ob >> 9) & 1) << 5)); }
__host__ __device__ __forceinline__ void stage_rc(int b, int& R, int& C) { const int st = b / 1024, sb = b % 1024, swz = sb ^ (((sb >> 9) & 1) << 5); R = (st >> 1) * 16 + swz / 64; C = (st & 1) * 32 + (swz % 64) / 2; }
__host__ __device__ __forceinline__ int perm32(int rho) { const int n = rho >> 4, i = rho & 15; return 8 * (i >> 2) + 4 * n + (i & 3); }

struct GUnit { unsigned a, b; int last, i0, i1; };

template <bool SUB, class Epi, class Sched>
__device__ __forceinline__ void gemm_phase(LAS unsigned char* lds, const Sched& S, const Epi& E, const char* Abase, const char* Bbase, const int lda, const int ldb, const unsigned ahalf, const unsigned bhalf, const int nt) {
    int tid_ = threadIdx.x; asm volatile("" : "+v"(tid_));
    const int tid = tid_, wid = __builtin_amdgcn_readfirstlane(tid >> 6), lane = tid & 63, wr = wid >> 2, wc = wid & 3, fr = lane & 15, fq = lane >> 4;
    unsigned voffA[2], voffB[2];
#pragma unroll
    for (int i = 0; i < 2; ++i) { int R, C; stage_rc(tid * 16 + i * 8192, R, C); const int Rb = Epi::PERM ? ((R & ~31) + perm32(R & 31)) : R;
        voffA[i] = (unsigned)(R * lda + C) * 2u; voffB[i] = (unsigned)(Rb * ldb + C) * 2u; }
    constexpr unsigned kstep = BK * 2;
    const unsigned ldsw = (unsigned)wid * 1024u;
    const int aoff = lds_byte(wr * 64 + fr, fq * 8), boff = lds_byte(wc * 32 + fr, fq * 8);
#define PG8_SA(b, h) (((b) * 2 + (h)) * HTB)
#define PG8_SB(b, h) ((4 + (b) * 2 + (h)) * HTB)
#define PG8_STAGE(bufoff, gbase, voff) do { _Pragma("unroll") for (int _i = 0; _i < 2; ++_i) \
        __builtin_amdgcn_global_load_lds((const unsigned*)((const char*)(gbase) + (voff)[_i]), (LAS unsigned*)(lds + (bufoff) + ldsw + _i * 8192), 16, 0, 0); } while (0)
#define PG8_LDA(dst, b, h) do { _Pragma("unroll") for (int m = 0; m < 4; ++m) _Pragma("unroll") for (int k = 0; k < 2; ++k) dst[m][k] = *(const LAS bf16x8*)(lds + PG8_SA(b, h) + aoff + m * 2048 + k * 1024); } while (0)
#define PG8_LDB(dst, b, h) do { _Pragma("unroll") for (int n = 0; n < 2; ++n) _Pragma("unroll") for (int k = 0; k < 2; ++k) dst[n][k] = *(const LAS bf16x8*)(lds + PG8_SB(b, h) + boff + n * 2048 + k * 1024); } while (0)
#define PG8_MMA(ai, bj, At, Bt) do { __builtin_amdgcn_s_setprio(1); _Pragma("unroll") for (int m = 0; m < 4; ++m) _Pragma("unroll") for (int n = 0; n < 2; ++n) _Pragma("unroll") for (int k = 0; k < 2; ++k) \
        acc[ai][bj][m][n] = __builtin_amdgcn_mfma_f32_16x16x32_bf16(Bt[n][k], At[m][k], acc[ai][bj][m][n], 0, 0, 0); __builtin_amdgcn_s_setprio(0); } while (0)
#define PG8_WAIT_V(n) asm volatile("s_waitcnt vmcnt(" #n ")" ::: "memory")
#define PG8_WAIT_L(n) asm volatile("s_waitcnt lgkmcnt(" #n ")" ::: "memory")
#define PG8_BAR __builtin_amdgcn_s_barrier()
#define PG8_SCHED __builtin_amdgcn_sched_barrier(0)
    GUnit cur, nxt; int ui = 0;
    if (!S.next(0, cur)) return;
    f32x4 acc[2][2][4][2];
#pragma unroll
    for (int a = 0; a < 2; ++a)
#pragma unroll
        for (int b = 0; b < 2; ++b)
#pragma unroll
            for (int m = 0; m < 4; ++m)
#pragma unroll
                for (int n = 0; n < 2; ++n) acc[a][b][m][n] = (f32x4){0.f, 0.f, 0.f, 0.f};
    bf16x8 At[4][2], B0[2][2], B1[2][2];
    { const char* cA = Abase + cur.a; const char* cB = Bbase + cur.b;
      PG8_STAGE(PG8_SB(0, 0), cB, voffB); PG8_STAGE(PG8_SB(0, 1), cB + bhalf, voffB); PG8_STAGE(PG8_SA(0, 0), cA, voffA); PG8_STAGE(PG8_SA(0, 1), cA + ahalf, voffA);
      if (wr == 1) PG8_BAR;
      PG8_WAIT_V(2); PG8_BAR;
      PG8_STAGE(PG8_SB(1, 0), cB + kstep, voffB); PG8_STAGE(PG8_SA(1, 0), cA + kstep, voffA); PG8_STAGE(PG8_SB(1, 1), cB + bhalf + kstep, voffB);
      PG8_WAIT_V(6); PG8_BAR; }
    for (;;) {
        const bool has_next = S.next(ui + 1, nxt);
        const char* cA = Abase + cur.a; const char* cB = Bbase + cur.b;
        const char* nA = Abase + (has_next ? nxt.a : cur.a); const char* nB = Bbase + (has_next ? nxt.b : cur.b);
        for (int t = 0; t < nt; t += 2) {
            const bool last = (t == nt - 2);
            const char* a1 = cA + (unsigned)(t + 1) * kstep;
            const char* a2 = last ? nA : cA + (unsigned)(t + 2) * kstep; const char* b2 = last ? nB : cB + (unsigned)(t + 2) * kstep;
            const char* a3 = a2 + kstep; const char* b3 = b2 + kstep;
            PG8_LDB(B0, 0, 0); PG8_LDB(B1, 0, 1); PG8_SCHED; PG8_LDA(At, 0, 0); PG8_STAGE(PG8_SA(1, 1), a1 + ahalf, voffA);
            PG8_WAIT_V(8); PG8_WAIT_L(0); PG8_BAR; PG8_MMA(0, 0, At, B0); PG8_MMA(0, 1, At, B1); PG8_BAR; PG8_SCHED;
            PG8_LDA(At, 0, 1); PG8_STAGE(PG8_SB(0, 0), b2, voffB); PG8_STAGE(PG8_SB(0, 1), b2 + bhalf, voffB); PG8_STAGE(PG8_SA(0, 0), a2, voffA);
            PG8_WAIT_V(8); PG8_WAIT_L(0); PG8_BAR; PG8_MMA(1, 0, At, B0); PG8_MMA(1, 1, At, B1); PG8_BAR; PG8_SCHED;
            PG8_LDB(B0, 1, 0); PG8_LDB(B1, 1, 1); PG8_SCHED; PG8_LDA(At, 1, 0); PG8_STAGE(PG8_SA(0, 1), a2 + ahalf, voffA);
            PG8_WAIT_V(8); PG8_WAIT_L(0); PG8_BAR; PG8_MMA(0, 0, At, B0); PG8_MMA(0, 1, At, B1); PG8_BAR; PG8_SCHED;
            PG8_LDA(At, 1, 1); PG8_STAGE(PG8_SB(1, 0), b3, voffB); PG8_STAGE(PG8_SB(1, 1), b3 + bhalf, voffB); PG8_STAGE(PG8_SA(1, 0), a3, voffA);
            PG8_WAIT_V(8); PG8_WAIT_L(0); PG8_BAR; PG8_MMA(1, 0, At, B0); PG8_MMA(1, 1, At, B1); PG8_BAR; PG8_SCHED;
        }
        const bool fin = SUB ? (cur.last != 0) : true;
        if (fin) { if (wr == 0) PG8_BAR; E(acc, cur, wr, wc, fr, fq); }
        if (!has_next) break;
        if (fin) {
#pragma unroll
            for (int a = 0; a < 2; ++a)
#pragma unroll
                for (int b = 0; b < 2; ++b)
#pragma unroll
                    for (int m = 0; m < 4; ++m)
#pragma unroll
                        for (int n = 0; n < 2; ++n) acc[a][b][m][n] = (f32x4){0.f, 0.f, 0.f, 0.f};
        }
        cur = nxt; ++ui;
        if (fin) { if (wr == 1) PG8_BAR; }
    }
    PG8_WAIT_V(0);
    PG8_BAR;
#undef PG8_SA
#undef PG8_SB
#undef PG8_STAGE
#undef PG8_LDA
#undef PG8_LDB
#undef PG8_MMA
#undef PG8_WAIT_V
#undef PG8_WAIT_L
#undef PG8_BAR
#undef PG8_SCHED
}

struct SchedDense {
    int nM, nN, nwg, G, c; unsigned atile, btile;
    __device__ __forceinline__ void init(int nM_, int nN_, int G_, int c_, int lda, int ldb) {
        nM = nM_; nN = nN_; nwg = nM * nN; G = G_; c = c_; atile = 256u * lda * 2u; btile = 256u * ldb * 2u; }
    __device__ __forceinline__ bool next(int i, GUnit& u) const {
        const int L = i * G + c; if (L >= nwg) return false;
        int wgid = L; { const int q = nwg / NXCD, r = nwg % NXCD, xcd = wgid % NXCD, off = wgid / NXCD; wgid = (xcd < r ? xcd * (q + 1) : r * (q + 1) + (xcd - r) * q) + off; }
        const int nig = WGM * nN, gid = wgid / nig, fm = gid * WGM, gsz = (nM - fm) < WGM ? (nM - fm) : WGM;
        const int pm = fm + ((wgid % nig) % gsz), pn = (wgid % nig) / gsz;
        u.a = (unsigned)pm * atile; u.b = (unsigned)pn * btile; u.last = 1; u.i0 = pm; u.i1 = pn; return true;
    }
};
}

struct Args { const float* in[N_IN]; float* out; unsigned char* ws; int ph_lo, ph_hi; };
static_assert(sizeof(Args) == N_IN * 8 + 8 + 8 + 8, "Args has no padding");

#define CAS __attribute__((address_space(4)))
typedef const float* fptr_t;
struct Ctx {
    const CAS fptr_t* in; float* out; unsigned char* ws; LAS unsigned char* lds; int tid, lane, wave, G, bid;
};
#define WSP(T, off) ((T*)(C.ws + (off)))

__device__ __forceinline__ void build_tiletab(const Ctx& C, int l) {
    volatile LAS int* lc = (volatile LAS int*)(C.lds + LDSCTL_OFF);
    __syncthreads();
    if (C.tid == 0) {
        const unsigned* cnt = WSP(const unsigned, WS_CTL) + CW_CNT + l * 64;
        int off = 0, t = 0;
        for (int b = 0; b < NBIN; ++b) {
            const int n = (int)__hip_atomic_load(cnt + b, __ATOMIC_RELAXED, __HIP_MEMORY_SCOPE_AGENT);
            lc[LC_OFFS + b] = off;
            const int nt = (n + 255) >> 8;
            for (int k = 0; k < nt; ++k) lc[LC_TILEBIN + t + k] = b;
            t += nt; off += nt * 256;
        }
        lc[LC_OFFS + NBIN] = off; lc[LC_T] = t;
    }
    __syncthreads();
}
__device__ __forceinline__ int expert_of(int bin, int es) {
    const int g = bin / 6, p = bin - g * 6;
    const int lo = p < 3 ? 0 : (p < 5 ? 1 : 2), hi = p < 3 ? p + 1 : (p < 5 ? p - 1 : 3);
    return 4 * g + (es ? hi : lo);
}

struct SchedUp {
    int T, G, c; const volatile LAS int* tilebin;
    __device__ __forceinline__ bool next(int i, pg8::GUnit& u) const {
        const int idx = i * G + c; if (idx >= 4 * T) return false;
        const int rt = idx >> 2, q = idx & 3, es = q >> 1, fb = q & 1;
        const int bin = __builtin_amdgcn_readfirstlane(tilebin[rt]);
        const int e = expert_of(bin, es);
        u.a = (unsigned)rt * 256u * 2048u; u.b = (unsigned)(e * 256 + fb * 128) * 2048u;
        u.last = 1; u.i0 = rt; u.i1 = q; return true;
    }
};
struct SchedDown {
    int T, G, c; const volatile LAS int* tilebin;
    __device__ __forceinline__ bool next(int i, pg8::GUnit& u) const {
        const int idx = (i >> 1) * G + c, sub = i & 1; if (idx >= 4 * T) return false;
        const int rt = idx >> 2, pn = idx & 3;
        const int bin = __builtin_amdgcn_readfirstlane(tilebin[rt]);
        const int e = expert_of(bin, sub);
        u.a = (unsigned)rt * 256u * 1024u + (unsigned)sub * 512u; u.b = (unsigned)(e * 1024 + pn * 256) * 512u;
        u.last = sub; u.i0 = rt; u.i1 = pn; return true;
    }
};

struct EpiHG {
    static constexpr bool PERM = true;
    bf16_t* O; const float* lower;
    __device__ __forceinline__ void operator()(const f32x4 (&acc)[2][2][4][2], const pg8::GUnit& u, int wr, int wc, int fr, int fq) const {
        const int kind = u.i1 >> 1;
        const int row0 = u.i0 * 256 + wr * 64 + fr, colt = u.i1 * 256 + wc * 32 + 8 * fq;
#pragma unroll
        for (int bj = 0; bj < 2; ++bj) {
            const int col = colt + bj * 128;
            float om[8];
#pragma unroll
            for (int j = 0; j < 8; ++j) om[j] = 1.f;
            if (kind >= 3) { const float* lb = lower + (kind - 3) * 2048 + (col & 511);
#pragma unroll
                for (int j = 0; j < 8; ++j) om[j] = 1.f - lb[j]; }
#pragma unroll
            for (int ai = 0; ai < 2; ++ai)
#pragma unroll
                for (int m = 0; m < 4; ++m) {
                    float v[8];
#pragma unroll
                    for (int j = 0; j < 8; ++j) v[j] = acc[ai][bj][m][j >> 2][j & 3];
                    if (kind == 0) {
#pragma unroll
                        for (int j = 0; j < 8; ++j) v[j] = siluf_(v[j]);
                    } else if (kind >= 3) {
#pragma unroll
                        for (int j = 0; j < 8; ++j) v[j] = om[j] * sigmoidf_(-v[j]);
                    }
                    u32x4 w; w.x = pk2(v[0], v[1]); w.y = pk2(v[2], v[3]); w.z = pk2(v[4], v[5]); w.w = pk2(v[6], v[7]);
                    *(u32x4*)(O + (size_t)(row0 + ai * 128 + m * 16) * NHG + col) = w;
                }
        }
    }
};
struct EpiHY {
    static constexpr bool PERM = true;
    bf16_t* O;
    __device__ __forceinline__ void operator()(const f32x4 (&acc)[2][2][4][2], const pg8::GUnit& u, int wr, int wc, int fr, int fq) const {
        const int row0 = u.i0 * 256 + wr * 64 + fr, colt = u.i1 * 256 + wc * 32 + 8 * fq;
#pragma unroll
        for (int ai = 0; ai < 2; ++ai)
#pragma unroll
            for (int m = 0; m < 4; ++m)
#pragma unroll
                for (int bj = 0; bj < 2; ++bj) {
                    const f32x4 v0 = acc[ai][bj][m][0], v1 = acc[ai][bj][m][1];
                    u32x4 w; w.x = pk2(v0[0], v0[1]); w.y = pk2(v0[2], v0[3]); w.z = pk2(v1[0], v1[1]); w.w = pk2(v1[2], v1[3]);
                    *(u32x4*)(O + (size_t)(row0 + ai * 128 + m * 16) * NTOK + colt + bj * 128) = w;
                }
    }
};
struct EpiOut {
    static constexpr bool PERM = false;
    const float* xlat; const float* xctx; float* xo; const float* mods; int first;
    __device__ __forceinline__ void operator()(const f32x4 (&acc)[2][2][4][2], const pg8::GUnit& u, int wr, int wc, int fr, int fq) const {
        const int row0 = u.i0 * 256 + wr * 64 + fr, col0 = u.i1 * 256 + wc * 32 + 4 * fq;
#pragma unroll
        for (int ai = 0; ai < 2; ++ai)
#pragma unroll
            for (int m = 0; m < 4; ++m) {
                const int row = row0 + ai * 128 + m * 16;
                const float* src = first ? (row < NLAT ? xlat + (size_t)row * D : xctx + (size_t)(row - NLAT) * D) : xo + (size_t)row * D;
                const float* g1 = mods + bidx(row) * 6144 + 2048;
#pragma unroll
                for (int bj = 0; bj < 2; ++bj)
#pragma unroll
                    for (int n = 0; n < 2; ++n) { const int col = col0 + bj * 128 + n * 16;
                        const f32x4 xv = *(const f32x4*)(src + col), gv = *(const f32x4*)(g1 + col);
                        *(f32x4*)(xo + (size_t)row * D + col) = xv + gv * acc[ai][bj][m][n]; }
            }
    }
};
struct EpiAct {
    static constexpr bool PERM = true;
    bf16_t* O; const float* roww;
    __device__ __forceinline__ void operator()(const f32x4 (&acc)[2][2][4][2], const pg8::GUnit& u, int wr, int wc, int fr, int fq) const {
        const int es = u.i1 >> 1; const int pos0 = u.i0 * 256 + wr * 64 + fr, col = u.i1 * 128 + wc * 32 + 8 * fq;
#pragma unroll
        for (int ai = 0; ai < 2; ++ai)
#pragma unroll
            for (int m = 0; m < 4; ++m) {
                const int pos = pos0 + ai * 128 + m * 16;
                const float wgt = roww[pos * 2 + es];
                float v[8];
#pragma unroll
                for (int j = 0; j < 8; ++j) v[j] = siluf_(acc[ai][0][m][j >> 2][j & 3]) * acc[ai][1][m][j >> 2][j & 3] * wgt;
                u32x4 w; w.x = pk2(v[0], v[1]); w.y = pk2(v[2], v[3]); w.z = pk2(v[4], v[5]); w.w = pk2(v[6], v[7]);
                *(u32x4*)(O + (size_t)pos * 512 + col) = w;
            }
    }
};
struct EpiDown {
    static constexpr bool PERM = false;
    float* xo; const int* rowtok; const float* mods;
    __device__ __forceinline__ void operator()(const f32x4 (&acc)[2][2][4][2], const pg8::GUnit& u, int wr, int wc, int fr, int fq) const {
        const int pos0 = u.i0 * 256 + wr * 64 + fr, col0 = u.i1 * 256 + wc * 32 + 4 * fq;
#pragma unroll
        for (int ai = 0; ai < 2; ++ai)
#pragma unroll
            for (int m = 0; m < 4; ++m) {
                const int tok = rowtok[pos0 + ai * 128 + m * 16];
                if (tok >= 0) {
                    const float* g2 = mods + bidx(tok) * 6144 + 5120;
                    float* xr = xo + (size_t)tok * D;
#pragma unroll
                    for (int bj = 0; bj < 2; ++bj)
#pragma unroll
                        for (int n = 0; n < 2; ++n) { const int col = col0 + bj * 128 + n * 16;
                            const f32x4 xv = *(const f32x4*)(xr + col), gv = *(const f32x4*)(g2 + col);
                            *(f32x4*)(xr + col) = xv + gv * acc[ai][bj][m][n]; }
                }
            }
    }
};

__device__ __forceinline__ int padx(int i) { return i + (i >> 3); }
__device__ __forceinline__ f32x2 cmul(f32x2 a, f32x2 b) { return (f32x2){a.x * b.x - a.y * b.y, a.x * b.y + a.y * b.x}; }
__device__ __forceinline__ f32x2 cmulc(f32x2 a, f32x2 b) { return (f32x2){a.x * b.x + a.y * b.y, a.y * b.x - a.x * b.y}; }
constexpr int XPAD = 2048 + 256;

__device__ __forceinline__ void fft_p1_dif(f32x2 (&v)[8], int tt, const LAS f32x2* T) {
#pragma unroll
    for (int g = 0; g < 2; ++g) { const int u = tt + 256 * g;
#pragma unroll
        for (int j = 0; j < 2; ++j) { const f32x2 a = v[g + 2 * j], b = v[g + 2 * j + 4]; v[g + 2 * j] = a + b; v[g + 2 * j + 4] = cmul(a - b, T[2 * (u + 512 * j)]); }
        const f32x2 tw = T[4 * u];
        { const f32x2 a = v[g], b = v[g + 2]; v[g] = a + b; v[g + 2] = cmul(a - b, tw); }
        { const f32x2 a = v[g + 4], b = v[g + 6]; v[g + 4] = a + b; v[g + 6] = cmul(a - b, tw); } }
}
__device__ __forceinline__ void fft_p1_dit(f32x2 (&v)[8], int tt, const LAS f32x2* T) {
#pragma unroll
    for (int g = 0; g < 2; ++g) { const int u = tt + 256 * g;
        const f32x2 tw = T[4 * u];
        { const f32x2 a = v[g], b = cmulc(v[g + 2], tw); v[g] = a + b; v[g + 2] = a - b; }
        { const f32x2 a = v[g + 4], b = cmulc(v[g + 6], tw); v[g + 4] = a + b; v[g + 6] = a - b; }
#pragma unroll
        for (int j = 0; j < 2; ++j) { const f32x2 a = v[g + 2 * j], b = cmulc(v[g + 2 * j + 4], T[2 * (u + 512 * j)]); v[g + 2 * j] = a + b; v[g + 2 * j + 4] = a - b; } }
}
template <int Q> __device__ __forceinline__ void r8_dif(f32x2 (&e)[8], int r, const LAS f32x2* T) {
    constexpr int S2 = 512 / Q;
#pragma unroll
    for (int j = 0; j < 4; ++j) { const f32x2 a = e[j], b = e[j + 4]; e[j] = a + b; e[j + 4] = cmul(a - b, T[S2 * (r + Q * j)]); }
#pragma unroll
    for (int jj = 0; jj < 4; ++jj) { const int j = (jj & 1) + 4 * (jj >> 1); const f32x2 a = e[j], b = e[j + 2]; e[j] = a + b; e[j + 2] = cmul(a - b, T[2 * S2 * (r + Q * (j & 1))]); }
    const f32x2 tw = T[4 * S2 * r];
#pragma unroll
    for (int j = 0; j < 8; j += 2) { const f32x2 a = e[j], b = e[j + 1]; e[j] = a + b; e[j + 1] = cmul(a - b, tw); }
}
template <int Q> __device__ __forceinline__ void r8_dit(f32x2 (&e)[8], int r, const LAS f32x2* T) {
    constexpr int S2 = 512 / Q;
    const f32x2 tw = T[4 * S2 * r];
#pragma unroll
    for (int j = 0; j < 8; j += 2) { const f32x2 a = e[j], b = cmulc(e[j + 1], tw); e[j] = a + b; e[j + 1] = a - b; }
#pragma unroll
    for (int jj = 0; jj < 4; ++jj) { const int j = (jj & 1) + 4 * (jj >> 1); const f32x2 a = e[j], b = cmulc(e[j + 2], T[2 * S2 * (r + Q * (j & 1))]); e[j] = a + b; e[j + 2] = a - b; }
#pragma unroll
    for (int j = 0; j < 4; ++j) { const f32x2 a = e[j], b = cmulc(e[j + 4], T[S2 * (r + Q * j)]); e[j] = a + b; e[j + 4] = a - b; }
}
template <int Q, bool INV> __device__ __forceinline__ void fft_mid(LAS f32x2* X, int tt, const LAS f32x2* T) {
    const int blk = tt / Q, r = tt % Q, base = blk * 8 * Q + r;
    f32x2 e[8];
#pragma unroll
    for (int j = 0; j < 8; ++j) e[j] = X[padx(base + Q * j)];
    if (INV) r8_dit<Q>(e, r, T); else r8_dif<Q>(e, r, T);
#pragma unroll
    for (int j = 0; j < 8; ++j) X[padx(base + Q * j)] = e[j];
}
__device__ __forceinline__ void fft_conv_half(f32x2 (&v)[8], LAS f32x2* X, const LAS f32x2* T, const f32x2* K, int tt) {
    f32x2 kv[8];
#pragma unroll
    for (int j = 0; j < 8; ++j) kv[j] = K[8 * tt + j];
    fft_p1_dif(v, tt, T);
#pragma unroll
    for (int m = 0; m < 8; ++m) X[padx(tt + 256 * m)] = v[m];
    __syncthreads();
    fft_mid<64, false>(X, tt, T); __syncthreads();
    fft_mid<8, false>(X, tt, T); __syncthreads();
    f32x2 e[8];
#pragma unroll
    for (int j = 0; j < 8; ++j) e[j] = X[padx(8 * tt + j)];
    r8_dif<1>(e, 0, T);
#pragma unroll
    for (int j = 0; j < 8; ++j) e[j] = cmul(e[j], kv[j]);
    r8_dit<1>(e, 0, T);
#pragma unroll
    for (int j = 0; j < 8; ++j) X[padx(8 * tt + j)] = e[j];
    __syncthreads();
    fft_mid<8, true>(X, tt, T); __syncthreads();
    fft_mid<64, true>(X, tt, T); __syncthreads();
#pragma unroll
    for (int m = 0; m < 8; ++m) v[m] = X[padx(tt + 256 * m)];
    fft_p1_dit(v, tt, T);
}
__device__ __forceinline__ void fft_fwd_store(f32x2 (&v)[8], LAS f32x2* X, const LAS f32x2* T, f32x2* Kout, int tt) {
    fft_p1_dif(v, tt, T);
#pragma unroll
    for (int m = 0; m < 8; ++m) X[padx(tt + 256 * m)] = v[m];
    __syncthreads();
    fft_mid<64, false>(X, tt, T); __syncthreads();
    fft_mid<8, false>(X, tt, T); __syncthreads();
    f32x2 e[8];
#pragma unroll
    for (int j = 0; j < 8; ++j) e[j] = X[padx(8 * tt + j)];
    r8_dif<1>(e, 0, T);
#pragma unroll
    for (int j = 0; j < 8; ++j) Kout[8 * tt + j] = e[j];
    __syncthreads();
}
__device__ __forceinline__ void build_twiddles(const Ctx& C, LAS f32x2* T) {
    for (int k = C.tid; k < 2048; k += NTHR) { float s, c; sincospif((float)k * (1.0f / 2048.0f), &s, &c); T[k] = (f32x2){c, -s}; }
}

__device__ __forceinline__ void phase0(const Ctx& C) {
    LAS float* sil = (LAS float*)C.lds;
    LAS float* red = sil + 9 * 1024;
    LAS float* zs = red + 8 * 9 * 64;
    LAS float* h1s = zs + 8 * 40;
    const float* cin = C.in[IN_C]; const float* cctx = C.in[IN_CCTX];
    for (int i = C.tid; i < 9 * 1024; i += NTHR) { const int r = i >> 10, k = i & 1023; const float v = r < 8 ? cin[r * 1024 + k] : cctx[k]; sil[i] = v / (1.0f + expf(-v)); }
    __syncthreads();
    float* mods = WSP(float, WS_MODS);
    const float* wmod = C.in[IN_WMOD]; const float* bmod = C.in[IN_BMOD];
    for (int item = C.bid; item < 4 * 96; item += C.G) {
        const int l = item / 96, cb = item % 96, cc = C.tid & 63, kg = C.tid >> 6;
        const float* w = wmod + ((size_t)l * 1024 + kg * 128) * 6144 + cb * 64 + cc;
        const LAS float* sk = sil + kg * 128;
        float acc[9];
#pragma unroll
        for (int r = 0; r < 9; ++r) acc[r] = 0.f;
#pragma unroll 4
        for (int k = 0; k < 128; ++k) { const float wv = w[(size_t)k * 6144];
#pragma unroll
            for (int r = 0; r < 9; ++r) acc[r] += sk[r * 1024 + k] * wv; }
#pragma unroll
        for (int r = 0; r < 9; ++r) red[(kg * 9 + r) * 64 + cc] = acc[r];
        __syncthreads();
        for (int o = C.tid; o < 576; o += NTHR) { const int r = o >> 6, c2 = o & 63; float s = 0.f;
#pragma unroll
            for (int g = 0; g < 8; ++g) s += red[(g * 9 + r) * 64 + c2];
            mods[(size_t)(l * 9 + r) * 6144 + cb * 64 + c2] = s + bmod[l * 6144 + cb * 64 + c2]; }
        __syncthreads();
    }
    for (int item = C.bid; item < 4 * 288; item += C.G) {
        const int l = item / 288, r = item % 288, isctx = r >= 256;
        const int L = isctx ? 256 : 2048, t0 = (isctx ? r - 256 : r) * 8, tl = C.tid >> 6, j = C.tid & 63, t = t0 + tl;
        if (j < 33) { float z;
            if (j == 0) z = (float)t / (float)(L - 1);
            else { const int fi = (j - 1) & 15; const float freq = 1e-4f + (float)fi * ((15.0f - 1e-4f) / 15.0f);
                const float ang = ((float)(2.0 * 3.14159265358979323846 / L) * (float)t) * freq; z = (j <= 16) ? cosf(ang) : -sinf(ang); }
            zs[tl * 40 + j] = z; }
        __syncthreads();
        { const float* w1 = C.in[IN_W1] + (size_t)l * 33 * 64; float s = C.in[IN_B1][l * 64 + j];
            for (int i = 0; i < 33; ++i) s += zs[tl * 40 + i] * w1[i * 64 + j];
            h1s[tl * 64 + j] = sinf(s); }
        __syncthreads();
        { const float* w2 = C.in[IN_W2] + (size_t)l * 64 * 64; float s = C.in[IN_B2][l * 64 + j];
            for (int i = 0; i < 64; ++i) s += h1s[tl * 64 + i] * w2[i * 64 + j];
            float* dst = isctx ? WSP(float, WS_H2C) + ((size_t)l * 256 + t) * 64 : WSP(float, WS_H2L) + ((size_t)l * 2048 + t) * 64;
            dst[j] = sinf(s); }
        __syncthreads();
    }
    if (C.bid == C.G - 1) {
        const float* lb = C.in[IN_LB]; float* lower = WSP(float, WS_LOWER);
        for (int i = C.tid; i < 1024; i += NTHR) { const int d = i >> 9, c = i & 511; float v[4], mx = -3.4e38f, s = 0.f;
#pragma unroll
            for (int l = 0; l < 4; ++l) { v[l] = lb[(d * 4 + l) * 512 + c]; mx = fmaxf(mx, v[l]); }
#pragma unroll
            for (int l = 0; l < 4; ++l) { v[l] = expf(v[l] - mx); s += v[l]; }
            float cum = 0.f;
#pragma unroll
            for (int l = 0; l < 4; ++l) { if (l > 0) cum += v[l] / s; lower[(d * 4 + l) * 512 + c] = cum; } }
    }
}

__device__ __forceinline__ const float* xrow_src(const Ctx& C, int l, int row) {
    return l == 0 ? (row < NLAT ? C.in[IN_X] + (size_t)row * D : C.in[IN_CTX] + (size_t)(row - NLAT) * D) : WSP(const float, WS_XBUF) + (size_t)row * D;
}
__device__ __forceinline__ void transpose_item(const float* W, int K, int N, bf16_t* WT, LAS float* scr, int item, int lane) {
    const int nblk = N / 32, kb = item / nblk, nb = item % nblk, k0 = 64 * kb, n0 = 32 * nb;
#pragma unroll 8
    for (int i = 0; i < 32; ++i) { const int kk = 2 * i + (lane >> 5); scr[kk * 33 + (lane & 31)] = W[(size_t)(k0 + kk) * N + n0 + (lane & 31)]; }
    LDS_WAIT(); asm volatile("" ::: "memory");
    const int c = lane & 7;
#pragma unroll
    for (int j = 0; j < 4; ++j) { const int n = (lane >> 3) + 8 * j; const LAS float* s = scr + (8 * c) * 33 + n;
        u32x4 o; o.x = pk2(s[0 * 33], s[1 * 33]); o.y = pk2(s[2 * 33], s[3 * 33]); o.z = pk2(s[4 * 33], s[5 * 33]); o.w = pk2(s[6 * 33], s[7 * 33]);
        *(u32x4*)(WT + (size_t)(n0 + n) * K + k0 + 8 * c) = o; }
    LDS_WAIT(); asm volatile("" ::: "memory");
}
__device__ __forceinline__ void phase_l1(const Ctx& C, int l) {
    const int gw = C.bid * NWAVES + C.wave, NGW = C.G * NWAVES;
    const float* mods = WSP(const float, WS_MODS) + (size_t)l * 9 * 6144;
    bf16_t* an = WSP(bf16_t, WS_R1);
    for (int row = gw; row < NTOK; row += NGW) {
        const float* src = xrow_src(C, l, row); const float* md = mods + bidx(row) * 6144;
        f32x4 v[4]; float ss = 0.f;
#pragma unroll
        for (int j = 0; j < 4; ++j) { v[j] = *(const f32x4*)(src + C.lane * 4 + 256 * j); ss += (v[j].x * v[j].x + v[j].y * v[j].y) + (v[j].z * v[j].z + v[j].w * v[j].w); }
        ss = wave_sum(ss); const float rinv = 1.0f / sqrtf(ss * (1.0f / D) + EPS);
#pragma unroll
        for (int j = 0; j < 4; ++j) { const int k = C.lane * 4 + 256 * j; const f32x4 sh = *(const f32x4*)(md + k), sc = *(const f32x4*)(md + 1024 + k);
            const f32x4 o = v[j] * rinv * (sc + 1.0f) + sh; u32x2 w; w.x = pk2(o.x, o.y); w.y = pk2(o.z, o.w);
            *(u32x2*)(an + (size_t)row * D + k) = w; }
    }
    {
        LAS float* scr = (LAS float*)(C.lds + C.wave * 16384);
        constexpr int I_IN = 16 * 128, I_OUT = 16 * 32, I_E = 128;
        constexpr int NIT = I_IN + I_OUT + 3 * 16 * I_E;
        for (int it = gw; it < NIT; it += NGW) {
            int r = it;
            if (r < I_IN) { transpose_item(C.in[IN_WIN] + (size_t)l * D * DIN, D, DIN, WSP(bf16_t, WS_WIN), scr, r, C.lane); continue; } r -= I_IN;
            if (r < I_OUT) { transpose_item(C.in[IN_WOUT] + (size_t)l * D * D, D, D, WSP(bf16_t, WS_WOUT), scr, r, C.lane); continue; } r -= I_OUT;
            if (r < 16 * I_E) { const int e = r / I_E; transpose_item(C.in[IN_WG] + ((size_t)l * NE + e) * D * DE, D, DE, WSP(bf16_t, WS_WG) + (size_t)e * DE * D, scr, r % I_E, C.lane); continue; } r -= 16 * I_E;
            if (r < 16 * I_E) { const int e = r / I_E; transpose_item(C.in[IN_WU] + ((size_t)l * NE + e) * D * DE, D, DE, WSP(bf16_t, WS_WU) + (size_t)e * DE * D, scr, r % I_E, C.lane); continue; } r -= 16 * I_E;
            { const int e = r / I_E; transpose_item(C.in[IN_WD] + ((size_t)l * NE + e) * DE * D, DE, D, WSP(bf16_t, WS_WD) + (size_t)e * D * DE, scr, r % I_E, C.lane); }
        }
    }
    __syncthreads();
    {
        LAS f32x2* T = (LAS f32x2*)C.lds;
        const int team = C.tid >> 8, tt = C.tid & 255;
        LAS f32x2* X = (LAS f32x2*)(C.lds + 16384) + team * XPAD;
        LAS float* hbs = (LAS float*)(C.lds + 16384 + 2 * XPAD * 8) + team * 2048;
        LAS float* w3s = (LAS float*)(C.lds + 16384 + 2 * XPAD * 8 + 16384) + team * 128;
        LAS float* reds = (LAS float*)(C.lds + 16384 + 2 * XPAD * 8 + 16384 + 1024);
        build_twiddles(C, T);
        __syncthreads();
        const float* h2 = WSP(const float, WS_H2L) + (size_t)l * 2048 * 64;
        const float* w3 = C.in[IN_W3] + (size_t)l * 64 * 2048; const float* b3 = C.in[IN_B3] + l * 2048;
        f32x2* kspec = WSP(f32x2, WS_KSPEC);
        for (int item = C.bid; item < 512; item += C.G) {
            const int idx = item * 2 + team, o = idx >> 9, c = idx & 511;
            const int colf = o * 1024 + c, colb = colf + 512;
            if (tt < 128) w3s[tt] = w3[(size_t)(tt & 63) * 2048 + ((tt >> 6) ? colb : colf)];
            __syncthreads();
            const float delta = fabsf(logf(1e-2f) / 0.3f + (float)c * ((logf(1e-2f) / 1.5f - logf(1e-2f) / 0.3f) / 511.0f));
            float hf[8], hb[8], s = 0.f;
#pragma unroll
            for (int j = 0; j < 8; ++j) { const int t = tt + 256 * j; const f32x4* hr = (const f32x4*)(h2 + (size_t)t * 64);
                float af = b3[colf], ab = b3[colb];
#pragma unroll
                for (int i4 = 0; i4 < 16; ++i4) { const f32x4 h = hr[i4];
                    af += h.x * w3s[i4 * 4] + h.y * w3s[i4 * 4 + 1] + h.z * w3s[i4 * 4 + 2] + h.w * w3s[i4 * 4 + 3];
                    ab += h.x * w3s[64 + i4 * 4] + h.y * w3s[64 + i4 * 4 + 1] + h.z * w3s[64 + i4 * 4 + 2] + h.w * w3s[64 + i4 * 4 + 3]; }
                const float win = expf(-((float)t / 2047.0f) * delta);
                hf[j] = af * win; hb[j] = ab * win; s += fabsf(hf[j]) + fabsf(hb[j]); }
            s = wave_sum(s);
            if (C.lane == 0) reds[C.wave] = s;
            __syncthreads();
            const float tot = reds[team * 4] + reds[team * 4 + 1] + reds[team * 4 + 2] + reds[team * 4 + 3];
            const float inv = 1.0f / (tot * 4096.0f);
#pragma unroll
            for (int j = 0; j < 8; ++j) { hf[j] *= inv; hb[j] *= inv; hbs[tt + 256 * j] = hb[j]; }
            __syncthreads();
            f32x2 ve[8], vo[8];
#pragma unroll
            for (int j = 0; j < 8; ++j) { const int n = tt + 256 * j; const float kb = n > 0 ? hbs[2048 - n] : 0.f;
                ve[j] = (f32x2){hf[j] + kb, 0.f}; const float dd = hf[j] - kb; const f32x2 tw = T[n]; vo[j] = (f32x2){dd * tw.x, dd * tw.y}; }
            f32x2* kout = kspec + ((size_t)(o * 512 + c) * 2) * 2048;
            fft_fwd_store(ve, X, T, kout, tt);
            fft_fwd_store(vo, X, T, kout + 2048, tt);
        }
    }
}

__device__ __forceinline__ float shortconv(const LAS bf16_t* raw, int t, int mask, int tmax, float w0, float w1, float w2, float bias) {
    const float pm = ((t & mask) != 0) ? bf2f(raw[t - 1]) : 0.f;
    const float pc = bf2f(raw[t]);
    const float pp = ((t & mask) != mask && t < tmax) ? bf2f(raw[t + 1]) : 0.f;
    return w0 * pm + w1 * pc + w2 * pp + bias;
}
__device__ __forceinline__ void hyena_lat(const Ctx& C, int l, int item) {
    const int bp = item >> 6, cg = item & 63, team = C.tid >> 8, tt = C.tid & 255;
    LAS f32x2* T = (LAS f32x2*)C.lds;
    LAS f32x2* X = (LAS f32x2*)(C.lds + 16384) + team * XPAD;
    LAS bf16_t* raw = (LAS bf16_t*)(C.lds + 16384 + 2 * XPAD * 8) + team * 4096;
    LAS bf16_t* outs = (LAS bf16_t*)(C.lds + 16384 + 2 * XPAD * 8 + 16384);
    const bf16_t* phyt = WSP(const bf16_t, WS_PHYT);
    const float* cw = C.in[IN_CONVW] + (size_t)l * 3 * NHY; const float* cb = C.in[IN_CONVB] + (size_t)l * NHY;
    const float* hyb = C.in[IN_HYBIAS] + (size_t)l * 2 * DH;
    const f32x2* kspec = WSP(const f32x2, WS_KSPEC);
    const int ba = 2 * bp;
    for (int round = 0; round < 4; ++round) {
        const int c = cg * 8 + round * 2 + team;
        f32x2 z[8], acc[8], v[8];
#pragma unroll 1
        for (int stage = 0; stage < 3; ++stage) {
            const int ch = stage * 512 + c;
            __syncthreads();
#pragma unroll
            for (int k = 0; k < 2; ++k) { const int q = tt + 256 * k, rr = q >> 8, cc = q & 255;
                *(LAS u32x4*)(raw + rr * 2048 + cc * 8) = *(const u32x4*)(phyt + (size_t)ch * NTOK + (size_t)(ba + rr) * 2048 + cc * 8); }
            __syncthreads();
            const float w0 = cw[ch], w1 = cw[NHY + ch], w2 = cw[2 * NHY + ch], bs = cb[ch];
            if (stage == 0) {
#pragma unroll
                for (int j = 0; j < 8; ++j) { const int t = tt + 256 * j; z[j] = (f32x2){shortconv(raw, t, 63, 4096, w0, w1, w2, bs), shortconv(raw + 2048, t, 63, 4096, w0, w1, w2, bs)}; }
            } else {
                const float dsk = hyb[(stage - 1) * DH + c];
#pragma unroll
                for (int j = 0; j < 8; ++j) { const int t = tt + 256 * j; const f32x2 cv = acc[j] + z[j] * dsk;
                    z[j] = (f32x2){shortconv(raw, t, 63, 4096, w0, w1, w2, bs) * cv.x, shortconv(raw + 2048, t, 63, 4096, w0, w1, w2, bs) * cv.y}; }
            }
            if (stage == 2) {
#pragma unroll
                for (int j = 0; j < 8; ++j) { const int t = tt + 256 * j; outs[(size_t)t * 8 + round * 2 + team] = (bf16_t)f2bf(z[j].x); outs[(size_t)(2048 + t) * 8 + round * 2 + team] = (bf16_t)f2bf(z[j].y); }
                break;
            }
            const f32x2* K = kspec + ((size_t)(stage * 512 + c) * 2) * 2048;
#pragma unroll
            for (int j = 0; j < 8; ++j) v[j] = z[j];
            fft_conv_half(v, X, T, K, tt);
#pragma unroll
            for (int j = 0; j < 8; ++j) acc[j] = v[j];
#pragma unroll
            for (int j = 0; j < 8; ++j) v[j] = cmul(z[j], T[tt + 256 * j]);
            fft_conv_half(v, X, T, K + 2048, tt);
#pragma unroll
            for (int j = 0; j < 8; ++j) acc[j] += cmulc(v[j], T[tt + 256 * j]);
        }
    }
    __syncthreads();
    bf16_t* Y = WSP(bf16_t, WS_R1);
    for (int i = C.tid; i < 4096; i += NTHR) { const int b = i >> 11, t = i & 2047;
        *(u32x4*)(Y + ((size_t)(ba + b) * 2048 + t) * D + cg * 8) = *(const LAS u32x4*)(outs + (size_t)i * 8); }
    __syncthreads();
}
__device__ __forceinline__ void hyena_ctx(const Ctx& C, int l, int c) {
    LAS float* hf = (LAS float*)(C.lds + 16384);
    LAS float* hb = hf + 512;
    LAS float* us = hb + 512;
    LAS float* z2 = us + 3 * 2048;
    LAS float* reds = z2 + 2048;
    LAS float* w3s = reds + 8;
    const float* h2 = WSP(const float, WS_H2C) + (size_t)l * 256 * 64;
    const float* w3 = C.in[IN_W3] + (size_t)l * 64 * 2048; const float* b3 = C.in[IN_B3] + l * 2048;
    const bf16_t* phyt = WSP(const bf16_t, WS_PHYT);
    const float* cw = C.in[IN_CONVW] + (size_t)l * 3 * NHY; const float* cb = C.in[IN_CONVB] + (size_t)l * NHY;
    const float* hyb = C.in[IN_HYBIAS] + (size_t)l * 2 * DH;
    __syncthreads();
    if (C.tid < 256) { const int i = C.tid & 63, which = C.tid >> 6;   w3s[C.tid] = w3[(size_t)i * 2048 + (which >> 1) * 1024 + (which & 1) * 512 + c]; }
    __syncthreads();
    { const int t = C.tid & 255, o = C.tid >> 8;
        const f32x4* hr = (const f32x4*)(h2 + (size_t)t * 64);
        float af = b3[o * 1024 + c], ab = b3[o * 1024 + 512 + c];
        const LAS float* wf = w3s + (o * 2) * 64; const LAS float* wb = w3s + (o * 2 + 1) * 64;
#pragma unroll
        for (int i4 = 0; i4 < 16; ++i4) { const f32x4 h = hr[i4];
            af += h.x * wf[i4 * 4] + h.y * wf[i4 * 4 + 1] + h.z * wf[i4 * 4 + 2] + h.w * wf[i4 * 4 + 3];
            ab += h.x * wb[i4 * 4] + h.y * wb[i4 * 4 + 1] + h.z * wb[i4 * 4 + 2] + h.w * wb[i4 * 4 + 3]; }
        const float delta = fabsf(logf(1e-2f) / 0.3f + (float)c * ((logf(1e-2f) / 1.5f - logf(1e-2f) / 0.3f) / 511.0f));
        const float win = expf(-((float)t / 255.0f) * delta);
        af *= win; ab *= win;
        float s = wave_sum(fabsf(af) + fabsf(ab));
        if (C.lane == 0) reds[C.wave] = s;
        __syncthreads();
        const float tot = reds[o * 4] + reds[o * 4 + 1] + reds[o * 4 + 2] + reds[o * 4 + 3];
        hf[o * 256 + t] = af / tot; hb[o * 256 + t] = ab / tot; }
    for (int i = C.tid; i < 3 * 2048; i += NTHR) { const int grp = i >> 11, b = (i >> 8) & 7, t = i & 255, ch = grp * 512 + c;
        const bf16_t* p = phyt + (size_t)ch * NTOK + NLAT + b * 256;
        const float pm = t > 0 ? bf2f(p[t - 1]) : 0.f, pc = bf2f(p[t]), pp = t < 255 ? bf2f(p[t + 1]) : 0.f;
        us[i] = cw[ch] * pm + cw[NHY + ch] * pc + cw[2 * NHY + ch] * pp + cb[ch]; }
    __syncthreads();
    const int b = C.tid >> 6, t0 = C.tid & 63;
    bf16_t* Y = WSP(bf16_t, WS_R1);
#pragma unroll 1
    for (int o = 0; o < 2; ++o) {
        const LAS float* uin = o == 0 ? us + b * 256 : z2 + b * 256;
        const LAS float* f = hf + o * 256; const LAS float* g = hb + o * 256;
        float a[4] = {0.f, 0.f, 0.f, 0.f};
        for (int s = 0; s < 256; ++s) { const float uv = uin[s];
#pragma unroll
            for (int jj = 0; jj < 4; ++jj) { const int d = t0 + 64 * jj - s; a[jj] += uv * (d >= 0 ? f[d] : g[-d]); } }
        const float dsk = hyb[o * DH + c];
        __syncthreads();
#pragma unroll
        for (int jj = 0; jj < 4; ++jj) { const int t = t0 + 64 * jj; const float cv = a[jj] + uin[t] * dsk;
            if (o == 0) z2[b * 256 + t] = us[2048 + b * 256 + t] * cv;
            else Y[(size_t)(NLAT + b * 256 + t) * D + c] = (bf16_t)f2bf(us[4096 + b * 256 + t] * cv); }
        __syncthreads();
    }
}
__device__ __forceinline__ void hgrn_scan(const Ctx& C, int item) {
    const int dvq = item & 3, dir = (item >> 2) & 1, h = (item >> 3) & 3, b = item >> 5;
    LAS float* qs = (LAS float*)C.lds;
    LAS float* ks = qs + 2 * 4096;
    LAS float* vs = ks + 2 * 4096;
    LAS float* os = vs + 2 * 1024;
    const bf16_t* phg = WSP(const bf16_t, WS_PHG);
    bf16_t* odir = WSP(bf16_t, WS_ODIR) + (size_t)dir * NTOK * 512;
    const int kg = C.lane & 15, j = C.wave * 4 + (C.lane >> 4);
    const int ltok = C.tid >> 4, lpart = C.tid & 15;
    float S[8];
#pragma unroll
    for (int i = 0; i < 8; ++i) S[i] = 0.f;
    auto rowof = [&](int sg) -> int { if (sg < 256) { const int t = dir ? 255 - sg : sg; return NLAT + b * 256 + t; } const int s2 = sg - 256; const int t = dir ? 2047 - s2 : s2; return b * 2048 + t; };
    u32x4 rq, rk, rv;
    { const int row = rowof(ltok); rq = *(const u32x4*)(phg + (size_t)row * NHG + h * 128 + lpart * 8); rk = *(const u32x4*)(phg + (size_t)row * NHG + 1536 + dir * 512 + h * 128 + lpart * 8);
      if (C.tid < 128) { const int r2 = rowof(C.tid >> 2); rv = *(const u32x4*)(phg + (size_t)r2 * NHG + 512 + h * 128 + dvq * 32 + (C.tid & 3) * 8); } }
    __syncthreads();
    { LAS float* q = qs + ltok * 128 + lpart * 8; LAS float* k = ks + ltok * 128 + lpart * 8;
      q[0] = bflo(rq.x); q[1] = bfhi(rq.x); q[2] = bflo(rq.y); q[3] = bfhi(rq.y); q[4] = bflo(rq.z); q[5] = bfhi(rq.z); q[6] = bflo(rq.w); q[7] = bfhi(rq.w);
      k[0] = bflo(rk.x); k[1] = bfhi(rk.x); k[2] = bflo(rk.y); k[3] = bfhi(rk.y); k[4] = bflo(rk.z); k[5] = bfhi(rk.z); k[6] = bflo(rk.w); k[7] = bfhi(rk.w);
      if (C.tid < 128) { LAS float* vv = vs + (C.tid >> 2) * 32 + (C.tid & 3) * 8;
        vv[0] = bflo(rv.x); vv[1] = bfhi(rv.x); vv[2] = bflo(rv.y); vv[3] = bfhi(rv.y); vv[4] = bflo(rv.z); vv[5] = bfhi(rv.z); vv[6] = bflo(rv.w); vv[7] = bfhi(rv.w); } }
    __syncthreads();
    constexpr int NCH = (CTXL + SEQ) / 32;
#pragma unroll 1
    for (int ch = 0; ch < NCH; ++ch) {
        const int buf = ch & 1;
        if (ch + 1 < NCH) { const int row = rowof((ch + 1) * 32 + ltok);
            rq = *(const u32x4*)(phg + (size_t)row * NHG + h * 128 + lpart * 8); rk = *(const u32x4*)(phg + (size_t)row * NHG + 1536 + dir * 512 + h * 128 + lpart * 8);
            if (C.tid < 128) { const int r2 = rowof((ch + 1) * 32 + (C.tid >> 2)); rv = *(const u32x4*)(phg + (size_t)r2 * NHG + 512 + h * 128 + dvq * 32 + (C.tid & 3) * 8); } }
        const LAS float* qb = qs + buf * 4096 + kg * 8; const LAS float* kb = ks + buf * 4096 + kg * 8; const LAS float* vb = vs + buf * 1024 + j; LAS float* ob = os + buf * 1024 + j;
#pragma unroll 4
        for (int s = 0; s < 32; ++s) {
            const f32x4 q0 = *(const LAS f32x4*)(qb + s * 128), q1 = *(const LAS f32x4*)(qb + s * 128 + 4), k0 = *(const LAS f32x4*)(kb + s * 128), k1 = *(const LAS f32x4*)(kb + s * 128 + 4);
            const float vv = vb[s * 32];
            float o = 0.f;
#pragma unroll
            for (int i = 0; i < 4; ++i) { S[i] += k0[i] * (vv - S[i]); o += q0[i] * S[i]; S[4 + i] += k1[i] * (vv - S[4 + i]); o += q1[i] * S[4 + i]; }
            o = row16_sum(o);
            if (kg == 0) ob[s * 32] = o;
        }
        if (ch + 1 < NCH) { LAS float* q = qs + (buf ^ 1) * 4096 + ltok * 128 + lpart * 8; LAS float* k = ks + (buf ^ 1) * 4096 + ltok * 128 + lpart * 8;
            q[0] = bflo(rq.x); q[1] = bfhi(rq.x); q[2] = bflo(rq.y); q[3] = bfhi(rq.y); q[4] = bflo(rq.z); q[5] = bfhi(rq.z); q[6] = bflo(rq.w); q[7] = bfhi(rq.w);
            k[0] = bflo(rk.x); k[1] = bfhi(rk.x); k[2] = bflo(rk.y); k[3] = bfhi(rk.y); k[4] = bflo(rk.z); k[5] = bfhi(rk.z); k[6] = bflo(rk.w); k[7] = bfhi(rk.w);
            if (C.tid < 128) { LAS float* vv = vs + (buf ^ 1) * 1024 + (C.tid >> 2) * 32 + (C.tid & 3) * 8;
                vv[0] = bflo(rv.x); vv[1] = bfhi(rv.x); vv[2] = bflo(rv.y); vv[3] = bfhi(rv.y); vv[4] = bflo(rv.z); vv[5] = bfhi(rv.z); vv[6] = bflo(rv.w); vv[7] = bfhi(rv.w); } }
        __syncthreads();
        { const int i2 = C.tid * 2, tok = i2 >> 5, jx = i2 & 31; const int row = rowof(ch * 32 + tok);
            const LAS float* op = os + buf * 1024 + tok * 32 + jx;
            *(unsigned*)(odir + (size_t)row * 512 + h * 128 + dvq * 32 + jx) = pk2(op[0], op[1]); }
    }
    __syncthreads();
}
__device__ __forceinline__ void phase_l3(const Ctx& C, int l) {
    build_twiddles(C, (LAS f32x2*)C.lds);
    __syncthreads();
    for (int item = C.bid; item < 256; item += C.G) hyena_lat(C, l, item);
    if (l < DEPTH - 1) for (int c = C.bid; c < 512; c += C.G) hyena_ctx(C, l, c);
    __syncthreads();
    for (int item = C.bid; item < 256; item += C.G) hgrn_scan(C, item);
}
__device__ __forceinline__ void phase_l3b(const Ctx& C, int l) {
    const int gw = C.bid * NWAVES + C.wave, NGW = C.G * NWAVES;
    const bf16_t* od0 = WSP(const bf16_t, WS_ODIR); const bf16_t* od1 = od0 + (size_t)NTOK * 512;
    const bf16_t* phg = WSP(const bf16_t, WS_PHG); bf16_t* Y = WSP(bf16_t, WS_R1);
    const float* nw = C.in[IN_NORMW] + l * 128;
    const int nrows = (l < DEPTH - 1) ? NTOK : NLAT;
    for (int row = gw; row < nrows; row += NGW) {
        const int idx = C.lane * 8;
        const u32x4 a = *(const u32x4*)(od0 + (size_t)row * 512 + idx), b = *(const u32x4*)(od1 + (size_t)row * 512 + idx), g = *(const u32x4*)(phg + (size_t)row * NHG + 1024 + idx);
        float o[8] = {bflo(a.x) + bflo(b.x), bfhi(a.x) + bfhi(b.x), bflo(a.y) + bflo(b.y), bfhi(a.y) + bfhi(b.y), bflo(a.z) + bflo(b.z), bfhi(a.z) + bfhi(b.z), bflo(a.w) + bflo(b.w), bfhi(a.w) + bfhi(b.w)};
        const float gg[8] = {bflo(g.x), bfhi(g.x), bflo(g.y), bfhi(g.y), bflo(g.z), bfhi(g.z), bflo(g.w), bfhi(g.w)};
        float ss = 0.f;
#pragma unroll
        for (int i = 0; i < 8; ++i) ss += o[i] * o[i];
        ss = row16_sum(ss);
        const float rinv = 1.0f / sqrtf(ss * (1.0f / 128.0f) + EPS);
        float y[8];
#pragma unroll
        for (int i = 0; i < 8; ++i) y[i] = o[i] * rinv * nw[(idx + i) & 127] * siluf_(gg[i]);
        u32x4 w; w.x = pk2(y[0], y[1]); w.y = pk2(y[2], y[3]); w.z = pk2(y[4], y[5]); w.w = pk2(y[6], y[7]);
        *(u32x4*)(Y + (size_t)row * D + 512 + idx) = w;
    }
}

__device__ __forceinline__ void phase_l5a(const Ctx& C, int l) {
    LAS float* rwT = (LAS float*)C.lds;
    const float* rw = C.in[IN_RW];
    for (int i = C.tid; i < 16 * 1024; i += NTHR) { const int k = i >> 4, e = i & 15; rwT[e * 1024 + k] = rw[i]; }
    __syncthreads();
    const int gw = C.bid * NWAVES + C.wave, NGW = C.G * NWAVES;
    const float* mods = WSP(const float, WS_MODS) + (size_t)l * 9 * 6144;
    const float* xb = WSP(const float, WS_XBUF);
    const float* rbias = C.in[IN_RB];
    unsigned* cnt = WSP(unsigned, WS_CTL) + CW_CNT + l * 64;
    int* tokinfo = WSP(int, WS_TOKINFO);
    const int nrows = (l < DEPTH - 1) ? NTOK : NLAT;
    for (int row = gw; row < nrows; row += NGW) {
        const float* src = xb + (size_t)row * D; const float* md = mods + bidx(row) * 6144;
        f32x4 v[4]; float ss = 0.f;
#pragma unroll
        for (int j = 0; j < 4; ++j) { v[j] = *(const f32x4*)(src + C.lane * 4 + 256 * j); ss += (v[j].x * v[j].x + v[j].y * v[j].y) + (v[j].z * v[j].z + v[j].w * v[j].w); }
        ss = wave_sum(ss); const float rinv = 1.0f / sqrtf(ss * (1.0f / D) + EPS);
        float lg[16];
#pragma unroll
        for (int e = 0; e < 16; ++e) lg[e] = 0.f;
#pragma unroll
        for (int j = 0; j < 4; ++j) { const int k = C.lane * 4 + 256 * j; const f32x4 sh = *(const f32x4*)(md + 3072 + k), sc = *(const f32x4*)(md + 4096 + k);
            const f32x4 hh = v[j] * rinv * (sc + 1.0f) + sh;
#pragma unroll
            for (int e = 0; e < 16; ++e) { const f32x4 w = *(const LAS f32x4*)(rwT + e * 1024 + k); lg[e] += hh.x * w.x + hh.y * w.y + hh.z * w.z + hh.w * w.w; } }
#pragma unroll
        for (int e = 0; e < 16; ++e) lg[e] = wave_sum(lg[e]);
        float mx = lg[0];
#pragma unroll
        for (int e = 1; e < 16; ++e) mx = fmaxf(mx, lg[e]);
        float sc[16], se = 0.f;
#pragma unroll
        for (int e = 0; e < 16; ++e) { sc[e] = expf(lg[e] - mx); se += sc[e]; }
        float sel[16];
#pragma unroll
        for (int e = 0; e < 16; ++e) { sc[e] = sc[e] / se; sel[e] = sc[e] + rbias[e]; }
        float bestgs = -3.4e38f; int bg = 0; float bs[4], bsc[4];
#pragma unroll
        for (int g = 0; g < 4; ++g) {
            float m1 = -3.4e38f, m2 = -3.4e38f;
#pragma unroll
            for (int i = 0; i < 4; ++i) { const float x = sel[4 * g + i]; if (x > m1) { m2 = m1; m1 = x; } else if (x > m2) m2 = x; }
            const float gs = m1 + m2;
            if (gs > bestgs) { bestgs = gs; bg = g;
#pragma unroll
                for (int i = 0; i < 4; ++i) { bs[i] = sel[4 * g + i]; bsc[i] = sc[4 * g + i]; } }
        }
        int i0 = 0; float b0 = bs[0];
#pragma unroll
        for (int i = 1; i < 4; ++i) if (bs[i] > b0) { b0 = bs[i]; i0 = i; }
        int i1 = -1; float b1 = -3.4e38f;
#pragma unroll
        for (int i = 0; i < 4; ++i) if (i != i0 && bs[i] > b1) { b1 = bs[i]; i1 = i; }
        float w0 = 0.f, w1 = 0.f;
#pragma unroll
        for (int i = 0; i < 4; ++i) { if (i == i0) w0 = bsc[i]; if (i == i1) w1 = bsc[i]; }
        const float wn = w0 + w1; w0 /= wn; w1 /= wn;
        const int lo = i0 < i1 ? i0 : i1, hi = i0 < i1 ? i1 : i0;
        const float wlo = i0 < i1 ? w0 : w1, whi = i0 < i1 ? w1 : w0;
        const int bin = bg * 6 + (lo * (7 - lo)) / 2 + (hi - lo - 1);
        if (C.lane == 0) { const unsigned slot = atomicAdd(cnt + bin, 1u);
            *(int4*)(tokinfo + (size_t)row * 4) = make_int4(bin, (int)slot, __float_as_int(wlo), __float_as_int(whi)); }
    }
}
__device__ __forceinline__ void phase_l5b(const Ctx& C, int l) {
    build_tiletab(C, l);
    const volatile LAS int* lc = (const volatile LAS int*)(C.lds + LDSCTL_OFF);
    const int gw = C.bid * NWAVES + C.wave, NGW = C.G * NWAVES;
    const float* mods = WSP(const float, WS_MODS) + (size_t)l * 9 * 6144;
    const float* xb = WSP(const float, WS_XBUF);
    const int* tokinfo = WSP(const int, WS_TOKINFO);
    bf16_t* hs = WSP(bf16_t, WS_PHG); int* rowtok = WSP(int, WS_ROWTOK); float* roww = WSP(float, WS_ROWW);
    const int nrows = (l < DEPTH - 1) ? NTOK : NLAT;
    for (int row = gw; row < nrows; row += NGW) {
        const int4 ti = *(const int4*)(tokinfo + (size_t)row * 4);
        const int pos = lc[LC_OFFS + ti.x] + ti.y;
        const float* src = xb + (size_t)row * D; const float* md = mods + bidx(row) * 6144;
        f32x4 v[4]; float ss = 0.f;
#pragma unroll
        for (int j = 0; j < 4; ++j) { v[j] = *(const f32x4*)(src + C.lane * 4 + 256 * j); ss += (v[j].x * v[j].x + v[j].y * v[j].y) + (v[j].z * v[j].z + v[j].w * v[j].w); }
        ss = wave_sum(ss); const float rinv = 1.0f / sqrtf(ss * (1.0f / D) + EPS);
#pragma unroll
        for (int j = 0; j < 4; ++j) { const int k = C.lane * 4 + 256 * j; const f32x4 sh = *(const f32x4*)(md + 3072 + k), sc = *(const f32x4*)(md + 4096 + k);
            const f32x4 o = v[j] * rinv * (sc + 1.0f) + sh; u32x2 w; w.x = pk2(o.x, o.y); w.y = pk2(o.z, o.w);
            *(u32x2*)(hs + (size_t)pos * D + k) = w; }
        if (C.lane == 0) { rowtok[pos] = row; roww[pos * 2] = __int_as_float(ti.z); roww[pos * 2 + 1] = __int_as_float(ti.w); }
    }
    if (C.bid < NBIN) { const int b = C.bid; const int start = lc[LC_OFFS + b], end = lc[LC_OFFS + b + 1];
        const int n = (int)__hip_atomic_load(WSP(unsigned, WS_CTL) + CW_CNT + l * 64 + b, __ATOMIC_RELAXED, __HIP_MEMORY_SCOPE_AGENT);
        for (int p = start + n + C.tid; p < end; p += NTHR) { rowtok[p] = -1; roww[p * 2] = 0.f; roww[p * 2 + 1] = 0.f; } }
}

__device__ __forceinline__ void phase_final(const Ctx& C) {
    const int gw = C.bid * NWAVES + C.wave, NGW = C.G * NWAVES;
    const float* xb = WSP(const float, WS_XBUF); const float* fw = C.in[IN_FNW];
    for (int row = gw; row < NLAT; row += NGW) {
        const float* src = xb + (size_t)row * D;
        f32x4 v[4]; float ss = 0.f;
#pragma unroll
        for (int j = 0; j < 4; ++j) { v[j] = *(const f32x4*)(src + C.lane * 4 + 256 * j); ss += (v[j].x * v[j].x + v[j].y * v[j].y) + (v[j].z * v[j].z + v[j].w * v[j].w); }
        ss = wave_sum(ss); const float rinv = 1.0f / sqrtf(ss * (1.0f / D) + EPS);
#pragma unroll
        for (int j = 0; j < 4; ++j) { const int k = C.lane * 4 + 256 * j; const f32x4 w = *(const f32x4*)(fw + k);
            *(f32x4*)(C.out + (size_t)row * D + k) = v[j] * rinv * w; }
    }
}

constexpr int PH_PER_LAYER = 9, N_PHASES = 1 + DEPTH * PH_PER_LAYER + 1;
__global__ void __launch_bounds__(NTHR, 2) trunk_fwd(Args args) {
    extern __shared__ __attribute__((aligned(16))) unsigned char lds[];
    Ctx C; C.in = (const CAS fptr_t*)__builtin_amdgcn_kernarg_segment_ptr(); C.out = args.out; C.ws = args.ws; C.lds = (LAS unsigned char*)lds;
    C.tid = threadIdx.x; C.lane = C.tid & 63; C.wave = __builtin_amdgcn_readfirstlane(C.tid >> 6); C.G = gridDim.x; C.bid = blockIdx.x;
    LAS unsigned char* ldsl0 = (LAS unsigned char*)lds;
    if (C.tid < 64) ((LAS unsigned*)(ldsl0 + LDSCTL_OFF))[C.tid] = 0u;
    __syncthreads();
    const int lo = args.ph_lo, hi = args.ph_hi;
    XcdBarrier bar; bar.bar = WSP(unsigned, WS_CTL) + CW_BAR; bar.x = 0; bar.st = (volatile LAS unsigned*)(ldsl0 + LDSCTL_OFF + LC_BAR);
    if (hi - lo > 1) bar = xcd_barrier_post(WSP(unsigned, WS_CTL) + CW_BAR, (volatile LAS unsigned*)(ldsl0 + LDSCTL_OFF + LC_BAR));
#define IN(k) (lo <= (k) && (k) < hi)
#define SEAM(k) do { if (IN(k) && IN((k) + 1)) xcd_barrier(bar); } while (0)
#ifndef EN
#define EN 0xFFFF
#endif
    if ((EN & 1) && IN(0)) { phase0(C); SEAM(0); }
    const Ctx C0 = C;
#pragma unroll 1
    for (int l = 0; l < DEPTH; ++l) {
        const int p0 = 1 + l * PH_PER_LAYER;
        Ctx C = C0; { int t_ = C0.tid; asm volatile("" : "+v"(t_)); C.tid = t_; C.lane = t_ & 63; C.wave = __builtin_amdgcn_readfirstlane(t_ >> 6);
                      int b_ = C0.bid; asm volatile("" : "+s"(b_)); C.bid = b_; int g_ = C0.G; asm volatile("" : "+s"(g_)); C.G = g_; unsigned char* w_ = C0.ws; asm volatile("" : "+s"(w_)); C.ws = w_;
                      const CAS fptr_t* i_ = C0.in; asm volatile("" : "+s"(i_)); C.in = i_;
                      LAS unsigned char* l_ = C0.lds; asm volatile("" : "+s"(l_)); C.lds = l_; }
        LAS unsigned char* const ldsl = C.lds;
        const float* modl = WSP(const float, WS_MODS) + (size_t)l * 9 * 6144;
        if ((EN & 2) && IN(p0 + 0)) { phase_l1(C, l); SEAM(p0 + 0); }
        if ((EN & 4) && IN(p0 + 1)) {
            { pg8::SchedDense S; S.init(NTOK / 256, NHG / 256, C.G, C.bid, D, D);
              EpiHG E{WSP(bf16_t, WS_PHG), WSP(const float, WS_LOWER) + l * 512};
              pg8::gemm_phase<false>(ldsl, S, E, (const char*)WSP(bf16_t, WS_R1), (const char*)(WSP(bf16_t, WS_WIN) + (size_t)NHY * D), D, D, 128u * D * 2u, 128u * D * 2u, D / 64); }
            { pg8::SchedDense S; S.init(NHY / 256, NTOK / 256, C.G, C.bid, D, D);
              EpiHY E{WSP(bf16_t, WS_PHYT)};
              pg8::gemm_phase<false>(ldsl, S, E, (const char*)WSP(bf16_t, WS_WIN), (const char*)WSP(bf16_t, WS_R1), D, D, 128u * D * 2u, 128u * D * 2u, D / 64); }
            SEAM(p0 + 1);
        }
        if ((EN & 8) && IN(p0 + 2)) { phase_l3(C, l); SEAM(p0 + 2); }
        if ((EN & 16) && IN(p0 + 3)) { phase_l3b(C, l); SEAM(p0 + 3); }
        if ((EN & 32) && IN(p0 + 4)) {
            pg8::SchedDense S; S.init(NTOK / 256, D / 256, C.G, C.bid, D, D);
            EpiOut E{C.in[IN_X], C.in[IN_CTX], WSP(float, WS_XBUF), modl, l == 0 ? 1 : 0};
            pg8::gemm_phase<false>(ldsl, S, E, (const char*)WSP(bf16_t, WS_R1), (const char*)WSP(bf16_t, WS_WOUT), D, D, 128u * D * 2u, 128u * D * 2u, D / 64);
            SEAM(p0 + 4);
        }
        if ((EN & 64) && IN(p0 + 5)) { phase_l5a(C, l); SEAM(p0 + 5); }
        if ((EN & 128) && IN(p0 + 6)) { phase_l5b(C, l); SEAM(p0 + 6); }
        if ((EN & 256) && IN(p0 + 7)) {
            build_tiletab(C, l);
            const volatile LAS int* lc = (const volatile LAS int*)(ldsl + LDSCTL_OFF);
            SchedUp S{lc[LC_T], C.G, C.bid, lc + LC_TILEBIN};
            EpiAct E{WSP(bf16_t, WS_R1), WSP(const float, WS_ROWW)};
            pg8::gemm_phase<false>(ldsl, S, E, (const char*)WSP(bf16_t, WS_PHG), (const char*)WSP(bf16_t, WS_WG), D, D, 128u * D * 2u, (unsigned)(WS_WU - WS_WG), D / 64);
            SEAM(p0 + 7);
        }
        if ((EN & 512) && IN(p0 + 8)) {
            build_tiletab(C, l);
            const volatile LAS int* lc = (const volatile LAS int*)(ldsl + LDSCTL_OFF);
            SchedDown S{lc[LC_T], C.G, C.bid, lc + LC_TILEBIN};
            EpiDown E{WSP(float, WS_XBUF), WSP(const int, WS_ROWTOK), modl};
            pg8::gemm_phase<true>(ldsl, S, E, (const char*)WSP(bf16_t, WS_R1), (const char*)WSP(bf16_t, WS_WD), 512, 256, 128u * 512u * 2u, 128u * 256u * 2u, 4);
            SEAM(p0 + 8);
        }
    }
    if ((EN & 1024) && IN(N_PHASES - 1)) phase_final(C);
#undef IN
#undef SEAM
}

extern "C" void kernel_launch(void* const* d_in, const int* in_sizes, int n_in, void* d_out, int out_size, void* d_ws, size_t ws_size, hipStream_t stream) {
    static int grid = 0;
    if (grid == 0) {
        if (n_in != N_IN || in_sizes[0] != NLAT * D || out_size != NLAT * D || ws_size < WS_END) { fprintf(stderr, "kernel_launch: unexpected shapes / workspace (%d inputs, ws %zu < %zu)\n", n_in, ws_size, (size_t)WS_END); grid = -1; return; }
        int dev = 0, cus = 0, per_cu = 0;
        if (hipGetDevice(&dev) != hipSuccess || hipDeviceGetAttribute(&cus, hipDeviceAttributeMultiprocessorCount, dev) != hipSuccess) { grid = -1; return; }
        if (hipFuncSetAttribute((const void*)trunk_fwd, hipFuncAttributeMaxDynamicSharedMemorySize, LDS_BYTES) != hipSuccess) { fprintf(stderr, "kernel_launch: hipFuncSetAttribute failed\n"); grid = -1; return; }
        if (hipOccupancyMaxActiveBlocksPerMultiprocessor(&per_cu, (const void*)trunk_fwd, NTHR, LDS_BYTES) != hipSuccess || per_cu < 1) { fprintf(stderr, "kernel_launch: occupancy query says %d\n", per_cu); }
        (void)hipGetLastError();
        grid = cus;
    }
    if (grid < 0) return;
    (void)hipMemsetAsync((char*)d_ws + WS_CTL, 0, CTL_ZERO_BYTES, stream);
    Args a{};
    for (int i = 0; i < N_IN; ++i) a.in[i] = (const float*)d_in[i];
    a.out = (float*)d_out; a.ws = (unsigned char*)d_ws;
#if MK_PER_PHASE
    for (int p = 0; p < N_PHASES; ++p) { a.ph_lo = p; a.ph_hi = p + 1; hipLaunchKernelGGL(trunk_fwd, dim3(grid), dim3(NTHR), LDS_BYTES, stream, a); }
#else
    a.ph_lo = 0; a.ph_hi = N_PHASES;
    hipLaunchKernelGGL(trunk_fwd, dim3(grid), dim3(NTHR), LDS_BYTES, stream, a);
#endif
}
```

```cpp
#include <hip/hip_runtime.h>
#include <cstdio>
#include <cstdint>

#ifndef MK_PER_PHASE
#define MK_PER_PHASE 0
#endif

#define LAS __attribute__((address_space(3)))
typedef unsigned short bf16_t;
typedef short bf16x8 __attribute__((ext_vector_type(8)));
typedef float f32x4 __attribute__((ext_vector_type(4)));
typedef float f32x2 __attribute__((ext_vector_type(2)));
typedef unsigned u32x4 __attribute__((ext_vector_type(4)));
typedef unsigned u32x2 __attribute__((ext_vector_type(2)));

constexpr int NB = 8, SEQ = 2048, D = 1024, DEPTH = 4, CTXL = 256;
constexpr int NLAT = NB * SEQ, NCTX = NB * CTXL, NTOK = NLAT + NCTX;
constexpr int DH = 512, NHY = 1536, NHG = 2560, DIN = 4096;
constexpr int NE = 16, DE = 256, NBIN = 24, SROWS = 24576;
constexpr float EPS = 1e-6f;
constexpr int NTHR = 512, NWAVES = 8;
enum { IN_X = 0, IN_C, IN_CTX, IN_CCTX, IN_WMOD, IN_BMOD, IN_WIN, IN_WOUT, IN_CONVW, IN_CONVB, IN_W1, IN_B1, IN_W2, IN_B2, IN_W3, IN_B3,
       IN_HYBIAS, IN_LB, IN_NORMW, IN_RW, IN_RB, IN_WG, IN_WU, IN_WD, IN_FNW, N_IN };

constexpr size_t MiB = 1u << 20;
constexpr size_t WS_CTL = 0, CTL_ZERO_BYTES = 1 * MiB;
constexpr size_t WS_MODS = 1 * MiB;
constexpr size_t WS_LOWER = 2 * MiB;
constexpr size_t WS_H2L = 3 * MiB;
constexpr size_t WS_H2C = 5 * MiB;
constexpr size_t WS_TOKINFO = 6 * MiB;
constexpr size_t WS_ROWTOK = 6 * MiB + 512 * 1024;
constexpr size_t WS_ROWW = 7 * MiB;
constexpr size_t WS_WIN = 8 * MiB;
constexpr size_t WS_WOUT = 16 * MiB;
constexpr size_t WS_WG = 18 * MiB;
constexpr size_t WS_WU = 26 * MiB;
constexpr size_t WS_WD = 34 * MiB;
constexpr size_t WS_KSPEC = 42 * MiB;
constexpr size_t WS_XBUF = 74 * MiB;
constexpr size_t WS_R1 = 146 * MiB;
constexpr size_t WS_PHG = 182 * MiB;
constexpr size_t WS_PHYT = 272 * MiB;
constexpr size_t WS_ODIR = 326 * MiB;
constexpr size_t WS_KSPC = 362 * MiB;
constexpr size_t WS_END = 378 * MiB;
constexpr int CW_BAR = 4096;
constexpr int CW_CNT = 16384;
constexpr int CW_Q = 20480;

constexpr int LDS_BYTES = 147456;
constexpr int LDSCTL_OFF = 143 * 1024;
constexpr int LC_BAR = 0;
constexpr int LC_T = 8;
constexpr int LC_Q = 9;
constexpr int LC_OFFS = 16;
constexpr int LC_TILEBIN = 48;

__device__ __forceinline__ unsigned f2bf(float f) { unsigned u = __builtin_bit_cast(unsigned, f); return (u + 0x7fffu + ((u >> 16) & 1u)) >> 16; }
__device__ __forceinline__ unsigned pk2(float lo, float hi) { return f2bf(lo) | (f2bf(hi) << 16); }
__device__ __forceinline__ float bf2f(unsigned b) { return __builtin_bit_cast(float, (b & 0xffffu) << 16); }
__device__ __forceinline__ float bflo(unsigned w) { return __builtin_bit_cast(float, w << 16); }
__device__ __forceinline__ float bfhi(unsigned w) { return __builtin_bit_cast(float, w & 0xffff0000u); }
__device__ __forceinline__ float sigmoidf_(float x) { return 1.0f / (1.0f + __expf(-x)); }
__device__ __forceinline__ float siluf_(float x) { return x / (1.0f + __expf(-x)); }
#define DPP_ADD(v, ctrl, rmask) v += __builtin_bit_cast(float, __builtin_amdgcn_update_dpp(0, __builtin_bit_cast(int, v), ctrl, rmask, 0xF, false))
__device__ __forceinline__ float row16_sum(float v) {
    DPP_ADD(v, 0xB1, 0xF);
    DPP_ADD(v, 0x4E, 0xF);
    DPP_ADD(v, 0x141, 0xF);
    DPP_ADD(v, 0x140, 0xF);
    return v;
}
__device__ __forceinline__ float wave_sum(float v) {
    v = row16_sum(v);
    DPP_ADD(v, 0x142, 0xA);
    DPP_ADD(v, 0x143, 0xC);
    return __builtin_bit_cast(float, __builtin_amdgcn_readlane(__builtin_bit_cast(int, v), 63));
}
__device__ __forceinline__ int bidx(int row) { return row < NLAT ? (row >> 11) : 8; }
#define LDS_WAIT() asm volatile("s_waitcnt lgkmcnt(0)" ::: "memory")

#define XB_TMO      128
#define XB_XCNT(j)  (256  + 64 * (j))
#define XB_XSUB(j)  (1280 + 64 * (j))
#define XB_XGEN(j)  (2304 + 64 * (j))
#define XB_TOP      3328
#define XB_TOPGEN   3392
#define XCD_BAR_WORDS 3456
#define XB_SPIN_CAP (1u << 18)
__device__ __forceinline__ unsigned xb_ld(unsigned* p)              { return __hip_atomic_load(p, __ATOMIC_RELAXED, __HIP_MEMORY_SCOPE_AGENT); }
__device__ __forceinline__ unsigned xb_add(unsigned* p, unsigned v) { return __hip_atomic_fetch_add(p, v, __ATOMIC_RELAXED, __HIP_MEMORY_SCOPE_AGENT); }
__device__ __forceinline__ unsigned xb_xcc_id() { return (unsigned)__builtin_amdgcn_s_getreg((3 << 11) | 20) & 0xFu; }
#define XB_SPIN(cond, bar) do { unsigned _sp = 0; while (cond) { __builtin_amdgcn_s_sleep(1); \
    if ((++_sp & 255u) == 0u) { if (xb_ld(&(bar)[XB_TMO])) break; if (_sp > XB_SPIN_CAP) { atomicAdd(&(bar)[XB_TMO], 1u); break; } } } } while (0)
struct XcdBarrier { unsigned* bar; unsigned x; volatile LAS unsigned* st; };
__device__ __forceinline__ XcdBarrier xcd_barrier_post(unsigned* bar, volatile LAS unsigned* st) {
    XcdBarrier b; b.bar = bar; b.x = xb_xcc_id(); b.st = st;
    if (threadIdx.x == 0) (void)xb_add(&bar[XB_XCNT(b.x)], 1u);
    return b;
}
__device__ __forceinline__ void xcd_barrier_complete(unsigned* bar, unsigned x, unsigned& nloc, unsigned& nx) {
    const unsigned G = gridDim.x * gridDim.y * gridDim.z;
    unsigned sum, cnt, mine, sp = 0u;
    for (;;) {
        sum = 0u; cnt = 0u; mine = 0u;
#pragma unroll
        for (unsigned j = 0; j < 16; ++j) { const unsigned c = xb_ld(&bar[XB_XCNT(j)]); sum += c; cnt += (c > 0u) ? 1u : 0u; mine = (j == x) ? c : mine; }
        if (sum == G) break;
        __builtin_amdgcn_s_sleep(1);
        if ((++sp & 255u) == 0u) { if (xb_ld(&bar[XB_TMO])) break; if (sp > XB_SPIN_CAP) { atomicAdd(&bar[XB_TMO], 1u); break; } }
    }
    nloc = mine > 0u ? mine : 1u; nx = cnt > 0u ? cnt : 1u;
}
__device__ __forceinline__ void xcd_barrier(const XcdBarrier& b) {
    asm volatile("s_waitcnt vmcnt(0)" ::: "memory");
    __syncthreads();
    if (threadIdx.x == 0) {
        unsigned* bar = b.bar; unsigned bx = b.x;
        asm volatile("" : "+s"(bar), "+s"(bx));
        __builtin_amdgcn_s_waitcnt(0);
        unsigned nloc = b.st[0], nx = b.st[1];
        if (nloc == 0u) { xcd_barrier_complete(bar, bx, nloc, nx); b.st[0] = nloc; b.st[1] = nx; }
        const unsigned old = xb_add(&bar[XB_XSUB(bx)], 1u);
        const unsigned gen = old / nloc;
        if (old + 1u == (gen + 1u) * nloc) {
            __builtin_amdgcn_fence(__ATOMIC_RELEASE, "agent");
            asm volatile("s_waitcnt vmcnt(0)" ::: "memory");
            const unsigned og = xb_add(&bar[XB_TOP], 1u);
            const unsigned tg = og / nx;
            if (og + 1u == (tg + 1u) * nx) xb_add(&bar[XB_TOPGEN], 1u);
            else XB_SPIN(xb_ld(&bar[XB_TOPGEN]) == tg, bar);
            __builtin_amdgcn_fence(__ATOMIC_ACQUIRE, "agent");
            xb_add(&bar[XB_XGEN(bx)], 1u);
            asm volatile("s_waitcnt vmcnt(0)" ::: "memory");
        } else {
            XB_SPIN(xb_ld(&bar[XB_XGEN(bx)]) == gen, bar);
            __builtin_amdgcn_fence(__ATOMIC_ACQUIRE, "agent");
            asm volatile("s_waitcnt vmcnt(0)" ::: "memory");
        }
    }
    __syncthreads();
}

namespace pg8 {
constexpr int BM = 256, BK = 64, HALF = 128, HTB = HALF * BK * 2, STAGE_BYTES = 8 * HTB, NXCD = 8, WGM = 8;
__host__ __device__ __forceinline__ int lds_byte(int r, int c) { const int st = (r >> 4) * 2 + (c >> 5), rr = r & 15, cc = c & 31, ob = rr * 64 + cc * 2; return st * 1024 + (ob ^ (((ob >> 9) & 1) << 5)); }
__host__ __device__ __forceinline__ void stage_rc(int b, int& R, int& C) { const int st = b / 1024, sb = b % 1024, swz = sb ^ (((sb >> 9) & 1) << 5); R = (st >> 1) * 16 + swz / 64; C = (st & 1) * 32 + (swz % 64) / 2; }
__host__ __device__ __forceinline__ int perm32(int rho) { const int n = rho >> 4, i = rho & 15; return 8 * (i >> 2) + 4 * n + (i & 3); }

struct GUnit { unsigned a, b; int last, i0, i1; };

template <bool SUB, class Epi, class Sched>
__device__ __forceinline__ void gemm_phase(LAS unsigned char* lds, const Sched& S, const Epi& E, const char* Abase, const char* Bbase, const int lda, const int ldb, const unsigned ahalf, const unsigned bhalf, const int nt) {
    int tid_ = threadIdx.x; asm volatile("" : "+v"(tid_));
    const int tid = tid_, wid = __builtin_amdgcn_readfirstlane(tid >> 6), lane = tid & 63, wr = wid >> 2, wc = wid & 3, fr = lane & 15, fq = lane >> 4;
    unsigned voffA[2], voffB[2];
#pragma unroll
    for (int i = 0; i < 2; ++i) { int R, C; stage_rc(tid * 16 + i * 8192, R, C); const int Rb = Epi::PERM ? ((R & ~31) + perm32(R & 31)) : R;
        voffA[i] = (unsigned)(R * lda + C) * 2u; voffB[i] = (unsigned)(Rb * ldb + C) * 2u; }
    constexpr unsigned kstep = BK * 2;
    const unsigned ldsw = (unsigned)wid * 1024u;
    const int aoff = lds_byte(wr * 64 + fr, fq * 8), boff = lds_byte(wc * 32 + fr, fq * 8);
#define PG8_SA(b, h) (((b) * 2 + (h)) * HTB)
#define PG8_SB(b, h) ((4 + (b) * 2 + (h)) * HTB)
#define PG8_STAGE(bufoff, gbase, voff) do { _Pragma("unroll") for (int _i = 0; _i < 2; ++_i) \
        __builtin_amdgcn_global_load_lds((const unsigned*)((const char*)(gbase) + (voff)[_i]), (LAS unsigned*)(lds + (bufoff) + ldsw + _i * 8192), 16, 0, 0); } while (0)
#define PG8_LDA(dst, b, h) do { _Pragma("unroll") for (int m = 0; m < 4; ++m) _Pragma("unroll") for (int k = 0; k < 2; ++k) dst[m][k] = *(const LAS bf16x8*)(lds + PG8_SA(b, h) + aoff + m * 2048 + k * 1024); } while (0)
#define PG8_LDB(dst, b, h) do { _Pragma("unroll") for (int n = 0; n < 2; ++n) _Pragma("unroll") for (int k = 0; k < 2; ++k) dst[n][k] = *(const LAS bf16x8*)(lds + PG8_SB(b, h) + boff + n * 2048 + k * 1024); } while (0)
#define PG8_MMA(ai, bj, At, Bt) do { __builtin_amdgcn_s_setprio(1); _Pragma("unroll") for (int m = 0; m < 4; ++m) _Pragma("unroll") for (int n = 0; n < 2; ++n) _Pragma("unroll") for (int k = 0; k < 2; ++k) \
        acc[ai][bj][m][n] = __builtin_amdgcn_mfma_f32_16x16x32_bf16(Bt[n][k], At[m][k], acc[ai][bj][m][n], 0, 0, 0); __builtin_amdgcn_s_setprio(0); } while (0)
#define PG8_WAIT_V(n) asm volatile("s_waitcnt vmcnt(" #n ")" ::: "memory")
#define PG8_WAIT_L(n) asm volatile("s_waitcnt lgkmcnt(" #n ")" ::: "memory")
#define PG8_BAR __builtin_amdgcn_s_barrier()
#define PG8_SCHED __builtin_amdgcn_sched_barrier(0)
    GUnit cur, nxt; int ui = 0;
    if (!S.next(0, cur)) return;
    f32x4 acc[2][2][4][2];
#pragma unroll
    for (int a = 0; a < 2; ++a)
#pragma unroll
        for (int b = 0; b < 2; ++b)
#pragma unroll
            for (int m = 0; m < 4; ++m)
#pragma unroll
                for (int n = 0; n < 2; ++n) acc[a][b][m][n] = (f32x4){0.f, 0.f, 0.f, 0.f};
    bf16x8 At[4][2], B0[2][2], B1[2][2];
    { const char* cA = Abase + cur.a; const char* cB = Bbase + cur.b;
      PG8_STAGE(PG8_SB(0, 0), cB, voffB); PG8_STAGE(PG8_SB(0, 1), cB + bhalf, voffB); PG8_STAGE(PG8_SA(0, 0), cA, voffA); PG8_STAGE(PG8_SA(0, 1), cA + ahalf, voffA);
      if (wr == 1) PG8_BAR;
      PG8_WAIT_V(2); PG8_BAR;
      PG8_STAGE(PG8_SB(1, 0), cB + kstep, voffB); PG8_STAGE(PG8_SA(1, 0), cA + kstep, voffA); PG8_STAGE(PG8_SB(1, 1), cB + bhalf + kstep, voffB);
      PG8_WAIT_V(6); PG8_BAR; }
    for (;;) {
        const bool has_next = S.next(ui + 1, nxt);
        const char* cA = Abase + cur.a; const char* cB = Bbase + cur.b;
        const char* nA = Abase + (has_next ? nxt.a : cur.a); const char* nB = Bbase + (has_next ? nxt.b : cur.b);
        for (int t = 0; t < nt; t += 2) {
            const bool last = (t == nt - 2);
            const char* a1 = cA + (unsigned)(t + 1) * kstep;
            const char* a2 = last ? nA : cA + (unsigned)(t + 2) * kstep; const char* b2 = last ? nB : cB + (unsigned)(t + 2) * kstep;
            const char* a3 = a2 + kstep; const char* b3 = b2 + kstep;
            PG8_LDB(B0, 0, 0); PG8_LDB(B1, 0, 1); PG8_SCHED; PG8_LDA(At, 0, 0); PG8_STAGE(PG8_SA(1, 1), a1 + ahalf, voffA);
            PG8_WAIT_V(8); PG8_WAIT_L(0); PG8_BAR; PG8_MMA(0, 0, At, B0); PG8_MMA(0, 1, At, B1); PG8_BAR; PG8_SCHED;
            PG8_LDA(At, 0, 1); PG8_STAGE(PG8_SB(0, 0), b2, voffB); PG8_STAGE(PG8_SB(0, 1), b2 + bhalf, voffB); PG8_STAGE(PG8_SA(0, 0), a2, voffA);
            PG8_WAIT_V(8); PG8_WAIT_L(0); PG8_BAR; PG8_MMA(1, 0, At, B0); PG8_MMA(1, 1, At, B1); PG8_BAR; PG8_SCHED;
            PG8_LDB(B0, 1, 0); PG8_LDB(B1, 1, 1); PG8_SCHED; PG8_LDA(At, 1, 0); PG8_STAGE(PG8_SA(0, 1), a2 + ahalf, voffA);
            PG8_WAIT_V(8); PG8_WAIT_L(0); PG8_BAR; PG8_MMA(0, 0, At, B0); PG8_MMA(0, 1, At, B1); PG8_BAR; PG8_SCHED;
            PG8_LDA(At, 1, 1); PG8_STAGE(PG8_SB(1, 0), b3, voffB); PG8_STAGE(PG8_SB(1, 1), b3 + bhalf, voffB); PG8_STAGE(PG8_SA(1, 0), a3, voffA);
            PG8_WAIT_V(8); PG8_WAIT_L(0); PG8_BAR; PG8_MMA(1, 0, At, B0); PG8_MMA(1, 1, At, B1); PG8_BAR; PG8_SCHED;
        }
        const bool fin = SUB ? (cur.last != 0) : true;
        if (fin) { if (wr == 0) PG8_BAR; E(acc, cur, wr, wc, fr, fq); }
        if (!has_next) break;
        if (fin) {
#pragma unroll
            for (int a = 0; a < 2; ++a)
#pragma unroll
                for (int b = 0; b < 2; ++b)
#pragma unroll
                    for (int m = 0; m < 4; ++m)
#pragma unroll
                        for (int n = 0; n < 2; ++n) acc[a][b][m][n] = (f32x4){0.f, 0.f, 0.f, 0.f};
        }
        cur = nxt; ++ui;
        if (fin) { if (wr == 1) PG8_BAR; }
    }
    PG8_WAIT_V(0);
    PG8_BAR;
#undef PG8_SA
#undef PG8_SB
#undef PG8_STAGE
#undef PG8_LDA
#undef PG8_LDB
#undef PG8_MMA
#undef PG8_WAIT_V
#undef PG8_WAIT_L
#undef PG8_BAR
#undef PG8_SCHED
}

struct SchedDense {
    int nM, nN, nwg, G, c; unsigned atile, btile;
    __device__ __forceinline__ void init(int nM_, int nN_, int G_, int c_, int lda, int ldb) {
        nM = nM_; nN = nN_; nwg = nM * nN; G = G_; c = c_; atile = 256u * lda * 2u; btile = 256u * ldb * 2u; }
    __device__ __forceinline__ bool next(int i, GUnit& u) const {
        const int L = i * G + c; if (L >= nwg) return false;
        int wgid = L; { const int q = nwg / NXCD, r = nwg % NXCD, xcd = wgid % NXCD, off = wgid / NXCD; wgid = (xcd < r ? xcd * (q + 1) : r * (q + 1) + (xcd - r) * q) + off; }
        const int nig = WGM * nN, gid = wgid / nig, fm = gid * WGM, gsz = (nM - fm) < WGM ? (nM - fm) : WGM;
        const int pm = fm + ((wgid % nig) % gsz), pn = (wgid % nig) / gsz;
        u.a = (unsigned)pm * atile; u.b = (unsigned)pn * btile; u.last = 1; u.i0 = pm; u.i1 = pn; return true;
    }
};
}

struct Args { const float* in[N_IN]; float* out; unsigned char* ws; int ph_lo, ph_hi; };
static_assert(sizeof(Args) == N_IN * 8 + 8 + 8 + 8, "Args has no padding");

#define CAS __attribute__((address_space(4)))
typedef const float* fptr_t;
struct Ctx {
    const CAS fptr_t* in; float* out; unsigned char* ws; LAS unsigned char* lds; int tid, lane, wave, G, bid;
};
#define WSP(T, off) ((T*)(C.ws + (off)))

__device__ __forceinline__ void build_tiletab(const Ctx& C, int l) {
    volatile LAS int* lc = (volatile LAS int*)(C.lds + LDSCTL_OFF);
    __syncthreads();
    if (C.tid == 0) {
        const unsigned* cnt = WSP(const unsigned, WS_CTL) + CW_CNT + l * 64;
        int off = 0, t = 0;
        for (int b = 0; b < NBIN; ++b) {
            const int n = (int)__hip_atomic_load(cnt + b, __ATOMIC_RELAXED, __HIP_MEMORY_SCOPE_AGENT);
            lc[LC_OFFS + b] = off;
            const int nt = (n + 255) >> 8;
            for (int k = 0; k < nt; ++k) lc[LC_TILEBIN + t + k] = b;
            t += nt; off += nt * 256;
        }
        lc[LC_OFFS + NBIN] = off; lc[LC_T] = t;
    }
    __syncthreads();
}
__device__ __forceinline__ int expert_of(int bin, int es) {
    const int g = bin / 6, p = bin - g * 6;
    const int lo = p < 3 ? 0 : (p < 5 ? 1 : 2), hi = p < 3 ? p + 1 : (p < 5 ? p - 1 : 3);
    return 4 * g + (es ? hi : lo);
}

struct SchedUp {
    int T, G, c; const volatile LAS int* tilebin;
    __device__ __forceinline__ bool next(int i, pg8::GUnit& u) const {
        const int idx = i * G + c; if (idx >= 4 * T) return false;
        const int rt = idx >> 2, q = idx & 3, es = q >> 1, fb = q & 1;
        const int bin = __builtin_amdgcn_readfirstlane(tilebin[rt]);
        const int e = expert_of(bin, es);
        u.a = (unsigned)rt * 256u * 2048u; u.b = (unsigned)(e * 256 + fb * 128) * 2048u;
        u.last = 1; u.i0 = rt; u.i1 = q; return true;
    }
};
struct SchedDown {
    int T, G, c; const volatile LAS int* tilebin;
    __device__ __forceinline__ bool next(int i, pg8::GUnit& u) const {
        const int idx = (i >> 1) * G + c, sub = i & 1; if (idx >= 4 * T) return false;
        const int rt = idx >> 2, pn = idx & 3;
        const int bin = __builtin_amdgcn_readfirstlane(tilebin[rt]);
        const int e = expert_of(bin, sub);
        u.a = (unsigned)rt * 256u * 1024u + (unsigned)sub * 512u; u.b = (unsigned)(e * 1024 + pn * 256) * 512u;
        u.last = sub; u.i0 = rt; u.i1 = pn; return true;
    }
};

struct EpiHG {
    static constexpr bool PERM = true;
    bf16_t* O; const float* lower;
    __device__ __forceinline__ void operator()(const f32x4 (&acc)[2][2][4][2], const pg8::GUnit& u, int wr, int wc, int fr, int fq) const {
        const int kind = u.i1 >> 1;
        const int row0 = u.i0 * 256 + wr * 64 + fr, colt = u.i1 * 256 + wc * 32 + 8 * fq;
#pragma unroll
        for (int bj = 0; bj < 2; ++bj) {
            const int col = colt + bj * 128;
            float om[8];
#pragma unroll
            for (int j = 0; j < 8; ++j) om[j] = 1.f;
            if (kind >= 3) { const float* lb = lower + (kind - 3) * 2048 + (col & 511);
#pragma unroll
                for (int j = 0; j < 8; ++j) om[j] = 1.f - lb[j]; }
#pragma unroll
            for (int ai = 0; ai < 2; ++ai)
#pragma unroll
                for (int m = 0; m < 4; ++m) {
                    float v[8];
#pragma unroll
                    for (int j = 0; j < 8; ++j) v[j] = acc[ai][bj][m][j >> 2][j & 3];
                    if (kind == 0) {
#pragma unroll
                        for (int j = 0; j < 8; ++j) v[j] = siluf_(v[j]);
                    } else if (kind >= 3) {
#pragma unroll
                        for (int j = 0; j < 8; ++j) v[j] = om[j] * sigmoidf_(-v[j]);
                    }
                    u32x4 w; w.x = pk2(v[0], v[1]); w.y = pk2(v[2], v[3]); w.z = pk2(v[4], v[5]); w.w = pk2(v[6], v[7]);
                    *(u32x4*)(O + (size_t)(row0 + ai * 128 + m * 16) * NHG + col) = w;
                }
        }
    }
};
struct EpiHY {
    static constexpr bool PERM = true;
    bf16_t* O;
    __device__ __forceinline__ void operator()(const f32x4 (&acc)[2][2][4][2], const pg8::GUnit& u, int wr, int wc, int fr, int fq) const {
        const int row0 = u.i0 * 256 + wr * 64 + fr, colt = u.i1 * 256 + wc * 32 + 8 * fq;
#pragma unroll
        for (int ai = 0; ai < 2; ++ai)
#pragma unroll
            for (int m = 0; m < 4; ++m)
#pragma unroll
                for (int bj = 0; bj < 2; ++bj) {
                    const f32x4 v0 = acc[ai][bj][m][0], v1 = acc[ai][bj][m][1];
                    u32x4 w; w.x = pk2(v0[0], v0[1]); w.y = pk2(v0[2], v0[3]); w.z = pk2(v1[0], v1[1]); w.w = pk2(v1[2], v1[3]);
                    *(u32x4*)(O + (size_t)(row0 + ai * 128 + m * 16) * NTOK + colt + bj * 128) = w;
                }
    }
};
struct EpiOut {
    static constexpr bool PERM = false;
    const float* xlat; const float* xctx; float* xo; const float* mods; int first;
    __device__ __forceinline__ void operator()(const f32x4 (&acc)[2][2][4][2], const pg8::GUnit& u, int wr, int wc, int fr, int fq) const {
        const int row0 = u.i0 * 256 + wr * 64 + fr, col0 = u.i1 * 256 + wc * 32 + 4 * fq;
#pragma unroll
        for (int ai = 0; ai < 2; ++ai)
#pragma unroll
            for (int m = 0; m < 4; ++m) {
                const int row = row0 + ai * 128 + m * 16;
                const float* src = first ? (row < NLAT ? xlat + (size_t)row * D : xctx + (size_t)(row - NLAT) * D) : xo + (size_t)row * D;
                const float* g1 = mods + bidx(row) * 6144 + 2048;
#pragma unroll
                for (int bj = 0; bj < 2; ++bj)
#pragma unroll
                    for (int n = 0; n < 2; ++n) { const int col = col0 + bj * 128 + n * 16;
                        const f32x4 xv = *(const f32x4*)(src + col), gv = *(const f32x4*)(g1 + col);
                        *(f32x4*)(xo + (size_t)row * D + col) = xv + gv * acc[ai][bj][m][n]; }
            }
    }
};
struct EpiAct {
    static constexpr bool PERM = true;
    bf16_t* O; const float* roww;
    __device__ __forceinline__ void operator()(const f32x4 (&acc)[2][2][4][2], const pg8::GUnit& u, int wr, int wc, int fr, int fq) const {
        const int es = u.i1 >> 1; const int pos0 = u.i0 * 256 + wr * 64 + fr, col = u.i1 * 128 + wc * 32 + 8 * fq;
#pragma unroll
        for (int ai = 0; ai < 2; ++ai)
#pragma unroll
            for (int m = 0; m < 4; ++m) {
                const int pos = pos0 + ai * 128 + m * 16;
                const float wgt = roww[pos * 2 + es];
                float v[8];
#pragma unroll
                for (int j = 0; j < 8; ++j) v[j] = siluf_(acc[ai][0][m][j >> 2][j & 3]) * acc[ai][1][m][j >> 2][j & 3] * wgt;
                u32x4 w; w.x = pk2(v[0], v[1]); w.y = pk2(v[2], v[3]); w.z = pk2(v[4], v[5]); w.w = pk2(v[6], v[7]);
                *(u32x4*)(O + (size_t)pos * 512 + col) = w;
            }
    }
};
struct EpiDown {
    static constexpr bool PERM = false;
    float* xo; const int* rowtok; const float* mods;
    __device__ __forceinline__ void operator()(const f32x4 (&acc)[2][2][4][2], const pg8::GUnit& u, int wr, int wc, int fr, int fq) const {
        const int pos0 = u.i0 * 256 + wr * 64 + fr, col0 = u.i1 * 256 + wc * 32 + 4 * fq;
#pragma unroll
        for (int ai = 0; ai < 2; ++ai)
#pragma unroll
            for (int m = 0; m < 4; ++m) {
                const int tok = rowtok[pos0 + ai * 128 + m * 16];
                if (tok >= 0) {
                    const float* g2 = mods + bidx(tok) * 6144 + 5120;
                    float* xr = xo + (size_t)tok * D;
#pragma unroll
                    for (int bj = 0; bj < 2; ++bj)
#pragma unroll
                        for (int n = 0; n < 2; ++n) { const int col = col0 + bj * 128 + n * 16;
                            const f32x4 xv = *(const f32x4*)(xr + col), gv = *(const f32x4*)(g2 + col);
                            *(f32x4*)(xr + col) = xv + gv * acc[ai][bj][m][n]; }
                }
            }
    }
};

__device__ __forceinline__ int padx(int i) { return i + (i >> 3); }
__device__ __forceinline__ f32x2 cmul(f32x2 a, f32x2 b) { return (f32x2){a.x * b.x - a.y * b.y, a.x * b.y + a.y * b.x}; }
__device__ __forceinline__ f32x2 cmulc(f32x2 a, f32x2 b) { return (f32x2){a.x * b.x + a.y * b.y, a.y * b.x - a.x * b.y}; }
constexpr int XPAD = 2048 + 256;

__device__ __forceinline__ void fft_p1_dif(f32x2 (&v)[8], int tt, const LAS f32x2* T) {
#pragma unroll
    for (int g = 0; g < 2; ++g) { const int u = tt + 256 * g;
#pragma unroll
        for (int j = 0; j < 2; ++j) { const f32x2 a = v[g + 2 * j], b = v[g + 2 * j + 4]; v[g + 2 * j] = a + b; v[g + 2 * j + 4] = cmul(a - b, T[2 * (u + 512 * j)]); }
        const f32x2 tw = T[4 * u];
        { const f32x2 a = v[g], b = v[g + 2]; v[g] = a + b; v[g + 2] = cmul(a - b, tw); }
        { const f32x2 a = v[g + 4], b = v[g + 6]; v[g + 4] = a + b; v[g + 6] = cmul(a - b, tw); } }
}
__device__ __forceinline__ void fft_p1_dit(f32x2 (&v)[8], int tt, const LAS f32x2* T) {
#pragma unroll
    for (int g = 0; g < 2; ++g) { const int u = tt + 256 * g;
        const f32x2 tw = T[4 * u];
        { const f32x2 a = v[g], b = cmulc(v[g + 2], tw); v[g] = a + b; v[g + 2] = a - b; }
        { const f32x2 a = v[g + 4], b = cmulc(v[g + 6], tw); v[g + 4] = a + b; v[g + 6] = a - b; }
#pragma unroll
        for (int j = 0; j < 2; ++j) { const f32x2 a = v[g + 2 * j], b = cmulc(v[g + 2 * j + 4], T[2 * (u + 512 * j)]); v[g + 2 * j] = a + b; v[g + 2 * j + 4] = a - b; } }
}
template <int Q> __device__ __forceinline__ void r8_dif(f32x2 (&e)[8], int r, const LAS f32x2* T) {
    constexpr int S2 = 512 / Q;
#pragma unroll
    for (int j = 0; j < 4; ++j) { const f32x2 a = e[j], b = e[j + 4]; e[j] = a + b; e[j + 4] = cmul(a - b, T[S2 * (r + Q * j)]); }
#pragma unroll
    for (int jj = 0; jj < 4; ++jj) { const int j = (jj & 1) + 4 * (jj >> 1); const f32x2 a = e[j], b = e[j + 2]; e[j] = a + b; e[j + 2] = cmul(a - b, T[2 * S2 * (r + Q * (j & 1))]); }
    const f32x2 tw = T[4 * S2 * r];
#pragma unroll
    for (int j = 0; j < 8; j += 2) { const f32x2 a = e[j], b = e[j + 1]; e[j] = a + b; e[j + 1] = cmul(a - b, tw); }
}
template <int Q> __device__ __forceinline__ void r8_dit(f32x2 (&e)[8], int r, const LAS f32x2* T) {
    constexpr int S2 = 512 / Q;
    const f32x2 tw = T[4 * S2 * r];
#pragma unroll
    for (int j = 0; j < 8; j += 2) { const f32x2 a = e[j], b = cmulc(e[j + 1], tw); e[j] = a + b; e[j + 1] = a - b; }
#pragma unroll
    for (int jj = 0; jj < 4; ++jj) { const int j = (jj & 1) + 4 * (jj >> 1); const f32x2 a = e[j], b = cmulc(e[j + 2], T[2 * S2 * (r + Q * (j & 1))]); e[j] = a + b; e[j + 2] = a - b; }
#pragma unroll
    for (int j = 0; j < 4; ++j) { const f32x2 a = e[j], b = cmulc(e[j + 4], T[S2 * (r + Q * j)]); e[j] = a + b; e[j + 4] = a - b; }
}
template <int Q, bool INV> __device__ __forceinline__ void fft_mid(LAS f32x2* X, int tt, const LAS f32x2* T) {
    const int blk = tt / Q, r = tt % Q, base = blk * 8 * Q + r;
    f32x2 e[8];
#pragma unroll
    for (int j = 0; j < 8; ++j) e[j] = X[padx(base + Q * j)];
    if (INV) r8_dit<Q>(e, r, T); else r8_dif<Q>(e, r, T);
#pragma unroll
    for (int j = 0; j < 8; ++j) X[padx(base + Q * j)] = e[j];
}
__device__ __forceinline__ void fft_conv_half(f32x2 (&v)[8], LAS f32x2* X, const LAS f32x2* T, const f32x2* K, int tt) {
    f32x2 kv[8];
#pragma unroll
    for (int j = 0; j < 8; ++j) kv[j] = K[8 * tt + j];
    fft_p1_dif(v, tt, T);
#pragma unroll
    for (int m = 0; m < 8; ++m) X[padx(tt + 256 * m)] = v[m];
    __syncthreads();
    fft_mid<64, false>(X, tt, T); __syncthreads();
    fft_mid<8, false>(X, tt, T); __syncthreads();
    f32x2 e[8];
#pragma unroll
    for (int j = 0; j < 8; ++j) e[j] = X[padx(8 * tt + j)];
    r8_dif<1>(e, 0, T);
#pragma unroll
    for (int j = 0; j < 8; ++j) e[j] = cmul(e[j], kv[j]);
    r8_dit<1>(e, 0, T);
#pragma unroll
    for (int j = 0; j < 8; ++j) X[padx(8 * tt + j)] = e[j];
    __syncthreads();
    fft_mid<8, true>(X, tt, T); __syncthreads();
    fft_mid<64, true>(X, tt, T); __syncthreads();
#pragma unroll
    for (int m = 0; m < 8; ++m) v[m] = X[padx(tt + 256 * m)];
    fft_p1_dit(v, tt, T);
}
__device__ __forceinline__ void fft_fwd_store(f32x2 (&v)[8], LAS f32x2* X, const LAS f32x2* T, f32x2* Kout, int tt) {
    fft_p1_dif(v, tt, T);
#pragma unroll
    for (int m = 0; m < 8; ++m) X[padx(tt + 256 * m)] = v[m];
    __syncthreads();
    fft_mid<64, false>(X, tt, T); __syncthreads();
    fft_mid<8, false>(X, tt, T); __syncthreads();
    f32x2 e[8];
#pragma unroll
    for (int j = 0; j < 8; ++j) e[j] = X[padx(8 * tt + j)];
    r8_dif<1>(e, 0, T);
#pragma unroll
    for (int j = 0; j < 8; ++j) Kout[8 * tt + j] = e[j];
    __syncthreads();
}
__device__ __forceinline__ void build_twiddles(const Ctx& C, LAS f32x2* T) {
    for (int k = C.tid; k < 2048; k += NTHR) { float s, c; sincospif((float)k * (1.0f / 2048.0f), &s, &c); T[k] = (f32x2){c, -s}; }
}

__device__ __forceinline__ void phase0(const Ctx& C) {
    LAS float* sil = (LAS float*)C.lds;
    LAS float* red = sil + 9 * 1024;
    LAS float* zs = red + 8 * 9 * 64;
    LAS float* h1s = zs + 8 * 40;
    const float* cin = C.in[IN_C]; const float* cctx = C.in[IN_CCTX];
    for (int i = C.tid; i < 9 * 1024; i += NTHR) { const int r = i >> 10, k = i & 1023; const float v = r < 8 ? cin[r * 1024 + k] : cctx[k]; sil[i] = v / (1.0f + expf(-v)); }
    __syncthreads();
    float* mods = WSP(float, WS_MODS);
    const float* wmod = C.in[IN_WMOD]; const float* bmod = C.in[IN_BMOD];
    for (int item = C.bid; item < 4 * 96; item += C.G) {
        const int l = item / 96, cb = item % 96, cc = C.tid & 63, kg = C.tid >> 6;
        const float* w = wmod + ((size_t)l * 1024 + kg * 128) * 6144 + cb * 64 + cc;
        const LAS float* sk = sil + kg * 128;
        float acc[9];
#pragma unroll
        for (int r = 0; r < 9; ++r) acc[r] = 0.f;
#pragma unroll 4
        for (int k = 0; k < 128; ++k) { const float wv = w[(size_t)k * 6144];
#pragma unroll
            for (int r = 0; r < 9; ++r) acc[r] += sk[r * 1024 + k] * wv; }
#pragma unroll
        for (int r = 0; r < 9; ++r) red[(kg * 9 + r) * 64 + cc] = acc[r];
        __syncthreads();
        for (int o = C.tid; o < 576; o += NTHR) { const int r = o >> 6, c2 = o & 63; float s = 0.f;
#pragma unroll
            for (int g = 0; g < 8; ++g) s += red[(g * 9 + r) * 64 + c2];
            mods[(size_t)(l * 9 + r) * 6144 + cb * 64 + c2] = s + bmod[l * 6144 + cb * 64 + c2]; }
        __syncthreads();
    }
    for (int item = C.bid; item < 4 * 288; item += C.G) {
        const int l = item / 288, r = item % 288, isctx = r >= 256;
        const int L = isctx ? 256 : 2048, t0 = (isctx ? r - 256 : r) * 8, tl = C.tid >> 6, j = C.tid & 63, t = t0 + tl;
        if (j < 33) { float z;
            if (j == 0) z = (float)t / (float)(L - 1);
            else { const int fi = (j - 1) & 15; const float freq = 1e-4f + (float)fi * ((15.0f - 1e-4f) / 15.0f);
                const float ang = ((float)(2.0 * 3.14159265358979323846 / L) * (float)t) * freq; z = (j <= 16) ? cosf(ang) : -sinf(ang); }
            zs[tl * 40 + j] = z; }
        __syncthreads();
        { const float* w1 = C.in[IN_W1] + (size_t)l * 33 * 64; float s = C.in[IN_B1][l * 64 + j];
            for (int i = 0; i < 33; ++i) s += zs[tl * 40 + i] * w1[i * 64 + j];
            h1s[tl * 64 + j] = sinf(s); }
        __syncthreads();
        { const float* w2 = C.in[IN_W2] + (size_t)l * 64 * 64; float s = C.in[IN_B2][l * 64 + j];
            for (int i = 0; i < 64; ++i) s += h1s[tl * 64 + i] * w2[i * 64 + j];
            float* dst = isctx ? WSP(float, WS_H2C) + ((size_t)l * 256 + t) * 64 : WSP(float, WS_H2L) + ((size_t)l * 2048 + t) * 64;
            dst[j] = sinf(s); }
        __syncthreads();
    }
    if (C.bid == C.G - 1) {
        const float* lb = C.in[IN_LB]; float* lower = WSP(float, WS_LOWER);
        for (int i = C.tid; i < 1024; i += NTHR) { const int d = i >> 9, c = i & 511; float v[4], mx = -3.4e38f, s = 0.f;
#pragma unroll
            for (int l = 0; l < 4; ++l) { v[l] = lb[(d * 4 + l) * 512 + c]; mx = fmaxf(mx, v[l]); }
#pragma unroll
            for (int l = 0; l < 4; ++l) { v[l] = expf(v[l] - mx); s += v[l]; }
            float cum = 0.f;
#pragma unroll
            for (int l = 0; l < 4; ++l) { if (l > 0) cum += v[l] / s; lower[(d * 4 + l) * 512 + c] = cum; } }
    }
}

__device__ __forceinline__ const float* xrow_src(const Ctx& C, int l, int row) {
    return l == 0 ? (row < NLAT ? C.in[IN_X] + (size_t)row * D : C.in[IN_CTX] + (size_t)(row - NLAT) * D) : WSP(const float, WS_XBUF) + (size_t)row * D;
}
__device__ __forceinline__ void transpose_item(const float* W, int K, int N, bf16_t* WT, LAS float* scr, int item, int lane) {
    const int nblk = N / 32, kb = item / nblk, nb = item % nblk, k0 = 64 * kb, n0 = 32 * nb;
#pragma unroll 8
    for (int i = 0; i < 32; ++i) { const int kk = 2 * i + (lane >> 5); scr[kk * 33 + (lane & 31)] = W[(size_t)(k0 + kk) * N + n0 + (lane & 31)]; }
    LDS_WAIT(); asm volatile("" ::: "memory");
    const int c = lane & 7;
#pragma unroll
    for (int j = 0; j < 4; ++j) { const int n = (lane >> 3) + 8 * j; const LAS float* s = scr + (8 * c) * 33 + n;
        u32x4 o; o.x = pk2(s[0 * 33], s[1 * 33]); o.y = pk2(s[2 * 33], s[3 * 33]); o.z = pk2(s[4 * 33], s[5 * 33]); o.w = pk2(s[6 * 33], s[7 * 33]);
        *(u32x4*)(WT + (size_t)(n0 + n) * K + k0 + 8 * c) = o; }
    LDS_WAIT(); asm volatile("" ::: "memory");
}
__device__ __forceinline__ void phase_l1(const Ctx& C, int l) {
    const int gw = C.bid * NWAVES + C.wave, NGW = C.G * NWAVES;
    const float* mods = WSP(const float, WS_MODS) + (size_t)l * 9 * 6144;
    bf16_t* an = WSP(bf16_t, WS_R1);
    for (int row = gw; row < NTOK; row += NGW) {
        const float* src = xrow_src(C, l, row); const float* md = mods + bidx(row) * 6144;
        f32x4 v[4]; float ss = 0.f;
#pragma unroll
        for (int j = 0; j < 4; ++j) { v[j] = *(const f32x4*)(src + C.lane * 4 + 256 * j); ss += (v[j].x * v[j].x + v[j].y * v[j].y) + (v[j].z * v[j].z + v[j].w * v[j].w); }
        ss = wave_sum(ss); const float rinv = 1.0f / sqrtf(ss * (1.0f / D) + EPS);
#pragma unroll
        for (int j = 0; j < 4; ++j) { const int k = C.lane * 4 + 256 * j; const f32x4 sh = *(const f32x4*)(md + k), sc = *(const f32x4*)(md + 1024 + k);
            const f32x4 o = v[j] * rinv * (sc + 1.0f) + sh; u32x2 w; w.x = pk2(o.x, o.y); w.y = pk2(o.z, o.w);
            *(u32x2*)(an + (size_t)row * D + k) = w; }
    }
    {
        LAS float* scr = (LAS float*)(C.lds + C.wave * 16384);
        constexpr int I_IN = 16 * 128, I_OUT = 16 * 32, I_E = 128;
        constexpr int NIT = I_IN + I_OUT + 3 * 16 * I_E;
        for (int it = gw; it < NIT; it += NGW) {
            int r = it;
            if (r < I_IN) { transpose_item(C.in[IN_WIN] + (size_t)l * D * DIN, D, DIN, WSP(bf16_t, WS_WIN), scr, r, C.lane); continue; } r -= I_IN;
            if (r < I_OUT) { transpose_item(C.in[IN_WOUT] + (size_t)l * D * D, D, D, WSP(bf16_t, WS_WOUT), scr, r, C.lane); continue; } r -= I_OUT;
            if (r < 16 * I_E) { const int e = r / I_E; transpose_item(C.in[IN_WG] + ((size_t)l * NE + e) * D * DE, D, DE, WSP(bf16_t, WS_WG) + (size_t)e * DE * D, scr, r % I_E, C.lane); continue; } r -= 16 * I_E;
            if (r < 16 * I_E) { const int e = r / I_E; transpose_item(C.in[IN_WU] + ((size_t)l * NE + e) * D * DE, D, DE, WSP(bf16_t, WS_WU) + (size_t)e * DE * D, scr, r % I_E, C.lane); continue; } r -= 16 * I_E;
            { const int e = r / I_E; transpose_item(C.in[IN_WD] + ((size_t)l * NE + e) * DE * D, DE, D, WSP(bf16_t, WS_WD) + (size_t)e * D * DE, scr, r % I_E, C.lane); }
        }
    }
    __syncthreads();
    {
        LAS f32x2* T = (LAS f32x2*)C.lds;
        const int team = C.tid >> 8, tt = C.tid & 255;
        LAS f32x2* X = (LAS f32x2*)(C.lds + 16384) + team * XPAD;
        LAS float* hbs = (LAS float*)(C.lds + 16384 + 2 * XPAD * 8) + team * 2048;
        LAS float* w3s = (LAS float*)(C.lds + 16384 + 2 * XPAD * 8 + 16384) + team * 128;
        LAS float* reds = (LAS float*)(C.lds + 16384 + 2 * XPAD * 8 + 16384 + 1024);
        build_twiddles(C, T);
        __syncthreads();
        const float* h2 = WSP(const float, WS_H2L) + (size_t)l * 2048 * 64;
        const float* w3 = C.in[IN_W3] + (size_t)l * 64 * 2048; const float* b3 = C.in[IN_B3] + l * 2048;
        f32x2* kspec = WSP(f32x2, WS_KSPEC);
        for (int item = C.bid; item < 512; item += C.G) {
            const int idx = item * 2 + team, o = idx >> 9, c = idx & 511;
            const int colf = o * 1024 + c, colb = colf + 512;
            if (tt < 128) w3s[tt] = w3[(size_t)(tt & 63) * 2048 + ((tt >> 6) ? colb : colf)];
            __syncthreads();
            const float delta = fabsf(logf(1e-2f) / 0.3f + (float)c * ((logf(1e-2f) / 1.5f - logf(1e-2f) / 0.3f) / 511.0f));
            float hf[8], hb[8], s = 0.f;
#pragma unroll
            for (int j = 0; j < 8; ++j) { const int t = tt + 256 * j; const f32x4* hr = (const f32x4*)(h2 + (size_t)t * 64);
                float af = b3[colf], ab = b3[colb];
#pragma unroll
                for (int i4 = 0; i4 < 16; ++i4) { const f32x4 h = hr[i4];
                    af += h.x * w3s[i4 * 4] + h.y * w3s[i4 * 4 + 1] + h.z * w3s[i4 * 4 + 2] + h.w * w3s[i4 * 4 + 3];
                    ab += h.x * w3s[64 + i4 * 4] + h.y * w3s[64 + i4 * 4 + 1] + h.z * w3s[64 + i4 * 4 + 2] + h.w * w3s[64 + i4 * 4 + 3]; }
                const float win = expf(-((float)t / 2047.0f) * delta);
                hf[j] = af * win; hb[j] = ab * win; s += fabsf(hf[j]) + fabsf(hb[j]);
                asm volatile("" ::: "memory"); }
            s = wave_sum(s);
            if (C.lane == 0) reds[C.wave] = s;
            __syncthreads();
            const float tot = reds[team * 4] + reds[team * 4 + 1] + reds[team * 4 + 2] + reds[team * 4 + 3];
            const float inv = 1.0f / (tot * 4096.0f);
#pragma unroll
            for (int j = 0; j < 8; ++j) { hf[j] *= inv; hb[j] *= inv; hbs[tt + 256 * j] = hb[j]; }
            __syncthreads();
            f32x2 ve[8], vo[8];
#pragma unroll
            for (int j = 0; j < 8; ++j) { const int n = tt + 256 * j; const float kb = n > 0 ? hbs[2048 - n] : 0.f;
                ve[j] = (f32x2){hf[j] + kb, 0.f}; const float dd = hf[j] - kb; const f32x2 tw = T[n]; vo[j] = (f32x2){dd * tw.x, dd * tw.y}; }
            f32x2* kout = kspec + ((size_t)(o * 512 + c) * 2) * 2048;
            fft_fwd_store(ve, X, T, kout, tt);
            fft_fwd_store(vo, X, T, kout + 2048, tt);
        }
        if (l < DEPTH - 1) {
            const float* h2c = WSP(const float, WS_H2C) + (size_t)l * 256 * 64;
            f32x2* kspc = WSP(f32x2, WS_KSPC);
            for (int item = C.bid; item < 512; item += C.G) {
                const int idx = item * 2 + team, o = idx >> 9, c = idx & 511;
                const int colf = o * 1024 + c, colb = colf + 512;
                if (tt < 128) w3s[tt] = w3[(size_t)(tt & 63) * 2048 + ((tt >> 6) ? colb : colf)];
                __syncthreads();
                const float delta = fabsf(logf(1e-2f) / 0.3f + (float)c * ((logf(1e-2f) / 1.5f - logf(1e-2f) / 0.3f) / 511.0f));
                float af = b3[colf], ab = b3[colb];
                { const f32x4* hr = (const f32x4*)(h2c + (size_t)tt * 64);
#pragma unroll
                  for (int i4 = 0; i4 < 16; ++i4) { const f32x4 h = hr[i4];
                    af += h.x * w3s[i4 * 4] + h.y * w3s[i4 * 4 + 1] + h.z * w3s[i4 * 4 + 2] + h.w * w3s[i4 * 4 + 3];
                    ab += h.x * w3s[64 + i4 * 4] + h.y * w3s[64 + i4 * 4 + 1] + h.z * w3s[64 + i4 * 4 + 2] + h.w * w3s[64 + i4 * 4 + 3]; } }
                const float win = expf(-((float)tt / 255.0f) * delta);
                af *= win; ab *= win;
                const float s = wave_sum(fabsf(af) + fabsf(ab));
                if (C.lane == 0) reds[C.wave] = s;
                __syncthreads();
                const float tot = reds[team * 4] + reds[team * 4 + 1] + reds[team * 4 + 2] + reds[team * 4 + 3];
                const float inv = 1.0f / (tot * 2048.0f);
                af *= inv; ab *= inv; hbs[tt] = ab;
                __syncthreads();
                f32x2 vk[8];
#pragma unroll
                for (int j = 0; j < 8; ++j) vk[j] = (f32x2){0.f, 0.f};
                vk[0] = (f32x2){af, 0.f};
                vk[7] = (f32x2){tt > 0 ? hbs[256 - tt] : 0.f, 0.f};
                fft_fwd_store(vk, X, T, kspc + (size_t)(o * 512 + c) * 2048, tt);
            }
        }
    }
}

__device__ __forceinline__ float shortconv(const LAS bf16_t* raw, int t, int mask, int tmax, float w0, float w1, float w2, float bias) {
    const float pm = ((t & mask) != 0) ? bf2f(raw[t - 1]) : 0.f;
    const float pc = bf2f(raw[t]);
    const float pp = ((t & mask) != mask && t < tmax) ? bf2f(raw[t + 1]) : 0.f;
    return w0 * pm + w1 * pc + w2 * pp + bias;
}
__device__ __forceinline__ void hyena_lat(const Ctx& C, int l, int item) {
    const int bp = item >> 6, cg = item & 63, team = C.tid >> 8, tt = C.tid & 255;
    LAS f32x2* T = (LAS f32x2*)C.lds;
    LAS f32x2* X = (LAS f32x2*)(C.lds + 16384) + team * XPAD;
    LAS bf16_t* raw = (LAS bf16_t*)(C.lds + 16384 + 2 * XPAD * 8) + team * 4096;
    LAS bf16_t* outs = (LAS bf16_t*)(C.lds + 16384 + 2 * XPAD * 8 + 16384);
    const bf16_t* phyt = WSP(const bf16_t, WS_PHYT);
    const float* cw = C.in[IN_CONVW] + (size_t)l * 3 * NHY; const float* cb = C.in[IN_CONVB] + (size_t)l * NHY;
    const float* hyb = C.in[IN_HYBIAS] + (size_t)l * 2 * DH;
    const f32x2* kspec = WSP(const f32x2, WS_KSPEC);
    const int ba = 2 * bp;
    for (int round = 0; round < 4; ++round) {
        const int c = cg * 8 + round * 2 + team;
        f32x2 z[8], acc[8], v[8];
#pragma unroll 1
        for (int stage = 0; stage < 3; ++stage) {
            const int ch = stage * 512 + c;
            __syncthreads();
#pragma unroll
            for (int k = 0; k < 2; ++k) { const int q = tt + 256 * k, rr = q >> 8, cc = q & 255;
                *(LAS u32x4*)(raw + rr * 2048 + cc * 8) = *(const u32x4*)(phyt + (size_t)ch * NTOK + (size_t)(ba + rr) * 2048 + cc * 8); }
            __syncthreads();
            const float w0 = cw[ch], w1 = cw[NHY + ch], w2 = cw[2 * NHY + ch], bs = cb[ch];
            if (stage == 0) {
#pragma unroll
                for (int j = 0; j < 8; ++j) { const int t = tt + 256 * j; z[j] = (f32x2){shortconv(raw, t, 63, 4096, w0, w1, w2, bs), shortconv(raw + 2048, t, 63, 4096, w0, w1, w2, bs)}; }
            } else {
                const float dsk = hyb[(stage - 1) * DH + c];
#pragma unroll
                for (int j = 0; j < 8; ++j) { const int t = tt + 256 * j; const f32x2 cv = acc[j] + z[j] * dsk;
                    z[j] = (f32x2){shortconv(raw, t, 63, 4096, w0, w1, w2, bs) * cv.x, shortconv(raw + 2048, t, 63, 4096, w0, w1, w2, bs) * cv.y}; }
            }
            if (stage == 2) {
#pragma unroll
                for (int j = 0; j < 8; ++j) { const int t = tt + 256 * j; outs[(size_t)t * 8 + round * 2 + team] = (bf16_t)f2bf(z[j].x); outs[(size_t)(2048 + t) * 8 + round * 2 + team] = (bf16_t)f2bf(z[j].y); }
                break;
            }
            const f32x2* K = kspec + ((size_t)(stage * 512 + c) * 2) * 2048;
#pragma unroll
            for (int j = 0; j < 8; ++j) v[j] = z[j];
            fft_conv_half(v, X, T, K, tt);
#pragma unroll
            for (int j = 0; j < 8; ++j) acc[j] = v[j];
#pragma unroll
            for (int j = 0; j < 8; ++j) v[j] = cmul(z[j], T[tt + 256 * j]);
            fft_conv_half(v, X, T, K + 2048, tt);
#pragma unroll
            for (int j = 0; j < 8; ++j) acc[j] += cmulc(v[j], T[tt + 256 * j]);
        }
    }
    __syncthreads();
    bf16_t* Y = WSP(bf16_t, WS_R1);
    for (int i = C.tid; i < 4096; i += NTHR) { const int b = i >> 11, t = i & 2047;
        *(u32x4*)(Y + ((size_t)(ba + b) * 2048 + t) * D + cg * 8) = *(const LAS u32x4*)(outs + (size_t)i * 8); }
    __syncthreads();
}
__device__ __forceinline__ void hyena_ctx2(const Ctx& C, int l, int item) {
    const int team = C.tid >> 8, tt = C.tid & 255, c = item * 2 + team;
    LAS f32x2* T = (LAS f32x2*)C.lds;
    LAS f32x2* X = (LAS f32x2*)(C.lds + 16384) + team * XPAD;
    LAS bf16_t* raw = (LAS bf16_t*)(C.lds + 16384 + 2 * XPAD * 8) + team * 4096;
    const bf16_t* phyt = WSP(const bf16_t, WS_PHYT);
    const float* cw = C.in[IN_CONVW] + (size_t)l * 3 * NHY; const float* cb = C.in[IN_CONVB] + (size_t)l * NHY;
    const float* hyb = C.in[IN_HYBIAS] + (size_t)l * 2 * DH;
    const f32x2* kspc = WSP(const f32x2, WS_KSPC);
    bf16_t* Y = WSP(bf16_t, WS_R1);
    f32x2 z[8], v[8];
#pragma unroll
    for (int j = 0; j < 8; ++j) z[j] = (f32x2){0.f, 0.f};
#pragma unroll 1
    for (int stage = 0; stage < 3; ++stage) {
        const int ch = stage * 512 + c;
        __syncthreads();
        *(LAS u32x4*)(raw + tt * 8) = *(const u32x4*)(phyt + (size_t)ch * NTOK + NLAT + tt * 8);
        __syncthreads();
        const float w0 = cw[ch], w1 = cw[NHY + ch], w2 = cw[2 * NHY + ch], bs = cb[ch];
        const float dsk = stage > 0 ? hyb[(stage - 1) * DH + c] : 0.f;
#pragma unroll
        for (int p = 0; p < 4; ++p) {
            const float ua = shortconv(raw, (2 * p) * 256 + tt, 255, 4096, w0, w1, w2, bs), ub = shortconv(raw, (2 * p + 1) * 256 + tt, 255, 4096, w0, w1, w2, bs);
            if (stage == 0) z[2 * p] = (f32x2){ua, ub};
            else { const f32x2 cv = v[2 * p] + z[2 * p] * dsk; z[2 * p] = (f32x2){ua * cv.x, ub * cv.y}; }
        }
        if (stage == 2) {
#pragma unroll
            for (int p = 0; p < 4; ++p) { Y[(size_t)(NLAT + (2 * p) * 256 + tt) * D + c] = (bf16_t)f2bf(z[2 * p].x); Y[(size_t)(NLAT + (2 * p + 1) * 256 + tt) * D + c] = (bf16_t)f2bf(z[2 * p].y); }
            break;
        }
#pragma unroll
        for (int j = 0; j < 8; ++j) v[j] = z[j];
        fft_conv_half(v, X, T, kspc + (size_t)(stage * 512 + c) * 2048, tt);
    }
}

constexpr int HG_QT = 0, HG_QP = 17408, HG_KP = 34816, HG_ST = 52224, HG_VT = 87040, HG_KH = 105472, HG_P = 123904, HG_SUB = 133120, HG_D = 135168;
__device__ __forceinline__ void hgrn_mfma(const Ctx& C, int item) {
    const int dir = item & 1, h = (item >> 1) & 3, b = item >> 3;
    LAS unsigned char* L = C.lds;
    const int lane = C.lane, w = C.wave, r = lane & 15, quad = lane >> 4;
    const int I = w >> 1, col = (w & 1) * 64 + lane;
    const bf16_t* phg = WSP(const bf16_t, WS_PHG);
    bf16_t* odir = WSP(bf16_t, WS_ODIR) + (size_t)dir * NTOK * 512;
    LAS float* subtot = (LAS float*)(L + HG_SUB); LAS float* Dv = (LAS float*)(L + HG_D);
    __syncthreads();
    for (int i = C.tid; i < (128 * 272) / 16; i += NTHR) *(LAS u32x4*)(L + HG_ST + i * 16) = (u32x4){0u, 0u, 0u, 0u};
    for (int i = C.tid; i < (64 * 144) / 16; i += NTHR) *(LAS u32x4*)(L + HG_P + i * 16) = (u32x4){0u, 0u, 0u, 0u};
    f32x4 sacc[8];
#pragma unroll
    for (int t = 0; t < 8; ++t) sacc[t] = (f32x4){0.f, 0.f, 0.f, 0.f};
    unsigned short qr[16], kr[16], vr[16];
    const int rstep = dir ? -1 : 1;
    const size_t colq = (size_t)h * 128 + col, colk = 1536 + (size_t)dir * 512 + h * 128 + col, colv = 512 + (size_t)h * 128 + col;
    auto chunk_row0 = [&](int ch) -> int { return ch < 4 ? NLAT + b * 256 + (dir ? 255 - ch * 64 : ch * 64) : b * 2048 + (dir ? 2047 - (ch - 4) * 64 : (ch - 4) * 64); };
    { const int row0 = chunk_row0(0) + rstep * 16 * I;
#pragma unroll
      for (int i = 0; i < 16; ++i) { const bf16_t* p = phg + (size_t)(row0 + rstep * i) * NHG; qr[i] = p[colq]; kr[i] = p[colk]; vr[i] = p[colv]; } }
    __syncthreads();
#pragma unroll 1
    for (int ch = 0; ch < 36; ++ch) {
        float cum[16]; float cs = 0.f;
#pragma unroll
        for (int i = 0; i < 16; ++i) { cs += __logf(1.0f - bf2f(kr[i])); cum[i] = cs; }
        subtot[I * 128 + col] = cs;
        __syncthreads();
        const float s0 = subtot[col], s1 = subtot[128 + col], s2 = subtot[256 + col], s3 = subtot[384 + col];
        const float pre = (I > 0 ? s0 : 0.f) + (I > 1 ? s1 : 0.f) + (I > 2 ? s2 : 0.f), rho = s0 + s1, tot = (s0 + s1) + (s2 + s3);
        const float erho = __expf(rho), eend = __expf(tot - rho);
        unsigned khp[8], vtp[8];
#pragma unroll
        for (int i = 0; i < 16; ++i) {
            const float bi = pre + cum[i], e1 = __expf(bi - rho), e2 = __expf(rho - bi), qf = bf2f(qr[i]), kf = bf2f(kr[i]);
            const int srow = (16 * I + i) * 272 + col * 2;
            *(LAS bf16_t*)(L + HG_QP + srow) = (bf16_t)f2bf(qf * e1);
            *(LAS bf16_t*)(L + HG_QT + srow) = (bf16_t)f2bf(qf * e1 * erho);
            *(LAS bf16_t*)(L + HG_KP + srow) = (bf16_t)f2bf(kf * e2);
            const unsigned khb = f2bf(kf * e2 * eend);
            if (i & 1) { khp[i >> 1] |= khb << 16; vtp[i >> 1] |= (unsigned)vr[i] << 16; } else { khp[i >> 1] = khb; vtp[i >> 1] = (unsigned)vr[i]; }
        }
        *(LAS u32x4*)(L + HG_KH + col * 144 + I * 32) = (u32x4){khp[0], khp[1], khp[2], khp[3]};
        *(LAS u32x4*)(L + HG_KH + col * 144 + I * 32 + 16) = (u32x4){khp[4], khp[5], khp[6], khp[7]};
        *(LAS u32x4*)(L + HG_VT + col * 144 + I * 32) = (u32x4){vtp[0], vtp[1], vtp[2], vtp[3]};
        *(LAS u32x4*)(L + HG_VT + col * 144 + I * 32 + 16) = (u32x4){vtp[4], vtp[5], vtp[6], vtp[7]};
        if (I == 0) Dv[col] = __expf(tot);
        const int crow0 = chunk_row0(ch);
        if (ch + 1 < 36) { const int row0 = chunk_row0(ch + 1) + rstep * 16 * I;
#pragma unroll
            for (int i = 0; i < 16; ++i) { const bf16_t* p = phg + (size_t)(row0 + rstep * i) * NHG; qr[i] = p[colq]; kr[i] = p[colk]; vr[i] = p[colv]; } }
        __syncthreads();
#pragma unroll 1
        for (int blk = w; blk < 10; blk += 8) {
            const int I2 = blk < 1 ? 0 : (blk < 3 ? 1 : (blk < 6 ? 2 : 3)), J2 = blk - (I2 * (I2 + 1)) / 2;
            f32x4 pa = (f32x4){0.f, 0.f, 0.f, 0.f};
#pragma unroll
            for (int kk = 0; kk < 4; ++kk) {
                const bf16x8 a = *(const LAS bf16x8*)(L + HG_KP + (J2 * 16 + r) * 272 + (32 * kk + 8 * quad) * 2);
                const bf16x8 bq = *(const LAS bf16x8*)(L + HG_QP + (I2 * 16 + r) * 272 + (32 * kk + 8 * quad) * 2);
                pa = __builtin_amdgcn_mfma_f32_16x16x32_bf16(a, bq, pa, 0, 0, 0);
            }
            if (I2 == J2) {
#pragma unroll
                for (int rr = 0; rr < 4; ++rr) if (4 * quad + rr > r) pa[rr] = 0.f;
            }
            u32x2 pw; pw.x = pk2(pa[0], pa[1]); pw.y = pk2(pa[2], pa[3]);
            *(LAS u32x2*)(L + HG_P + (I2 * 16 + r) * 144 + (J2 * 16 + 4 * quad) * 2) = pw;
        }
        __syncthreads();
        {
            bf16x8 sfr[4];
#pragma unroll
            for (int kk = 0; kk < 4; ++kk) sfr[kk] = *(const LAS bf16x8*)(L + HG_ST + (16 * w + r) * 272 + (32 * kk + 8 * quad) * 2);
            const bf16x8 vf0 = *(const LAS bf16x8*)(L + HG_VT + (16 * w + r) * 144 + (8 * quad) * 2);
            const bf16x8 vf1 = *(const LAS bf16x8*)(L + HG_VT + (16 * w + r) * 144 + (32 + 8 * quad) * 2);
#pragma unroll
            for (int I3 = 0; I3 < 4; ++I3) {
                f32x4 oa = (f32x4){0.f, 0.f, 0.f, 0.f};
#pragma unroll
                for (int kk = 0; kk < 4; ++kk) {
                    const bf16x8 bq = *(const LAS bf16x8*)(L + HG_QT + (I3 * 16 + r) * 272 + (32 * kk + 8 * quad) * 2);
                    oa = __builtin_amdgcn_mfma_f32_16x16x32_bf16(sfr[kk], bq, oa, 0, 0, 0);
                }
                { const bf16x8 bp = *(const LAS bf16x8*)(L + HG_P + (I3 * 16 + r) * 144 + (8 * quad) * 2);
                  oa = __builtin_amdgcn_mfma_f32_16x16x32_bf16(vf0, bp, oa, 0, 0, 0); }
                if (I3 >= 2) { const bf16x8 bp = *(const LAS bf16x8*)(L + HG_P + (I3 * 16 + r) * 144 + (32 + 8 * quad) * 2);
                  oa = __builtin_amdgcn_mfma_f32_16x16x32_bf16(vf1, bp, oa, 0, 0, 0); }
                const int row = crow0 + rstep * (16 * I3 + r);
                u32x2 ow; ow.x = pk2(oa[0], oa[1]); ow.y = pk2(oa[2], oa[3]);
                *(u32x2*)(odir + (size_t)row * 512 + h * 128 + 16 * w + 4 * quad) = ow;
            }
#pragma unroll
            for (int t = 0; t < 8; ++t) {
                const f32x4 dd = *(const LAS f32x4*)(L + HG_D + (16 * t + 4 * quad) * 4);
                f32x4 sa = sacc[t] * dd;
                const bf16x8 a0 = *(const LAS bf16x8*)(L + HG_KH + (16 * t + r) * 144 + (8 * quad) * 2);
                const bf16x8 a1 = *(const LAS bf16x8*)(L + HG_KH + (16 * t + r) * 144 + (32 + 8 * quad) * 2);
                sa = __builtin_amdgcn_mfma_f32_16x16x32_bf16(a0, vf0, sa, 0, 0, 0);
                sa = __builtin_amdgcn_mfma_f32_16x16x32_bf16(a1, vf1, sa, 0, 0, 0);
                sacc[t] = sa;
                u32x2 sw; sw.x = pk2(sa[0], sa[1]); sw.y = pk2(sa[2], sa[3]);
                *(LAS u32x2*)(L + HG_ST + (16 * w + r) * 272 + (16 * t + 4 * quad) * 2) = sw;
            }
        }
    }
    __syncthreads();
}
__device__ __forceinline__ void phase_l3(const Ctx& C, int l) {
    if (C.bid < 64) hgrn_mfma(C, C.bid);
    build_twiddles(C, (LAS f32x2*)C.lds);
    __syncthreads();
    unsigned* qh = WSP(unsigned, WS_CTL) + CW_Q + l * 64;
    volatile LAS int* lc = (volatile LAS int*)(C.lds + LDSCTL_OFF);
    const int nitems = 256 + (l < DEPTH - 1 ? 256 : 0);
    for (;;) {
        if (C.tid == 0) lc[LC_Q] = (int)__hip_atomic_fetch_add(qh, 1u, __ATOMIC_RELAXED, __HIP_MEMORY_SCOPE_AGENT);
        __syncthreads();
        const int item = lc[LC_Q];
        __syncthreads();
        if (item >= nitems) break;
        if (item < 256) hyena_lat(C, l, item); else hyena_ctx2(C, l, item - 256);
    }
}
__device__ __forceinline__ void phase_l3b(const Ctx& C, int l) {
    const int gw = C.bid * NWAVES + C.wave, NGW = C.G * NWAVES;
    const bf16_t* od0 = WSP(const bf16_t, WS_ODIR); const bf16_t* od1 = od0 + (size_t)NTOK * 512;
    const bf16_t* phg = WSP(const bf16_t, WS_PHG); bf16_t* Y = WSP(bf16_t, WS_R1);
    const float* nw = C.in[IN_NORMW] + l * 128;
    const int nrows = (l < DEPTH - 1) ? NTOK : NLAT;
    for (int row = gw; row < nrows; row += NGW) {
        const int idx = C.lane * 8;
        const u32x4 a = *(const u32x4*)(od0 + (size_t)row * 512 + idx), b = *(const u32x4*)(od1 + (size_t)row * 512 + idx), g = *(const u32x4*)(phg + (size_t)row * NHG + 1024 + idx);
        float o[8] = {bflo(a.x) + bflo(b.x), bfhi(a.x) + bfhi(b.x), bflo(a.y) + bflo(b.y), bfhi(a.y) + bfhi(b.y), bflo(a.z) + bflo(b.z), bfhi(a.z) + bfhi(b.z), bflo(a.w) + bflo(b.w), bfhi(a.w) + bfhi(b.w)};
        const float gg[8] = {bflo(g.x), bfhi(g.x), bflo(g.y), bfhi(g.y), bflo(g.z), bfhi(g.z), bflo(g.w), bfhi(g.w)};
        float ss = 0.f;
#pragma unroll
        for (int i = 0; i < 8; ++i) ss += o[i] * o[i];
        ss = row16_sum(ss);
        const float rinv = 1.0f / sqrtf(ss * (1.0f / 128.0f) + EPS);
        float y[8];
#pragma unroll
        for (int i = 0; i < 8; ++i) y[i] = o[i] * rinv * nw[(idx + i) & 127] * siluf_(gg[i]);
        u32x4 w; w.x = pk2(y[0], y[1]); w.y = pk2(y[2], y[3]); w.z = pk2(y[4], y[5]); w.w = pk2(y[6], y[7]);
        *(u32x4*)(Y + (size_t)row * D + 512 + idx) = w;
    }
}

__device__ __forceinline__ void phase_l5a(const Ctx& C, int l) {
    LAS float* rwT = (LAS float*)C.lds;
    const float* rw = C.in[IN_RW];
    for (int i = C.tid; i < 16 * 1024; i += NTHR) { const int k = i >> 4, e = i & 15; rwT[e * 1024 + k] = rw[i]; }
    __syncthreads();
    const int gw = C.bid * NWAVES + C.wave, NGW = C.G * NWAVES;
    const float* mods = WSP(const float, WS_MODS) + (size_t)l * 9 * 6144;
    const float* xb = WSP(const float, WS_XBUF);
    const float* rbias = C.in[IN_RB];
    unsigned* cnt = WSP(unsigned, WS_CTL) + CW_CNT + l * 64;
    int* tokinfo = WSP(int, WS_TOKINFO);
    const int nrows = (l < DEPTH - 1) ? NTOK : NLAT;
    for (int row = gw; row < nrows; row += NGW) {
        const float* src = xb + (size_t)row * D; const float* md = mods + bidx(row) * 6144;
        f32x4 v[4]; float ss = 0.f;
#pragma unroll
        for (int j = 0; j < 4; ++j) { v[j] = *(const f32x4*)(src + C.lane * 4 + 256 * j); ss += (v[j].x * v[j].x + v[j].y * v[j].y) + (v[j].z * v[j].z + v[j].w * v[j].w); }
        ss = wave_sum(ss); const float rinv = 1.0f / sqrtf(ss * (1.0f / D) + EPS);
        float lg[16];
#pragma unroll
        for (int e = 0; e < 16; ++e) lg[e] = 0.f;
#pragma unroll
        for (int j = 0; j < 4; ++j) { const int k = C.lane * 4 + 256 * j; const f32x4 sh = *(const f32x4*)(md + 3072 + k), sc = *(const f32x4*)(md + 4096 + k);
            const f32x4 hh = v[j] * rinv * (sc + 1.0f) + sh;
#pragma unroll
            for (int e = 0; e < 16; ++e) { const f32x4 w = *(const LAS f32x4*)(rwT + e * 1024 + k); lg[e] += hh.x * w.x + hh.y * w.y + hh.z * w.z + hh.w * w.w; } }
#pragma unroll
        for (int e = 0; e < 16; ++e) lg[e] = wave_sum(lg[e]);
        float mx = lg[0];
#pragma unroll
        for (int e = 1; e < 16; ++e) mx = fmaxf(mx, lg[e]);
        float sc[16], se = 0.f;
#pragma unroll
        for (int e = 0; e < 16; ++e) { sc[e] = expf(lg[e] - mx); se += sc[e]; }
        float sel[16];
#pragma unroll
        for (int e = 0; e < 16; ++e) { sc[e] = sc[e] / se; sel[e] = sc[e] + rbias[e]; }
        float bestgs = -3.4e38f; int bg = 0; float bs[4], bsc[4];
#pragma unroll
        for (int g = 0; g < 4; ++g) {
            float m1 = -3.4e38f, m2 = -3.4e38f;
#pragma unroll
            for (int i = 0; i < 4; ++i) { const float x = sel[4 * g + i]; if (x > m1) { m2 = m1; m1 = x; } else if (x > m2) m2 = x; }
            const float gs = m1 + m2;
            if (gs > bestgs) { bestgs = gs; bg = g;
#pragma unroll
                for (int i = 0; i < 4; ++i) { bs[i] = sel[4 * g + i]; bsc[i] = sc[4 * g + i]; } }
        }
        int i0 = 0; float b0 = bs[0];
#pragma unroll
        for (int i = 1; i < 4; ++i) if (bs[i] > b0) { b0 = bs[i]; i0 = i; }
        int i1 = -1; float b1 = -3.4e38f;
#pragma unroll
        for (int i = 0; i < 4; ++i) if (i != i0 && bs[i] > b1) { b1 = bs[i]; i1 = i; }
        float w0 = 0.f, w1 = 0.f;
#pragma unroll
        for (int i = 0; i < 4; ++i) { if (i == i0) w0 = bsc[i]; if (i == i1) w1 = bsc[i]; }
        const float wn = w0 + w1; w0 /= wn; w1 /= wn;
        const int lo = i0 < i1 ? i0 : i1, hi = i0 < i1 ? i1 : i0;
        const float wlo = i0 < i1 ? w0 : w1, whi = i0 < i1 ? w1 : w0;
        const int bin = bg * 6 + (lo * (7 - lo)) / 2 + (hi - lo - 1);
        if (C.lane == 0) { const unsigned slot = atomicAdd(cnt + bin, 1u);
            *(int4*)(tokinfo + (size_t)row * 4) = make_int4(bin, (int)slot, __float_as_int(wlo), __float_as_int(whi)); }
    }
}
__device__ __forceinline__ void phase_l5b(const Ctx& C, int l) {
    build_tiletab(C, l);
    const volatile LAS int* lc = (const volatile LAS int*)(C.lds + LDSCTL_OFF);
    const int gw = C.bid * NWAVES + C.wave, NGW = C.G * NWAVES;
    const float* mods = WSP(const float, WS_MODS) + (size_t)l * 9 * 6144;
    const float* xb = WSP(const float, WS_XBUF);
    const int* tokinfo = WSP(const int, WS_TOKINFO);
    bf16_t* hs = WSP(bf16_t, WS_PHG); int* rowtok = WSP(int, WS_ROWTOK); float* roww = WSP(float, WS_ROWW);
    const int nrows = (l < DEPTH - 1) ? NTOK : NLAT;
    for (int row = gw; row < nrows; row += NGW) {
        const int4 ti = *(const int4*)(tokinfo + (size_t)row * 4);
        const int pos = lc[LC_OFFS + ti.x] + ti.y;
        const float* src = xb + (size_t)row * D; const float* md = mods + bidx(row) * 6144;
        f32x4 v[4]; float ss = 0.f;
#pragma unroll
        for (int j = 0; j < 4; ++j) { v[j] = *(const f32x4*)(src + C.lane * 4 + 256 * j); ss += (v[j].x * v[j].x + v[j].y * v[j].y) + (v[j].z * v[j].z + v[j].w * v[j].w); }
        ss = wave_sum(ss); const float rinv = 1.0f / sqrtf(ss * (1.0f / D) + EPS);
#pragma unroll
        for (int j = 0; j < 4; ++j) { const int k = C.lane * 4 + 256 * j; const f32x4 sh = *(const f32x4*)(md + 3072 + k), sc = *(const f32x4*)(md + 4096 + k);
            const f32x4 o = v[j] * rinv * (sc + 1.0f) + sh; u32x2 w; w.x = pk2(o.x, o.y); w.y = pk2(o.z, o.w);
            *(u32x2*)(hs + (size_t)pos * D + k) = w; }
        if (C.lane == 0) { rowtok[pos] = row; roww[pos * 2] = __int_as_float(ti.z); roww[pos * 2 + 1] = __int_as_float(ti.w); }
    }
    if (C.bid < NBIN) { const int b = C.bid; const int start = lc[LC_OFFS + b], end = lc[LC_OFFS + b + 1];
        const int n = (int)__hip_atomic_load(WSP(unsigned, WS_CTL) + CW_CNT + l * 64 + b, __ATOMIC_RELAXED, __HIP_MEMORY_SCOPE_AGENT);
        for (int p = start + n + C.tid; p < end; p += NTHR) { rowtok[p] = -1; roww[p * 2] = 0.f; roww[p * 2 + 1] = 0.f; } }
}

__device__ __forceinline__ void phase_final(const Ctx& C) {
    const int gw = C.bid * NWAVES + C.wave, NGW = C.G * NWAVES;
    const float* xb = WSP(const float, WS_XBUF); const float* fw = C.in[IN_FNW];
    for (int row = gw; row < NLAT; row += NGW) {
        const float* src = xb + (size_t)row * D;
        f32x4 v[4]; float ss = 0.f;
#pragma unroll
        for (int j = 0; j < 4; ++j) { v[j] = *(const f32x4*)(src + C.lane * 4 + 256 * j); ss += (v[j].x * v[j].x + v[j].y * v[j].y) + (v[j].z * v[j].z + v[j].w * v[j].w); }
        ss = wave_sum(ss); const float rinv = 1.0f / sqrtf(ss * (1.0f / D) + EPS);
#pragma unroll
        for (int j = 0; j < 4; ++j) { const int k = C.lane * 4 + 256 * j; const f32x4 w = *(const f32x4*)(fw + k);
            *(f32x4*)(C.out + (size_t)row * D + k) = v[j] * rinv * w; }
    }
}

constexpr int PH_PER_LAYER = 9, N_PHASES = 1 + DEPTH * PH_PER_LAYER + 1;
__global__ void __launch_bounds__(NTHR, 2) trunk_fwd(Args args) {
    extern __shared__ __attribute__((aligned(16))) unsigned char lds[];
    Ctx C; C.in = (const CAS fptr_t*)__builtin_amdgcn_kernarg_segment_ptr(); C.out = args.out; C.ws = args.ws; C.lds = (LAS unsigned char*)lds;
    C.tid = threadIdx.x; C.lane = C.tid & 63; C.wave = __builtin_amdgcn_readfirstlane(C.tid >> 6); C.G = gridDim.x; C.bid = blockIdx.x;
    LAS unsigned char* ldsl0 = (LAS unsigned char*)lds;
    if (C.tid < 64) ((LAS unsigned*)(ldsl0 + LDSCTL_OFF))[C.tid] = 0u;
    __syncthreads();
    const int lo = args.ph_lo, hi = args.ph_hi;
    XcdBarrier bar; bar.bar = WSP(unsigned, WS_CTL) + CW_BAR; bar.x = 0; bar.st = (volatile LAS unsigned*)(ldsl0 + LDSCTL_OFF + LC_BAR);
    if (hi - lo > 1) bar = xcd_barrier_post(WSP(unsigned, WS_CTL) + CW_BAR, (volatile LAS unsigned*)(ldsl0 + LDSCTL_OFF + LC_BAR));
#define IN(k) (lo <= (k) && (k) < hi)
#define SEAM(k) do { if (IN(k) && IN((k) + 1)) xcd_barrier(bar); } while (0)
#ifndef EN
#define EN 0xFFFF
#endif
    if ((EN & 1) && IN(0)) { phase0(C); SEAM(0); }
    const Ctx C0 = C;
#pragma unroll 1
    for (int l = 0; l < DEPTH; ++l) {
        const int p0 = 1 + l * PH_PER_LAYER;
        Ctx C = C0; { int t_ = C0.tid; asm volatile("" : "+v"(t_)); C.tid = t_; C.lane = t_ & 63; C.wave = __builtin_amdgcn_readfirstlane(t_ >> 6);
                      int b_ = C0.bid; asm volatile("" : "+s"(b_)); C.bid = b_; int g_ = C0.G; asm volatile("" : "+s"(g_)); C.G = g_; unsigned char* w_ = C0.ws; asm volatile("" : "+s"(w_)); C.ws = w_;
                      const CAS fptr_t* i_ = C0.in; asm volatile("" : "+s"(i_)); C.in = i_;
                      LAS unsigned char* l_ = C0.lds; asm volatile("" : "+s"(l_)); C.lds = l_; }
        LAS unsigned char* const ldsl = C.lds;
        const float* modl = WSP(const float, WS_MODS) + (size_t)l * 9 * 6144;
        if ((EN & 2) && IN(p0 + 0)) { phase_l1(C, l); SEAM(p0 + 0); }
        if ((EN & 4) && IN(p0 + 1)) {
            { pg8::SchedDense S; S.init(NTOK / 256, NHG / 256, C.G, C.bid, D, D);
              EpiHG E{WSP(bf16_t, WS_PHG), WSP(const float, WS_LOWER) + l * 512};
              pg8::gemm_phase<false>(ldsl, S, E, (const char*)WSP(bf16_t, WS_R1), (const char*)(WSP(bf16_t, WS_WIN) + (size_t)NHY * D), D, D, 128u * D * 2u, 128u * D * 2u, D / 64); }
            { pg8::SchedDense S; S.init(NHY / 256, NTOK / 256, C.G, C.bid, D, D);
              EpiHY E{WSP(bf16_t, WS_PHYT)};
              pg8::gemm_phase<false>(ldsl, S, E, (const char*)WSP(bf16_t, WS_WIN), (const char*)WSP(bf16_t, WS_R1), D, D, 128u * D * 2u, 128u * D * 2u, D / 64); }
            SEAM(p0 + 1);
        }
        if ((EN & 8) && IN(p0 + 2)) { phase_l3(C, l); SEAM(p0 + 2); }
        if ((EN & 16) && IN(p0 + 3)) { phase_l3b(C, l); SEAM(p0 + 3); }
        if ((EN & 32) && IN(p0 + 4)) {
            pg8::SchedDense S; S.init(NTOK / 256, D / 256, C.G, C.bid, D, D);
            EpiOut E{C.in[IN_X], C.in[IN_CTX], WSP(float, WS_XBUF), modl, l == 0 ? 1 : 0};
            pg8::gemm_phase<false>(ldsl, S, E, (const char*)WSP(bf16_t, WS_R1), (const char*)WSP(bf16_t, WS_WOUT), D, D, 128u * D * 2u, 128u * D * 2u, D / 64);
            SEAM(p0 + 4);
        }
        if ((EN & 64) && IN(p0 + 5)) { phase_l5a(C, l); SEAM(p0 + 5); }
        if ((EN & 128) && IN(p0 + 6)) { phase_l5b(C, l); SEAM(p0 + 6); }
        if ((EN & 256) && IN(p0 + 7)) {
            build_tiletab(C, l);
            const volatile LAS int* lc = (const volatile LAS int*)(ldsl + LDSCTL_OFF);
            SchedUp S{lc[LC_T], C.G, C.bid, lc + LC_TILEBIN};
            EpiAct E{WSP(bf16_t, WS_R1), WSP(const float, WS_ROWW)};
            pg8::gemm_phase<false>(ldsl, S, E, (const char*)WSP(bf16_t, WS_PHG), (const char*)WSP(bf16_t, WS_WG), D, D, 128u * D * 2u, (unsigned)(WS_WU - WS_WG), D / 64);
            SEAM(p0 + 7);
        }
        if ((EN & 512) && IN(p0 + 8)) {
            build_tiletab(C, l);
            const volatile LAS int* lc = (const volatile LAS int*)(ldsl + LDSCTL_OFF);
            SchedDown S{lc[LC_T], C.G, C.bid, lc + LC_TILEBIN};
            EpiDown E{WSP(float, WS_XBUF), WSP(const int, WS_ROWTOK), modl};
            pg8::gemm_phase<true>(ldsl, S, E, (const char*)WSP(bf16_t, WS_R1), (const char*)WSP(bf16_t, WS_WD), 512, 256, 128u * 512u * 2u, 128u * 256u * 2u, 4);
            SEAM(p0 + 8);
        }
    }
    if ((EN & 1024) && IN(N_PHASES - 1)) phase_final(C);
#undef IN
#undef SEAM
}

extern "C" void kernel_launch(void* const* d_in, const int* in_sizes, int n_in, void* d_out, int out_size, void* d_ws, size_t ws_size, hipStream_t stream) {
    static int grid = 0;
    if (grid == 0) {
        if (n_in != N_IN || in_sizes[0] != NLAT * D || out_size != NLAT * D || ws_size < WS_END) { fprintf(stderr, "kernel_launch: unexpected shapes / workspace (%d inputs, ws %zu < %zu)\n", n_in, ws_size, (size_t)WS_END); grid = -1; return; }
        int dev = 0, cus = 0, per_cu = 0;
        if (hipGetDevice(&dev) != hipSuccess || hipDeviceGetAttribute(&cus, hipDeviceAttributeMultiprocessorCount, dev) != hipSuccess) { grid = -1; return; }
        if (hipFuncSetAttribute((const void*)trunk_fwd, hipFuncAttributeMaxDynamicSharedMemorySize, LDS_BYTES) != hipSuccess) { fprintf(stderr, "kernel_launch: hipFuncSetAttribute failed\n"); grid = -1; return; }
        if (hipOccupancyMaxActiveBlocksPerMultiprocessor(&per_cu, (const void*)trunk_fwd, NTHR, LDS_BYTES) != hipSuccess || per_cu < 1) { fprintf(stderr, "kernel_launch: occupancy query says %d\n", per_cu); }
        (void)hipGetLastError();
        grid = cus;
    }
    if (grid < 0) return;
    (void)hipMemsetAsync((char*)d_ws + WS_CTL, 0, CTL_ZERO_BYTES, stream);
    Args a{};
    for (int i = 0; i < N_IN; ++i) a.in[i] = (const float*)d_in[i];
    a.out = (float*)d_out; a.ws = (unsigned char*)d_ws;
#if MK_PER_PHASE
    for (int p = 0; p < N_PHASES; ++p) { a.ph_lo = p; a.ph_hi = p + 1; hipLaunchKernelGGL(trunk_fwd, dim3(grid), dim3(NTHR), LDS_BYTES, stream, a); }
#else
    a.ph_lo = 0; a.ph_hi = N_PHASES;
    hipLaunchKernelGGL(trunk_fwd, dim3(grid), dim3(NTHR), LDS_BYTES, stream, a);
#endif
}
```

```cpp
#include <hip/hip_runtime.h>
#include <cstdio>
#include <cstdint>

#ifndef PROBE_HOST
#define PROBE_HOST 0
#endif
#ifndef MK_PER_PHASE
#define MK_PER_PHASE 0
#endif

#define LAS __attribute__((address_space(3)))
typedef unsigned short bf16_t;
typedef short bf16x8 __attribute__((ext_vector_type(8)));
typedef float f32x4 __attribute__((ext_vector_type(4)));
typedef float f32x2 __attribute__((ext_vector_type(2)));
typedef unsigned u32x4 __attribute__((ext_vector_type(4)));
typedef unsigned u32x2 __attribute__((ext_vector_type(2)));

constexpr int NB = 8, SEQ = 2048, D = 1024, DEPTH = 4, CTXL = 256;
constexpr int NLAT = NB * SEQ, NCTX = NB * CTXL, NTOK = NLAT + NCTX;
constexpr int DH = 512, NHY = 1536, NHG = 2560, DIN = 4096;
constexpr int NE = 16, DE = 256, NBIN = 24, SROWS = 24576;
constexpr float EPS = 1e-6f;
constexpr int NTHR = 512, NWAVES = 8;
enum { IN_X = 0, IN_C, IN_CTX, IN_CCTX, IN_WMOD, IN_BMOD, IN_WIN, IN_WOUT, IN_CONVW, IN_CONVB, IN_W1, IN_B1, IN_W2, IN_B2, IN_W3, IN_B3,
       IN_HYBIAS, IN_LB, IN_NORMW, IN_RW, IN_RB, IN_WG, IN_WU, IN_WD, IN_FNW, N_IN };

constexpr size_t MiB = 1u << 20;
constexpr size_t WS_CTL = 0, CTL_ZERO_BYTES = 1 * MiB;
constexpr size_t WS_MODS = 1 * MiB;
constexpr size_t WS_LOWER = 2 * MiB;
constexpr size_t WS_H2L = 3 * MiB;
constexpr size_t WS_H2C = 5 * MiB;
constexpr size_t WS_TOKINFO = 6 * MiB;
constexpr size_t WS_BLKBASE = 6 * MiB + 320 * 1024;
constexpr size_t WS_ROWTOK = 6 * MiB + 512 * 1024;
constexpr size_t WS_ROWW = 7 * MiB;
constexpr size_t WS_WIN = 8 * MiB;
constexpr size_t WS_WOUT = 16 * MiB;
constexpr size_t WS_WG = 18 * MiB;
constexpr size_t WS_WU = 26 * MiB;
constexpr size_t WS_WD = 34 * MiB;
constexpr size_t WS_KSPEC = 42 * MiB;
constexpr size_t WS_XBUF = 74 * MiB;
constexpr size_t WS_R1 = 146 * MiB;
constexpr size_t WS_PHG = 182 * MiB;
constexpr size_t WS_PHYT = 272 * MiB;
constexpr size_t WS_ODIR = 326 * MiB;
constexpr size_t WS_KSPC = 362 * MiB;
constexpr size_t WS_END = 378 * MiB;
constexpr int CW_BAR = 4096;
constexpr int CW_CNT = 16384;
constexpr int CW_Q = 32768;

constexpr int LDS_BYTES = 147456;
constexpr int LDSCTL_OFF = 143 * 1024;
constexpr int LC_BAR = 0;
constexpr int LC_T = 8;
constexpr int LC_Q = 9;
constexpr int LC_OFFS = 16;
constexpr int LC_TILEBIN = 48;

__device__ __forceinline__ unsigned f2bf(float f) { unsigned u = __builtin_bit_cast(unsigned, f); return (u + 0x7fffu + ((u >> 16) & 1u)) >> 16; }
__device__ __forceinline__ unsigned pk2(float lo, float hi) { return f2bf(lo) | (f2bf(hi) << 16); }
__device__ __forceinline__ float bf2f(unsigned b) { return __builtin_bit_cast(float, (b & 0xffffu) << 16); }
__device__ __forceinline__ float bflo(unsigned w) { return __builtin_bit_cast(float, w << 16); }
__device__ __forceinline__ float bfhi(unsigned w) { return __builtin_bit_cast(float, w & 0xffff0000u); }
__device__ __forceinline__ float sigmoidf_(float x) { return 1.0f / (1.0f + __expf(-x)); }
__device__ __forceinline__ float siluf_(float x) { return x / (1.0f + __expf(-x)); }
#define DPP_ADD(v, ctrl, rmask) v += __builtin_bit_cast(float, __builtin_amdgcn_update_dpp(0, __builtin_bit_cast(int, v), ctrl, rmask, 0xF, false))
__device__ __forceinline__ float row16_sum(float v) {
    DPP_ADD(v, 0xB1, 0xF);
    DPP_ADD(v, 0x4E, 0xF);
    DPP_ADD(v, 0x141, 0xF);
    DPP_ADD(v, 0x140, 0xF);
    return v;
}
__device__ __forceinline__ float wave_sum(float v) {
    v = row16_sum(v);
    DPP_ADD(v, 0x142, 0xA);
    DPP_ADD(v, 0x143, 0xC);
    return __builtin_bit_cast(float, __builtin_amdgcn_readlane(__builtin_bit_cast(int, v), 63));
}
__device__ __forceinline__ int bidx(int row) { return row < NLAT ? (row >> 11) : 8; }
#define LDS_WAIT() asm volatile("s_waitcnt lgkmcnt(0)" ::: "memory")

#define XB_TMO      128
#define XB_XCNT(j)  (256  + 64 * (j))
#define XB_XSUB(j)  (1280 + 64 * (j))
#define XB_XGEN(j)  (2304 + 64 * (j))
#define XB_TOP      3328
#define XB_TOPGEN   3392
#define XCD_BAR_WORDS 3456
#define XB_SPIN_CAP (1u << 18)
__device__ __forceinline__ unsigned xb_ld(unsigned* p)              { return __hip_atomic_load(p, __ATOMIC_RELAXED, __HIP_MEMORY_SCOPE_AGENT); }
__device__ __forceinline__ unsigned xb_add(unsigned* p, unsigned v) { return __hip_atomic_fetch_add(p, v, __ATOMIC_RELAXED, __HIP_MEMORY_SCOPE_AGENT); }
__device__ __forceinline__ unsigned xb_xcc_id() { return (unsigned)__builtin_amdgcn_s_getreg((3 << 11) | 20) & 0xFu; }
#define XB_SPIN(cond, bar) do { unsigned _sp = 0; while (cond) { __builtin_amdgcn_s_sleep(1); \
    if ((++_sp & 255u) == 0u) { if (xb_ld(&(bar)[XB_TMO])) break; if (_sp > XB_SPIN_CAP) { atomicAdd(&(bar)[XB_TMO], 1u); break; } } } } while (0)
struct XcdBarrier { unsigned* bar; unsigned x; volatile LAS unsigned* st; };
__device__ __forceinline__ XcdBarrier xcd_barrier_post(unsigned* bar, volatile LAS unsigned* st) {
    XcdBarrier b; b.bar = bar; b.x = xb_xcc_id(); b.st = st;
    if (threadIdx.x == 0) (void)xb_add(&bar[XB_XCNT(b.x)], 1u);
    return b;
}
__device__ __forceinline__ void xcd_barrier_complete(unsigned* bar, unsigned x, unsigned& nloc, unsigned& nx) {
    const unsigned G = gridDim.x * gridDim.y * gridDim.z;
    unsigned sum, cnt, mine, sp = 0u;
    for (;;) {
        sum = 0u; cnt = 0u; mine = 0u;
#pragma unroll
        for (unsigned j = 0; j < 16; ++j) { const unsigned c = xb_ld(&bar[XB_XCNT(j)]); sum += c; cnt += (c > 0u) ? 1u : 0u; mine = (j == x) ? c : mine; }
        if (sum == G) break;
        __builtin_amdgcn_s_sleep(1);
        if ((++sp & 255u) == 0u) { if (xb_ld(&bar[XB_TMO])) break; if (sp > XB_SPIN_CAP) { atomicAdd(&bar[XB_TMO], 1u); break; } }
    }
    nloc = mine > 0u ? mine : 1u; nx = cnt > 0u ? cnt : 1u;
}
__device__ __forceinline__ void xcd_barrier(const XcdBarrier& b) {
    asm volatile("s_waitcnt vmcnt(0)" ::: "memory");
    __syncthreads();
    if (threadIdx.x == 0) {
        unsigned* bar = b.bar; unsigned bx = b.x;
        asm volatile("" : "+s"(bar), "+s"(bx));
        __builtin_amdgcn_s_waitcnt(0);
        unsigned nloc = b.st[0], nx = b.st[1];
        if (nloc == 0u) { xcd_barrier_complete(bar, bx, nloc, nx); b.st[0] = nloc; b.st[1] = nx; }
        const unsigned old = xb_add(&bar[XB_XSUB(bx)], 1u);
        const unsigned gen = old / nloc;
        if (old + 1u == (gen + 1u) * nloc) {
            __builtin_amdgcn_fence(__ATOMIC_RELEASE, "agent");
            asm volatile("s_waitcnt vmcnt(0)" ::: "memory");
            const unsigned og = xb_add(&bar[XB_TOP], 1u);
            const unsigned tg = og / nx;
            if (og + 1u == (tg + 1u) * nx) xb_add(&bar[XB_TOPGEN], 1u);
            else XB_SPIN(xb_ld(&bar[XB_TOPGEN]) == tg, bar);
            __builtin_amdgcn_fence(__ATOMIC_ACQUIRE, "agent");
            xb_add(&bar[XB_XGEN(bx)], 1u);
            asm volatile("s_waitcnt vmcnt(0)" ::: "memory");
        } else {
            XB_SPIN(xb_ld(&bar[XB_XGEN(bx)]) == gen, bar);
            __builtin_amdgcn_fence(__ATOMIC_ACQUIRE, "agent");
            asm volatile("s_waitcnt vmcnt(0)" ::: "memory");
        }
    }
    __syncthreads();
}

namespace pg8 {
constexpr int BM = 256, BK = 64, HALF = 128, HTB = HALF * BK * 2, STAGE_BYTES = 8 * HTB, NXCD = 8, WGM = 8;
__host__ __device__ __forceinline__ int lds_byte(int r, int c) { const int st = (r >> 4) * 2 + (c >> 5), rr = r & 15, cc = c & 31, ob = rr * 64 + cc * 2; return st * 1024 + (ob ^ (((ob >> 9) & 1) << 5)); }
__host__ __device__ __forceinline__ void stage_rc(int b, int& R, int& C) { const int st = b / 1024, sb = b % 1024, swz = sb ^ (((sb >> 9) & 1) << 5); R = (st >> 1) * 16 + swz / 64; C = (st & 1) * 32 + (swz % 64) / 2; }
__host__ __device__ __forceinline__ int perm32(int rho) { const int n = rho >> 4, i = rho & 15; return 8 * (i >> 2) + 4 * n + (i & 3); }

struct GUnit { unsigned a, b; int last, i0, i1; };

template <bool SUB, class Epi, class Sched>
__device__ __forceinline__ void gemm_phase(LAS unsigned char* lds, const Sched& S, const Epi& E, const char* Abase, const char* Bbase, const int lda, const int ldb, const unsigned ahalf, const unsigned bhalf, const int nt) {
    int tid_ = threadIdx.x; asm volatile("" : "+v"(tid_));
    const int tid = tid_, wid = __builtin_amdgcn_readfirstlane(tid >> 6), lane = tid & 63, wr = wid >> 2, wc = wid & 3, fr = lane & 15, fq = lane >> 4;
    unsigned voffA[2], voffB[2];
#pragma unroll
    for (int i = 0; i < 2; ++i) { int R, C; stage_rc(tid * 16 + i * 8192, R, C); const int Rb = Epi::PERM ? ((R & ~31) + perm32(R & 31)) : R;
        voffA[i] = (unsigned)(R * lda + C) * 2u; voffB[i] = (unsigned)(Rb * ldb + C) * 2u; }
    constexpr unsigned kstep = BK * 2;
    const unsigned ldsw = (unsigned)wid * 1024u;
    const int aoff = lds_byte(wr * 64 + fr, fq * 8), boff = lds_byte(wc * 32 + fr, fq * 8);
#define PG8_SA(b, h) (((b) * 2 + (h)) * HTB)
#define PG8_SB(b, h) ((4 + (b) * 2 + (h)) * HTB)
#define PG8_STAGE(bufoff, gbase, voff) do { _Pragma("unroll") for (int _i = 0; _i < 2; ++_i) \
        __builtin_amdgcn_global_load_lds((const unsigned*)((const char*)(gbase) + (voff)[_i]), (LAS unsigned*)(lds + (bufoff) + ldsw + _i * 8192), 16, 0, 0); } while (0)
#define PG8_LDA(dst, b, h) do { _Pragma("unroll") for (int m = 0; m < 4; ++m) _Pragma("unroll") for (int k = 0; k < 2; ++k) dst[m][k] = *(const LAS bf16x8*)(lds + PG8_SA(b, h) + aoff + m * 2048 + k * 1024); } while (0)
#define PG8_LDB(dst, b, h) do { _Pragma("unroll") for (int n = 0; n < 2; ++n) _Pragma("unroll") for (int k = 0; k < 2; ++k) dst[n][k] = *(const LAS bf16x8*)(lds + PG8_SB(b, h) + boff + n * 2048 + k * 1024); } while (0)
#define PG8_MMA(ai, bj, At, Bt) do { __builtin_amdgcn_s_setprio(1); _Pragma("unroll") for (int m = 0; m < 4; ++m) _Pragma("unroll") for (int n = 0; n < 2; ++n) _Pragma("unroll") for (int k = 0; k < 2; ++k) \
        acc[ai][bj][m][n] = __builtin_amdgcn_mfma_f32_16x16x32_bf16(Bt[n][k], At[m][k], acc[ai][bj][m][n], 0, 0, 0); __builtin_amdgcn_s_setprio(0); } while (0)
#define PG8_WAIT_V(n) asm volatile("s_waitcnt vmcnt(" #n ")" ::: "memory")
#define PG8_WAIT_L(n) asm volatile("s_waitcnt lgkmcnt(" #n ")" ::: "memory")
#define PG8_BAR __builtin_amdgcn_s_barrier()
#define PG8_SCHED __builtin_amdgcn_sched_barrier(0)
    GUnit cur, nxt; int ui = 0;
    if (!S.next(0, cur)) return;
    f32x4 acc[2][2][4][2];
#pragma unroll
    for (int a = 0; a < 2; ++a)
#pragma unroll
        for (int b = 0; b < 2; ++b)
#pragma unroll
            for (int m = 0; m < 4; ++m)
#pragma unroll
                for (int n = 0; n < 2; ++n) acc[a][b][m][n] = (f32x4){0.f, 0.f, 0.f, 0.f};
    bf16x8 At[4][2], B0[2][2], B1[2][2];
    { const char* cA = Abase + cur.a; const char* cB = Bbase + cur.b;
      PG8_STAGE(PG8_SB(0, 0), cB, voffB); PG8_STAGE(PG8_SB(0, 1), cB + bhalf, voffB); PG8_STAGE(PG8_SA(0, 0), cA, voffA); PG8_STAGE(PG8_SA(0, 1), cA + ahalf, voffA);
      if (wr == 1) PG8_BAR;
      PG8_WAIT_V(2); PG8_BAR;
      PG8_STAGE(PG8_SB(1, 0), cB + kstep, voffB); PG8_STAGE(PG8_SA(1, 0), cA + kstep, voffA); PG8_STAGE(PG8_SB(1, 1), cB + bhalf + kstep, voffB);
      PG8_WAIT_V(6); PG8_BAR; }
    for (;;) {
        const bool has_next = S.next(ui + 1, nxt);
        const char* cA = Abase + cur.a; const char* cB = Bbase + cur.b;
        const char* nA = Abase + (has_next ? nxt.a : cur.a); const char* nB = Bbase + (has_next ? nxt.b : cur.b);
        for (int t = 0; t < nt; t += 2) {
            const bool last = (t == nt - 2);
            const char* a1 = cA + (unsigned)(t + 1) * kstep;
            const char* a2 = last ? nA : cA + (unsigned)(t + 2) * kstep; const char* b2 = last ? nB : cB + (unsigned)(t + 2) * kstep;
            const char* a3 = a2 + kstep; const char* b3 = b2 + kstep;
            PG8_LDB(B0, 0, 0); PG8_LDB(B1, 0, 1); PG8_SCHED; PG8_LDA(At, 0, 0); PG8_STAGE(PG8_SA(1, 1), a1 + ahalf, voffA);
            PG8_WAIT_V(8); PG8_WAIT_L(0); PG8_BAR; PG8_MMA(0, 0, At, B0); PG8_MMA(0, 1, At, B1); PG8_BAR; PG8_SCHED;
            PG8_LDA(At, 0, 1); PG8_STAGE(PG8_SB(0, 0), b2, voffB); PG8_STAGE(PG8_SB(0, 1), b2 + bhalf, voffB); PG8_STAGE(PG8_SA(0, 0), a2, voffA);
            PG8_WAIT_V(8); PG8_WAIT_L(0); PG8_BAR; PG8_MMA(1, 0, At, B0); PG8_MMA(1, 1, At, B1); PG8_BAR; PG8_SCHED;
            PG8_LDB(B0, 1, 0); PG8_LDB(B1, 1, 1); PG8_SCHED; PG8_LDA(At, 1, 0); PG8_STAGE(PG8_SA(0, 1), a2 + ahalf, voffA);
            PG8_WAIT_V(8); PG8_WAIT_L(0); PG8_BAR; PG8_MMA(0, 0, At, B0); PG8_MMA(0, 1, At, B1); PG8_BAR; PG8_SCHED;
            PG8_LDA(At, 1, 1); PG8_STAGE(PG8_SB(1, 0), b3, voffB); PG8_STAGE(PG8_SB(1, 1), b3 + bhalf, voffB); PG8_STAGE(PG8_SA(1, 0), a3, voffA);
            PG8_WAIT_V(8); PG8_WAIT_L(0); PG8_BAR; PG8_MMA(1, 0, At, B0); PG8_MMA(1, 1, At, B1); PG8_BAR; PG8_SCHED;
        }
        const bool fin = SUB ? (cur.last != 0) : true;
        if (fin) { if (wr == 0) PG8_BAR; E(acc, cur, wr, wc, fr, fq); }
        if (!has_next) break;
        if (fin) {
#pragma unroll
            for (int a = 0; a < 2; ++a)
#pragma unroll
                for (int b = 0; b < 2; ++b)
#pragma unroll
                    for (int m = 0; m < 4; ++m)
#pragma unroll
                        for (int n = 0; n < 2; ++n) acc[a][b][m][n] = (f32x4){0.f, 0.f, 0.f, 0.f};
        }
        cur = nxt; ++ui;
        if (fin) { if (wr == 1) PG8_BAR; }
    }
    PG8_WAIT_V(0);
    PG8_BAR;
#undef PG8_SA
#undef PG8_SB
#undef PG8_STAGE
#undef PG8_LDA
#undef PG8_LDB
#undef PG8_MMA
#undef PG8_WAIT_V
#undef PG8_WAIT_L
#undef PG8_BAR
#undef PG8_SCHED
}

struct SchedDense {
    int nM, nN, nwg, G, c; unsigned atile, btile;
    __device__ __forceinline__ void init(int nM_, int nN_, int G_, int c_, int lda, int ldb) {
        nM = nM_; nN = nN_; nwg = nM * nN; G = G_; c = c_; atile = 256u * lda * 2u; btile = 256u * ldb * 2u; }
    __device__ __forceinline__ bool next(int i, GUnit& u) const {
        const int L = i * G + c; if (L >= nwg) return false;
        int wgid = L; { const int q = nwg / NXCD, r = nwg % NXCD, xcd = wgid % NXCD, off = wgid / NXCD; wgid = (xcd < r ? xcd * (q + 1) : r * (q + 1) + (xcd - r) * q) + off; }
        const int nig = WGM * nN, gid = wgid / nig, fm = gid * WGM, gsz = (nM - fm) < WGM ? (nM - fm) : WGM;
        const int pm = fm + ((wgid % nig) % gsz), pn = (wgid % nig) / gsz;
        u.a = (unsigned)pm * atile; u.b = (unsigned)pn * btile; u.last = 1; u.i0 = pm; u.i1 = pn; return true;
    }
};
}

struct Args { const float* in[N_IN]; float* out; unsigned char* ws; int ph_lo, ph_hi, rep, pad; };
static_assert(sizeof(Args) == N_IN * 8 + 8 + 8 + 16, "Args has no padding");

#define CAS __attribute__((address_space(4)))
typedef const float* fptr_t;
struct Ctx {
    const CAS fptr_t* in; float* out; unsigned char* ws; LAS unsigned char* lds; int tid, lane, wave, G, bid, rep, dry;
};
#define WSP(T, off) ((T*)(C.ws + (off)))

__device__ __forceinline__ void build_tiletab(const Ctx& C, int l) {
    volatile LAS int* lc = (volatile LAS int*)(C.lds + LDSCTL_OFF);
    __syncthreads();
    if (C.tid == 0) {
        const unsigned* cnt = WSP(const unsigned, WS_CTL) + CW_CNT + l * 32 * 64;
        int off = 0, t = 0;
        for (int b = 0; b < NBIN; ++b) {
            const int n = (int)__hip_atomic_load(cnt + b * 64, __ATOMIC_RELAXED, __HIP_MEMORY_SCOPE_AGENT);
            lc[LC_OFFS + b] = off;
            const int nt = (n + 255) >> 8;
            for (int k = 0; k < nt; ++k) lc[LC_TILEBIN + t + k] = b;
            t += nt; off += nt * 256;
        }
        lc[LC_OFFS + NBIN] = off; lc[LC_T] = t;
    }
    __syncthreads();
}
__device__ __forceinline__ int expert_of(int bin, int es) {
    const int g = bin / 6, p = bin - g * 6;
    const int lo = p < 3 ? 0 : (p < 5 ? 1 : 2), hi = p < 3 ? p + 1 : (p < 5 ? p - 1 : 3);
    return 4 * g + (es ? hi : lo);
}

struct SchedUp {
    int T, G, c; const volatile LAS int* tilebin;
    __device__ __forceinline__ bool next(int i, pg8::GUnit& u) const {
        const int idx = i * G + c; if (idx >= 4 * T) return false;
        const int rt = idx >> 2, q = idx & 3, es = q >> 1, fb = q & 1;
        const int bin = __builtin_amdgcn_readfirstlane(tilebin[rt]);
        const int e = expert_of(bin, es);
        u.a = (unsigned)rt * 256u * 2048u; u.b = (unsigned)(e * 256 + fb * 128) * 2048u;
        u.last = 1; u.i0 = rt; u.i1 = q; return true;
    }
};
struct SchedDown {
    int T, G, c; const volatile LAS int* tilebin;
    __device__ __forceinline__ bool next(int i, pg8::GUnit& u) const {
        const int idx = (i >> 1) * G + c, sub = i & 1; if (idx >= 4 * T) return false;
        const int rt = idx >> 2, pn = idx & 3;
        const int bin = __builtin_amdgcn_readfirstlane(tilebin[rt]);
        const int e = expert_of(bin, sub);
        u.a = (unsigned)rt * 256u * 1024u + (unsigned)sub * 512u; u.b = (unsigned)(e * 1024 + pn * 256) * 512u;
        u.last = sub; u.i0 = rt; u.i1 = pn; return true;
    }
};

struct EpiHG {
    static constexpr bool PERM = true;
    bf16_t* O; const float* lower;
    __device__ __forceinline__ void operator()(const f32x4 (&acc)[2][2][4][2], const pg8::GUnit& u, int wr, int wc, int fr, int fq) const {
        const int kind = u.i1 >> 1;
        const int row0 = u.i0 * 256 + wr * 64 + fr, colt = u.i1 * 256 + wc * 32 + 8 * fq;
#pragma unroll
        for (int bj = 0; bj < 2; ++bj) {
            const int col = colt + bj * 128;
            float om[8];
#pragma unroll
            for (int j = 0; j < 8; ++j) om[j] = 1.f;
            if (kind >= 3) { const float* lb = lower + (kind - 3) * 2048 + (col & 511);
#pragma unroll
                for (int j = 0; j < 8; ++j) om[j] = 1.f - lb[j]; }
#pragma unroll
            for (int ai = 0; ai < 2; ++ai)
#pragma unroll
                for (int m = 0; m < 4; ++m) {
                    float v[8];
#pragma unroll
                    for (int j = 0; j < 8; ++j) v[j] = acc[ai][bj][m][j >> 2][j & 3];
                    if (kind == 0) {
#pragma unroll
                        for (int j = 0; j < 8; ++j) v[j] = siluf_(v[j]);
                    } else if (kind >= 3) {
#pragma unroll
                        for (int j = 0; j < 8; ++j) v[j] = om[j] * sigmoidf_(-v[j]);
                    }
                    u32x4 w; w.x = pk2(v[0], v[1]); w.y = pk2(v[2], v[3]); w.z = pk2(v[4], v[5]); w.w = pk2(v[6], v[7]);
                    *(u32x4*)(O + (size_t)(row0 + ai * 128 + m * 16) * NHG + col) = w;
                }
        }
    }
};
struct EpiHY {
    static constexpr bool PERM = true;
    bf16_t* O;
    __device__ __forceinline__ void operator()(const f32x4 (&acc)[2][2][4][2], const pg8::GUnit& u, int wr, int wc, int fr, int fq) const {
        const int row0 = u.i0 * 256 + wr * 64 + fr, colt = u.i1 * 256 + wc * 32 + 8 * fq;
#pragma unroll
        for (int ai = 0; ai < 2; ++ai)
#pragma unroll
            for (int m = 0; m < 4; ++m)
#pragma unroll
                for (int bj = 0; bj < 2; ++bj) {
                    const f32x4 v0 = acc[ai][bj][m][0], v1 = acc[ai][bj][m][1];
                    u32x4 w; w.x = pk2(v0[0], v0[1]); w.y = pk2(v0[2], v0[3]); w.z = pk2(v1[0], v1[1]); w.w = pk2(v1[2], v1[3]);
                    *(u32x4*)(O + (size_t)(row0 + ai * 128 + m * 16) * NTOK + colt + bj * 128) = w;
                }
    }
};
struct EpiOut {
    static constexpr bool PERM = false;
    const float* xlat; const float* xctx; float* xo; const float* mods; int first; int dry;
    __device__ __forceinline__ void operator()(const f32x4 (&acc)[2][2][4][2], const pg8::GUnit& u, int wr, int wc, int fr, int fq) const {
        const int row0 = u.i0 * 256 + wr * 64 + fr, col0 = u.i1 * 256 + wc * 32 + 4 * fq;
#pragma unroll
        for (int ai = 0; ai < 2; ++ai)
#pragma unroll
            for (int m = 0; m < 4; ++m) {
                const int row = row0 + ai * 128 + m * 16;
                const float* src = first ? (row < NLAT ? xlat + (size_t)row * D : xctx + (size_t)(row - NLAT) * D) : xo + (size_t)row * D;
                const float* g1 = mods + bidx(row) * 6144 + 2048;
#pragma unroll
                for (int bj = 0; bj < 2; ++bj)
#pragma unroll
                    for (int n = 0; n < 2; ++n) { const int col = col0 + bj * 128 + n * 16;
                        const f32x4 xv = *(const f32x4*)(src + col), gv = *(const f32x4*)(g1 + col);
                        if (!dry) *(f32x4*)(xo + (size_t)row * D + col) = xv + gv * acc[ai][bj][m][n]; }
            }
    }
};
struct EpiAct {
    static constexpr bool PERM = true;
    bf16_t* O; const float* roww;
    __device__ __forceinline__ void operator()(const f32x4 (&acc)[2][2][4][2], const pg8::GUnit& u, int wr, int wc, int fr, int fq) const {
        const int es = u.i1 >> 1; const int pos0 = u.i0 * 256 + wr * 64 + fr, col = u.i1 * 128 + wc * 32 + 8 * fq;
#pragma unroll
        for (int ai = 0; ai < 2; ++ai)
#pragma unroll
            for (int m = 0; m < 4; ++m) {
                const int pos = pos0 + ai * 128 + m * 16;
                const float wgt = roww[pos * 2 + es];
                float v[8];
#pragma unroll
                for (int j = 0; j < 8; ++j) v[j] = siluf_(acc[ai][0][m][j >> 2][j & 3]) * acc[ai][1][m][j >> 2][j & 3] * wgt;
                u32x4 w; w.x = pk2(v[0], v[1]); w.y = pk2(v[2], v[3]); w.z = pk2(v[4], v[5]); w.w = pk2(v[6], v[7]);
                *(u32x4*)(O + (size_t)pos * 512 + col) = w;
            }
    }
};
struct EpiDown {
    static constexpr bool PERM = false;
    float* xo; const int* rowtok; const float* mods; int dry;
    __device__ __forceinline__ void operator()(const f32x4 (&acc)[2][2][4][2], const pg8::GUnit& u, int wr, int wc, int fr, int fq) const {
        const int pos0 = u.i0 * 256 + wr * 64 + fr, col0 = u.i1 * 256 + wc * 32 + 4 * fq;
#pragma unroll
        for (int ai = 0; ai < 2; ++ai)
#pragma unroll
            for (int m = 0; m < 4; ++m) {
                const int tok = rowtok[pos0 + ai * 128 + m * 16];
                if (tok >= 0) {
                    const float* g2 = mods + bidx(tok) * 6144 + 5120;
                    float* xr = xo + (size_t)tok * D;
#pragma unroll
                    for (int bj = 0; bj < 2; ++bj)
#pragma unroll
                        for (int n = 0; n < 2; ++n) { const int col = col0 + bj * 128 + n * 16;
                            const f32x4 xv = *(const f32x4*)(xr + col), gv = *(const f32x4*)(g2 + col);
                            if (!dry) *(f32x4*)(xr + col) = xv + gv * acc[ai][bj][m][n]; }
                }
            }
    }
};

__device__ __forceinline__ int padx(int i) { return i + (i >> 3); }
__device__ __forceinline__ f32x2 cmul(f32x2 a, f32x2 b) { return (f32x2){a.x * b.x - a.y * b.y, a.x * b.y + a.y * b.x}; }
__device__ __forceinline__ f32x2 cmulc(f32x2 a, f32x2 b) { return (f32x2){a.x * b.x + a.y * b.y, a.y * b.x - a.x * b.y}; }
constexpr int XPAD = 2048 + 256;

__device__ __forceinline__ void fft_p1_dif(f32x2 (&v)[8], int tt, const LAS f32x2* T) {
#pragma unroll
    for (int g = 0; g < 2; ++g) { const int u = tt + 256 * g;
#pragma unroll
        for (int j = 0; j < 2; ++j) { const f32x2 a = v[g + 2 * j], b = v[g + 2 * j + 4]; v[g + 2 * j] = a + b; v[g + 2 * j + 4] = cmul(a - b, T[2 * (u + 512 * j)]); }
        const f32x2 tw = T[4 * u];
        { const f32x2 a = v[g], b = v[g + 2]; v[g] = a + b; v[g + 2] = cmul(a - b, tw); }
        { const f32x2 a = v[g + 4], b = v[g + 6]; v[g + 4] = a + b; v[g + 6] = cmul(a - b, tw); } }
}
__device__ __forceinline__ void fft_p1_dit(f32x2 (&v)[8], int tt, const LAS f32x2* T) {
#pragma unroll
    for (int g = 0; g < 2; ++g) { const int u = tt + 256 * g;
        const f32x2 tw = T[4 * u];
        { const f32x2 a = v[g], b = cmulc(v[g + 2], tw); v[g] = a + b; v[g + 2] = a - b; }
        { const f32x2 a = v[g + 4], b = cmulc(v[g + 6], tw); v[g + 4] = a + b; v[g + 6] = a - b; }
#pragma unroll
        for (int j = 0; j < 2; ++j) { const f32x2 a = v[g + 2 * j], b = cmulc(v[g + 2 * j + 4], T[2 * (u + 512 * j)]); v[g + 2 * j] = a + b; v[g + 2 * j + 4] = a - b; } }
}
template <int Q> __device__ __forceinline__ void r8_dif(f32x2 (&e)[8], int r, const LAS f32x2* T) {
    constexpr int S2 = 512 / Q;
#pragma unroll
    for (int j = 0; j < 4; ++j) { const f32x2 a = e[j], b = e[j + 4]; e[j] = a + b; e[j + 4] = cmul(a - b, T[S2 * (r + Q * j)]); }
#pragma unroll
    for (int jj = 0; jj < 4; ++jj) { const int j = (jj & 1) + 4 * (jj >> 1); const f32x2 a = e[j], b = e[j + 2]; e[j] = a + b; e[j + 2] = cmul(a - b, T[2 * S2 * (r + Q * (j & 1))]); }
    const f32x2 tw = T[4 * S2 * r];
#pragma unroll
    for (int j = 0; j < 8; j += 2) { const f32x2 a = e[j], b = e[j + 1]; e[j] = a + b; e[j + 1] = cmul(a - b, tw); }
}
template <int Q> __device__ __forceinline__ void r8_dit(f32x2 (&e)[8], int r, const LAS f32x2* T) {
    constexpr int S2 = 512 / Q;
    const f32x2 tw = T[4 * S2 * r];
#pragma unroll
    for (int j = 0; j < 8; j += 2) { const f32x2 a = e[j], b = cmulc(e[j + 1], tw); e[j] = a + b; e[j + 1] = a - b; }
#pragma unroll
    for (int jj = 0; jj < 4; ++jj) { const int j = (jj & 1) + 4 * (jj >> 1); const f32x2 a = e[j], b = cmulc(e[j + 2], T[2 * S2 * (r + Q * (j & 1))]); e[j] = a + b; e[j + 2] = a - b; }
#pragma unroll
    for (int j = 0; j < 4; ++j) { const f32x2 a = e[j], b = cmulc(e[j + 4], T[S2 * (r + Q * j)]); e[j] = a + b; e[j + 4] = a - b; }
}
template <int Q, bool INV> __device__ __forceinline__ void fft_mid(LAS f32x2* X, int tt, const LAS f32x2* T) {
    const int blk = tt / Q, r = tt % Q, base = blk * 8 * Q + r;
    f32x2 e[8];
#pragma unroll
    for (int j = 0; j < 8; ++j) e[j] = X[padx(base + Q * j)];
    if (INV) r8_dit<Q>(e, r, T); else r8_dif<Q>(e, r, T);
#pragma unroll
    for (int j = 0; j < 8; ++j) X[padx(base + Q * j)] = e[j];
}
__device__ __forceinline__ void fft_conv_half(f32x2 (&v)[8], LAS f32x2* X, const LAS f32x2* T, const f32x2* K, int tt) {
    f32x2 kv[8];
#pragma unroll
    for (int j = 0; j < 8; ++j) kv[j] = K[8 * tt + j];
    fft_p1_dif(v, tt, T);
#pragma unroll
    for (int m = 0; m < 8; ++m) X[padx(tt + 256 * m)] = v[m];
    __syncthreads();
    fft_mid<64, false>(X, tt, T); __syncthreads();
    fft_mid<8, false>(X, tt, T); __syncthreads();
    f32x2 e[8];
#pragma unroll
    for (int j = 0; j < 8; ++j) e[j] = X[padx(8 * tt + j)];
    r8_dif<1>(e, 0, T);
#pragma unroll
    for (int j = 0; j < 8; ++j) e[j] = cmul(e[j], kv[j]);
    r8_dit<1>(e, 0, T);
#pragma unroll
    for (int j = 0; j < 8; ++j) X[padx(8 * tt + j)] = e[j];
    __syncthreads();
    fft_mid<8, true>(X, tt, T); __syncthreads();
    fft_mid<64, true>(X, tt, T); __syncthreads();
#pragma unroll
    for (int m = 0; m < 8; ++m) v[m] = X[padx(tt + 256 * m)];
    fft_p1_dit(v, tt, T);
}
__device__ __forceinline__ void fft_fwd_store(f32x2 (&v)[8], LAS f32x2* X, const LAS f32x2* T, f32x2* Kout, int tt) {
    fft_p1_dif(v, tt, T);
#pragma unroll
    for (int m = 0; m < 8; ++m) X[padx(tt + 256 * m)] = v[m];
    __syncthreads();
    fft_mid<64, false>(X, tt, T); __syncthreads();
    fft_mid<8, false>(X, tt, T); __syncthreads();
    f32x2 e[8];
#pragma unroll
    for (int j = 0; j < 8; ++j) e[j] = X[padx(8 * tt + j)];
    r8_dif<1>(e, 0, T);
#pragma unroll
    for (int j = 0; j < 8; ++j) Kout[8 * tt + j] = e[j];
    __syncthreads();
}
__device__ __forceinline__ void build_twiddles(const Ctx& C, LAS f32x2* T) {
    for (int k = C.tid; k < 2048; k += NTHR) { float s, c; sincospif((float)k * (1.0f / 2048.0f), &s, &c); T[k] = (f32x2){c, -s}; }
}

__device__ __forceinline__ void phase0(const Ctx& C) {
    LAS float* sil = (LAS float*)C.lds;
    LAS float* red = sil + 9 * 1024;
    LAS float* zs = red + 8 * 9 * 64;
    LAS float* h1s = zs + 8 * 40;
    const float* cin = C.in[IN_C]; const float* cctx = C.in[IN_CCTX];
    for (int i = C.tid; i < 9 * 1024; i += NTHR) { const int r = i >> 10, k = i & 1023; const float v = r < 8 ? cin[r * 1024 + k] : cctx[k]; sil[i] = v / (1.0f + expf(-v)); }
    __syncthreads();
    float* mods = WSP(float, WS_MODS);
    const float* wmod = C.in[IN_WMOD]; const float* bmod = C.in[IN_BMOD];
    for (int item = C.bid; item < 4 * 96; item += C.G) {
        const int l = item / 96, cb = item % 96, cc = C.tid & 63, kg = C.tid >> 6;
        const float* w = wmod + ((size_t)l * 1024 + kg * 128) * 6144 + cb * 64 + cc;
        const LAS float* sk = sil + kg * 128;
        float acc[9];
#pragma unroll
        for (int r = 0; r < 9; ++r) acc[r] = 0.f;
#pragma unroll 4
        for (int k = 0; k < 128; ++k) { const float wv = w[(size_t)k * 6144];
#pragma unroll
            for (int r = 0; r < 9; ++r) acc[r] += sk[r * 1024 + k] * wv; }
#pragma unroll
        for (int r = 0; r < 9; ++r) red[(kg * 9 + r) * 64 + cc] = acc[r];
        __syncthreads();
        for (int o = C.tid; o < 576; o += NTHR) { const int r = o >> 6, c2 = o & 63; float s = 0.f;
#pragma unroll
            for (int g = 0; g < 8; ++g) s += red[(g * 9 + r) * 64 + c2];
            mods[(size_t)(l * 9 + r) * 6144 + cb * 64 + c2] = s + bmod[l * 6144 + cb * 64 + c2]; }
        __syncthreads();
    }
    for (int item = C.bid; item < 4 * 288; item += C.G) {
        const int l = item / 288, r = item % 288, isctx = r >= 256;
        const int L = isctx ? 256 : 2048, t0 = (isctx ? r - 256 : r) * 8, tl = C.tid >> 6, j = C.tid & 63, t = t0 + tl;
        if (j < 33) { float z;
            if (j == 0) z = (float)t / (float)(L - 1);
            else { const int fi = (j - 1) & 15; const float freq = 1e-4f + (float)fi * ((15.0f - 1e-4f) / 15.0f);
                const float ang = ((float)(2.0 * 3.14159265358979323846 / L) * (float)t) * freq; z = (j <= 16) ? cosf(ang) : -sinf(ang); }
            zs[tl * 40 + j] = z; }
        __syncthreads();
        { const float* w1 = C.in[IN_W1] + (size_t)l * 33 * 64; float s = C.in[IN_B1][l * 64 + j];
            for (int i = 0; i < 33; ++i) s += zs[tl * 40 + i] * w1[i * 64 + j];
            h1s[tl * 64 + j] = sinf(s); }
        __syncthreads();
        { const float* w2 = C.in[IN_W2] + (size_t)l * 64 * 64; float s = C.in[IN_B2][l * 64 + j];
            for (int i = 0; i < 64; ++i) s += h1s[tl * 64 + i] * w2[i * 64 + j];
            float* dst = isctx ? WSP(float, WS_H2C) + ((size_t)l * 256 + t) * 64 : WSP(float, WS_H2L) + ((size_t)l * 2048 + t) * 64;
            dst[j] = sinf(s); }
        __syncthreads();
    }
    if (C.bid == C.G - 1) {
        const float* lb = C.in[IN_LB]; float* lower = WSP(float, WS_LOWER);
        for (int i = C.tid; i < 1024; i += NTHR) { const int d = i >> 9, c = i & 511; float v[4], mx = -3.4e38f, s = 0.f;
#pragma unroll
            for (int l = 0; l < 4; ++l) { v[l] = lb[(d * 4 + l) * 512 + c]; mx = fmaxf(mx, v[l]); }
#pragma unroll
            for (int l = 0; l < 4; ++l) { v[l] = expf(v[l] - mx); s += v[l]; }
            float cum = 0.f;
#pragma unroll
            for (int l = 0; l < 4; ++l) { if (l > 0) cum += v[l] / s; lower[(d * 4 + l) * 512 + c] = cum; } }
    }
}

__device__ __forceinline__ const float* xrow_src(const Ctx& C, int l, int row) {
    return l == 0 ? (row < NLAT ? C.in[IN_X] + (size_t)row * D : C.in[IN_CTX] + (size_t)(row - NLAT) * D) : WSP(const float, WS_XBUF) + (size_t)row * D;
}
__device__ __forceinline__ void transpose_item(const float* W, int K, int N, bf16_t* WT, LAS float* scr, int item, int lane) {
    const int nblk = N / 32, kb = item / nblk, nb = item % nblk, k0 = 64 * kb, n0 = 32 * nb;
#pragma unroll 8
    for (int i = 0; i < 32; ++i) { const int kk = 2 * i + (lane >> 5); scr[kk * 33 + (lane & 31)] = W[(size_t)(k0 + kk) * N + n0 + (lane & 31)]; }
    LDS_WAIT(); asm volatile("" ::: "memory");
    const int c = lane & 7;
#pragma unroll
    for (int j = 0; j < 4; ++j) { const int n = (lane >> 3) + 8 * j; const LAS float* s = scr + (8 * c) * 33 + n;
        u32x4 o; o.x = pk2(s[0 * 33], s[1 * 33]); o.y = pk2(s[2 * 33], s[3 * 33]); o.z = pk2(s[4 * 33], s[5 * 33]); o.w = pk2(s[6 * 33], s[7 * 33]);
        *(u32x4*)(WT + (size_t)(n0 + n) * K + k0 + 8 * c) = o; }
    LDS_WAIT(); asm volatile("" ::: "memory");
}
__device__ __forceinline__ void phase_l1(const Ctx& C, int l) {
    const int gw = C.bid * NWAVES + C.wave, NGW = C.G * NWAVES;
    const float* mods = WSP(const float, WS_MODS) + (size_t)l * 9 * 6144;
    bf16_t* an = WSP(bf16_t, WS_R1);
    f32x4 nv[4];
    if (gw < NTOK) { const float* src = xrow_src(C, l, gw);
#pragma unroll
        for (int j = 0; j < 4; ++j) nv[j] = *(const f32x4*)(src + C.lane * 4 + 256 * j); }
    for (int row = gw; row < NTOK; row += NGW) {
        const float* md = mods + bidx(row) * 6144;
        f32x4 v[4]; float ss = 0.f;
#pragma unroll
        for (int j = 0; j < 4; ++j) v[j] = nv[j];
        if (row + NGW < NTOK) { const float* src = xrow_src(C, l, row + NGW);
#pragma unroll
            for (int j = 0; j < 4; ++j) nv[j] = *(const f32x4*)(src + C.lane * 4 + 256 * j); }
#pragma unroll
        for (int j = 0; j < 4; ++j) ss += (v[j].x * v[j].x + v[j].y * v[j].y) + (v[j].z * v[j].z + v[j].w * v[j].w);
        ss = wave_sum(ss); const float rinv = 1.0f / sqrtf(ss * (1.0f / D) + EPS);
#pragma unroll
        for (int j = 0; j < 4; ++j) { const int k = C.lane * 4 + 256 * j; const f32x4 sh = *(const f32x4*)(md + k), sc = *(const f32x4*)(md + 1024 + k);
            const f32x4 o = v[j] * rinv * (sc + 1.0f) + sh; u32x2 w; w.x = pk2(o.x, o.y); w.y = pk2(o.z, o.w);
            *(u32x2*)(an + (size_t)row * D + k) = w; }
    }
    {
        LAS float* scr = (LAS float*)(C.lds + C.wave * 16384);
        constexpr int I_IN = 16 * 128, I_OUT = 16 * 32, I_E = 128;
        constexpr int NIT = I_IN + I_OUT + 3 * 16 * I_E;
        for (int it = gw; it < NIT; it += NGW) {
            int r = it;
            if (r < I_IN) { transpose_item(C.in[IN_WIN] + (size_t)l * D * DIN, D, DIN, WSP(bf16_t, WS_WIN), scr, r, C.lane); continue; } r -= I_IN;
            if (r < I_OUT) { transpose_item(C.in[IN_WOUT] + (size_t)l * D * D, D, D, WSP(bf16_t, WS_WOUT), scr, r, C.lane); continue; } r -= I_OUT;
            if (r < 16 * I_E) { const int e = r / I_E; transpose_item(C.in[IN_WG] + ((size_t)l * NE + e) * D * DE, D, DE, WSP(bf16_t, WS_WG) + (size_t)e * DE * D, scr, r % I_E, C.lane); continue; } r -= 16 * I_E;
            if (r < 16 * I_E) { const int e = r / I_E; transpose_item(C.in[IN_WU] + ((size_t)l * NE + e) * D * DE, D, DE, WSP(bf16_t, WS_WU) + (size_t)e * DE * D, scr, r % I_E, C.lane); continue; } r -= 16 * I_E;
            { const int e = r / I_E; transpose_item(C.in[IN_WD] + ((size_t)l * NE + e) * DE * D, DE, D, WSP(bf16_t, WS_WD) + (size_t)e * D * DE, scr, r % I_E, C.lane); }
        }
    }
    __syncthreads();
    {
        LAS f32x2* T = (LAS f32x2*)C.lds;
        const int team = C.tid >> 8, tt = C.tid & 255;
        LAS f32x2* X = (LAS f32x2*)(C.lds + 16384) + team * XPAD;
        LAS float* hbs = (LAS float*)(C.lds + 16384 + 2 * XPAD * 8) + team * 2048;
        LAS float* w3s = (LAS float*)(C.lds + 16384 + 2 * XPAD * 8 + 16384) + team * 128;
        LAS float* reds = (LAS float*)(C.lds + 16384 + 2 * XPAD * 8 + 16384 + 1024);
        build_twiddles(C, T);
        __syncthreads();
        const float* h2 = WSP(const float, WS_H2L) + (size_t)l * 2048 * 64;
        const float* w3 = C.in[IN_W3] + (size_t)l * 64 * 2048; const float* b3 = C.in[IN_B3] + l * 2048;
        f32x2* kspec = WSP(f32x2, WS_KSPEC);
        for (int item = C.bid; item < 512; item += C.G) {
            const int idx = item * 2 + team, o = idx >> 9, c = idx & 511;
            const int colf = o * 1024 + c, colb = colf + 512;
            if (tt < 128) w3s[tt] = w3[(size_t)(tt & 63) * 2048 + ((tt >> 6) ? colb : colf)];
            __syncthreads();
            const float delta = fabsf(logf(1e-2f) / 0.3f + (float)c * ((logf(1e-2f) / 1.5f - logf(1e-2f) / 0.3f) / 511.0f));
            float hf[8], hb[8], s = 0.f;
#pragma unroll
            for (int j = 0; j < 8; ++j) { const int t = tt + 256 * j; const f32x4* hr = (const f32x4*)(h2 + (size_t)t * 64);
                float af = b3[colf], ab = b3[colb];
#pragma unroll
                for (int i4 = 0; i4 < 16; ++i4) { const f32x4 h = hr[i4];
                    af += h.x * w3s[i4 * 4] + h.y * w3s[i4 * 4 + 1] + h.z * w3s[i4 * 4 + 2] + h.w * w3s[i4 * 4 + 3];
                    ab += h.x * w3s[64 + i4 * 4] + h.y * w3s[64 + i4 * 4 + 1] + h.z * w3s[64 + i4 * 4 + 2] + h.w * w3s[64 + i4 * 4 + 3]; }
                const float win = expf(-((float)t / 2047.0f) * delta);
                hf[j] = af * win; hb[j] = ab * win; s += fabsf(hf[j]) + fabsf(hb[j]);
                asm volatile("" ::: "memory"); }
            s = wave_sum(s);
            if (C.lane == 0) reds[C.wave] = s;
            __syncthreads();
            const float tot = reds[team * 4] + reds[team * 4 + 1] + reds[team * 4 + 2] + reds[team * 4 + 3];
            const float inv = 1.0f / (tot * 4096.0f);
#pragma unroll
            for (int j = 0; j < 8; ++j) { hf[j] *= inv; hb[j] *= inv; hbs[tt + 256 * j] = hb[j]; }
            __syncthreads();
            f32x2 ve[8], vo[8];
#pragma unroll
            for (int j = 0; j < 8; ++j) { const int n = tt + 256 * j; const float kb = n > 0 ? hbs[2048 - n] : 0.f;
                ve[j] = (f32x2){hf[j] + kb, 0.f}; const float dd = hf[j] - kb; const f32x2 tw = T[n]; vo[j] = (f32x2){dd * tw.x, dd * tw.y}; }
            f32x2* kout = kspec + ((size_t)(o * 512 + c) * 2) * 2048;
            fft_fwd_store(ve, X, T, kout, tt);
            fft_fwd_store(vo, X, T, kout + 2048, tt);
        }
        if (l < DEPTH - 1) {
            const float* h2c = WSP(const float, WS_H2C) + (size_t)l * 256 * 64;
            f32x2* kspc = WSP(f32x2, WS_KSPC);
            for (int item = C.bid; item < 512; item += C.G) {
                const int idx = item * 2 + team, o = idx >> 9, c = idx & 511;
                const int colf = o * 1024 + c, colb = colf + 512;
                if (tt < 128) w3s[tt] = w3[(size_t)(tt & 63) * 2048 + ((tt >> 6) ? colb : colf)];
                __syncthreads();
                const float delta = fabsf(logf(1e-2f) / 0.3f + (float)c * ((logf(1e-2f) / 1.5f - logf(1e-2f) / 0.3f) / 511.0f));
                float af = b3[colf], ab = b3[colb];
                { const f32x4* hr = (const f32x4*)(h2c + (size_t)tt * 64);
#pragma unroll
                  for (int i4 = 0; i4 < 16; ++i4) { const f32x4 h = hr[i4];
                    af += h.x * w3s[i4 * 4] + h.y * w3s[i4 * 4 + 1] + h.z * w3s[i4 * 4 + 2] + h.w * w3s[i4 * 4 + 3];
                    ab += h.x * w3s[64 + i4 * 4] + h.y * w3s[64 + i4 * 4 + 1] + h.z * w3s[64 + i4 * 4 + 2] + h.w * w3s[64 + i4 * 4 + 3]; } }
                const float win = expf(-((float)tt / 255.0f) * delta);
                af *= win; ab *= win;
                const float s = wave_sum(fabsf(af) + fabsf(ab));
                if (C.lane == 0) reds[C.wave] = s;
                __syncthreads();
                const float tot = reds[team * 4] + reds[team * 4 + 1] + reds[team * 4 + 2] + reds[team * 4 + 3];
                const float inv = 1.0f / (tot * 2048.0f);
                af *= inv; ab *= inv; hbs[tt] = ab;
                __syncthreads();
                f32x2 vk[8];
#pragma unroll
                for (int j = 0; j < 8; ++j) vk[j] = (f32x2){0.f, 0.f};
                vk[0] = (f32x2){af, 0.f};
                vk[7] = (f32x2){tt > 0 ? hbs[256 - tt] : 0.f, 0.f};
                fft_fwd_store(vk, X, T, kspc + (size_t)(o * 512 + c) * 2048, tt);
            }
        }
    }
}

__device__ __forceinline__ float shortconv(const LAS bf16_t* raw, int t, int mask, int tmax, float w0, float w1, float w2, float bias) {
    const float pm = ((t & mask) != 0) ? bf2f(raw[t - 1]) : 0.f;
    const float pc = bf2f(raw[t]);
    const float pp = ((t & mask) != mask && t < tmax) ? bf2f(raw[t + 1]) : 0.f;
    return w0 * pm + w1 * pc + w2 * pp + bias;
}
constexpr int HY_CH = 4, HY_ITEMS = 4 * (512 / HY_CH);
__device__ __forceinline__ void hyena_lat(const Ctx& C, int l, int item) {
    const int bp = item & 3, cg = item >> 2, team = C.tid >> 8, tt = C.tid & 255;
    LAS f32x2* T = (LAS f32x2*)C.lds;
    LAS f32x2* X = (LAS f32x2*)(C.lds + 16384) + team * XPAD;
    LAS bf16_t* raw = (LAS bf16_t*)(C.lds + 16384 + 2 * XPAD * 8) + team * 4096;
    LAS bf16_t* outs = (LAS bf16_t*)(C.lds + 16384 + 2 * XPAD * 8 + 16384);
    const bf16_t* phyt = WSP(const bf16_t, WS_PHYT);
    const float* cw = C.in[IN_CONVW] + (size_t)l * 3 * NHY; const float* cb = C.in[IN_CONVB] + (size_t)l * NHY;
    const float* hyb = C.in[IN_HYBIAS] + (size_t)l * 2 * DH;
    const f32x2* kspec = WSP(const f32x2, WS_KSPEC);
    const int ba = 2 * bp;
    for (int round = 0; round < HY_CH / 2; ++round) {
        const int c = cg * HY_CH + round * 2 + team;
        f32x2 z[8], acc[8], v[8];
#pragma unroll 1
        for (int stage = 0; stage < 3; ++stage) {
            const int ch = stage * 512 + c;
            __syncthreads();
#pragma unroll
            for (int k = 0; k < 2; ++k) { const int q = tt + 256 * k, rr = q >> 8, cc = q & 255;
                *(LAS u32x4*)(raw + rr * 2048 + cc * 8) = *(const u32x4*)(phyt + (size_t)ch * NTOK + (size_t)(ba + rr) * 2048 + cc * 8); }
            __syncthreads();
            const float w0 = cw[ch], w1 = cw[NHY + ch], w2 = cw[2 * NHY + ch], bs = cb[ch];
            if (stage == 0) {
#pragma unroll
                for (int j = 0; j < 8; ++j) { const int t = tt + 256 * j; z[j] = (f32x2){shortconv(raw, t, 63, 4096, w0, w1, w2, bs), shortconv(raw + 2048, t, 63, 4096, w0, w1, w2, bs)}; }
            } else {
                const float dsk = hyb[(stage - 1) * DH + c];
#pragma unroll
                for (int j = 0; j < 8; ++j) { const int t = tt + 256 * j; const f32x2 cv = acc[j] + z[j] * dsk;
                    z[j] = (f32x2){shortconv(raw, t, 63, 4096, w0, w1, w2, bs) * cv.x, shortconv(raw + 2048, t, 63, 4096, w0, w1, w2, bs) * cv.y}; }
            }
            if (stage == 2) {
#pragma unroll
                for (int j = 0; j < 8; ++j) { const int t = tt + 256 * j; outs[(size_t)t * HY_CH + round * 2 + team] = (bf16_t)f2bf(z[j].x); outs[(size_t)(2048 + t) * HY_CH + round * 2 + team] = (bf16_t)f2bf(z[j].y); }
                break;
            }
            const f32x2* K = kspec + ((size_t)(stage * 512 + c) * 2) * 2048;
#pragma unroll
            for (int j = 0; j < 8; ++j) v[j] = z[j];
            fft_conv_half(v, X, T, K, tt);
#pragma unroll
            for (int j = 0; j < 8; ++j) acc[j] = v[j];
#pragma unroll
            for (int j = 0; j < 8; ++j) v[j] = cmul(z[j], T[tt + 256 * j]);
            fft_conv_half(v, X, T, K + 2048, tt);
#pragma unroll
            for (int j = 0; j < 8; ++j) acc[j] += cmulc(v[j], T[tt + 256 * j]);
        }
    }
    __syncthreads();
    bf16_t* Y = WSP(bf16_t, WS_R1);
    for (int i = C.tid; i < 4096; i += NTHR) { const int b = i >> 11, t = i & 2047;
        if (HY_CH == 8) *(u32x4*)(Y + ((size_t)(ba + b) * 2048 + t) * D + cg * 8) = *(const LAS u32x4*)(outs + (size_t)i * 8);
        else *(u32x2*)(Y + ((size_t)(ba + b) * 2048 + t) * D + cg * 4) = *(const LAS u32x2*)(outs + (size_t)i * 4); }
    __syncthreads();
}
__device__ __forceinline__ void hyena_ctx2(const Ctx& C, int l, int item) {
    const int team = C.tid >> 8, tt = C.tid & 255, c = item * 2 + team;
    LAS f32x2* T = (LAS f32x2*)C.lds;
    LAS f32x2* X = (LAS f32x2*)(C.lds + 16384) + team * XPAD;
    LAS bf16_t* raw = (LAS bf16_t*)(C.lds + 16384 + 2 * XPAD * 8) + team * 4096;
    const bf16_t* phyt = WSP(const bf16_t, WS_PHYT);
    const float* cw = C.in[IN_CONVW] + (size_t)l * 3 * NHY; const float* cb = C.in[IN_CONVB] + (size_t)l * NHY;
    const float* hyb = C.in[IN_HYBIAS] + (size_t)l * 2 * DH;
    const f32x2* kspc = WSP(const f32x2, WS_KSPC);
    bf16_t* Y = WSP(bf16_t, WS_R1);
    f32x2 z[8], v[8];
#pragma unroll
    for (int j = 0; j < 8; ++j) z[j] = (f32x2){0.f, 0.f};
#pragma unroll 1
    for (int stage = 0; stage < 3; ++stage) {
        const int ch = stage * 512 + c;
        __syncthreads();
        *(LAS u32x4*)(raw + tt * 8) = *(const u32x4*)(phyt + (size_t)ch * NTOK + NLAT + tt * 8);
        __syncthreads();
        const float w0 = cw[ch], w1 = cw[NHY + ch], w2 = cw[2 * NHY + ch], bs = cb[ch];
        const float dsk = stage > 0 ? hyb[(stage - 1) * DH + c] : 0.f;
#pragma unroll
        for (int p = 0; p < 4; ++p) {
            const float ua = shortconv(raw, (2 * p) * 256 + tt, 255, 4096, w0, w1, w2, bs), ub = shortconv(raw, (2 * p + 1) * 256 + tt, 255, 4096, w0, w1, w2, bs);
            if (stage == 0) z[2 * p] = (f32x2){ua, ub};
            else { const f32x2 cv = v[2 * p] + z[2 * p] * dsk; z[2 * p] = (f32x2){ua * cv.x, ub * cv.y}; }
        }
        if (stage == 2) {
#pragma unroll
            for (int p = 0; p < 4; ++p) { Y[(size_t)(NLAT + (2 * p) * 256 + tt) * D + c] = (bf16_t)f2bf(z[2 * p].x); Y[(size_t)(NLAT + (2 * p + 1) * 256 + tt) * D + c] = (bf16_t)f2bf(z[2 * p].y); }
            break;
        }
#pragma unroll
        for (int j = 0; j < 8; ++j) v[j] = z[j];
        fft_conv_half(v, X, T, kspc + (size_t)(stage * 512 + c) * 2048, tt);
    }
}

constexpr int HG_QT = 0, HG_QP = 17408, HG_KP = 34816, HG_ST = 52224, HG_VT = 87040, HG_KH = 105472, HG_P = 123904, HG_SUB = 133120, HG_D = 135168;
__device__ __forceinline__ void hgrn_mfma(const Ctx& C, int item) {
    const int dir = item & 1, h = (item >> 1) & 3, b = item >> 3;
    LAS unsigned char* L = C.lds;
    const int lane = C.lane, w = C.wave, r = lane & 15, quad = lane >> 4;
    const int I = w >> 1, col = (w & 1) * 64 + lane;
    const bf16_t* phg = WSP(const bf16_t, WS_PHG);
    bf16_t* odir = WSP(bf16_t, WS_ODIR) + (size_t)dir * NTOK * 512;
    LAS float* subtot = (LAS float*)(L + HG_SUB); LAS float* Dv = (LAS float*)(L + HG_D);
    __syncthreads();
    for (int i = C.tid; i < (128 * 272) / 16; i += NTHR) *(LAS u32x4*)(L + HG_ST + i * 16) = (u32x4){0u, 0u, 0u, 0u};
    for (int i = C.tid; i < (64 * 144) / 16; i += NTHR) *(LAS u32x4*)(L + HG_P + i * 16) = (u32x4){0u, 0u, 0u, 0u};
    f32x4 sacc[8];
#pragma unroll
    for (int t = 0; t < 8; ++t) sacc[t] = (f32x4){0.f, 0.f, 0.f, 0.f};
    unsigned short qr[16], kr[16], vr[16];
    const int rstep = dir ? -1 : 1;
    const size_t colq = (size_t)h * 128 + col, colk = 1536 + (size_t)dir * 512 + h * 128 + col, colv = 512 + (size_t)h * 128 + col;
    auto chunk_row0 = [&](int ch) -> int { return ch < 4 ? NLAT + b * 256 + (dir ? 255 - ch * 64 : ch * 64) : b * 2048 + (dir ? 2047 - (ch - 4) * 64 : (ch - 4) * 64); };
    { const int row0 = chunk_row0(0) + rstep * 16 * I;
#pragma unroll
      for (int i = 0; i < 16; ++i) { const bf16_t* p = phg + (size_t)(row0 + rstep * i) * NHG; qr[i] = p[colq]; kr[i] = p[colk]; vr[i] = p[colv]; } }
    __syncthreads();
#pragma unroll 1
    for (int ch = 0; ch < 36; ++ch) {
        float cum[16]; float cs = 0.f;
#pragma unroll
        for (int i = 0; i < 16; ++i) { cs += __logf(1.0f - bf2f(kr[i])); cum[i] = cs; }
        subtot[I * 128 + col] = cs;
        __syncthreads();
        const float s0 = subtot[col], s1 = subtot[128 + col], s2 = subtot[256 + col], s3 = subtot[384 + col];
        const float pre = (I > 0 ? s0 : 0.f) + (I > 1 ? s1 : 0.f) + (I > 2 ? s2 : 0.f), rho = s0 + s1, tot = (s0 + s1) + (s2 + s3);
        const float erho = __expf(rho), eend = __expf(tot - rho);
        unsigned khp[8], vtp[8];
#pragma unroll
        for (int i = 0; i < 16; ++i) {
            const float bi = pre + cum[i], e1 = __expf(bi - rho), e2 = __expf(rho - bi), qf = bf2f(qr[i]), kf = bf2f(kr[i]);
            const int srow = (16 * I + i) * 272 + col * 2;
            *(LAS bf16_t*)(L + HG_QP + srow) = (bf16_t)f2bf(qf * e1);
            *(LAS bf16_t*)(L + HG_QT + srow) = (bf16_t)f2bf(qf * e1 * erho);
            *(LAS bf16_t*)(L + HG_KP + srow) = (bf16_t)f2bf(kf * e2);
            const unsigned khb = f2bf(kf * e2 * eend);
            if (i & 1) { khp[i >> 1] |= khb << 16; vtp[i >> 1] |= (unsigned)vr[i] << 16; } else { khp[i >> 1] = khb; vtp[i >> 1] = (unsigned)vr[i]; }
        }
        *(LAS u32x4*)(L + HG_KH + col * 144 + I * 32) = (u32x4){khp[0], khp[1], khp[2], khp[3]};
        *(LAS u32x4*)(L + HG_KH + col * 144 + I * 32 + 16) = (u32x4){khp[4], khp[5], khp[6], khp[7]};
        *(LAS u32x4*)(L + HG_VT + col * 144 + I * 32) = (u32x4){vtp[0], vtp[1], vtp[2], vtp[3]};
        *(LAS u32x4*)(L + HG_VT + col * 144 + I * 32 + 16) = (u32x4){vtp[4], vtp[5], vtp[6], vtp[7]};
        if (I == 0) Dv[col] = __expf(tot);
        const int crow0 = chunk_row0(ch);
        if (ch + 1 < 36) { const int row0 = chunk_row0(ch + 1) + rstep * 16 * I;
#pragma unroll
            for (int i = 0; i < 16; ++i) { const bf16_t* p = phg + (size_t)(row0 + rstep * i) * NHG; qr[i] = p[colq]; kr[i] = p[colk]; vr[i] = p[colv]; } }
        __syncthreads();
#pragma unroll 1
        for (int blk = w; blk < 10; blk += 8) {
            const int I2 = blk < 1 ? 0 : (blk < 3 ? 1 : (blk < 6 ? 2 : 3)), J2 = blk - (I2 * (I2 + 1)) / 2;
            f32x4 pa = (f32x4){0.f, 0.f, 0.f, 0.f};
#pragma unroll
            for (int kk = 0; kk < 4; ++kk) {
                const bf16x8 a = *(const LAS bf16x8*)(L + HG_KP + (J2 * 16 + r) * 272 + (32 * kk + 8 * quad) * 2);
                const bf16x8 bq = *(const LAS bf16x8*)(L + HG_QP + (I2 * 16 + r) * 272 + (32 * kk + 8 * quad) * 2);
                pa = __builtin_amdgcn_mfma_f32_16x16x32_bf16(a, bq, pa, 0, 0, 0);
            }
            if (I2 == J2) {
#pragma unroll
                for (int rr = 0; rr < 4; ++rr) if (4 * quad + rr > r) pa[rr] = 0.f;
            }
            u32x2 pw; pw.x = pk2(pa[0], pa[1]); pw.y = pk2(pa[2], pa[3]);
            *(LAS u32x2*)(L + HG_P + (I2 * 16 + r) * 144 + (J2 * 16 + 4 * quad) * 2) = pw;
        }
        __syncthreads();
        {
            bf16x8 sfr[4];
#pragma unroll
            for (int kk = 0; kk < 4; ++kk) sfr[kk] = *(const LAS bf16x8*)(L + HG_ST + (16 * w + r) * 272 + (32 * kk + 8 * quad) * 2);
            const bf16x8 vf0 = *(const LAS bf16x8*)(L + HG_VT + (16 * w + r) * 144 + (8 * quad) * 2);
            const bf16x8 vf1 = *(const LAS bf16x8*)(L + HG_VT + (16 * w + r) * 144 + (32 + 8 * quad) * 2);
#pragma unroll
            for (int I3 = 0; I3 < 4; ++I3) {
                f32x4 oa = (f32x4){0.f, 0.f, 0.f, 0.f};
#pragma unroll
                for (int kk = 0; kk < 4; ++kk) {
                    const bf16x8 bq = *(const LAS bf16x8*)(L + HG_QT + (I3 * 16 + r) * 272 + (32 * kk + 8 * quad) * 2);
                    oa = __builtin_amdgcn_mfma_f32_16x16x32_bf16(sfr[kk], bq, oa, 0, 0, 0);
                }
                { const bf16x8 bp = *(const LAS bf16x8*)(L + HG_P + (I3 * 16 + r) * 144 + (8 * quad) * 2);
                  oa = __builtin_amdgcn_mfma_f32_16x16x32_bf16(vf0, bp, oa, 0, 0, 0); }
                if (I3 >= 2) { const bf16x8 bp = *(const LAS bf16x8*)(L + HG_P + (I3 * 16 + r) * 144 + (32 + 8 * quad) * 2);
                  oa = __builtin_amdgcn_mfma_f32_16x16x32_bf16(vf1, bp, oa, 0, 0, 0); }
                const int row = crow0 + rstep * (16 * I3 + r);
                u32x2 ow; ow.x = pk2(oa[0], oa[1]); ow.y = pk2(oa[2], oa[3]);
                *(u32x2*)(odir + (size_t)row * 512 + h * 128 + 16 * w + 4 * quad) = ow;
            }
#pragma unroll
            for (int t = 0; t < 8; ++t) {
                const f32x4 dd = *(const LAS f32x4*)(L + HG_D + (16 * t + 4 * quad) * 4);
                f32x4 sa = sacc[t] * dd;
                const bf16x8 a0 = *(const LAS bf16x8*)(L + HG_KH + (16 * t + r) * 144 + (8 * quad) * 2);
                const bf16x8 a1 = *(const LAS bf16x8*)(L + HG_KH + (16 * t + r) * 144 + (32 + 8 * quad) * 2);
                sa = __builtin_amdgcn_mfma_f32_16x16x32_bf16(a0, vf0, sa, 0, 0, 0);
                sa = __builtin_amdgcn_mfma_f32_16x16x32_bf16(a1, vf1, sa, 0, 0, 0);
                sacc[t] = sa;
                u32x2 sw; sw.x = pk2(sa[0], sa[1]); sw.y = pk2(sa[2], sa[3]);
                *(LAS u32x2*)(L + HG_ST + (16 * w + r) * 272 + (16 * t + 4 * quad) * 2) = sw;
            }
        }
    }
    __syncthreads();
}
__device__ __forceinline__ void phase_l3(const Ctx& C, int l) {
    if (C.bid < 64) hgrn_mfma(C, C.bid);
    build_twiddles(C, (LAS f32x2*)C.lds);
    __syncthreads();
    unsigned* qh = WSP(unsigned, WS_CTL) + CW_Q + l * 64 + C.rep * 16;
    volatile LAS int* lc = (volatile LAS int*)(C.lds + LDSCTL_OFF);
    const int nitems = HY_ITEMS + (l < DEPTH - 1 ? 256 : 0);
    for (;;) {
        if (C.tid == 0) lc[LC_Q] = (int)__hip_atomic_fetch_add(qh, 1u, __ATOMIC_RELAXED, __HIP_MEMORY_SCOPE_AGENT);
        __syncthreads();
        const int item = lc[LC_Q];
        __syncthreads();
        if (item >= nitems) break;
        if (item < HY_ITEMS) hyena_lat(C, l, item); else hyena_ctx2(C, l, item - HY_ITEMS);
    }
}
__device__ __forceinline__ void phase_l3b(const Ctx& C, int l) {
    const int gw = C.bid * NWAVES + C.wave, NGW = C.G * NWAVES;
    const bf16_t* od0 = WSP(const bf16_t, WS_ODIR); const bf16_t* od1 = od0 + (size_t)NTOK * 512;
    const bf16_t* phg = WSP(const bf16_t, WS_PHG); bf16_t* Y = WSP(bf16_t, WS_R1);
    const float* nw = C.in[IN_NORMW] + l * 128;
    const int nrows = (l < DEPTH - 1) ? NTOK : NLAT;
    for (int row = gw; row < nrows; row += NGW) {
        const int idx = C.lane * 8;
        const u32x4 a = *(const u32x4*)(od0 + (size_t)row * 512 + idx), b = *(const u32x4*)(od1 + (size_t)row * 512 + idx), g = *(const u32x4*)(phg + (size_t)row * NHG + 1024 + idx);
        float o[8] = {bflo(a.x) + bflo(b.x), bfhi(a.x) + bfhi(b.x), bflo(a.y) + bflo(b.y), bfhi(a.y) + bfhi(b.y), bflo(a.z) + bflo(b.z), bfhi(a.z) + bfhi(b.z), bflo(a.w) + bflo(b.w), bfhi(a.w) + bfhi(b.w)};
        const float gg[8] = {bflo(g.x), bfhi(g.x), bflo(g.y), bfhi(g.y), bflo(g.z), bfhi(g.z), bflo(g.w), bfhi(g.w)};
        float ss = 0.f;
#pragma unroll
        for (int i = 0; i < 8; ++i) ss += o[i] * o[i];
        ss = row16_sum(ss);
        const float rinv = 1.0f / sqrtf(ss * (1.0f / 128.0f) + EPS);
        float y[8];
#pragma unroll
        for (int i = 0; i < 8; ++i) y[i] = o[i] * rinv * nw[(idx + i) & 127] * siluf_(gg[i]);
        u32x4 w; w.x = pk2(y[0], y[1]); w.y = pk2(y[2], y[3]); w.z = pk2(y[4], y[5]); w.w = pk2(y[6], y[7]);
        *(u32x4*)(Y + (size_t)row * D + 512 + idx) = w;
    }
}

__device__ __forceinline__ void phase_l5a(const Ctx& C, int l) {
    LAS float* rwT = (LAS float*)C.lds;
    const float* rw = C.in[IN_RW];
    for (int i = C.tid; i < 16 * 1024; i += NTHR) { const int k = i >> 4, e = i & 15; rwT[e * 1024 + k] = rw[i]; }
    const int gw = C.bid * NWAVES + C.wave, NGW = C.G * NWAVES;
    const float* mods = WSP(const float, WS_MODS) + (size_t)l * 9 * 6144;
    const float* xb = WSP(const float, WS_XBUF);
    const float* rbias = C.in[IN_RB];
    unsigned* cnt = WSP(unsigned, WS_CTL) + CW_CNT + l * 32 * 64;
    int* tokinfo = WSP(int, WS_TOKINFO);
    LAS int* lcnt = (LAS int*)(C.lds + 65536);
    if (C.tid < 32) lcnt[C.tid] = 0;
    __syncthreads();
    const int nrows = (l < DEPTH - 1) ? NTOK : NLAT;
    f32x4 nv[4];
    if (gw < nrows) {
#pragma unroll
        for (int j = 0; j < 4; ++j) nv[j] = *(const f32x4*)(xb + (size_t)gw * D + C.lane * 4 + 256 * j); }
    for (int row = gw; row < nrows; row += NGW) {
        const float* md = mods + bidx(row) * 6144;
        f32x4 v[4]; float ss = 0.f;
#pragma unroll
        for (int j = 0; j < 4; ++j) v[j] = nv[j];
        if (row + NGW < nrows) {
#pragma unroll
            for (int j = 0; j < 4; ++j) nv[j] = *(const f32x4*)(xb + (size_t)(row + NGW) * D + C.lane * 4 + 256 * j); }
#pragma unroll
        for (int j = 0; j < 4; ++j) ss += (v[j].x * v[j].x + v[j].y * v[j].y) + (v[j].z * v[j].z + v[j].w * v[j].w);
        ss = wave_sum(ss); const float rinv = 1.0f / sqrtf(ss * (1.0f / D) + EPS);
        float lg[16];
#pragma unroll
        for (int e = 0; e < 16; ++e) lg[e] = 0.f;
#pragma unroll
        for (int j = 0; j < 4; ++j) { const int k = C.lane * 4 + 256 * j; const f32x4 sh = *(const f32x4*)(md + 3072 + k), sc = *(const f32x4*)(md + 4096 + k);
            const f32x4 hh = v[j] * rinv * (sc + 1.0f) + sh;
#pragma unroll
            for (int e = 0; e < 16; ++e) { const f32x4 w = *(const LAS f32x4*)(rwT + e * 1024 + k); lg[e] += hh.x * w.x + hh.y * w.y + hh.z * w.z + hh.w * w.w; } }
#pragma unroll
        for (int e = 0; e < 16; ++e) lg[e] = wave_sum(lg[e]);
        float mx = lg[0];
#pragma unroll
        for (int e = 1; e < 16; ++e) mx = fmaxf(mx, lg[e]);
        float sc[16], se = 0.f;
#pragma unroll
        for (int e = 0; e < 16; ++e) { sc[e] = expf(lg[e] - mx); se += sc[e]; }
        float sel[16];
#pragma unroll
        for (int e = 0; e < 16; ++e) { sc[e] = sc[e] / se; sel[e] = sc[e] + rbias[e]; }
        float bestgs = -3.4e38f; int bg = 0; float bs[4], bsc[4];
#pragma unroll
        for (int g = 0; g < 4; ++g) {
            float m1 = -3.4e38f, m2 = -3.4e38f;
#pragma unroll
            for (int i = 0; i < 4; ++i) { const float x = sel[4 * g + i]; if (x > m1) { m2 = m1; m1 = x; } else if (x > m2) m2 = x; }
            const float gs = m1 + m2;
            if (gs > bestgs) { bestgs = gs; bg = g;
#pragma unroll
                for (int i = 0; i < 4; ++i) { bs[i] = sel[4 * g + i]; bsc[i] = sc[4 * g + i]; } }
        }
        int i0 = 0; float b0 = bs[0];
#pragma unroll
        for (int i = 1; i < 4; ++i) if (bs[i] > b0) { b0 = bs[i]; i0 = i; }
        int i1 = -1; float b1 = -3.4e38f;
#pragma unroll
        for (int i = 0; i < 4; ++i) if (i != i0 && bs[i] > b1) { b1 = bs[i]; i1 = i; }
        float w0 = 0.f, w1 = 0.f;
#pragma unroll
        for (int i = 0; i < 4; ++i) { if (i == i0) w0 = bsc[i]; if (i == i1) w1 = bsc[i]; }
        const float wn = w0 + w1; w0 /= wn; w1 /= wn;
        const int lo = i0 < i1 ? i0 : i1, hi = i0 < i1 ? i1 : i0;
        const float wlo = i0 < i1 ? w0 : w1, whi = i0 < i1 ? w1 : w0;
        const int bin = bg * 6 + (lo * (7 - lo)) / 2 + (hi - lo - 1);
        if (C.lane == 0) { const int slot = __hip_atomic_fetch_add(lcnt + bin, 1, __ATOMIC_RELAXED, __HIP_MEMORY_SCOPE_WORKGROUP);
            *(int4*)(tokinfo + (size_t)row * 4) = make_int4(bin, slot, __float_as_int(wlo), __float_as_int(whi)); }
    }
    __syncthreads();
    if (C.tid < NBIN && !C.dry) { const int n = lcnt[C.tid];
        WSP(int, WS_BLKBASE)[C.bid * 32 + C.tid] = n > 0 ? (int)__hip_atomic_fetch_add(cnt + C.tid * 64, (unsigned)n, __ATOMIC_RELAXED, __HIP_MEMORY_SCOPE_AGENT) : 0; }
}
__device__ __forceinline__ void phase_l5b(const Ctx& C, int l) {
    build_tiletab(C, l);
    const volatile LAS int* lc = (const volatile LAS int*)(C.lds + LDSCTL_OFF);
    const int gw = C.bid * NWAVES + C.wave, NGW = C.G * NWAVES;
    const float* mods = WSP(const float, WS_MODS) + (size_t)l * 9 * 6144;
    const float* xb = WSP(const float, WS_XBUF);
    const int* tokinfo = WSP(const int, WS_TOKINFO); const int* blkbase = WSP(const int, WS_BLKBASE);
    bf16_t* hs = WSP(bf16_t, WS_PHG); int* rowtok = WSP(int, WS_ROWTOK); float* roww = WSP(float, WS_ROWW);
    const int nrows = (l < DEPTH - 1) ? NTOK : NLAT;
    f32x4 nv[4]; int4 nti = make_int4(0, 0, 0, 0);
    if (gw < nrows) { nti = *(const int4*)(tokinfo + (size_t)gw * 4);
#pragma unroll
        for (int j = 0; j < 4; ++j) nv[j] = *(const f32x4*)(xb + (size_t)gw * D + C.lane * 4 + 256 * j); }
    for (int row = gw; row < nrows; row += NGW) {
        const int4 ti = nti;
        const int pos = lc[LC_OFFS + ti.x] + blkbase[((row % NGW) >> 3) * 32 + ti.x] + ti.y;
        const float* md = mods + bidx(row) * 6144;
        f32x4 v[4]; float ss = 0.f;
#pragma unroll
        for (int j = 0; j < 4; ++j) v[j] = nv[j];
        if (row + NGW < nrows) { nti = *(const int4*)(tokinfo + (size_t)(row + NGW) * 4);
#pragma unroll
            for (int j = 0; j < 4; ++j) nv[j] = *(const f32x4*)(xb + (size_t)(row + NGW) * D + C.lane * 4 + 256 * j); }
#pragma unroll
        for (int j = 0; j < 4; ++j) ss += (v[j].x * v[j].x + v[j].y * v[j].y) + (v[j].z * v[j].z + v[j].w * v[j].w);
        ss = wave_sum(ss); const float rinv = 1.0f / sqrtf(ss * (1.0f / D) + EPS);
#pragma unroll
        for (int j = 0; j < 4; ++j) { const int k = C.lane * 4 + 256 * j; const f32x4 sh = *(const f32x4*)(md + 3072 + k), sc = *(const f32x4*)(md + 4096 + k);
            const f32x4 o = v[j] * rinv * (sc + 1.0f) + sh; u32x2 w; w.x = pk2(o.x, o.y); w.y = pk2(o.z, o.w);
            *(u32x2*)(hs + (size_t)pos * D + k) = w; }
        if (C.lane == 0) { rowtok[pos] = row; roww[pos * 2] = __int_as_float(ti.z); roww[pos * 2 + 1] = __int_as_float(ti.w); }
    }
    if (C.bid < NBIN) { const int b = C.bid; const int start = lc[LC_OFFS + b], end = lc[LC_OFFS + b + 1];
        const int n = (int)__hip_atomic_load(WSP(unsigned, WS_CTL) + CW_CNT + (l * 32 + b) * 64, __ATOMIC_RELAXED, __HIP_MEMORY_SCOPE_AGENT);
        for (int p = start + n + C.tid; p < end; p += NTHR) { rowtok[p] = -1; roww[p * 2] = 0.f; roww[p * 2 + 1] = 0.f; } }
}

__device__ __forceinline__ void phase_final(const Ctx& C) {
    const int gw = C.bid * NWAVES + C.wave, NGW = C.G * NWAVES;
    const float* xb = WSP(const float, WS_XBUF); const float* fw = C.in[IN_FNW];
    f32x4 nv[4];
    if (gw < NLAT) {
#pragma unroll
        for (int j = 0; j < 4; ++j) nv[j] = *(const f32x4*)(xb + (size_t)gw * D + C.lane * 4 + 256 * j); }
    for (int row = gw; row < NLAT; row += NGW) {
        f32x4 v[4]; float ss = 0.f;
#pragma unroll
        for (int j = 0; j < 4; ++j) v[j] = nv[j];
        if (row + NGW < NLAT) {
#pragma unroll
            for (int j = 0; j < 4; ++j) nv[j] = *(const f32x4*)(xb + (size_t)(row + NGW) * D + C.lane * 4 + 256 * j); }
#pragma unroll
        for (int j = 0; j < 4; ++j) ss += (v[j].x * v[j].x + v[j].y * v[j].y) + (v[j].z * v[j].z + v[j].w * v[j].w);
        ss = wave_sum(ss); const float rinv = 1.0f / sqrtf(ss * (1.0f / D) + EPS);
#pragma unroll
        for (int j = 0; j < 4; ++j) { const int k = C.lane * 4 + 256 * j; const f32x4 w = *(const f32x4*)(fw + k);
            *(f32x4*)(C.out + (size_t)row * D + k) = v[j] * rinv * w; }
    }
}

constexpr int PH_PER_LAYER = 9, N_PHASES = 1 + DEPTH * PH_PER_LAYER + 1;
__global__ void __launch_bounds__(NTHR, 2) trunk_fwd(Args args) {
    extern __shared__ __attribute__((aligned(16))) unsigned char lds[];
    Ctx C; C.in = (const CAS fptr_t*)__builtin_amdgcn_kernarg_segment_ptr(); C.out = args.out; C.ws = args.ws; C.lds = (LAS unsigned char*)lds;
    C.tid = threadIdx.x; C.lane = C.tid & 63; C.wave = __builtin_amdgcn_readfirstlane(C.tid >> 6); C.G = gridDim.x; C.bid = blockIdx.x; C.rep = args.rep; C.dry = (args.rep + 1 < args.pad) ? 1 : 0;
    LAS unsigned char* ldsl0 = (LAS unsigned char*)lds;
    if (C.tid < 64) ((LAS unsigned*)(ldsl0 + LDSCTL_OFF))[C.tid] = 0u;
    __syncthreads();
    const int lo = args.ph_lo, hi = args.ph_hi;
    XcdBarrier bar; bar.bar = WSP(unsigned, WS_CTL) + CW_BAR; bar.x = 0; bar.st = (volatile LAS unsigned*)(ldsl0 + LDSCTL_OFF + LC_BAR);
    if (hi - lo > 1) bar = xcd_barrier_post(WSP(unsigned, WS_CTL) + CW_BAR, (volatile LAS unsigned*)(ldsl0 + LDSCTL_OFF + LC_BAR));
#define IN(k) (lo <= (k) && (k) < hi)
#define SEAM(k) do { if (IN(k) && IN((k) + 1)) xcd_barrier(bar); } while (0)
#ifndef EN
#define EN 0xFFFF
#endif
    if ((EN & 1) && IN(0)) { phase0(C); SEAM(0); }
    const Ctx C0 = C;
#pragma unroll 1
    for (int l = 0; l < DEPTH; ++l) {
        const int p0 = 1 + l * PH_PER_LAYER;
        Ctx C = C0; { int t_ = C0.tid; asm volatile("" : "+v"(t_)); C.tid = t_; C.lane = t_ & 63; C.wave = __builtin_amdgcn_readfirstlane(t_ >> 6);
                      int b_ = C0.bid; asm volatile("" : "+s"(b_)); C.bid = b_; int g_ = C0.G; asm volatile("" : "+s"(g_)); C.G = g_; unsigned char* w_ = C0.ws; asm volatile("" : "+s"(w_)); C.ws = w_;
                      const CAS fptr_t* i_ = C0.in; asm volatile("" : "+s"(i_)); C.in = i_;
                      LAS unsigned char* l_ = C0.lds; asm volatile("" : "+s"(l_)); C.lds = l_; }
        LAS unsigned char* const ldsl = C.lds;
        const float* modl = WSP(const float, WS_MODS) + (size_t)l * 9 * 6144;
        if ((EN & 2) && IN(p0 + 0)) { phase_l1(C, l); SEAM(p0 + 0); }
        if ((EN & 4) && IN(p0 + 1)) {
            { pg8::SchedDense S; S.init(NTOK / 256, NHG / 256, C.G, C.bid, D, D);
              EpiHG E{WSP(bf16_t, WS_PHG), WSP(const float, WS_LOWER) + l * 512};
              pg8::gemm_phase<false>(ldsl, S, E, (const char*)WSP(bf16_t, WS_R1), (const char*)(WSP(bf16_t, WS_WIN) + (size_t)NHY * D), D, D, 128u * D * 2u, 128u * D * 2u, D / 64); }
            { pg8::SchedDense S; S.init(NHY / 256, NTOK / 256, C.G, C.bid, D, D);
              EpiHY E{WSP(bf16_t, WS_PHYT)};
              pg8::gemm_phase<false>(ldsl, S, E, (const char*)WSP(bf16_t, WS_WIN), (const char*)WSP(bf16_t, WS_R1), D, D, 128u * D * 2u, 128u * D * 2u, D / 64); }
            SEAM(p0 + 1);
        }
        if ((EN & 8) && IN(p0 + 2)) { phase_l3(C, l); SEAM(p0 + 2); }
        if ((EN & 16) && IN(p0 + 3)) { phase_l3b(C, l); SEAM(p0 + 3); }
        if ((EN & 32) && IN(p0 + 4)) {
            pg8::SchedDense S; S.init(NTOK / 256, D / 256, C.G, C.bid, D, D);
            EpiOut E{C.in[IN_X], C.in[IN_CTX], WSP(float, WS_XBUF), modl, l == 0 ? 1 : 0, C.dry};
            pg8::gemm_phase<false>(ldsl, S, E, (const char*)WSP(bf16_t, WS_R1), (const char*)WSP(bf16_t, WS_WOUT), D, D, 128u * D * 2u, 128u * D * 2u, D / 64);
            SEAM(p0 + 4);
        }
        if ((EN & 64) && IN(p0 + 5)) { phase_l5a(C, l); SEAM(p0 + 5); }
        if ((EN & 128) && IN(p0 + 6)) { phase_l5b(C, l); SEAM(p0 + 6); }
        if ((EN & 256) && IN(p0 + 7)) {
            build_tiletab(C, l);
            const volatile LAS int* lc = (const volatile LAS int*)(ldsl + LDSCTL_OFF);
            SchedUp S{lc[LC_T], C.G, C.bid, lc + LC_TILEBIN};
            EpiAct E{WSP(bf16_t, WS_R1), WSP(const float, WS_ROWW)};
            pg8::gemm_phase<false>(ldsl, S, E, (const char*)WSP(bf16_t, WS_PHG), (const char*)WSP(bf16_t, WS_WG), D, D, 128u * D * 2u, (unsigned)(WS_WU - WS_WG), D / 64);
            SEAM(p0 + 7);
        }
        if ((EN & 512) && IN(p0 + 8)) {
            build_tiletab(C, l);
            const volatile LAS int* lc = (const volatile LAS int*)(ldsl + LDSCTL_OFF);
            SchedDown S{lc[LC_T], C.G, C.bid, lc + LC_TILEBIN};
            EpiDown E{WSP(float, WS_XBUF), WSP(const int, WS_ROWTOK), modl, C.dry};
            pg8::gemm_phase<true>(ldsl, S, E, (const char*)WSP(bf16_t, WS_R1), (const char*)WSP(bf16_t, WS_WD), 512, 256, 128u * 512u * 2u, 128u * 256u * 2u, 4);
            SEAM(p0 + 8);
        }
    }
    if ((EN & 1024) && IN(N_PHASES - 1)) phase_final(C);
#undef IN
#undef SEAM
}

extern "C" void kernel_launch(void* const* d_in, const int* in_sizes, int n_in, void* d_out, int out_size, void* d_ws, size_t ws_size, hipStream_t stream) {
    static int grid = 0;
    if (grid == 0) {
        if (n_in != N_IN || in_sizes[0] != NLAT * D || out_size != NLAT * D || ws_size < WS_END) { fprintf(stderr, "kernel_launch: unexpected shapes / workspace (%d inputs, ws %zu < %zu)\n", n_in, ws_size, (size_t)WS_END); grid = -1; return; }
        int dev = 0, cus = 0, per_cu = 0;
        if (hipGetDevice(&dev) != hipSuccess || hipDeviceGetAttribute(&cus, hipDeviceAttributeMultiprocessorCount, dev) != hipSuccess) { grid = -1; return; }
        if (hipFuncSetAttribute((const void*)trunk_fwd, hipFuncAttributeMaxDynamicSharedMemorySize, LDS_BYTES) != hipSuccess) { fprintf(stderr, "kernel_launch: hipFuncSetAttribute failed\n"); grid = -1; return; }
        if (hipOccupancyMaxActiveBlocksPerMultiprocessor(&per_cu, (const void*)trunk_fwd, NTHR, LDS_BYTES) != hipSuccess || per_cu < 1) { fprintf(stderr, "kernel_launch: occupancy query says %d\n", per_cu); }
        (void)hipGetLastError();
        grid = cus;
    }
    if (grid < 0) return;
    (void)hipMemsetAsync((char*)d_ws + WS_CTL, 0, CTL_ZERO_BYTES, stream);
    Args a{};
    for (int i = 0; i < N_IN; ++i) a.in[i] = (const float*)d_in[i];
    a.out = (float*)d_out; a.ws = (unsigned char*)d_ws;
#if MK_PER_PHASE
    for (int p = 0; p < N_PHASES; ++p) { a.ph_lo = p; a.ph_hi = p + 1; const int kind = p == 0 ? 0 : (p == N_PHASES - 1 ? 10 : 1 + (p - 1) % PH_PER_LAYER);
        const int nrep = ((PROBE_HOST >> kind) & 1) ? 2 : 1; a.pad = nrep;
        for (int rep = 0; rep < nrep; ++rep) { a.rep = rep; hipLaunchKernelGGL(trunk_fwd, dim3(grid), dim3(NTHR), LDS_BYTES, stream, a); } }
#else
    a.ph_lo = 0; a.ph_hi = N_PHASES; a.rep = 0; a.pad = 1;
    hipLaunchKernelGGL(trunk_fwd, dim3(grid), dim3(NTHR), LDS_BYTES, stream, a);
#endif
}
```

```cpp
#include <hip/hip_runtime.h>
#include <cstdio>
#include <cstdint>

#ifndef PROBE_HOST
#define PROBE_HOST 0
#endif
#ifndef PROBE_SKIP
#define PROBE_SKIP 1
#endif
#ifndef MK_PER_PHASE
#define MK_PER_PHASE 0
#endif

#define LAS __attribute__((address_space(3)))
typedef unsigned short bf16_t;
typedef short bf16x8 __attribute__((ext_vector_type(8)));
typedef float f32x4 __attribute__((ext_vector_type(4)));
typedef float f32x2 __attribute__((ext_vector_type(2)));
typedef unsigned u32x4 __attribute__((ext_vector_type(4)));
typedef unsigned u32x2 __attribute__((ext_vector_type(2)));

constexpr int NB = 8, SEQ = 2048, D = 1024, DEPTH = 4, CTXL = 256;
constexpr int NLAT = NB * SEQ, NCTX = NB * CTXL, NTOK = NLAT + NCTX;
constexpr int DH = 512, NHY = 1536, NHG = 2560, DIN = 4096;
constexpr int NE = 16, DE = 256, NBIN = 24, SROWS = 24576;
constexpr float EPS = 1e-6f;
constexpr int NTHR = 512, NWAVES = 8;
enum { IN_X = 0, IN_C, IN_CTX, IN_CCTX, IN_WMOD, IN_BMOD, IN_WIN, IN_WOUT, IN_CONVW, IN_CONVB, IN_W1, IN_B1, IN_W2, IN_B2, IN_W3, IN_B3,
       IN_HYBIAS, IN_LB, IN_NORMW, IN_RW, IN_RB, IN_WG, IN_WU, IN_WD, IN_FNW, N_IN };

constexpr size_t MiB = 1u << 20;
constexpr size_t WS_CTL = 0, CTL_ZERO_BYTES = 1 * MiB;
constexpr size_t WS_MODS = 1 * MiB;
constexpr size_t WS_LOWER = 2 * MiB;
constexpr size_t WS_BIAS2 = 2 * MiB + 64 * 1024;
constexpr size_t WS_HPAD = 3 * MiB;
constexpr size_t WS_TOKINFO = 6 * MiB;
constexpr size_t WS_BLKBASE = 6 * MiB + 320 * 1024;
constexpr size_t WS_ROWTOK = 6 * MiB + 512 * 1024;
constexpr size_t WS_ROWW = 7 * MiB;
constexpr size_t WS_WIN = 8 * MiB;
constexpr size_t WS_WOUT = 16 * MiB;
constexpr size_t WS_WG = 18 * MiB;
constexpr size_t WS_WU = 26 * MiB;
constexpr size_t WS_WD = 34 * MiB;
constexpr size_t WS_KSPEC = 42 * MiB;
constexpr size_t WS_XBUF = 74 * MiB;
constexpr size_t WS_R1 = 146 * MiB;
constexpr size_t WS_PHG = 182 * MiB;
constexpr size_t WS_PHYT = 272 * MiB;
constexpr size_t WS_ODIR = 326 * MiB;
constexpr size_t WS_KSPC = 362 * MiB;
constexpr size_t WS_W3T = 378 * MiB;
constexpr size_t WS_HF = 380 * MiB;
constexpr size_t WS_END = 416 * MiB;
constexpr int CW_BAR = 4096;
constexpr int CW_CNT = 16384;
constexpr int CW_Q = 32768;

constexpr int LDS_BYTES = 147456;
constexpr int LDSCTL_OFF = 143 * 1024;
constexpr int LC_BAR = 0;
constexpr int LC_T = 8;
constexpr int LC_Q = 9;
constexpr int LC_OFFS = 16;
constexpr int LC_TILEBIN = 48;

__device__ __forceinline__ unsigned f2bf(float f) { unsigned u = __builtin_bit_cast(unsigned, f); return (u + 0x7fffu + ((u >> 16) & 1u)) >> 16; }
__device__ __forceinline__ unsigned pk2(float lo, float hi) { return f2bf(lo) | (f2bf(hi) << 16); }
__device__ __forceinline__ float bf2f(unsigned b) { return __builtin_bit_cast(float, (b & 0xffffu) << 16); }
__device__ __forceinline__ float bflo(unsigned w) { return __builtin_bit_cast(float, w << 16); }
__device__ __forceinline__ float bfhi(unsigned w) { return __builtin_bit_cast(float, w & 0xffff0000u); }
__device__ __forceinline__ float sigmoidf_(float x) { return 1.0f / (1.0f + __expf(-x)); }
__device__ __forceinline__ float siluf_(float x) { return x / (1.0f + __expf(-x)); }
#define DPP_ADD(v, ctrl, rmask) v += __builtin_bit_cast(float, __builtin_amdgcn_update_dpp(0, __builtin_bit_cast(int, v), ctrl, rmask, 0xF, false))
__device__ __forceinline__ float row16_sum(float v) {
    DPP_ADD(v, 0xB1, 0xF);
    DPP_ADD(v, 0x4E, 0xF);
    DPP_ADD(v, 0x141, 0xF);
    DPP_ADD(v, 0x140, 0xF);
    return v;
}
__device__ __forceinline__ float wave_sum(float v) {
    v = row16_sum(v);
    DPP_ADD(v, 0x142, 0xA);
    DPP_ADD(v, 0x143, 0xC);
    return __builtin_bit_cast(float, __builtin_amdgcn_readlane(__builtin_bit_cast(int, v), 63));
}
__device__ __forceinline__ int lane_id_opaque() { int x; asm volatile("v_mbcnt_lo_u32_b32 %0, -1, 0\n\tv_mbcnt_hi_u32_b32 %0, -1, %0" : "=v"(x)); return x; }
__device__ __forceinline__ int bidx(int row) { return row < NLAT ? (row >> 11) : 8; }
#define LDS_WAIT() asm volatile("s_waitcnt lgkmcnt(0)" ::: "memory")

#define XB_TMO      128
#define XB_XCNT(j)  (256  + 64 * (j))
#define XB_XSUB(j)  (1280 + 64 * (j))
#define XB_XGEN(j)  (2304 + 64 * (j))
#define XB_TOP      3328
#define XB_TOPGEN   3392
#define XCD_BAR_WORDS 3456
#define XB_SPIN_CAP (1u << 18)
__device__ __forceinline__ unsigned xb_ld(unsigned* p)              { return __hip_atomic_load(p, __ATOMIC_RELAXED, __HIP_MEMORY_SCOPE_AGENT); }
__device__ __forceinline__ unsigned xb_add(unsigned* p, unsigned v) { return __hip_atomic_fetch_add(p, v, __ATOMIC_RELAXED, __HIP_MEMORY_SCOPE_AGENT); }
__device__ __forceinline__ unsigned xb_xcc_id() { return (unsigned)__builtin_amdgcn_s_getreg((3 << 11) | 20) & 0xFu; }
#define XB_SPIN(cond, bar) do { unsigned _sp = 0; while (cond) { __builtin_amdgcn_s_sleep(1); \
    if ((++_sp & 255u) == 0u) { if (xb_ld(&(bar)[XB_TMO])) break; if (_sp > XB_SPIN_CAP) { atomicAdd(&(bar)[XB_TMO], 1u); break; } } } } while (0)
struct XcdBarrier { unsigned* bar; unsigned x; volatile LAS unsigned* st; };
__device__ __forceinline__ XcdBarrier xcd_barrier_post(unsigned* bar, volatile LAS unsigned* st) {
    XcdBarrier b; b.bar = bar; b.x = xb_xcc_id(); b.st = st;
    if (threadIdx.x == 0) (void)xb_add(&bar[XB_XCNT(b.x)], 1u);
    return b;
}
__device__ __forceinline__ void xcd_barrier_complete(unsigned* bar, unsigned x, unsigned& nloc, unsigned& nx) {
    const unsigned G = gridDim.x * gridDim.y * gridDim.z;
    unsigned sum, cnt, mine, sp = 0u;
    for (;;) {
        sum = 0u; cnt = 0u; mine = 0u;
#pragma unroll
        for (unsigned j = 0; j < 16; ++j) { const unsigned c = xb_ld(&bar[XB_XCNT(j)]); sum += c; cnt += (c > 0u) ? 1u : 0u; mine = (j == x) ? c : mine; }
        if (sum == G) break;
        __builtin_amdgcn_s_sleep(1);
        if ((++sp & 255u) == 0u) { if (xb_ld(&bar[XB_TMO])) break; if (sp > XB_SPIN_CAP) { atomicAdd(&bar[XB_TMO], 1u); break; } }
    }
    nloc = mine > 0u ? mine : 1u; nx = cnt > 0u ? cnt : 1u;
}
__device__ __forceinline__ void xcd_barrier(const XcdBarrier& b) {
    asm volatile("s_waitcnt vmcnt(0)" ::: "memory");
    __syncthreads();
    if (threadIdx.x == 0) {
        unsigned* bar = b.bar; unsigned bx = b.x;
        asm volatile("" : "+s"(bar), "+s"(bx));
        __builtin_amdgcn_s_waitcnt(0);
        unsigned nloc = b.st[0], nx = b.st[1];
        if (nloc == 0u) { xcd_barrier_complete(bar, bx, nloc, nx); b.st[0] = nloc; b.st[1] = nx; }
        const unsigned old = xb_add(&bar[XB_XSUB(bx)], 1u);
        const unsigned gen = old / nloc;
        if (old + 1u == (gen + 1u) * nloc) {
            __builtin_amdgcn_fence(__ATOMIC_RELEASE, "agent");
            asm volatile("s_waitcnt vmcnt(0)" ::: "memory");
            const unsigned og = xb_add(&bar[XB_TOP], 1u);
            const unsigned tg = og / nx;
            if (og + 1u == (tg + 1u) * nx) xb_add(&bar[XB_TOPGEN], 1u);
            else XB_SPIN(xb_ld(&bar[XB_TOPGEN]) == tg, bar);
            __builtin_amdgcn_fence(__ATOMIC_ACQUIRE, "agent");
            xb_add(&bar[XB_XGEN(bx)], 1u);
            asm volatile("s_waitcnt vmcnt(0)" ::: "memory");
        } else {
            XB_SPIN(xb_ld(&bar[XB_XGEN(bx)]) == gen, bar);
            __builtin_amdgcn_fence(__ATOMIC_ACQUIRE, "agent");
            asm volatile("s_waitcnt vmcnt(0)" ::: "memory");
        }
    }
    __syncthreads();
}

namespace pg8 {
constexpr int BM = 256, BK = 64, HALF = 128, HTB = HALF * BK * 2, STAGE_BYTES = 8 * HTB, NXCD = 8, WGM = 8;
__host__ __device__ __forceinline__ int lds_byte(int r, int c) { const int st = (r >> 4) * 2 + (c >> 5), rr = r & 15, cc = c & 31, ob = rr * 64 + cc * 2; return st * 1024 + (ob ^ (((ob >> 9) & 1) << 5)); }
__host__ __device__ __forceinline__ void stage_rc(int b, int& R, int& C) { const int st = b / 1024, sb = b % 1024, swz = sb ^ (((sb >> 9) & 1) << 5); R = (st >> 1) * 16 + swz / 64; C = (st & 1) * 32 + (swz % 64) / 2; }
__host__ __device__ __forceinline__ int perm32(int rho) { const int n = rho >> 4, i = rho & 15; return 8 * (i >> 2) + 4 * n + (i & 3); }

struct GUnit { unsigned a, b; int last, i0, i1; };

template <bool SUB, class Epi, class Sched>
__device__ __forceinline__ void gemm_phase(LAS unsigned char* lds, const Sched& S, const Epi& E, const char* Abase, const char* Bbase, const int lda, const int ldb, const unsigned ahalf, const unsigned bhalf, const int nt) {
    int tid_ = threadIdx.x; asm volatile("" : "+v"(tid_));
    const int tid = tid_, wid = __builtin_amdgcn_readfirstlane(tid >> 6), lane = tid & 63, wr = wid >> 2, wc = wid & 3, fr = lane & 15, fq = lane >> 4;
    unsigned voffA[2], voffB[2];
#pragma unroll
    for (int i = 0; i < 2; ++i) { int R, C; stage_rc(tid * 16 + i * 8192, R, C); const int Rb = Epi::PERM ? ((R & ~31) + perm32(R & 31)) : R;
        voffA[i] = (unsigned)(R * lda + C) * 2u; voffB[i] = (unsigned)(Rb * ldb + C) * 2u; }
    constexpr unsigned kstep = BK * 2;
    const unsigned ldsw = (unsigned)wid * 1024u;
    const int aoff = lds_byte(wr * 64 + fr, fq * 8), boff = lds_byte(wc * 32 + fr, fq * 8);
#define PG8_SA(b, h) (((b) * 2 + (h)) * HTB)
#define PG8_SB(b, h) ((4 + (b) * 2 + (h)) * HTB)
#define PG8_STAGE(bufoff, gbase, voff) do { _Pragma("unroll") for (int _i = 0; _i < 2; ++_i) \
        __builtin_amdgcn_global_load_lds((const unsigned*)((const char*)(gbase) + (voff)[_i]), (LAS unsigned*)(lds + (bufoff) + ldsw + _i * 8192), 16, 0, 0); } while (0)
#define PG8_LDA(dst, b, h) do { _Pragma("unroll") for (int m = 0; m < 4; ++m) _Pragma("unroll") for (int k = 0; k < 2; ++k) dst[m][k] = *(const LAS bf16x8*)(lds + PG8_SA(b, h) + aoff + m * 2048 + k * 1024); } while (0)
#define PG8_LDB(dst, b, h) do { _Pragma("unroll") for (int n = 0; n < 2; ++n) _Pragma("unroll") for (int k = 0; k < 2; ++k) dst[n][k] = *(const LAS bf16x8*)(lds + PG8_SB(b, h) + boff + n * 2048 + k * 1024); } while (0)
#define PG8_MMA(ai, bj, At, Bt) do { __builtin_amdgcn_s_setprio(1); _Pragma("unroll") for (int m = 0; m < 4; ++m) _Pragma("unroll") for (int n = 0; n < 2; ++n) _Pragma("unroll") for (int k = 0; k < 2; ++k) \
        acc[ai][bj][m][n] = __builtin_amdgcn_mfma_f32_16x16x32_bf16(Bt[n][k], At[m][k], acc[ai][bj][m][n], 0, 0, 0); __builtin_amdgcn_s_setprio(0); } while (0)
#define PG8_WAIT_V(n) asm volatile("s_waitcnt vmcnt(" #n ")" ::: "memory")
#define PG8_WAIT_L(n) asm volatile("s_waitcnt lgkmcnt(" #n ")" ::: "memory")
#define PG8_BAR __builtin_amdgcn_s_barrier()
#define PG8_SCHED __builtin_amdgcn_sched_barrier(0)
    GUnit cur, nxt; int ui = 0;
    if (!S.next(0, cur)) return;
    f32x4 acc[2][2][4][2];
#pragma unroll
    for (int a = 0; a < 2; ++a)
#pragma unroll
        for (int b = 0; b < 2; ++b)
#pragma unroll
            for (int m = 0; m < 4; ++m)
#pragma unroll
                for (int n = 0; n < 2; ++n) acc[a][b][m][n] = (f32x4){0.f, 0.f, 0.f, 0.f};
    bf16x8 At[4][2], B0[2][2], B1[2][2];
    { const char* cA = Abase + cur.a; const char* cB = Bbase + cur.b;
      PG8_STAGE(PG8_SB(0, 0), cB, voffB); PG8_STAGE(PG8_SB(0, 1), cB + bhalf, voffB); PG8_STAGE(PG8_SA(0, 0), cA, voffA); PG8_STAGE(PG8_SA(0, 1), cA + ahalf, voffA);
      if (wr == 1) PG8_BAR;
      PG8_WAIT_V(2); PG8_BAR;
      PG8_STAGE(PG8_SB(1, 0), cB + kstep, voffB); PG8_STAGE(PG8_SA(1, 0), cA + kstep, voffA); PG8_STAGE(PG8_SB(1, 1), cB + bhalf + kstep, voffB);
      PG8_WAIT_V(6); PG8_BAR; }
    for (;;) {
        const bool has_next = S.next(ui + 1, nxt);
        const char* cA = Abase + cur.a; const char* cB = Bbase + cur.b;
        const char* nA = Abase + (has_next ? nxt.a : cur.a); const char* nB = Bbase + (has_next ? nxt.b : cur.b);
        for (int t = 0; t < nt; t += 2) {
            const bool last = (t == nt - 2);
            const char* a1 = cA + (unsigned)(t + 1) * kstep;
            const char* a2 = last ? nA : cA + (unsigned)(t + 2) * kstep; const char* b2 = last ? nB : cB + (unsigned)(t + 2) * kstep;
            const char* a3 = a2 + kstep; const char* b3 = b2 + kstep;
            PG8_LDB(B0, 0, 0); PG8_LDB(B1, 0, 1); PG8_SCHED; PG8_LDA(At, 0, 0); PG8_STAGE(PG8_SA(1, 1), a1 + ahalf, voffA);
            PG8_WAIT_V(8); PG8_WAIT_L(0); PG8_BAR; PG8_MMA(0, 0, At, B0); PG8_MMA(0, 1, At, B1); PG8_BAR; PG8_SCHED;
            PG8_LDA(At, 0, 1); PG8_STAGE(PG8_SB(0, 0), b2, voffB); PG8_STAGE(PG8_SB(0, 1), b2 + bhalf, voffB); PG8_STAGE(PG8_SA(0, 0), a2, voffA);
            PG8_WAIT_V(8); PG8_WAIT_L(0); PG8_BAR; PG8_MMA(1, 0, At, B0); PG8_MMA(1, 1, At, B1); PG8_BAR; PG8_SCHED;
            PG8_LDB(B0, 1, 0); PG8_LDB(B1, 1, 1); PG8_SCHED; PG8_LDA(At, 1, 0); PG8_STAGE(PG8_SA(0, 1), a2 + ahalf, voffA);
            PG8_WAIT_V(8); PG8_WAIT_L(0); PG8_BAR; PG8_MMA(0, 0, At, B0); PG8_MMA(0, 1, At, B1); PG8_BAR; PG8_SCHED;
            PG8_LDA(At, 1, 1); PG8_STAGE(PG8_SB(1, 0), b3, voffB); PG8_STAGE(PG8_SB(1, 1), b3 + bhalf, voffB); PG8_STAGE(PG8_SA(1, 0), a3, voffA);
            PG8_WAIT_V(8); PG8_WAIT_L(0); PG8_BAR; PG8_MMA(1, 0, At, B0); PG8_MMA(1, 1, At, B1); PG8_BAR; PG8_SCHED;
        }
        const bool fin = SUB ? (cur.last != 0) : true;
        if (fin) { if (wr == 0) PG8_BAR; E(acc, cur, wr, wc, fr, fq); }
        if (!has_next) break;
        if (fin) {
#pragma unroll
            for (int a = 0; a < 2; ++a)
#pragma unroll
                for (int b = 0; b < 2; ++b)
#pragma unroll
                    for (int m = 0; m < 4; ++m)
#pragma unroll
                        for (int n = 0; n < 2; ++n) acc[a][b][m][n] = (f32x4){0.f, 0.f, 0.f, 0.f};
        }
        cur = nxt; ++ui;
        if (fin) { if (wr == 1) PG8_BAR; }
    }
    PG8_WAIT_V(0);
    PG8_BAR;
#undef PG8_SA
#undef PG8_SB
#undef PG8_STAGE
#undef PG8_LDA
#undef PG8_LDB
#undef PG8_MMA
#undef PG8_WAIT_V
#undef PG8_WAIT_L
#undef PG8_BAR
#undef PG8_SCHED
}

struct SchedDense {
    int nM, nN, nwg, G, c; unsigned atile, btile;
    __device__ __forceinline__ void init(int nM_, int nN_, int G_, int c_, int lda, int ldb) {
        nM = nM_; nN = nN_; nwg = nM * nN; G = G_; c = c_; atile = 256u * lda * 2u; btile = 256u * ldb * 2u; }
    __device__ __forceinline__ bool next(int i, GUnit& u) const {
        const int L = i * G + c; if (L >= nwg) return false;
        int wgid = L; { const int q = nwg / NXCD, r = nwg % NXCD, xcd = wgid % NXCD, off = wgid / NXCD; wgid = (xcd < r ? xcd * (q + 1) : r * (q + 1) + (xcd - r) * q) + off; }
        const int nig = WGM * nN, gid = wgid / nig, fm = gid * WGM, gsz = (nM - fm) < WGM ? (nM - fm) : WGM;
        const int pm = fm + ((wgid % nig) % gsz), pn = (wgid % nig) / gsz;
        u.a = (unsigned)pm * atile; u.b = (unsigned)pn * btile; u.last = 1; u.i0 = pm; u.i1 = pn; return true;
    }
};
}

struct Args { const float* in[N_IN]; float* out; unsigned char* ws; int ph_lo, ph_hi, rep, pad; };
static_assert(sizeof(Args) == N_IN * 8 + 8 + 8 + 16, "Args has no padding");

#define CAS __attribute__((address_space(4)))
typedef const float* fptr_t;
struct Ctx {
    const CAS fptr_t* in; float* out; unsigned char* ws; LAS unsigned char* lds; int tid, lane, wave, G, bid, rep, dry;
};
#define WSP(T, off) ((T*)(C.ws + (off)))

__device__ __forceinline__ void build_tiletab(const Ctx& C, int l) {
    volatile LAS int* lc = (volatile LAS int*)(C.lds + LDSCTL_OFF);
    __syncthreads();
    if (C.tid == 0) {
        const unsigned* cnt = WSP(const unsigned, WS_CTL) + CW_CNT + l * 32 * 64;
        int off = 0, t = 0;
        for (int b = 0; b < NBIN; ++b) {
            const int n = (int)__hip_atomic_load(cnt + b * 64, __ATOMIC_RELAXED, __HIP_MEMORY_SCOPE_AGENT);
            lc[LC_OFFS + b] = off;
            const int nt = (n + 255) >> 8;
            for (int k = 0; k < nt; ++k) lc[LC_TILEBIN + t + k] = b;
            t += nt; off += nt * 256;
        }
        lc[LC_OFFS + NBIN] = off; lc[LC_T] = t;
    }
    __syncthreads();
}
__device__ __forceinline__ int expert_of(int bin, int es) {
    const int g = bin / 6, p = bin - g * 6;
    const int lo = p < 3 ? 0 : (p < 5 ? 1 : 2), hi = p < 3 ? p + 1 : (p < 5 ? p - 1 : 3);
    return 4 * g + (es ? hi : lo);
}

struct SchedUp {
    int T, G, c; const volatile LAS int* tilebin;
    __device__ __forceinline__ bool next(int i, pg8::GUnit& u) const {
        const int idx = i * G + c; if (idx >= 4 * T) return false;
        const int rt = idx >> 2, q = idx & 3, es = q >> 1, fb = q & 1;
        const int bin = __builtin_amdgcn_readfirstlane(tilebin[rt]);
        const int e = expert_of(bin, es);
        u.a = (unsigned)rt * 256u * 2048u; u.b = (unsigned)(e * 256 + fb * 128) * 2048u;
        u.last = 1; u.i0 = rt; u.i1 = q; return true;
    }
};
struct SchedDown {
    int T, G, c; const volatile LAS int* tilebin;
    __device__ __forceinline__ bool next(int i, pg8::GUnit& u) const {
        const int idx = (i >> 1) * G + c, sub = i & 1; if (idx >= 4 * T) return false;
        const int rt = idx >> 2, pn = idx & 3;
        const int bin = __builtin_amdgcn_readfirstlane(tilebin[rt]);
        const int e = expert_of(bin, sub);
        u.a = (unsigned)rt * 256u * 1024u + (unsigned)sub * 512u; u.b = (unsigned)(e * 1024 + pn * 256) * 512u;
        u.last = sub; u.i0 = rt; u.i1 = pn; return true;
    }
};

struct EpiHG {
    static constexpr bool PERM = true;
    bf16_t* O; const float* lower;
    __device__ __forceinline__ void operator()(const f32x4 (&acc)[2][2][4][2], const pg8::GUnit& u, int wr, int wc, int fr, int fq) const {
        const int kind = u.i1 >> 1;
        const int row0 = u.i0 * 256 + wr * 64 + fr, colt = u.i1 * 256 + wc * 32 + 8 * fq;
#pragma unroll
        for (int bj = 0; bj < 2; ++bj) {
            const int col = colt + bj * 128;
            float om[8];
#pragma unroll
            for (int j = 0; j < 8; ++j) om[j] = 1.f;
            if (kind >= 3) { const float* lb = lower + (kind - 3) * 2048 + (col & 511);
#pragma unroll
                for (int j = 0; j < 8; ++j) om[j] = 1.f - lb[j]; }
#pragma unroll
            for (int ai = 0; ai < 2; ++ai)
#pragma unroll
                for (int m = 0; m < 4; ++m) {
                    float v[8];
#pragma unroll
                    for (int j = 0; j < 8; ++j) v[j] = acc[ai][bj][m][j >> 2][j & 3];
                    if (kind == 0) {
#pragma unroll
                        for (int j = 0; j < 8; ++j) v[j] = siluf_(v[j]);
                    } else if (kind >= 3) {
#pragma unroll
                        for (int j = 0; j < 8; ++j) v[j] = om[j] * sigmoidf_(-v[j]);
                    }
                    u32x4 w; w.x = pk2(v[0], v[1]); w.y = pk2(v[2], v[3]); w.z = pk2(v[4], v[5]); w.w = pk2(v[6], v[7]);
                    *(u32x4*)(O + (size_t)(row0 + ai * 128 + m * 16) * NHG + col) = w;
                }
        }
    }
};
struct EpiHY {
    static constexpr bool PERM = true;
    bf16_t* O;
    __device__ __forceinline__ void operator()(const f32x4 (&acc)[2][2][4][2], const pg8::GUnit& u, int wr, int wc, int fr, int fq) const {
        const int row0 = u.i0 * 256 + wr * 64 + fr, colt = u.i1 * 256 + wc * 32 + 8 * fq;
#pragma unroll
        for (int ai = 0; ai < 2; ++ai)
#pragma unroll
            for (int m = 0; m < 4; ++m)
#pragma unroll
                for (int bj = 0; bj < 2; ++bj) {
                    const f32x4 v0 = acc[ai][bj][m][0], v1 = acc[ai][bj][m][1];
                    u32x4 w; w.x = pk2(v0[0], v0[1]); w.y = pk2(v0[2], v0[3]); w.z = pk2(v1[0], v1[1]); w.w = pk2(v1[2], v1[3]);
                    *(u32x4*)(O + (size_t)(row0 + ai * 128 + m * 16) * NTOK + colt + bj * 128) = w;
                }
    }
};
struct EpiOut {
    static constexpr bool PERM = false;
    const float* xlat; const float* xctx; float* xo; const float* mods; int first; int dry;
    __device__ __forceinline__ void operator()(const f32x4 (&acc)[2][2][4][2], const pg8::GUnit& u, int wr, int wc, int fr, int fq) const {
        const int row0 = u.i0 * 256 + wr * 64 + fr, col0 = u.i1 * 256 + wc * 32 + 4 * fq;
#pragma unroll
        for (int ai = 0; ai < 2; ++ai)
#pragma unroll
            for (int m = 0; m < 4; ++m) {
                const int row = row0 + ai * 128 + m * 16;
                const float* src = first ? (row < NLAT ? xlat + (size_t)row * D : xctx + (size_t)(row - NLAT) * D) : xo + (size_t)row * D;
                const float* g1 = mods + bidx(row) * 6144 + 2048;
#pragma unroll
                for (int bj = 0; bj < 2; ++bj)
#pragma unroll
                    for (int n = 0; n < 2; ++n) { const int col = col0 + bj * 128 + n * 16;
                        const f32x4 xv = *(const f32x4*)(src + col), gv = *(const f32x4*)(g1 + col);
                        if (!dry) *(f32x4*)(xo + (size_t)row * D + col) = xv + gv * acc[ai][bj][m][n]; }
            }
    }
};
struct EpiAct {
    static constexpr bool PERM = true;
    bf16_t* O; const float* roww;
    __device__ __forceinline__ void operator()(const f32x4 (&acc)[2][2][4][2], const pg8::GUnit& u, int wr, int wc, int fr, int fq) const {
        const int es = u.i1 >> 1; const int pos0 = u.i0 * 256 + wr * 64 + fr, col = u.i1 * 128 + wc * 32 + 8 * fq;
#pragma unroll
        for (int ai = 0; ai < 2; ++ai)
#pragma unroll
            for (int m = 0; m < 4; ++m) {
                const int pos = pos0 + ai * 128 + m * 16;
                const float wgt = roww[pos * 2 + es];
                float v[8];
#pragma unroll
                for (int j = 0; j < 8; ++j) v[j] = siluf_(acc[ai][0][m][j >> 2][j & 3]) * acc[ai][1][m][j >> 2][j & 3] * wgt;
                u32x4 w; w.x = pk2(v[0], v[1]); w.y = pk2(v[2], v[3]); w.z = pk2(v[4], v[5]); w.w = pk2(v[6], v[7]);
                *(u32x4*)(O + (size_t)pos * 512 + col) = w;
            }
    }
};
struct EpiDown {
    static constexpr bool PERM = false;
    float* xo; const int* rowtok; const float* mods; int dry;
    __device__ __forceinline__ void operator()(const f32x4 (&acc)[2][2][4][2], const pg8::GUnit& u, int wr, int wc, int fr, int fq) const {
        const int pos0 = u.i0 * 256 + wr * 64 + fr, col0 = u.i1 * 256 + wc * 32 + 4 * fq;
#pragma unroll
        for (int ai = 0; ai < 2; ++ai)
#pragma unroll
            for (int m = 0; m < 4; ++m) {
                const int tok = rowtok[pos0 + ai * 128 + m * 16];
                if (tok >= 0) {
                    const float* g2 = mods + bidx(tok) * 6144 + 5120;
                    float* xr = xo + (size_t)tok * D;
#pragma unroll
                    for (int bj = 0; bj < 2; ++bj)
#pragma unroll
                        for (int n = 0; n < 2; ++n) { const int col = col0 + bj * 128 + n * 16;
                            const f32x4 xv = *(const f32x4*)(xr + col), gv = *(const f32x4*)(g2 + col);
                            if (!dry) *(f32x4*)(xr + col) = xv + gv * acc[ai][bj][m][n]; }
                }
            }
    }
};

struct SchedFilt {
    int G, c;
    __device__ __forceinline__ bool next(int i, pg8::GUnit& u) const {
        const int idx = i * G + c; if (idx >= 4 * 72) return false;
        const int l = idx / 72, r = idx - l * 72, pm = r / 9, pn = r - pm * 9;
        u.a = (unsigned)(l * 2048 + pm * 256) * 256u; u.b = (unsigned)(l * 2304 + pn * 256) * 256u; u.last = 1; u.i0 = l * 16 + pm; u.i1 = pn; return true;
    }
};
struct EpiFilt {
    static constexpr bool PERM = true;
    bf16_t* HF; const float* b3;
    __device__ __forceinline__ void operator()(const f32x4 (&acc)[2][2][4][2], const pg8::GUnit& u, int wr, int wc, int fr, int fq) const {
        const int l = u.i0 >> 4, pm = u.i0 & 15;
        const int row0 = pm * 256 + wr * 64 + fr, t00 = u.i1 * 256 + wc * 32 + 8 * fq;
#pragma unroll
        for (int ai = 0; ai < 2; ++ai)
#pragma unroll
            for (int m = 0; m < 4; ++m) {
                const int row = row0 + ai * 128 + m * 16, c = row & 511;
                const float delta = fabsf(logf(1e-2f) / 0.3f + (float)c * ((logf(1e-2f) / 1.5f - logf(1e-2f) / 0.3f) / 511.0f));
                const float bias = b3[l * 2048 + row];
#pragma unroll
                for (int bj = 0; bj < 2; ++bj) {
                    const int t0 = t00 + bj * 128;
                    float v[8];
#pragma unroll
                    for (int j = 0; j < 8; ++j) { const int t = t0 + j; const float tn = t < 2048 ? (float)t / 2047.0f : (float)(t - 2048) / 255.0f;
                        v[j] = (acc[ai][bj][m][j >> 2][j & 3] + bias) * expf(-tn * delta); }
                    u32x4 w; w.x = pk2(v[0], v[1]); w.y = pk2(v[2], v[3]); w.z = pk2(v[4], v[5]); w.w = pk2(v[6], v[7]);
                    *(u32x4*)(HF + ((size_t)(l * 2048 + row)) * 2304 + t0) = w;
                }
            }
    }
};

__device__ __forceinline__ int padx(int i) { return i + (i >> 3); }
__device__ __forceinline__ f32x2 cmul(f32x2 a, f32x2 b) { return (f32x2){a.x * b.x - a.y * b.y, a.x * b.y + a.y * b.x}; }
__device__ __forceinline__ f32x2 cmulc(f32x2 a, f32x2 b) { return (f32x2){a.x * b.x + a.y * b.y, a.y * b.x - a.x * b.y}; }
constexpr int XPAD = 2048 + 256;

__device__ __forceinline__ void fft_p1_dif(f32x2 (&v)[8], int tt, const LAS f32x2* T) {
#pragma unroll
    for (int g = 0; g < 2; ++g) { const int u = tt + 256 * g;
#pragma unroll
        for (int j = 0; j < 2; ++j) { const f32x2 a = v[g + 2 * j], b = v[g + 2 * j + 4]; v[g + 2 * j] = a + b; v[g + 2 * j + 4] = cmul(a - b, T[2 * (u + 512 * j)]); }
        const f32x2 tw = T[4 * u];
        { const f32x2 a = v[g], b = v[g + 2]; v[g] = a + b; v[g + 2] = cmul(a - b, tw); }
        { const f32x2 a = v[g + 4], b = v[g + 6]; v[g + 4] = a + b; v[g + 6] = cmul(a - b, tw); } }
}
__device__ __forceinline__ void fft_p1_dit(f32x2 (&v)[8], int tt, const LAS f32x2* T) {
#pragma unroll
    for (int g = 0; g < 2; ++g) { const int u = tt + 256 * g;
        const f32x2 tw = T[4 * u];
        { const f32x2 a = v[g], b = cmulc(v[g + 2], tw); v[g] = a + b; v[g + 2] = a - b; }
        { const f32x2 a = v[g + 4], b = cmulc(v[g + 6], tw); v[g + 4] = a + b; v[g + 6] = a - b; }
#pragma unroll
        for (int j = 0; j < 2; ++j) { const f32x2 a = v[g + 2 * j], b = cmulc(v[g + 2 * j + 4], T[2 * (u + 512 * j)]); v[g + 2 * j] = a + b; v[g + 2 * j + 4] = a - b; } }
}
template <int Q> __device__ __forceinline__ void r8_dif(f32x2 (&e)[8], int r, const LAS f32x2* T) {
    constexpr int S2 = 512 / Q;
#pragma unroll
    for (int j = 0; j < 4; ++j) { const f32x2 a = e[j], b = e[j + 4]; e[j] = a + b; e[j + 4] = cmul(a - b, T[S2 * (r + Q * j)]); }
#pragma unroll
    for (int jj = 0; jj < 4; ++jj) { const int j = (jj & 1) + 4 * (jj >> 1); const f32x2 a = e[j], b = e[j + 2]; e[j] = a + b; e[j + 2] = cmul(a - b, T[2 * S2 * (r + Q * (j & 1))]); }
    const f32x2 tw = T[4 * S2 * r];
#pragma unroll
    for (int j = 0; j < 8; j += 2) { const f32x2 a = e[j], b = e[j + 1]; e[j] = a + b; e[j + 1] = cmul(a - b, tw); }
}
template <int Q> __device__ __forceinline__ void r8_dit(f32x2 (&e)[8], int r, const LAS f32x2* T) {
    constexpr int S2 = 512 / Q;
    const f32x2 tw = T[4 * S2 * r];
#pragma unroll
    for (int j = 0; j < 8; j += 2) { const f32x2 a = e[j], b = cmulc(e[j + 1], tw); e[j] = a + b; e[j + 1] = a - b; }
#pragma unroll
    for (int jj = 0; jj < 4; ++jj) { const int j = (jj & 1) + 4 * (jj >> 1); const f32x2 a = e[j], b = cmulc(e[j + 2], T[2 * S2 * (r + Q * (j & 1))]); e[j] = a + b; e[j + 2] = a - b; }
#pragma unroll
    for (int j = 0; j < 4; ++j) { const f32x2 a = e[j], b = cmulc(e[j + 4], T[S2 * (r + Q * j)]); e[j] = a + b; e[j + 4] = a - b; }
}
template <int Q, bool INV> __device__ __forceinline__ void fft_mid(LAS f32x2* X, int tt, const LAS f32x2* T) {
    const int blk = tt / Q, r = tt % Q, base = blk * 8 * Q + r;
    f32x2 e[8];
#pragma unroll
    for (int j = 0; j < 8; ++j) e[j] = X[padx(base + Q * j)];
    if (INV) r8_dit<Q>(e, r, T); else r8_dif<Q>(e, r, T);
#pragma unroll
    for (int j = 0; j < 8; ++j) X[padx(base + Q * j)] = e[j];
}
__device__ __forceinline__ void fft_conv_half(f32x2 (&v)[8], LAS f32x2* X, const LAS f32x2* T, const f32x2* K, int tt) {
    f32x2 kv[8];
#pragma unroll
    for (int j = 0; j < 8; ++j) kv[j] = K[8 * tt + j];
    fft_p1_dif(v, tt, T);
#pragma unroll
    for (int m = 0; m < 8; ++m) X[padx(tt + 256 * m)] = v[m];
    __syncthreads();
    fft_mid<64, false>(X, tt, T); __syncthreads();
    fft_mid<8, false>(X, tt, T); __syncthreads();
    f32x2 e[8];
#pragma unroll
    for (int j = 0; j < 8; ++j) e[j] = X[padx(8 * tt + j)];
    r8_dif<1>(e, 0, T);
#pragma unroll
    for (int j = 0; j < 8; ++j) e[j] = cmul(e[j], kv[j]);
    r8_dit<1>(e, 0, T);
#pragma unroll
    for (int j = 0; j < 8; ++j) X[padx(8 * tt + j)] = e[j];
    __syncthreads();
    fft_mid<8, true>(X, tt, T); __syncthreads();
    fft_mid<64, true>(X, tt, T); __syncthreads();
#pragma unroll
    for (int m = 0; m < 8; ++m) v[m] = X[padx(tt + 256 * m)];
    fft_p1_dit(v, tt, T);
}
__device__ __forceinline__ void fft_fwd_store(f32x2 (&v)[8], LAS f32x2* X, const LAS f32x2* T, f32x2* Kout, int tt) {
    fft_p1_dif(v, tt, T);
#pragma unroll
    for (int m = 0; m < 8; ++m) X[padx(tt + 256 * m)] = v[m];
    __syncthreads();
    fft_mid<64, false>(X, tt, T); __syncthreads();
    fft_mid<8, false>(X, tt, T); __syncthreads();
    f32x2 e[8];
#pragma unroll
    for (int j = 0; j < 8; ++j) e[j] = X[padx(8 * tt + j)];
    r8_dif<1>(e, 0, T);
#pragma unroll
    for (int j = 0; j < 8; ++j) Kout[8 * tt + j] = e[j];
    __syncthreads();
}
__device__ __forceinline__ void build_twiddles(const Ctx& C, LAS f32x2* T) {
    for (int k = C.tid; k < 2048; k += NTHR) { float s, c; sincospif((float)k * (1.0f / 2048.0f), &s, &c); T[k] = (f32x2){c, -s}; }
}

__device__ __forceinline__ void phase0(const Ctx& C) {
    LAS float* sil = (LAS float*)C.lds;
    LAS float* red = sil + 9 * 1024;
    LAS float* zs = red + 8 * 9 * 64;
    LAS float* h1s = zs + 8 * 40;
    const float* cin = C.in[IN_C]; const float* cctx = C.in[IN_CCTX];
    for (int i = C.tid; i < 9 * 1024; i += NTHR) { const int r = i >> 10, k = i & 1023; const float v = r < 8 ? cin[r * 1024 + k] : cctx[k]; sil[i] = v / (1.0f + expf(-v)); }
    __syncthreads();
    float* mods = WSP(float, WS_MODS);
    const float* wmod = C.in[IN_WMOD]; const float* bmod = C.in[IN_BMOD];
    for (int item = C.bid; item < 4 * 96; item += C.G) {
        const int l = item / 96, cb = item % 96, cc = C.tid & 63, kg = C.tid >> 6;
        const float* w = wmod + ((size_t)l * 1024 + kg * 128) * 6144 + cb * 64 + cc;
        const LAS float* sk = sil + kg * 128;
        float acc[9];
#pragma unroll
        for (int r = 0; r < 9; ++r) acc[r] = 0.f;
#pragma unroll 4
        for (int k = 0; k < 128; ++k) { const float wv = w[(size_t)k * 6144];
#pragma unroll
            for (int r = 0; r < 9; ++r) acc[r] += sk[r * 1024 + k] * wv; }
#pragma unroll
        for (int r = 0; r < 9; ++r) red[(kg * 9 + r) * 64 + cc] = acc[r];
        __syncthreads();
        for (int o = C.tid; o < 576; o += NTHR) { const int r = o >> 6, c2 = o & 63; float s = 0.f;
#pragma unroll
            for (int g = 0; g < 8; ++g) s += red[(g * 9 + r) * 64 + c2];
            mods[(size_t)(l * 9 + r) * 6144 + cb * 64 + c2] = s + bmod[l * 6144 + cb * 64 + c2]; }
        __syncthreads();
    }
    for (int item = C.bid; item < 4 * 288; item += C.G) {
        const int l = item / 288, r = item % 288, isctx = r >= 256;
        const int L = isctx ? 256 : 2048, t0 = (isctx ? r - 256 : r) * 8, tl = C.tid >> 6, j = C.tid & 63, t = t0 + tl;
        if (j < 33) { float z;
            if (j == 0) z = (float)t / (float)(L - 1);
            else { const int fi = (j - 1) & 15; const float freq = 1e-4f + (float)fi * ((15.0f - 1e-4f) / 15.0f);
                const float ang = ((float)(2.0 * 3.14159265358979323846 / L) * (float)t) * freq; z = (j <= 16) ? cosf(ang) : -sinf(ang); }
            zs[tl * 40 + j] = z; }
        __syncthreads();
        { const float* w1 = C.in[IN_W1] + (size_t)l * 33 * 64; float s = C.in[IN_B1][l * 64 + j];
            for (int i = 0; i < 33; ++i) s += zs[tl * 40 + i] * w1[i * 64 + j];
            h1s[tl * 64 + j] = sinf(s); }
        __syncthreads();
        { const float* w2 = C.in[IN_W2] + (size_t)l * 64 * 64; float s = C.in[IN_B2][l * 64 + j];
            for (int i = 0; i < 64; ++i) s += h1s[tl * 64 + i] * w2[i * 64 + j];
            bf16_t* dst = WSP(bf16_t, WS_HPAD) + ((size_t)l * 2304 + (isctx ? 2048 + t : t)) * 128;
            dst[j] = (bf16_t)f2bf(sinf(s)); dst[64 + j] = (bf16_t)0; }
        __syncthreads();
    }
    {
        const float* w3 = C.in[IN_W3]; bf16_t* w3t = WSP(bf16_t, WS_W3T);
        for (int i = C.bid * NTHR + C.tid; i < 4 * 64 * 2048; i += C.G * NTHR) { const int l = i >> 17, k = (i >> 11) & 63, col = i & 2047;
            w3t[((size_t)l * 2048 + col) * 128 + k] = (bf16_t)f2bf(w3[i]); w3t[((size_t)l * 2048 + col) * 128 + 64 + k] = (bf16_t)0; }
    }
    if (C.bid == C.G - 1) {
        const float* lb = C.in[IN_LB]; float* lower = WSP(float, WS_LOWER);
        for (int i = C.tid; i < 1024; i += NTHR) { const int d = i >> 9, c = i & 511; float v[4], mx = -3.4e38f, s = 0.f;
#pragma unroll
            for (int l = 0; l < 4; ++l) { v[l] = lb[(d * 4 + l) * 512 + c]; mx = fmaxf(mx, v[l]); }
#pragma unroll
            for (int l = 0; l < 4; ++l) { v[l] = expf(v[l] - mx); s += v[l]; }
            float cum = 0.f;
#pragma unroll
            for (int l = 0; l < 4; ++l) { if (l > 0) cum += v[l] / s; lower[(d * 4 + l) * 512 + c] = cum; } }
    }
}

__device__ __forceinline__ const float* xrow_src(const Ctx& C, int l, int row) {
    return l == 0 ? (row < NLAT ? C.in[IN_X] + (size_t)row * D : C.in[IN_CTX] + (size_t)(row - NLAT) * D) : WSP(const float, WS_XBUF) + (size_t)row * D;
}
__device__ __forceinline__ void transpose_item(const float* W, int K, int N, bf16_t* WT, LAS float* scr, int item, int lane) {
    const int nblk = N / 32, kb = item / nblk, nb = item % nblk, k0 = 64 * kb, n0 = 32 * nb;
#pragma unroll 8
    for (int i = 0; i < 32; ++i) { const int kk = 2 * i + (lane >> 5); scr[kk * 33 + (lane & 31)] = W[(size_t)(k0 + kk) * N + n0 + (lane & 31)]; }
    LDS_WAIT(); asm volatile("" ::: "memory");
    const int c = lane & 7;
#pragma unroll
    for (int j = 0; j < 4; ++j) { const int n = (lane >> 3) + 8 * j; const LAS float* s = scr + (8 * c) * 33 + n;
        u32x4 o; o.x = pk2(s[0 * 33], s[1 * 33]); o.y = pk2(s[2 * 33], s[3 * 33]); o.z = pk2(s[4 * 33], s[5 * 33]); o.w = pk2(s[6 * 33], s[7 * 33]);
        *(u32x4*)(WT + (size_t)(n0 + n) * K + k0 + 8 * c) = o; }
    LDS_WAIT(); asm volatile("" ::: "memory");
}
__device__ __forceinline__ void phase_l1(const Ctx& C, int l) {
    const int gw = C.bid * NWAVES + C.wave, NGW = C.G * NWAVES;
    const float* mods = WSP(const float, WS_MODS) + (size_t)l * 9 * 6144;
    bf16_t* an = WSP(bf16_t, WS_R1);
    f32x4 nv[4];
    if (!(C.dry & 2)) {
    if (gw < NTOK) { const float* src = xrow_src(C, l, gw);
#pragma unroll
        for (int j = 0; j < 4; ++j) nv[j] = *(const f32x4*)(src + C.lane * 4 + 256 * j); }
    for (int row = gw; row < NTOK; row += NGW) {
        const float* md = mods + bidx(row) * 6144;
        f32x4 v[4]; float ss = 0.f;
#pragma unroll
        for (int j = 0; j < 4; ++j) v[j] = nv[j];
        if (row + NGW < NTOK) { const float* src = xrow_src(C, l, row + NGW);
#pragma unroll
            for (int j = 0; j < 4; ++j) nv[j] = *(const f32x4*)(src + C.lane * 4 + 256 * j); }
#pragma unroll
        for (int j = 0; j < 4; ++j) ss += (v[j].x * v[j].x + v[j].y * v[j].y) + (v[j].z * v[j].z + v[j].w * v[j].w);
        ss = wave_sum(ss); const float rinv = 1.0f / sqrtf(ss * (1.0f / D) + EPS);
#pragma unroll
        for (int j = 0; j < 4; ++j) { const int k = C.lane * 4 + 256 * j; const f32x4 sh = *(const f32x4*)(md + k), sc = *(const f32x4*)(md + 1024 + k);
            const f32x4 o = v[j] * rinv * (sc + 1.0f) + sh; u32x2 w; w.x = pk2(o.x, o.y); w.y = pk2(o.z, o.w);
            *(u32x2*)(an + (size_t)row * D + k) = w; }
    }
    }
    if (!(C.dry & 4)) {
        LAS float* scr = (LAS float*)(C.lds + C.wave * 16384);
        constexpr int I_IN = 16 * 128, I_OUT = 16 * 32, I_E = 128;
        constexpr int NIT = I_IN + I_OUT + 3 * 16 * I_E;
        for (int it = gw; it < NIT; it += NGW) {
            int r = it;
            if (r < I_IN) { transpose_item(C.in[IN_WIN] + (size_t)l * D * DIN, D, DIN, WSP(bf16_t, WS_WIN), scr, r, C.lane); continue; } r -= I_IN;
            if (r < I_OUT) { transpose_item(C.in[IN_WOUT] + (size_t)l * D * D, D, D, WSP(bf16_t, WS_WOUT), scr, r, C.lane); continue; } r -= I_OUT;
            if (r < 16 * I_E) { const int e = r / I_E; transpose_item(C.in[IN_WG] + ((size_t)l * NE + e) * D * DE, D, DE, WSP(bf16_t, WS_WG) + (size_t)e * DE * D, scr, r % I_E, C.lane); continue; } r -= 16 * I_E;
            if (r < 16 * I_E) { const int e = r / I_E; transpose_item(C.in[IN_WU] + ((size_t)l * NE + e) * D * DE, D, DE, WSP(bf16_t, WS_WU) + (size_t)e * DE * D, scr, r % I_E, C.lane); continue; } r -= 16 * I_E;
            { const int e = r / I_E; transpose_item(C.in[IN_WD] + ((size_t)l * NE + e) * DE * D, DE, D, WSP(bf16_t, WS_WD) + (size_t)e * D * DE, scr, r % I_E, C.lane); }
        }
    }
    __syncthreads();
    {
        LAS f32x2* T = (LAS f32x2*)C.lds;
        const int team = C.tid >> 8, tt = C.tid & 255;
        LAS f32x2* X = (LAS f32x2*)(C.lds + 16384) + team * XPAD;
        LAS float* hbs = (LAS float*)(C.lds + 16384 + 2 * XPAD * 8) + team * 2048;
        LAS float* reds = (LAS float*)(C.lds + 16384 + 2 * XPAD * 8 + 16384 + 1024);
        build_twiddles(C, T);
        __syncthreads();
        const bf16_t* hfl = WSP(const bf16_t, WS_HF) + (size_t)l * 2048 * 2304;
        f32x2* kspec = WSP(f32x2, WS_KSPEC);
        if (!(C.dry & 8))
        for (int item = C.bid; item < 512; item += C.G) {
            const int idx = item * 2 + team, o = idx >> 9, c = idx & 511;
            const int colf = o * 1024 + c, colb = colf + 512;
            const bf16_t* hfp = hfl + (size_t)colf * 2304; const bf16_t* hbp = hfl + (size_t)colb * 2304;
            float hf[8], hb[8], s = 0.f;
#pragma unroll
            for (int j = 0; j < 8; ++j) { const int t = tt + 256 * j; hf[j] = bf2f(hfp[t]); hb[j] = bf2f(hbp[t]); s += fabsf(hf[j]) + fabsf(hb[j]); }
            s = wave_sum(s);
            if (C.lane == 0) reds[C.wave] = s;
            __syncthreads();
            const float tot = reds[team * 4] + reds[team * 4 + 1] + reds[team * 4 + 2] + reds[team * 4 + 3];
            const float inv = 1.0f / (tot * 4096.0f);
#pragma unroll
            for (int j = 0; j < 8; ++j) { hf[j] *= inv; hb[j] *= inv; hbs[tt + 256 * j] = hb[j]; }
            __syncthreads();
            f32x2 ve[8], vo[8];
#pragma unroll
            for (int j = 0; j < 8; ++j) { const int n = tt + 256 * j; const float kb = n > 0 ? hbs[2048 - n] : 0.f;
                ve[j] = (f32x2){hf[j] + kb, 0.f}; const float dd = hf[j] - kb; const f32x2 tw = T[n]; vo[j] = (f32x2){dd * tw.x, dd * tw.y}; }
            f32x2* kout = kspec + ((size_t)(o * 512 + c) * 2) * 2048;
            fft_fwd_store(ve, X, T, kout, tt);
            fft_fwd_store(vo, X, T, kout + 2048, tt);
        }
        if (l < DEPTH - 1 && !(C.dry & 16)) {
            f32x2* kspc = WSP(f32x2, WS_KSPC);
            for (int item = C.bid; item < 512; item += C.G) {
                const int idx = item * 2 + team, o = idx >> 9, c = idx & 511;
                const int colf = o * 1024 + c, colb = colf + 512;
                float af = bf2f(hfl[(size_t)colf * 2304 + 2048 + tt]), ab = bf2f(hfl[(size_t)colb * 2304 + 2048 + tt]);
                __syncthreads();
                const float s = wave_sum(fabsf(af) + fabsf(ab));
                if (C.lane == 0) reds[C.wave] = s;
                __syncthreads();
                const float tot = reds[team * 4] + reds[team * 4 + 1] + reds[team * 4 + 2] + reds[team * 4 + 3];
                const float inv = 1.0f / (tot * 2048.0f);
                af *= inv; ab *= inv; hbs[tt] = ab;
                __syncthreads();
                f32x2 vk[8];
#pragma unroll
                for (int j = 0; j < 8; ++j) vk[j] = (f32x2){0.f, 0.f};
                vk[0] = (f32x2){af, 0.f};
                vk[7] = (f32x2){tt > 0 ? hbs[256 - tt] : 0.f, 0.f};
                fft_fwd_store(vk, X, T, kspc + (size_t)(o * 512 + c) * 2048, tt);
            }
        }
    }
}

__device__ __forceinline__ float shortconv(const LAS bf16_t* raw, int t, int mask, int tmax, float w0, float w1, float w2, float bias) {
    const float pm = ((t & mask) != 0) ? bf2f(raw[t - 1]) : 0.f;
    const float pc = bf2f(raw[t]);
    const float pp = ((t & mask) != mask && t < tmax) ? bf2f(raw[t + 1]) : 0.f;
    return w0 * pm + w1 * pc + w2 * pp + bias;
}
constexpr int HY_CH = 4, HY_ITEMS = 4 * (512 / HY_CH);
__device__ __forceinline__ void hyena_lat(const Ctx& C, int l, int item) {
    const int bp = item & 3, cg = item >> 2, team = C.tid >> 8, tt = C.tid & 255;
    LAS f32x2* T = (LAS f32x2*)C.lds;
    LAS f32x2* X = (LAS f32x2*)(C.lds + 16384) + team * XPAD;
    LAS bf16_t* raw = (LAS bf16_t*)(C.lds + 16384 + 2 * XPAD * 8) + team * 4096;
    LAS bf16_t* outs = (LAS bf16_t*)(C.lds + 16384 + 2 * XPAD * 8 + 16384);
    const bf16_t* phyt = WSP(const bf16_t, WS_PHYT);
    const float* cw = C.in[IN_CONVW] + (size_t)l * 3 * NHY; const float* cb = C.in[IN_CONVB] + (size_t)l * NHY;
    const float* hyb = C.in[IN_HYBIAS] + (size_t)l * 2 * DH;
    const f32x2* kspec = WSP(const f32x2, WS_KSPEC);
    const int ba = 2 * bp;
    for (int round = 0; round < HY_CH / 2; ++round) {
        const int c = cg * HY_CH + round * 2 + team;
        f32x2 z[8], acc[8], v[8];
#pragma unroll 1
        for (int stage = 0; stage < 3; ++stage) {
            const int ch = stage * 512 + c;
            __syncthreads();
#pragma unroll
            for (int k = 0; k < 2; ++k) { const int q = tt + 256 * k, rr = q >> 8, cc = q & 255;
                *(LAS u32x4*)(raw + rr * 2048 + cc * 8) = *(const u32x4*)(phyt + (size_t)ch * NTOK + (size_t)(ba + rr) * 2048 + cc * 8); }
            __syncthreads();
            const float w0 = cw[ch], w1 = cw[NHY + ch], w2 = cw[2 * NHY + ch], bs = cb[ch];
            if (stage == 0) {
#pragma unroll
                for (int j = 0; j < 8; ++j) { const int t = tt + 256 * j; z[j] = (f32x2){shortconv(raw, t, 63, 4096, w0, w1, w2, bs), shortconv(raw + 2048, t, 63, 4096, w0, w1, w2, bs)}; }
            } else {
                const float dsk = hyb[(stage - 1) * DH + c];
#pragma unroll
                for (int j = 0; j < 8; ++j) { const int t = tt + 256 * j; const f32x2 cv = acc[j] + z[j] * dsk;
                    z[j] = (f32x2){shortconv(raw, t, 63, 4096, w0, w1, w2, bs) * cv.x, shortconv(raw + 2048, t, 63, 4096, w0, w1, w2, bs) * cv.y}; }
            }
            if (stage == 2) {
#pragma unroll
                for (int j = 0; j < 8; ++j) { const int t = tt + 256 * j; outs[(size_t)t * HY_CH + round * 2 + team] = (bf16_t)f2bf(z[j].x); outs[(size_t)(2048 + t) * HY_CH + round * 2 + team] = (bf16_t)f2bf(z[j].y); }
                break;
            }
            const f32x2* K = kspec + ((size_t)(stage * 512 + c) * 2) * 2048;
#pragma unroll
            for (int j = 0; j < 8; ++j) v[j] = z[j];
            fft_conv_half(v, X, T, K, tt);
#pragma unroll
            for (int j = 0; j < 8; ++j) acc[j] = v[j];
#pragma unroll
            for (int j = 0; j < 8; ++j) v[j] = cmul(z[j], T[tt + 256 * j]);
            fft_conv_half(v, X, T, K + 2048, tt);
#pragma unroll
            for (int j = 0; j < 8; ++j) acc[j] += cmulc(v[j], T[tt + 256 * j]);
        }
    }
    __syncthreads();
    bf16_t* Y = WSP(bf16_t, WS_R1);
    for (int i = C.tid; i < 4096; i += NTHR) { const int b = i >> 11, t = i & 2047;
        if (HY_CH == 8) *(u32x4*)(Y + ((size_t)(ba + b) * 2048 + t) * D + cg * 8) = *(const LAS u32x4*)(outs + (size_t)i * 8);
        else *(u32x2*)(Y + ((size_t)(ba + b) * 2048 + t) * D + cg * 4) = *(const LAS u32x2*)(outs + (size_t)i * 4); }
    __syncthreads();
}
__device__ __forceinline__ void hyena_ctx2(const Ctx& C, int l, int item) {
    const int team = C.tid >> 8, tt = C.tid & 255, c = item * 2 + team;
    LAS f32x2* T = (LAS f32x2*)C.lds;
    LAS f32x2* X = (LAS f32x2*)(C.lds + 16384) + team * XPAD;
    LAS bf16_t* raw = (LAS bf16_t*)(C.lds + 16384 + 2 * XPAD * 8) + team * 4096;
    const bf16_t* phyt = WSP(const bf16_t, WS_PHYT);
    const float* cw = C.in[IN_CONVW] + (size_t)l * 3 * NHY; const float* cb = C.in[IN_CONVB] + (size_t)l * NHY;
    const float* hyb = C.in[IN_HYBIAS] + (size_t)l * 2 * DH;
    const f32x2* kspc = WSP(const f32x2, WS_KSPC);
    bf16_t* Y = WSP(bf16_t, WS_R1);
    f32x2 z[8], v[8];
#pragma unroll
    for (int j = 0; j < 8; ++j) z[j] = (f32x2){0.f, 0.f};
#pragma unroll 1
    for (int stage = 0; stage < 3; ++stage) {
        const int ch = stage * 512 + c;
        __syncthreads();
        *(LAS u32x4*)(raw + tt * 8) = *(const u32x4*)(phyt + (size_t)ch * NTOK + NLAT + tt * 8);
        __syncthreads();
        const float w0 = cw[ch], w1 = cw[NHY + ch], w2 = cw[2 * NHY + ch], bs = cb[ch];
        const float dsk = stage > 0 ? hyb[(stage - 1) * DH + c] : 0.f;
#pragma unroll
        for (int p = 0; p < 4; ++p) {
            const float ua = shortconv(raw, (2 * p) * 256 + tt, 255, 4096, w0, w1, w2, bs), ub = shortconv(raw, (2 * p + 1) * 256 + tt, 255, 4096, w0, w1, w2, bs);
            if (stage == 0) z[2 * p] = (f32x2){ua, ub};
            else { const f32x2 cv = v[2 * p] + z[2 * p] * dsk; z[2 * p] = (f32x2){ua * cv.x, ub * cv.y}; }
        }
        if (stage == 2) {
#pragma unroll
            for (int p = 0; p < 4; ++p) { Y[(size_t)(NLAT + (2 * p) * 256 + tt) * D + c] = (bf16_t)f2bf(z[2 * p].x); Y[(size_t)(NLAT + (2 * p + 1) * 256 + tt) * D + c] = (bf16_t)f2bf(z[2 * p].y); }
            break;
        }
#pragma unroll
        for (int j = 0; j < 8; ++j) v[j] = z[j];
        fft_conv_half(v, X, T, kspc + (size_t)(stage * 512 + c) * 2048, tt);
    }
}

constexpr int HG_QT = 0, HG_QP = 17408, HG_KP = 34816, HG_ST = 52224, HG_VT = 87040, HG_KH = 105472, HG_P = 123904, HG_SUB = 133120, HG_D = 135168;
__device__ __forceinline__ void hgrn_mfma(const Ctx& C, int item) {
    const int dir = item & 1, h = (item >> 1) & 3, b = item >> 3;
    LAS unsigned char* L = C.lds;
    const int lane = C.lane, w = C.wave, r = lane & 15, quad = lane >> 4;
    const int I = w >> 1, col = (w & 1) * 64 + lane;
    const bf16_t* phg = WSP(const bf16_t, WS_PHG);
    bf16_t* odir = WSP(bf16_t, WS_ODIR) + (size_t)dir * NTOK * 512;
    LAS float* subtot = (LAS float*)(L + HG_SUB); LAS float* Dv = (LAS float*)(L + HG_D);
    __syncthreads();
    for (int i = C.tid; i < (128 * 272) / 16; i += NTHR) *(LAS u32x4*)(L + HG_ST + i * 16) = (u32x4){0u, 0u, 0u, 0u};
    for (int i = C.tid; i < (64 * 144) / 16; i += NTHR) *(LAS u32x4*)(L + HG_P + i * 16) = (u32x4){0u, 0u, 0u, 0u};
    f32x4 sacc[8];
#pragma unroll
    for (int t = 0; t < 8; ++t) sacc[t] = (f32x4){0.f, 0.f, 0.f, 0.f};
    unsigned short qr[16], kr[16], vr[16];
    const int rstep = dir ? -1 : 1;
    const size_t colq = (size_t)h * 128 + col, colk = 1536 + (size_t)dir * 512 + h * 128 + col, colv = 512 + (size_t)h * 128 + col;
    auto chunk_row0 = [&](int ch) -> int { return ch < 4 ? NLAT + b * 256 + (dir ? 255 - ch * 64 : ch * 64) : b * 2048 + (dir ? 2047 - (ch - 4) * 64 : (ch - 4) * 64); };
    { const int row0 = chunk_row0(0) + rstep * 16 * I;
#pragma unroll
      for (int i = 0; i < 16; ++i) { const bf16_t* p = phg + (size_t)(row0 + rstep * i) * NHG; qr[i] = p[colq]; kr[i] = p[colk]; vr[i] = p[colv]; } }
    __syncthreads();
#pragma unroll 1
    for (int ch = 0; ch < 36; ++ch) {
        float cum[16]; float cs = 0.f;
#pragma unroll
        for (int i = 0; i < 16; ++i) { cs += __logf(1.0f - bf2f(kr[i])); cum[i] = cs; }
        subtot[I * 128 + col] = cs;
        __syncthreads();
        const float s0 = subtot[col], s1 = subtot[128 + col], s2 = subtot[256 + col], s3 = subtot[384 + col];
        const float pre = (I > 0 ? s0 : 0.f) + (I > 1 ? s1 : 0.f) + (I > 2 ? s2 : 0.f), rho = s0 + s1, tot = (s0 + s1) + (s2 + s3);
        const float erho = __expf(rho), eend = __expf(tot - rho);
        unsigned khp[8], vtp[8];
#pragma unroll
        for (int i = 0; i < 16; ++i) {
            const float bi = pre + cum[i], e1 = __expf(bi - rho), e2 = __expf(rho - bi), qf = bf2f(qr[i]), kf = bf2f(kr[i]);
            const int srow = (16 * I + i) * 272 + col * 2;
            *(LAS bf16_t*)(L + HG_QP + srow) = (bf16_t)f2bf(qf * e1);
            *(LAS bf16_t*)(L + HG_QT + srow) = (bf16_t)f2bf(qf * e1 * erho);
            *(LAS bf16_t*)(L + HG_KP + srow) = (bf16_t)f2bf(kf * e2);
            const unsigned khb = f2bf(kf * e2 * eend);
            if (i & 1) { khp[i >> 1] |= khb << 16; vtp[i >> 1] |= (unsigned)vr[i] << 16; } else { khp[i >> 1] = khb; vtp[i >> 1] = (unsigned)vr[i]; }
        }
        *(LAS u32x4*)(L + HG_KH + col * 144 + I * 32) = (u32x4){khp[0], khp[1], khp[2], khp[3]};
        *(LAS u32x4*)(L + HG_KH + col * 144 + I * 32 + 16) = (u32x4){khp[4], khp[5], khp[6], khp[7]};
        *(LAS u32x4*)(L + HG_VT + col * 144 + I * 32) = (u32x4){vtp[0], vtp[1], vtp[2], vtp[3]};
        *(LAS u32x4*)(L + HG_VT + col * 144 + I * 32 + 16) = (u32x4){vtp[4], vtp[5], vtp[6], vtp[7]};
        if (I == 0) Dv[col] = __expf(tot);
        const int crow0 = chunk_row0(ch);
        if (ch + 1 < 36) { const int row0 = chunk_row0(ch + 1) + rstep * 16 * I;
#pragma unroll
            for (int i = 0; i < 16; ++i) { const bf16_t* p = phg + (size_t)(row0 + rstep * i) * NHG; qr[i] = p[colq]; kr[i] = p[colk]; vr[i] = p[colv]; } }
        __syncthreads();
#pragma unroll 1
        for (int blk = w; blk < 10; blk += 8) {
            const int I2 = blk < 1 ? 0 : (blk < 3 ? 1 : (blk < 6 ? 2 : 3)), J2 = blk - (I2 * (I2 + 1)) / 2;
            f32x4 pa = (f32x4){0.f, 0.f, 0.f, 0.f};
#pragma unroll
            for (int kk = 0; kk < 4; ++kk) {
                const bf16x8 a = *(const LAS bf16x8*)(L + HG_KP + (J2 * 16 + r) * 272 + (32 * kk + 8 * quad) * 2);
                const bf16x8 bq = *(const LAS bf16x8*)(L + HG_QP + (I2 * 16 + r) * 272 + (32 * kk + 8 * quad) * 2);
                pa = __builtin_amdgcn_mfma_f32_16x16x32_bf16(a, bq, pa, 0, 0, 0);
            }
            if (I2 == J2) {
#pragma unroll
                for (int rr = 0; rr < 4; ++rr) if (4 * quad + rr > r) pa[rr] = 0.f;
            }
            u32x2 pw; pw.x = pk2(pa[0], pa[1]); pw.y = pk2(pa[2], pa[3]);
            *(LAS u32x2*)(L + HG_P + (I2 * 16 + r) * 144 + (J2 * 16 + 4 * quad) * 2) = pw;
        }
        __syncthreads();
        {
            bf16x8 sfr[4];
#pragma unroll
            for (int kk = 0; kk < 4; ++kk) sfr[kk] = *(const LAS bf16x8*)(L + HG_ST + (16 * w + r) * 272 + (32 * kk + 8 * quad) * 2);
            const bf16x8 vf0 = *(const LAS bf16x8*)(L + HG_VT + (16 * w + r) * 144 + (8 * quad) * 2);
            const bf16x8 vf1 = *(const LAS bf16x8*)(L + HG_VT + (16 * w + r) * 144 + (32 + 8 * quad) * 2);
#pragma unroll
            for (int I3 = 0; I3 < 4; ++I3) {
                f32x4 oa = (f32x4){0.f, 0.f, 0.f, 0.f};
#pragma unroll
                for (int kk = 0; kk < 4; ++kk) {
                    const bf16x8 bq = *(const LAS bf16x8*)(L + HG_QT + (I3 * 16 + r) * 272 + (32 * kk + 8 * quad) * 2);
                    oa = __builtin_amdgcn_mfma_f32_16x16x32_bf16(sfr[kk], bq, oa, 0, 0, 0);
                }
                { const bf16x8 bp = *(const LAS bf16x8*)(L + HG_P + (I3 * 16 + r) * 144 + (8 * quad) * 2);
                  oa = __builtin_amdgcn_mfma_f32_16x16x32_bf16(vf0, bp, oa, 0, 0, 0); }
                if (I3 >= 2) { const bf16x8 bp = *(const LAS bf16x8*)(L + HG_P + (I3 * 16 + r) * 144 + (32 + 8 * quad) * 2);
                  oa = __builtin_amdgcn_mfma_f32_16x16x32_bf16(vf1, bp, oa, 0, 0, 0); }
                const int row = crow0 + rstep * (16 * I3 + r);
                u32x2 ow; ow.x = pk2(oa[0], oa[1]); ow.y = pk2(oa[2], oa[3]);
                *(u32x2*)(odir + (size_t)row * 512 + h * 128 + 16 * w + 4 * quad) = ow;
            }
#pragma unroll
            for (int t = 0; t < 8; ++t) {
                const f32x4 dd = *(const LAS f32x4*)(L + HG_D + (16 * t + 4 * quad) * 4);
                f32x4 sa = sacc[t] * dd;
                const bf16x8 a0 = *(const LAS bf16x8*)(L + HG_KH + (16 * t + r) * 144 + (8 * quad) * 2);
                const bf16x8 a1 = *(const LAS bf16x8*)(L + HG_KH + (16 * t + r) * 144 + (32 + 8 * quad) * 2);
                sa = __builtin_amdgcn_mfma_f32_16x16x32_bf16(a0, vf0, sa, 0, 0, 0);
                sa = __builtin_amdgcn_mfma_f32_16x16x32_bf16(a1, vf1, sa, 0, 0, 0);
                sacc[t] = sa;
                u32x2 sw; sw.x = pk2(sa[0], sa[1]); sw.y = pk2(sa[2], sa[3]);
                *(LAS u32x2*)(L + HG_ST + (16 * w + r) * 272 + (16 * t + 4 * quad) * 2) = sw;
            }
        }
    }
    __syncthreads();
}
__device__ __forceinline__ void phase_l3(const Ctx& C, int l) {
    if (C.bid < 64) hgrn_mfma(C, C.bid);
    build_twiddles(C, (LAS f32x2*)C.lds);
    __syncthreads();
    unsigned* qh = WSP(unsigned, WS_CTL) + CW_Q + l * 64 + C.rep * 16;
    volatile LAS int* lc = (volatile LAS int*)(C.lds + LDSCTL_OFF);
    const int nitems = HY_ITEMS + (l < DEPTH - 1 ? 256 : 0);
    for (;;) {
        if (C.tid == 0) lc[LC_Q] = (int)__hip_atomic_fetch_add(qh, 1u, __ATOMIC_RELAXED, __HIP_MEMORY_SCOPE_AGENT);
        __syncthreads();
        const int item = lc[LC_Q];
        __syncthreads();
        if (item >= nitems) break;
        if (item < HY_ITEMS) hyena_lat(C, l, item); else hyena_ctx2(C, l, item - HY_ITEMS);
    }
}
__device__ __forceinline__ void phase_l3b(const Ctx& C, int l) {
    const int gw = C.bid * NWAVES + C.wave, NGW = C.G * NWAVES;
    const bf16_t* od0 = WSP(const bf16_t, WS_ODIR); const bf16_t* od1 = od0 + (size_t)NTOK * 512;
    const bf16_t* phg = WSP(const bf16_t, WS_PHG); bf16_t* Y = WSP(bf16_t, WS_R1);
    const float* nw = C.in[IN_NORMW] + l * 128;
    const int nrows = (l < DEPTH - 1) ? NTOK : NLAT;
    for (int row = gw; row < nrows; row += NGW) {
        const int idx = C.lane * 8;
        const u32x4 a = *(const u32x4*)(od0 + (size_t)row * 512 + idx), b = *(const u32x4*)(od1 + (size_t)row * 512 + idx), g = *(const u32x4*)(phg + (size_t)row * NHG + 1024 + idx);
        float o[8] = {bflo(a.x) + bflo(b.x), bfhi(a.x) + bfhi(b.x), bflo(a.y) + bflo(b.y), bfhi(a.y) + bfhi(b.y), bflo(a.z) + bflo(b.z), bfhi(a.z) + bfhi(b.z), bflo(a.w) + bflo(b.w), bfhi(a.w) + bfhi(b.w)};
        const float gg[8] = {bflo(g.x), bfhi(g.x), bflo(g.y), bfhi(g.y), bflo(g.z), bfhi(g.z), bflo(g.w), bfhi(g.w)};
        float ss = 0.f;
#pragma unroll
        for (int i = 0; i < 8; ++i) ss += o[i] * o[i];
        ss = row16_sum(ss);
        const float rinv = 1.0f / sqrtf(ss * (1.0f / 128.0f) + EPS);
        float y[8];
#pragma unroll
        for (int i = 0; i < 8; ++i) y[i] = o[i] * rinv * nw[(idx + i) & 127] * siluf_(gg[i]);
        u32x4 w; w.x = pk2(y[0], y[1]); w.y = pk2(y[2], y[3]); w.z = pk2(y[4], y[5]); w.w = pk2(y[6], y[7]);
        *(u32x4*)(Y + (size_t)row * D + 512 + idx) = w;
    }
}

constexpr int RW_PITCH = 1028;
__device__ __forceinline__ void phase_l5a(const Ctx& C, int l) {
    LAS float* rwT = (LAS float*)C.lds;
    LAS int* lcnt = (LAS int*)(C.lds + 16 * RW_PITCH * 4);
    LAS float* wsc = (LAS float*)(C.lds + 16 * RW_PITCH * 4 + 128) + C.wave * 384;
    const float* rw = C.in[IN_RW];
    for (int i = C.tid; i < 16 * 1024; i += NTHR) { const int k = i >> 4, e = i & 15; rwT[e * RW_PITCH + k] = rw[i]; }
    if (C.tid < 32) lcnt[C.tid] = 0;
    __syncthreads();
    const int gw = C.bid * NWAVES + C.wave, NGW = C.G * NWAVES;
    const float* mods = WSP(const float, WS_MODS) + (size_t)l * 9 * 6144;
    const float* bias2 = WSP(const float, WS_BIAS2) + l * 9 * 16;
    const float* xb = WSP(const float, WS_XBUF);
    const float* rbias = C.in[IN_RB];
    unsigned* cnt = WSP(unsigned, WS_CTL) + CW_CNT + l * 32 * 64;
    int* tokinfo = WSP(int, WS_TOKINFO);
    const int ngroups = ((l < DEPTH - 1) ? NTOK : NLAT) / 16;
    const int li = C.lane & 15, kq = C.lane >> 4;
    for (int g = gw; g < ngroups; g += NGW) {
        const int row0 = g * 16, bb = bidx(row0);
        const float* xp = xb + (size_t)(row0 + li) * D + kq * 4;
        const float* scp = mods + bb * 6144 + 4096 + kq * 4;
        const LAS float* bp = rwT + li * RW_PITCH + kq * 4;
        f32x4 acc0 = (f32x4){0.f, 0.f, 0.f, 0.f}, acc1 = acc0, acc2 = acc0, acc3 = acc0; float ss = 0.f;
#pragma unroll 8
        for (int m = 0; m < 64; ++m) {
            const f32x4 xv = *(const f32x4*)(xp + 16 * m), sc = *(const f32x4*)(scp + 16 * m), bv = *(const LAS f32x4*)(bp + 16 * m);
            ss += (xv.x * xv.x + xv.y * xv.y) + (xv.z * xv.z + xv.w * xv.w);
            const f32x4 av = xv * (sc + 1.0f);
            acc0 = __builtin_amdgcn_mfma_f32_16x16x4f32(av.x, bv.x, acc0, 0, 0, 0);
            acc1 = __builtin_amdgcn_mfma_f32_16x16x4f32(av.y, bv.y, acc1, 0, 0, 0);
            acc2 = __builtin_amdgcn_mfma_f32_16x16x4f32(av.z, bv.z, acc2, 0, 0, 0);
            acc3 = __builtin_amdgcn_mfma_f32_16x16x4f32(av.w, bv.w, acc3, 0, 0, 0);
        }
        const f32x4 acc = (acc0 + acc1) + (acc2 + acc3);
        wsc[C.lane] = ss;
#pragma unroll
        for (int r = 0; r < 4; ++r) wsc[64 + (4 * kq + r) * 17 + li] = acc[r];
        LDS_WAIT(); asm volatile("" ::: "memory");
        if (C.lane < 16) {
            const int row = row0 + C.lane;
            const float sst = (wsc[C.lane] + wsc[16 + C.lane]) + (wsc[32 + C.lane] + wsc[48 + C.lane]);
            const float rinv = 1.0f / sqrtf(sst * (1.0f / D) + EPS);
            float lg[16];
#pragma unroll
            for (int e = 0; e < 16; ++e) lg[e] = rinv * wsc[64 + C.lane * 17 + e] + bias2[bb * 16 + e];
            float mx = lg[0];
#pragma unroll
            for (int e = 1; e < 16; ++e) mx = fmaxf(mx, lg[e]);
            float sc[16], se = 0.f;
#pragma unroll
            for (int e = 0; e < 16; ++e) { sc[e] = expf(lg[e] - mx); se += sc[e]; }
            float sel[16];
#pragma unroll
            for (int e = 0; e < 16; ++e) { sc[e] = sc[e] / se; sel[e] = sc[e] + rbias[e]; }
            float bestgs = -3.4e38f; int bg = 0; float bs[4], bsc[4];
#pragma unroll
            for (int gg = 0; gg < 4; ++gg) {
                float m1 = -3.4e38f, m2 = -3.4e38f;
#pragma unroll
                for (int i = 0; i < 4; ++i) { const float x = sel[4 * gg + i]; if (x > m1) { m2 = m1; m1 = x; } else if (x > m2) m2 = x; }
                const float gs = m1 + m2;
                if (gs > bestgs) { bestgs = gs; bg = gg;
#pragma unroll
                    for (int i = 0; i < 4; ++i) { bs[i] = sel[4 * gg + i]; bsc[i] = sc[4 * gg + i]; } }
            }
            int i0 = 0; float b0 = bs[0];
#pragma unroll
            for (int i = 1; i < 4; ++i) if (bs[i] > b0) { b0 = bs[i]; i0 = i; }
            int i1 = -1; float b1 = -3.4e38f;
#pragma unroll
            for (int i = 0; i < 4; ++i) if (i != i0 && bs[i] > b1) { b1 = bs[i]; i1 = i; }
            float w0 = 0.f, w1 = 0.f;
#pragma unroll
            for (int i = 0; i < 4; ++i) { if (i == i0) w0 = bsc[i]; if (i == i1) w1 = bsc[i]; }
            const float wn = w0 + w1; w0 /= wn; w1 /= wn;
            const int lo = i0 < i1 ? i0 : i1, hi = i0 < i1 ? i1 : i0;
            const float wlo = i0 < i1 ? w0 : w1, whi = i0 < i1 ? w1 : w0;
            const int bin = bg * 6 + (lo * (7 - lo)) / 2 + (hi - lo - 1);
            const int slot = __hip_atomic_fetch_add(lcnt + bin, 1, __ATOMIC_RELAXED, __HIP_MEMORY_SCOPE_WORKGROUP);
            *(int4*)(tokinfo + (size_t)row * 4) = make_int4(bin, slot, __float_as_int(wlo), __float_as_int(whi));
        }
        LDS_WAIT(); asm volatile("" ::: "memory");
    }
    __syncthreads();
    if (C.tid < NBIN && !C.dry) { const int n = lcnt[C.tid];
        WSP(int, WS_BLKBASE)[C.bid * 32 + C.tid] = n > 0 ? (int)__hip_atomic_fetch_add(cnt + C.tid * 64, (unsigned)n, __ATOMIC_RELAXED, __HIP_MEMORY_SCOPE_AGENT) : 0; }
}
__device__ __forceinline__ void phase_l5b(const Ctx& C, int l) {
    build_tiletab(C, l);
    const volatile LAS int* lc = (const volatile LAS int*)(C.lds + LDSCTL_OFF);
    const int gw = C.bid * NWAVES + C.wave, NGW = C.G * NWAVES;
    const float* mods = WSP(const float, WS_MODS) + (size_t)l * 9 * 6144;
    const float* xb = WSP(const float, WS_XBUF);
    const int* tokinfo = WSP(const int, WS_TOKINFO); const int* blkbase = WSP(const int, WS_BLKBASE);
    bf16_t* hs = WSP(bf16_t, WS_PHG); int* rowtok = WSP(int, WS_ROWTOK); float* roww = WSP(float, WS_ROWW);
    const int nrows = (l < DEPTH - 1) ? NTOK : NLAT;
    f32x4 nv[4]; int4 nti = make_int4(0, 0, 0, 0);
    if (gw < nrows) { nti = *(const int4*)(tokinfo + (size_t)gw * 4);
#pragma unroll
        for (int j = 0; j < 4; ++j) nv[j] = *(const f32x4*)(xb + (size_t)gw * D + C.lane * 4 + 256 * j); }
    for (int row = gw; row < nrows; row += NGW) {
        const int4 ti = nti;
        const int pos = lc[LC_OFFS + ti.x] + blkbase[(((row >> 4) % NGW) >> 3) * 32 + ti.x] + ti.y;
        const float* md = mods + bidx(row) * 6144;
        f32x4 v[4]; float ss = 0.f;
#pragma unroll
        for (int j = 0; j < 4; ++j) v[j] = nv[j];
        if (row + NGW < nrows) { nti = *(const int4*)(tokinfo + (size_t)(row + NGW) * 4);
#pragma unroll
            for (int j = 0; j < 4; ++j) nv[j] = *(const f32x4*)(xb + (size_t)(row + NGW) * D + C.lane * 4 + 256 * j); }
#pragma unroll
        for (int j = 0; j < 4; ++j) ss += (v[j].x * v[j].x + v[j].y * v[j].y) + (v[j].z * v[j].z + v[j].w * v[j].w);
        ss = wave_sum(ss); const float rinv = 1.0f / sqrtf(ss * (1.0f / D) + EPS);
#pragma unroll
        for (int j = 0; j < 4; ++j) { const int k = C.lane * 4 + 256 * j; const f32x4 sh = *(const f32x4*)(md + 3072 + k), sc = *(const f32x4*)(md + 4096 + k);
            const f32x4 o = v[j] * rinv * (sc + 1.0f) + sh; u32x2 w; w.x = pk2(o.x, o.y); w.y = pk2(o.z, o.w);
            *(u32x2*)(hs + (size_t)pos * D + k) = w; }
        if (C.lane == 0) { rowtok[pos] = row; roww[pos * 2] = __int_as_float(ti.z); roww[pos * 2 + 1] = __int_as_float(ti.w); }
    }
    if (C.bid < NBIN) { const int b = C.bid; const int start = lc[LC_OFFS + b], end = lc[LC_OFFS + b + 1];
        const int n = (int)__hip_atomic_load(WSP(unsigned, WS_CTL) + CW_CNT + (l * 32 + b) * 64, __ATOMIC_RELAXED, __HIP_MEMORY_SCOPE_AGENT);
        for (int p = start + n + C.tid; p < end; p += NTHR) { rowtok[p] = -1; roww[p * 2] = 0.f; roww[p * 2 + 1] = 0.f; } }
}

__device__ __forceinline__ void phase_final(const Ctx& C) {
    const int gw = C.bid * NWAVES + C.wave, NGW = C.G * NWAVES;
    const float* xb = WSP(const float, WS_XBUF); const float* fw = C.in[IN_FNW];
    f32x4 nv[4];
    if (gw < NLAT) {
#pragma unroll
        for (int j = 0; j < 4; ++j) nv[j] = *(const f32x4*)(xb + (size_t)gw * D + C.lane * 4 + 256 * j); }
    for (int row = gw; row < NLAT; row += NGW) {
        f32x4 v[4]; float ss = 0.f;
#pragma unroll
        for (int j = 0; j < 4; ++j) v[j] = nv[j];
        if (row + NGW < NLAT) {
#pragma unroll
            for (int j = 0; j < 4; ++j) nv[j] = *(const f32x4*)(xb + (size_t)(row + NGW) * D + C.lane * 4 + 256 * j); }
#pragma unroll
        for (int j = 0; j < 4; ++j) ss += (v[j].x * v[j].x + v[j].y * v[j].y) + (v[j].z * v[j].z + v[j].w * v[j].w);
        ss = wave_sum(ss); const float rinv = 1.0f / sqrtf(ss * (1.0f / D) + EPS);
#pragma unroll
        for (int j = 0; j < 4; ++j) { const int k = C.lane * 4 + 256 * j; const f32x4 w = *(const f32x4*)(fw + k);
            *(f32x4*)(C.out + (size_t)row * D + k) = v[j] * rinv * w; }
    }
}

constexpr int PH_PER_LAYER = 9, N_PHASES = 2 + DEPTH * PH_PER_LAYER + 1;
__global__ void __launch_bounds__(NTHR, 2) trunk_fwd(Args args) {
    extern __shared__ __attribute__((aligned(16))) unsigned char lds[];
    Ctx C; C.in = (const CAS fptr_t*)__builtin_amdgcn_kernarg_segment_ptr(); C.out = args.out; C.ws = args.ws; C.lds = (LAS unsigned char*)lds;
    C.tid = threadIdx.x; C.lane = C.tid & 63; C.wave = __builtin_amdgcn_readfirstlane(C.tid >> 6); C.G = gridDim.x; C.bid = blockIdx.x; C.rep = args.rep; C.dry = (args.rep + 1 < (args.pad & 255)) ? (args.pad >> 8) : 0;
    LAS unsigned char* ldsl0 = (LAS unsigned char*)lds;
    if (C.tid < 64) ((LAS unsigned*)(ldsl0 + LDSCTL_OFF))[C.tid] = 0u;
    __syncthreads();
    const int lo = args.ph_lo, hi = args.ph_hi;
    XcdBarrier bar; bar.bar = WSP(unsigned, WS_CTL) + CW_BAR; bar.x = 0; bar.st = (volatile LAS unsigned*)(ldsl0 + LDSCTL_OFF + LC_BAR);
    if (hi - lo > 1) bar = xcd_barrier_post(WSP(unsigned, WS_CTL) + CW_BAR, (volatile LAS unsigned*)(ldsl0 + LDSCTL_OFF + LC_BAR));
#define IN(k) (lo <= (k) && (k) < hi)
#define SEAM(k) do { if (IN(k) && IN((k) + 1)) xcd_barrier(bar); } while (0)
#ifndef EN
#define EN 0xFFFF
#endif
    if ((EN & 1) && IN(0)) { phase0(C); SEAM(0); }
    if ((EN & 1) && IN(1)) {
        if (C.bid == C.G - 1) {
            const float* md = WSP(const float, WS_MODS); const float* rw = C.in[IN_RW]; float* b2 = WSP(float, WS_BIAS2);
            for (int o = C.tid; o < 4 * 9 * 16; o += NTHR) { const int lr = o >> 4, e = o & 15; const float* sh = md + (size_t)lr * 6144 + 3072; float sacc = 0.f;
                for (int k = 0; k < 1024; ++k) sacc += sh[k] * rw[k * 16 + e];
                b2[o] = sacc; }
        }
        SchedFilt S{C.G, C.bid};
        EpiFilt E{WSP(bf16_t, WS_HF), C.in[IN_B3]};
        pg8::gemm_phase<false>(ldsl0, S, E, (const char*)WSP(bf16_t, WS_W3T), (const char*)WSP(bf16_t, WS_HPAD), 128, 128, 128u * 128u * 2u, 128u * 128u * 2u, 2);
        SEAM(1);
    }
    const Ctx C0 = C;
#pragma unroll 1
    for (int l = 0; l < DEPTH; ++l) {
        const int p0 = 2 + l * PH_PER_LAYER;
        Ctx C = C0; { int t_ = C0.wave * 64 + lane_id_opaque(); asm volatile("" : "+v"(t_)); C.tid = t_; C.lane = t_ & 63; C.wave = __builtin_amdgcn_readfirstlane(t_ >> 6);
                      int b_ = C0.bid; asm volatile("" : "+s"(b_)); C.bid = b_; int g_ = C0.G; asm volatile("" : "+s"(g_)); C.G = g_; unsigned char* w_ = C0.ws; asm volatile("" : "+s"(w_)); C.ws = w_;
                      const CAS fptr_t* i_ = C0.in; asm volatile("" : "+s"(i_)); C.in = i_;
                      LAS unsigned char* l_ = C0.lds; asm volatile("" : "+s"(l_)); C.lds = l_; }
        LAS unsigned char* const ldsl = C.lds;
        const float* modl = WSP(const float, WS_MODS) + (size_t)l * 9 * 6144;
        if ((EN & 2) && IN(p0 + 0)) { phase_l1(C, l); SEAM(p0 + 0); }
        if ((EN & 4) && IN(p0 + 1)) {
            { pg8::SchedDense S; S.init(NTOK / 256, NHG / 256, C.G, C.bid, D, D);
              EpiHG E{WSP(bf16_t, WS_PHG), WSP(const float, WS_LOWER) + l * 512};
              pg8::gemm_phase<false>(ldsl, S, E, (const char*)WSP(bf16_t, WS_R1), (const char*)(WSP(bf16_t, WS_WIN) + (size_t)NHY * D), D, D, 128u * D * 2u, 128u * D * 2u, D / 64); }
            { pg8::SchedDense S; S.init(NHY / 256, NTOK / 256, C.G, C.bid, D, D);
              EpiHY E{WSP(bf16_t, WS_PHYT)};
              pg8::gemm_phase<false>(ldsl, S, E, (const char*)WSP(bf16_t, WS_WIN), (const char*)WSP(bf16_t, WS_R1), D, D, 128u * D * 2u, 128u * D * 2u, D / 64); }
            SEAM(p0 + 1);
        }
        if ((EN & 8) && IN(p0 + 2)) { phase_l3(C, l); SEAM(p0 + 2); }
        if ((EN & 16) && IN(p0 + 3)) { phase_l3b(C, l); SEAM(p0 + 3); }
        if ((EN & 32) && IN(p0 + 4)) {
            pg8::SchedDense S; S.init(NTOK / 256, D / 256, C.G, C.bid, D, D);
            EpiOut E{C.in[IN_X], C.in[IN_CTX], WSP(float, WS_XBUF), modl, l == 0 ? 1 : 0, C.dry};
            pg8::gemm_phase<false>(ldsl, S, E, (const char*)WSP(bf16_t, WS_R1), (const char*)WSP(bf16_t, WS_WOUT), D, D, 128u * D * 2u, 128u * D * 2u, D / 64);
            SEAM(p0 + 4);
        }
        if ((EN & 64) && IN(p0 + 5)) { phase_l5a(C, l); SEAM(p0 + 5); }
        if ((EN & 128) && IN(p0 + 6)) { phase_l5b(C, l); SEAM(p0 + 6); }
        if ((EN & 256) && IN(p0 + 7)) {
            build_tiletab(C, l);
            const volatile LAS int* lc = (const volatile LAS int*)(ldsl + LDSCTL_OFF);
            SchedUp S{lc[LC_T], C.G, C.bid, lc + LC_TILEBIN};
            EpiAct E{WSP(bf16_t, WS_R1), WSP(const float, WS_ROWW)};
            pg8::gemm_phase<false>(ldsl, S, E, (const char*)WSP(bf16_t, WS_PHG), (const char*)WSP(bf16_t, WS_WG), D, D, 128u * D * 2u, (unsigned)(WS_WU - WS_WG), D / 64);
            SEAM(p0 + 7);
        }
        if ((EN & 512) && IN(p0 + 8)) {
            build_tiletab(C, l);
            const volatile LAS int* lc = (const volatile LAS int*)(ldsl + LDSCTL_OFF);
            SchedDown S{lc[LC_T], C.G, C.bid, lc + LC_TILEBIN};
            EpiDown E{WSP(float, WS_XBUF), WSP(const int, WS_ROWTOK), modl, C.dry};
            pg8::gemm_phase<true>(ldsl, S, E, (const char*)WSP(bf16_t, WS_R1), (const char*)WSP(bf16_t, WS_WD), 512, 256, 128u * 512u * 2u, 128u * 256u * 2u, 4);
            SEAM(p0 + 8);
        }
    }
    if ((EN & 1024) && IN(N_PHASES - 1)) { Ctx CF = C0; CF.tid = C0.wave * 64 + lane_id_opaque(); CF.lane = CF.tid & 63; phase_final(CF); }
#undef IN
#undef SEAM
}

extern "C" void kernel_launch(void* const* d_in, const int* in_sizes, int n_in, void* d_out, int out_size, void* d_ws, size_t ws_size, hipStream_t stream) {
    static int grid = 0;
    if (grid == 0) {
        if (n_in != N_IN || in_sizes[0] != NLAT * D || out_size != NLAT * D || ws_size < WS_END) { fprintf(stderr, "kernel_launch: unexpected shapes / workspace (%d inputs, ws %zu < %zu)\n", n_in, ws_size, (size_t)WS_END); grid = -1; return; }
        int dev = 0, cus = 0, per_cu = 0;
        if (hipGetDevice(&dev) != hipSuccess || hipDeviceGetAttribute(&cus, hipDeviceAttributeMultiprocessorCount, dev) != hipSuccess) { grid = -1; return; }
        if (hipFuncSetAttribute((const void*)trunk_fwd, hipFuncAttributeMaxDynamicSharedMemorySize, LDS_BYTES) != hipSuccess) { fprintf(stderr, "kernel_launch: hipFuncSetAttribute failed\n"); grid = -1; return; }
        if (hipOccupancyMaxActiveBlocksPerMultiprocessor(&per_cu, (const void*)trunk_fwd, NTHR, LDS_BYTES) != hipSuccess || per_cu < 1) { fprintf(stderr, "kernel_launch: occupancy query says %d\n", per_cu); }
        (void)hipGetLastError();
        grid = cus;
    }
    if (grid < 0) return;
    (void)hipMemsetAsync((char*)d_ws + WS_CTL, 0, CTL_ZERO_BYTES, stream);
    Args a{};
    for (int i = 0; i < N_IN; ++i) a.in[i] = (const float*)d_in[i];
    a.out = (float*)d_out; a.ws = (unsigned char*)d_ws;
#if MK_PER_PHASE
    for (int p = 0; p < N_PHASES; ++p) { a.ph_lo = p; a.ph_hi = p + 1; const int kind = p == 0 ? 0 : (p == 1 ? 11 : (p == N_PHASES - 1 ? 10 : 1 + (p - 2) % PH_PER_LAYER));
        const int nrep = ((PROBE_HOST >> kind) & 1) ? 2 : 1; a.pad = nrep | (PROBE_SKIP << 8);
        for (int rep = 0; rep < nrep; ++rep) { a.rep = rep; hipLaunchKernelGGL(trunk_fwd, dim3(grid), dim3(NTHR), LDS_BYTES, stream, a); } }
#else
    a.ph_lo = 0; a.ph_hi = N_PHASES; a.rep = 0; a.pad = 1;
    hipLaunchKernelGGL(trunk_fwd, dim3(grid), dim3(NTHR), LDS_BYTES, stream, a);
#endif
}
```

```cpp
#include <hip/hip_runtime.h>
#include <cstdio>
#include <cstdint>

#ifndef PROBE_HOST
#define PROBE_HOST 0
#endif
#ifndef PROBE_SKIP
#define PROBE_SKIP 1
#endif
#ifndef MK_PER_PHASE
#define MK_PER_PHASE 0
#endif

#define LAS __attribute__((address_space(3)))
typedef unsigned short bf16_t;
typedef short bf16x8 __attribute__((ext_vector_type(8)));
typedef float f32x4 __attribute__((ext_vector_type(4)));
typedef float f32x2 __attribute__((ext_vector_type(2)));
typedef unsigned u32x4 __attribute__((ext_vector_type(4)));
typedef unsigned u32x2 __attribute__((ext_vector_type(2)));

constexpr int NB = 8, SEQ = 2048, D = 1024, DEPTH = 4, CTXL = 256;
constexpr int NLAT = NB * SEQ, NCTX = NB * CTXL, NTOK = NLAT + NCTX;
constexpr int DH = 512, NHY = 1536, NHG = 2560, DIN = 4096;
constexpr int NE = 16, DE = 256, NBIN = 24, SROWS = 24576;
constexpr float EPS = 1e-6f;
constexpr int NTHR = 512, NWAVES = 8;
enum { IN_X = 0, IN_C, IN_CTX, IN_CCTX, IN_WMOD, IN_BMOD, IN_WIN, IN_WOUT, IN_CONVW, IN_CONVB, IN_W1, IN_B1, IN_W2, IN_B2, IN_W3, IN_B3,
       IN_HYBIAS, IN_LB, IN_NORMW, IN_RW, IN_RB, IN_WG, IN_WU, IN_WD, IN_FNW, N_IN };

constexpr size_t MiB = 1u << 20;
constexpr size_t WS_CTL = 0, CTL_ZERO_BYTES = 1 * MiB;
constexpr size_t WS_MODS = 1 * MiB;
constexpr size_t WS_LOWER = 2 * MiB;
constexpr size_t WS_BIAS2 = 2 * MiB + 64 * 1024;
constexpr size_t WS_HPAD = 3 * MiB;
constexpr size_t WS_TOKINFO = 6 * MiB;
constexpr size_t WS_BLKBASE = 6 * MiB + 320 * 1024;
constexpr size_t WS_ROWTOK = 6 * MiB + 512 * 1024;
constexpr size_t WS_ROWW = 7 * MiB;
constexpr size_t WS_WIN = 8 * MiB;
constexpr size_t WS_WOUT = 16 * MiB;
constexpr size_t WS_WG = 18 * MiB;
constexpr size_t WS_WU = 26 * MiB;
constexpr size_t WS_WD = 34 * MiB;
constexpr size_t WS_KSPEC = 42 * MiB;
constexpr size_t WS_XBUF = 74 * MiB;
constexpr size_t WS_R1 = 146 * MiB;
constexpr size_t WS_PHG = 182 * MiB;
constexpr size_t WS_PHYT = 272 * MiB;
constexpr size_t WS_ODIR = 326 * MiB;
constexpr size_t WS_KSPC = 362 * MiB;
constexpr size_t WS_W3T = 378 * MiB;
constexpr size_t WS_HF = 380 * MiB;
constexpr size_t WS_END = 416 * MiB;
constexpr int CW_BAR = 4096;
constexpr int CW_CNT = 16384;
constexpr int CW_Q = 32768;

constexpr int LDS_BYTES = 147456;
constexpr int LDSCTL_OFF = 143 * 1024;
constexpr int LC_BAR = 0;
constexpr int LC_T = 8;
constexpr int LC_Q = 9;
constexpr int LC_OFFS = 16;
constexpr int LC_TILEBIN = 48;

__device__ __forceinline__ unsigned f2bf(float f) { unsigned u = __builtin_bit_cast(unsigned, f); return (u + 0x7fffu + ((u >> 16) & 1u)) >> 16; }
__device__ __forceinline__ unsigned pk2(float lo, float hi) { return f2bf(lo) | (f2bf(hi) << 16); }
__device__ __forceinline__ float bf2f(unsigned b) { return __builtin_bit_cast(float, (b & 0xffffu) << 16); }
__device__ __forceinline__ float bflo(unsigned w) { return __builtin_bit_cast(float, w << 16); }
__device__ __forceinline__ float bfhi(unsigned w) { return __builtin_bit_cast(float, w & 0xffff0000u); }
__device__ __forceinline__ float sigmoidf_(float x) { return 1.0f / (1.0f + __expf(-x)); }
__device__ __forceinline__ float siluf_(float x) { return x / (1.0f + __expf(-x)); }
#define DPP_ADD(v, ctrl, rmask) v += __builtin_bit_cast(float, __builtin_amdgcn_update_dpp(0, __builtin_bit_cast(int, v), ctrl, rmask, 0xF, false))
__device__ __forceinline__ float row16_sum(float v) {
    DPP_ADD(v, 0xB1, 0xF);
    DPP_ADD(v, 0x4E, 0xF);
    DPP_ADD(v, 0x141, 0xF);
    DPP_ADD(v, 0x140, 0xF);
    return v;
}
__device__ __forceinline__ float wave_sum(float v) {
    v = row16_sum(v);
    DPP_ADD(v, 0x142, 0xA);
    DPP_ADD(v, 0x143, 0xC);
    return __builtin_bit_cast(float, __builtin_amdgcn_readlane(__builtin_bit_cast(int, v), 63));
}
__device__ __forceinline__ int lane_id_opaque() { int x; asm volatile("v_mbcnt_lo_u32_b32 %0, -1, 0\n\tv_mbcnt_hi_u32_b32 %0, -1, %0" : "=v"(x)); return x; }
__device__ __forceinline__ int bidx(int row) { return row < NLAT ? (row >> 11) : 8; }
#define LDS_WAIT() asm volatile("s_waitcnt lgkmcnt(0)" ::: "memory")

#define XB_TMO      128
#define XB_XCNT(j)  (256  + 64 * (j))
#define XB_XSUB(j)  (1280 + 64 * (j))
#define XB_XGEN(j)  (2304 + 64 * (j))
#define XB_TOP      3328
#define XB_TOPGEN   3392
#define XCD_BAR_WORDS 3456
#define XB_SPIN_CAP (1u << 18)
__device__ __forceinline__ unsigned xb_ld(unsigned* p)              { return __hip_atomic_load(p, __ATOMIC_RELAXED, __HIP_MEMORY_SCOPE_AGENT); }
__device__ __forceinline__ unsigned xb_add(unsigned* p, unsigned v) { return __hip_atomic_fetch_add(p, v, __ATOMIC_RELAXED, __HIP_MEMORY_SCOPE_AGENT); }
__device__ __forceinline__ unsigned xb_xcc_id() { return (unsigned)__builtin_amdgcn_s_getreg((3 << 11) | 20) & 0xFu; }
#define XB_SPIN(cond, bar) do { unsigned _sp = 0; while (cond) { __builtin_amdgcn_s_sleep(1); \
    if ((++_sp & 255u) == 0u) { if (xb_ld(&(bar)[XB_TMO])) break; if (_sp > XB_SPIN_CAP) { atomicAdd(&(bar)[XB_TMO], 1u); break; } } } } while (0)
struct XcdBarrier { unsigned* bar; unsigned x; volatile LAS unsigned* st; };
__device__ __forceinline__ XcdBarrier xcd_barrier_post(unsigned* bar, volatile LAS unsigned* st) {
    XcdBarrier b; b.bar = bar; b.x = xb_xcc_id(); b.st = st;
    if (threadIdx.x == 0) (void)xb_add(&bar[XB_XCNT(b.x)], 1u);
    return b;
}
__device__ __forceinline__ void xcd_barrier_complete(unsigned* bar, unsigned x, unsigned& nloc, unsigned& nx) {
    const unsigned G = gridDim.x * gridDim.y * gridDim.z;
    unsigned sum, cnt, mine, sp = 0u;
    for (;;) {
        sum = 0u; cnt = 0u; mine = 0u;
#pragma unroll
        for (unsigned j = 0; j < 16; ++j) { const unsigned c = xb_ld(&bar[XB_XCNT(j)]); sum += c; cnt += (c > 0u) ? 1u : 0u; mine = (j == x) ? c : mine; }
        if (sum == G) break;
        __builtin_amdgcn_s_sleep(1);
        if ((++sp & 255u) == 0u) { if (xb_ld(&bar[XB_TMO])) break; if (sp > XB_SPIN_CAP) { atomicAdd(&bar[XB_TMO], 1u); break; } }
    }
    nloc = mine > 0u ? mine : 1u; nx = cnt > 0u ? cnt : 1u;
}
__device__ __forceinline__ void xcd_barrier(const XcdBarrier& b) {
    asm volatile("s_waitcnt vmcnt(0)" ::: "memory");
    __syncthreads();
    if (threadIdx.x == 0) {
        unsigned* bar = b.bar; unsigned bx = b.x;
        asm volatile("" : "+s"(bar), "+s"(bx));
        __builtin_amdgcn_s_waitcnt(0);
        unsigned nloc = b.st[0], nx = b.st[1];
        if (nloc == 0u) { xcd_barrier_complete(bar, bx, nloc, nx); b.st[0] = nloc; b.st[1] = nx; }
        const unsigned old = xb_add(&bar[XB_XSUB(bx)], 1u);
        const unsigned gen = old / nloc;
        if (old + 1u == (gen + 1u) * nloc) {
            __builtin_amdgcn_fence(__ATOMIC_RELEASE, "agent");
            asm volatile("s_waitcnt vmcnt(0)" ::: "memory");
            const unsigned og = xb_add(&bar[XB_TOP], 1u);
            const unsigned tg = og / nx;
            if (og + 1u == (tg + 1u) * nx) xb_add(&bar[XB_TOPGEN], 1u);
            else XB_SPIN(xb_ld(&bar[XB_TOPGEN]) == tg, bar);
            __builtin_amdgcn_fence(__ATOMIC_ACQUIRE, "agent");
            xb_add(&bar[XB_XGEN(bx)], 1u);
            asm volatile("s_waitcnt vmcnt(0)" ::: "memory");
        } else {
            XB_SPIN(xb_ld(&bar[XB_XGEN(bx)]) == gen, bar);
            __builtin_amdgcn_fence(__ATOMIC_ACQUIRE, "agent");
            asm volatile("s_waitcnt vmcnt(0)" ::: "memory");
        }
    }
    __syncthreads();
}

namespace pg8 {
constexpr int BM = 256, BK = 64, HALF = 128, HTB = HALF * BK * 2, STAGE_BYTES = 8 * HTB, NXCD = 8, WGM = 8;
__host__ __device__ __forceinline__ int lds_byte(int r, int c) { const int st = (r >> 4) * 2 + (c >> 5), rr = r & 15, cc = c & 31, ob = rr * 64 + cc * 2; return st * 1024 + (ob ^ (((ob >> 9) & 1) << 5)); }
__host__ __device__ __forceinline__ void stage_rc(int b, int& R, int& C) { const int st = b / 1024, sb = b % 1024, swz = sb ^ (((sb >> 9) & 1) << 5); R = (st >> 1) * 16 + swz / 64; C = (st & 1) * 32 + (swz % 64) / 2; }
__host__ __device__ __forceinline__ int perm32(int rho) { const int n = rho >> 4, i = rho & 15; return 8 * (i >> 2) + 4 * n + (i & 3); }

struct GUnit { unsigned a, b; int last, i0, i1; };

template <bool SUB, class Epi, class Sched>
__device__ __forceinline__ void gemm_phase(LAS unsigned char* lds, const Sched& S, const Epi& E, const char* Abase, const char* Bbase, const int lda, const int ldb, const unsigned ahalf, const unsigned bhalf, const int nt) {
    int tid_ = threadIdx.x; asm volatile("" : "+v"(tid_));
    const int tid = tid_, wid = __builtin_amdgcn_readfirstlane(tid >> 6), lane = tid & 63, wr = wid >> 2, wc = wid & 3, fr = lane & 15, fq = lane >> 4;
    unsigned voffA[2], voffB[2];
#pragma unroll
    for (int i = 0; i < 2; ++i) { int R, C; stage_rc(tid * 16 + i * 8192, R, C); const int Rb = Epi::PERM ? ((R & ~31) + perm32(R & 31)) : R;
        voffA[i] = (unsigned)(R * lda + C) * 2u; voffB[i] = (unsigned)(Rb * ldb + C) * 2u; }
    constexpr unsigned kstep = BK * 2;
    const unsigned ldsw = (unsigned)wid * 1024u;
    const int aoff = lds_byte(wr * 64 + fr, fq * 8), boff = lds_byte(wc * 32 + fr, fq * 8);
#define PG8_SA(b, h) (((b) * 2 + (h)) * HTB)
#define PG8_SB(b, h) ((4 + (b) * 2 + (h)) * HTB)
#define PG8_STAGE(bufoff, gbase, voff) do { _Pragma("unroll") for (int _i = 0; _i < 2; ++_i) \
        __builtin_amdgcn_global_load_lds((const unsigned*)((const char*)(gbase) + (voff)[_i]), (LAS unsigned*)(lds + (bufoff) + ldsw + _i * 8192), 16, 0, 0); } while (0)
#define PG8_LDA(dst, b, h) do { _Pragma("unroll") for (int m = 0; m < 4; ++m) _Pragma("unroll") for (int k = 0; k < 2; ++k) dst[m][k] = *(const LAS bf16x8*)(lds + PG8_SA(b, h) + aoff + m * 2048 + k * 1024); } while (0)
#define PG8_LDB(dst, b, h) do { _Pragma("unroll") for (int n = 0; n < 2; ++n) _Pragma("unroll") for (int k = 0; k < 2; ++k) dst[n][k] = *(const LAS bf16x8*)(lds + PG8_SB(b, h) + boff + n * 2048 + k * 1024); } while (0)
#define PG8_MMA(ai, bj, At, Bt) do { __builtin_amdgcn_s_setprio(1); _Pragma("unroll") for (int m = 0; m < 4; ++m) _Pragma("unroll") for (int n = 0; n < 2; ++n) _Pragma("unroll") for (int k = 0; k < 2; ++k) \
        acc[ai][bj][m][n] = __builtin_amdgcn_mfma_f32_16x16x32_bf16(Bt[n][k], At[m][k], acc[ai][bj][m][n], 0, 0, 0); __builtin_amdgcn_s_setprio(0); } while (0)
#define PG8_WAIT_V(n) asm volatile("s_waitcnt vmcnt(" #n ")" ::: "memory")
#define PG8_WAIT_L(n) asm volatile("s_waitcnt lgkmcnt(" #n ")" ::: "memory")
#define PG8_BAR __builtin_amdgcn_s_barrier()
#define PG8_SCHED __builtin_amdgcn_sched_barrier(0)
    GUnit cur, nxt; int ui = 0;
    if (!S.next(0, cur)) return;
    f32x4 acc[2][2][4][2];
#pragma unroll
    for (int a = 0; a < 2; ++a)
#pragma unroll
        for (int b = 0; b < 2; ++b)
#pragma unroll
            for (int m = 0; m < 4; ++m)
#pragma unroll
                for (int n = 0; n < 2; ++n) acc[a][b][m][n] = (f32x4){0.f, 0.f, 0.f, 0.f};
    bf16x8 At[4][2], B0[2][2], B1[2][2];
    { const char* cA = Abase + cur.a; const char* cB = Bbase + cur.b;
      PG8_STAGE(PG8_SB(0, 0), cB, voffB); PG8_STAGE(PG8_SB(0, 1), cB + bhalf, voffB); PG8_STAGE(PG8_SA(0, 0), cA, voffA); PG8_STAGE(PG8_SA(0, 1), cA + ahalf, voffA);
      if (wr == 1) PG8_BAR;
      PG8_WAIT_V(2); PG8_BAR;
      PG8_STAGE(PG8_SB(1, 0), cB + kstep, voffB); PG8_STAGE(PG8_SA(1, 0), cA + kstep, voffA); PG8_STAGE(PG8_SB(1, 1), cB + bhalf + kstep, voffB);
      PG8_WAIT_V(6); PG8_BAR; }
    for (;;) {
        const bool has_next = S.next(ui + 1, nxt);
        const char* cA = Abase + cur.a; const char* cB = Bbase + cur.b;
        const char* nA = Abase + (has_next ? nxt.a : cur.a); const char* nB = Bbase + (has_next ? nxt.b : cur.b);
        for (int t = 0; t < nt; t += 2) {
            const bool last = (t == nt - 2);
            const char* a1 = cA + (unsigned)(t + 1) * kstep;
            const char* a2 = last ? nA : cA + (unsigned)(t + 2) * kstep; const char* b2 = last ? nB : cB + (unsigned)(t + 2) * kstep;
            const char* a3 = a2 + kstep; const char* b3 = b2 + kstep;
            PG8_LDB(B0, 0, 0); PG8_LDB(B1, 0, 1); PG8_SCHED; PG8_LDA(At, 0, 0); PG8_STAGE(PG8_SA(1, 1), a1 + ahalf, voffA);
            PG8_WAIT_V(8); PG8_WAIT_L(0); PG8_BAR; PG8_MMA(0, 0, At, B0); PG8_MMA(0, 1, At, B1); PG8_BAR; PG8_SCHED;
            PG8_LDA(At, 0, 1); PG8_STAGE(PG8_SB(0, 0), b2, voffB); PG8_STAGE(PG8_SB(0, 1), b2 + bhalf, voffB); PG8_STAGE(PG8_SA(0, 0), a2, voffA);
            PG8_WAIT_V(8); PG8_WAIT_L(0); PG8_BAR; PG8_MMA(1, 0, At, B0); PG8_MMA(1, 1, At, B1); PG8_BAR; PG8_SCHED;
            PG8_LDB(B0, 1, 0); PG8_LDB(B1, 1, 1); PG8_SCHED; PG8_LDA(At, 1, 0); PG8_STAGE(PG8_SA(0, 1), a2 + ahalf, voffA);
            PG8_WAIT_V(8); PG8_WAIT_L(0); PG8_BAR; PG8_MMA(0, 0, At, B0); PG8_MMA(0, 1, At, B1); PG8_BAR; PG8_SCHED;
            PG8_LDA(At, 1, 1); PG8_STAGE(PG8_SB(1, 0), b3, voffB); PG8_STAGE(PG8_SB(1, 1), b3 + bhalf, voffB); PG8_STAGE(PG8_SA(1, 0), a3, voffA);
            PG8_WAIT_V(8); PG8_WAIT_L(0); PG8_BAR; PG8_MMA(1, 0, At, B0); PG8_MMA(1, 1, At, B1); PG8_BAR; PG8_SCHED;
        }
        const bool fin = SUB ? (cur.last != 0) : true;
        if (fin) { if (wr == 0) PG8_BAR; E(acc, cur, wr, wc, fr, fq); }
        if (!has_next) break;
        if (fin) {
#pragma unroll
            for (int a = 0; a < 2; ++a)
#pragma unroll
                for (int b = 0; b < 2; ++b)
#pragma unroll
                    for (int m = 0; m < 4; ++m)
#pragma unroll
                        for (int n = 0; n < 2; ++n) acc[a][b][m][n] = (f32x4){0.f, 0.f, 0.f, 0.f};
        }
        cur = nxt; ++ui;
        if (fin) { if (wr == 1) PG8_BAR; }
    }
    PG8_WAIT_V(0);
    PG8_BAR;
#undef PG8_SA
#undef PG8_SB
#undef PG8_STAGE
#undef PG8_LDA
#undef PG8_LDB
#undef PG8_MMA
#undef PG8_WAIT_V
#undef PG8_WAIT_L
#undef PG8_BAR
#undef PG8_SCHED
}

struct SchedDense {
    int nM, nN, nwg, G, c; unsigned atile, btile;
    __device__ __forceinline__ void init(int nM_, int nN_, int G_, int c_, int lda, int ldb) {
        nM = nM_; nN = nN_; nwg = nM * nN; G = G_; c = c_; atile = 256u * lda * 2u; btile = 256u * ldb * 2u; }
    __device__ __forceinline__ bool next(int i, GUnit& u) const {
        const int L = i * G + c; if (L >= nwg) return false;
        int wgid = L; { const int q = nwg / NXCD, r = nwg % NXCD, xcd = wgid % NXCD, off = wgid / NXCD; wgid = (xcd < r ? xcd * (q + 1) : r * (q + 1) + (xcd - r) * q) + off; }
        const int nig = WGM * nN, gid = wgid / nig, fm = gid * WGM, gsz = (nM - fm) < WGM ? (nM - fm) : WGM;
        const int pm = fm + ((wgid % nig) % gsz), pn = (wgid % nig) / gsz;
        u.a = (unsigned)pm * atile; u.b = (unsigned)pn * btile; u.last = 1; u.i0 = pm; u.i1 = pn; return true;
    }
};
}

struct Args { const float* in[N_IN]; float* out; unsigned char* ws; int ph_lo, ph_hi, rep, pad; };
static_assert(sizeof(Args) == N_IN * 8 + 8 + 8 + 16, "Args has no padding");

#define CAS __attribute__((address_space(4)))
typedef const float* fptr_t;
struct Ctx {
    const CAS fptr_t* in; float* out; unsigned char* ws; LAS unsigned char* lds; int tid, lane, wave, G, bid, rep, dry;
};
#define WSP(T, off) ((T*)(C.ws + (off)))

__device__ __forceinline__ void build_tiletab(const Ctx& C, int l) {
    volatile LAS int* lc = (volatile LAS int*)(C.lds + LDSCTL_OFF);
    __syncthreads();
    if (C.tid == 0) {
        const unsigned* cnt = WSP(const unsigned, WS_CTL) + CW_CNT + l * 32 * 64;
        int off = 0, t = 0;
        for (int b = 0; b < NBIN; ++b) {
            const int n = (int)__hip_atomic_load(cnt + b * 64, __ATOMIC_RELAXED, __HIP_MEMORY_SCOPE_AGENT);
            lc[LC_OFFS + b] = off;
            const int nt = (n + 255) >> 8;
            for (int k = 0; k < nt; ++k) lc[LC_TILEBIN + t + k] = b;
            t += nt; off += nt * 256;
        }
        lc[LC_OFFS + NBIN] = off; lc[LC_T] = t;
    }
    __syncthreads();
}
__device__ __forceinline__ int expert_of(int bin, int es) {
    const int g = bin / 6, p = bin - g * 6;
    const int lo = p < 3 ? 0 : (p < 5 ? 1 : 2), hi = p < 3 ? p + 1 : (p < 5 ? p - 1 : 3);
    return 4 * g + (es ? hi : lo);
}

struct SchedUp {
    int T, G, c; const volatile LAS int* tilebin;
    __device__ __forceinline__ bool next(int i, pg8::GUnit& u) const {
        const int idx = i * G + c; if (idx >= 4 * T) return false;
        const int rt = idx >> 2, q = idx & 3, es = q >> 1, fb = q & 1;
        const int bin = __builtin_amdgcn_readfirstlane(tilebin[rt]);
        const int e = expert_of(bin, es);
        u.a = (unsigned)rt * 256u * 2048u; u.b = (unsigned)(e * 256 + fb * 128) * 2048u;
        u.last = 1; u.i0 = rt; u.i1 = q; return true;
    }
};
struct SchedDown {
    int T, G, c; const volatile LAS int* tilebin;
    __device__ __forceinline__ bool next(int i, pg8::GUnit& u) const {
        const int idx = (i >> 1) * G + c, sub = i & 1; if (idx >= 4 * T) return false;
        const int rt = idx >> 2, pn = idx & 3;
        const int bin = __builtin_amdgcn_readfirstlane(tilebin[rt]);
        const int e = expert_of(bin, sub);
        u.a = (unsigned)rt * 256u * 1024u + (unsigned)sub * 512u; u.b = (unsigned)(e * 1024 + pn * 256) * 512u;
        u.last = sub; u.i0 = rt; u.i1 = pn; return true;
    }
};

struct EpiHG {
    static constexpr bool PERM = true;
    bf16_t* O; const float* lower;
    __device__ __forceinline__ void operator()(const f32x4 (&acc)[2][2][4][2], const pg8::GUnit& u, int wr, int wc, int fr, int fq) const {
        const int kind = u.i1 >> 1;
        const int row0 = u.i0 * 256 + wr * 64 + fr, colt = u.i1 * 256 + wc * 32 + 8 * fq;
#pragma unroll
        for (int bj = 0; bj < 2; ++bj) {
            const int col = colt + bj * 128;
            float om[8];
#pragma unroll
            for (int j = 0; j < 8; ++j) om[j] = 1.f;
            if (kind >= 3) { const float* lb = lower + (kind - 3) * 2048 + (col & 511);
#pragma unroll
                for (int j = 0; j < 8; ++j) om[j] = 1.f - lb[j]; }
#pragma unroll
            for (int ai = 0; ai < 2; ++ai)
#pragma unroll
                for (int m = 0; m < 4; ++m) {
                    float v[8];
#pragma unroll
                    for (int j = 0; j < 8; ++j) v[j] = acc[ai][bj][m][j >> 2][j & 3];
                    if (kind == 0) {
#pragma unroll
                        for (int j = 0; j < 8; ++j) v[j] = siluf_(v[j]);
                    } else if (kind >= 3) {
#pragma unroll
                        for (int j = 0; j < 8; ++j) v[j] = om[j] * sigmoidf_(-v[j]);
                    }
                    u32x4 w; w.x = pk2(v[0], v[1]); w.y = pk2(v[2], v[3]); w.z = pk2(v[4], v[5]); w.w = pk2(v[6], v[7]);
                    *(u32x4*)(O + (size_t)(row0 + ai * 128 + m * 16) * NHG + col) = w;
                }
        }
    }
};
struct EpiHY {
    static constexpr bool PERM = true;
    bf16_t* O;
    __device__ __forceinline__ void operator()(const f32x4 (&acc)[2][2][4][2], const pg8::GUnit& u, int wr, int wc, int fr, int fq) const {
        const int row0 = u.i0 * 256 + wr * 64 + fr, colt = u.i1 * 256 + wc * 32 + 8 * fq;
#pragma unroll
        for (int ai = 0; ai < 2; ++ai)
#pragma unroll
            for (int m = 0; m < 4; ++m)
#pragma unroll
                for (int bj = 0; bj < 2; ++bj) {
                    const f32x4 v0 = acc[ai][bj][m][0], v1 = acc[ai][bj][m][1];
                    u32x4 w; w.x = pk2(v0[0], v0[1]); w.y = pk2(v0[2], v0[3]); w.z = pk2(v1[0], v1[1]); w.w = pk2(v1[2], v1[3]);
                    *(u32x4*)(O + (size_t)(row0 + ai * 128 + m * 16) * NTOK + colt + bj * 128) = w;
                }
    }
};
struct EpiOut {
    static constexpr bool PERM = false;
    const float* xlat; const float* xctx; float* xo; const float* mods; int first; int dry;
    __device__ __forceinline__ void operator()(const f32x4 (&acc)[2][2][4][2], const pg8::GUnit& u, int wr, int wc, int fr, int fq) const {
        const int row0 = u.i0 * 256 + wr * 64 + fr, col0 = u.i1 * 256 + wc * 32 + 4 * fq;
#pragma unroll
        for (int ai = 0; ai < 2; ++ai)
#pragma unroll
            for (int m = 0; m < 4; ++m) {
                const int row = row0 + ai * 128 + m * 16;
                const float* src = first ? (row < NLAT ? xlat + (size_t)row * D : xctx + (size_t)(row - NLAT) * D) : xo + (size_t)row * D;
                const float* g1 = mods + bidx(row) * 6144 + 2048;
#pragma unroll
                for (int bj = 0; bj < 2; ++bj)
#pragma unroll
                    for (int n = 0; n < 2; ++n) { const int col = col0 + bj * 128 + n * 16;
                        const f32x4 xv = *(const f32x4*)(src + col), gv = *(const f32x4*)(g1 + col);
                        if (!dry) *(f32x4*)(xo + (size_t)row * D + col) = xv + gv * acc[ai][bj][m][n]; }
            }
    }
};
struct EpiAct {
    static constexpr bool PERM = true;
    bf16_t* O; const float* roww;
    __device__ __forceinline__ void operator()(const f32x4 (&acc)[2][2][4][2], const pg8::GUnit& u, int wr, int wc, int fr, int fq) const {
        const int es = u.i1 >> 1; const int pos0 = u.i0 * 256 + wr * 64 + fr, col = u.i1 * 128 + wc * 32 + 8 * fq;
#pragma unroll
        for (int ai = 0; ai < 2; ++ai)
#pragma unroll
            for (int m = 0; m < 4; ++m) {
                const int pos = pos0 + ai * 128 + m * 16;
                const float wgt = roww[pos * 2 + es];
                float v[8];
#pragma unroll
                for (int j = 0; j < 8; ++j) v[j] = siluf_(acc[ai][0][m][j >> 2][j & 3]) * acc[ai][1][m][j >> 2][j & 3] * wgt;
                u32x4 w; w.x = pk2(v[0], v[1]); w.y = pk2(v[2], v[3]); w.z = pk2(v[4], v[5]); w.w = pk2(v[6], v[7]);
                *(u32x4*)(O + (size_t)pos * 512 + col) = w;
            }
    }
};
struct EpiDown {
    static constexpr bool PERM = false;
    float* xo; const int* rowtok; const float* mods; int dry;
    __device__ __forceinline__ void operator()(const f32x4 (&acc)[2][2][4][2], const pg8::GUnit& u, int wr, int wc, int fr, int fq) const {
        const int pos0 = u.i0 * 256 + wr * 64 + fr, col0 = u.i1 * 256 + wc * 32 + 4 * fq;
#pragma unroll
        for (int ai = 0; ai < 2; ++ai)
#pragma unroll
            for (int m = 0; m < 4; ++m) {
                const int tok = rowtok[pos0 + ai * 128 + m * 16];
                if (tok >= 0) {
                    const float* g2 = mods + bidx(tok) * 6144 + 5120;
                    float* xr = xo + (size_t)tok * D;
#pragma unroll
                    for (int bj = 0; bj < 2; ++bj)
#pragma unroll
                        for (int n = 0; n < 2; ++n) { const int col = col0 + bj * 128 + n * 16;
                            const f32x4 xv = *(const f32x4*)(xr + col), gv = *(const f32x4*)(g2 + col);
                            if (!dry) *(f32x4*)(xr + col) = xv + gv * acc[ai][bj][m][n]; }
                }
            }
    }
};

struct SchedFilt {
    int G, c;
    __device__ __forceinline__ bool next(int i, pg8::GUnit& u) const {
        const int idx = i * G + c; if (idx >= 4 * 72) return false;
        const int l = idx / 72, r = idx - l * 72, pm = r / 9, pn = r - pm * 9;
        u.a = (unsigned)(l * 2048 + pm * 256) * 256u; u.b = (unsigned)(l * 2304 + pn * 256) * 256u; u.last = 1; u.i0 = l * 16 + pm; u.i1 = pn; return true;
    }
};
struct EpiFilt {
    static constexpr bool PERM = true;
    bf16_t* HF; const float* b3;
    __device__ __forceinline__ void operator()(const f32x4 (&acc)[2][2][4][2], const pg8::GUnit& u, int wr, int wc, int fr, int fq) const {
        const int l = u.i0 >> 4, pm = u.i0 & 15;
        const int row0 = pm * 256 + wr * 64 + fr, t00 = u.i1 * 256 + wc * 32 + 8 * fq;
#pragma unroll
        for (int ai = 0; ai < 2; ++ai)
#pragma unroll
            for (int m = 0; m < 4; ++m) {
                const int row = row0 + ai * 128 + m * 16, c = row & 511;
                const float delta = fabsf(logf(1e-2f) / 0.3f + (float)c * ((logf(1e-2f) / 1.5f - logf(1e-2f) / 0.3f) / 511.0f));
                const float bias = b3[l * 2048 + row];
#pragma unroll
                for (int bj = 0; bj < 2; ++bj) {
                    const int t0 = t00 + bj * 128;
                    float v[8];
#pragma unroll
                    for (int j = 0; j < 8; ++j) { const int t = t0 + j; const float tn = t < 2048 ? (float)t / 2047.0f : (float)(t - 2048) / 255.0f;
                        v[j] = (acc[ai][bj][m][j >> 2][j & 3] + bias) * expf(-tn * delta); }
                    u32x4 w; w.x = pk2(v[0], v[1]); w.y = pk2(v[2], v[3]); w.z = pk2(v[4], v[5]); w.w = pk2(v[6], v[7]);
                    *(u32x4*)(HF + ((size_t)(l * 2048 + row)) * 2304 + t0) = w;
                }
            }
    }
};

__device__ __forceinline__ int padx(int i) { return i + (i >> 3); }
__device__ __forceinline__ f32x2 cmul(f32x2 a, f32x2 b) { return (f32x2){a.x * b.x - a.y * b.y, a.x * b.y + a.y * b.x}; }
__device__ __forceinline__ f32x2 cmulc(f32x2 a, f32x2 b) { return (f32x2){a.x * b.x + a.y * b.y, a.y * b.x - a.x * b.y}; }
constexpr int XPAD = 2048 + 256;

__device__ __forceinline__ void fft_p1_dif(f32x2 (&v)[8], int tt, const LAS f32x2* T) {
#pragma unroll
    for (int g = 0; g < 2; ++g) { const int u = tt + 256 * g;
#pragma unroll
        for (int j = 0; j < 2; ++j) { const f32x2 a = v[g + 2 * j], b = v[g + 2 * j + 4]; v[g + 2 * j] = a + b; v[g + 2 * j + 4] = cmul(a - b, T[2 * (u + 512 * j)]); }
        const f32x2 tw = T[4 * u];
        { const f32x2 a = v[g], b = v[g + 2]; v[g] = a + b; v[g + 2] = cmul(a - b, tw); }
        { const f32x2 a = v[g + 4], b = v[g + 6]; v[g + 4] = a + b; v[g + 6] = cmul(a - b, tw); } }
}
__device__ __forceinline__ void fft_p1_dit(f32x2 (&v)[8], int tt, const LAS f32x2* T) {
#pragma unroll
    for (int g = 0; g < 2; ++g) { const int u = tt + 256 * g;
        const f32x2 tw = T[4 * u];
        { const f32x2 a = v[g], b = cmulc(v[g + 2], tw); v[g] = a + b; v[g + 2] = a - b; }
        { const f32x2 a = v[g + 4], b = cmulc(v[g + 6], tw); v[g + 4] = a + b; v[g + 6] = a - b; }
#pragma unroll
        for (int j = 0; j < 2; ++j) { const f32x2 a = v[g + 2 * j], b = cmulc(v[g + 2 * j + 4], T[2 * (u + 512 * j)]); v[g + 2 * j] = a + b; v[g + 2 * j + 4] = a - b; } }
}
template <int Q> __device__ __forceinline__ void r8_dif(f32x2 (&e)[8], int r, const LAS f32x2* T) {
    constexpr int S2 = 512 / Q;
#pragma unroll
    for (int j = 0; j < 4; ++j) { const f32x2 a = e[j], b = e[j + 4]; e[j] = a + b; e[j + 4] = cmul(a - b, T[S2 * (r + Q * j)]); }
#pragma unroll
    for (int jj = 0; jj < 4; ++jj) { const int j = (jj & 1) + 4 * (jj >> 1); const f32x2 a = e[j], b = e[j + 2]; e[j] = a + b; e[j + 2] = cmul(a - b, T[2 * S2 * (r + Q * (j & 1))]); }
    const f32x2 tw = T[4 * S2 * r];
#pragma unroll
    for (int j = 0; j < 8; j += 2) { const f32x2 a = e[j], b = e[j + 1]; e[j] = a + b; e[j + 1] = cmul(a - b, tw); }
}
template <int Q> __device__ __forceinline__ void r8_dit(f32x2 (&e)[8], int r, const LAS f32x2* T) {
    constexpr int S2 = 512 / Q;
    const f32x2 tw = T[4 * S2 * r];
#pragma unroll
    for (int j = 0; j < 8; j += 2) { const f32x2 a = e[j], b = cmulc(e[j + 1], tw); e[j] = a + b; e[j + 1] = a - b; }
#pragma unroll
    for (int jj = 0; jj < 4; ++jj) { const int j = (jj & 1) + 4 * (jj >> 1); const f32x2 a = e[j], b = cmulc(e[j + 2], T[2 * S2 * (r + Q * (j & 1))]); e[j] = a + b; e[j + 2] = a - b; }
#pragma unroll
    for (int j = 0; j < 4; ++j) { const f32x2 a = e[j], b = cmulc(e[j + 4], T[S2 * (r + Q * j)]); e[j] = a + b; e[j + 4] = a - b; }
}
template <int Q, bool INV> __device__ __forceinline__ void fft_mid(LAS f32x2* X, int tt, const LAS f32x2* T) {
    const int blk = tt / Q, r = tt % Q, base = blk * 8 * Q + r;
    f32x2 e[8];
#pragma unroll
    for (int j = 0; j < 8; ++j) e[j] = X[padx(base + Q * j)];
    if (INV) r8_dit<Q>(e, r, T); else r8_dif<Q>(e, r, T);
#pragma unroll
    for (int j = 0; j < 8; ++j) X[padx(base + Q * j)] = e[j];
}
__device__ __forceinline__ void fft_conv_half(f32x2 (&v)[8], LAS f32x2* X, const LAS f32x2* T, const f32x2* K, int tt) {
    f32x2 kv[8];
#pragma unroll
    for (int j = 0; j < 8; ++j) kv[j] = K[8 * tt + j];
    fft_p1_dif(v, tt, T);
#pragma unroll
    for (int m = 0; m < 8; ++m) X[padx(tt + 256 * m)] = v[m];
    __syncthreads();
    fft_mid<64, false>(X, tt, T); __syncthreads();
    fft_mid<8, false>(X, tt, T); __syncthreads();
    f32x2 e[8];
#pragma unroll
    for (int j = 0; j < 8; ++j) e[j] = X[padx(8 * tt + j)];
    r8_dif<1>(e, 0, T);
#pragma unroll
    for (int j = 0; j < 8; ++j) e[j] = cmul(e[j], kv[j]);
    r8_dit<1>(e, 0, T);
#pragma unroll
    for (int j = 0; j < 8; ++j) X[padx(8 * tt + j)] = e[j];
    __syncthreads();
    fft_mid<8, true>(X, tt, T); __syncthreads();
    fft_mid<64, true>(X, tt, T); __syncthreads();
#pragma unroll
    for (int m = 0; m < 8; ++m) v[m] = X[padx(tt + 256 * m)];
    fft_p1_dit(v, tt, T);
}
__device__ __forceinline__ void fft_fwd_store(f32x2 (&v)[8], LAS f32x2* X, const LAS f32x2* T, f32x2* Kout, int tt) {
    fft_p1_dif(v, tt, T);
#pragma unroll
    for (int m = 0; m < 8; ++m) X[padx(tt + 256 * m)] = v[m];
    __syncthreads();
    fft_mid<64, false>(X, tt, T); __syncthreads();
    fft_mid<8, false>(X, tt, T); __syncthreads();
    f32x2 e[8];
#pragma unroll
    for (int j = 0; j < 8; ++j) e[j] = X[padx(8 * tt + j)];
    r8_dif<1>(e, 0, T);
#pragma unroll
    for (int j = 0; j < 8; ++j) Kout[8 * tt + j] = e[j];
    __syncthreads();
}
__device__ __forceinline__ int padx16(int i) { return i + (i >> 4); }
constexpr int XPAD16 = 2048 + 128;
template <int Q> __device__ __forceinline__ void r16_dif(f32x2 (&e)[16], int r, const LAS f32x2* T) {
    constexpr int S2 = 256 / Q;
#pragma unroll
    for (int j = 0; j < 8; ++j) { const f32x2 a = e[j], b = e[j + 8]; e[j] = a + b; e[j + 8] = cmul(a - b, T[S2 * (r + Q * j)]); }
#pragma unroll
    for (int jj = 0; jj < 8; ++jj) { const int j = (jj & 3) + 8 * (jj >> 2); const f32x2 a = e[j], b = e[j + 4]; e[j] = a + b; e[j + 4] = cmul(a - b, T[2 * S2 * (r + Q * (j & 3))]); }
#pragma unroll
    for (int jj = 0; jj < 8; ++jj) { const int j = (jj & 1) + 4 * (jj >> 1); const f32x2 a = e[j], b = e[j + 2]; e[j] = a + b; e[j + 2] = cmul(a - b, T[4 * S2 * (r + Q * (j & 1))]); }
    const f32x2 tw = T[8 * S2 * r];
#pragma unroll
    for (int j = 0; j < 16; j += 2) { const f32x2 a = e[j], b = e[j + 1]; e[j] = a + b; e[j + 1] = cmul(a - b, tw); }
}
template <int Q> __device__ __forceinline__ void r16_dit(f32x2 (&e)[16], int r, const LAS f32x2* T) {
    constexpr int S2 = 256 / Q;
    const f32x2 tw = T[8 * S2 * r];
#pragma unroll
    for (int j = 0; j < 16; j += 2) { const f32x2 a = e[j], b = cmulc(e[j + 1], tw); e[j] = a + b; e[j + 1] = a - b; }
#pragma unroll
    for (int jj = 0; jj < 8; ++jj) { const int j = (jj & 1) + 4 * (jj >> 1); const f32x2 a = e[j], b = cmulc(e[j + 2], T[4 * S2 * (r + Q * (j & 1))]); e[j] = a + b; e[j + 2] = a - b; }
#pragma unroll
    for (int jj = 0; jj < 8; ++jj) { const int j = (jj & 3) + 8 * (jj >> 2); const f32x2 a = e[j], b = cmulc(e[j + 4], T[2 * S2 * (r + Q * (j & 3))]); e[j] = a + b; e[j + 4] = a - b; }
#pragma unroll
    for (int j = 0; j < 8; ++j) { const f32x2 a = e[j], b = cmulc(e[j + 8], T[S2 * (r + Q * j)]); e[j] = a + b; e[j + 8] = a - b; }
}
__device__ __forceinline__ void fft_conv_half16(f32x2 (&v)[16], LAS f32x2* X, const LAS f32x2* T, const f32x2* K, int tt) {
    r16_dif<128>(v, tt, T);
#pragma unroll
    for (int m = 0; m < 16; ++m) X[padx16(tt + 128 * m)] = v[m];
    __syncthreads();
    const int r = tt & 7, base = (tt >> 3) * 128 + r;
#pragma unroll
    for (int j = 0; j < 16; ++j) v[j] = X[padx16(base + 8 * j)];
    r16_dif<8>(v, r, T);
#pragma unroll
    for (int j = 0; j < 16; ++j) X[padx16(base + 8 * j)] = v[j];
    f32x2 kv[16];
#pragma unroll
    for (int j = 0; j < 16; ++j) kv[j] = K[16 * tt + j];
    __syncthreads();
#pragma unroll
    for (int g = 0; g < 2; ++g) { f32x2 e[8];
#pragma unroll
        for (int j = 0; j < 8; ++j) e[j] = X[padx16(16 * tt + 8 * g + j)];
        r8_dif<1>(e, 0, T);
#pragma unroll
        for (int j = 0; j < 8; ++j) e[j] = cmul(e[j], kv[8 * g + j]);
        r8_dit<1>(e, 0, T);
#pragma unroll
        for (int j = 0; j < 8; ++j) X[padx16(16 * tt + 8 * g + j)] = e[j]; }
    __syncthreads();
#pragma unroll
    for (int j = 0; j < 16; ++j) v[j] = X[padx16(base + 8 * j)];
    r16_dit<8>(v, r, T);
#pragma unroll
    for (int j = 0; j < 16; ++j) X[padx16(base + 8 * j)] = v[j];
    __syncthreads();
#pragma unroll
    for (int m = 0; m < 16; ++m) v[m] = X[padx16(tt + 128 * m)];
    r16_dit<128>(v, tt, T);
}
__device__ __forceinline__ void fft_fwd_store16(f32x2 (&v)[16], LAS f32x2* X, const LAS f32x2* T, f32x2* Kout, int tt) {
    r16_dif<128>(v, tt, T);
#pragma unroll
    for (int m = 0; m < 16; ++m) X[padx16(tt + 128 * m)] = v[m];
    __syncthreads();
    const int r = tt & 7, base = (tt >> 3) * 128 + r;
#pragma unroll
    for (int j = 0; j < 16; ++j) v[j] = X[padx16(base + 8 * j)];
    r16_dif<8>(v, r, T);
#pragma unroll
    for (int j = 0; j < 16; ++j) X[padx16(base + 8 * j)] = v[j];
    __syncthreads();
#pragma unroll
    for (int g = 0; g < 2; ++g) { f32x2 e[8];
#pragma unroll
        for (int j = 0; j < 8; ++j) e[j] = X[padx16(16 * tt + 8 * g + j)];
        r8_dif<1>(e, 0, T);
#pragma unroll
        for (int j = 0; j < 8; ++j) Kout[16 * tt + 8 * g + j] = e[j]; }
    __syncthreads();
}
__device__ __forceinline__ void build_twiddles(const Ctx& C, LAS f32x2* T) {
    for (int k = C.tid; k < 2048; k += NTHR) { float s, c; sincospif((float)k * (1.0f / 2048.0f), &s, &c); T[k] = (f32x2){c, -s}; }
}

__device__ __forceinline__ void phase0(const Ctx& C) {
    LAS float* sil = (LAS float*)C.lds;
    LAS float* red = sil + 9 * 1024;
    LAS float* zs = red + 8 * 9 * 64;
    LAS float* h1s = zs + 8 * 40;
    const float* cin = C.in[IN_C]; const float* cctx = C.in[IN_CCTX];
    for (int i = C.tid; i < 9 * 1024; i += NTHR) { const int r = i >> 10, k = i & 1023; const float v = r < 8 ? cin[r * 1024 + k] : cctx[k]; sil[i] = v / (1.0f + expf(-v)); }
    __syncthreads();
    float* mods = WSP(float, WS_MODS);
    const float* wmod = C.in[IN_WMOD]; const float* bmod = C.in[IN_BMOD];
    for (int item = C.bid; item < 4 * 96; item += C.G) {
        const int l = item / 96, cb = item % 96, cc = C.tid & 63, kg = C.tid >> 6;
        const float* w = wmod + ((size_t)l * 1024 + kg * 128) * 6144 + cb * 64 + cc;
        const LAS float* sk = sil + kg * 128;
        float acc[9];
#pragma unroll
        for (int r = 0; r < 9; ++r) acc[r] = 0.f;
#pragma unroll 4
        for (int k = 0; k < 128; ++k) { const float wv = w[(size_t)k * 6144];
#pragma unroll
            for (int r = 0; r < 9; ++r) acc[r] += sk[r * 1024 + k] * wv; }
#pragma unroll
        for (int r = 0; r < 9; ++r) red[(kg * 9 + r) * 64 + cc] = acc[r];
        __syncthreads();
        for (int o = C.tid; o < 576; o += NTHR) { const int r = o >> 6, c2 = o & 63; float s = 0.f;
#pragma unroll
            for (int g = 0; g < 8; ++g) s += red[(g * 9 + r) * 64 + c2];
            mods[(size_t)(l * 9 + r) * 6144 + cb * 64 + c2] = s + bmod[l * 6144 + cb * 64 + c2]; }
        __syncthreads();
    }
    for (int item = C.bid; item < 4 * 288; item += C.G) {
        const int l = item / 288, r = item % 288, isctx = r >= 256;
        const int L = isctx ? 256 : 2048, t0 = (isctx ? r - 256 : r) * 8, tl = C.tid >> 6, j = C.tid & 63, t = t0 + tl;
        if (j < 33) { float z;
            if (j == 0) z = (float)t / (float)(L - 1);
            else { const int fi = (j - 1) & 15; const float freq = 1e-4f + (float)fi * ((15.0f - 1e-4f) / 15.0f);
                const float ang = ((float)(2.0 * 3.14159265358979323846 / L) * (float)t) * freq; z = (j <= 16) ? cosf(ang) : -sinf(ang); }
            zs[tl * 40 + j] = z; }
        __syncthreads();
        { const float* w1 = C.in[IN_W1] + (size_t)l * 33 * 64; float s = C.in[IN_B1][l * 64 + j];
            for (int i = 0; i < 33; ++i) s += zs[tl * 40 + i] * w1[i * 64 + j];
            h1s[tl * 64 + j] = sinf(s); }
        __syncthreads();
        { const float* w2 = C.in[IN_W2] + (size_t)l * 64 * 64; float s = C.in[IN_B2][l * 64 + j];
            for (int i = 0; i < 64; ++i) s += h1s[tl * 64 + i] * w2[i * 64 + j];
            bf16_t* dst = WSP(bf16_t, WS_HPAD) + ((size_t)l * 2304 + (isctx ? 2048 + t : t)) * 128;
            dst[j] = (bf16_t)f2bf(sinf(s)); dst[64 + j] = (bf16_t)0; }
        __syncthreads();
    }
    {
        const float* w3 = C.in[IN_W3]; bf16_t* w3t = WSP(bf16_t, WS_W3T);
        for (int i = C.bid * NTHR + C.tid; i < 4 * 64 * 2048; i += C.G * NTHR) { const int l = i >> 17, k = (i >> 11) & 63, col = i & 2047;
            w3t[((size_t)l * 2048 + col) * 128 + k] = (bf16_t)f2bf(w3[i]); w3t[((size_t)l * 2048 + col) * 128 + 64 + k] = (bf16_t)0; }
    }
    if (C.bid == C.G - 1) {
        const float* lb = C.in[IN_LB]; float* lower = WSP(float, WS_LOWER);
        for (int i = C.tid; i < 1024; i += NTHR) { const int d = i >> 9, c = i & 511; float v[4], mx = -3.4e38f, s = 0.f;
#pragma unroll
            for (int l = 0; l < 4; ++l) { v[l] = lb[(d * 4 + l) * 512 + c]; mx = fmaxf(mx, v[l]); }
#pragma unroll
            for (int l = 0; l < 4; ++l) { v[l] = expf(v[l] - mx); s += v[l]; }
            float cum = 0.f;
#pragma unroll
            for (int l = 0; l < 4; ++l) { if (l > 0) cum += v[l] / s; lower[(d * 4 + l) * 512 + c] = cum; } }
    }
}

__device__ __forceinline__ const float* xrow_src(const Ctx& C, int l, int row) {
    return l == 0 ? (row < NLAT ? C.in[IN_X] + (size_t)row * D : C.in[IN_CTX] + (size_t)(row - NLAT) * D) : WSP(const float, WS_XBUF) + (size_t)row * D;
}
__device__ __forceinline__ void transpose_item(const float* W, int K, int N, bf16_t* WT, LAS float* scr, int item, int lane) {
    const int nblk = N / 32, kb = item / nblk, nb = item % nblk, k0 = 64 * kb, n0 = 32 * nb;
#pragma unroll 8
    for (int i = 0; i < 32; ++i) { const int kk = 2 * i + (lane >> 5); scr[kk * 33 + (lane & 31)] = W[(size_t)(k0 + kk) * N + n0 + (lane & 31)]; }
    LDS_WAIT(); asm volatile("" ::: "memory");
    const int c = lane & 7;
#pragma unroll
    for (int j = 0; j < 4; ++j) { const int n = (lane >> 3) + 8 * j; const LAS float* s = scr + (8 * c) * 33 + n;
        u32x4 o; o.x = pk2(s[0 * 33], s[1 * 33]); o.y = pk2(s[2 * 33], s[3 * 33]); o.z = pk2(s[4 * 33], s[5 * 33]); o.w = pk2(s[6 * 33], s[7 * 33]);
        *(u32x4*)(WT + (size_t)(n0 + n) * K + k0 + 8 * c) = o; }
    LDS_WAIT(); asm volatile("" ::: "memory");
}
__device__ __forceinline__ void phase_l1(const Ctx& C, int l) {
    const int gw = C.bid * NWAVES + C.wave, NGW = C.G * NWAVES;
    const float* mods = WSP(const float, WS_MODS) + (size_t)l * 9 * 6144;
    bf16_t* an = WSP(bf16_t, WS_R1);
    f32x4 nv[4];
    if (!(C.dry & 2)) {
    if (gw < NTOK) { const float* src = xrow_src(C, l, gw);
#pragma unroll
        for (int j = 0; j < 4; ++j) nv[j] = *(const f32x4*)(src + C.lane * 4 + 256 * j); }
    for (int row = gw; row < NTOK; row += NGW) {
        const float* md = mods + bidx(row) * 6144;
        f32x4 v[4]; float ss = 0.f;
#pragma unroll
        for (int j = 0; j < 4; ++j) v[j] = nv[j];
        if (row + NGW < NTOK) { const float* src = xrow_src(C, l, row + NGW);
#pragma unroll
            for (int j = 0; j < 4; ++j) nv[j] = *(const f32x4*)(src + C.lane * 4 + 256 * j); }
#pragma unroll
        for (int j = 0; j < 4; ++j) ss += (v[j].x * v[j].x + v[j].y * v[j].y) + (v[j].z * v[j].z + v[j].w * v[j].w);
        ss = wave_sum(ss); const float rinv = 1.0f / sqrtf(ss * (1.0f / D) + EPS);
#pragma unroll
        for (int j = 0; j < 4; ++j) { const int k = C.lane * 4 + 256 * j; const f32x4 sh = *(const f32x4*)(md + k), sc = *(const f32x4*)(md + 1024 + k);
            const f32x4 o = v[j] * rinv * (sc + 1.0f) + sh; u32x2 w; w.x = pk2(o.x, o.y); w.y = pk2(o.z, o.w);
            *(u32x2*)(an + (size_t)row * D + k) = w; }
    }
    }
    if (!(C.dry & 4)) {
        LAS float* scr = (LAS float*)(C.lds + C.wave * 16384);
        constexpr int I_IN = 16 * 128, I_OUT = 16 * 32, I_E = 128;
        constexpr int NIT = I_IN + I_OUT + 3 * 16 * I_E;
        for (int it = gw; it < NIT; it += NGW) {
            int r = it;
            if (r < I_IN) { transpose_item(C.in[IN_WIN] + (size_t)l * D * DIN, D, DIN, WSP(bf16_t, WS_WIN), scr, r, C.lane); continue; } r -= I_IN;
            if (r < I_OUT) { transpose_item(C.in[IN_WOUT] + (size_t)l * D * D, D, D, WSP(bf16_t, WS_WOUT), scr, r, C.lane); continue; } r -= I_OUT;
            if (r < 16 * I_E) { const int e = r / I_E; transpose_item(C.in[IN_WG] + ((size_t)l * NE + e) * D * DE, D, DE, WSP(bf16_t, WS_WG) + (size_t)e * DE * D, scr, r % I_E, C.lane); continue; } r -= 16 * I_E;
            if (r < 16 * I_E) { const int e = r / I_E; transpose_item(C.in[IN_WU] + ((size_t)l * NE + e) * D * DE, D, DE, WSP(bf16_t, WS_WU) + (size_t)e * DE * D, scr, r % I_E, C.lane); continue; } r -= 16 * I_E;
            { const int e = r / I_E; transpose_item(C.in[IN_WD] + ((size_t)l * NE + e) * DE * D, DE, D, WSP(bf16_t, WS_WD) + (size_t)e * D * DE, scr, r % I_E, C.lane); }
        }
    }
    __syncthreads();
    {
        LAS f32x2* T = (LAS f32x2*)C.lds;
        const int team = C.tid >> 7, tt = C.tid & 127;
        LAS f32x2* X = (LAS f32x2*)(C.lds + 16384) + team * XPAD16;
        LAS float* hbs = (LAS float*)(C.lds + 16384 + 4 * XPAD16 * 8) + team * 2048;
        LAS float* reds = (LAS float*)(C.lds + 16384 + 4 * XPAD16 * 8 + 32768);
        build_twiddles(C, T);
        __syncthreads();
        const bf16_t* hfl = WSP(const bf16_t, WS_HF) + (size_t)l * 2048 * 2304;
        f32x2* kspec = WSP(f32x2, WS_KSPEC);
        if (!(C.dry & 8))
        for (int item = C.bid; item < 256; item += C.G) {
            const int idx = item * 4 + team, o = idx >> 9, c = idx & 511;
            const int colf = o * 1024 + c, colb = colf + 512;
            const bf16_t* hfp = hfl + (size_t)colf * 2304; const bf16_t* hbp = hfl + (size_t)colb * 2304;
            float hf[16], hb[16], s = 0.f;
#pragma unroll
            for (int j = 0; j < 16; ++j) { const int t = tt + 128 * j; hf[j] = bf2f(hfp[t]); hb[j] = bf2f(hbp[t]); s += fabsf(hf[j]) + fabsf(hb[j]); }
            s = wave_sum(s);
            if (C.lane == 0) reds[C.wave] = s;
            __syncthreads();
            const float inv = 1.0f / ((reds[team * 2] + reds[team * 2 + 1]) * 4096.0f);
#pragma unroll
            for (int j = 0; j < 16; ++j) { hf[j] *= inv; hbs[tt + 128 * j] = hb[j] * inv; }
            __syncthreads();
            f32x2* kout = kspec + ((size_t)(o * 512 + c) * 2) * 2048;
            f32x2 vv[16];
#pragma unroll
            for (int j = 0; j < 16; ++j) { const int n = tt + 128 * j; const float kb = n > 0 ? hbs[2048 - n] : 0.f; vv[j] = (f32x2){hf[j] + kb, 0.f}; }
            fft_fwd_store16(vv, X, T, kout, tt);
#pragma unroll
            for (int j = 0; j < 16; ++j) { const int n = tt + 128 * j; const float kb = n > 0 ? hbs[2048 - n] : 0.f; const float dd = hf[j] - kb; const f32x2 tw = T[n]; vv[j] = (f32x2){dd * tw.x, dd * tw.y}; }
            fft_fwd_store16(vv, X, T, kout + 2048, tt);
        }
        if (l < DEPTH - 1 && !(C.dry & 16)) {
            f32x2* kspc = WSP(f32x2, WS_KSPC);
            for (int item = C.bid; item < 256; item += C.G) {
                const int idx = item * 4 + team, o = idx >> 9, c = idx & 511;
                const int colf = o * 1024 + c, colb = colf + 512;
                float af0 = bf2f(hfl[(size_t)colf * 2304 + 2048 + tt]), af1 = bf2f(hfl[(size_t)colf * 2304 + 2048 + 128 + tt]);
                float ab0 = bf2f(hfl[(size_t)colb * 2304 + 2048 + tt]), ab1 = bf2f(hfl[(size_t)colb * 2304 + 2048 + 128 + tt]);
                __syncthreads();
                const float s = wave_sum((fabsf(af0) + fabsf(af1)) + (fabsf(ab0) + fabsf(ab1)));
                if (C.lane == 0) reds[C.wave] = s;
                __syncthreads();
                const float inv = 1.0f / ((reds[team * 2] + reds[team * 2 + 1]) * 2048.0f);
                af0 *= inv; af1 *= inv; hbs[tt] = ab0 * inv; hbs[128 + tt] = ab1 * inv;
                __syncthreads();
                f32x2 vk[16];
#pragma unroll
                for (int j = 0; j < 16; ++j) vk[j] = (f32x2){0.f, 0.f};
                vk[0] = (f32x2){af0, 0.f}; vk[1] = (f32x2){af1, 0.f};
                vk[14] = (f32x2){tt > 0 ? hbs[256 - tt] : 0.f, 0.f};
                vk[15] = (f32x2){hbs[128 - tt], 0.f};
                fft_fwd_store16(vk, X, T, kspc + (size_t)(o * 512 + c) * 2048, tt);
            }
        }
    }
}

__device__ __forceinline__ float shortconv(const LAS bf16_t* raw, int t, int mask, int tmax, float w0, float w1, float w2, float bias) {
    const float pm = ((t & mask) != 0) ? bf2f(raw[t - 1]) : 0.f;
    const float pc = bf2f(raw[t]);
    const float pp = ((t & mask) != mask && t < tmax) ? bf2f(raw[t + 1]) : 0.f;
    return w0 * pm + w1 * pc + w2 * pp + bias;
}
constexpr int HY_CH = 4, HY_ITEMS = 4 * (512 / HY_CH), HYC_ITEMS = 512 / 4;
__device__ __forceinline__ void hyena_lat(const Ctx& C, int l, int item) {
    const int bp = item & 3, cg = item >> 2, team = C.tid >> 7, tt = C.tid & 127;
    LAS f32x2* T = (LAS f32x2*)C.lds;
    LAS f32x2* X = (LAS f32x2*)(C.lds + 16384) + team * XPAD16;
    LAS bf16_t* raw = (LAS bf16_t*)(C.lds + 16384 + 4 * XPAD16 * 8) + team * 4096;
    const bf16_t* phyt = WSP(const bf16_t, WS_PHYT);
    const float* cw = C.in[IN_CONVW] + (size_t)l * 3 * NHY; const float* cb = C.in[IN_CONVB] + (size_t)l * NHY;
    const float* hyb = C.in[IN_HYBIAS] + (size_t)l * 2 * DH;
    const f32x2* kspec = WSP(const f32x2, WS_KSPEC);
    const int ba = 2 * bp, c = cg * 4 + team;
    f32x2 z[16], acc[16], v[16];
#pragma unroll 1
    for (int stage = 0; stage < 3; ++stage) {
        const int ch = stage * 512 + c;
        __syncthreads();
#pragma unroll
        for (int k = 0; k < 4; ++k) { const int q = tt + 128 * k, rr = q >> 8, cc = q & 255;
            *(LAS u32x4*)(raw + rr * 2048 + cc * 8) = *(const u32x4*)(phyt + (size_t)ch * NTOK + (size_t)(ba + rr) * 2048 + cc * 8); }
        __syncthreads();
        const float w0 = cw[ch], w1 = cw[NHY + ch], w2 = cw[2 * NHY + ch], bs = cb[ch];
        if (stage == 0) {
#pragma unroll
            for (int j = 0; j < 16; ++j) { const int t = tt + 128 * j; z[j] = (f32x2){shortconv(raw, t, 63, 4096, w0, w1, w2, bs), shortconv(raw + 2048, t, 63, 4096, w0, w1, w2, bs)}; }
        } else {
            const float dsk = hyb[(stage - 1) * DH + c];
#pragma unroll
            for (int j = 0; j < 16; ++j) { const int t = tt + 128 * j; const f32x2 cv = acc[j] + z[j] * dsk;
                z[j] = (f32x2){shortconv(raw, t, 63, 4096, w0, w1, w2, bs) * cv.x, shortconv(raw + 2048, t, 63, 4096, w0, w1, w2, bs) * cv.y}; }
        }
        if (stage == 2) {
            LAS bf16_t* ob = (LAS bf16_t*)X;
#pragma unroll
            for (int j = 0; j < 16; ++j) { const int t = tt + 128 * j; ob[t] = (bf16_t)f2bf(z[j].x); ob[2048 + t] = (bf16_t)f2bf(z[j].y); }
            break;
        }
        const f32x2* K = kspec + ((size_t)(stage * 512 + c) * 2) * 2048;
#pragma unroll
        for (int j = 0; j < 16; ++j) v[j] = z[j];
        fft_conv_half16(v, X, T, K, tt);
#pragma unroll
        for (int j = 0; j < 16; ++j) acc[j] = v[j];
#pragma unroll
        for (int j = 0; j < 16; ++j) v[j] = cmul(z[j], T[tt + 128 * j]);
        fft_conv_half16(v, X, T, K + 2048, tt);
#pragma unroll
        for (int j = 0; j < 16; ++j) acc[j] += cmulc(v[j], T[tt + 128 * j]);
    }
    __syncthreads();
    bf16_t* Y = WSP(bf16_t, WS_R1);
    for (int i = C.tid; i < 4096; i += NTHR) { const int b = i >> 11, t = i & 2047;
        const LAS bf16_t* o0 = (const LAS bf16_t*)((LAS f32x2*)(C.lds + 16384)) + i;
        u32x2 w; w.x = (unsigned)o0[0] | ((unsigned)o0[XPAD16 * 4] << 16); w.y = (unsigned)o0[2 * XPAD16 * 4] | ((unsigned)o0[3 * XPAD16 * 4] << 16);
        *(u32x2*)(Y + ((size_t)(ba + b) * 2048 + t) * D + cg * 4) = w; }
    __syncthreads();
}
__device__ __forceinline__ void hyena_ctx2(const Ctx& C, int l, int item) {
    const int team = C.tid >> 7, tt = C.tid & 127, c = item * 4 + team;
    LAS f32x2* T = (LAS f32x2*)C.lds;
    LAS f32x2* X = (LAS f32x2*)(C.lds + 16384) + team * XPAD16;
    LAS bf16_t* raw = (LAS bf16_t*)(C.lds + 16384 + 4 * XPAD16 * 8) + team * 4096;
    const bf16_t* phyt = WSP(const bf16_t, WS_PHYT);
    const float* cw = C.in[IN_CONVW] + (size_t)l * 3 * NHY; const float* cb = C.in[IN_CONVB] + (size_t)l * NHY;
    const float* hyb = C.in[IN_HYBIAS] + (size_t)l * 2 * DH;
    const f32x2* kspc = WSP(const f32x2, WS_KSPC);
    bf16_t* Y = WSP(bf16_t, WS_R1);
    f32x2 z[16], v[16];
#pragma unroll
    for (int j = 0; j < 16; ++j) { z[j] = (f32x2){0.f, 0.f}; v[j] = (f32x2){0.f, 0.f}; }
#pragma unroll 1
    for (int stage = 0; stage < 3; ++stage) {
        const int ch = stage * 512 + c;
        __syncthreads();
#pragma unroll
        for (int k = 0; k < 2; ++k) { const int q = tt + 128 * k; *(LAS u32x4*)(raw + q * 8) = *(const u32x4*)(phyt + (size_t)ch * NTOK + NLAT + q * 8); }
        __syncthreads();
        const float w0 = cw[ch], w1 = cw[NHY + ch], w2 = cw[2 * NHY + ch], bs = cb[ch];
        const float dsk = stage > 0 ? hyb[(stage - 1) * DH + c] : 0.f;
#pragma unroll
        for (int p = 0; p < 4; ++p)
#pragma unroll
            for (int hh = 0; hh < 2; ++hh) { const int m = 4 * p + hh, tok = hh * 128 + tt;
                const float ua = shortconv(raw, (2 * p) * 256 + tok, 255, 4096, w0, w1, w2, bs), ub = shortconv(raw, (2 * p + 1) * 256 + tok, 255, 4096, w0, w1, w2, bs);
                if (stage == 0) z[m] = (f32x2){ua, ub};
                else { const f32x2 cv = v[m] + z[m] * dsk; z[m] = (f32x2){ua * cv.x, ub * cv.y}; } }
        if (stage == 2) {
#pragma unroll
            for (int p = 0; p < 4; ++p)
#pragma unroll
                for (int hh = 0; hh < 2; ++hh) { const int m = 4 * p + hh, tok = hh * 128 + tt;
                    Y[(size_t)(NLAT + (2 * p) * 256 + tok) * D + c] = (bf16_t)f2bf(z[m].x); Y[(size_t)(NLAT + (2 * p + 1) * 256 + tok) * D + c] = (bf16_t)f2bf(z[m].y); }
            break;
        }
#pragma unroll
        for (int j = 0; j < 16; ++j) v[j] = z[j];
        fft_conv_half16(v, X, T, kspc + (size_t)(stage * 512 + c) * 2048, tt);
    }
}

constexpr int HG_QT = 0, HG_QP = 17408, HG_KP = 34816, HG_ST = 52224, HG_VT = 87040, HG_KH = 105472, HG_P = 123904, HG_SUB = 133120, HG_D = 135168;
__device__ __forceinline__ void hgrn_mfma(const Ctx& C, int item) {
    const int dir = item & 1, h = (item >> 1) & 3, b = item >> 3;
    LAS unsigned char* L = C.lds;
    const int lane = C.lane, w = C.wave, r = lane & 15, quad = lane >> 4;
    const int I = w >> 1, col = (w & 1) * 64 + lane;
    const bf16_t* phg = WSP(const bf16_t, WS_PHG);
    bf16_t* odir = WSP(bf16_t, WS_ODIR) + (size_t)dir * NTOK * 512;
    LAS float* subtot = (LAS float*)(L + HG_SUB); LAS float* Dv = (LAS float*)(L + HG_D);
    __syncthreads();
    for (int i = C.tid; i < (128 * 272) / 16; i += NTHR) *(LAS u32x4*)(L + HG_ST + i * 16) = (u32x4){0u, 0u, 0u, 0u};
    for (int i = C.tid; i < (64 * 144) / 16; i += NTHR) *(LAS u32x4*)(L + HG_P + i * 16) = (u32x4){0u, 0u, 0u, 0u};
    f32x4 sacc[8];
#pragma unroll
    for (int t = 0; t < 8; ++t) sacc[t] = (f32x4){0.f, 0.f, 0.f, 0.f};
    unsigned short qr[16], kr[16], vr[16];
    const int rstep = dir ? -1 : 1;
    const size_t colq = (size_t)h * 128 + col, colk = 1536 + (size_t)dir * 512 + h * 128 + col, colv = 512 + (size_t)h * 128 + col;
    auto chunk_row0 = [&](int ch) -> int { return ch < 4 ? NLAT + b * 256 + (dir ? 255 - ch * 64 : ch * 64) : b * 2048 + (dir ? 2047 - (ch - 4) * 64 : (ch - 4) * 64); };
    { const int row0 = chunk_row0(0) + rstep * 16 * I;
#pragma unroll
      for (int i = 0; i < 16; ++i) { const bf16_t* p = phg + (size_t)(row0 + rstep * i) * NHG; qr[i] = p[colq]; kr[i] = p[colk]; vr[i] = p[colv]; } }
    __syncthreads();
#pragma unroll 1
    for (int ch = 0; ch < 36; ++ch) {
        float cum[16]; float cs = 0.f;
#pragma unroll
        for (int i = 0; i < 16; ++i) { cs += __logf(1.0f - bf2f(kr[i])); cum[i] = cs; }
        subtot[I * 128 + col] = cs;
        __syncthreads();
        const float s0 = subtot[col], s1 = subtot[128 + col], s2 = subtot[256 + col], s3 = subtot[384 + col];
        const float pre = (I > 0 ? s0 : 0.f) + (I > 1 ? s1 : 0.f) + (I > 2 ? s2 : 0.f), rho = s0 + s1, tot = (s0 + s1) + (s2 + s3);
        const float erho = __expf(rho), eend = __expf(tot - rho);
        unsigned khp[8], vtp[8];
#pragma unroll
        for (int i = 0; i < 16; ++i) {
            const float bi = pre + cum[i], e1 = __expf(bi - rho), e2 = __expf(rho - bi), qf = bf2f(qr[i]), kf = bf2f(kr[i]);
            const int srow = (16 * I + i) * 272 + col * 2;
            *(LAS bf16_t*)(L + HG_QP + srow) = (bf16_t)f2bf(qf * e1);
            *(LAS bf16_t*)(L + HG_QT + srow) = (bf16_t)f2bf(qf * e1 * erho);
            *(LAS bf16_t*)(L + HG_KP + srow) = (bf16_t)f2bf(kf * e2);
            const unsigned khb = f2bf(kf * e2 * eend);
            if (i & 1) { khp[i >> 1] |= khb << 16; vtp[i >> 1] |= (unsigned)vr[i] << 16; } else { khp[i >> 1] = khb; vtp[i >> 1] = (unsigned)vr[i]; }
        }
        *(LAS u32x4*)(L + HG_KH + col * 144 + I * 32) = (u32x4){khp[0], khp[1], khp[2], khp[3]};
        *(LAS u32x4*)(L + HG_KH + col * 144 + I * 32 + 16) = (u32x4){khp[4], khp[5], khp[6], khp[7]};
        *(LAS u32x4*)(L + HG_VT + col * 144 + I * 32) = (u32x4){vtp[0], vtp[1], vtp[2], vtp[3]};
        *(LAS u32x4*)(L + HG_VT + col * 144 + I * 32 + 16) = (u32x4){vtp[4], vtp[5], vtp[6], vtp[7]};
        if (I == 0) Dv[col] = __expf(tot);
        const int crow0 = chunk_row0(ch);
        if (ch + 1 < 36) { const int row0 = chunk_row0(ch + 1) + rstep * 16 * I;
#pragma unroll
            for (int i = 0; i < 16; ++i) { const bf16_t* p = phg + (size_t)(row0 + rstep * i) * NHG; qr[i] = p[colq]; kr[i] = p[colk]; vr[i] = p[colv]; } }
        __syncthreads();
#pragma unroll 1
        for (int blk = w; blk < 10; blk += 8) {
            const int I2 = blk < 1 ? 0 : (blk < 3 ? 1 : (blk < 6 ? 2 : 3)), J2 = blk - (I2 * (I2 + 1)) / 2;
            f32x4 pa = (f32x4){0.f, 0.f, 0.f, 0.f};
#pragma unroll
            for (int kk = 0; kk < 4; ++kk) {
                const bf16x8 a = *(const LAS bf16x8*)(L + HG_KP + (J2 * 16 + r) * 272 + (32 * kk + 8 * quad) * 2);
                const bf16x8 bq = *(const LAS bf16x8*)(L + HG_QP + (I2 * 16 + r) * 272 + (32 * kk + 8 * quad) * 2);
                pa = __builtin_amdgcn_mfma_f32_16x16x32_bf16(a, bq, pa, 0, 0, 0);
            }
            if (I2 == J2) {
#pragma unroll
                for (int rr = 0; rr < 4; ++rr) if (4 * quad + rr > r) pa[rr] = 0.f;
            }
            u32x2 pw; pw.x = pk2(pa[0], pa[1]); pw.y = pk2(pa[2], pa[3]);
            *(LAS u32x2*)(L + HG_P + (I2 * 16 + r) * 144 + (J2 * 16 + 4 * quad) * 2) = pw;
        }
        __syncthreads();
        {
            bf16x8 sfr[4];
#pragma unroll
            for (int kk = 0; kk < 4; ++kk) sfr[kk] = *(const LAS bf16x8*)(L + HG_ST + (16 * w + r) * 272 + (32 * kk + 8 * quad) * 2);
            const bf16x8 vf0 = *(const LAS bf16x8*)(L + HG_VT + (16 * w + r) * 144 + (8 * quad) * 2);
            const bf16x8 vf1 = *(const LAS bf16x8*)(L + HG_VT + (16 * w + r) * 144 + (32 + 8 * quad) * 2);
#pragma unroll
            for (int I3 = 0; I3 < 4; ++I3) {
                f32x4 oa = (f32x4){0.f, 0.f, 0.f, 0.f};
#pragma unroll
                for (int kk = 0; kk < 4; ++kk) {
                    const bf16x8 bq = *(const LAS bf16x8*)(L + HG_QT + (I3 * 16 + r) * 272 + (32 * kk + 8 * quad) * 2);
                    oa = __builtin_amdgcn_mfma_f32_16x16x32_bf16(sfr[kk], bq, oa, 0, 0, 0);
                }
                { const bf16x8 bp = *(const LAS bf16x8*)(L + HG_P + (I3 * 16 + r) * 144 + (8 * quad) * 2);
                  oa = __builtin_amdgcn_mfma_f32_16x16x32_bf16(vf0, bp, oa, 0, 0, 0); }
                if (I3 >= 2) { const bf16x8 bp = *(const LAS bf16x8*)(L + HG_P + (I3 * 16 + r) * 144 + (32 + 8 * quad) * 2);
                  oa = __builtin_amdgcn_mfma_f32_16x16x32_bf16(vf1, bp, oa, 0, 0, 0); }
                const int row = crow0 + rstep * (16 * I3 + r);
                u32x2 ow; ow.x = pk2(oa[0], oa[1]); ow.y = pk2(oa[2], oa[3]);
                *(u32x2*)(odir + (size_t)row * 512 + h * 128 + 16 * w + 4 * quad) = ow;
            }
#pragma unroll
            for (int t = 0; t < 8; ++t) {
                const f32x4 dd = *(const LAS f32x4*)(L + HG_D + (16 * t + 4 * quad) * 4);
                f32x4 sa = sacc[t] * dd;
                const bf16x8 a0 = *(const LAS bf16x8*)(L + HG_KH + (16 * t + r) * 144 + (8 * quad) * 2);
                const bf16x8 a1 = *(const LAS bf16x8*)(L + HG_KH + (16 * t + r) * 144 + (32 + 8 * quad) * 2);
                sa = __builtin_amdgcn_mfma_f32_16x16x32_bf16(a0, vf0, sa, 0, 0, 0);
                sa = __builtin_amdgcn_mfma_f32_16x16x32_bf16(a1, vf1, sa, 0, 0, 0);
                sacc[t] = sa;
                u32x2 sw; sw.x = pk2(sa[0], sa[1]); sw.y = pk2(sa[2], sa[3]);
                *(LAS u32x2*)(L + HG_ST + (16 * w + r) * 272 + (16 * t + 4 * quad) * 2) = sw;
            }
        }
    }
    __syncthreads();
}
__device__ __forceinline__ void phase_l3(const Ctx& C, int l) {
    if (C.bid < 64) hgrn_mfma(C, C.bid);
    build_twiddles(C, (LAS f32x2*)C.lds);
    __syncthreads();
    unsigned* qh = WSP(unsigned, WS_CTL) + CW_Q + l * 64 + C.rep * 16;
    volatile LAS int* lc = (volatile LAS int*)(C.lds + LDSCTL_OFF);
    const int nitems = HY_ITEMS + (l < DEPTH - 1 ? HYC_ITEMS : 0);
    for (;;) {
        if (C.tid == 0) lc[LC_Q] = (int)__hip_atomic_fetch_add(qh, 1u, __ATOMIC_RELAXED, __HIP_MEMORY_SCOPE_AGENT);
        __syncthreads();
        const int item = lc[LC_Q];
        __syncthreads();
        if (item >= nitems) break;
        Ctx CI = C; { int t_ = C.tid; asm volatile("" : "+v"(t_)); CI.tid = t_; CI.lane = t_ & 63; }
        if (item < HY_ITEMS) hyena_lat(CI, l, item); else hyena_ctx2(CI, l, item - HY_ITEMS);
    }
}
__device__ __forceinline__ void phase_l3b(const Ctx& C, int l) {
    const int gw = C.bid * NWAVES + C.wave, NGW = C.G * NWAVES;
    const bf16_t* od0 = WSP(const bf16_t, WS_ODIR); const bf16_t* od1 = od0 + (size_t)NTOK * 512;
    const bf16_t* phg = WSP(const bf16_t, WS_PHG); bf16_t* Y = WSP(bf16_t, WS_R1);
    const float* nw = C.in[IN_NORMW] + l * 128;
    const int nrows = (l < DEPTH - 1) ? NTOK : NLAT;
    for (int row = gw; row < nrows; row += NGW) {
        const int idx = C.lane * 8;
        const u32x4 a = *(const u32x4*)(od0 + (size_t)row * 512 + idx), b = *(const u32x4*)(od1 + (size_t)row * 512 + idx), g = *(const u32x4*)(phg + (size_t)row * NHG + 1024 + idx);
        float o[8] = {bflo(a.x) + bflo(b.x), bfhi(a.x) + bfhi(b.x), bflo(a.y) + bflo(b.y), bfhi(a.y) + bfhi(b.y), bflo(a.z) + bflo(b.z), bfhi(a.z) + bfhi(b.z), bflo(a.w) + bflo(b.w), bfhi(a.w) + bfhi(b.w)};
        const float gg[8] = {bflo(g.x), bfhi(g.x), bflo(g.y), bfhi(g.y), bflo(g.z), bfhi(g.z), bflo(g.w), bfhi(g.w)};
        float ss = 0.f;
#pragma unroll
        for (int i = 0; i < 8; ++i) ss += o[i] * o[i];
        ss = row16_sum(ss);
        const float rinv = 1.0f / sqrtf(ss * (1.0f / 128.0f) + EPS);
        float y[8];
#pragma unroll
        for (int i = 0; i < 8; ++i) y[i] = o[i] * rinv * nw[(idx + i) & 127] * siluf_(gg[i]);
        u32x4 w; w.x = pk2(y[0], y[1]); w.y = pk2(y[2], y[3]); w.z = pk2(y[4], y[5]); w.w = pk2(y[6], y[7]);
        *(u32x4*)(Y + (size_t)row * D + 512 + idx) = w;
    }
}

constexpr int RW_PITCH = 1028;
__device__ __forceinline__ void phase_l5a(const Ctx& C, int l) {
    LAS float* rwT = (LAS float*)C.lds;
    LAS int* lcnt = (LAS int*)(C.lds + 16 * RW_PITCH * 4);
    LAS float* wsc = (LAS float*)(C.lds + 16 * RW_PITCH * 4 + 128) + C.wave * 384;
    const float* rw = C.in[IN_RW];
    for (int i = C.tid; i < 16 * 1024; i += NTHR) { const int k = i >> 4, e = i & 15; rwT[e * RW_PITCH + k] = rw[i]; }
    if (C.tid < 32) lcnt[C.tid] = 0;
    __syncthreads();
    const int gw = C.bid * NWAVES + C.wave, NGW = C.G * NWAVES;
    const float* mods = WSP(const float, WS_MODS) + (size_t)l * 9 * 6144;
    const float* bias2 = WSP(const float, WS_BIAS2) + l * 9 * 16;
    const float* xb = WSP(const float, WS_XBUF);
    const float* rbias = C.in[IN_RB];
    unsigned* cnt = WSP(unsigned, WS_CTL) + CW_CNT + l * 32 * 64;
    int* tokinfo = WSP(int, WS_TOKINFO);
    const int ngroups = ((l < DEPTH - 1) ? NTOK : NLAT) / 16;
    const int li = C.lane & 15, kq = C.lane >> 4;
    for (int g = gw; g < ngroups; g += NGW) {
        const int row0 = g * 16, bb = bidx(row0);
        const float* xp = xb + (size_t)(row0 + li) * D + kq * 4;
        const float* scp = mods + bb * 6144 + 4096 + kq * 4;
        const LAS float* bp = rwT + li * RW_PITCH + kq * 4;
        f32x4 acc0 = (f32x4){0.f, 0.f, 0.f, 0.f}, acc1 = acc0, acc2 = acc0, acc3 = acc0; float ss = 0.f;
#pragma unroll 8
        for (int m = 0; m < 64; ++m) {
            const f32x4 xv = *(const f32x4*)(xp + 16 * m), sc = *(const f32x4*)(scp + 16 * m), bv = *(const LAS f32x4*)(bp + 16 * m);
            ss += (xv.x * xv.x + xv.y * xv.y) + (xv.z * xv.z + xv.w * xv.w);
            const f32x4 av = xv * (sc + 1.0f);
            acc0 = __builtin_amdgcn_mfma_f32_16x16x4f32(av.x, bv.x, acc0, 0, 0, 0);
            acc1 = __builtin_amdgcn_mfma_f32_16x16x4f32(av.y, bv.y, acc1, 0, 0, 0);
            acc2 = __builtin_amdgcn_mfma_f32_16x16x4f32(av.z, bv.z, acc2, 0, 0, 0);
            acc3 = __builtin_amdgcn_mfma_f32_16x16x4f32(av.w, bv.w, acc3, 0, 0, 0);
        }
        const f32x4 acc = (acc0 + acc1) + (acc2 + acc3);
        wsc[C.lane] = ss;
#pragma unroll
        for (int r = 0; r < 4; ++r) wsc[64 + (4 * kq + r) * 17 + li] = acc[r];
        LDS_WAIT(); asm volatile("" ::: "memory");
        if (C.lane < 16) {
            const int row = row0 + C.lane;
            const float sst = (wsc[C.lane] + wsc[16 + C.lane]) + (wsc[32 + C.lane] + wsc[48 + C.lane]);
            const float rinv = 1.0f / sqrtf(sst * (1.0f / D) + EPS);
            float lg[16];
#pragma unroll
            for (int e = 0; e < 16; ++e) lg[e] = rinv * wsc[64 + C.lane * 17 + e] + bias2[bb * 16 + e];
            float mx = lg[0];
#pragma unroll
            for (int e = 1; e < 16; ++e) mx = fmaxf(mx, lg[e]);
            float sc[16], se = 0.f;
#pragma unroll
            for (int e = 0; e < 16; ++e) { sc[e] = expf(lg[e] - mx); se += sc[e]; }
            float sel[16];
#pragma unroll
            for (int e = 0; e < 16; ++e) { sc[e] = sc[e] / se; sel[e] = sc[e] + rbias[e]; }
            float bestgs = -3.4e38f; int bg = 0; float bs[4], bsc[4];
#pragma unroll
            for (int gg = 0; gg < 4; ++gg) {
                float m1 = -3.4e38f, m2 = -3.4e38f;
#pragma unroll
                for (int i = 0; i < 4; ++i) { const float x = sel[4 * gg + i]; if (x > m1) { m2 = m1; m1 = x; } else if (x > m2) m2 = x; }
                const float gs = m1 + m2;
                if (gs > bestgs) { bestgs = gs; bg = gg;
#pragma unroll
                    for (int i = 0; i < 4; ++i) { bs[i] = sel[4 * gg + i]; bsc[i] = sc[4 * gg + i]; } }
            }
            int i0 = 0; float b0 = bs[0];
#pragma unroll
            for (int i = 1; i < 4; ++i) if (bs[i] > b0) { b0 = bs[i]; i0 = i; }
            int i1 = -1; float b1 = -3.4e38f;
#pragma unroll
            for (int i = 0; i < 4; ++i) if (i != i0 && bs[i] > b1) { b1 = bs[i]; i1 = i; }
            float w0 = 0.f, w1 = 0.f;
#pragma unroll
            for (int i = 0; i < 4; ++i) { if (i == i0) w0 = bsc[i]; if (i == i1) w1 = bsc[i]; }
            const float wn = w0 + w1; w0 /= wn; w1 /= wn;
            const int lo = i0 < i1 ? i0 : i1, hi = i0 < i1 ? i1 : i0;
            const float wlo = i0 < i1 ? w0 : w1, whi = i0 < i1 ? w1 : w0;
            const int bin = bg * 6 + (lo * (7 - lo)) / 2 + (hi - lo - 1);
            const int slot = __hip_atomic_fetch_add(lcnt + bin, 1, __ATOMIC_RELAXED, __HIP_MEMORY_SCOPE_WORKGROUP);
            *(int4*)(tokinfo + (size_t)row * 4) = make_int4(bin, slot, __float_as_int(wlo), __float_as_int(whi));
        }
        LDS_WAIT(); asm volatile("" ::: "memory");
    }
    __syncthreads();
    if (C.tid < NBIN && !C.dry) { const int n = lcnt[C.tid];
        WSP(int, WS_BLKBASE)[C.bid * 32 + C.tid] = n > 0 ? (int)__hip_atomic_fetch_add(cnt + C.tid * 64, (unsigned)n, __ATOMIC_RELAXED, __HIP_MEMORY_SCOPE_AGENT) : 0; }
}
__device__ __forceinline__ void phase_l5b(const Ctx& C, int l) {
    build_tiletab(C, l);
    const volatile LAS int* lc = (const volatile LAS int*)(C.lds + LDSCTL_OFF);
    const int gw = C.bid * NWAVES + C.wave, NGW = C.G * NWAVES;
    const float* mods = WSP(const float, WS_MODS) + (size_t)l * 9 * 6144;
    const float* xb = WSP(const float, WS_XBUF);
    const int* tokinfo = WSP(const int, WS_TOKINFO); const int* blkbase = WSP(const int, WS_BLKBASE);
    bf16_t* hs = WSP(bf16_t, WS_PHG); int* rowtok = WSP(int, WS_ROWTOK); float* roww = WSP(float, WS_ROWW);
    const int nrows = (l < DEPTH - 1) ? NTOK : NLAT;
    f32x4 nv[4]; int4 nti = make_int4(0, 0, 0, 0);
    if (gw < nrows) { nti = *(const int4*)(tokinfo + (size_t)gw * 4);
#pragma unroll
        for (int j = 0; j < 4; ++j) nv[j] = *(const f32x4*)(xb + (size_t)gw * D + C.lane * 4 + 256 * j); }
    for (int row = gw; row < nrows; row += NGW) {
        const int4 ti = nti;
        const int pos = lc[LC_OFFS + ti.x] + blkbase[(((row >> 4) % NGW) >> 3) * 32 + ti.x] + ti.y;
        const float* md = mods + bidx(row) * 6144;
        f32x4 v[4]; float ss = 0.f;
#pragma unroll
        for (int j = 0; j < 4; ++j) v[j] = nv[j];
        if (row + NGW < nrows) { nti = *(const int4*)(tokinfo + (size_t)(row + NGW) * 4);
#pragma unroll
            for (int j = 0; j < 4; ++j) nv[j] = *(const f32x4*)(xb + (size_t)(row + NGW) * D + C.lane * 4 + 256 * j); }
#pragma unroll
        for (int j = 0; j < 4; ++j) ss += (v[j].x * v[j].x + v[j].y * v[j].y) + (v[j].z * v[j].z + v[j].w * v[j].w);
        ss = wave_sum(ss); const float rinv = 1.0f / sqrtf(ss * (1.0f / D) + EPS);
#pragma unroll
        for (int j = 0; j < 4; ++j) { const int k = C.lane * 4 + 256 * j; const f32x4 sh = *(const f32x4*)(md + 3072 + k), sc = *(const f32x4*)(md + 4096 + k);
            const f32x4 o = v[j] * rinv * (sc + 1.0f) + sh; u32x2 w; w.x = pk2(o.x, o.y); w.y = pk2(o.z, o.w);
            *(u32x2*)(hs + (size_t)pos * D + k) = w; }
        if (C.lane == 0) { rowtok[pos] = row; roww[pos * 2] = __int_as_float(ti.z); roww[pos * 2 + 1] = __int_as_float(ti.w); }
    }
    if (C.bid < NBIN) { const int b = C.bid; const int start = lc[LC_OFFS + b], end = lc[LC_OFFS + b + 1];
        const int n = (int)__hip_atomic_load(WSP(unsigned, WS_CTL) + CW_CNT + (l * 32 + b) * 64, __ATOMIC_RELAXED, __HIP_MEMORY_SCOPE_AGENT);
        for (int p = start + n + C.tid; p < end; p += NTHR) { rowtok[p] = -1; roww[p * 2] = 0.f; roww[p * 2 + 1] = 0.f; } }
}

__device__ __forceinline__ void phase_final(const Ctx& C) {
    const int gw = C.bid * NWAVES + C.wave, NGW = C.G * NWAVES;
    const float* xb = WSP(const float, WS_XBUF); const float* fw = C.in[IN_FNW];
    f32x4 nv[4];
    if (gw < NLAT) {
#pragma unroll
        for (int j = 0; j < 4; ++j) nv[j] = *(const f32x4*)(xb + (size_t)gw * D + C.lane * 4 + 256 * j); }
    for (int row = gw; row < NLAT; row += NGW) {
        f32x4 v[4]; float ss = 0.f;
#pragma unroll
        for (int j = 0; j < 4; ++j) v[j] = nv[j];
        if (row + NGW < NLAT) {
#pragma unroll
            for (int j = 0; j < 4; ++j) nv[j] = *(const f32x4*)(xb + (size_t)(row + NGW) * D + C.lane * 4 + 256 * j); }
#pragma unroll
        for (int j = 0; j < 4; ++j) ss += (v[j].x * v[j].x + v[j].y * v[j].y) + (v[j].z * v[j].z + v[j].w * v[j].w);
        ss = wave_sum(ss); const float rinv = 1.0f / sqrtf(ss * (1.0f / D) + EPS);
#pragma unroll
        for (int j = 0; j < 4; ++j) { const int k = C.lane * 4 + 256 * j; const f32x4 w = *(const f32x4*)(fw + k);
            *(f32x4*)(C.out + (size_t)row * D + k) = v[j] * rinv * w; }
    }
}

constexpr int PH_PER_LAYER = 9, N_PHASES = 2 + DEPTH * PH_PER_LAYER + 1;
__global__ void __launch_bounds__(NTHR, 2) trunk_fwd(Args args) {
    extern __shared__ __attribute__((aligned(16))) unsigned char lds[];
    Ctx C; C.in = (const CAS fptr_t*)__builtin_amdgcn_kernarg_segment_ptr(); C.out = args.out; C.ws = args.ws; C.lds = (LAS unsigned char*)lds;
    C.tid = threadIdx.x; C.lane = C.tid & 63; C.wave = __builtin_amdgcn_readfirstlane(C.tid >> 6); C.G = gridDim.x; C.bid = blockIdx.x; C.rep = args.rep; C.dry = (args.rep + 1 < (args.pad & 255)) ? (args.pad >> 8) : 0;
    LAS unsigned char* ldsl0 = (LAS unsigned char*)lds;
    if (C.tid < 64) ((LAS unsigned*)(ldsl0 + LDSCTL_OFF))[C.tid] = 0u;
    __syncthreads();
    const int lo = args.ph_lo, hi = args.ph_hi;
    XcdBarrier bar; bar.bar = WSP(unsigned, WS_CTL) + CW_BAR; bar.x = 0; bar.st = (volatile LAS unsigned*)(ldsl0 + LDSCTL_OFF + LC_BAR);
    if (hi - lo > 1) bar = xcd_barrier_post(WSP(unsigned, WS_CTL) + CW_BAR, (volatile LAS unsigned*)(ldsl0 + LDSCTL_OFF + LC_BAR));
#define IN(k) (lo <= (k) && (k) < hi)
#define SEAM(k) do { if (IN(k) && IN((k) + 1)) xcd_barrier(bar); } while (0)
#ifndef EN
#define EN 0xFFFF
#endif
    if ((EN & 1) && IN(0)) { phase0(C); SEAM(0); }
    if ((EN & 1) && IN(1)) {
        if (C.bid == C.G - 1) {
            const float* md = WSP(const float, WS_MODS); const float* rw = C.in[IN_RW]; float* b2 = WSP(float, WS_BIAS2);
            for (int o = C.tid; o < 4 * 9 * 16; o += NTHR) { const int lr = o >> 4, e = o & 15; const float* sh = md + (size_t)lr * 6144 + 3072; float sacc = 0.f;
                for (int k = 0; k < 1024; ++k) sacc += sh[k] * rw[k * 16 + e];
                b2[o] = sacc; }
        }
        SchedFilt S{C.G, C.bid};
        EpiFilt E{WSP(bf16_t, WS_HF), C.in[IN_B3]};
        pg8::gemm_phase<false>(ldsl0, S, E, (const char*)WSP(bf16_t, WS_W3T), (const char*)WSP(bf16_t, WS_HPAD), 128, 128, 128u * 128u * 2u, 128u * 128u * 2u, 2);
        SEAM(1);
    }
    const Ctx C0 = C;
#pragma unroll 1
    for (int l = 0; l < DEPTH; ++l) {
        const int p0 = 2 + l * PH_PER_LAYER;
        Ctx C = C0; { int t_ = C0.wave * 64 + lane_id_opaque(); asm volatile("" : "+v"(t_)); C.tid = t_; C.lane = t_ & 63; C.wave = __builtin_amdgcn_readfirstlane(t_ >> 6);
                      int b_ = C0.bid; asm volatile("" : "+s"(b_)); C.bid = b_; int g_ = C0.G; asm volatile("" : "+s"(g_)); C.G = g_; unsigned char* w_ = C0.ws; asm volatile("" : "+s"(w_)); C.ws = w_;
                      const CAS fptr_t* i_ = C0.in; asm volatile("" : "+s"(i_)); C.in = i_;
                      LAS unsigned char* l_ = C0.lds; asm volatile("" : "+s"(l_)); C.lds = l_; }
        LAS unsigned char* const ldsl = C.lds;
        const float* modl = WSP(const float, WS_MODS) + (size_t)l * 9 * 6144;
        if ((EN & 2) && IN(p0 + 0)) { phase_l1(C, l); SEAM(p0 + 0); }
        if ((EN & 4) && IN(p0 + 1)) {
            { pg8::SchedDense S; S.init(NTOK / 256, NHG / 256, C.G, C.bid, D, D);
              EpiHG E{WSP(bf16_t, WS_PHG), WSP(const float, WS_LOWER) + l * 512};
              pg8::gemm_phase<false>(ldsl, S, E, (const char*)WSP(bf16_t, WS_R1), (const char*)(WSP(bf16_t, WS_WIN) + (size_t)NHY * D), D, D, 128u * D * 2u, 128u * D * 2u, D / 64); }
            { pg8::SchedDense S; S.init(NHY / 256, NTOK / 256, C.G, C.bid, D, D);
              EpiHY E{WSP(bf16_t, WS_PHYT)};
              pg8::gemm_phase<false>(ldsl, S, E, (const char*)WSP(bf16_t, WS_WIN), (const char*)WSP(bf16_t, WS_R1), D, D, 128u * D * 2u, 128u * D * 2u, D / 64); }
            SEAM(p0 + 1);
        }
        if ((EN & 8) && IN(p0 + 2)) { phase_l3(C, l); SEAM(p0 + 2); }
        if ((EN & 16) && IN(p0 + 3)) { phase_l3b(C, l); SEAM(p0 + 3); }
        if ((EN & 32) && IN(p0 + 4)) {
            pg8::SchedDense S; S.init(NTOK / 256, D / 256, C.G, C.bid, D, D);
            EpiOut E{C.in[IN_X], C.in[IN_CTX], WSP(float, WS_XBUF), modl, l == 0 ? 1 : 0, C.dry};
            pg8::gemm_phase<false>(ldsl, S, E, (const char*)WSP(bf16_t, WS_R1), (const char*)WSP(bf16_t, WS_WOUT), D, D, 128u * D * 2u, 128u * D * 2u, D / 64);
            SEAM(p0 + 4);
        }
        if ((EN & 64) && IN(p0 + 5)) { phase_l5a(C, l); SEAM(p0 + 5); }
        if ((EN & 128) && IN(p0 + 6)) { phase_l5b(C, l); SEAM(p0 + 6); }
        if ((EN & 256) && IN(p0 + 7)) {
            build_tiletab(C, l);
            const volatile LAS int* lc = (const volatile LAS int*)(ldsl + LDSCTL_OFF);
            SchedUp S{lc[LC_T], C.G, C.bid, lc + LC_TILEBIN};
            EpiAct E{WSP(bf16_t, WS_R1), WSP(const float, WS_ROWW)};
            pg8::gemm_phase<false>(ldsl, S, E, (const char*)WSP(bf16_t, WS_PHG), (const char*)WSP(bf16_t, WS_WG), D, D, 128u * D * 2u, (unsigned)(WS_WU - WS_WG), D / 64);
            SEAM(p0 + 7);
        }
        if ((EN & 512) && IN(p0 + 8)) {
            build_tiletab(C, l);
            const volatile LAS int* lc = (const volatile LAS int*)(ldsl + LDSCTL_OFF);
            SchedDown S{lc[LC_T], C.G, C.bid, lc + LC_TILEBIN};
            EpiDown E{WSP(float, WS_XBUF), WSP(const int, WS_ROWTOK), modl, C.dry};
            pg8::gemm_phase<true>(ldsl, S, E, (const char*)WSP(bf16_t, WS_R1), (const char*)WSP(bf16_t, WS_WD), 512, 256, 128u * 512u * 2u, 128u * 256u * 2u, 4);
            SEAM(p0 + 8);
        }
    }
    if ((EN & 1024) && IN(N_PHASES - 1)) { Ctx CF = C0; CF.tid = C0.wave * 64 + lane_id_opaque(); CF.lane = CF.tid & 63; phase_final(CF); }
#undef IN
#undef SEAM
}

extern "C" void kernel_launch(void* const* d_in, const int* in_sizes, int n_in, void* d_out, int out_size, void* d_ws, size_t ws_size, hipStream_t stream) {
    static int grid = 0;
    if (grid == 0) {
        if (n_in != N_IN || in_sizes[0] != NLAT * D || out_size != NLAT * D || ws_size < WS_END) { fprintf(stderr, "kernel_launch: unexpected shapes / workspace (%d inputs, ws %zu < %zu)\n", n_in, ws_size, (size_t)WS_END); grid = -1; return; }
        int dev = 0, cus = 0, per_cu = 0;
        if (hipGetDevice(&dev) != hipSuccess || hipDeviceGetAttribute(&cus, hipDeviceAttributeMultiprocessorCount, dev) != hipSuccess) { grid = -1; return; }
        if (hipFuncSetAttribute((const void*)trunk_fwd, hipFuncAttributeMaxDynamicSharedMemorySize, LDS_BYTES) != hipSuccess) { fprintf(stderr, "kernel_launch: hipFuncSetAttribute failed\n"); grid = -1; return; }
        if (hipOccupancyMaxActiveBlocksPerMultiprocessor(&per_cu, (const void*)trunk_fwd, NTHR, LDS_BYTES) != hipSuccess || per_cu < 1) { fprintf(stderr, "kernel_launch: occupancy query says %d\n", per_cu); }
        (void)hipGetLastError();
        grid = cus;
    }
    if (grid < 0) return;
    (void)hipMemsetAsync((char*)d_ws + WS_CTL, 0, CTL_ZERO_BYTES, stream);
    Args a{};
    for (int i = 0; i < N_IN; ++i) a.in[i] = (const float*)d_in[i];
    a.out = (float*)d_out; a.ws = (unsigned char*)d_ws;
#if MK_PER_PHASE
    for (int p = 0; p < N_PHASES; ++p) { a.ph_lo = p; a.ph_hi = p + 1; const int kind = p == 0 ? 0 : (p == 1 ? 11 : (p == N_PHASES - 1 ? 10 : 1 + (p - 2) % PH_PER_LAYER));
        const int nrep = ((PROBE_HOST >> kind) & 1) ? 2 : 1; a.pad = nrep | (PROBE_SKIP << 8);
        for (int rep = 0; rep < nrep; ++rep) { a.rep = rep; hipLaunchKernelGGL(trunk_fwd, dim3(grid), dim3(NTHR), LDS_BYTES, stream, a); } }
#else
    a.ph_lo = 0; a.ph_hi = N_PHASES; a.rep = 0; a.pad = 1;
    hipLaunchKernelGGL(trunk_fwd, dim3(grid), dim3(NTHR), LDS_BYTES, stream, a);
#endif
}
```

```cpp
#include <hip/hip_runtime.h>
#include <cstdio>
#include <cstdint>

#ifndef PROBE_HOST
#define PROBE_HOST 0
#endif
#ifndef PROBE_SKIP
#define PROBE_SKIP 1
#endif
#ifndef MK_PER_PHASE
#define MK_PER_PHASE 0
#endif

#define LAS __attribute__((address_space(3)))
typedef unsigned short bf16_t;
typedef short bf16x8 __attribute__((ext_vector_type(8)));
typedef float f32x4 __attribute__((ext_vector_type(4)));
typedef float f32x2 __attribute__((ext_vector_type(2)));
typedef unsigned u32x4 __attribute__((ext_vector_type(4)));
typedef unsigned u32x2 __attribute__((ext_vector_type(2)));

constexpr int NB = 8, SEQ = 2048, D = 1024, DEPTH = 4, CTXL = 256;
constexpr int NLAT = NB * SEQ, NCTX = NB * CTXL, NTOK = NLAT + NCTX;
constexpr int DH = 512, NHY = 1536, NHG = 2560, DIN = 4096;
constexpr int NE = 16, DE = 256, NBIN = 24, SROWS = 24576;
constexpr float EPS = 1e-6f;
constexpr int NTHR = 512, NWAVES = 8;
enum { IN_X = 0, IN_C, IN_CTX, IN_CCTX, IN_WMOD, IN_BMOD, IN_WIN, IN_WOUT, IN_CONVW, IN_CONVB, IN_W1, IN_B1, IN_W2, IN_B2, IN_W3, IN_B3,
       IN_HYBIAS, IN_LB, IN_NORMW, IN_RW, IN_RB, IN_WG, IN_WU, IN_WD, IN_FNW, N_IN };

constexpr size_t MiB = 1u << 20;
constexpr size_t WS_CTL = 0, CTL_ZERO_BYTES = 1 * MiB;
constexpr size_t WS_MODS = 1 * MiB;
constexpr size_t WS_LOWER = 2 * MiB;
constexpr size_t WS_BIAS2 = 2 * MiB + 64 * 1024;
constexpr size_t WS_HPAD = 3 * MiB;
constexpr size_t WS_TOKINFO = 6 * MiB;
constexpr size_t WS_BLKBASE = 6 * MiB + 320 * 1024;
constexpr size_t WS_ROWTOK = 6 * MiB + 512 * 1024;
constexpr size_t WS_ROWW = 7 * MiB;
constexpr size_t WS_WIN = 8 * MiB;
constexpr size_t WS_WOUT = 16 * MiB;
constexpr size_t WS_WG = 18 * MiB;
constexpr size_t WS_WU = 26 * MiB;
constexpr size_t WS_WD = 34 * MiB;
constexpr size_t WS_KSPEC = 42 * MiB;
constexpr size_t WS_XBUF = 74 * MiB;
constexpr size_t WS_R1 = 146 * MiB;
constexpr size_t WS_PHG = 182 * MiB;
constexpr size_t WS_PHYT = 272 * MiB;
constexpr size_t WS_ODIR = 326 * MiB;
constexpr size_t WS_KSPC = 362 * MiB;
constexpr size_t WS_W3T = 378 * MiB;
constexpr size_t WS_HF = 380 * MiB;
constexpr size_t WS_END = 416 * MiB;
constexpr int CW_BAR = 4096;
constexpr int CW_CNT = 16384;
constexpr int CW_T6 = 65536;
constexpr int CW_Q = 32768;

constexpr int LDS_BYTES = 147456;
constexpr int LDSCTL_OFF = 143 * 1024;
constexpr int LC_BAR = 0;
constexpr int LC_T = 8;
constexpr int LC_Q = 9;
constexpr int LC_OFFS = 16;
constexpr int LC_TILEBIN = 48;

__device__ __forceinline__ unsigned f2bf(float f) { unsigned u = __builtin_bit_cast(unsigned, f); return (u + 0x7fffu + ((u >> 16) & 1u)) >> 16; }
__device__ __forceinline__ unsigned pk2(float lo, float hi) { return f2bf(lo) | (f2bf(hi) << 16); }
__device__ __forceinline__ float bf2f(unsigned b) { return __builtin_bit_cast(float, (b & 0xffffu) << 16); }
__device__ __forceinline__ float bflo(unsigned w) { return __builtin_bit_cast(float, w << 16); }
__device__ __forceinline__ float bfhi(unsigned w) { return __builtin_bit_cast(float, w & 0xffff0000u); }
__device__ __forceinline__ float sigmoidf_(float x) { return 1.0f / (1.0f + __expf(-x)); }
__device__ __forceinline__ float siluf_(float x) { return x / (1.0f + __expf(-x)); }
#define DPP_ADD(v, ctrl, rmask) v += __builtin_bit_cast(float, __builtin_amdgcn_update_dpp(0, __builtin_bit_cast(int, v), ctrl, rmask, 0xF, false))
__device__ __forceinline__ float row16_sum(float v) {
    DPP_ADD(v, 0xB1, 0xF);
    DPP_ADD(v, 0x4E, 0xF);
    DPP_ADD(v, 0x141, 0xF);
    DPP_ADD(v, 0x140, 0xF);
    return v;
}
__device__ __forceinline__ float wave_sum(float v) {
    v = row16_sum(v);
    DPP_ADD(v, 0x142, 0xA);
    DPP_ADD(v, 0x143, 0xC);
    return __builtin_bit_cast(float, __builtin_amdgcn_readlane(__builtin_bit_cast(int, v), 63));
}
__device__ __forceinline__ int lane_id_opaque() { int x; asm volatile("v_mbcnt_lo_u32_b32 %0, -1, 0\n\tv_mbcnt_hi_u32_b32 %0, -1, %0" : "=v"(x)); return x; }
__device__ __forceinline__ int bidx(int row) { return row < NLAT ? (row >> 11) : 8; }
#define LDS_WAIT() asm volatile("s_waitcnt lgkmcnt(0)" ::: "memory")

#define XB_TMO      128
#define XB_XCNT(j)  (256  + 64 * (j))
#define XB_XSUB(j)  (1280 + 64 * (j))
#define XB_XGEN(j)  (2304 + 64 * (j))
#define XB_TOP      3328
#define XB_TOPGEN   3392
#define XCD_BAR_WORDS 3456
#define XB_SPIN_CAP (1u << 18)
__device__ __forceinline__ unsigned xb_ld(unsigned* p)              { return __hip_atomic_load(p, __ATOMIC_RELAXED, __HIP_MEMORY_SCOPE_AGENT); }
__device__ __forceinline__ unsigned xb_add(unsigned* p, unsigned v) { return __hip_atomic_fetch_add(p, v, __ATOMIC_RELAXED, __HIP_MEMORY_SCOPE_AGENT); }
__device__ __forceinline__ unsigned xb_xcc_id() { return (unsigned)__builtin_amdgcn_s_getreg((3 << 11) | 20) & 0xFu; }
#define XB_SPIN(cond, bar) do { unsigned _sp = 0; while (cond) { __builtin_amdgcn_s_sleep(1); \
    if ((++_sp & 255u) == 0u) { if (xb_ld(&(bar)[XB_TMO])) break; if (_sp > XB_SPIN_CAP) { atomicAdd(&(bar)[XB_TMO], 1u); break; } } } } while (0)
struct XcdBarrier { unsigned* bar; unsigned x; volatile LAS unsigned* st; };
__device__ __forceinline__ XcdBarrier xcd_barrier_post(unsigned* bar, volatile LAS unsigned* st) {
    XcdBarrier b; b.bar = bar; b.x = xb_xcc_id(); b.st = st;
    if (threadIdx.x == 0) (void)xb_add(&bar[XB_XCNT(b.x)], 1u);
    return b;
}
__device__ __forceinline__ void xcd_barrier_complete(unsigned* bar, unsigned x, unsigned& nloc, unsigned& nx) {
    const unsigned G = gridDim.x * gridDim.y * gridDim.z;
    unsigned sum, cnt, mine, sp = 0u;
    for (;;) {
        sum = 0u; cnt = 0u; mine = 0u;
#pragma unroll
        for (unsigned j = 0; j < 16; ++j) { const unsigned c = xb_ld(&bar[XB_XCNT(j)]); sum += c; cnt += (c > 0u) ? 1u : 0u; mine = (j == x) ? c : mine; }
        if (sum == G) break;
        __builtin_amdgcn_s_sleep(1);
        if ((++sp & 255u) == 0u) { if (xb_ld(&bar[XB_TMO])) break; if (sp > XB_SPIN_CAP) { atomicAdd(&bar[XB_TMO], 1u); break; } }
    }
    nloc = mine > 0u ? mine : 1u; nx = cnt > 0u ? cnt : 1u;
}
__device__ __forceinline__ void xcd_barrier(const XcdBarrier& b, const int tid0) {
    asm volatile("s_waitcnt vmcnt(0)" ::: "memory");
    __syncthreads();
    if (tid0 == 0) {
        unsigned* bar = b.bar; unsigned bx = b.x;
        asm volatile("" : "+s"(bar), "+s"(bx));
        __builtin_amdgcn_s_waitcnt(0);
        unsigned nloc = b.st[0], nx = b.st[1];
        if (nloc == 0u) { xcd_barrier_complete(bar, bx, nloc, nx); b.st[0] = nloc; b.st[1] = nx; }
        const unsigned old = xb_add(&bar[XB_XSUB(bx)], 1u);
        const unsigned gen = old / nloc;
        if (old + 1u == (gen + 1u) * nloc) {
            __builtin_amdgcn_fence(__ATOMIC_RELEASE, "agent");
            asm volatile("s_waitcnt vmcnt(0)" ::: "memory");
            const unsigned og = xb_add(&bar[XB_TOP], 1u);
            const unsigned tg = og / nx;
            if (og + 1u == (tg + 1u) * nx) xb_add(&bar[XB_TOPGEN], 1u);
            else XB_SPIN(xb_ld(&bar[XB_TOPGEN]) == tg, bar);
            __builtin_amdgcn_fence(__ATOMIC_ACQUIRE, "agent");
            xb_add(&bar[XB_XGEN(bx)], 1u);
            asm volatile("s_waitcnt vmcnt(0)" ::: "memory");
        } else {
            XB_SPIN(xb_ld(&bar[XB_XGEN(bx)]) == gen, bar);
            __builtin_amdgcn_fence(__ATOMIC_ACQUIRE, "agent");
            asm volatile("s_waitcnt vmcnt(0)" ::: "memory");
        }
    }
    __syncthreads();
}

namespace pg8 {
constexpr int BM = 256, BK = 64, HALF = 128, HTB = HALF * BK * 2, STAGE_BYTES = 8 * HTB, NXCD = 8, WGM = 8;
__host__ __device__ __forceinline__ int lds_byte(int r, int c) { const int st = (r >> 4) * 2 + (c >> 5), rr = r & 15, cc = c & 31, ob = rr * 64 + cc * 2; return st * 1024 + (ob ^ (((ob >> 9) & 1) << 5)); }
__host__ __device__ __forceinline__ void stage_rc(int b, int& R, int& C) { const int st = b / 1024, sb = b % 1024, swz = sb ^ (((sb >> 9) & 1) << 5); R = (st >> 1) * 16 + swz / 64; C = (st & 1) * 32 + (swz % 64) / 2; }
__host__ __device__ __forceinline__ int perm32(int rho) { const int n = rho >> 4, i = rho & 15; return 8 * (i >> 2) + 4 * n + (i & 3); }

struct GUnit { unsigned a, b; int last, i0, i1; };

template <bool SUB, class Epi, class Sched>
__device__ __forceinline__ void gemm_phase(LAS unsigned char* lds, const Sched& S, const Epi& E, const char* Abase, const char* Bbase, const int lda, const int ldb, const unsigned ahalf, const unsigned bhalf, const int nt, const int tid_in) {
    int tid_ = tid_in; asm volatile("" : "+v"(tid_));
    const int tid = tid_, wid = __builtin_amdgcn_readfirstlane(tid >> 6), lane = tid & 63, wr = wid >> 2, wc = wid & 3, fr = lane & 15, fq = lane >> 4;
    unsigned voffA[2], voffB[2];
#pragma unroll
    for (int i = 0; i < 2; ++i) { int R, C; stage_rc(tid * 16 + i * 8192, R, C); const int Rb = Epi::PERM ? ((R & ~31) + perm32(R & 31)) : R;
        voffA[i] = (unsigned)(R * lda + C) * 2u; voffB[i] = (unsigned)(Rb * ldb + C) * 2u; }
    constexpr unsigned kstep = BK * 2;
    const unsigned ldsw = (unsigned)wid * 1024u;
    const int aoff = lds_byte(wr * 64 + fr, fq * 8), boff = lds_byte(wc * 32 + fr, fq * 8);
#define PG8_SA(b, h) (((b) * 2 + (h)) * HTB)
#define PG8_SB(b, h) ((4 + (b) * 2 + (h)) * HTB)
#define PG8_STAGE(bufoff, gbase, voff) do { _Pragma("unroll") for (int _i = 0; _i < 2; ++_i) \
        __builtin_amdgcn_global_load_lds((const unsigned*)((const char*)(gbase) + (voff)[_i]), (LAS unsigned*)(lds + (bufoff) + ldsw + _i * 8192), 16, 0, 0); } while (0)
#define PG8_LDA(dst, b, h) do { _Pragma("unroll") for (int m = 0; m < 4; ++m) _Pragma("unroll") for (int k = 0; k < 2; ++k) dst[m][k] = *(const LAS bf16x8*)(lds + PG8_SA(b, h) + aoff + m * 2048 + k * 1024); } while (0)
#define PG8_LDB(dst, b, h) do { _Pragma("unroll") for (int n = 0; n < 2; ++n) _Pragma("unroll") for (int k = 0; k < 2; ++k) dst[n][k] = *(const LAS bf16x8*)(lds + PG8_SB(b, h) + boff + n * 2048 + k * 1024); } while (0)
#define PG8_MMA(ai, bj, At, Bt) do { __builtin_amdgcn_s_setprio(1); _Pragma("unroll") for (int m = 0; m < 4; ++m) _Pragma("unroll") for (int n = 0; n < 2; ++n) _Pragma("unroll") for (int k = 0; k < 2; ++k) \
        acc[ai][bj][m][n] = __builtin_amdgcn_mfma_f32_16x16x32_bf16(Bt[n][k], At[m][k], acc[ai][bj][m][n], 0, 0, 0); __builtin_amdgcn_s_setprio(0); } while (0)
#define PG8_WAIT_V(n) asm volatile("s_waitcnt vmcnt(" #n ")" ::: "memory")
#define PG8_WAIT_L(n) asm volatile("s_waitcnt lgkmcnt(" #n ")" ::: "memory")
#define PG8_BAR __builtin_amdgcn_s_barrier()
#define PG8_SCHED __builtin_amdgcn_sched_barrier(0)
    GUnit cur, nxt; int ui = 0;
    if (!S.next(0, cur)) return;
    f32x4 acc[2][2][4][2];
    float zf_ = 0.f; asm volatile("" : "+v"(zf_));
#pragma unroll
    for (int a = 0; a < 2; ++a)
#pragma unroll
        for (int b = 0; b < 2; ++b)
#pragma unroll
            for (int m = 0; m < 4; ++m)
#pragma unroll
                for (int n = 0; n < 2; ++n) acc[a][b][m][n] = (f32x4){zf_, zf_, zf_, zf_};
    bf16x8 At[4][2], B0[2][2], B1[2][2];
    { const char* cA = Abase + cur.a; const char* cB = Bbase + cur.b;
      PG8_STAGE(PG8_SB(0, 0), cB, voffB); PG8_STAGE(PG8_SB(0, 1), cB + bhalf, voffB); PG8_STAGE(PG8_SA(0, 0), cA, voffA); PG8_STAGE(PG8_SA(0, 1), cA + ahalf, voffA);
      if (wr == 1) PG8_BAR;
      PG8_WAIT_V(2); PG8_BAR;
      PG8_STAGE(PG8_SB(1, 0), cB + kstep, voffB); PG8_STAGE(PG8_SA(1, 0), cA + kstep, voffA); PG8_STAGE(PG8_SB(1, 1), cB + bhalf + kstep, voffB);
      PG8_WAIT_V(6); PG8_BAR; }
    for (;;) {
        const bool has_next = S.next(ui + 1, nxt);
        const char* cA = Abase + cur.a; const char* cB = Bbase + cur.b;
        const char* nA = Abase + (has_next ? nxt.a : cur.a); const char* nB = Bbase + (has_next ? nxt.b : cur.b);
        for (int t = 0; t < nt; t += 2) {
            const bool last = (t == nt - 2);
            const char* a1 = cA + (unsigned)(t + 1) * kstep;
            const char* a2 = last ? nA : cA + (unsigned)(t + 2) * kstep; const char* b2 = last ? nB : cB + (unsigned)(t + 2) * kstep;
            const char* a3 = a2 + kstep; const char* b3 = b2 + kstep;
            PG8_LDB(B0, 0, 0); PG8_LDB(B1, 0, 1); PG8_SCHED; PG8_LDA(At, 0, 0); PG8_STAGE(PG8_SA(1, 1), a1 + ahalf, voffA);
            PG8_WAIT_V(8); PG8_WAIT_L(0); PG8_BAR; PG8_MMA(0, 0, At, B0); PG8_MMA(0, 1, At, B1); PG8_BAR; PG8_SCHED;
            PG8_LDA(At, 0, 1); PG8_STAGE(PG8_SB(0, 0), b2, voffB); PG8_STAGE(PG8_SB(0, 1), b2 + bhalf, voffB); PG8_STAGE(PG8_SA(0, 0), a2, voffA);
            PG8_WAIT_V(8); PG8_WAIT_L(0); PG8_BAR; PG8_MMA(1, 0, At, B0); PG8_MMA(1, 1, At, B1); PG8_BAR; PG8_SCHED;
            PG8_LDB(B0, 1, 0); PG8_LDB(B1, 1, 1); PG8_SCHED; PG8_LDA(At, 1, 0); PG8_STAGE(PG8_SA(0, 1), a2 + ahalf, voffA);
            PG8_WAIT_V(8); PG8_WAIT_L(0); PG8_BAR; PG8_MMA(0, 0, At, B0); PG8_MMA(0, 1, At, B1); PG8_BAR; PG8_SCHED;
            PG8_LDA(At, 1, 1); PG8_STAGE(PG8_SB(1, 0), b3, voffB); PG8_STAGE(PG8_SB(1, 1), b3 + bhalf, voffB); PG8_STAGE(PG8_SA(1, 0), a3, voffA);
            PG8_WAIT_V(8); PG8_WAIT_L(0); PG8_BAR; PG8_MMA(1, 0, At, B0); PG8_MMA(1, 1, At, B1); PG8_BAR; PG8_SCHED;
        }
        const bool fin = SUB ? (cur.last != 0) : true;
        if (fin) { if (wr == 0) PG8_BAR; E(acc, cur, wr, wc, fr, fq); }
        if (!has_next) break;
        if (fin) {
#pragma unroll
            for (int a = 0; a < 2; ++a)
#pragma unroll
                for (int b = 0; b < 2; ++b)
#pragma unroll
                    for (int m = 0; m < 4; ++m)
#pragma unroll
                        for (int n = 0; n < 2; ++n) acc[a][b][m][n] = (f32x4){zf_, zf_, zf_, zf_};
        }
        cur = nxt; ++ui;
        if (fin) { if (wr == 1) PG8_BAR; }
    }
    PG8_WAIT_V(0);
    PG8_BAR;
#undef PG8_SA
#undef PG8_SB
#undef PG8_STAGE
#undef PG8_LDA
#undef PG8_LDB
#undef PG8_MMA
#undef PG8_WAIT_V
#undef PG8_WAIT_L
#undef PG8_BAR
#undef PG8_SCHED
}

struct SchedDense {
    int nM, nN, nwg, G, c; unsigned atile, btile;
    __device__ __forceinline__ void init(int nM_, int nN_, int G_, int c_, int lda, int ldb) {
        nM = nM_; nN = nN_; nwg = nM * nN; G = G_; c = c_; atile = 256u * lda * 2u; btile = 256u * ldb * 2u; }
    __device__ __forceinline__ bool next(int i, GUnit& u) const {
        const int L = i * G + c; if (L >= nwg) return false;
        int wgid = L; { const int q = nwg / NXCD, r = nwg % NXCD, xcd = wgid % NXCD, off = wgid / NXCD; wgid = (xcd < r ? xcd * (q + 1) : r * (q + 1) + (xcd - r) * q) + off; }
        const int nig = WGM * nN, gid = wgid / nig, fm = gid * WGM, gsz = (nM - fm) < WGM ? (nM - fm) : WGM;
        const int pm = fm + ((wgid % nig) % gsz), pn = (wgid % nig) / gsz;
        u.a = (unsigned)pm * atile; u.b = (unsigned)pn * btile; u.last = 1; u.i0 = pm; u.i1 = pn; return true;
    }
};
}

struct Args { const float* in[N_IN]; float* out; unsigned char* ws; int ph_lo, ph_hi, rep, pad; };
static_assert(sizeof(Args) == N_IN * 8 + 8 + 8 + 16, "Args has no padding");

#define CAS __attribute__((address_space(4)))
typedef const float* fptr_t;
struct Ctx {
    const CAS fptr_t* in; float* out; unsigned char* ws; LAS unsigned char* lds; int tid, lane, wave, G, bid, rep, dry;
};
#define WSP(T, off) ((T*)(C.ws + (off)))

__device__ __forceinline__ void build_tiletab(const Ctx& C, int l) {
    volatile LAS int* lc = (volatile LAS int*)(C.lds + LDSCTL_OFF);
    __syncthreads();
    if (C.tid == 0) {
        const unsigned* cnt = WSP(const unsigned, WS_CTL) + CW_CNT + l * 32 * 64;
        int off = 0, t = 0;
        for (int b = 0; b < NBIN; ++b) {
            const int n = (int)__hip_atomic_load(cnt + b * 64, __ATOMIC_RELAXED, __HIP_MEMORY_SCOPE_AGENT);
            lc[LC_OFFS + b] = off;
            const int nt = (n + 255) >> 8;
            for (int k = 0; k < nt; ++k) lc[LC_TILEBIN + t + k] = b;
            t += nt; off += nt * 256;
        }
        lc[LC_OFFS + NBIN] = off; lc[LC_T] = t;
    }
    __syncthreads();
}
__device__ __forceinline__ int expert_of(int bin, int es) {
    const int g = bin / 6, p = bin - g * 6;
    const int lo = p < 3 ? 0 : (p < 5 ? 1 : 2), hi = p < 3 ? p + 1 : (p < 5 ? p - 1 : 3);
    return 4 * g + (es ? hi : lo);
}

struct SchedUp {
    int T, G, c; const volatile LAS int* tilebin;
    __device__ __forceinline__ bool next(int i, pg8::GUnit& u) const {
        const int idx = i * G + c; if (idx >= 4 * T) return false;
        const int rt = idx >> 2, q = idx & 3, es = q >> 1, fb = q & 1;
        const int bin = __builtin_amdgcn_readfirstlane(tilebin[rt]);
        const int e = expert_of(bin, es);
        u.a = (unsigned)rt * 256u * 2048u; u.b = (unsigned)(e * 256 + fb * 128) * 2048u;
        u.last = 1; u.i0 = rt; u.i1 = q; return true;
    }
};
struct SchedDown {
    int T, G, c; const volatile LAS int* tilebin;
    __device__ __forceinline__ bool next(int i, pg8::GUnit& u) const {
        const int idx = (i >> 1) * G + c, sub = i & 1; if (idx >= 4 * T) return false;
        const int rt = idx >> 2, pn = idx & 3;
        const int bin = __builtin_amdgcn_readfirstlane(tilebin[rt]);
        const int e = expert_of(bin, sub);
        u.a = (unsigned)rt * 256u * 1024u + (unsigned)sub * 512u; u.b = (unsigned)(e * 1024 + pn * 256) * 512u;
        u.last = sub; u.i0 = rt; u.i1 = pn; return true;
    }
};

struct SchedUp1 {
    int idx; const volatile LAS int* tilebin;
    __device__ __forceinline__ bool next(int i, pg8::GUnit& u) const {
        if (i != 0) return false;
        const int rt = idx >> 2, q = idx & 3, es = q >> 1, fb = q & 1;
        const int bin = __builtin_amdgcn_readfirstlane(tilebin[rt]);
        const int e = expert_of(bin, es);
        u.a = (unsigned)rt * 256u * 2048u; u.b = (unsigned)(e * 256 + fb * 128) * 2048u;
        u.last = 1; u.i0 = rt; u.i1 = q; return true;
    }
};
struct SchedDown1 {
    int idx; const volatile LAS int* tilebin;
    __device__ __forceinline__ bool next(int i, pg8::GUnit& u) const {
        if (i > 1) return false;
        const int sub = i, rt = idx >> 2, pn = idx & 3;
        const int bin = __builtin_amdgcn_readfirstlane(tilebin[rt]);
        const int e = expert_of(bin, sub);
        u.a = (unsigned)rt * 256u * 1024u + (unsigned)sub * 512u; u.b = (unsigned)(e * 1024 + pn * 256) * 512u;
        u.last = sub; u.i0 = rt; u.i1 = pn; return true;
    }
};

struct EpiHG {
    static constexpr bool PERM = true;
    bf16_t* O; const float* lower;
    __device__ __forceinline__ void operator()(const f32x4 (&acc)[2][2][4][2], const pg8::GUnit& u, int wr, int wc, int fr, int fq) const {
        const int kind = u.i1 >> 1;
        const int row0 = u.i0 * 256 + wr * 64 + fr, colt = u.i1 * 256 + wc * 32 + 8 * fq;
#pragma unroll
        for (int bj = 0; bj < 2; ++bj) {
            const int col = colt + bj * 128;
            float om[8];
#pragma unroll
            for (int j = 0; j < 8; ++j) om[j] = 1.f;
            if (kind >= 3) { const float* lb = lower + (kind - 3) * 2048 + (col & 511);
#pragma unroll
                for (int j = 0; j < 8; ++j) om[j] = 1.f - lb[j]; }
#pragma unroll
            for (int ai = 0; ai < 2; ++ai)
#pragma unroll
                for (int m = 0; m < 4; ++m) {
                    float v[8];
#pragma unroll
                    for (int j = 0; j < 8; ++j) v[j] = acc[ai][bj][m][j >> 2][j & 3];
                    if (kind == 0) {
#pragma unroll
                        for (int j = 0; j < 8; ++j) v[j] = siluf_(v[j]);
                    } else if (kind >= 3) {
#pragma unroll
                        for (int j = 0; j < 8; ++j) v[j] = om[j] * sigmoidf_(-v[j]);
                    }
                    u32x4 w; w.x = pk2(v[0], v[1]); w.y = pk2(v[2], v[3]); w.z = pk2(v[4], v[5]); w.w = pk2(v[6], v[7]);
                    *(u32x4*)(O + (size_t)(row0 + ai * 128 + m * 16) * NHG + col) = w;
                }
        }
    }
};
struct EpiHY {
    static constexpr bool PERM = true;
    bf16_t* O;
    __device__ __forceinline__ void operator()(const f32x4 (&acc)[2][2][4][2], const pg8::GUnit& u, int wr, int wc, int fr, int fq) const {
        const int row0 = u.i0 * 256 + wr * 64 + fr, colt = u.i1 * 256 + wc * 32 + 8 * fq;
#pragma unroll
        for (int ai = 0; ai < 2; ++ai)
#pragma unroll
            for (int m = 0; m < 4; ++m)
#pragma unroll
                for (int bj = 0; bj < 2; ++bj) {
                    const f32x4 v0 = acc[ai][bj][m][0], v1 = acc[ai][bj][m][1];
                    u32x4 w; w.x = pk2(v0[0], v0[1]); w.y = pk2(v0[2], v0[3]); w.z = pk2(v1[0], v1[1]); w.w = pk2(v1[2], v1[3]);
                    *(u32x4*)(O + (size_t)(row0 + ai * 128 + m * 16) * NTOK + colt + bj * 128) = w;
                }
    }
};
struct EpiOut {
    static constexpr bool PERM = false;
    const float* xlat; const float* xctx; float* xo; const float* mods; int first; int dry;
    __device__ __forceinline__ void operator()(const f32x4 (&acc)[2][2][4][2], const pg8::GUnit& u, int wr, int wc, int fr, int fq) const {
        const int row0 = u.i0 * 256 + wr * 64 + fr, col0 = u.i1 * 256 + wc * 32 + 4 * fq;
#pragma unroll
        for (int ai = 0; ai < 2; ++ai)
#pragma unroll
            for (int m = 0; m < 4; ++m) {
                const int row = row0 + ai * 128 + m * 16;
                const float* src = first ? (row < NLAT ? xlat + (size_t)row * D : xctx + (size_t)(row - NLAT) * D) : xo + (size_t)row * D;
                const float* g1 = mods + bidx(row) * 6144 + 2048;
#pragma unroll
                for (int bj = 0; bj < 2; ++bj)
#pragma unroll
                    for (int n = 0; n < 2; ++n) { const int col = col0 + bj * 128 + n * 16;
                        const f32x4 xv = *(const f32x4*)(src + col), gv = *(const f32x4*)(g1 + col);
                        if (!dry) *(f32x4*)(xo + (size_t)row * D + col) = xv + gv * acc[ai][bj][m][n]; }
            }
    }
};
struct EpiAct {
    static constexpr bool PERM = true;
    bf16_t* O; const float* roww;
    __device__ __forceinline__ void operator()(const f32x4 (&acc)[2][2][4][2], const pg8::GUnit& u, int wr, int wc, int fr, int fq) const {
        const int es = u.i1 >> 1; const int pos0 = u.i0 * 256 + wr * 64 + fr, col = u.i1 * 128 + wc * 32 + 8 * fq;
        const __amdgpu_buffer_rsrc_t rsrc = __builtin_amdgcn_make_buffer_rsrc(O, 0, SROWS * 512 * 2, 0x00020000);
#pragma unroll
        for (int ai = 0; ai < 2; ++ai)
#pragma unroll
            for (int m = 0; m < 4; ++m) {
                const int pos = pos0 + ai * 128 + m * 16;
                const float wgt = roww[pos * 2 + es];
                float v[8];
#pragma unroll
                for (int j = 0; j < 8; ++j) v[j] = siluf_(acc[ai][0][m][j >> 2][j & 3]) * acc[ai][1][m][j >> 2][j & 3] * wgt;
                u32x4 w; w.x = pk2(v[0], v[1]); w.y = pk2(v[2], v[3]); w.z = pk2(v[4], v[5]); w.w = pk2(v[6], v[7]);
                __builtin_amdgcn_raw_buffer_store_b128(w, rsrc, (unsigned)(pos * 512 + col) * 2u, 0, 16);
            }
    }
};
struct EpiDown {
    static constexpr bool PERM = false;
    float* xo; const int* rowtok; const float* mods; int dry;
    __device__ __forceinline__ void operator()(const f32x4 (&acc)[2][2][4][2], const pg8::GUnit& u, int wr, int wc, int fr, int fq) const {
        const int pos0 = u.i0 * 256 + wr * 64 + fr, col0 = u.i1 * 256 + wc * 32 + 4 * fq;
#pragma unroll
        for (int ai = 0; ai < 2; ++ai)
#pragma unroll
            for (int m = 0; m < 4; ++m) {
                const int tok = rowtok[pos0 + ai * 128 + m * 16];
                if (tok >= 0) {
                    const float* g2 = mods + bidx(tok) * 6144 + 5120;
                    float* xr = xo + (size_t)tok * D;
#pragma unroll
                    for (int bj = 0; bj < 2; ++bj)
#pragma unroll
                        for (int n = 0; n < 2; ++n) { const int col = col0 + bj * 128 + n * 16;
                            const f32x4 xv = *(const f32x4*)(xr + col), gv = *(const f32x4*)(g2 + col);
                            if (!dry) *(f32x4*)(xr + col) = xv + gv * acc[ai][bj][m][n]; }
                }
            }
    }
};

struct SchedFilt {
    int G, c;
    __device__ __forceinline__ bool next(int i, pg8::GUnit& u) const {
        const int idx = i * G + c; if (idx >= 4 * 72) return false;
        const int l = idx / 72, r = idx - l * 72, pm = r / 9, pn = r - pm * 9;
        u.a = (unsigned)(l * 2048 + pm * 256) * 256u; u.b = (unsigned)(l * 2304 + pn * 256) * 256u; u.last = 1; u.i0 = l * 16 + pm; u.i1 = pn; return true;
    }
};
struct EpiFilt {
    static constexpr bool PERM = true;
    bf16_t* HF; const float* b3;
    __device__ __forceinline__ void operator()(const f32x4 (&acc)[2][2][4][2], const pg8::GUnit& u, int wr, int wc, int fr, int fq) const {
        const int l = u.i0 >> 4, pm = u.i0 & 15;
        const int row0 = pm * 256 + wr * 64 + fr, t00 = u.i1 * 256 + wc * 32 + 8 * fq;
#pragma unroll
        for (int ai = 0; ai < 2; ++ai)
#pragma unroll
            for (int m = 0; m < 4; ++m) {
                const int row = row0 + ai * 128 + m * 16, c = row & 511;
                const float delta = fabsf(logf(1e-2f) / 0.3f + (float)c * ((logf(1e-2f) / 1.5f - logf(1e-2f) / 0.3f) / 511.0f));
                const float bias = b3[l * 2048 + row];
#pragma unroll
                for (int bj = 0; bj < 2; ++bj) {
                    const int t0 = t00 + bj * 128;
                    float v[8];
#pragma unroll
                    for (int j = 0; j < 8; ++j) { const int t = t0 + j; const float tn = t < 2048 ? (float)t / 2047.0f : (float)(t - 2048) / 255.0f;
                        v[j] = (acc[ai][bj][m][j >> 2][j & 3] + bias) * expf(-tn * delta); }
                    u32x4 w; w.x = pk2(v[0], v[1]); w.y = pk2(v[2], v[3]); w.z = pk2(v[4], v[5]); w.w = pk2(v[6], v[7]);
                    *(u32x4*)(HF + ((size_t)(l * 2048 + row)) * 2304 + t0) = w;
                }
            }
    }
};

__device__ __forceinline__ int padx(int i) { return i + (i >> 3); }
__device__ __forceinline__ f32x2 cmul(f32x2 a, f32x2 b) { return (f32x2){a.x * b.x - a.y * b.y, a.x * b.y + a.y * b.x}; }
__device__ __forceinline__ f32x2 cmulc(f32x2 a, f32x2 b) { return (f32x2){a.x * b.x + a.y * b.y, a.y * b.x - a.x * b.y}; }
constexpr int XPAD = 2048 + 256;

__device__ __forceinline__ void fft_p1_dif(f32x2 (&v)[8], int tt, const LAS f32x2* T) {
#pragma unroll
    for (int g = 0; g < 2; ++g) { const int u = tt + 256 * g;
#pragma unroll
        for (int j = 0; j < 2; ++j) { const f32x2 a = v[g + 2 * j], b = v[g + 2 * j + 4]; v[g + 2 * j] = a + b; v[g + 2 * j + 4] = cmul(a - b, T[2 * (u + 512 * j)]); }
        const f32x2 tw = T[4 * u];
        { const f32x2 a = v[g], b = v[g + 2]; v[g] = a + b; v[g + 2] = cmul(a - b, tw); }
        { const f32x2 a = v[g + 4], b = v[g + 6]; v[g + 4] = a + b; v[g + 6] = cmul(a - b, tw); } }
}
__device__ __forceinline__ void fft_p1_dit(f32x2 (&v)[8], int tt, const LAS f32x2* T) {
#pragma unroll
    for (int g = 0; g < 2; ++g) { const int u = tt + 256 * g;
        const f32x2 tw = T[4 * u];
        { const f32x2 a = v[g], b = cmulc(v[g + 2], tw); v[g] = a + b; v[g + 2] = a - b; }
        { const f32x2 a = v[g + 4], b = cmulc(v[g + 6], tw); v[g + 4] = a + b; v[g + 6] = a - b; }
#pragma unroll
        for (int j = 0; j < 2; ++j) { const f32x2 a = v[g + 2 * j], b = cmulc(v[g + 2 * j + 4], T[2 * (u + 512 * j)]); v[g + 2 * j] = a + b; v[g + 2 * j + 4] = a - b; } }
}
template <int Q> __device__ __forceinline__ void r8_dif(f32x2 (&e)[8], int r, const LAS f32x2* T) {
    constexpr int S2 = 512 / Q;
#pragma unroll
    for (int j = 0; j < 4; ++j) { const f32x2 a = e[j], b = e[j + 4]; e[j] = a + b; e[j + 4] = cmul(a - b, T[S2 * (r + Q * j)]); }
#pragma unroll
    for (int jj = 0; jj < 4; ++jj) { const int j = (jj & 1) + 4 * (jj >> 1); const f32x2 a = e[j], b = e[j + 2]; e[j] = a + b; e[j + 2] = cmul(a - b, T[2 * S2 * (r + Q * (j & 1))]); }
    const f32x2 tw = T[4 * S2 * r];
#pragma unroll
    for (int j = 0; j < 8; j += 2) { const f32x2 a = e[j], b = e[j + 1]; e[j] = a + b; e[j + 1] = cmul(a - b, tw); }
}
template <int Q> __device__ __forceinline__ void r8_dit(f32x2 (&e)[8], int r, const LAS f32x2* T) {
    constexpr int S2 = 512 / Q;
    const f32x2 tw = T[4 * S2 * r];
#pragma unroll
    for (int j = 0; j < 8; j += 2) { const f32x2 a = e[j], b = cmulc(e[j + 1], tw); e[j] = a + b; e[j + 1] = a - b; }
#pragma unroll
    for (int jj = 0; jj < 4; ++jj) { const int j = (jj & 1) + 4 * (jj >> 1); const f32x2 a = e[j], b = cmulc(e[j + 2], T[2 * S2 * (r + Q * (j & 1))]); e[j] = a + b; e[j + 2] = a - b; }
#pragma unroll
    for (int j = 0; j < 4; ++j) { const f32x2 a = e[j], b = cmulc(e[j + 4], T[S2 * (r + Q * j)]); e[j] = a + b; e[j + 4] = a - b; }
}
template <int Q, bool INV> __device__ __forceinline__ void fft_mid(LAS f32x2* X, int tt, const LAS f32x2* T) {
    const int blk = tt / Q, r = tt % Q, base = blk * 8 * Q + r;
    f32x2 e[8];
#pragma unroll
    for (int j = 0; j < 8; ++j) e[j] = X[padx(base + Q * j)];
    if (INV) r8_dit<Q>(e, r, T); else r8_dif<Q>(e, r, T);
#pragma unroll
    for (int j = 0; j < 8; ++j) X[padx(base + Q * j)] = e[j];
}
__device__ __forceinline__ void fft_conv_half(f32x2 (&v)[8], LAS f32x2* X, const LAS f32x2* T, const f32x2* K, int tt) {
    f32x2 kv[8];
#pragma unroll
    for (int j = 0; j < 8; ++j) kv[j] = K[8 * tt + j];
    fft_p1_dif(v, tt, T);
#pragma unroll
    for (int m = 0; m < 8; ++m) X[padx(tt + 256 * m)] = v[m];
    __syncthreads();
    fft_mid<64, false>(X, tt, T); __syncthreads();
    fft_mid<8, false>(X, tt, T); __syncthreads();
    f32x2 e[8];
#pragma unroll
    for (int j = 0; j < 8; ++j) e[j] = X[padx(8 * tt + j)];
    r8_dif<1>(e, 0, T);
#pragma unroll
    for (int j = 0; j < 8; ++j) e[j] = cmul(e[j], kv[j]);
    r8_dit<1>(e, 0, T);
#pragma unroll
    for (int j = 0; j < 8; ++j) X[padx(8 * tt + j)] = e[j];
    __syncthreads();
    fft_mid<8, true>(X, tt, T); __syncthreads();
    fft_mid<64, true>(X, tt, T); __syncthreads();
#pragma unroll
    for (int m = 0; m < 8; ++m) v[m] = X[padx(tt + 256 * m)];
    fft_p1_dit(v, tt, T);
}
__device__ __forceinline__ void fft_fwd_store(f32x2 (&v)[8], LAS f32x2* X, const LAS f32x2* T, f32x2* Kout, int tt) {
    fft_p1_dif(v, tt, T);
#pragma unroll
    for (int m = 0; m < 8; ++m) X[padx(tt + 256 * m)] = v[m];
    __syncthreads();
    fft_mid<64, false>(X, tt, T); __syncthreads();
    fft_mid<8, false>(X, tt, T); __syncthreads();
    f32x2 e[8];
#pragma unroll
    for (int j = 0; j < 8; ++j) e[j] = X[padx(8 * tt + j)];
    r8_dif<1>(e, 0, T);
#pragma unroll
    for (int j = 0; j < 8; ++j) Kout[8 * tt + j] = e[j];
    __syncthreads();
}
__device__ __forceinline__ int padx16(int i) { return i + (i >> 4); }
constexpr int XPAD16 = 2048 + 128;
template <int Q> __device__ __forceinline__ void r16_dif(f32x2 (&e)[16], int r, const LAS f32x2* T) {
    constexpr int S2 = 256 / Q;
#pragma unroll
    for (int j = 0; j < 8; ++j) { const f32x2 a = e[j], b = e[j + 8]; e[j] = a + b; e[j + 8] = cmul(a - b, T[S2 * (r + Q * j)]); }
#pragma unroll
    for (int jj = 0; jj < 8; ++jj) { const int j = (jj & 3) + 8 * (jj >> 2); const f32x2 a = e[j], b = e[j + 4]; e[j] = a + b; e[j + 4] = cmul(a - b, T[2 * S2 * (r + Q * (j & 3))]); }
#pragma unroll
    for (int jj = 0; jj < 8; ++jj) { const int j = (jj & 1) + 4 * (jj >> 1); const f32x2 a = e[j], b = e[j + 2]; e[j] = a + b; e[j + 2] = cmul(a - b, T[4 * S2 * (r + Q * (j & 1))]); }
    const f32x2 tw = T[8 * S2 * r];
#pragma unroll
    for (int j = 0; j < 16; j += 2) { const f32x2 a = e[j], b = e[j + 1]; e[j] = a + b; e[j + 1] = cmul(a - b, tw); }
}
template <int Q> __device__ __forceinline__ void r16_dit(f32x2 (&e)[16], int r, const LAS f32x2* T) {
    constexpr int S2 = 256 / Q;
    const f32x2 tw = T[8 * S2 * r];
#pragma unroll
    for (int j = 0; j < 16; j += 2) { const f32x2 a = e[j], b = cmulc(e[j + 1], tw); e[j] = a + b; e[j + 1] = a - b; }
#pragma unroll
    for (int jj = 0; jj < 8; ++jj) { const int j = (jj & 1) + 4 * (jj >> 1); const f32x2 a = e[j], b = cmulc(e[j + 2], T[4 * S2 * (r + Q * (j & 1))]); e[j] = a + b; e[j + 2] = a - b; }
#pragma unroll
    for (int jj = 0; jj < 8; ++jj) { const int j = (jj & 3) + 8 * (jj >> 2); const f32x2 a = e[j], b = cmulc(e[j + 4], T[2 * S2 * (r + Q * (j & 3))]); e[j] = a + b; e[j + 4] = a - b; }
#pragma unroll
    for (int j = 0; j < 8; ++j) { const f32x2 a = e[j], b = cmulc(e[j + 8], T[S2 * (r + Q * j)]); e[j] = a + b; e[j + 8] = a - b; }
}
__device__ __forceinline__ void fft_conv_half16(f32x2 (&v)[16], LAS f32x2* X, const LAS f32x2* T, const f32x2* K, int tt) {
    r16_dif<128>(v, tt, T);
#pragma unroll
    for (int m = 0; m < 16; ++m) X[padx16(tt + 128 * m)] = v[m];
    __syncthreads();
    const int r = tt & 7, base = (tt >> 3) * 128 + r;
#pragma unroll
    for (int j = 0; j < 16; ++j) v[j] = X[padx16(base + 8 * j)];
    r16_dif<8>(v, r, T);
#pragma unroll
    for (int j = 0; j < 16; ++j) X[padx16(base + 8 * j)] = v[j];
    f32x2 kv[16];
#pragma unroll
    for (int j = 0; j < 16; ++j) kv[j] = K[16 * tt + j];
    __syncthreads();
#pragma unroll
    for (int g = 0; g < 2; ++g) { f32x2 e[8];
#pragma unroll
        for (int j = 0; j < 8; ++j) e[j] = X[padx16(16 * tt + 8 * g + j)];
        r8_dif<1>(e, 0, T);
#pragma unroll
        for (int j = 0; j < 8; ++j) e[j] = cmul(e[j], kv[8 * g + j]);
        r8_dit<1>(e, 0, T);
#pragma unroll
        for (int j = 0; j < 8; ++j) X[padx16(16 * tt + 8 * g + j)] = e[j]; }
    __syncthreads();
#pragma unroll
    for (int j = 0; j < 16; ++j) v[j] = X[padx16(base + 8 * j)];
    r16_dit<8>(v, r, T);
#pragma unroll
    for (int j = 0; j < 16; ++j) X[padx16(base + 8 * j)] = v[j];
    __syncthreads();
#pragma unroll
    for (int m = 0; m < 16; ++m) v[m] = X[padx16(tt + 128 * m)];
    r16_dit<128>(v, tt, T);
}
__device__ __forceinline__ void fft_fwd_store16(f32x2 (&v)[16], LAS f32x2* X, const LAS f32x2* T, f32x2* Kout, int tt) {
    r16_dif<128>(v, tt, T);
#pragma unroll
    for (int m = 0; m < 16; ++m) X[padx16(tt + 128 * m)] = v[m];
    __syncthreads();
    const int r = tt & 7, base = (tt >> 3) * 128 + r;
#pragma unroll
    for (int j = 0; j < 16; ++j) v[j] = X[padx16(base + 8 * j)];
    r16_dif<8>(v, r, T);
#pragma unroll
    for (int j = 0; j < 16; ++j) X[padx16(base + 8 * j)] = v[j];
    __syncthreads();
#pragma unroll
    for (int g = 0; g < 2; ++g) { f32x2 e[8];
#pragma unroll
        for (int j = 0; j < 8; ++j) e[j] = X[padx16(16 * tt + 8 * g + j)];
        r8_dif<1>(e, 0, T);
#pragma unroll
        for (int j = 0; j < 8; ++j) Kout[16 * tt + 8 * g + j] = e[j]; }
    __syncthreads();
}
__device__ __forceinline__ void build_twiddles(const Ctx& C, LAS f32x2* T) {
    for (int k = C.tid; k < 2048; k += NTHR) { float s, c; sincospif((float)k * (1.0f / 2048.0f), &s, &c); T[k] = (f32x2){c, -s}; }
}

__device__ __forceinline__ void phase0(const Ctx& C) {
    LAS float* sil = (LAS float*)C.lds;
    LAS float* red = sil + 9 * 1024;
    LAS float* zs = red + 8 * 9 * 64;
    LAS float* h1s = zs + 8 * 40;
    const float* cin = C.in[IN_C]; const float* cctx = C.in[IN_CCTX];
    for (int i = C.tid; i < 9 * 1024; i += NTHR) { const int r = i >> 10, k = i & 1023; const float v = r < 8 ? cin[r * 1024 + k] : cctx[k]; sil[i] = v / (1.0f + expf(-v)); }
    __syncthreads();
    float* mods = WSP(float, WS_MODS);
    const float* wmod = C.in[IN_WMOD]; const float* bmod = C.in[IN_BMOD];
    for (int item = C.bid; item < 4 * 96; item += C.G) {
        const int l = item / 96, cb = item % 96, cc = C.tid & 63, kg = C.tid >> 6;
        const float* w = wmod + ((size_t)l * 1024 + kg * 128) * 6144 + cb * 64 + cc;
        const LAS float* sk = sil + kg * 128;
        float acc[9];
#pragma unroll
        for (int r = 0; r < 9; ++r) acc[r] = 0.f;
#pragma unroll 4
        for (int k = 0; k < 128; ++k) { const float wv = w[(size_t)k * 6144];
#pragma unroll
            for (int r = 0; r < 9; ++r) acc[r] += sk[r * 1024 + k] * wv; }
#pragma unroll
        for (int r = 0; r < 9; ++r) red[(kg * 9 + r) * 64 + cc] = acc[r];
        __syncthreads();
        for (int o = C.tid; o < 576; o += NTHR) { const int r = o >> 6, c2 = o & 63; float s = 0.f;
#pragma unroll
            for (int g = 0; g < 8; ++g) s += red[(g * 9 + r) * 64 + c2];
            mods[(size_t)(l * 9 + r) * 6144 + cb * 64 + c2] = s + bmod[l * 6144 + cb * 64 + c2]; }
        __syncthreads();
    }
    for (int item = C.bid; item < 4 * 288; item += C.G) {
        const int l = item / 288, r = item % 288, isctx = r >= 256;
        const int L = isctx ? 256 : 2048, t0 = (isctx ? r - 256 : r) * 8, tl = C.tid >> 6, j = C.tid & 63, t = t0 + tl;
        if (j < 33) { float z;
            if (j == 0) z = (float)t / (float)(L - 1);
            else { const int fi = (j - 1) & 15; const float freq = 1e-4f + (float)fi * ((15.0f - 1e-4f) / 15.0f);
                const float ang = ((float)(2.0 * 3.14159265358979323846 / L) * (float)t) * freq; z = (j <= 16) ? cosf(ang) : -sinf(ang); }
            zs[tl * 40 + j] = z; }
        __syncthreads();
        { const float* w1 = C.in[IN_W1] + (size_t)l * 33 * 64; float s = C.in[IN_B1][l * 64 + j];
            for (int i = 0; i < 33; ++i) s += zs[tl * 40 + i] * w1[i * 64 + j];
            h1s[tl * 64 + j] = sinf(s); }
        __syncthreads();
        { const float* w2 = C.in[IN_W2] + (size_t)l * 64 * 64; float s = C.in[IN_B2][l * 64 + j];
            for (int i = 0; i < 64; ++i) s += h1s[tl * 64 + i] * w2[i * 64 + j];
            bf16_t* dst = WSP(bf16_t, WS_HPAD) + ((size_t)l * 2304 + (isctx ? 2048 + t : t)) * 128;
            dst[j] = (bf16_t)f2bf(sinf(s)); dst[64 + j] = (bf16_t)0; }
        __syncthreads();
    }
    {
        const float* w3 = C.in[IN_W3]; bf16_t* w3t = WSP(bf16_t, WS_W3T);
        for (int i = C.bid * NTHR + C.tid; i < 4 * 64 * 2048; i += C.G * NTHR) { const int l = i >> 17, k = (i >> 11) & 63, col = i & 2047;
            w3t[((size_t)l * 2048 + col) * 128 + k] = (bf16_t)f2bf(w3[i]); w3t[((size_t)l * 2048 + col) * 128 + 64 + k] = (bf16_t)0; }
    }
    if (C.bid == C.G - 1) {
        const float* lb = C.in[IN_LB]; float* lower = WSP(float, WS_LOWER);
        for (int i = C.tid; i < 1024; i += NTHR) { const int d = i >> 9, c = i & 511; float v[4], mx = -3.4e38f, s = 0.f;
#pragma unroll
            for (int l = 0; l < 4; ++l) { v[l] = lb[(d * 4 + l) * 512 + c]; mx = fmaxf(mx, v[l]); }
#pragma unroll
            for (int l = 0; l < 4; ++l) { v[l] = expf(v[l] - mx); s += v[l]; }
            float cum = 0.f;
#pragma unroll
            for (int l = 0; l < 4; ++l) { if (l > 0) cum += v[l] / s; lower[(d * 4 + l) * 512 + c] = cum; } }
    }
}

__device__ __forceinline__ const float* xrow_src(const Ctx& C, int l, int row) {
    return l == 0 ? (row < NLAT ? C.in[IN_X] + (size_t)row * D : C.in[IN_CTX] + (size_t)(row - NLAT) * D) : WSP(const float, WS_XBUF) + (size_t)row * D;
}
__device__ __forceinline__ void transpose_item(const float* W, int K, int N, bf16_t* WT, LAS float* scr, int item, int lane) {
    const int nblk = N / 32, kb = item / nblk, nb = item % nblk, k0 = 64 * kb, n0 = 32 * nb;
#pragma unroll 8
    for (int i = 0; i < 32; ++i) { const int kk = 2 * i + (lane >> 5); scr[kk * 33 + (lane & 31)] = W[(size_t)(k0 + kk) * N + n0 + (lane & 31)]; }
    LDS_WAIT(); asm volatile("" ::: "memory");
    const int c = lane & 7;
#pragma unroll
    for (int j = 0; j < 4; ++j) { const int n = (lane >> 3) + 8 * j; const LAS float* s = scr + (8 * c) * 33 + n;
        u32x4 o; o.x = pk2(s[0 * 33], s[1 * 33]); o.y = pk2(s[2 * 33], s[3 * 33]); o.z = pk2(s[4 * 33], s[5 * 33]); o.w = pk2(s[6 * 33], s[7 * 33]);
        *(u32x4*)(WT + (size_t)(n0 + n) * K + k0 + 8 * c) = o; }
    LDS_WAIT(); asm volatile("" ::: "memory");
}
__device__ __forceinline__ void phase_l1(const Ctx& C, int l) {
    const int gw = C.bid * NWAVES + C.wave, NGW = C.G * NWAVES;
    const float* mods = WSP(const float, WS_MODS) + (size_t)l * 9 * 6144;
    bf16_t* an = WSP(bf16_t, WS_R1);
    f32x4 nv[4];
    if (!(C.dry & 2)) {
    if (gw < NTOK) { const float* src = xrow_src(C, l, gw);
#pragma unroll
        for (int j = 0; j < 4; ++j) nv[j] = *(const f32x4*)(src + C.lane * 4 + 256 * j); }
    for (int row = gw; row < NTOK; row += NGW) {
        const float* md = mods + bidx(row) * 6144;
        f32x4 v[4]; float ss = 0.f;
#pragma unroll
        for (int j = 0; j < 4; ++j) v[j] = nv[j];
        if (row + NGW < NTOK) { const float* src = xrow_src(C, l, row + NGW);
#pragma unroll
            for (int j = 0; j < 4; ++j) nv[j] = *(const f32x4*)(src + C.lane * 4 + 256 * j); }
#pragma unroll
        for (int j = 0; j < 4; ++j) ss += (v[j].x * v[j].x + v[j].y * v[j].y) + (v[j].z * v[j].z + v[j].w * v[j].w);
        ss = wave_sum(ss); const float rinv = 1.0f / sqrtf(ss * (1.0f / D) + EPS);
#pragma unroll
        for (int j = 0; j < 4; ++j) { const int k = C.lane * 4 + 256 * j; const f32x4 sh = *(const f32x4*)(md + k), sc = *(const f32x4*)(md + 1024 + k);
            const f32x4 o = v[j] * rinv * (sc + 1.0f) + sh; u32x2 w; w.x = pk2(o.x, o.y); w.y = pk2(o.z, o.w);
            *(u32x2*)(an + (size_t)row * D + k) = w; }
    }
    }
    if (!(C.dry & 4)) {
        LAS float* scr = (LAS float*)(C.lds + C.wave * 16384);
        constexpr int I_IN = 16 * 128, I_OUT = 16 * 32, I_E = 128;
        constexpr int NIT = I_IN + I_OUT + 3 * 16 * I_E;
        for (int it = gw; it < NIT; it += NGW) {
            int r = it;
            if (r < I_IN) { transpose_item(C.in[IN_WIN] + (size_t)l * D * DIN, D, DIN, WSP(bf16_t, WS_WIN), scr, r, C.lane); continue; } r -= I_IN;
            if (r < I_OUT) { transpose_item(C.in[IN_WOUT] + (size_t)l * D * D, D, D, WSP(bf16_t, WS_WOUT), scr, r, C.lane); continue; } r -= I_OUT;
            if (r < 16 * I_E) { const int e = r / I_E; transpose_item(C.in[IN_WG] + ((size_t)l * NE + e) * D * DE, D, DE, WSP(bf16_t, WS_WG) + (size_t)e * DE * D, scr, r % I_E, C.lane); continue; } r -= 16 * I_E;
            if (r < 16 * I_E) { const int e = r / I_E; transpose_item(C.in[IN_WU] + ((size_t)l * NE + e) * D * DE, D, DE, WSP(bf16_t, WS_WU) + (size_t)e * DE * D, scr, r % I_E, C.lane); continue; } r -= 16 * I_E;
            { const int e = r / I_E; transpose_item(C.in[IN_WD] + ((size_t)l * NE + e) * DE * D, DE, D, WSP(bf16_t, WS_WD) + (size_t)e * D * DE, scr, r % I_E, C.lane); }
        }
    }
    __syncthreads();
    {
        LAS f32x2* T = (LAS f32x2*)C.lds;
        const int team = C.tid >> 7, tt = C.tid & 127;
        LAS f32x2* X = (LAS f32x2*)(C.lds + 16384) + team * XPAD16;
        LAS float* hbs = (LAS float*)(C.lds + 16384 + 4 * XPAD16 * 8) + team * 2048;
        LAS float* reds = (LAS float*)(C.lds + 16384 + 4 * XPAD16 * 8 + 32768);
        build_twiddles(C, T);
        __syncthreads();
        const bf16_t* hfl = WSP(const bf16_t, WS_HF) + (size_t)l * 2048 * 2304;
        f32x2* kspec = WSP(f32x2, WS_KSPEC);
        if (!(C.dry & 8))
        for (int item = C.bid; item < 256; item += C.G) {
            const int idx = item * 4 + team, o = idx >> 9, c = idx & 511;
            const int colf = o * 1024 + c, colb = colf + 512;
            const bf16_t* hfp = hfl + (size_t)colf * 2304; const bf16_t* hbp = hfl + (size_t)colb * 2304;
            float hf[16], hb[16], s = 0.f;
#pragma unroll
            for (int j = 0; j < 16; ++j) { const int t = tt + 128 * j; hf[j] = bf2f(hfp[t]); hb[j] = bf2f(hbp[t]); s += fabsf(hf[j]) + fabsf(hb[j]); }
            s = wave_sum(s);
            if (C.lane == 0) reds[C.wave] = s;
            __syncthreads();
            const float inv = 1.0f / ((reds[team * 2] + reds[team * 2 + 1]) * 4096.0f);
#pragma unroll
            for (int j = 0; j < 16; ++j) { hf[j] *= inv; hbs[tt + 128 * j] = hb[j] * inv; }
            __syncthreads();
            f32x2* kout = kspec + ((size_t)(o * 512 + c) * 2) * 2048;
            f32x2 vv[16];
#pragma unroll
            for (int j = 0; j < 16; ++j) { const int n = tt + 128 * j; const float kb = n > 0 ? hbs[2048 - n] : 0.f; vv[j] = (f32x2){hf[j] + kb, 0.f}; }
            fft_fwd_store16(vv, X, T, kout, tt);
#pragma unroll
            for (int j = 0; j < 16; ++j) { const int n = tt + 128 * j; const float kb = n > 0 ? hbs[2048 - n] : 0.f; const float dd = hf[j] - kb; const f32x2 tw = T[n]; vv[j] = (f32x2){dd * tw.x, dd * tw.y}; }
            fft_fwd_store16(vv, X, T, kout + 2048, tt);
        }
        if (l < DEPTH - 1 && !(C.dry & 16)) {
            f32x2* kspc = WSP(f32x2, WS_KSPC);
            for (int item = C.bid; item < 256; item += C.G) {
                const int idx = item * 4 + team, o = idx >> 9, c = idx & 511;
                const int colf = o * 1024 + c, colb = colf + 512;
                float af0 = bf2f(hfl[(size_t)colf * 2304 + 2048 + tt]), af1 = bf2f(hfl[(size_t)colf * 2304 + 2048 + 128 + tt]);
                float ab0 = bf2f(hfl[(size_t)colb * 2304 + 2048 + tt]), ab1 = bf2f(hfl[(size_t)colb * 2304 + 2048 + 128 + tt]);
                __syncthreads();
                const float s = wave_sum((fabsf(af0) + fabsf(af1)) + (fabsf(ab0) + fabsf(ab1)));
                if (C.lane == 0) reds[C.wave] = s;
                __syncthreads();
                const float inv = 1.0f / ((reds[team * 2] + reds[team * 2 + 1]) * 2048.0f);
                af0 *= inv; af1 *= inv; hbs[tt] = ab0 * inv; hbs[128 + tt] = ab1 * inv;
                __syncthreads();
                f32x2 vk[16];
#pragma unroll
                for (int j = 0; j < 16; ++j) vk[j] = (f32x2){0.f, 0.f};
                vk[0] = (f32x2){af0, 0.f}; vk[1] = (f32x2){af1, 0.f};
                vk[14] = (f32x2){tt > 0 ? hbs[256 - tt] : 0.f, 0.f};
                vk[15] = (f32x2){hbs[128 - tt], 0.f};
                fft_fwd_store16(vk, X, T, kspc + (size_t)(o * 512 + c) * 2048, tt);
            }
        }
    }
}

__device__ __forceinline__ float shortconv(const LAS bf16_t* raw, int t, int mask, int tmax, float w0, float w1, float w2, float bias) {
    const float pm = ((t & mask) != 0) ? bf2f(raw[t - 1]) : 0.f;
    const float pc = bf2f(raw[t]);
    const float pp = ((t & mask) != mask && t < tmax) ? bf2f(raw[t + 1]) : 0.f;
    return w0 * pm + w1 * pc + w2 * pp + bias;
}
constexpr int HY_CH = 4, HY_ITEMS = 4 * (512 / HY_CH), HYC_ITEMS = 512 / 4;
__device__ __forceinline__ void hyena_lat(const Ctx& C, int l, int item) {
    const int bp = item & 3, cg = item >> 2, team = C.tid >> 7, tt = C.tid & 127;
    LAS f32x2* T = (LAS f32x2*)C.lds;
    LAS f32x2* X = (LAS f32x2*)(C.lds + 16384) + team * XPAD16;
    LAS bf16_t* raw = (LAS bf16_t*)(C.lds + 16384 + 4 * XPAD16 * 8) + team * 4096;
    const bf16_t* phyt = WSP(const bf16_t, WS_PHYT);
    const float* cw = C.in[IN_CONVW] + (size_t)l * 3 * NHY; const float* cb = C.in[IN_CONVB] + (size_t)l * NHY;
    const float* hyb = C.in[IN_HYBIAS] + (size_t)l * 2 * DH;
    const f32x2* kspec = WSP(const f32x2, WS_KSPEC);
    const int ba = 2 * bp, c = cg * 4 + team;
    f32x2 z[16], acc[16], v[16];
#pragma unroll 1
    for (int stage = 0; stage < 3; ++stage) {
        const int ch = stage * 512 + c;
        __syncthreads();
#pragma unroll
        for (int k = 0; k < 4; ++k) { const int q = tt + 128 * k, rr = q >> 8, cc = q & 255;
            *(LAS u32x4*)(raw + rr * 2048 + cc * 8) = *(const u32x4*)(phyt + (size_t)ch * NTOK + (size_t)(ba + rr) * 2048 + cc * 8); }
        __syncthreads();
        const float w0 = cw[ch], w1 = cw[NHY + ch], w2 = cw[2 * NHY + ch], bs = cb[ch];
        if (stage == 0) {
#pragma unroll
            for (int j = 0; j < 16; ++j) { const int t = tt + 128 * j; z[j] = (f32x2){shortconv(raw, t, 63, 4096, w0, w1, w2, bs), shortconv(raw + 2048, t, 63, 4096, w0, w1, w2, bs)}; }
        } else {
            const float dsk = hyb[(stage - 1) * DH + c];
#pragma unroll
            for (int j = 0; j < 16; ++j) { const int t = tt + 128 * j; const f32x2 cv = acc[j] + z[j] * dsk;
                z[j] = (f32x2){shortconv(raw, t, 63, 4096, w0, w1, w2, bs) * cv.x, shortconv(raw + 2048, t, 63, 4096, w0, w1, w2, bs) * cv.y}; }
        }
        if (stage == 2) {
            LAS bf16_t* ob = (LAS bf16_t*)X;
#pragma unroll
            for (int j = 0; j < 16; ++j) { const int t = tt + 128 * j; ob[t] = (bf16_t)f2bf(z[j].x); ob[2048 + t] = (bf16_t)f2bf(z[j].y); }
            break;
        }
        const f32x2* K = kspec + ((size_t)(stage * 512 + c) * 2) * 2048;
#pragma unroll
        for (int j = 0; j < 16; ++j) v[j] = z[j];
        fft_conv_half16(v, X, T, K, tt);
#pragma unroll
        for (int j = 0; j < 16; ++j) acc[j] = v[j];
#pragma unroll
        for (int j = 0; j < 16; ++j) v[j] = cmul(z[j], T[tt + 128 * j]);
        fft_conv_half16(v, X, T, K + 2048, tt);
#pragma unroll
        for (int j = 0; j < 16; ++j) acc[j] += cmulc(v[j], T[tt + 128 * j]);
    }
    __syncthreads();
    bf16_t* Y = WSP(bf16_t, WS_R1);
    for (int i = C.tid; i < 4096; i += NTHR) { const int b = i >> 11, t = i & 2047;
        const LAS bf16_t* o0 = (const LAS bf16_t*)((LAS f32x2*)(C.lds + 16384)) + i;
        u32x2 w; w.x = (unsigned)o0[0] | ((unsigned)o0[XPAD16 * 4] << 16); w.y = (unsigned)o0[2 * XPAD16 * 4] | ((unsigned)o0[3 * XPAD16 * 4] << 16);
        *(u32x2*)(Y + ((size_t)(ba + b) * 2048 + t) * D + cg * 4) = w; }
    __syncthreads();
}
__device__ __forceinline__ void hyena_ctx2(const Ctx& C, int l, int item) {
    const int team = C.tid >> 7, tt = C.tid & 127, c = item * 4 + team;
    LAS f32x2* T = (LAS f32x2*)C.lds;
    LAS f32x2* X = (LAS f32x2*)(C.lds + 16384) + team * XPAD16;
    LAS bf16_t* raw = (LAS bf16_t*)(C.lds + 16384 + 4 * XPAD16 * 8) + team * 4096;
    const bf16_t* phyt = WSP(const bf16_t, WS_PHYT);
    const float* cw = C.in[IN_CONVW] + (size_t)l * 3 * NHY; const float* cb = C.in[IN_CONVB] + (size_t)l * NHY;
    const float* hyb = C.in[IN_HYBIAS] + (size_t)l * 2 * DH;
    const f32x2* kspc = WSP(const f32x2, WS_KSPC);
    bf16_t* Y = WSP(bf16_t, WS_R1);
    f32x2 z[16], v[16];
#pragma unroll
    for (int j = 0; j < 16; ++j) { z[j] = (f32x2){0.f, 0.f}; v[j] = (f32x2){0.f, 0.f}; }
#pragma unroll 1
    for (int stage = 0; stage < 3; ++stage) {
        const int ch = stage * 512 + c;
        __syncthreads();
#pragma unroll
        for (int k = 0; k < 2; ++k) { const int q = tt + 128 * k; *(LAS u32x4*)(raw + q * 8) = *(const u32x4*)(phyt + (size_t)ch * NTOK + NLAT + q * 8); }
        __syncthreads();
        const float w0 = cw[ch], w1 = cw[NHY + ch], w2 = cw[2 * NHY + ch], bs = cb[ch];
        const float dsk = stage > 0 ? hyb[(stage - 1) * DH + c] : 0.f;
#pragma unroll
        for (int p = 0; p < 4; ++p)
#pragma unroll
            for (int hh = 0; hh < 2; ++hh) { const int m = 4 * p + hh, tok = hh * 128 + tt;
                const float ua = shortconv(raw, (2 * p) * 256 + tok, 255, 4096, w0, w1, w2, bs), ub = shortconv(raw, (2 * p + 1) * 256 + tok, 255, 4096, w0, w1, w2, bs);
                if (stage == 0) z[m] = (f32x2){ua, ub};
                else { const f32x2 cv = v[m] + z[m] * dsk; z[m] = (f32x2){ua * cv.x, ub * cv.y}; } }
        if (stage == 2) {
#pragma unroll
            for (int p = 0; p < 4; ++p)
#pragma unroll
                for (int hh = 0; hh < 2; ++hh) { const int m = 4 * p + hh, tok = hh * 128 + tt;
                    Y[(size_t)(NLAT + (2 * p) * 256 + tok) * D + c] = (bf16_t)f2bf(z[m].x); Y[(size_t)(NLAT + (2 * p + 1) * 256 + tok) * D + c] = (bf16_t)f2bf(z[m].y); }
            break;
        }
#pragma unroll
        for (int j = 0; j < 16; ++j) v[j] = z[j];
        fft_conv_half16(v, X, T, kspc + (size_t)(stage * 512 + c) * 2048, tt);
    }
}

constexpr int HG_QT = 0, HG_QP = 17408, HG_KP = 34816, HG_ST = 52224, HG_VT = 87040, HG_KH = 105472, HG_P = 123904, HG_SUB = 133120, HG_D = 135168;
__device__ __forceinline__ void hgrn_mfma(const Ctx& C, int item) {
    const int dir = item & 1, h = (item >> 1) & 3, b = item >> 3;
    LAS unsigned char* L = C.lds;
    const int lane = C.lane, w = C.wave, r = lane & 15, quad = lane >> 4;
    const int I = w >> 1, col = (w & 1) * 64 + lane;
    const bf16_t* phg = WSP(const bf16_t, WS_PHG);
    bf16_t* odir = WSP(bf16_t, WS_ODIR) + (size_t)dir * NTOK * 512;
    LAS float* subtot = (LAS float*)(L + HG_SUB); LAS float* Dv = (LAS float*)(L + HG_D);
    __syncthreads();
    unsigned z0_ = 0u; asm volatile("" : "+v"(z0_));
    const u32x4 zv_ = (u32x4){z0_, z0_, z0_, z0_}; const float zff_ = __builtin_bit_cast(float, z0_); const f32x4 zv4f_ = (f32x4){zff_, zff_, zff_, zff_};
    for (int i = C.tid; i < (128 * 272) / 16; i += NTHR) *(LAS u32x4*)(L + HG_ST + i * 16) = zv_;
    for (int i = C.tid; i < (64 * 144) / 16; i += NTHR) *(LAS u32x4*)(L + HG_P + i * 16) = zv_;
    f32x4 sacc[8];
#pragma unroll
    for (int t = 0; t < 8; ++t) sacc[t] = zv4f_;
    unsigned short qr[16], kr[16], vr[16];
    const int rstep = dir ? -1 : 1;
    const size_t colq = (size_t)h * 128 + col, colk = 1536 + (size_t)dir * 512 + h * 128 + col, colv = 512 + (size_t)h * 128 + col;
    auto chunk_row0 = [&](int ch) -> int { return ch < 4 ? NLAT + b * 256 + (dir ? 255 - ch * 64 : ch * 64) : b * 2048 + (dir ? 2047 - (ch - 4) * 64 : (ch - 4) * 64); };
    { const int row0 = chunk_row0(0) + rstep * 16 * I;
#pragma unroll
      for (int i = 0; i < 16; ++i) { const bf16_t* p = phg + (size_t)(row0 + rstep * i) * NHG; qr[i] = p[colq]; kr[i] = p[colk]; vr[i] = p[colv]; } }
    __syncthreads();
#pragma unroll 1
    for (int ch = 0; ch < 36; ++ch) {
        float cum[16]; float cs = 0.f;
#pragma unroll
        for (int i = 0; i < 16; ++i) { cs += __logf(1.0f - bf2f(kr[i])); cum[i] = cs; }
        subtot[I * 128 + col] = cs;
        __syncthreads();
        const float s0 = subtot[col], s1 = subtot[128 + col], s2 = subtot[256 + col], s3 = subtot[384 + col];
        const float pre = (I > 0 ? s0 : 0.f) + (I > 1 ? s1 : 0.f) + (I > 2 ? s2 : 0.f), rho = s0 + s1, tot = (s0 + s1) + (s2 + s3);
        const float erho = __expf(rho), eend = __expf(tot - rho);
        unsigned khp[8], vtp[8];
#pragma unroll
        for (int i = 0; i < 16; ++i) {
            const float bi = pre + cum[i], e1 = __expf(bi - rho), e2 = __expf(rho - bi), qf = bf2f(qr[i]), kf = bf2f(kr[i]);
            const int srow = (16 * I + i) * 272 + col * 2;
            *(LAS bf16_t*)(L + HG_QP + srow) = (bf16_t)f2bf(qf * e1);
            *(LAS bf16_t*)(L + HG_QT + srow) = (bf16_t)f2bf(qf * e1 * erho);
            *(LAS bf16_t*)(L + HG_KP + srow) = (bf16_t)f2bf(kf * e2);
            const unsigned khb = f2bf(kf * e2 * eend);
            if (i & 1) { khp[i >> 1] |= khb << 16; vtp[i >> 1] |= (unsigned)vr[i] << 16; } else { khp[i >> 1] = khb; vtp[i >> 1] = (unsigned)vr[i]; }
        }
        *(LAS u32x4*)(L + HG_KH + col * 144 + I * 32) = (u32x4){khp[0], khp[1], khp[2], khp[3]};
        *(LAS u32x4*)(L + HG_KH + col * 144 + I * 32 + 16) = (u32x4){khp[4], khp[5], khp[6], khp[7]};
        *(LAS u32x4*)(L + HG_VT + col * 144 + I * 32) = (u32x4){vtp[0], vtp[1], vtp[2], vtp[3]};
        *(LAS u32x4*)(L + HG_VT + col * 144 + I * 32 + 16) = (u32x4){vtp[4], vtp[5], vtp[6], vtp[7]};
        if (I == 0) Dv[col] = __expf(tot);
        const int crow0 = chunk_row0(ch);
        if (ch + 1 < 36) { const int row0 = chunk_row0(ch + 1) + rstep * 16 * I;
#pragma unroll
            for (int i = 0; i < 16; ++i) { const bf16_t* p = phg + (size_t)(row0 + rstep * i) * NHG; qr[i] = p[colq]; kr[i] = p[colk]; vr[i] = p[colv]; } }
        __syncthreads();
#pragma unroll 1
        for (int blk = w; blk < 10; blk += 8) {
            const int I2 = blk < 1 ? 0 : (blk < 3 ? 1 : (blk < 6 ? 2 : 3)), J2 = blk - (I2 * (I2 + 1)) / 2;
            f32x4 pa = zv4f_;
#pragma unroll
            for (int kk = 0; kk < 4; ++kk) {
                const bf16x8 a = *(const LAS bf16x8*)(L + HG_KP + (J2 * 16 + r) * 272 + (32 * kk + 8 * quad) * 2);
                const bf16x8 bq = *(const LAS bf16x8*)(L + HG_QP + (I2 * 16 + r) * 272 + (32 * kk + 8 * quad) * 2);
                pa = __builtin_amdgcn_mfma_f32_16x16x32_bf16(a, bq, pa, 0, 0, 0);
            }
            if (I2 == J2) {
#pragma unroll
                for (int rr = 0; rr < 4; ++rr) if (4 * quad + rr > r) pa[rr] = 0.f;
            }
            u32x2 pw; pw.x = pk2(pa[0], pa[1]); pw.y = pk2(pa[2], pa[3]);
            *(LAS u32x2*)(L + HG_P + (I2 * 16 + r) * 144 + (J2 * 16 + 4 * quad) * 2) = pw;
        }
        __syncthreads();
        {
            bf16x8 sfr[4];
#pragma unroll
            for (int kk = 0; kk < 4; ++kk) sfr[kk] = *(const LAS bf16x8*)(L + HG_ST + (16 * w + r) * 272 + (32 * kk + 8 * quad) * 2);
            const bf16x8 vf0 = *(const LAS bf16x8*)(L + HG_VT + (16 * w + r) * 144 + (8 * quad) * 2);
            const bf16x8 vf1 = *(const LAS bf16x8*)(L + HG_VT + (16 * w + r) * 144 + (32 + 8 * quad) * 2);
#pragma unroll
            for (int I3 = 0; I3 < 4; ++I3) {
                f32x4 oa = zv4f_;
#pragma unroll
                for (int kk = 0; kk < 4; ++kk) {
                    const bf16x8 bq = *(const LAS bf16x8*)(L + HG_QT + (I3 * 16 + r) * 272 + (32 * kk + 8 * quad) * 2);
                    oa = __builtin_amdgcn_mfma_f32_16x16x32_bf16(sfr[kk], bq, oa, 0, 0, 0);
                }
                { const bf16x8 bp = *(const LAS bf16x8*)(L + HG_P + (I3 * 16 + r) * 144 + (8 * quad) * 2);
                  oa = __builtin_amdgcn_mfma_f32_16x16x32_bf16(vf0, bp, oa, 0, 0, 0); }
                if (I3 >= 2) { const bf16x8 bp = *(const LAS bf16x8*)(L + HG_P + (I3 * 16 + r) * 144 + (32 + 8 * quad) * 2);
                  oa = __builtin_amdgcn_mfma_f32_16x16x32_bf16(vf1, bp, oa, 0, 0, 0); }
                const int row = crow0 + rstep * (16 * I3 + r);
                u32x2 ow; ow.x = pk2(oa[0], oa[1]); ow.y = pk2(oa[2], oa[3]);
                *(u32x2*)(odir + (size_t)row * 512 + h * 128 + 16 * w + 4 * quad) = ow;
            }
#pragma unroll
            for (int t = 0; t < 8; ++t) {
                const f32x4 dd = *(const LAS f32x4*)(L + HG_D + (16 * t + 4 * quad) * 4);
                f32x4 sa = sacc[t] * dd;
                const bf16x8 a0 = *(const LAS bf16x8*)(L + HG_KH + (16 * t + r) * 144 + (8 * quad) * 2);
                const bf16x8 a1 = *(const LAS bf16x8*)(L + HG_KH + (16 * t + r) * 144 + (32 + 8 * quad) * 2);
                sa = __builtin_amdgcn_mfma_f32_16x16x32_bf16(a0, vf0, sa, 0, 0, 0);
                sa = __builtin_amdgcn_mfma_f32_16x16x32_bf16(a1, vf1, sa, 0, 0, 0);
                sacc[t] = sa;
                u32x2 sw; sw.x = pk2(sa[0], sa[1]); sw.y = pk2(sa[2], sa[3]);
                *(LAS u32x2*)(L + HG_ST + (16 * w + r) * 272 + (16 * t + 4 * quad) * 2) = sw;
            }
        }
    }
    __syncthreads();
}
__device__ __forceinline__ void phase_l3(const Ctx& C, int l) {
    if (C.bid < 64) hgrn_mfma(C, C.bid);
    build_twiddles(C, (LAS f32x2*)C.lds);
    __syncthreads();
    unsigned* qh = WSP(unsigned, WS_CTL) + CW_Q + l * 64 + C.rep * 16;
    volatile LAS int* lc = (volatile LAS int*)(C.lds + LDSCTL_OFF);
    const int nitems = HY_ITEMS + (l < DEPTH - 1 ? HYC_ITEMS : 0);
    for (;;) {
        if (C.tid == 0) lc[LC_Q] = (int)__hip_atomic_fetch_add(qh, 1u, __ATOMIC_RELAXED, __HIP_MEMORY_SCOPE_AGENT);
        __syncthreads();
        const int item = lc[LC_Q];
        __syncthreads();
        if (item >= nitems) break;
        Ctx CI = C; { int t_ = C.tid; asm volatile("" : "+v"(t_)); CI.tid = t_; CI.lane = t_ & 63; }
        if (item < HY_ITEMS) hyena_lat(CI, l, item); else hyena_ctx2(CI, l, item - HY_ITEMS);
    }
}
__device__ __forceinline__ void phase_l3b(const Ctx& C, int l) {
    const int gw = C.bid * NWAVES + C.wave, NGW = C.G * NWAVES;
    const bf16_t* od0 = WSP(const bf16_t, WS_ODIR); const bf16_t* od1 = od0 + (size_t)NTOK * 512;
    const bf16_t* phg = WSP(const bf16_t, WS_PHG); bf16_t* Y = WSP(bf16_t, WS_R1);
    const float* nw = C.in[IN_NORMW] + l * 128;
    const int nrows = (l < DEPTH - 1) ? NTOK : NLAT;
    for (int row = gw; row < nrows; row += NGW) {
        const int idx = C.lane * 8;
        const u32x4 a = *(const u32x4*)(od0 + (size_t)row * 512 + idx), b = *(const u32x4*)(od1 + (size_t)row * 512 + idx), g = *(const u32x4*)(phg + (size_t)row * NHG + 1024 + idx);
        float o[8] = {bflo(a.x) + bflo(b.x), bfhi(a.x) + bfhi(b.x), bflo(a.y) + bflo(b.y), bfhi(a.y) + bfhi(b.y), bflo(a.z) + bflo(b.z), bfhi(a.z) + bfhi(b.z), bflo(a.w) + bflo(b.w), bfhi(a.w) + bfhi(b.w)};
        const float gg[8] = {bflo(g.x), bfhi(g.x), bflo(g.y), bfhi(g.y), bflo(g.z), bfhi(g.z), bflo(g.w), bfhi(g.w)};
        float ss = 0.f;
#pragma unroll
        for (int i = 0; i < 8; ++i) ss += o[i] * o[i];
        ss = row16_sum(ss);
        const float rinv = 1.0f / sqrtf(ss * (1.0f / 128.0f) + EPS);
        float y[8];
#pragma unroll
        for (int i = 0; i < 8; ++i) y[i] = o[i] * rinv * nw[(idx + i) & 127] * siluf_(gg[i]);
        u32x4 w; w.x = pk2(y[0], y[1]); w.y = pk2(y[2], y[3]); w.z = pk2(y[4], y[5]); w.w = pk2(y[6], y[7]);
        *(u32x4*)(Y + (size_t)row * D + 512 + idx) = w;
    }
}

constexpr int RW_PITCH = 1028;
__device__ __forceinline__ void phase_l5a(const Ctx& C, int l) {
    LAS float* rwT = (LAS float*)C.lds;
    LAS int* lcnt = (LAS int*)(C.lds + 16 * RW_PITCH * 4);
    LAS float* wsc = (LAS float*)(C.lds + 16 * RW_PITCH * 4 + 128) + C.wave * 384;
    const float* rw = C.in[IN_RW];
    for (int i = C.tid; i < 16 * 1024; i += NTHR) { const int k = i >> 4, e = i & 15; rwT[e * RW_PITCH + k] = rw[i]; }
    if (C.tid < 32) lcnt[C.tid] = 0;
    __syncthreads();
    const int gw = C.bid * NWAVES + C.wave, NGW = C.G * NWAVES;
    const float* mods = WSP(const float, WS_MODS) + (size_t)l * 9 * 6144;
    const float* bias2 = WSP(const float, WS_BIAS2) + l * 9 * 16;
    const float* xb = WSP(const float, WS_XBUF);
    const float* rbias = C.in[IN_RB];
    unsigned* cnt = WSP(unsigned, WS_CTL) + CW_CNT + l * 32 * 64;
    int* tokinfo = WSP(int, WS_TOKINFO);
    const int ngroups = ((l < DEPTH - 1) ? NTOK : NLAT) / 16;
    const int li = C.lane & 15, kq = C.lane >> 4;
    for (int g = gw; g < ngroups; g += NGW) {
        const int row0 = g * 16, bb = bidx(row0);
        const float* xp = xb + (size_t)(row0 + li) * D + kq * 4;
        const float* scp = mods + bb * 6144 + 4096 + kq * 4;
        const LAS float* bp = rwT + li * RW_PITCH + kq * 4;
        f32x4 acc0 = (f32x4){0.f, 0.f, 0.f, 0.f}, acc1 = acc0, acc2 = acc0, acc3 = acc0; float ss = 0.f;
#pragma unroll 8
        for (int m = 0; m < 64; ++m) {
            const f32x4 xv = *(const f32x4*)(xp + 16 * m), sc = *(const f32x4*)(scp + 16 * m), bv = *(const LAS f32x4*)(bp + 16 * m);
            ss += (xv.x * xv.x + xv.y * xv.y) + (xv.z * xv.z + xv.w * xv.w);
            const f32x4 av = xv * (sc + 1.0f);
            acc0 = __builtin_amdgcn_mfma_f32_16x16x4f32(av.x, bv.x, acc0, 0, 0, 0);
            acc1 = __builtin_amdgcn_mfma_f32_16x16x4f32(av.y, bv.y, acc1, 0, 0, 0);
            acc2 = __builtin_amdgcn_mfma_f32_16x16x4f32(av.z, bv.z, acc2, 0, 0, 0);
            acc3 = __builtin_amdgcn_mfma_f32_16x16x4f32(av.w, bv.w, acc3, 0, 0, 0);
        }
        const f32x4 acc = (acc0 + acc1) + (acc2 + acc3);
        wsc[C.lane] = ss;
#pragma unroll
        for (int r = 0; r < 4; ++r) wsc[64 + (4 * kq + r) * 17 + li] = acc[r];
        LDS_WAIT(); asm volatile("" ::: "memory");
        if (C.lane < 16) {
            const int row = row0 + C.lane;
            const float sst = (wsc[C.lane] + wsc[16 + C.lane]) + (wsc[32 + C.lane] + wsc[48 + C.lane]);
            const float rinv = 1.0f / sqrtf(sst * (1.0f / D) + EPS);
            float lg[16];
#pragma unroll
            for (int e = 0; e < 16; ++e) lg[e] = rinv * wsc[64 + C.lane * 17 + e] + bias2[bb * 16 + e];
            float mx = lg[0];
#pragma unroll
            for (int e = 1; e < 16; ++e) mx = fmaxf(mx, lg[e]);
            float sc[16], se = 0.f;
#pragma unroll
            for (int e = 0; e < 16; ++e) { sc[e] = expf(lg[e] - mx); se += sc[e]; }
            float sel[16];
#pragma unroll
            for (int e = 0; e < 16; ++e) { sc[e] = sc[e] / se; sel[e] = sc[e] + rbias[e]; }
            float bestgs = -3.4e38f; int bg = 0; float bs[4], bsc[4];
#pragma unroll
            for (int gg = 0; gg < 4; ++gg) {
                float m1 = -3.4e38f, m2 = -3.4e38f;
#pragma unroll
                for (int i = 0; i < 4; ++i) { const float x = sel[4 * gg + i]; if (x > m1) { m2 = m1; m1 = x; } else if (x > m2) m2 = x; }
                const float gs = m1 + m2;
                if (gs > bestgs) { bestgs = gs; bg = gg;
#pragma unroll
                    for (int i = 0; i < 4; ++i) { bs[i] = sel[4 * gg + i]; bsc[i] = sc[4 * gg + i]; } }
            }
            int i0 = 0; float b0 = bs[0];
#pragma unroll
            for (int i = 1; i < 4; ++i) if (bs[i] > b0) { b0 = bs[i]; i0 = i; }
            int i1 = -1; float b1 = -3.4e38f;
#pragma unroll
            for (int i = 0; i < 4; ++i) if (i != i0 && bs[i] > b1) { b1 = bs[i]; i1 = i; }
            float w0 = 0.f, w1 = 0.f;
#pragma unroll
            for (int i = 0; i < 4; ++i) { if (i == i0) w0 = bsc[i]; if (i == i1) w1 = bsc[i]; }
            const float wn = w0 + w1; w0 /= wn; w1 /= wn;
            const int lo = i0 < i1 ? i0 : i1, hi = i0 < i1 ? i1 : i0;
            const float wlo = i0 < i1 ? w0 : w1, whi = i0 < i1 ? w1 : w0;
            const int bin = bg * 6 + (lo * (7 - lo)) / 2 + (hi - lo - 1);
            const int slot = __hip_atomic_fetch_add(lcnt + bin, 1, __ATOMIC_RELAXED, __HIP_MEMORY_SCOPE_WORKGROUP);
            *(int4*)(tokinfo + (size_t)row * 4) = make_int4(bin, slot, __float_as_int(wlo), __float_as_int(whi));
        }
        LDS_WAIT(); asm volatile("" ::: "memory");
    }
    __syncthreads();
    if (C.tid < NBIN && !C.dry) { const int n = lcnt[C.tid];
        WSP(int, WS_BLKBASE)[C.bid * 32 + C.tid] = n > 0 ? (int)__hip_atomic_fetch_add(cnt + C.tid * 64, (unsigned)n, __ATOMIC_RELAXED, __HIP_MEMORY_SCOPE_AGENT) : 0; }
}
__device__ __forceinline__ void phase_l5b(const Ctx& C, int l) {
    build_tiletab(C, l);
    const volatile LAS int* lc = (const volatile LAS int*)(C.lds + LDSCTL_OFF);
    const int gw = C.bid * NWAVES + C.wave, NGW = C.G * NWAVES;
    const float* mods = WSP(const float, WS_MODS) + (size_t)l * 9 * 6144;
    const float* xb = WSP(const float, WS_XBUF);
    const int* tokinfo = WSP(const int, WS_TOKINFO); const int* blkbase = WSP(const int, WS_BLKBASE);
    bf16_t* hs = WSP(bf16_t, WS_PHG); int* rowtok = WSP(int, WS_ROWTOK); float* roww = WSP(float, WS_ROWW);
    const int nrows = (l < DEPTH - 1) ? NTOK : NLAT;
    f32x4 nv[4]; int4 nti = make_int4(0, 0, 0, 0);
    if (gw < nrows) { nti = *(const int4*)(tokinfo + (size_t)gw * 4);
#pragma unroll
        for (int j = 0; j < 4; ++j) nv[j] = *(const f32x4*)(xb + (size_t)gw * D + C.lane * 4 + 256 * j); }
    for (int row = gw; row < nrows; row += NGW) {
        const int4 ti = nti;
        const int pos = lc[LC_OFFS + ti.x] + blkbase[(((row >> 4) % NGW) >> 3) * 32 + ti.x] + ti.y;
        const float* md = mods + bidx(row) * 6144;
        f32x4 v[4]; float ss = 0.f;
#pragma unroll
        for (int j = 0; j < 4; ++j) v[j] = nv[j];
        if (row + NGW < nrows) { nti = *(const int4*)(tokinfo + (size_t)(row + NGW) * 4);
#pragma unroll
            for (int j = 0; j < 4; ++j) nv[j] = *(const f32x4*)(xb + (size_t)(row + NGW) * D + C.lane * 4 + 256 * j); }
#pragma unroll
        for (int j = 0; j < 4; ++j) ss += (v[j].x * v[j].x + v[j].y * v[j].y) + (v[j].z * v[j].z + v[j].w * v[j].w);
        ss = wave_sum(ss); const float rinv = 1.0f / sqrtf(ss * (1.0f / D) + EPS);
#pragma unroll
        for (int j = 0; j < 4; ++j) { const int k = C.lane * 4 + 256 * j; const f32x4 sh = *(const f32x4*)(md + 3072 + k), sc = *(const f32x4*)(md + 4096 + k);
            const f32x4 o = v[j] * rinv * (sc + 1.0f) + sh; u32x2 w; w.x = pk2(o.x, o.y); w.y = pk2(o.z, o.w);
            *(u32x2*)(hs + (size_t)pos * D + k) = w; }
        if (C.lane == 0) { rowtok[pos] = row; roww[pos * 2] = __int_as_float(ti.z); roww[pos * 2 + 1] = __int_as_float(ti.w); }
    }
    if (C.bid < NBIN) { const int b = C.bid; const int start = lc[LC_OFFS + b], end = lc[LC_OFFS + b + 1];
        const int n = (int)__hip_atomic_load(WSP(unsigned, WS_CTL) + CW_CNT + (l * 32 + b) * 64, __ATOMIC_RELAXED, __HIP_MEMORY_SCOPE_AGENT);
        float zf_ = 0.f; asm volatile("" : "+v"(zf_));
        for (int p = start + n + C.tid; p < end; p += NTHR) { rowtok[p] = -1; roww[p * 2] = zf_; roww[p * 2 + 1] = zf_; } }
}

__device__ __forceinline__ void phase_final(const Ctx& C) {
    const int gw = C.bid * NWAVES + C.wave, NGW = C.G * NWAVES;
    const float* xb = WSP(const float, WS_XBUF); const float* fw = C.in[IN_FNW];
    f32x4 nv[4];
    if (gw < NLAT) {
#pragma unroll
        for (int j = 0; j < 4; ++j) nv[j] = *(const f32x4*)(xb + (size_t)gw * D + C.lane * 4 + 256 * j); }
    for (int row = gw; row < NLAT; row += NGW) {
        f32x4 v[4]; float ss = 0.f;
#pragma unroll
        for (int j = 0; j < 4; ++j) v[j] = nv[j];
        if (row + NGW < NLAT) {
#pragma unroll
            for (int j = 0; j < 4; ++j) nv[j] = *(const f32x4*)(xb + (size_t)(row + NGW) * D + C.lane * 4 + 256 * j); }
#pragma unroll
        for (int j = 0; j < 4; ++j) ss += (v[j].x * v[j].x + v[j].y * v[j].y) + (v[j].z * v[j].z + v[j].w * v[j].w);
        ss = wave_sum(ss); const float rinv = 1.0f / sqrtf(ss * (1.0f / D) + EPS);
#pragma unroll
        for (int j = 0; j < 4; ++j) { const int k = C.lane * 4 + 256 * j; const f32x4 w = *(const f32x4*)(fw + k);
            *(f32x4*)(C.out + (size_t)row * D + k) = v[j] * rinv * w; }
    }
}

constexpr int PH_PER_LAYER = 8, N_PHASES = 2 + DEPTH * PH_PER_LAYER + 1;
__global__ void __launch_bounds__(NTHR, 2) trunk_fwd(Args args) {
    extern __shared__ __attribute__((aligned(16))) unsigned char lds[];
    Ctx C; C.in = (const CAS fptr_t*)__builtin_amdgcn_kernarg_segment_ptr(); C.out = args.out; C.ws = args.ws; C.lds = (LAS unsigned char*)lds;
    C.tid = threadIdx.x; C.lane = C.tid & 63; C.wave = __builtin_amdgcn_readfirstlane(C.tid >> 6); C.G = gridDim.x; C.bid = blockIdx.x; C.rep = args.rep; C.dry = (args.rep + 1 < (args.pad & 255)) ? (args.pad >> 8) : 0;
    LAS unsigned char* ldsl0 = (LAS unsigned char*)lds;
    if (C.tid < 64) ((LAS unsigned*)(ldsl0 + LDSCTL_OFF))[C.tid] = 0u;
    __syncthreads();
    const int lo = args.ph_lo, hi = args.ph_hi;
    XcdBarrier bar; bar.bar = WSP(unsigned, WS_CTL) + CW_BAR; bar.x = 0; bar.st = (volatile LAS unsigned*)(ldsl0 + LDSCTL_OFF + LC_BAR);
    if (hi - lo > 1) bar = xcd_barrier_post(WSP(unsigned, WS_CTL) + CW_BAR, (volatile LAS unsigned*)(ldsl0 + LDSCTL_OFF + LC_BAR));
#define FRESH_TID (C.wave * 64 + lane_id_opaque())
#define IN(k) (lo <= (k) && (k) < hi)
#define SEAM(k) do { if (IN(k) && IN((k) + 1)) xcd_barrier(bar, FRESH_TID); } while (0)
#ifndef EN
#define EN 0xFFFF
#endif
    if ((EN & 1) && IN(0)) { phase0(C); SEAM(0); }
    if ((EN & 1) && IN(1)) {
        if (C.bid == C.G - 1) {
            const float* md = WSP(const float, WS_MODS); const float* rw = C.in[IN_RW]; float* b2 = WSP(float, WS_BIAS2);
            for (int o = C.tid; o < 4 * 9 * 16; o += NTHR) { const int lr = o >> 4, e = o & 15; const float* sh = md + (size_t)lr * 6144 + 3072; float sacc = 0.f;
                for (int k = 0; k < 1024; ++k) sacc += sh[k] * rw[k * 16 + e];
                b2[o] = sacc; }
        }
        SchedFilt S{C.G, C.bid};
        EpiFilt E{WSP(bf16_t, WS_HF), C.in[IN_B3]};
        pg8::gemm_phase<false>(ldsl0, S, E, (const char*)WSP(bf16_t, WS_W3T), (const char*)WSP(bf16_t, WS_HPAD), 128, 128, 128u * 128u * 2u, 128u * 128u * 2u, 2, FRESH_TID);
        SEAM(1);
    }
    const Ctx C0 = C;
#pragma unroll 1
    for (int l = 0; l < DEPTH; ++l) {
        const int p0 = 2 + l * PH_PER_LAYER;
        Ctx C = C0; { int t_ = C0.wave * 64 + lane_id_opaque(); asm volatile("" : "+v"(t_)); C.tid = t_; C.lane = t_ & 63; C.wave = __builtin_amdgcn_readfirstlane(t_ >> 6);
                      int b_ = C0.bid; asm volatile("" : "+s"(b_)); C.bid = b_; int g_ = C0.G; asm volatile("" : "+s"(g_)); C.G = g_; unsigned char* w_ = C0.ws; asm volatile("" : "+s"(w_)); C.ws = w_;
                      const CAS fptr_t* i_ = C0.in; asm volatile("" : "+s"(i_)); C.in = i_;
                      LAS unsigned char* l_ = C0.lds; asm volatile("" : "+s"(l_)); C.lds = l_; }
        LAS unsigned char* const ldsl = C.lds;
        const float* modl = WSP(const float, WS_MODS) + (size_t)l * 9 * 6144;
        if ((EN & 2) && IN(p0 + 0)) { phase_l1(C, l); SEAM(p0 + 0); }
        if ((EN & 4) && IN(p0 + 1)) {
            { pg8::SchedDense S; S.init(NTOK / 256, NHG / 256, C.G, C.bid, D, D);
              EpiHG E{WSP(bf16_t, WS_PHG), WSP(const float, WS_LOWER) + l * 512};
              pg8::gemm_phase<false>(ldsl, S, E, (const char*)WSP(bf16_t, WS_R1), (const char*)(WSP(bf16_t, WS_WIN) + (size_t)NHY * D), D, D, 128u * D * 2u, 128u * D * 2u, D / 64, FRESH_TID); }
            { pg8::SchedDense S; S.init(NHY / 256, NTOK / 256, C.G, C.bid, D, D);
              EpiHY E{WSP(bf16_t, WS_PHYT)};
              pg8::gemm_phase<false>(ldsl, S, E, (const char*)WSP(bf16_t, WS_WIN), (const char*)WSP(bf16_t, WS_R1), D, D, 128u * D * 2u, 128u * D * 2u, D / 64, FRESH_TID); }
            SEAM(p0 + 1);
        }
        if ((EN & 8) && IN(p0 + 2)) { phase_l3(C, l); SEAM(p0 + 2); }
        if ((EN & 16) && IN(p0 + 3)) { phase_l3b(C, l); SEAM(p0 + 3); }
        if ((EN & 32) && IN(p0 + 4)) {
            pg8::SchedDense S; S.init(NTOK / 256, D / 256, C.G, C.bid, D, D);
            EpiOut E{C.in[IN_X], C.in[IN_CTX], WSP(float, WS_XBUF), modl, l == 0 ? 1 : 0, C.dry};
            pg8::gemm_phase<false>(ldsl, S, E, (const char*)WSP(bf16_t, WS_R1), (const char*)WSP(bf16_t, WS_WOUT), D, D, 128u * D * 2u, 128u * D * 2u, D / 64, FRESH_TID);
            SEAM(p0 + 4);
        }
        if ((EN & 64) && IN(p0 + 5)) { phase_l5a(C, l); SEAM(p0 + 5); }
        if ((EN & 128) && IN(p0 + 6)) { phase_l5b(C, l); SEAM(p0 + 6); }
        if ((EN & 256) && IN(p0 + 7)) {
            build_tiletab(C, l);
            const volatile LAS int* lc = (const volatile LAS int*)(ldsl + LDSCTL_OFF);
            const int n6 = 4 * lc[LC_T];
            unsigned* cnt6 = WSP(unsigned, WS_CTL) + CW_T6 + l * 96 * 64;
#pragma unroll 1
            for (int idx = C.bid; idx < n6; idx += C.G) {
                SchedUp1 S{idx, lc + LC_TILEBIN};
                EpiAct E{WSP(bf16_t, WS_R1), WSP(const float, WS_ROWW)};
                pg8::gemm_phase<false>(ldsl, S, E, (const char*)WSP(bf16_t, WS_PHG), (const char*)WSP(bf16_t, WS_WG), D, D, 128u * D * 2u, (unsigned)(WS_WU - WS_WG), D / 64, FRESH_TID);
                asm volatile("s_waitcnt vmcnt(0)" ::: "memory");
                __syncthreads();
                if (C.wave * 64 + lane_id_opaque() == 0) {
                    __hip_atomic_fetch_add(cnt6 + (idx >> 2) * 64, 1u, __ATOMIC_RELAXED, __HIP_MEMORY_SCOPE_AGENT); }
            }
            int nb2 = n6 - C.G; nb2 = nb2 < 0 ? 0 : (nb2 > C.G - 64 ? C.G - 64 : nb2);
            const int nw = C.G - nb2;
            if (C.bid >= nb2) {
#pragma unroll 1
                for (int j = C.bid - nb2; j < n6; j += nw) {
                    if (C.wave * 64 + lane_id_opaque() == 0) { unsigned* cw = cnt6 + (j >> 2) * 64; unsigned sp = 0;
                        while (__hip_atomic_load(cw, __ATOMIC_RELAXED, __HIP_MEMORY_SCOPE_AGENT) < 4u) { __builtin_amdgcn_s_sleep(2); if (++sp > (1u << 22)) break; }
                        __builtin_amdgcn_fence(__ATOMIC_ACQUIRE, "agent"); asm volatile("s_waitcnt vmcnt(0)" ::: "memory"); }
                    __syncthreads();
                    SchedDown1 S{j, lc + LC_TILEBIN};
                    EpiDown E{WSP(float, WS_XBUF), WSP(const int, WS_ROWTOK), modl, C.dry};
                    pg8::gemm_phase<true>(ldsl, S, E, (const char*)WSP(bf16_t, WS_R1), (const char*)WSP(bf16_t, WS_WD), 512, 256, 128u * 512u * 2u, 128u * 256u * 2u, 4, FRESH_TID);
                }
            }
            SEAM(p0 + 7);
        }
    }
    if ((EN & 1024) && IN(N_PHASES - 1)) { Ctx CF = C0; CF.tid = C0.wave * 64 + lane_id_opaque(); CF.lane = CF.tid & 63; phase_final(CF); }
#undef IN
#undef SEAM
}

extern "C" void kernel_launch(void* const* d_in, const int* in_sizes, int n_in, void* d_out, int out_size, void* d_ws, size_t ws_size, hipStream_t stream) {
    static int grid = 0;
    if (grid == 0) {
        if (n_in != N_IN || in_sizes[0] != NLAT * D || out_size != NLAT * D || ws_size < WS_END) { fprintf(stderr, "kernel_launch: unexpected shapes / workspace (%d inputs, ws %zu < %zu)\n", n_in, ws_size, (size_t)WS_END); grid = -1; return; }
        int dev = 0, cus = 0, per_cu = 0;
        if (hipGetDevice(&dev) != hipSuccess || hipDeviceGetAttribute(&cus, hipDeviceAttributeMultiprocessorCount, dev) != hipSuccess) { grid = -1; return; }
        if (hipFuncSetAttribute((const void*)trunk_fwd, hipFuncAttributeMaxDynamicSharedMemorySize, LDS_BYTES) != hipSuccess) { fprintf(stderr, "kernel_launch: hipFuncSetAttribute failed\n"); grid = -1; return; }
        if (hipOccupancyMaxActiveBlocksPerMultiprocessor(&per_cu, (const void*)trunk_fwd, NTHR, LDS_BYTES) != hipSuccess || per_cu < 1) { fprintf(stderr, "kernel_launch: occupancy query says %d\n", per_cu); }
        (void)hipGetLastError();
        grid = cus;
    }
    if (grid < 0) return;
    (void)hipMemsetAsync((char*)d_ws + WS_CTL, 0, CTL_ZERO_BYTES, stream);
    Args a{};
    for (int i = 0; i < N_IN; ++i) a.in[i] = (const float*)d_in[i];
    a.out = (float*)d_out; a.ws = (unsigned char*)d_ws;
#if MK_PER_PHASE
    for (int p = 0; p < N_PHASES; ++p) { a.ph_lo = p; a.ph_hi = p + 1; const int kind = p == 0 ? 0 : (p == 1 ? 11 : (p == N_PHASES - 1 ? 10 : 1 + (p - 2) % PH_PER_LAYER));
        const int nrep = ((PROBE_HOST >> kind) & 1) ? 2 : 1; a.pad = nrep | (PROBE_SKIP << 8);
        for (int rep = 0; rep < nrep; ++rep) { a.rep = rep; hipLaunchKernelGGL(trunk_fwd, dim3(grid), dim3(NTHR), LDS_BYTES, stream, a); } }
#else
    a.ph_lo = 0; a.ph_hi = N_PHASES; a.rep = 0; a.pad = 1;
    hipLaunchKernelGGL(trunk_fwd, dim3(grid), dim3(NTHR), LDS_BYTES, stream, a);
#endif
}
```

```cpp
#include <hip/hip_runtime.h>
#include <cstdio>
#include <cstdint>

#ifndef PROBE_HOST
#define PROBE_HOST 0
#endif
#ifndef PROBE_SKIP
#define PROBE_SKIP 1
#endif
#ifndef MK_PER_PHASE
#define MK_PER_PHASE 0
#endif

#define LAS __attribute__((address_space(3)))
typedef unsigned short bf16_t;
typedef short bf16x8 __attribute__((ext_vector_type(8)));
typedef float f32x4 __attribute__((ext_vector_type(4)));
typedef float f32x2 __attribute__((ext_vector_type(2)));
typedef unsigned u32x4 __attribute__((ext_vector_type(4)));
typedef unsigned u32x2 __attribute__((ext_vector_type(2)));

constexpr int NB = 8, SEQ = 2048, D = 1024, DEPTH = 4, CTXL = 256;
constexpr int NLAT = NB * SEQ, NCTX = NB * CTXL, NTOK = NLAT + NCTX;
constexpr int DH = 512, NHY = 1536, NHG = 2560, DIN = 4096;
constexpr int NE = 16, DE = 256, NBIN = 24, SROWS = 24576;
constexpr float EPS = 1e-6f;
constexpr int NTHR = 512, NWAVES = 8;
enum { IN_X = 0, IN_C, IN_CTX, IN_CCTX, IN_WMOD, IN_BMOD, IN_WIN, IN_WOUT, IN_CONVW, IN_CONVB, IN_W1, IN_B1, IN_W2, IN_B2, IN_W3, IN_B3,
       IN_HYBIAS, IN_LB, IN_NORMW, IN_RW, IN_RB, IN_WG, IN_WU, IN_WD, IN_FNW, N_IN };

constexpr size_t MiB = 1u << 20;
constexpr size_t WS_CTL = 0, CTL_ZERO_BYTES = 1 * MiB;
constexpr size_t WS_MODS = 1 * MiB;
constexpr size_t WS_LOWER = 2 * MiB;
constexpr size_t WS_BIAS2 = 2 * MiB + 64 * 1024;
constexpr size_t WS_HPAD = 3 * MiB;
constexpr size_t WS_TOKINFO = 6 * MiB;
constexpr size_t WS_BLKBASE = 6 * MiB + 320 * 1024;
constexpr size_t WS_ROWTOK = 6 * MiB + 512 * 1024;
constexpr size_t WS_ROWW = 7 * MiB;
constexpr size_t WS_WIN = 8 * MiB;
constexpr size_t WS_WOUT = 16 * MiB;
constexpr size_t WS_WG = 18 * MiB;
constexpr size_t WS_WU = 26 * MiB;
constexpr size_t WS_WD = 34 * MiB;
constexpr size_t WS_KSPEC = 42 * MiB;
constexpr size_t WS_XBUF = 74 * MiB;
constexpr size_t WS_R1 = 146 * MiB;
constexpr size_t WS_PHG = 182 * MiB;
constexpr size_t WS_PHYT = 272 * MiB;
constexpr size_t WS_ODIR = 326 * MiB;
constexpr size_t WS_KSPC = 362 * MiB;
constexpr size_t WS_W3T = 378 * MiB;
constexpr size_t WS_HF = 380 * MiB;
constexpr size_t WS_END = 416 * MiB;
constexpr int CW_BAR = 4096;
constexpr int CW_CNT = 16384;
constexpr int CW_T6 = 65536;
constexpr int CW_Q = 32768;

constexpr int LDS_BYTES = 147456;
constexpr int LDSCTL_OFF = 143 * 1024;
constexpr int LC_BAR = 0;
constexpr int LC_T = 8;
constexpr int LC_Q = 9;
constexpr int LC_OFFS = 16;
constexpr int LC_TILEBIN = 48;

__device__ __forceinline__ unsigned f2bf(float f) { return (unsigned)__builtin_bit_cast(unsigned short, (__bf16)f); }
typedef __bf16 bf16x2v __attribute__((ext_vector_type(2)));
__device__ __forceinline__ unsigned pk2(float lo, float hi) { const f32x2 v = {lo, hi}; return __builtin_bit_cast(unsigned, __builtin_convertvector(v, bf16x2v)); }
__device__ __forceinline__ float bf2f(unsigned b) { return __builtin_bit_cast(float, (b & 0xffffu) << 16); }
__device__ __forceinline__ float bflo(unsigned w) { return __builtin_bit_cast(float, w << 16); }
__device__ __forceinline__ float bfhi(unsigned w) { return __builtin_bit_cast(float, w & 0xffff0000u); }
__device__ __forceinline__ float sigmoidf_(float x) { return __builtin_amdgcn_rcpf(1.0f + __expf(-x)); }
__device__ __forceinline__ float siluf_(float x) { return x * __builtin_amdgcn_rcpf(1.0f + __expf(-x)); }
#define DPP_ADD(v, ctrl, rmask) v += __builtin_bit_cast(float, __builtin_amdgcn_update_dpp(0, __builtin_bit_cast(int, v), ctrl, rmask, 0xF, false))
__device__ __forceinline__ float row16_sum(float v) {
    DPP_ADD(v, 0xB1, 0xF);
    DPP_ADD(v, 0x4E, 0xF);
    DPP_ADD(v, 0x141, 0xF);
    DPP_ADD(v, 0x140, 0xF);
    return v;
}
__device__ __forceinline__ float wave_sum(float v) {
    v = row16_sum(v);
    DPP_ADD(v, 0x142, 0xA);
    DPP_ADD(v, 0x143, 0xC);
    return __builtin_bit_cast(float, __builtin_amdgcn_readlane(__builtin_bit_cast(int, v), 63));
}
__device__ __forceinline__ int lane_id_opaque() { int x; asm volatile("v_mbcnt_lo_u32_b32 %0, -1, 0\n\tv_mbcnt_hi_u32_b32 %0, -1, %0" : "=v"(x)); return x; }
__device__ __forceinline__ int bidx(int row) { return row < NLAT ? (row >> 11) : 8; }
#define LDS_WAIT() asm volatile("s_waitcnt lgkmcnt(0)" ::: "memory")

#define XB_TMO      128
#define XB_XCNT(j)  (256  + 64 * (j))
#define XB_XSUB(j)  (1280 + 64 * (j))
#define XB_XGEN(j)  (2304 + 64 * (j))
#define XB_TOP      3328
#define XB_TOPGEN   3392
#define XCD_BAR_WORDS 3456
#define XB_SPIN_CAP (1u << 18)
__device__ __forceinline__ unsigned xb_ld(unsigned* p)              { return __hip_atomic_load(p, __ATOMIC_RELAXED, __HIP_MEMORY_SCOPE_AGENT); }
__device__ __forceinline__ unsigned xb_add(unsigned* p, unsigned v) { return __hip_atomic_fetch_add(p, v, __ATOMIC_RELAXED, __HIP_MEMORY_SCOPE_AGENT); }
__device__ __forceinline__ unsigned xb_xcc_id() { return (unsigned)__builtin_amdgcn_s_getreg((3 << 11) | 20) & 0xFu; }
#define XB_SPIN(cond, bar) do { unsigned _sp = 0; while (cond) { __builtin_amdgcn_s_sleep(1); \
    if ((++_sp & 255u) == 0u) { if (xb_ld(&(bar)[XB_TMO])) break; if (_sp > XB_SPIN_CAP) { atomicAdd(&(bar)[XB_TMO], 1u); break; } } } } while (0)
struct XcdBarrier { unsigned* bar; unsigned x; volatile LAS unsigned* st; };
__device__ __forceinline__ XcdBarrier xcd_barrier_post(unsigned* bar, volatile LAS unsigned* st) {
    XcdBarrier b; b.bar = bar; b.x = xb_xcc_id(); b.st = st;
    if (threadIdx.x == 0) (void)xb_add(&bar[XB_XCNT(b.x)], 1u);
    return b;
}
__device__ __forceinline__ void xcd_barrier_complete(unsigned* bar, unsigned x, unsigned& nloc, unsigned& nx) {
    const unsigned G = gridDim.x * gridDim.y * gridDim.z;
    unsigned sum, cnt, mine, sp = 0u;
    for (;;) {
        sum = 0u; cnt = 0u; mine = 0u;
#pragma unroll
        for (unsigned j = 0; j < 16; ++j) { const unsigned c = xb_ld(&bar[XB_XCNT(j)]); sum += c; cnt += (c > 0u) ? 1u : 0u; mine = (j == x) ? c : mine; }
        if (sum == G) break;
        __builtin_amdgcn_s_sleep(1);
        if ((++sp & 255u) == 0u) { if (xb_ld(&bar[XB_TMO])) break; if (sp > XB_SPIN_CAP) { atomicAdd(&bar[XB_TMO], 1u); break; } }
    }
    nloc = mine > 0u ? mine : 1u; nx = cnt > 0u ? cnt : 1u;
}
__device__ __forceinline__ void xcd_barrier(const XcdBarrier& b, const int tid0) {
    asm volatile("s_waitcnt vmcnt(0)" ::: "memory");
    __syncthreads();
    if (tid0 == 0) {
        unsigned* bar = b.bar; unsigned bx = b.x;
        asm volatile("" : "+s"(bar), "+s"(bx));
        __builtin_amdgcn_s_waitcnt(0);
        unsigned nloc = b.st[0], nx = b.st[1];
        if (nloc == 0u) { xcd_barrier_complete(bar, bx, nloc, nx); b.st[0] = nloc; b.st[1] = nx; }
        const unsigned old = xb_add(&bar[XB_XSUB(bx)], 1u);
        const unsigned gen = old / nloc;
        if (old + 1u == (gen + 1u) * nloc) {
            __builtin_amdgcn_fence(__ATOMIC_RELEASE, "agent");
            asm volatile("s_waitcnt vmcnt(0)" ::: "memory");
            const unsigned og = xb_add(&bar[XB_TOP], 1u);
            const unsigned tg = og / nx;
            if (og + 1u == (tg + 1u) * nx) xb_add(&bar[XB_TOPGEN], 1u);
            else XB_SPIN(xb_ld(&bar[XB_TOPGEN]) == tg, bar);
            __builtin_amdgcn_fence(__ATOMIC_ACQUIRE, "agent");
            xb_add(&bar[XB_XGEN(bx)], 1u);
            asm volatile("s_waitcnt vmcnt(0)" ::: "memory");
        } else {
            XB_SPIN(xb_ld(&bar[XB_XGEN(bx)]) == gen, bar);
            __builtin_amdgcn_fence(__ATOMIC_ACQUIRE, "agent");
            asm volatile("s_waitcnt vmcnt(0)" ::: "memory");
        }
    }
    __syncthreads();
}

namespace pg8 {
constexpr int BM = 256, BK = 64, HALF = 128, HTB = HALF * BK * 2, STAGE_BYTES = 8 * HTB, NXCD = 8, WGM = 8;
__host__ __device__ __forceinline__ int lds_byte(int r, int c) { const int st = (r >> 4) * 2 + (c >> 5), rr = r & 15, cc = c & 31, ob = rr * 64 + cc * 2; return st * 1024 + (ob ^ (((ob >> 9) & 1) << 5)); }
__host__ __device__ __forceinline__ void stage_rc(int b, int& R, int& C) { const int st = b / 1024, sb = b % 1024, swz = sb ^ (((sb >> 9) & 1) << 5); R = (st >> 1) * 16 + swz / 64; C = (st & 1) * 32 + (swz % 64) / 2; }
__host__ __device__ __forceinline__ int perm32(int rho) { const int n = rho >> 4, i = rho & 15; return 8 * (i >> 2) + 4 * n + (i & 3); }

struct GUnit { unsigned a, b; int last, i0, i1; };

template <bool SUB, class Epi, class Sched>
__device__ __forceinline__ void gemm_phase(LAS unsigned char* lds, const Sched& S, const Epi& E, const char* Abase, const char* Bbase, const int lda, const int ldb, const unsigned ahalf, const unsigned bhalf, const int nt, const int tid_in) {
    int tid_ = tid_in; asm volatile("" : "+v"(tid_));
    const int tid = tid_, wid = __builtin_amdgcn_readfirstlane(tid >> 6), lane = tid & 63, wr = wid >> 2, wc = wid & 3, fr = lane & 15, fq = lane >> 4;
    unsigned voffA[2], voffB[2];
#pragma unroll
    for (int i = 0; i < 2; ++i) { int R, C; stage_rc(tid * 16 + i * 8192, R, C); const int Rb = Epi::PERM ? ((R & ~31) + perm32(R & 31)) : R;
        voffA[i] = (unsigned)(R * lda + C) * 2u; voffB[i] = (unsigned)(Rb * ldb + C) * 2u; }
    constexpr unsigned kstep = BK * 2;
    const unsigned ldsw = (unsigned)wid * 1024u;
    const int aoff = lds_byte(wr * 64 + fr, fq * 8), boff = lds_byte(wc * 32 + fr, fq * 8);
#define PG8_SA(b, h) (((b) * 2 + (h)) * HTB)
#define PG8_SB(b, h) ((4 + (b) * 2 + (h)) * HTB)
#define PG8_STAGE(bufoff, gbase, voff) do { _Pragma("unroll") for (int _i = 0; _i < 2; ++_i) \
        __builtin_amdgcn_global_load_lds((const unsigned*)((const char*)(gbase) + (voff)[_i]), (LAS unsigned*)(lds + (bufoff) + ldsw + _i * 8192), 16, 0, 0); } while (0)
#define PG8_LDA(dst, b, h) do { _Pragma("unroll") for (int m = 0; m < 4; ++m) _Pragma("unroll") for (int k = 0; k < 2; ++k) dst[m][k] = *(const LAS bf16x8*)(lds + PG8_SA(b, h) + aoff + m * 2048 + k * 1024); } while (0)
#define PG8_LDB(dst, b, h) do { _Pragma("unroll") for (int n = 0; n < 2; ++n) _Pragma("unroll") for (int k = 0; k < 2; ++k) dst[n][k] = *(const LAS bf16x8*)(lds + PG8_SB(b, h) + boff + n * 2048 + k * 1024); } while (0)
#define PG8_MMA(ai, bj, At, Bt) do { __builtin_amdgcn_s_setprio(1); _Pragma("unroll") for (int m = 0; m < 4; ++m) _Pragma("unroll") for (int n = 0; n < 2; ++n) _Pragma("unroll") for (int k = 0; k < 2; ++k) \
        acc[ai][bj][m][n] = __builtin_amdgcn_mfma_f32_16x16x32_bf16(Bt[n][k], At[m][k], acc[ai][bj][m][n], 0, 0, 0); __builtin_amdgcn_s_setprio(0); } while (0)
#define PG8_WAIT_V(n) asm volatile("s_waitcnt vmcnt(" #n ")" ::: "memory")
#define PG8_WAIT_L(n) asm volatile("s_waitcnt lgkmcnt(" #n ")" ::: "memory")
#define PG8_BAR __builtin_amdgcn_s_barrier()
#define PG8_SCHED __builtin_amdgcn_sched_barrier(0)
    GUnit cur, nxt; int ui = 0;
    if (!S.next(0, cur)) return;
    f32x4 acc[2][2][4][2];
    float zf_ = 0.f; asm volatile("" : "+v"(zf_));
#pragma unroll
    for (int a = 0; a < 2; ++a)
#pragma unroll
        for (int b = 0; b < 2; ++b)
#pragma unroll
            for (int m = 0; m < 4; ++m)
#pragma unroll
                for (int n = 0; n < 2; ++n) acc[a][b][m][n] = (f32x4){zf_, zf_, zf_, zf_};
    bf16x8 At[4][2], B0[2][2], B1[2][2];
    { const char* cA = Abase + cur.a; const char* cB = Bbase + cur.b;
      PG8_STAGE(PG8_SB(0, 0), cB, voffB); PG8_STAGE(PG8_SB(0, 1), cB + bhalf, voffB); PG8_STAGE(PG8_SA(0, 0), cA, voffA); PG8_STAGE(PG8_SA(0, 1), cA + ahalf, voffA);
      if (wr == 1) PG8_BAR;
      PG8_WAIT_V(2); PG8_BAR;
      PG8_STAGE(PG8_SB(1, 0), cB + kstep, voffB); PG8_STAGE(PG8_SA(1, 0), cA + kstep, voffA); PG8_STAGE(PG8_SB(1, 1), cB + bhalf + kstep, voffB);
      PG8_WAIT_V(6); PG8_BAR; }
    for (;;) {
        const bool has_next = S.next(ui + 1, nxt);
        const char* cA = Abase + cur.a; const char* cB = Bbase + cur.b;
        const char* nA = Abase + (has_next ? nxt.a : cur.a); const char* nB = Bbase + (has_next ? nxt.b : cur.b);
        for (int t = 0; t < nt; t += 2) {
            const bool last = (t == nt - 2);
            const char* a1 = cA + (unsigned)(t + 1) * kstep;
            const char* a2 = last ? nA : cA + (unsigned)(t + 2) * kstep; const char* b2 = last ? nB : cB + (unsigned)(t + 2) * kstep;
            const char* a3 = a2 + kstep; const char* b3 = b2 + kstep;
            PG8_LDB(B0, 0, 0); PG8_LDB(B1, 0, 1); PG8_SCHED; PG8_LDA(At, 0, 0); PG8_STAGE(PG8_SA(1, 1), a1 + ahalf, voffA);
            PG8_WAIT_V(8); PG8_WAIT_L(0); PG8_BAR; PG8_MMA(0, 0, At, B0); PG8_MMA(0, 1, At, B1); PG8_BAR; PG8_SCHED;
            PG8_LDA(At, 0, 1); PG8_STAGE(PG8_SB(0, 0), b2, voffB); PG8_STAGE(PG8_SB(0, 1), b2 + bhalf, voffB); PG8_STAGE(PG8_SA(0, 0), a2, voffA);
            PG8_WAIT_V(8); PG8_WAIT_L(0); PG8_BAR; PG8_MMA(1, 0, At, B0); PG8_MMA(1, 1, At, B1); PG8_BAR; PG8_SCHED;
            PG8_LDB(B0, 1, 0); PG8_LDB(B1, 1, 1); PG8_SCHED; PG8_LDA(At, 1, 0); PG8_STAGE(PG8_SA(0, 1), a2 + ahalf, voffA);
            PG8_WAIT_V(8); PG8_WAIT_L(0); PG8_BAR; PG8_MMA(0, 0, At, B0); PG8_MMA(0, 1, At, B1); PG8_BAR; PG8_SCHED;
            PG8_LDA(At, 1, 1); PG8_STAGE(PG8_SB(1, 0), b3, voffB); PG8_STAGE(PG8_SB(1, 1), b3 + bhalf, voffB); PG8_STAGE(PG8_SA(1, 0), a3, voffA);
            PG8_WAIT_V(8); PG8_WAIT_L(0); PG8_BAR; PG8_MMA(1, 0, At, B0); PG8_MMA(1, 1, At, B1); PG8_BAR; PG8_SCHED;
        }
        const bool fin = SUB ? (cur.last != 0) : true;
        if (fin) { if (wr == 0) PG8_BAR; E(acc, cur, wr, wc, fr, fq); }
        if (!has_next) break;
        if (fin) {
#pragma unroll
            for (int a = 0; a < 2; ++a)
#pragma unroll
                for (int b = 0; b < 2; ++b)
#pragma unroll
                    for (int m = 0; m < 4; ++m)
#pragma unroll
                        for (int n = 0; n < 2; ++n) acc[a][b][m][n] = (f32x4){zf_, zf_, zf_, zf_};
        }
        cur = nxt; ++ui;
        if (fin) { if (wr == 1) PG8_BAR; }
    }
    PG8_WAIT_V(0);
    PG8_BAR;
#undef PG8_SA
#undef PG8_SB
#undef PG8_STAGE
#undef PG8_LDA
#undef PG8_LDB
#undef PG8_MMA
#undef PG8_WAIT_V
#undef PG8_WAIT_L
#undef PG8_BAR
#undef PG8_SCHED
}

struct SchedDense {
    int nM, nN, nwg, G, c; unsigned atile, btile;
    __device__ __forceinline__ void init(int nM_, int nN_, int G_, int c_, int lda, int ldb) {
        nM = nM_; nN = nN_; nwg = nM * nN; G = G_; c = c_; atile = 256u * lda * 2u; btile = 256u * ldb * 2u; }
    __device__ __forceinline__ bool next(int i, GUnit& u) const {
        const int L = i * G + c; if (L >= nwg) return false;
        int wgid = L; { const int q = nwg / NXCD, r = nwg % NXCD, xcd = wgid % NXCD, off = wgid / NXCD; wgid = (xcd < r ? xcd * (q + 1) : r * (q + 1) + (xcd - r) * q) + off; }
        const int nig = WGM * nN, gid = wgid / nig, fm = gid * WGM, gsz = (nM - fm) < WGM ? (nM - fm) : WGM;
        const int pm = fm + ((wgid % nig) % gsz), pn = (wgid % nig) / gsz;
        u.a = (unsigned)pm * atile; u.b = (unsigned)pn * btile; u.last = 1; u.i0 = pm; u.i1 = pn; return true;
    }
};
}

struct Args { const float* in[N_IN]; float* out; unsigned char* ws; int ph_lo, ph_hi, rep, pad; };
static_assert(sizeof(Args) == N_IN * 8 + 8 + 8 + 16, "Args has no padding");

#define CAS __attribute__((address_space(4)))
typedef const float* fptr_t;
struct Ctx {
    const CAS fptr_t* in; float* out; unsigned char* ws; LAS unsigned char* lds; int tid, lane, wave, G, bid, rep, dry;
};
#define WSP(T, off) ((T*)(C.ws + (off)))

__device__ __forceinline__ void build_tiletab(const Ctx& C, int l) {
    volatile LAS int* lc = (volatile LAS int*)(C.lds + LDSCTL_OFF);
    __syncthreads();
    if (C.tid == 0) {
        const unsigned* cnt = WSP(const unsigned, WS_CTL) + CW_CNT + l * 32 * 64;
        int off = 0, t = 0;
        for (int b = 0; b < NBIN; ++b) {
            const int n = (int)__hip_atomic_load(cnt + b * 64, __ATOMIC_RELAXED, __HIP_MEMORY_SCOPE_AGENT);
            lc[LC_OFFS + b] = off;
            const int nt = (n + 255) >> 8;
            for (int k = 0; k < nt; ++k) lc[LC_TILEBIN + t + k] = b;
            t += nt; off += nt * 256;
        }
        lc[LC_OFFS + NBIN] = off; lc[LC_T] = t;
    }
    __syncthreads();
}
__device__ __forceinline__ int expert_of(int bin, int es) {
    const int g = bin / 6, p = bin - g * 6;
    const int lo = p < 3 ? 0 : (p < 5 ? 1 : 2), hi = p < 3 ? p + 1 : (p < 5 ? p - 1 : 3);
    return 4 * g + (es ? hi : lo);
}

struct SchedUp {
    int T, G, c; const volatile LAS int* tilebin;
    __device__ __forceinline__ bool next(int i, pg8::GUnit& u) const {
        const int idx = i * G + c; if (idx >= 4 * T) return false;
        const int rt = idx >> 2, q = idx & 3, es = q >> 1, fb = q & 1;
        const int bin = __builtin_amdgcn_readfirstlane(tilebin[rt]);
        const int e = expert_of(bin, es);
        u.a = (unsigned)rt * 256u * 2048u; u.b = (unsigned)(e * 256 + fb * 128) * 2048u;
        u.last = 1; u.i0 = rt; u.i1 = q; return true;
    }
};
struct SchedDown {
    int T, G, c; const volatile LAS int* tilebin;
    __device__ __forceinline__ bool next(int i, pg8::GUnit& u) const {
        const int idx = (i >> 1) * G + c, sub = i & 1; if (idx >= 4 * T) return false;
        const int rt = idx >> 2, pn = idx & 3;
        const int bin = __builtin_amdgcn_readfirstlane(tilebin[rt]);
        const int e = expert_of(bin, sub);
        u.a = (unsigned)rt * 256u * 1024u + (unsigned)sub * 512u; u.b = (unsigned)(e * 1024 + pn * 256) * 512u;
        u.last = sub; u.i0 = rt; u.i1 = pn; return true;
    }
};

struct SchedUp1 {
    int idx; const volatile LAS int* tilebin;
    __device__ __forceinline__ bool next(int i, pg8::GUnit& u) const {
        if (i != 0) return false;
        const int rt = idx >> 2, q = idx & 3, es = q >> 1, fb = q & 1;
        const int bin = __builtin_amdgcn_readfirstlane(tilebin[rt]);
        const int e = expert_of(bin, es);
        u.a = (unsigned)rt * 256u * 2048u; u.b = (unsigned)(e * 256 + fb * 128) * 2048u;
        u.last = 1; u.i0 = rt; u.i1 = q; return true;
    }
};
struct SchedDown1 {
    int idx; const volatile LAS int* tilebin;
    __device__ __forceinline__ bool next(int i, pg8::GUnit& u) const {
        if (i > 1) return false;
        const int sub = i, rt = idx >> 2, pn = idx & 3;
        const int bin = __builtin_amdgcn_readfirstlane(tilebin[rt]);
        const int e = expert_of(bin, sub);
        u.a = (unsigned)rt * 256u * 1024u + (unsigned)sub * 512u; u.b = (unsigned)(e * 1024 + pn * 256) * 512u;
        u.last = sub; u.i0 = rt; u.i1 = pn; return true;
    }
};

struct EpiHG {
    static constexpr bool PERM = true;
    bf16_t* O; const float* lower;
    __device__ __forceinline__ void operator()(const f32x4 (&acc)[2][2][4][2], const pg8::GUnit& u, int wr, int wc, int fr, int fq) const {
        const int kind = u.i1 >> 1;
        const int row0 = u.i0 * 256 + wr * 64 + fr, colt = u.i1 * 256 + wc * 32 + 8 * fq;
#pragma unroll
        for (int bj = 0; bj < 2; ++bj) {
            const int col = colt + bj * 128;
            float om[8];
#pragma unroll
            for (int j = 0; j < 8; ++j) om[j] = 1.f;
            if (kind >= 3) { const float* lb = lower + (kind - 3) * 2048 + (col & 511);
#pragma unroll
                for (int j = 0; j < 8; ++j) om[j] = 1.f - lb[j]; }
#pragma unroll
            for (int ai = 0; ai < 2; ++ai)
#pragma unroll
                for (int m = 0; m < 4; ++m) {
                    float v[8];
#pragma unroll
                    for (int j = 0; j < 8; ++j) v[j] = acc[ai][bj][m][j >> 2][j & 3];
                    if (kind == 0) {
#pragma unroll
                        for (int j = 0; j < 8; ++j) v[j] = siluf_(v[j]);
                    } else if (kind >= 3) {
#pragma unroll
                        for (int j = 0; j < 8; ++j) v[j] = om[j] * sigmoidf_(-v[j]);
                    }
                    u32x4 w; w.x = pk2(v[0], v[1]); w.y = pk2(v[2], v[3]); w.z = pk2(v[4], v[5]); w.w = pk2(v[6], v[7]);
                    *(u32x4*)(O + (size_t)(row0 + ai * 128 + m * 16) * NHG + col) = w;
                }
        }
    }
};
struct EpiHY {
    static constexpr bool PERM = true;
    bf16_t* O;
    __device__ __forceinline__ void operator()(const f32x4 (&acc)[2][2][4][2], const pg8::GUnit& u, int wr, int wc, int fr, int fq) const {
        const int row0 = u.i0 * 256 + wr * 64 + fr, colt = u.i1 * 256 + wc * 32 + 8 * fq;
#pragma unroll
        for (int ai = 0; ai < 2; ++ai)
#pragma unroll
            for (int m = 0; m < 4; ++m)
#pragma unroll
                for (int bj = 0; bj < 2; ++bj) {
                    const f32x4 v0 = acc[ai][bj][m][0], v1 = acc[ai][bj][m][1];
                    u32x4 w; w.x = pk2(v0[0], v0[1]); w.y = pk2(v0[2], v0[3]); w.z = pk2(v1[0], v1[1]); w.w = pk2(v1[2], v1[3]);
                    *(u32x4*)(O + (size_t)(row0 + ai * 128 + m * 16) * NTOK + colt + bj * 128) = w;
                }
    }
};
struct EpiOut {
    static constexpr bool PERM = false;
    const float* xlat; const float* xctx; float* xo; const float* mods; int first; int dry;
    __device__ __forceinline__ void operator()(const f32x4 (&acc)[2][2][4][2], const pg8::GUnit& u, int wr, int wc, int fr, int fq) const {
        const int row0 = u.i0 * 256 + wr * 64 + fr, col0 = u.i1 * 256 + wc * 32 + 4 * fq;
#pragma unroll
        for (int ai = 0; ai < 2; ++ai)
#pragma unroll
            for (int m = 0; m < 4; ++m) {
                const int row = row0 + ai * 128 + m * 16;
                const float* src = first ? (row < NLAT ? xlat + (size_t)row * D : xctx + (size_t)(row - NLAT) * D) : xo + (size_t)row * D;
                const float* g1 = mods + bidx(row) * 6144 + 2048;
#pragma unroll
                for (int bj = 0; bj < 2; ++bj)
#pragma unroll
                    for (int n = 0; n < 2; ++n) { const int col = col0 + bj * 128 + n * 16;
                        const f32x4 xv = *(const f32x4*)(src + col), gv = *(const f32x4*)(g1 + col);
                        if (!dry) *(f32x4*)(xo + (size_t)row * D + col) = xv + gv * acc[ai][bj][m][n]; }
            }
    }
};
struct EpiAct {
    static constexpr bool PERM = true;
    bf16_t* O; const float* roww;
    __device__ __forceinline__ void operator()(const f32x4 (&acc)[2][2][4][2], const pg8::GUnit& u, int wr, int wc, int fr, int fq) const {
        const int es = u.i1 >> 1; const int pos0 = u.i0 * 256 + wr * 64 + fr, col = u.i1 * 128 + wc * 32 + 8 * fq;
        const __amdgpu_buffer_rsrc_t rsrc = __builtin_amdgcn_make_buffer_rsrc(O, 0, SROWS * 512 * 2, 0x00020000);
#pragma unroll
        for (int ai = 0; ai < 2; ++ai)
#pragma unroll
            for (int m = 0; m < 4; ++m) {
                const int pos = pos0 + ai * 128 + m * 16;
                const float wgt = roww[pos * 2 + es];
                float v[8];
#pragma unroll
                for (int j = 0; j < 8; ++j) v[j] = siluf_(acc[ai][0][m][j >> 2][j & 3]) * acc[ai][1][m][j >> 2][j & 3] * wgt;
                u32x4 w; w.x = pk2(v[0], v[1]); w.y = pk2(v[2], v[3]); w.z = pk2(v[4], v[5]); w.w = pk2(v[6], v[7]);
                __builtin_amdgcn_raw_buffer_store_b128(w, rsrc, (unsigned)(pos * 512 + col) * 2u, 0, 16);
            }
    }
};
struct EpiDown {
    static constexpr bool PERM = false;
    float* xo; const int* rowtok; const float* mods; int dry;
    __device__ __forceinline__ void operator()(const f32x4 (&acc)[2][2][4][2], const pg8::GUnit& u, int wr, int wc, int fr, int fq) const {
        const int pos0 = u.i0 * 256 + wr * 64 + fr, col0 = u.i1 * 256 + wc * 32 + 4 * fq;
#pragma unroll
        for (int ai = 0; ai < 2; ++ai)
#pragma unroll
            for (int m = 0; m < 4; ++m) {
                const int tok = rowtok[pos0 + ai * 128 + m * 16];
                if (tok >= 0) {
                    const float* g2 = mods + bidx(tok) * 6144 + 5120;
                    float* xr = xo + (size_t)tok * D;
#pragma unroll
                    for (int bj = 0; bj < 2; ++bj)
#pragma unroll
                        for (int n = 0; n < 2; ++n) { const int col = col0 + bj * 128 + n * 16;
                            const f32x4 xv = *(const f32x4*)(xr + col), gv = *(const f32x4*)(g2 + col);
                            if (!dry) *(f32x4*)(xr + col) = xv + gv * acc[ai][bj][m][n]; }
                }
            }
    }
};

struct SchedFilt {
    int G, c;
    __device__ __forceinline__ bool next(int i, pg8::GUnit& u) const {
        const int idx = i * G + c; if (idx >= 4 * 72) return false;
        const int l = idx / 72, r = idx - l * 72, pm = r / 9, pn = r - pm * 9;
        u.a = (unsigned)(l * 2048 + pm * 256) * 256u; u.b = (unsigned)(l * 2304 + pn * 256) * 256u; u.last = 1; u.i0 = l * 16 + pm; u.i1 = pn; return true;
    }
};
struct EpiFilt {
    static constexpr bool PERM = true;
    bf16_t* HF; const float* b3;
    __device__ __forceinline__ void operator()(const f32x4 (&acc)[2][2][4][2], const pg8::GUnit& u, int wr, int wc, int fr, int fq) const {
        const int l = u.i0 >> 4, pm = u.i0 & 15;
        const int row0 = pm * 256 + wr * 64 + fr, t00 = u.i1 * 256 + wc * 32 + 8 * fq;
#pragma unroll
        for (int ai = 0; ai < 2; ++ai)
#pragma unroll
            for (int m = 0; m < 4; ++m) {
                const int row = row0 + ai * 128 + m * 16, c = row & 511;
                const float delta = fabsf(logf(1e-2f) / 0.3f + (float)c * ((logf(1e-2f) / 1.5f - logf(1e-2f) / 0.3f) / 511.0f));
                const float bias = b3[l * 2048 + row];
#pragma unroll
                for (int bj = 0; bj < 2; ++bj) {
                    const int t0 = t00 + bj * 128;
                    float v[8];
#pragma unroll
                    for (int j = 0; j < 8; ++j) { const int t = t0 + j; const float tn = t < 2048 ? (float)t / 2047.0f : (float)(t - 2048) / 255.0f;
                        v[j] = (acc[ai][bj][m][j >> 2][j & 3] + bias) * expf(-tn * delta); }
                    u32x4 w; w.x = pk2(v[0], v[1]); w.y = pk2(v[2], v[3]); w.z = pk2(v[4], v[5]); w.w = pk2(v[6], v[7]);
                    *(u32x4*)(HF + ((size_t)(l * 2048 + row)) * 2304 + t0) = w;
                }
            }
    }
};

__device__ __forceinline__ int padx(int i) { return i + (i >> 3); }
__device__ __forceinline__ f32x2 cmul(f32x2 a, f32x2 b) { return (f32x2){a.x * b.x - a.y * b.y, a.x * b.y + a.y * b.x}; }
__device__ __forceinline__ f32x2 cmulc(f32x2 a, f32x2 b) { return (f32x2){a.x * b.x + a.y * b.y, a.y * b.x - a.x * b.y}; }
constexpr int XPAD = 2048 + 256;

__device__ __forceinline__ void fft_p1_dif(f32x2 (&v)[8], int tt, const LAS f32x2* T) {
#pragma unroll
    for (int g = 0; g < 2; ++g) { const int u = tt + 256 * g;
#pragma unroll
        for (int j = 0; j < 2; ++j) { const f32x2 a = v[g + 2 * j], b = v[g + 2 * j + 4]; v[g + 2 * j] = a + b; v[g + 2 * j + 4] = cmul(a - b, T[2 * (u + 512 * j)]); }
        const f32x2 tw = T[4 * u];
        { const f32x2 a = v[g], b = v[g + 2]; v[g] = a + b; v[g + 2] = cmul(a - b, tw); }
        { const f32x2 a = v[g + 4], b = v[g + 6]; v[g + 4] = a + b; v[g + 6] = cmul(a - b, tw); } }
}
__device__ __forceinline__ void fft_p1_dit(f32x2 (&v)[8], int tt, const LAS f32x2* T) {
#pragma unroll
    for (int g = 0; g < 2; ++g) { const int u = tt + 256 * g;
        const f32x2 tw = T[4 * u];
        { const f32x2 a = v[g], b = cmulc(v[g + 2], tw); v[g] = a + b; v[g + 2] = a - b; }
        { const f32x2 a = v[g + 4], b = cmulc(v[g + 6], tw); v[g + 4] = a + b; v[g + 6] = a - b; }
#pragma unroll
        for (int j = 0; j < 2; ++j) { const f32x2 a = v[g + 2 * j], b = cmulc(v[g + 2 * j + 4], T[2 * (u + 512 * j)]); v[g + 2 * j] = a + b; v[g + 2 * j + 4] = a - b; } }
}
template <int Q> __device__ __forceinline__ void r8_dif(f32x2 (&e)[8], int r, const LAS f32x2* T) {
    constexpr int S2 = 512 / Q;
#pragma unroll
    for (int j = 0; j < 4; ++j) { const f32x2 a = e[j], b = e[j + 4]; e[j] = a + b; e[j + 4] = cmul(a - b, T[S2 * (r + Q * j)]); }
#pragma unroll
    for (int jj = 0; jj < 4; ++jj) { const int j = (jj & 1) + 4 * (jj >> 1); const f32x2 a = e[j], b = e[j + 2]; e[j] = a + b; e[j + 2] = cmul(a - b, T[2 * S2 * (r + Q * (j & 1))]); }
    const f32x2 tw = T[4 * S2 * r];
#pragma unroll
    for (int j = 0; j < 8; j += 2) { const f32x2 a = e[j], b = e[j + 1]; e[j] = a + b; e[j + 1] = cmul(a - b, tw); }
}
template <int Q> __device__ __forceinline__ void r8_dit(f32x2 (&e)[8], int r, const LAS f32x2* T) {
    constexpr int S2 = 512 / Q;
    const f32x2 tw = T[4 * S2 * r];
#pragma unroll
    for (int j = 0; j < 8; j += 2) { const f32x2 a = e[j], b = cmulc(e[j + 1], tw); e[j] = a + b; e[j + 1] = a - b; }
#pragma unroll
    for (int jj = 0; jj < 4; ++jj) { const int j = (jj & 1) + 4 * (jj >> 1); const f32x2 a = e[j], b = cmulc(e[j + 2], T[2 * S2 * (r + Q * (j & 1))]); e[j] = a + b; e[j + 2] = a - b; }
#pragma unroll
    for (int j = 0; j < 4; ++j) { const f32x2 a = e[j], b = cmulc(e[j + 4], T[S2 * (r + Q * j)]); e[j] = a + b; e[j + 4] = a - b; }
}
template <int Q, bool INV> __device__ __forceinline__ void fft_mid(LAS f32x2* X, int tt, const LAS f32x2* T) {
    const int blk = tt / Q, r = tt % Q, base = blk * 8 * Q + r;
    f32x2 e[8];
#pragma unroll
    for (int j = 0; j < 8; ++j) e[j] = X[padx(base + Q * j)];
    if (INV) r8_dit<Q>(e, r, T); else r8_dif<Q>(e, r, T);
#pragma unroll
    for (int j = 0; j < 8; ++j) X[padx(base + Q * j)] = e[j];
}
__device__ __forceinline__ void fft_conv_half(f32x2 (&v)[8], LAS f32x2* X, const LAS f32x2* T, const f32x2* K, int tt) {
    f32x2 kv[8];
#pragma unroll
    for (int j = 0; j < 8; ++j) kv[j] = K[8 * tt + j];
    fft_p1_dif(v, tt, T);
#pragma unroll
    for (int m = 0; m < 8; ++m) X[padx(tt + 256 * m)] = v[m];
    __syncthreads();
    fft_mid<64, false>(X, tt, T); __syncthreads();
    fft_mid<8, false>(X, tt, T); __syncthreads();
    f32x2 e[8];
#pragma unroll
    for (int j = 0; j < 8; ++j) e[j] = X[padx(8 * tt + j)];
    r8_dif<1>(e, 0, T);
#pragma unroll
    for (int j = 0; j < 8; ++j) e[j] = cmul(e[j], kv[j]);
    r8_dit<1>(e, 0, T);
#pragma unroll
    for (int j = 0; j < 8; ++j) X[padx(8 * tt + j)] = e[j];
    __syncthreads();
    fft_mid<8, true>(X, tt, T); __syncthreads();
    fft_mid<64, true>(X, tt, T); __syncthreads();
#pragma unroll
    for (int m = 0; m < 8; ++m) v[m] = X[padx(tt + 256 * m)];
    fft_p1_dit(v, tt, T);
}
__device__ __forceinline__ void fft_fwd_store(f32x2 (&v)[8], LAS f32x2* X, const LAS f32x2* T, f32x2* Kout, int tt) {
    fft_p1_dif(v, tt, T);
#pragma unroll
    for (int m = 0; m < 8; ++m) X[padx(tt + 256 * m)] = v[m];
    __syncthreads();
    fft_mid<64, false>(X, tt, T); __syncthreads();
    fft_mid<8, false>(X, tt, T); __syncthreads();
    f32x2 e[8];
#pragma unroll
    for (int j = 0; j < 8; ++j) e[j] = X[padx(8 * tt + j)];
    r8_dif<1>(e, 0, T);
#pragma unroll
    for (int j = 0; j < 8; ++j) Kout[8 * tt + j] = e[j];
    __syncthreads();
}
__device__ __forceinline__ int padx16(int i) { return i + (i >> 4); }
constexpr int XPAD16 = 2048 + 128;
template <int Q> __device__ __forceinline__ void r16_dif(f32x2 (&e)[16], int r, const LAS f32x2* T) {
    constexpr int S2 = 256 / Q;
#pragma unroll
    for (int j = 0; j < 8; ++j) { const f32x2 a = e[j], b = e[j + 8]; e[j] = a + b; e[j + 8] = cmul(a - b, T[S2 * (r + Q * j)]); }
#pragma unroll
    for (int jj = 0; jj < 8; ++jj) { const int j = (jj & 3) + 8 * (jj >> 2); const f32x2 a = e[j], b = e[j + 4]; e[j] = a + b; e[j + 4] = cmul(a - b, T[2 * S2 * (r + Q * (j & 3))]); }
#pragma unroll
    for (int jj = 0; jj < 8; ++jj) { const int j = (jj & 1) + 4 * (jj >> 1); const f32x2 a = e[j], b = e[j + 2]; e[j] = a + b; e[j + 2] = cmul(a - b, T[4 * S2 * (r + Q * (j & 1))]); }
    const f32x2 tw = T[8 * S2 * r];
#pragma unroll
    for (int j = 0; j < 16; j += 2) { const f32x2 a = e[j], b = e[j + 1]; e[j] = a + b; e[j + 1] = cmul(a - b, tw); }
}
template <int Q> __device__ __forceinline__ void r16_dit(f32x2 (&e)[16], int r, const LAS f32x2* T) {
    constexpr int S2 = 256 / Q;
    const f32x2 tw = T[8 * S2 * r];
#pragma unroll
    for (int j = 0; j < 16; j += 2) { const f32x2 a = e[j], b = cmulc(e[j + 1], tw); e[j] = a + b; e[j + 1] = a - b; }
#pragma unroll
    for (int jj = 0; jj < 8; ++jj) { const int j = (jj & 1) + 4 * (jj >> 1); const f32x2 a = e[j], b = cmulc(e[j + 2], T[4 * S2 * (r + Q * (j & 1))]); e[j] = a + b; e[j + 2] = a - b; }
#pragma unroll
    for (int jj = 0; jj < 8; ++jj) { const int j = (jj & 3) + 8 * (jj >> 2); const f32x2 a = e[j], b = cmulc(e[j + 4], T[2 * S2 * (r + Q * (j & 3))]); e[j] = a + b; e[j + 4] = a - b; }
#pragma unroll
    for (int j = 0; j < 8; ++j) { const f32x2 a = e[j], b = cmulc(e[j + 8], T[S2 * (r + Q * j)]); e[j] = a + b; e[j + 8] = a - b; }
}
__device__ __forceinline__ void fft_conv_half16(f32x2 (&v)[16], LAS f32x2* X, const LAS f32x2* T, const f32x2* K, int tt) {
    r16_dif<128>(v, tt, T);
#pragma unroll
    for (int m = 0; m < 16; ++m) X[padx16(tt + 128 * m)] = v[m];
    __syncthreads();
    const int r = tt & 7, base = (tt >> 3) * 128 + r;
#pragma unroll
    for (int j = 0; j < 16; ++j) v[j] = X[padx16(base + 8 * j)];
    r16_dif<8>(v, r, T);
#pragma unroll
    for (int j = 0; j < 16; ++j) X[padx16(base + 8 * j)] = v[j];
    f32x2 kv[16];
#pragma unroll
    for (int j = 0; j < 16; ++j) kv[j] = K[16 * tt + j];
    __syncthreads();
#pragma unroll
    for (int g = 0; g < 2; ++g) { f32x2 e[8];
#pragma unroll
        for (int j = 0; j < 8; ++j) e[j] = X[padx16(16 * tt + 8 * g + j)];
        r8_dif<1>(e, 0, T);
#pragma unroll
        for (int j = 0; j < 8; ++j) e[j] = cmul(e[j], kv[8 * g + j]);
        r8_dit<1>(e, 0, T);
#pragma unroll
        for (int j = 0; j < 8; ++j) X[padx16(16 * tt + 8 * g + j)] = e[j]; }
    __syncthreads();
#pragma unroll
    for (int j = 0; j < 16; ++j) v[j] = X[padx16(base + 8 * j)];
    r16_dit<8>(v, r, T);
#pragma unroll
    for (int j = 0; j < 16; ++j) X[padx16(base + 8 * j)] = v[j];
    __syncthreads();
#pragma unroll
    for (int m = 0; m < 16; ++m) v[m] = X[padx16(tt + 128 * m)];
    r16_dit<128>(v, tt, T);
}
__device__ __forceinline__ void fft_fwd_store16(f32x2 (&v)[16], LAS f32x2* X, const LAS f32x2* T, f32x2* Kout, int tt) {
    r16_dif<128>(v, tt, T);
#pragma unroll
    for (int m = 0; m < 16; ++m) X[padx16(tt + 128 * m)] = v[m];
    __syncthreads();
    const int r = tt & 7, base = (tt >> 3) * 128 + r;
#pragma unroll
    for (int j = 0; j < 16; ++j) v[j] = X[padx16(base + 8 * j)];
    r16_dif<8>(v, r, T);
#pragma unroll
    for (int j = 0; j < 16; ++j) X[padx16(base + 8 * j)] = v[j];
    __syncthreads();
#pragma unroll
    for (int g = 0; g < 2; ++g) { f32x2 e[8];
#pragma unroll
        for (int j = 0; j < 8; ++j) e[j] = X[padx16(16 * tt + 8 * g + j)];
        r8_dif<1>(e, 0, T);
#pragma unroll
        for (int j = 0; j < 8; ++j) Kout[16 * tt + 8 * g + j] = e[j]; }
    __syncthreads();
}
__device__ __forceinline__ void build_twiddles(const Ctx& C, LAS f32x2* T) {
    for (int k = C.tid; k < 2048; k += NTHR) { float s, c; sincospif((float)k * (1.0f / 2048.0f), &s, &c); T[k] = (f32x2){c, -s}; }
}

__device__ __forceinline__ void phase0(const Ctx& C) {
    LAS float* sil = (LAS float*)C.lds;
    LAS float* red = sil + 9 * 1024;
    LAS float* zs = red + 8 * 9 * 64;
    LAS float* h1s = zs + 8 * 40;
    const float* cin = C.in[IN_C]; const float* cctx = C.in[IN_CCTX];
    for (int i = C.tid; i < 9 * 1024; i += NTHR) { const int r = i >> 10, k = i & 1023; const float v = r < 8 ? cin[r * 1024 + k] : cctx[k]; sil[i] = v / (1.0f + expf(-v)); }
    __syncthreads();
    float* mods = WSP(float, WS_MODS);
    const float* wmod = C.in[IN_WMOD]; const float* bmod = C.in[IN_BMOD];
    for (int item = C.bid; item < 4 * 96; item += C.G) {
        const int l = item / 96, cb = item % 96, cc = C.tid & 63, kg = C.tid >> 6;
        const float* w = wmod + ((size_t)l * 1024 + kg * 128) * 6144 + cb * 64 + cc;
        const LAS float* sk = sil + kg * 128;
        float acc[9];
#pragma unroll
        for (int r = 0; r < 9; ++r) acc[r] = 0.f;
#pragma unroll 4
        for (int k = 0; k < 128; ++k) { const float wv = w[(size_t)k * 6144];
#pragma unroll
            for (int r = 0; r < 9; ++r) acc[r] += sk[r * 1024 + k] * wv; }
#pragma unroll
        for (int r = 0; r < 9; ++r) red[(kg * 9 + r) * 64 + cc] = acc[r];
        __syncthreads();
        for (int o = C.tid; o < 576; o += NTHR) { const int r = o >> 6, c2 = o & 63; float s = 0.f;
#pragma unroll
            for (int g = 0; g < 8; ++g) s += red[(g * 9 + r) * 64 + c2];
            mods[(size_t)(l * 9 + r) * 6144 + cb * 64 + c2] = s + bmod[l * 6144 + cb * 64 + c2]; }
        __syncthreads();
    }
    for (int item = C.bid; item < 4 * 288; item += C.G) {
        const int l = item / 288, r = item % 288, isctx = r >= 256;
        const int L = isctx ? 256 : 2048, t0 = (isctx ? r - 256 : r) * 8, tl = C.tid >> 6, j = C.tid & 63, t = t0 + tl;
        if (j < 33) { float z;
            if (j == 0) z = (float)t / (float)(L - 1);
            else { const int fi = (j - 1) & 15; const float freq = 1e-4f + (float)fi * ((15.0f - 1e-4f) / 15.0f);
                const float ang = ((float)(2.0 * 3.14159265358979323846 / L) * (float)t) * freq; z = (j <= 16) ? cosf(ang) : -sinf(ang); }
            zs[tl * 40 + j] = z; }
        __syncthreads();
        { const float* w1 = C.in[IN_W1] + (size_t)l * 33 * 64; float s = C.in[IN_B1][l * 64 + j];
            for (int i = 0; i < 33; ++i) s += zs[tl * 40 + i] * w1[i * 64 + j];
            h1s[tl * 64 + j] = sinf(s); }
        __syncthreads();
        { const float* w2 = C.in[IN_W2] + (size_t)l * 64 * 64; float s = C.in[IN_B2][l * 64 + j];
            for (int i = 0; i < 64; ++i) s += h1s[tl * 64 + i] * w2[i * 64 + j];
            bf16_t* dst = WSP(bf16_t, WS_HPAD) + ((size_t)l * 2304 + (isctx ? 2048 + t : t)) * 128;
            dst[j] = (bf16_t)f2bf(sinf(s)); dst[64 + j] = (bf16_t)0; }
        __syncthreads();
    }
    {
        const float* w3 = C.in[IN_W3]; bf16_t* w3t = WSP(bf16_t, WS_W3T);
        for (int i = C.bid * NTHR + C.tid; i < 4 * 64 * 2048; i += C.G * NTHR) { const int l = i >> 17, k = (i >> 11) & 63, col = i & 2047;
            w3t[((size_t)l * 2048 + col) * 128 + k] = (bf16_t)f2bf(w3[i]); w3t[((size_t)l * 2048 + col) * 128 + 64 + k] = (bf16_t)0; }
    }
    if (C.bid == C.G - 1) {
        const float* lb = C.in[IN_LB]; float* lower = WSP(float, WS_LOWER);
        for (int i = C.tid; i < 1024; i += NTHR) { const int d = i >> 9, c = i & 511; float v[4], mx = -3.4e38f, s = 0.f;
#pragma unroll
            for (int l = 0; l < 4; ++l) { v[l] = lb[(d * 4 + l) * 512 + c]; mx = fmaxf(mx, v[l]); }
#pragma unroll
            for (int l = 0; l < 4; ++l) { v[l] = expf(v[l] - mx); s += v[l]; }
            float cum = 0.f;
#pragma unroll
            for (int l = 0; l < 4; ++l) { if (l > 0) cum += v[l] / s; lower[(d * 4 + l) * 512 + c] = cum; } }
    }
}

__device__ __forceinline__ const float* xrow_src(const Ctx& C, int l, int row) {
    return l == 0 ? (row < NLAT ? C.in[IN_X] + (size_t)row * D : C.in[IN_CTX] + (size_t)(row - NLAT) * D) : WSP(const float, WS_XBUF) + (size_t)row * D;
}
__device__ __forceinline__ void transpose_item(const float* W, int K, int N, bf16_t* WT, LAS float* scr, int item, int lane) {
    const int nblk = N / 32, kb = item / nblk, nb = item % nblk, k0 = 64 * kb, n0 = 32 * nb;
#pragma unroll 8
    for (int i = 0; i < 32; ++i) { const int kk = 2 * i + (lane >> 5); scr[kk * 33 + (lane & 31)] = W[(size_t)(k0 + kk) * N + n0 + (lane & 31)]; }
    LDS_WAIT(); asm volatile("" ::: "memory");
    const int c = lane & 7;
#pragma unroll
    for (int j = 0; j < 4; ++j) { const int n = (lane >> 3) + 8 * j; const LAS float* s = scr + (8 * c) * 33 + n;
        u32x4 o; o.x = pk2(s[0 * 33], s[1 * 33]); o.y = pk2(s[2 * 33], s[3 * 33]); o.z = pk2(s[4 * 33], s[5 * 33]); o.w = pk2(s[6 * 33], s[7 * 33]);
        *(u32x4*)(WT + (size_t)(n0 + n) * K + k0 + 8 * c) = o; }
    LDS_WAIT(); asm volatile("" ::: "memory");
}
__device__ __forceinline__ void phase_l1(const Ctx& C, int l) {
    const int gw = C.bid * NWAVES + C.wave, NGW = C.G * NWAVES;
    const float* mods = WSP(const float, WS_MODS) + (size_t)l * 9 * 6144;
    bf16_t* an = WSP(bf16_t, WS_R1);
    f32x4 nv[4];
    if (!(C.dry & 2)) {
    if (gw < NTOK) { const float* src = xrow_src(C, l, gw);
#pragma unroll
        for (int j = 0; j < 4; ++j) nv[j] = *(const f32x4*)(src + C.lane * 4 + 256 * j); }
    for (int row = gw; row < NTOK; row += NGW) {
        const float* md = mods + bidx(row) * 6144;
        f32x4 v[4]; float ss = 0.f;
#pragma unroll
        for (int j = 0; j < 4; ++j) v[j] = nv[j];
        if (row + NGW < NTOK) { const float* src = xrow_src(C, l, row + NGW);
#pragma unroll
            for (int j = 0; j < 4; ++j) nv[j] = *(const f32x4*)(src + C.lane * 4 + 256 * j); }
#pragma unroll
        for (int j = 0; j < 4; ++j) ss += (v[j].x * v[j].x + v[j].y * v[j].y) + (v[j].z * v[j].z + v[j].w * v[j].w);
        ss = wave_sum(ss); const float rinv = 1.0f / sqrtf(ss * (1.0f / D) + EPS);
#pragma unroll
        for (int j = 0; j < 4; ++j) { const int k = C.lane * 4 + 256 * j; const f32x4 sh = *(const f32x4*)(md + k), sc = *(const f32x4*)(md + 1024 + k);
            const f32x4 o = v[j] * rinv * (sc + 1.0f) + sh; u32x2 w; w.x = pk2(o.x, o.y); w.y = pk2(o.z, o.w);
            *(u32x2*)(an + (size_t)row * D + k) = w; }
    }
    }
    if (!(C.dry & 4)) {
        LAS float* scr = (LAS float*)(C.lds + C.wave * 16384);
        constexpr int I_IN = 16 * 128, I_OUT = 16 * 32, I_E = 128;
        constexpr int NIT = I_IN + I_OUT + 3 * 16 * I_E;
        for (int it = gw; it < NIT; it += NGW) {
            int r = it;
            if (r < I_IN) { transpose_item(C.in[IN_WIN] + (size_t)l * D * DIN, D, DIN, WSP(bf16_t, WS_WIN), scr, r, C.lane); continue; } r -= I_IN;
            if (r < I_OUT) { transpose_item(C.in[IN_WOUT] + (size_t)l * D * D, D, D, WSP(bf16_t, WS_WOUT), scr, r, C.lane); continue; } r -= I_OUT;
            if (r < 16 * I_E) { const int e = r / I_E; transpose_item(C.in[IN_WG] + ((size_t)l * NE + e) * D * DE, D, DE, WSP(bf16_t, WS_WG) + (size_t)e * DE * D, scr, r % I_E, C.lane); continue; } r -= 16 * I_E;
            if (r < 16 * I_E) { const int e = r / I_E; transpose_item(C.in[IN_WU] + ((size_t)l * NE + e) * D * DE, D, DE, WSP(bf16_t, WS_WU) + (size_t)e * DE * D, scr, r % I_E, C.lane); continue; } r -= 16 * I_E;
            { const int e = r / I_E; transpose_item(C.in[IN_WD] + ((size_t)l * NE + e) * DE * D, DE, D, WSP(bf16_t, WS_WD) + (size_t)e * D * DE, scr, r % I_E, C.lane); }
        }
    }
    __syncthreads();
    {
        LAS f32x2* T = (LAS f32x2*)C.lds;
        const int team = C.tid >> 7, tt = C.tid & 127;
        LAS f32x2* X = (LAS f32x2*)(C.lds + 16384) + team * XPAD16;
        LAS float* hbs = (LAS float*)(C.lds + 16384 + 4 * XPAD16 * 8) + team * 2048;
        LAS float* reds = (LAS float*)(C.lds + 16384 + 4 * XPAD16 * 8 + 32768);
        build_twiddles(C, T);
        __syncthreads();
        const bf16_t* hfl = WSP(const bf16_t, WS_HF) + (size_t)l * 2048 * 2304;
        f32x2* kspec = WSP(f32x2, WS_KSPEC);
        if (!(C.dry & 8))
        for (int item = C.bid; item < 256; item += C.G) {
            const int idx = item * 4 + team, o = idx >> 9, c = idx & 511;
            const int colf = o * 1024 + c, colb = colf + 512;
            const bf16_t* hfp = hfl + (size_t)colf * 2304; const bf16_t* hbp = hfl + (size_t)colb * 2304;
            float hf[16], hb[16], s = 0.f;
#pragma unroll
            for (int j = 0; j < 16; ++j) { const int t = tt + 128 * j; hf[j] = bf2f(hfp[t]); hb[j] = bf2f(hbp[t]); s += fabsf(hf[j]) + fabsf(hb[j]); }
            s = wave_sum(s);
            if (C.lane == 0) reds[C.wave] = s;
            __syncthreads();
            const float inv = 1.0f / ((reds[team * 2] + reds[team * 2 + 1]) * 4096.0f);
#pragma unroll
            for (int j = 0; j < 16; ++j) { hf[j] *= inv; hbs[tt + 128 * j] = hb[j] * inv; }
            __syncthreads();
            f32x2* kout = kspec + ((size_t)(o * 512 + c) * 2) * 2048;
            f32x2 vv[16];
#pragma unroll
            for (int j = 0; j < 16; ++j) { const int n = tt + 128 * j; const float kb = n > 0 ? hbs[2048 - n] : 0.f; vv[j] = (f32x2){hf[j] + kb, 0.f}; }
            fft_fwd_store16(vv, X, T, kout, tt);
#pragma unroll
            for (int j = 0; j < 16; ++j) { const int n = tt + 128 * j; const float kb = n > 0 ? hbs[2048 - n] : 0.f; const float dd = hf[j] - kb; const f32x2 tw = T[n]; vv[j] = (f32x2){dd * tw.x, dd * tw.y}; }
            fft_fwd_store16(vv, X, T, kout + 2048, tt);
        }
        if (l < DEPTH - 1 && !(C.dry & 16)) {
            f32x2* kspc = WSP(f32x2, WS_KSPC);
            for (int item = C.bid; item < 256; item += C.G) {
                const int idx = item * 4 + team, o = idx >> 9, c = idx & 511;
                const int colf = o * 1024 + c, colb = colf + 512;
                float af0 = bf2f(hfl[(size_t)colf * 2304 + 2048 + tt]), af1 = bf2f(hfl[(size_t)colf * 2304 + 2048 + 128 + tt]);
                float ab0 = bf2f(hfl[(size_t)colb * 2304 + 2048 + tt]), ab1 = bf2f(hfl[(size_t)colb * 2304 + 2048 + 128 + tt]);
                __syncthreads();
                const float s = wave_sum((fabsf(af0) + fabsf(af1)) + (fabsf(ab0) + fabsf(ab1)));
                if (C.lane == 0) reds[C.wave] = s;
                __syncthreads();
                const float inv = 1.0f / ((reds[team * 2] + reds[team * 2 + 1]) * 2048.0f);
                af0 *= inv; af1 *= inv; hbs[tt] = ab0 * inv; hbs[128 + tt] = ab1 * inv;
                __syncthreads();
                f32x2 vk[16];
#pragma unroll
                for (int j = 0; j < 16; ++j) vk[j] = (f32x2){0.f, 0.f};
                vk[0] = (f32x2){af0, 0.f}; vk[1] = (f32x2){af1, 0.f};
                vk[14] = (f32x2){tt > 0 ? hbs[256 - tt] : 0.f, 0.f};
                vk[15] = (f32x2){hbs[128 - tt], 0.f};
                fft_fwd_store16(vk, X, T, kspc + (size_t)(o * 512 + c) * 2048, tt);
            }
        }
    }
}

__device__ __forceinline__ float shortconv(const LAS bf16_t* raw, int t, int mask, int tmax, float w0, float w1, float w2, float bias) {
    const float pm = ((t & mask) != 0) ? bf2f(raw[t - 1]) : 0.f;
    const float pc = bf2f(raw[t]);
    const float pp = ((t & mask) != mask && t < tmax) ? bf2f(raw[t + 1]) : 0.f;
    return w0 * pm + w1 * pc + w2 * pp + bias;
}
constexpr int HY_CH = 4, HY_ITEMS = 4 * (512 / HY_CH), HYC_ITEMS = 512 / 4;
__device__ __forceinline__ void hyena_lat(const Ctx& C, int l, int item) {
    const int bp = item & 3, cg = item >> 2, team = C.tid >> 7, tt = C.tid & 127;
    LAS f32x2* T = (LAS f32x2*)C.lds;
    LAS f32x2* X = (LAS f32x2*)(C.lds + 16384) + team * XPAD16;
    LAS bf16_t* raw = (LAS bf16_t*)(C.lds + 16384 + 4 * XPAD16 * 8) + team * 4096;
    const bf16_t* phyt = WSP(const bf16_t, WS_PHYT);
    const float* cw = C.in[IN_CONVW] + (size_t)l * 3 * NHY; const float* cb = C.in[IN_CONVB] + (size_t)l * NHY;
    const float* hyb = C.in[IN_HYBIAS] + (size_t)l * 2 * DH;
    const f32x2* kspec = WSP(const f32x2, WS_KSPEC);
    const int ba = 2 * bp, c = cg * 4 + team;
    f32x2 z[16], acc[16], v[16];
#pragma unroll 1
    for (int stage = 0; stage < 3; ++stage) {
        const int ch = stage * 512 + c;
        __syncthreads();
#pragma unroll
        for (int k = 0; k < 4; ++k) { const int q = tt + 128 * k, rr = q >> 8, cc = q & 255;
            *(LAS u32x4*)(raw + rr * 2048 + cc * 8) = *(const u32x4*)(phyt + (size_t)ch * NTOK + (size_t)(ba + rr) * 2048 + cc * 8); }
        __syncthreads();
        const float w0 = cw[ch], w1 = cw[NHY + ch], w2 = cw[2 * NHY + ch], bs = cb[ch];
        if (stage == 0) {
#pragma unroll
            for (int j = 0; j < 16; ++j) { const int t = tt + 128 * j; z[j] = (f32x2){shortconv(raw, t, 63, 4096, w0, w1, w2, bs), shortconv(raw + 2048, t, 63, 4096, w0, w1, w2, bs)}; }
        } else {
            const float dsk = hyb[(stage - 1) * DH + c];
#pragma unroll
            for (int j = 0; j < 16; ++j) { const int t = tt + 128 * j; const f32x2 cv = acc[j] + z[j] * dsk;
                z[j] = (f32x2){shortconv(raw, t, 63, 4096, w0, w1, w2, bs) * cv.x, shortconv(raw + 2048, t, 63, 4096, w0, w1, w2, bs) * cv.y}; }
        }
        if (stage == 2) {
            LAS bf16_t* ob = (LAS bf16_t*)X;
#pragma unroll
            for (int j = 0; j < 16; ++j) { const int t = tt + 128 * j; ob[t] = (bf16_t)f2bf(z[j].x); ob[2048 + t] = (bf16_t)f2bf(z[j].y); }
            break;
        }
        const f32x2* K = kspec + ((size_t)(stage * 512 + c) * 2) * 2048;
#pragma unroll
        for (int j = 0; j < 16; ++j) v[j] = z[j];
        fft_conv_half16(v, X, T, K, tt);
#pragma unroll
        for (int j = 0; j < 16; ++j) acc[j] = v[j];
#pragma unroll
        for (int j = 0; j < 16; ++j) v[j] = cmul(z[j], T[tt + 128 * j]);
        fft_conv_half16(v, X, T, K + 2048, tt);
#pragma unroll
        for (int j = 0; j < 16; ++j) acc[j] += cmulc(v[j], T[tt + 128 * j]);
    }
    __syncthreads();
    bf16_t* Y = WSP(bf16_t, WS_R1);
    for (int i = C.tid; i < 4096; i += NTHR) { const int b = i >> 11, t = i & 2047;
        const LAS bf16_t* o0 = (const LAS bf16_t*)((LAS f32x2*)(C.lds + 16384)) + i;
        u32x2 w; w.x = (unsigned)o0[0] | ((unsigned)o0[XPAD16 * 4] << 16); w.y = (unsigned)o0[2 * XPAD16 * 4] | ((unsigned)o0[3 * XPAD16 * 4] << 16);
        *(u32x2*)(Y + ((size_t)(ba + b) * 2048 + t) * D + cg * 4) = w; }
    __syncthreads();
}
__device__ __forceinline__ void hyena_ctx2(const Ctx& C, int l, int item) {
    const int team = C.tid >> 7, tt = C.tid & 127, c = item * 4 + team;
    LAS f32x2* T = (LAS f32x2*)C.lds;
    LAS f32x2* X = (LAS f32x2*)(C.lds + 16384) + team * XPAD16;
    LAS bf16_t* raw = (LAS bf16_t*)(C.lds + 16384 + 4 * XPAD16 * 8) + team * 4096;
    const bf16_t* phyt = WSP(const bf16_t, WS_PHYT);
    const float* cw = C.in[IN_CONVW] + (size_t)l * 3 * NHY; const float* cb = C.in[IN_CONVB] + (size_t)l * NHY;
    const float* hyb = C.in[IN_HYBIAS] + (size_t)l * 2 * DH;
    const f32x2* kspc = WSP(const f32x2, WS_KSPC);
    bf16_t* Y = WSP(bf16_t, WS_R1);
    f32x2 z[16], v[16];
#pragma unroll
    for (int j = 0; j < 16; ++j) { z[j] = (f32x2){0.f, 0.f}; v[j] = (f32x2){0.f, 0.f}; }
#pragma unroll 1
    for (int stage = 0; stage < 3; ++stage) {
        const int ch = stage * 512 + c;
        __syncthreads();
#pragma unroll
        for (int k = 0; k < 2; ++k) { const int q = tt + 128 * k; *(LAS u32x4*)(raw + q * 8) = *(const u32x4*)(phyt + (size_t)ch * NTOK + NLAT + q * 8); }
        __syncthreads();
        const float w0 = cw[ch], w1 = cw[NHY + ch], w2 = cw[2 * NHY + ch], bs = cb[ch];
        const float dsk = stage > 0 ? hyb[(stage - 1) * DH + c] : 0.f;
#pragma unroll
        for (int p = 0; p < 4; ++p)
#pragma unroll
            for (int hh = 0; hh < 2; ++hh) { const int m = 4 * p + hh, tok = hh * 128 + tt;
                const float ua = shortconv(raw, (2 * p) * 256 + tok, 255, 4096, w0, w1, w2, bs), ub = shortconv(raw, (2 * p + 1) * 256 + tok, 255, 4096, w0, w1, w2, bs);
                if (stage == 0) z[m] = (f32x2){ua, ub};
                else { const f32x2 cv = v[m] + z[m] * dsk; z[m] = (f32x2){ua * cv.x, ub * cv.y}; } }
        if (stage == 2) {
#pragma unroll
            for (int p = 0; p < 4; ++p)
#pragma unroll
                for (int hh = 0; hh < 2; ++hh) { const int m = 4 * p + hh, tok = hh * 128 + tt;
                    Y[(size_t)(NLAT + (2 * p) * 256 + tok) * D + c] = (bf16_t)f2bf(z[m].x); Y[(size_t)(NLAT + (2 * p + 1) * 256 + tok) * D + c] = (bf16_t)f2bf(z[m].y); }
            break;
        }
#pragma unroll
        for (int j = 0; j < 16; ++j) v[j] = z[j];
        fft_conv_half16(v, X, T, kspc + (size_t)(stage * 512 + c) * 2048, tt);
    }
}

constexpr int HG_QT = 0, HG_QP = 17408, HG_KP = 34816, HG_ST = 52224, HG_VT = 87040, HG_KH = 105472, HG_P = 123904, HG_SUB = 133120, HG_D = 135168;
__device__ __forceinline__ void hgrn_mfma(const Ctx& C, int item) {
    const int dir = item & 1, h = (item >> 1) & 3, b = item >> 3;
    LAS unsigned char* L = C.lds;
    const int lane = C.lane, w = C.wave, r = lane & 15, quad = lane >> 4;
    const int I = w >> 1, col = (w & 1) * 64 + lane;
    const bf16_t* phg = WSP(const bf16_t, WS_PHG);
    bf16_t* odir = WSP(bf16_t, WS_ODIR) + (size_t)dir * NTOK * 512;
    LAS float* subtot = (LAS float*)(L + HG_SUB); LAS float* Dv = (LAS float*)(L + HG_D);
    __syncthreads();
    unsigned z0_ = 0u; asm volatile("" : "+v"(z0_));
    const u32x4 zv_ = (u32x4){z0_, z0_, z0_, z0_}; const float zff_ = __builtin_bit_cast(float, z0_); const f32x4 zv4f_ = (f32x4){zff_, zff_, zff_, zff_};
    for (int i = C.tid; i < (128 * 272) / 16; i += NTHR) *(LAS u32x4*)(L + HG_ST + i * 16) = zv_;
    for (int i = C.tid; i < (64 * 144) / 16; i += NTHR) *(LAS u32x4*)(L + HG_P + i * 16) = zv_;
    f32x4 sacc[8];
#pragma unroll
    for (int t = 0; t < 8; ++t) sacc[t] = zv4f_;
    unsigned short qr[16], kr[16], vr[16];
    const int rstep = dir ? -1 : 1;
    const size_t colq = (size_t)h * 128 + col, colk = 1536 + (size_t)dir * 512 + h * 128 + col, colv = 512 + (size_t)h * 128 + col;
    auto chunk_row0 = [&](int ch) -> int { return ch < 4 ? NLAT + b * 256 + (dir ? 255 - ch * 64 : ch * 64) : b * 2048 + (dir ? 2047 - (ch - 4) * 64 : (ch - 4) * 64); };
    { const int row0 = chunk_row0(0) + rstep * 16 * I;
#pragma unroll
      for (int i = 0; i < 16; ++i) { const bf16_t* p = phg + (size_t)(row0 + rstep * i) * NHG; qr[i] = p[colq]; kr[i] = p[colk]; vr[i] = p[colv]; } }
    __syncthreads();
#pragma unroll 1
    for (int ch = 0; ch < 36; ++ch) {
        float cum[16]; float cs = 0.f;
#pragma unroll
        for (int i = 0; i < 16; ++i) { cs += __logf(1.0f - bf2f(kr[i])); cum[i] = cs; }
        subtot[I * 128 + col] = cs;
        __syncthreads();
        const float s0 = subtot[col], s1 = subtot[128 + col], s2 = subtot[256 + col], s3 = subtot[384 + col];
        const float pre = (I > 0 ? s0 : 0.f) + (I > 1 ? s1 : 0.f) + (I > 2 ? s2 : 0.f), rho = s0 + s1, tot = (s0 + s1) + (s2 + s3);
        const float erho = __expf(rho), eend = __expf(tot - rho);
        unsigned khp[8], vtp[8];
#pragma unroll
        for (int i = 0; i < 16; ++i) {
            const float bi = pre + cum[i], e1 = __expf(bi - rho), e2 = __expf(rho - bi), qf = bf2f(qr[i]), kf = bf2f(kr[i]);
            const int srow = (16 * I + i) * 272 + col * 2;
            *(LAS bf16_t*)(L + HG_QP + srow) = (bf16_t)f2bf(qf * e1);
            *(LAS bf16_t*)(L + HG_QT + srow) = (bf16_t)f2bf(qf * e1 * erho);
            *(LAS bf16_t*)(L + HG_KP + srow) = (bf16_t)f2bf(kf * e2);
            const unsigned khb = f2bf(kf * e2 * eend);
            if (i & 1) { khp[i >> 1] |= khb << 16; vtp[i >> 1] |= (unsigned)vr[i] << 16; } else { khp[i >> 1] = khb; vtp[i >> 1] = (unsigned)vr[i]; }
        }
        *(LAS u32x4*)(L + HG_KH + col * 144 + I * 32) = (u32x4){khp[0], khp[1], khp[2], khp[3]};
        *(LAS u32x4*)(L + HG_KH + col * 144 + I * 32 + 16) = (u32x4){khp[4], khp[5], khp[6], khp[7]};
        *(LAS u32x4*)(L + HG_VT + col * 144 + I * 32) = (u32x4){vtp[0], vtp[1], vtp[2], vtp[3]};
        *(LAS u32x4*)(L + HG_VT + col * 144 + I * 32 + 16) = (u32x4){vtp[4], vtp[5], vtp[6], vtp[7]};
        if (I == 0) Dv[col] = __expf(tot);
        const int crow0 = chunk_row0(ch);
        if (ch + 1 < 36) { const int row0 = chunk_row0(ch + 1) + rstep * 16 * I;
#pragma unroll
            for (int i = 0; i < 16; ++i) { const bf16_t* p = phg + (size_t)(row0 + rstep * i) * NHG; qr[i] = p[colq]; kr[i] = p[colk]; vr[i] = p[colv]; } }
        __syncthreads();
#pragma unroll 1
        for (int blk = w; blk < 10; blk += 8) {
            const int I2 = blk < 1 ? 0 : (blk < 3 ? 1 : (blk < 6 ? 2 : 3)), J2 = blk - (I2 * (I2 + 1)) / 2;
            f32x4 pa = zv4f_;
#pragma unroll
            for (int kk = 0; kk < 4; ++kk) {
                const bf16x8 a = *(const LAS bf16x8*)(L + HG_KP + (J2 * 16 + r) * 272 + (32 * kk + 8 * quad) * 2);
                const bf16x8 bq = *(const LAS bf16x8*)(L + HG_QP + (I2 * 16 + r) * 272 + (32 * kk + 8 * quad) * 2);
                pa = __builtin_amdgcn_mfma_f32_16x16x32_bf16(a, bq, pa, 0, 0, 0);
            }
            if (I2 == J2) {
#pragma unroll
                for (int rr = 0; rr < 4; ++rr) if (4 * quad + rr > r) pa[rr] = 0.f;
            }
            u32x2 pw; pw.x = pk2(pa[0], pa[1]); pw.y = pk2(pa[2], pa[3]);
            *(LAS u32x2*)(L + HG_P + (I2 * 16 + r) * 144 + (J2 * 16 + 4 * quad) * 2) = pw;
        }
        __syncthreads();
        {
            bf16x8 sfr[4];
#pragma unroll
            for (int kk = 0; kk < 4; ++kk) sfr[kk] = *(const LAS bf16x8*)(L + HG_ST + (16 * w + r) * 272 + (32 * kk + 8 * quad) * 2);
            const bf16x8 vf0 = *(const LAS bf16x8*)(L + HG_VT + (16 * w + r) * 144 + (8 * quad) * 2);
            const bf16x8 vf1 = *(const LAS bf16x8*)(L + HG_VT + (16 * w + r) * 144 + (32 + 8 * quad) * 2);
#pragma unroll
            for (int I3 = 0; I3 < 4; ++I3) {
                f32x4 oa = zv4f_;
#pragma unroll
                for (int kk = 0; kk < 4; ++kk) {
                    const bf16x8 bq = *(const LAS bf16x8*)(L + HG_QT + (I3 * 16 + r) * 272 + (32 * kk + 8 * quad) * 2);
                    oa = __builtin_amdgcn_mfma_f32_16x16x32_bf16(sfr[kk], bq, oa, 0, 0, 0);
                }
                { const bf16x8 bp = *(const LAS bf16x8*)(L + HG_P + (I3 * 16 + r) * 144 + (8 * quad) * 2);
                  oa = __builtin_amdgcn_mfma_f32_16x16x32_bf16(vf0, bp, oa, 0, 0, 0); }
                if (I3 >= 2) { const bf16x8 bp = *(const LAS bf16x8*)(L + HG_P + (I3 * 16 + r) * 144 + (32 + 8 * quad) * 2);
                  oa = __builtin_amdgcn_mfma_f32_16x16x32_bf16(vf1, bp, oa, 0, 0, 0); }
                const int row = crow0 + rstep * (16 * I3 + r);
                u32x2 ow; ow.x = pk2(oa[0], oa[1]); ow.y = pk2(oa[2], oa[3]);
                *(u32x2*)(odir + (size_t)row * 512 + h * 128 + 16 * w + 4 * quad) = ow;
            }
#pragma unroll
            for (int t = 0; t < 8; ++t) {
                const f32x4 dd = *(const LAS f32x4*)(L + HG_D + (16 * t + 4 * quad) * 4);
                f32x4 sa = sacc[t] * dd;
                const bf16x8 a0 = *(const LAS bf16x8*)(L + HG_KH + (16 * t + r) * 144 + (8 * quad) * 2);
                const bf16x8 a1 = *(const LAS bf16x8*)(L + HG_KH + (16 * t + r) * 144 + (32 + 8 * quad) * 2);
                sa = __builtin_amdgcn_mfma_f32_16x16x32_bf16(a0, vf0, sa, 0, 0, 0);
                sa = __builtin_amdgcn_mfma_f32_16x16x32_bf16(a1, vf1, sa, 0, 0, 0);
                sacc[t] = sa;
                u32x2 sw; sw.x = pk2(sa[0], sa[1]); sw.y = pk2(sa[2], sa[3]);
                *(LAS u32x2*)(L + HG_ST + (16 * w + r) * 272 + (16 * t + 4 * quad) * 2) = sw;
            }
        }
    }
    __syncthreads();
}
__device__ __forceinline__ void phase_l3(const Ctx& C, int l) {
    if (C.bid < 64) hgrn_mfma(C, C.bid);
    build_twiddles(C, (LAS f32x2*)C.lds);
    __syncthreads();
    unsigned* qh = WSP(unsigned, WS_CTL) + CW_Q + l * 64 + C.rep * 16;
    volatile LAS int* lc = (volatile LAS int*)(C.lds + LDSCTL_OFF);
    const int nitems = HY_ITEMS + (l < DEPTH - 1 ? HYC_ITEMS : 0);
    for (;;) {
        if (C.tid == 0) lc[LC_Q] = (int)__hip_atomic_fetch_add(qh, 1u, __ATOMIC_RELAXED, __HIP_MEMORY_SCOPE_AGENT);
        __syncthreads();
        const int item = lc[LC_Q];
        __syncthreads();
        if (item >= nitems) break;
        Ctx CI = C; { int t_ = C.tid; asm volatile("" : "+v"(t_)); CI.tid = t_; CI.lane = t_ & 63; }
        if (item < HY_ITEMS) hyena_lat(CI, l, item); else hyena_ctx2(CI, l, item - HY_ITEMS);
    }
}
__device__ __forceinline__ void phase_l3b(const Ctx& C, int l) {
    const int gw = C.bid * NWAVES + C.wave, NGW = C.G * NWAVES;
    const bf16_t* od0 = WSP(const bf16_t, WS_ODIR); const bf16_t* od1 = od0 + (size_t)NTOK * 512;
    const bf16_t* phg = WSP(const bf16_t, WS_PHG); bf16_t* Y = WSP(bf16_t, WS_R1);
    const float* nw = C.in[IN_NORMW] + l * 128;
    const int nrows = (l < DEPTH - 1) ? NTOK : NLAT;
    for (int row = gw; row < nrows; row += NGW) {
        const int idx = C.lane * 8;
        const u32x4 a = *(const u32x4*)(od0 + (size_t)row * 512 + idx), b = *(const u32x4*)(od1 + (size_t)row * 512 + idx), g = *(const u32x4*)(phg + (size_t)row * NHG + 1024 + idx);
        float o[8] = {bflo(a.x) + bflo(b.x), bfhi(a.x) + bfhi(b.x), bflo(a.y) + bflo(b.y), bfhi(a.y) + bfhi(b.y), bflo(a.z) + bflo(b.z), bfhi(a.z) + bfhi(b.z), bflo(a.w) + bflo(b.w), bfhi(a.w) + bfhi(b.w)};
        const float gg[8] = {bflo(g.x), bfhi(g.x), bflo(g.y), bfhi(g.y), bflo(g.z), bfhi(g.z), bflo(g.w), bfhi(g.w)};
        float ss = 0.f;
#pragma unroll
        for (int i = 0; i < 8; ++i) ss += o[i] * o[i];
        ss = row16_sum(ss);
        const float rinv = 1.0f / sqrtf(ss * (1.0f / 128.0f) + EPS);
        float y[8];
#pragma unroll
        for (int i = 0; i < 8; ++i) y[i] = o[i] * rinv * nw[(idx + i) & 127] * siluf_(gg[i]);
        u32x4 w; w.x = pk2(y[0], y[1]); w.y = pk2(y[2], y[3]); w.z = pk2(y[4], y[5]); w.w = pk2(y[6], y[7]);
        *(u32x4*)(Y + (size_t)row * D + 512 + idx) = w;
    }
}

constexpr int RW_PITCH = 1028;
__device__ __forceinline__ void phase_l5a(const Ctx& C, int l) {
    LAS float* rwT = (LAS float*)C.lds;
    LAS int* lcnt = (LAS int*)(C.lds + 16 * RW_PITCH * 4);
    LAS float* wsc = (LAS float*)(C.lds + 16 * RW_PITCH * 4 + 128) + C.wave * 384;
    const float* rw = C.in[IN_RW];
    for (int i = C.tid; i < 16 * 1024; i += NTHR) { const int k = i >> 4, e = i & 15; rwT[e * RW_PITCH + k] = rw[i]; }
    if (C.tid < 32) lcnt[C.tid] = 0;
    __syncthreads();
    const int gw = C.bid * NWAVES + C.wave, NGW = C.G * NWAVES;
    const float* mods = WSP(const float, WS_MODS) + (size_t)l * 9 * 6144;
    const float* bias2 = WSP(const float, WS_BIAS2) + l * 9 * 16;
    const float* xb = WSP(const float, WS_XBUF);
    const float* rbias = C.in[IN_RB];
    unsigned* cnt = WSP(unsigned, WS_CTL) + CW_CNT + l * 32 * 64;
    int* tokinfo = WSP(int, WS_TOKINFO);
    const int ngroups = ((l < DEPTH - 1) ? NTOK : NLAT) / 16;
    const int li = C.lane & 15, kq = C.lane >> 4;
    for (int g = gw; g < ngroups; g += NGW) {
        const int row0 = g * 16, bb = bidx(row0);
        const float* xp = xb + (size_t)(row0 + li) * D + kq * 4;
        const float* scp = mods + bb * 6144 + 4096 + kq * 4;
        const LAS float* bp = rwT + li * RW_PITCH + kq * 4;
        f32x4 acc0 = (f32x4){0.f, 0.f, 0.f, 0.f}, acc1 = acc0, acc2 = acc0, acc3 = acc0; float ss = 0.f;
#pragma unroll 8
        for (int m = 0; m < 64; ++m) {
            const f32x4 xv = *(const f32x4*)(xp + 16 * m), sc = *(const f32x4*)(scp + 16 * m), bv = *(const LAS f32x4*)(bp + 16 * m);
            ss += (xv.x * xv.x + xv.y * xv.y) + (xv.z * xv.z + xv.w * xv.w);
            const f32x4 av = xv * (sc + 1.0f);
            acc0 = __builtin_amdgcn_mfma_f32_16x16x4f32(av.x, bv.x, acc0, 0, 0, 0);
            acc1 = __builtin_amdgcn_mfma_f32_16x16x4f32(av.y, bv.y, acc1, 0, 0, 0);
            acc2 = __builtin_amdgcn_mfma_f32_16x16x4f32(av.z, bv.z, acc2, 0, 0, 0);
            acc3 = __builtin_amdgcn_mfma_f32_16x16x4f32(av.w, bv.w, acc3, 0, 0, 0);
        }
        const f32x4 acc = (acc0 + acc1) + (acc2 + acc3);
        wsc[C.lane] = ss;
#pragma unroll
        for (int r = 0; r < 4; ++r) wsc[64 + (4 * kq + r) * 17 + li] = acc[r];
        LDS_WAIT(); asm volatile("" ::: "memory");
        if (C.lane < 16) {
            const int row = row0 + C.lane;
            const float sst = (wsc[C.lane] + wsc[16 + C.lane]) + (wsc[32 + C.lane] + wsc[48 + C.lane]);
            const float rinv = 1.0f / sqrtf(sst * (1.0f / D) + EPS);
            float lg[16];
#pragma unroll
            for (int e = 0; e < 16; ++e) lg[e] = rinv * wsc[64 + C.lane * 17 + e] + bias2[bb * 16 + e];
            float mx = lg[0];
#pragma unroll
            for (int e = 1; e < 16; ++e) mx = fmaxf(mx, lg[e]);
            float sc[16], se = 0.f;
#pragma unroll
            for (int e = 0; e < 16; ++e) { sc[e] = expf(lg[e] - mx); se += sc[e]; }
            float sel[16];
#pragma unroll
            for (int e = 0; e < 16; ++e) { sc[e] = sc[e] / se; sel[e] = sc[e] + rbias[e]; }
            float bestgs = -3.4e38f; int bg = 0; float bs[4], bsc[4];
#pragma unroll
            for (int gg = 0; gg < 4; ++gg) {
                float m1 = -3.4e38f, m2 = -3.4e38f;
#pragma unroll
                for (int i = 0; i < 4; ++i) { const float x = sel[4 * gg + i]; if (x > m1) { m2 = m1; m1 = x; } else if (x > m2) m2 = x; }
                const float gs = m1 + m2;
                if (gs > bestgs) { bestgs = gs; bg = gg;
#pragma unroll
                    for (int i = 0; i < 4; ++i) { bs[i] = sel[4 * gg + i]; bsc[i] = sc[4 * gg + i]; } }
            }
            int i0 = 0; float b0 = bs[0];
#pragma unroll
            for (int i = 1; i < 4; ++i) if (bs[i] > b0) { b0 = bs[i]; i0 = i; }
            int i1 = -1; float b1 = -3.4e38f;
#pragma unroll
            for (int i = 0; i < 4; ++i) if (i != i0 && bs[i] > b1) { b1 = bs[i]; i1 = i; }
            float w0 = 0.f, w1 = 0.f;
#pragma unroll
            for (int i = 0; i < 4; ++i) { if (i == i0) w0 = bsc[i]; if (i == i1) w1 = bsc[i]; }
            const float wn = w0 + w1; w0 /= wn; w1 /= wn;
            const int lo = i0 < i1 ? i0 : i1, hi = i0 < i1 ? i1 : i0;
            const float wlo = i0 < i1 ? w0 : w1, whi = i0 < i1 ? w1 : w0;
            const int bin = bg * 6 + (lo * (7 - lo)) / 2 + (hi - lo - 1);
            const int slot = __hip_atomic_fetch_add(lcnt + bin, 1, __ATOMIC_RELAXED, __HIP_MEMORY_SCOPE_WORKGROUP);
            *(int4*)(tokinfo + (size_t)row * 4) = make_int4(bin, slot, __float_as_int(wlo), __float_as_int(whi));
        }
        LDS_WAIT(); asm volatile("" ::: "memory");
    }
    __syncthreads();
    if (C.tid < NBIN && !C.dry) { const int n = lcnt[C.tid];
        WSP(int, WS_BLKBASE)[C.bid * 32 + C.tid] = n > 0 ? (int)__hip_atomic_fetch_add(cnt + C.tid * 64, (unsigned)n, __ATOMIC_RELAXED, __HIP_MEMORY_SCOPE_AGENT) : 0; }
}
__device__ __forceinline__ void phase_l5b(const Ctx& C, int l) {
    build_tiletab(C, l);
    const volatile LAS int* lc = (const volatile LAS int*)(C.lds + LDSCTL_OFF);
    const int gw = C.bid * NWAVES + C.wave, NGW = C.G * NWAVES;
    const float* mods = WSP(const float, WS_MODS) + (size_t)l * 9 * 6144;
    const float* xb = WSP(const float, WS_XBUF);
    const int* tokinfo = WSP(const int, WS_TOKINFO); const int* blkbase = WSP(const int, WS_BLKBASE);
    bf16_t* hs = WSP(bf16_t, WS_PHG); int* rowtok = WSP(int, WS_ROWTOK); float* roww = WSP(float, WS_ROWW);
    const int nrows = (l < DEPTH - 1) ? NTOK : NLAT;
    f32x4 nv[4]; int4 nti = make_int4(0, 0, 0, 0);
    if (gw < nrows) { nti = *(const int4*)(tokinfo + (size_t)gw * 4);
#pragma unroll
        for (int j = 0; j < 4; ++j) nv[j] = *(const f32x4*)(xb + (size_t)gw * D + C.lane * 4 + 256 * j); }
    for (int row = gw; row < nrows; row += NGW) {
        const int4 ti = nti;
        const int pos = lc[LC_OFFS + ti.x] + blkbase[(((row >> 4) % NGW) >> 3) * 32 + ti.x] + ti.y;
        const float* md = mods + bidx(row) * 6144;
        f32x4 v[4]; float ss = 0.f;
#pragma unroll
        for (int j = 0; j < 4; ++j) v[j] = nv[j];
        if (row + NGW < nrows) { nti = *(const int4*)(tokinfo + (size_t)(row + NGW) * 4);
#pragma unroll
            for (int j = 0; j < 4; ++j) nv[j] = *(const f32x4*)(xb + (size_t)(row + NGW) * D + C.lane * 4 + 256 * j); }
#pragma unroll
        for (int j = 0; j < 4; ++j) ss += (v[j].x * v[j].x + v[j].y * v[j].y) + (v[j].z * v[j].z + v[j].w * v[j].w);
        ss = wave_sum(ss); const float rinv = 1.0f / sqrtf(ss * (1.0f / D) + EPS);
#pragma unroll
        for (int j = 0; j < 4; ++j) { const int k = C.lane * 4 + 256 * j; const f32x4 sh = *(const f32x4*)(md + 3072 + k), sc = *(const f32x4*)(md + 4096 + k);
            const f32x4 o = v[j] * rinv * (sc + 1.0f) + sh; u32x2 w; w.x = pk2(o.x, o.y); w.y = pk2(o.z, o.w);
            *(u32x2*)(hs + (size_t)pos * D + k) = w; }
        if (C.lane == 0) { rowtok[pos] = row; roww[pos * 2] = __int_as_float(ti.z); roww[pos * 2 + 1] = __int_as_float(ti.w); }
    }
    if (C.bid < NBIN) { const int b = C.bid; const int start = lc[LC_OFFS + b], end = lc[LC_OFFS + b + 1];
        const int n = (int)__hip_atomic_load(WSP(unsigned, WS_CTL) + CW_CNT + (l * 32 + b) * 64, __ATOMIC_RELAXED, __HIP_MEMORY_SCOPE_AGENT);
        float zf_ = 0.f; asm volatile("" : "+v"(zf_));
        for (int p = start + n + C.tid; p < end; p += NTHR) { rowtok[p] = -1; roww[p * 2] = zf_; roww[p * 2 + 1] = zf_; } }
}

__device__ __forceinline__ void phase_final(const Ctx& C) {
    const int gw = C.bid * NWAVES + C.wave, NGW = C.G * NWAVES;
    const float* xb = WSP(const float, WS_XBUF); const float* fw = C.in[IN_FNW];
    f32x4 nv[4];
    if (gw < NLAT) {
#pragma unroll
        for (int j = 0; j < 4; ++j) nv[j] = *(const f32x4*)(xb + (size_t)gw * D + C.lane * 4 + 256 * j); }
    for (int row = gw; row < NLAT; row += NGW) {
        f32x4 v[4]; float ss = 0.f;
#pragma unroll
        for (int j = 0; j < 4; ++j) v[j] = nv[j];
        if (row + NGW < NLAT) {
#pragma unroll
            for (int j = 0; j < 4; ++j) nv[j] = *(const f32x4*)(xb + (size_t)(row + NGW) * D + C.lane * 4 + 256 * j); }
#pragma unroll
        for (int j = 0; j < 4; ++j) ss += (v[j].x * v[j].x + v[j].y * v[j].y) + (v[j].z * v[j].z + v[j].w * v[j].w);
        ss = wave_sum(ss); const float rinv = 1.0f / sqrtf(ss * (1.0f / D) + EPS);
#pragma unroll
        for (int j = 0; j < 4; ++j) { const int k = C.lane * 4 + 256 * j; const f32x4 w = *(const f32x4*)(fw + k);
            *(f32x4*)(C.out + (size_t)row * D + k) = v[j] * rinv * w; }
    }
}

constexpr int PH_PER_LAYER = 8, N_PHASES = 2 + DEPTH * PH_PER_LAYER + 1;
__global__ void __launch_bounds__(NTHR, 2) trunk_fwd(Args args) {
    extern __shared__ __attribute__((aligned(16))) unsigned char lds[];
    Ctx C; C.in = (const CAS fptr_t*)__builtin_amdgcn_kernarg_segment_ptr(); C.out = args.out; C.ws = args.ws; C.lds = (LAS unsigned char*)lds;
    C.tid = threadIdx.x; C.lane = C.tid & 63; C.wave = __builtin_amdgcn_readfirstlane(C.tid >> 6); C.G = gridDim.x; C.bid = blockIdx.x; C.rep = args.rep; C.dry = (args.rep + 1 < (args.pad & 255)) ? (args.pad >> 8) : 0;
    LAS unsigned char* ldsl0 = (LAS unsigned char*)lds;
    if (C.tid < 64) ((LAS unsigned*)(ldsl0 + LDSCTL_OFF))[C.tid] = 0u;
    __syncthreads();
    const int lo = args.ph_lo, hi = args.ph_hi;
    XcdBarrier bar; bar.bar = WSP(unsigned, WS_CTL) + CW_BAR; bar.x = 0; bar.st = (volatile LAS unsigned*)(ldsl0 + LDSCTL_OFF + LC_BAR);
    if (hi - lo > 1) bar = xcd_barrier_post(WSP(unsigned, WS_CTL) + CW_BAR, (volatile LAS unsigned*)(ldsl0 + LDSCTL_OFF + LC_BAR));
#define FRESH_TID (C.wave * 64 + lane_id_opaque())
#define IN(k) (lo <= (k) && (k) < hi)
#define SEAM(k) do { if (IN(k) && IN((k) + 1)) xcd_barrier(bar, FRESH_TID); } while (0)
#ifndef EN
#define EN 0xFFFF
#endif
    if ((EN & 1) && IN(0)) { phase0(C); SEAM(0); }
    if ((EN & 1) && IN(1)) {
        {
            const float* md = WSP(const float, WS_MODS); const float* rw = C.in[IN_RW]; float* b2 = WSP(float, WS_BIAS2);
            for (int o = C.bid * NWAVES + C.wave; o < 4 * 9 * 16; o += C.G * NWAVES) { const int lr = o >> 4, e = o & 15; const float* sh = md + (size_t)lr * 6144 + 3072; float sacc = 0.f;
#pragma unroll
                for (int j = 0; j < 16; ++j) { const int k = C.lane + 64 * j; sacc += sh[k] * rw[k * 16 + e]; }
                sacc = wave_sum(sacc);
                if (C.lane == 0) b2[o] = sacc; }
        }
        SchedFilt S{C.G, C.bid};
        EpiFilt E{WSP(bf16_t, WS_HF), C.in[IN_B3]};
        pg8::gemm_phase<false>(ldsl0, S, E, (const char*)WSP(bf16_t, WS_W3T), (const char*)WSP(bf16_t, WS_HPAD), 128, 128, 128u * 128u * 2u, 128u * 128u * 2u, 2, FRESH_TID);
        SEAM(1);
    }
    const Ctx C0 = C;
#pragma unroll 1
    for (int l = 0; l < DEPTH; ++l) {
        const int p0 = 2 + l * PH_PER_LAYER;
        Ctx C = C0; { int t_ = C0.wave * 64 + lane_id_opaque(); asm volatile("" : "+v"(t_)); C.tid = t_; C.lane = t_ & 63; C.wave = __builtin_amdgcn_readfirstlane(t_ >> 6);
                      int b_ = C0.bid; asm volatile("" : "+s"(b_)); C.bid = b_; int g_ = C0.G; asm volatile("" : "+s"(g_)); C.G = g_; unsigned char* w_ = C0.ws; asm volatile("" : "+s"(w_)); C.ws = w_;
                      const CAS fptr_t* i_ = C0.in; asm volatile("" : "+s"(i_)); C.in = i_;
                      LAS unsigned char* l_ = C0.lds; asm volatile("" : "+s"(l_)); C.lds = l_; }
        LAS unsigned char* const ldsl = C.lds;
        const float* modl = WSP(const float, WS_MODS) + (size_t)l * 9 * 6144;
        if ((EN & 2) && IN(p0 + 0)) { phase_l1(C, l); SEAM(p0 + 0); }
        if ((EN & 4) && IN(p0 + 1)) {
            { pg8::SchedDense S; S.init(NTOK / 256, NHG / 256, C.G, C.bid, D, D);
              EpiHG E{WSP(bf16_t, WS_PHG), WSP(const float, WS_LOWER) + l * 512};
              pg8::gemm_phase<false>(ldsl, S, E, (const char*)WSP(bf16_t, WS_R1), (const char*)(WSP(bf16_t, WS_WIN) + (size_t)NHY * D), D, D, 128u * D * 2u, 128u * D * 2u, D / 64, FRESH_TID); }
            { pg8::SchedDense S; S.init(NHY / 256, NTOK / 256, C.G, C.bid, D, D);
              EpiHY E{WSP(bf16_t, WS_PHYT)};
              pg8::gemm_phase<false>(ldsl, S, E, (const char*)WSP(bf16_t, WS_WIN), (const char*)WSP(bf16_t, WS_R1), D, D, 128u * D * 2u, 128u * D * 2u, D / 64, FRESH_TID); }
            SEAM(p0 + 1);
        }
        if ((EN & 8) && IN(p0 + 2)) { phase_l3(C, l); SEAM(p0 + 2); }
        if ((EN & 16) && IN(p0 + 3)) { phase_l3b(C, l); SEAM(p0 + 3); }
        if ((EN & 32) && IN(p0 + 4)) {
            pg8::SchedDense S; S.init(NTOK / 256, D / 256, C.G, C.bid, D, D);
            EpiOut E{C.in[IN_X], C.in[IN_CTX], WSP(float, WS_XBUF), modl, l == 0 ? 1 : 0, C.dry};
            pg8::gemm_phase<false>(ldsl, S, E, (const char*)WSP(bf16_t, WS_R1), (const char*)WSP(bf16_t, WS_WOUT), D, D, 128u * D * 2u, 128u * D * 2u, D / 64, FRESH_TID);
            SEAM(p0 + 4);
        }
        if ((EN & 64) && IN(p0 + 5)) { phase_l5a(C, l); SEAM(p0 + 5); }
        if ((EN & 128) && IN(p0 + 6)) { phase_l5b(C, l); SEAM(p0 + 6); }
        if ((EN & 256) && IN(p0 + 7)) {
            build_tiletab(C, l);
            const volatile LAS int* lc = (const volatile LAS int*)(ldsl + LDSCTL_OFF);
            const int n6 = 4 * lc[LC_T];
            unsigned* cnt6 = WSP(unsigned, WS_CTL) + CW_T6 + l * 96 * 64;
#pragma unroll 1
            for (int idx = C.bid; idx < n6; idx += C.G) {
                SchedUp1 S{idx, lc + LC_TILEBIN};
                EpiAct E{WSP(bf16_t, WS_R1), WSP(const float, WS_ROWW)};
                pg8::gemm_phase<false>(ldsl, S, E, (const char*)WSP(bf16_t, WS_PHG), (const char*)WSP(bf16_t, WS_WG), D, D, 128u * D * 2u, (unsigned)(WS_WU - WS_WG), D / 64, FRESH_TID);
                asm volatile("s_waitcnt vmcnt(0)" ::: "memory");
                __syncthreads();
                if (C.wave * 64 + lane_id_opaque() == 0) {
                    __hip_atomic_fetch_add(cnt6 + (idx >> 2) * 64, 1u, __ATOMIC_RELAXED, __HIP_MEMORY_SCOPE_AGENT); }
            }
            int nb2 = n6 - C.G; nb2 = nb2 < 0 ? 0 : (nb2 > C.G - 64 ? C.G - 64 : nb2);
            const int nw = C.G - nb2;
            if (C.bid >= nb2) {
#pragma unroll 1
                for (int j = C.bid - nb2; j < n6; j += nw) {
                    if (C.wave * 64 + lane_id_opaque() == 0) { unsigned* cw = cnt6 + (j >> 2) * 64; unsigned sp = 0;
                        while (__hip_atomic_load(cw, __ATOMIC_RELAXED, __HIP_MEMORY_SCOPE_AGENT) < 4u) { __builtin_amdgcn_s_sleep(2); if (++sp > (1u << 22)) break; }
                        __builtin_amdgcn_fence(__ATOMIC_ACQUIRE, "agent"); asm volatile("s_waitcnt vmcnt(0)" ::: "memory"); }
                    __syncthreads();
                    SchedDown1 S{j, lc + LC_TILEBIN};
                    EpiDown E{WSP(float, WS_XBUF), WSP(const int, WS_ROWTOK), modl, C.dry};
                    pg8::gemm_phase<true>(ldsl, S, E, (const char*)WSP(bf16_t, WS_R1), (const char*)WSP(bf16_t, WS_WD), 512, 256, 128u * 512u * 2u, 128u * 256u * 2u, 4, FRESH_TID);
                }
            }
            SEAM(p0 + 7);
        }
    }
    if ((EN & 1024) && IN(N_PHASES - 1)) { Ctx CF = C0; CF.tid = C0.wave * 64 + lane_id_opaque(); CF.lane = CF.tid & 63; phase_final(CF); }
#undef IN
#undef SEAM
}

extern "C" void kernel_launch(void* const* d_in, const int* in_sizes, int n_in, void* d_out, int out_size, void* d_ws, size_t ws_size, hipStream_t stream) {
    static int grid = 0;
    if (grid == 0) {
        if (n_in != N_IN || in_sizes[0] != NLAT * D || out_size != NLAT * D || ws_size < WS_END) { fprintf(stderr, "kernel_launch: unexpected shapes / workspace (%d inputs, ws %zu < %zu)\n", n_in, ws_size, (size_t)WS_END); grid = -1; return; }
        int dev = 0, cus = 0, per_cu = 0;
        if (hipGetDevice(&dev) != hipSuccess || hipDeviceGetAttribute(&cus, hipDeviceAttributeMultiprocessorCount, dev) != hipSuccess) { grid = -1; return; }
        if (hipFuncSetAttribute((const void*)trunk_fwd, hipFuncAttributeMaxDynamicSharedMemorySize, LDS_BYTES) != hipSuccess) { fprintf(stderr, "kernel_launch: hipFuncSetAttribute failed\n"); grid = -1; return; }
        if (hipOccupancyMaxActiveBlocksPerMultiprocessor(&per_cu, (const void*)trunk_fwd, NTHR, LDS_BYTES) != hipSuccess || per_cu < 1) { fprintf(stderr, "kernel_launch: occupancy query says %d\n", per_cu); }
        (void)hipGetLastError();
        grid = cus;
    }
    if (grid < 0) return;
    (void)hipMemsetAsync((char*)d_ws + WS_CTL, 0, CTL_ZERO_BYTES, stream);
    Args a{};
    for (int i = 0; i < N_IN; ++i) a.in[i] = (const float*)d_in[i];
    a.out = (float*)d_out; a.ws = (unsigned char*)d_ws;
#if MK_PER_PHASE
    for (int p = 0; p < N_PHASES; ++p) { a.ph_lo = p; a.ph_hi = p + 1; const int kind = p == 0 ? 0 : (p == 1 ? 11 : (p == N_PHASES - 1 ? 10 : 1 + (p - 2) % PH_PER_LAYER));
        const int nrep = ((PROBE_HOST >> kind) & 1) ? 2 : 1; a.pad = nrep | (PROBE_SKIP << 8);
        for (int rep = 0; rep < nrep; ++rep) { a.rep = rep; hipLaunchKernelGGL(trunk_fwd, dim3(grid), dim3(NTHR), LDS_BYTES, stream, a); } }
#else
    a.ph_lo = 0; a.ph_hi = N_PHASES; a.rep = 0; a.pad = 1;
    hipLaunchKernelGGL(trunk_fwd, dim3(grid), dim3(NTHR), LDS_BYTES, stream, a);
#endif
}
```

```cpp
#include <hip/hip_runtime.h>
#include <cstdio>
#include <cstdint>

#ifndef PROBE_HOST
#define PROBE_HOST 0
#endif
#ifndef PROBE_SKIP
#define PROBE_SKIP 1
#endif
#ifndef MK_PER_PHASE
#define MK_PER_PHASE 0
#endif

#define LAS __attribute__((address_space(3)))
typedef unsigned short bf16_t;
typedef short bf16x8 __attribute__((ext_vector_type(8)));
typedef float f32x4 __attribute__((ext_vector_type(4)));
typedef float f32x2 __attribute__((ext_vector_type(2)));
typedef unsigned u32x4 __attribute__((ext_vector_type(4)));
typedef unsigned u32x2 __attribute__((ext_vector_type(2)));

constexpr int NB = 8, SEQ = 2048, D = 1024, DEPTH = 4, CTXL = 256;
constexpr int NLAT = NB * SEQ, NCTX = NB * CTXL, NTOK = NLAT + NCTX;
constexpr int DH = 512, NHY = 1536, NHG = 2560, DIN = 4096;
constexpr int NE = 16, DE = 256, NBIN = 24, SROWS = 24576;
constexpr float EPS = 1e-6f;
constexpr int NTHR = 512, NWAVES = 8;
enum { IN_X = 0, IN_C, IN_CTX, IN_CCTX, IN_WMOD, IN_BMOD, IN_WIN, IN_WOUT, IN_CONVW, IN_CONVB, IN_W1, IN_B1, IN_W2, IN_B2, IN_W3, IN_B3,
       IN_HYBIAS, IN_LB, IN_NORMW, IN_RW, IN_RB, IN_WG, IN_WU, IN_WD, IN_FNW, N_IN };

constexpr size_t MiB = 1u << 20;
constexpr size_t WS_CTL = 0, CTL_ZERO_BYTES = 1 * MiB;
constexpr size_t WS_MODS = 1 * MiB;
constexpr size_t WS_LOWER = 2 * MiB;
constexpr size_t WS_BIAS2 = 2 * MiB + 64 * 1024;
constexpr size_t WS_HPAD = 3 * MiB;
constexpr size_t WS_TOKINFO = 6 * MiB;
constexpr size_t WS_BLKBASE = 6 * MiB + 320 * 1024;
constexpr size_t WS_ROWTOK = 6 * MiB + 512 * 1024;
constexpr size_t WS_ROWW = 7 * MiB;
constexpr size_t WS_WIN = 8 * MiB;
constexpr size_t WS_WOUT = 16 * MiB;
constexpr size_t WS_WG = 18 * MiB;
constexpr size_t WS_WU = 26 * MiB;
constexpr size_t WS_WD = 34 * MiB;
constexpr size_t WS_KSPEC = 42 * MiB;
constexpr size_t WS_XBUF = 74 * MiB;
constexpr size_t WS_R1 = 146 * MiB;
constexpr size_t WS_PHG = 182 * MiB;
constexpr size_t WS_PHYT = 272 * MiB;
constexpr size_t WS_ODIR = 326 * MiB;
constexpr size_t WS_KSPC = 362 * MiB;
constexpr size_t WS_W3T = 378 * MiB;
constexpr size_t WS_HF = 380 * MiB;
constexpr size_t WS_END = 416 * MiB;
constexpr int CW_BAR = 4096;
constexpr int CW_CNT = 16384;
constexpr int CW_T6 = 65536;
constexpr int CW_Q = 32768;

constexpr int LDS_BYTES = 147456;
constexpr int LDSCTL_OFF = 143 * 1024;
constexpr int LC_BAR = 0;
constexpr int LC_T = 8;
constexpr int LC_Q = 9;
constexpr int LC_OFFS = 16;
constexpr int LC_TILEBIN = 48;

__device__ __forceinline__ unsigned f2bf(float f) { return (unsigned)__builtin_bit_cast(unsigned short, (__bf16)f); }
typedef __bf16 bf16x2v __attribute__((ext_vector_type(2)));
__device__ __forceinline__ unsigned pk2(float lo, float hi) { const f32x2 v = {lo, hi}; return __builtin_bit_cast(unsigned, __builtin_convertvector(v, bf16x2v)); }
__device__ __forceinline__ float bf2f(unsigned b) { return __builtin_bit_cast(float, (b & 0xffffu) << 16); }
__device__ __forceinline__ float bflo(unsigned w) { return __builtin_bit_cast(float, w << 16); }
__device__ __forceinline__ float bfhi(unsigned w) { return __builtin_bit_cast(float, w & 0xffff0000u); }
__device__ __forceinline__ float sigmoidf_(float x) { return __builtin_amdgcn_rcpf(1.0f + __expf(-x)); }
__device__ __forceinline__ float siluf_(float x) { return x * __builtin_amdgcn_rcpf(1.0f + __expf(-x)); }
#define DPP_ADD(v, ctrl, rmask) v += __builtin_bit_cast(float, __builtin_amdgcn_update_dpp(0, __builtin_bit_cast(int, v), ctrl, rmask, 0xF, false))
__device__ __forceinline__ float row16_sum(float v) {
    DPP_ADD(v, 0xB1, 0xF);
    DPP_ADD(v, 0x4E, 0xF);
    DPP_ADD(v, 0x141, 0xF);
    DPP_ADD(v, 0x140, 0xF);
    return v;
}
__device__ __forceinline__ float wave_sum(float v) {
    v = row16_sum(v);
    DPP_ADD(v, 0x142, 0xA);
    DPP_ADD(v, 0x143, 0xC);
    return __builtin_bit_cast(float, __builtin_amdgcn_readlane(__builtin_bit_cast(int, v), 63));
}
__device__ __forceinline__ int lane_id_opaque() { int x; asm volatile("v_mbcnt_lo_u32_b32 %0, -1, 0\n\tv_mbcnt_hi_u32_b32 %0, -1, %0" : "=v"(x)); return x; }
__device__ __forceinline__ int bidx(int row) { return row < NLAT ? (row >> 11) : 8; }
#define LDS_WAIT() asm volatile("s_waitcnt lgkmcnt(0)" ::: "memory")

#define XB_TMO      128
#define XB_XCNT(j)  (256  + 64 * (j))
#define XB_XSUB(j)  (1280 + 64 * (j))
#define XB_XGEN(j)  (2304 + 64 * (j))
#define XB_TOP      3328
#define XB_TOPGEN   3392
#define XCD_BAR_WORDS 3456
#define XB_SPIN_CAP (1u << 18)
__device__ __forceinline__ unsigned xb_ld(unsigned* p)              { return __hip_atomic_load(p, __ATOMIC_RELAXED, __HIP_MEMORY_SCOPE_AGENT); }
__device__ __forceinline__ unsigned xb_add(unsigned* p, unsigned v) { return __hip_atomic_fetch_add(p, v, __ATOMIC_RELAXED, __HIP_MEMORY_SCOPE_AGENT); }
__device__ __forceinline__ unsigned xb_xcc_id() { return (unsigned)__builtin_amdgcn_s_getreg((3 << 11) | 20) & 0xFu; }
#define XB_SPIN(cond, bar) do { unsigned _sp = 0; while (cond) { __builtin_amdgcn_s_sleep(1); \
    if ((++_sp & 255u) == 0u) { if (xb_ld(&(bar)[XB_TMO])) break; if (_sp > XB_SPIN_CAP) { atomicAdd(&(bar)[XB_TMO], 1u); break; } } } } while (0)
struct XcdBarrier { unsigned* bar; unsigned x; volatile LAS unsigned* st; };
__device__ __forceinline__ XcdBarrier xcd_barrier_post(unsigned* bar, volatile LAS unsigned* st) {
    XcdBarrier b; b.bar = bar; b.x = xb_xcc_id(); b.st = st;
    if (threadIdx.x == 0) (void)xb_add(&bar[XB_XCNT(b.x)], 1u);
    return b;
}
__device__ __forceinline__ void xcd_barrier_complete(unsigned* bar, unsigned x, unsigned& nloc, unsigned& nx) {
    const unsigned G = gridDim.x * gridDim.y * gridDim.z;
    unsigned sum, cnt, mine, sp = 0u;
    for (;;) {
        sum = 0u; cnt = 0u; mine = 0u;
#pragma unroll
        for (unsigned j = 0; j < 16; ++j) { const unsigned c = xb_ld(&bar[XB_XCNT(j)]); sum += c; cnt += (c > 0u) ? 1u : 0u; mine = (j == x) ? c : mine; }
        if (sum == G) break;
        __builtin_amdgcn_s_sleep(1);
        if ((++sp & 255u) == 0u) { if (xb_ld(&bar[XB_TMO])) break; if (sp > XB_SPIN_CAP) { atomicAdd(&bar[XB_TMO], 1u); break; } }
    }
    nloc = mine > 0u ? mine : 1u; nx = cnt > 0u ? cnt : 1u;
}
__device__ __forceinline__ void xcd_barrier(const XcdBarrier& b, const int tid0) {
    asm volatile("s_waitcnt vmcnt(0)" ::: "memory");
    __syncthreads();
    if (tid0 == 0) {
        unsigned* bar = b.bar; unsigned bx = b.x;
        asm volatile("" : "+s"(bar), "+s"(bx));
        __builtin_amdgcn_s_waitcnt(0);
        unsigned nloc = b.st[0], nx = b.st[1];
        if (nloc == 0u) { xcd_barrier_complete(bar, bx, nloc, nx); b.st[0] = nloc; b.st[1] = nx; }
        const unsigned old = xb_add(&bar[XB_XSUB(bx)], 1u);
        const unsigned gen = old / nloc;
        if (old + 1u == (gen + 1u) * nloc) {
            __builtin_amdgcn_fence(__ATOMIC_RELEASE, "agent");
            asm volatile("s_waitcnt vmcnt(0)" ::: "memory");
            const unsigned og = xb_add(&bar[XB_TOP], 1u);
            const unsigned tg = og / nx;
            if (og + 1u == (tg + 1u) * nx) xb_add(&bar[XB_TOPGEN], 1u);
            else XB_SPIN(xb_ld(&bar[XB_TOPGEN]) == tg, bar);
            __builtin_amdgcn_fence(__ATOMIC_ACQUIRE, "agent");
            xb_add(&bar[XB_XGEN(bx)], 1u);
            asm volatile("s_waitcnt vmcnt(0)" ::: "memory");
        } else {
            XB_SPIN(xb_ld(&bar[XB_XGEN(bx)]) == gen, bar);
            __builtin_amdgcn_fence(__ATOMIC_ACQUIRE, "agent");
            asm volatile("s_waitcnt vmcnt(0)" ::: "memory");
        }
    }
    __syncthreads();
}

namespace pg8 {
constexpr int BM = 256, BK = 64, HALF = 128, HTB = HALF * BK * 2, STAGE_BYTES = 8 * HTB, NXCD = 8, WGM = 8;
__host__ __device__ __forceinline__ int lds_byte(int r, int c) { const int st = (r >> 4) * 2 + (c >> 5), rr = r & 15, cc = c & 31, ob = rr * 64 + cc * 2; return st * 1024 + (ob ^ (((ob >> 9) & 1) << 5)); }
__host__ __device__ __forceinline__ void stage_rc(int b, int& R, int& C) { const int st = b / 1024, sb = b % 1024, swz = sb ^ (((sb >> 9) & 1) << 5); R = (st >> 1) * 16 + swz / 64; C = (st & 1) * 32 + (swz % 64) / 2; }
__host__ __device__ __forceinline__ int perm32(int rho) { const int n = rho >> 4, i = rho & 15; return 8 * (i >> 2) + 4 * n + (i & 3); }

struct GUnit { unsigned a, b; int last, i0, i1; };

template <bool SUB, class Epi, class Sched>
__device__ __forceinline__ void gemm_phase(LAS unsigned char* lds, const Sched& S, const Epi& E, const char* Abase, const char* Bbase, const int lda, const int ldb, const unsigned ahalf, const unsigned bhalf, const int nt, const int tid_in) {
    int tid_ = tid_in; asm volatile("" : "+v"(tid_));
    const int tid = tid_, wid = __builtin_amdgcn_readfirstlane(tid >> 6), lane = tid & 63, wr = wid >> 2, wc = wid & 3, fr = lane & 15, fq = lane >> 4;
    unsigned voffA[2], voffB[2];
#pragma unroll
    for (int i = 0; i < 2; ++i) { int R, C; stage_rc(tid * 16 + i * 8192, R, C); const int Rb = Epi::PERM ? ((R & ~31) + perm32(R & 31)) : R;
        voffA[i] = (unsigned)(R * lda + C) * 2u; voffB[i] = (unsigned)(Rb * ldb + C) * 2u; }
    constexpr unsigned kstep = BK * 2;
    const unsigned ldsw = (unsigned)wid * 1024u;
    const int aoff = lds_byte(wr * 64 + fr, fq * 8), boff = lds_byte(wc * 32 + fr, fq * 8);
#define PG8_SA(b, h) (((b) * 2 + (h)) * HTB)
#define PG8_SB(b, h) ((4 + (b) * 2 + (h)) * HTB)
#define PG8_STAGE(bufoff, gbase, voff) do { _Pragma("unroll") for (int _i = 0; _i < 2; ++_i) \
        __builtin_amdgcn_global_load_lds((const unsigned*)((const char*)(gbase) + (voff)[_i]), (LAS unsigned*)(lds + (bufoff) + ldsw + _i * 8192), 16, 0, 0); } while (0)
#define PG8_LDA(dst, b, h) do { _Pragma("unroll") for (int m = 0; m < 4; ++m) _Pragma("unroll") for (int k = 0; k < 2; ++k) dst[m][k] = *(const LAS bf16x8*)(lds + PG8_SA(b, h) + aoff + m * 2048 + k * 1024); } while (0)
#define PG8_LDB(dst, b, h) do { _Pragma("unroll") for (int n = 0; n < 2; ++n) _Pragma("unroll") for (int k = 0; k < 2; ++k) dst[n][k] = *(const LAS bf16x8*)(lds + PG8_SB(b, h) + boff + n * 2048 + k * 1024); } while (0)
#define PG8_MMA(ai, bj, At, Bt) do { __builtin_amdgcn_s_setprio(1); _Pragma("unroll") for (int m = 0; m < 4; ++m) _Pragma("unroll") for (int n = 0; n < 2; ++n) _Pragma("unroll") for (int k = 0; k < 2; ++k) \
        acc[ai][bj][m][n] = __builtin_amdgcn_mfma_f32_16x16x32_bf16(Bt[n][k], At[m][k], acc[ai][bj][m][n], 0, 0, 0); __builtin_amdgcn_s_setprio(0); } while (0)
#define PG8_WAIT_V(n) asm volatile("s_waitcnt vmcnt(" #n ")" ::: "memory")
#define PG8_WAIT_L(n) asm volatile("s_waitcnt lgkmcnt(" #n ")" ::: "memory")
#define PG8_BAR __builtin_amdgcn_s_barrier()
#define PG8_SCHED __builtin_amdgcn_sched_barrier(0)
    GUnit cur, nxt; int ui = 0;
    if (!S.next(0, cur)) return;
    f32x4 acc[2][2][4][2];
    float zf_ = 0.f; asm volatile("" : "+v"(zf_));
#pragma unroll
    for (int a = 0; a < 2; ++a)
#pragma unroll
        for (int b = 0; b < 2; ++b)
#pragma unroll
            for (int m = 0; m < 4; ++m)
#pragma unroll
                for (int n = 0; n < 2; ++n) acc[a][b][m][n] = (f32x4){zf_, zf_, zf_, zf_};
    bf16x8 At[4][2], B0[2][2], B1[2][2];
    { const char* cA = Abase + cur.a; const char* cB = Bbase + cur.b;
      PG8_STAGE(PG8_SB(0, 0), cB, voffB); PG8_STAGE(PG8_SB(0, 1), cB + bhalf, voffB); PG8_STAGE(PG8_SA(0, 0), cA, voffA); PG8_STAGE(PG8_SA(0, 1), cA + ahalf, voffA);
      if (wr == 1) PG8_BAR;
      PG8_WAIT_V(2); PG8_BAR;
      PG8_STAGE(PG8_SB(1, 0), cB + kstep, voffB); PG8_STAGE(PG8_SA(1, 0), cA + kstep, voffA); PG8_STAGE(PG8_SB(1, 1), cB + bhalf + kstep, voffB);
      PG8_WAIT_V(6); PG8_BAR; }
    for (;;) {
        const bool has_next = S.next(ui + 1, nxt);
        const char* cA = Abase + cur.a; const char* cB = Bbase + cur.b;
        const char* nA = Abase + (has_next ? nxt.a : cur.a); const char* nB = Bbase + (has_next ? nxt.b : cur.b);
        for (int t = 0; t < nt; t += 2) {
            const bool last = (t == nt - 2);
            const char* a1 = cA + (unsigned)(t + 1) * kstep;
            const char* a2 = last ? nA : cA + (unsigned)(t + 2) * kstep; const char* b2 = last ? nB : cB + (unsigned)(t + 2) * kstep;
            const char* a3 = a2 + kstep; const char* b3 = b2 + kstep;
            PG8_LDB(B0, 0, 0); PG8_LDB(B1, 0, 1); PG8_SCHED; PG8_LDA(At, 0, 0); PG8_STAGE(PG8_SA(1, 1), a1 + ahalf, voffA);
            PG8_WAIT_V(8); PG8_WAIT_L(0); PG8_BAR; PG8_MMA(0, 0, At, B0); PG8_MMA(0, 1, At, B1); PG8_BAR; PG8_SCHED;
            PG8_LDA(At, 0, 1); PG8_STAGE(PG8_SB(0, 0), b2, voffB); PG8_STAGE(PG8_SB(0, 1), b2 + bhalf, voffB); PG8_STAGE(PG8_SA(0, 0), a2, voffA);
            PG8_WAIT_V(8); PG8_WAIT_L(0); PG8_BAR; PG8_MMA(1, 0, At, B0); PG8_MMA(1, 1, At, B1); PG8_BAR; PG8_SCHED;
            PG8_LDB(B0, 1, 0); PG8_LDB(B1, 1, 1); PG8_SCHED; PG8_LDA(At, 1, 0); PG8_STAGE(PG8_SA(0, 1), a2 + ahalf, voffA);
            PG8_WAIT_V(8); PG8_WAIT_L(0); PG8_BAR; PG8_MMA(0, 0, At, B0); PG8_MMA(0, 1, At, B1); PG8_BAR; PG8_SCHED;
            PG8_LDA(At, 1, 1); PG8_STAGE(PG8_SB(1, 0), b3, voffB); PG8_STAGE(PG8_SB(1, 1), b3 + bhalf, voffB); PG8_STAGE(PG8_SA(1, 0), a3, voffA);
            PG8_WAIT_V(8); PG8_WAIT_L(0); PG8_BAR; PG8_MMA(1, 0, At, B0); PG8_MMA(1, 1, At, B1); PG8_BAR; PG8_SCHED;
        }
        const bool fin = SUB ? (cur.last != 0) : true;
        if (fin) { if (wr == 0) PG8_BAR; E(acc, cur, wr, wc, fr, fq); }
        if (!has_next) break;
        if (fin) {
#pragma unroll
            for (int a = 0; a < 2; ++a)
#pragma unroll
                for (int b = 0; b < 2; ++b)
#pragma unroll
                    for (int m = 0; m < 4; ++m)
#pragma unroll
                        for (int n = 0; n < 2; ++n) acc[a][b][m][n] = (f32x4){zf_, zf_, zf_, zf_};
        }
        cur = nxt; ++ui;
        if (fin) { if (wr == 1) PG8_BAR; }
    }
    PG8_WAIT_V(0);
    PG8_BAR;
#undef PG8_SA
#undef PG8_SB
#undef PG8_STAGE
#undef PG8_LDA
#undef PG8_LDB
#undef PG8_MMA
#undef PG8_WAIT_V
#undef PG8_WAIT_L
#undef PG8_BAR
#undef PG8_SCHED
}

struct SchedDense {
    int nM, nN, nwg, G, c; unsigned atile, btile;
    __device__ __forceinline__ void init(int nM_, int nN_, int G_, int c_, int lda, int ldb) {
        nM = nM_; nN = nN_; nwg = nM * nN; G = G_; c = c_; atile = 256u * lda * 2u; btile = 256u * ldb * 2u; }
    __device__ __forceinline__ bool next(int i, GUnit& u) const {
        const int L = i * G + c; if (L >= nwg) return false;
        int wgid = L; { const int q = nwg / NXCD, r = nwg % NXCD, xcd = wgid % NXCD, off = wgid / NXCD; wgid = (xcd < r ? xcd * (q + 1) : r * (q + 1) + (xcd - r) * q) + off; }
        const int nig = WGM * nN, gid = wgid / nig, fm = gid * WGM, gsz = (nM - fm) < WGM ? (nM - fm) : WGM;
        const int pm = fm + ((wgid % nig) % gsz), pn = (wgid % nig) / gsz;
        u.a = (unsigned)pm * atile; u.b = (unsigned)pn * btile; u.last = 1; u.i0 = pm; u.i1 = pn; return true;
    }
};
}

struct Args { const float* in[N_IN]; float* out; unsigned char* ws; int ph_lo, ph_hi, rep, pad; };
static_assert(sizeof(Args) == N_IN * 8 + 8 + 8 + 16, "Args has no padding");

#define CAS __attribute__((address_space(4)))
typedef const float* fptr_t;
struct Ctx {
    const CAS fptr_t* in; float* out; unsigned char* ws; LAS unsigned char* lds; int tid, lane, wave, G, bid, rep, dry;
};
#define WSP(T, off) ((T*)(C.ws + (off)))

__device__ __forceinline__ void build_tiletab(const Ctx& C, int l) {
    volatile LAS int* lc = (volatile LAS int*)(C.lds + LDSCTL_OFF);
    __syncthreads();
    if (C.tid == 0) {
        const unsigned* cnt = WSP(const unsigned, WS_CTL) + CW_CNT + l * 32 * 64;
        int off = 0, t = 0;
        for (int b = 0; b < NBIN; ++b) {
            const int n = (int)__hip_atomic_load(cnt + b * 64, __ATOMIC_RELAXED, __HIP_MEMORY_SCOPE_AGENT);
            lc[LC_OFFS + b] = off;
            const int nt = (n + 255) >> 8;
            for (int k = 0; k < nt; ++k) lc[LC_TILEBIN + t + k] = b;
            t += nt; off += nt * 256;
        }
        lc[LC_OFFS + NBIN] = off; lc[LC_T] = t;
    }
    __syncthreads();
}
__device__ __forceinline__ int expert_of(int bin, int es) {
    const int g = bin / 6, p = bin - g * 6;
    const int lo = p < 3 ? 0 : (p < 5 ? 1 : 2), hi = p < 3 ? p + 1 : (p < 5 ? p - 1 : 3);
    return 4 * g + (es ? hi : lo);
}

struct SchedUp {
    int T, G, c; const volatile LAS int* tilebin;
    __device__ __forceinline__ bool next(int i, pg8::GUnit& u) const {
        const int idx = i * G + c; if (idx >= 4 * T) return false;
        const int rt = idx >> 2, q = idx & 3, es = q >> 1, fb = q & 1;
        const int bin = __builtin_amdgcn_readfirstlane(tilebin[rt]);
        const int e = expert_of(bin, es);
        u.a = (unsigned)rt * 256u * 2048u; u.b = (unsigned)(e * 256 + fb * 128) * 2048u;
        u.last = 1; u.i0 = rt; u.i1 = q; return true;
    }
};
struct SchedDown {
    int T, G, c; const volatile LAS int* tilebin;
    __device__ __forceinline__ bool next(int i, pg8::GUnit& u) const {
        const int idx = (i >> 1) * G + c, sub = i & 1; if (idx >= 4 * T) return false;
        const int rt = idx >> 2, pn = idx & 3;
        const int bin = __builtin_amdgcn_readfirstlane(tilebin[rt]);
        const int e = expert_of(bin, sub);
        u.a = (unsigned)rt * 256u * 1024u + (unsigned)sub * 512u; u.b = (unsigned)(e * 1024 + pn * 256) * 512u;
        u.last = sub; u.i0 = rt; u.i1 = pn; return true;
    }
};

struct SchedUp1 {
    int idx; const volatile LAS int* tilebin;
    __device__ __forceinline__ bool next(int i, pg8::GUnit& u) const {
        if (i != 0) return false;
        const int rt = idx >> 2, q = idx & 3, es = q >> 1, fb = q & 1;
        const int bin = __builtin_amdgcn_readfirstlane(tilebin[rt]);
        const int e = expert_of(bin, es);
        u.a = (unsigned)rt * 256u * 2048u; u.b = (unsigned)(e * 256 + fb * 128) * 2048u;
        u.last = 1; u.i0 = rt; u.i1 = q; return true;
    }
};
struct SchedDown1 {
    int idx; const volatile LAS int* tilebin;
    __device__ __forceinline__ bool next(int i, pg8::GUnit& u) const {
        if (i > 1) return false;
        const int sub = i, rt = idx >> 2, pn = idx & 3;
        const int bin = __builtin_amdgcn_readfirstlane(tilebin[rt]);
        const int e = expert_of(bin, sub);
        u.a = (unsigned)rt * 256u * 1024u + (unsigned)sub * 512u; u.b = (unsigned)(e * 1024 + pn * 256) * 512u;
        u.last = sub; u.i0 = rt; u.i1 = pn; return true;
    }
};

struct EpiHG {
    static constexpr bool PERM = true;
    bf16_t* O; const float* lower;
    __device__ __forceinline__ void operator()(const f32x4 (&acc)[2][2][4][2], const pg8::GUnit& u, int wr, int wc, int fr, int fq) const {
        const int kind = u.i1 >> 1;
        const int row0 = u.i0 * 256 + wr * 64 + fr, colt = u.i1 * 256 + wc * 32 + 8 * fq;
#pragma unroll
        for (int bj = 0; bj < 2; ++bj) {
            const int col = colt + bj * 128;
            float om[8];
#pragma unroll
            for (int j = 0; j < 8; ++j) om[j] = 1.f;
            if (kind >= 3) { const float* lb = lower + (kind - 3) * 2048 + (col & 511);
#pragma unroll
                for (int j = 0; j < 8; ++j) om[j] = 1.f - lb[j]; }
#pragma unroll
            for (int ai = 0; ai < 2; ++ai)
#pragma unroll
                for (int m = 0; m < 4; ++m) {
                    float v[8];
#pragma unroll
                    for (int j = 0; j < 8; ++j) v[j] = acc[ai][bj][m][j >> 2][j & 3];
                    if (kind == 0) {
#pragma unroll
                        for (int j = 0; j < 8; ++j) v[j] = siluf_(v[j]);
                    } else if (kind >= 3) {
#pragma unroll
                        for (int j = 0; j < 8; ++j) v[j] = om[j] * sigmoidf_(-v[j]);
                    }
                    u32x4 w; w.x = pk2(v[0], v[1]); w.y = pk2(v[2], v[3]); w.z = pk2(v[4], v[5]); w.w = pk2(v[6], v[7]);
                    *(u32x4*)(O + (size_t)(row0 + ai * 128 + m * 16) * NHG + col) = w;
                }
        }
    }
};
struct EpiHY {
    static constexpr bool PERM = true;
    bf16_t* O;
    __device__ __forceinline__ void operator()(const f32x4 (&acc)[2][2][4][2], const pg8::GUnit& u, int wr, int wc, int fr, int fq) const {
        const int row0 = u.i0 * 256 + wr * 64 + fr, colt = u.i1 * 256 + wc * 32 + 8 * fq;
#pragma unroll
        for (int ai = 0; ai < 2; ++ai)
#pragma unroll
            for (int m = 0; m < 4; ++m)
#pragma unroll
                for (int bj = 0; bj < 2; ++bj) {
                    const f32x4 v0 = acc[ai][bj][m][0], v1 = acc[ai][bj][m][1];
                    u32x4 w; w.x = pk2(v0[0], v0[1]); w.y = pk2(v0[2], v0[3]); w.z = pk2(v1[0], v1[1]); w.w = pk2(v1[2], v1[3]);
                    *(u32x4*)(O + (size_t)(row0 + ai * 128 + m * 16) * NTOK + colt + bj * 128) = w;
                }
    }
};
struct EpiOut {
    static constexpr bool PERM = false;
    const float* xlat; const float* xctx; float* xo; const float* mods; int first; int dry;
    __device__ __forceinline__ void operator()(const f32x4 (&acc)[2][2][4][2], const pg8::GUnit& u, int wr, int wc, int fr, int fq) const {
        const int row0 = u.i0 * 256 + wr * 64 + fr, col0 = u.i1 * 256 + wc * 32 + 4 * fq;
#pragma unroll
        for (int ai = 0; ai < 2; ++ai)
#pragma unroll
            for (int m = 0; m < 4; ++m) {
                const int row = row0 + ai * 128 + m * 16;
                const float* src = first ? (row < NLAT ? xlat + (size_t)row * D : xctx + (size_t)(row - NLAT) * D) : xo + (size_t)row * D;
                const float* g1 = mods + bidx(row) * 6144 + 2048;
#pragma unroll
                for (int bj = 0; bj < 2; ++bj)
#pragma unroll
                    for (int n = 0; n < 2; ++n) { const int col = col0 + bj * 128 + n * 16;
                        const f32x4 xv = *(const f32x4*)(src + col), gv = *(const f32x4*)(g1 + col);
                        if (!dry) *(f32x4*)(xo + (size_t)row * D + col) = xv + gv * acc[ai][bj][m][n]; }
            }
    }
};
struct EpiAct {
    static constexpr bool PERM = true;
    bf16_t* O; const float* roww;
    __device__ __forceinline__ void operator()(const f32x4 (&acc)[2][2][4][2], const pg8::GUnit& u, int wr, int wc, int fr, int fq) const {
        const int es = u.i1 >> 1; const int pos0 = u.i0 * 256 + wr * 64 + fr, col = u.i1 * 128 + wc * 32 + 8 * fq;
        const __amdgpu_buffer_rsrc_t rsrc = __builtin_amdgcn_make_buffer_rsrc(O, 0, SROWS * 512 * 2, 0x00020000);
#pragma unroll
        for (int ai = 0; ai < 2; ++ai)
#pragma unroll
            for (int m = 0; m < 4; ++m) {
                const int pos = pos0 + ai * 128 + m * 16;
                const float wgt = roww[pos * 2 + es];
                float v[8];
#pragma unroll
                for (int j = 0; j < 8; ++j) v[j] = siluf_(acc[ai][0][m][j >> 2][j & 3]) * acc[ai][1][m][j >> 2][j & 3] * wgt;
                u32x4 w; w.x = pk2(v[0], v[1]); w.y = pk2(v[2], v[3]); w.z = pk2(v[4], v[5]); w.w = pk2(v[6], v[7]);
                __builtin_amdgcn_raw_buffer_store_b128(w, rsrc, (unsigned)(pos * 512 + col) * 2u, 0, 16);
            }
    }
};
struct EpiDown {
    static constexpr bool PERM = false;
    float* xo; const int* rowtok; const float* mods; int dry;
    __device__ __forceinline__ void operator()(const f32x4 (&acc)[2][2][4][2], const pg8::GUnit& u, int wr, int wc, int fr, int fq) const {
        const int pos0 = u.i0 * 256 + wr * 64 + fr, col0 = u.i1 * 256 + wc * 32 + 4 * fq;
#pragma unroll
        for (int ai = 0; ai < 2; ++ai)
#pragma unroll
            for (int m = 0; m < 4; ++m) {
                const int tok = rowtok[pos0 + ai * 128 + m * 16];
                if (tok >= 0) {
                    const float* g2 = mods + bidx(tok) * 6144 + 5120;
                    float* xr = xo + (size_t)tok * D;
#pragma unroll
                    for (int bj = 0; bj < 2; ++bj)
#pragma unroll
                        for (int n = 0; n < 2; ++n) { const int col = col0 + bj * 128 + n * 16;
                            const f32x4 xv = *(const f32x4*)(xr + col), gv = *(const f32x4*)(g2 + col);
                            if (!dry) *(f32x4*)(xr + col) = xv + gv * acc[ai][bj][m][n]; }
                }
            }
    }
};

struct SchedFilt {
    int G, c;
    __device__ __forceinline__ bool next(int i, pg8::GUnit& u) const {
        const int idx = i * G + c; if (idx >= 4 * 72) return false;
        const int l = idx / 72, r = idx - l * 72, pm = r / 9, pn = r - pm * 9;
        u.a = (unsigned)(l * 2048 + pm * 256) * 256u; u.b = (unsigned)(l * 2304 + pn * 256) * 256u; u.last = 1; u.i0 = l * 16 + pm; u.i1 = pn; return true;
    }
};
struct EpiFilt {
    static constexpr bool PERM = true;
    bf16_t* HF; const float* b3;
    __device__ __forceinline__ void operator()(const f32x4 (&acc)[2][2][4][2], const pg8::GUnit& u, int wr, int wc, int fr, int fq) const {
        const int l = u.i0 >> 4, pm = u.i0 & 15;
        const int row0 = pm * 256 + wr * 64 + fr, t00 = u.i1 * 256 + wc * 32 + 8 * fq;
#pragma unroll
        for (int ai = 0; ai < 2; ++ai)
#pragma unroll
            for (int m = 0; m < 4; ++m) {
                const int row = row0 + ai * 128 + m * 16, c = row & 511;
                const float delta = fabsf(logf(1e-2f) / 0.3f + (float)c * ((logf(1e-2f) / 1.5f - logf(1e-2f) / 0.3f) / 511.0f));
                const float bias = b3[l * 2048 + row];
#pragma unroll
                for (int bj = 0; bj < 2; ++bj) {
                    const int t0 = t00 + bj * 128;
                    float v[8];
#pragma unroll
                    for (int j = 0; j < 8; ++j) { const int t = t0 + j; const float tn = t < 2048 ? (float)t / 2047.0f : (float)(t - 2048) / 255.0f;
                        v[j] = (acc[ai][bj][m][j >> 2][j & 3] + bias) * expf(-tn * delta); }
                    u32x4 w; w.x = pk2(v[0], v[1]); w.y = pk2(v[2], v[3]); w.z = pk2(v[4], v[5]); w.w = pk2(v[6], v[7]);
                    *(u32x4*)(HF + ((size_t)(l * 2048 + row)) * 2304 + t0) = w;
                }
            }
    }
};

__device__ __forceinline__ int padx(int i) { return i + (i >> 3); }
__device__ __forceinline__ f32x2 cmul(f32x2 a, f32x2 b) { return (f32x2){a.x * b.x - a.y * b.y, a.x * b.y + a.y * b.x}; }
__device__ __forceinline__ f32x2 cmulc(f32x2 a, f32x2 b) { return (f32x2){a.x * b.x + a.y * b.y, a.y * b.x - a.x * b.y}; }
constexpr int XPAD = 2048 + 256;

__device__ __forceinline__ void fft_p1_dif(f32x2 (&v)[8], int tt, const LAS f32x2* T) {
#pragma unroll
    for (int g = 0; g < 2; ++g) { const int u = tt + 256 * g;
#pragma unroll
        for (int j = 0; j < 2; ++j) { const f32x2 a = v[g + 2 * j], b = v[g + 2 * j + 4]; v[g + 2 * j] = a + b; v[g + 2 * j + 4] = cmul(a - b, T[2 * (u + 512 * j)]); }
        const f32x2 tw = T[4 * u];
        { const f32x2 a = v[g], b = v[g + 2]; v[g] = a + b; v[g + 2] = cmul(a - b, tw); }
        { const f32x2 a = v[g + 4], b = v[g + 6]; v[g + 4] = a + b; v[g + 6] = cmul(a - b, tw); } }
}
__device__ __forceinline__ void fft_p1_dit(f32x2 (&v)[8], int tt, const LAS f32x2* T) {
#pragma unroll
    for (int g = 0; g < 2; ++g) { const int u = tt + 256 * g;
        const f32x2 tw = T[4 * u];
        { const f32x2 a = v[g], b = cmulc(v[g + 2], tw); v[g] = a + b; v[g + 2] = a - b; }
        { const f32x2 a = v[g + 4], b = cmulc(v[g + 6], tw); v[g + 4] = a + b; v[g + 6] = a - b; }
#pragma unroll
        for (int j = 0; j < 2; ++j) { const f32x2 a = v[g + 2 * j], b = cmulc(v[g + 2 * j + 4], T[2 * (u + 512 * j)]); v[g + 2 * j] = a + b; v[g + 2 * j + 4] = a - b; } }
}
template <int Q> __device__ __forceinline__ void r8_dif(f32x2 (&e)[8], int r, const LAS f32x2* T) {
    constexpr int S2 = 512 / Q;
#pragma unroll
    for (int j = 0; j < 4; ++j) { const f32x2 a = e[j], b = e[j + 4]; e[j] = a + b; e[j + 4] = cmul(a - b, T[S2 * (r + Q * j)]); }
#pragma unroll
    for (int jj = 0; jj < 4; ++jj) { const int j = (jj & 1) + 4 * (jj >> 1); const f32x2 a = e[j], b = e[j + 2]; e[j] = a + b; e[j + 2] = cmul(a - b, T[2 * S2 * (r + Q * (j & 1))]); }
    const f32x2 tw = T[4 * S2 * r];
#pragma unroll
    for (int j = 0; j < 8; j += 2) { const f32x2 a = e[j], b = e[j + 1]; e[j] = a + b; e[j + 1] = cmul(a - b, tw); }
}
template <int Q> __device__ __forceinline__ void r8_dit(f32x2 (&e)[8], int r, const LAS f32x2* T) {
    constexpr int S2 = 512 / Q;
    const f32x2 tw = T[4 * S2 * r];
#pragma unroll
    for (int j = 0; j < 8; j += 2) { const f32x2 a = e[j], b = cmulc(e[j + 1], tw); e[j] = a + b; e[j + 1] = a - b; }
#pragma unroll
    for (int jj = 0; jj < 4; ++jj) { const int j = (jj & 1) + 4 * (jj >> 1); const f32x2 a = e[j], b = cmulc(e[j + 2], T[2 * S2 * (r + Q * (j & 1))]); e[j] = a + b; e[j + 2] = a - b; }
#pragma unroll
    for (int j = 0; j < 4; ++j) { const f32x2 a = e[j], b = cmulc(e[j + 4], T[S2 * (r + Q * j)]); e[j] = a + b; e[j + 4] = a - b; }
}
template <int Q, bool INV> __device__ __forceinline__ void fft_mid(LAS f32x2* X, int tt, const LAS f32x2* T) {
    const int blk = tt / Q, r = tt % Q, base = blk * 8 * Q + r;
    f32x2 e[8];
#pragma unroll
    for (int j = 0; j < 8; ++j) e[j] = X[padx(base + Q * j)];
    if (INV) r8_dit<Q>(e, r, T); else r8_dif<Q>(e, r, T);
#pragma unroll
    for (int j = 0; j < 8; ++j) X[padx(base + Q * j)] = e[j];
}
__device__ __forceinline__ void fft_conv_half(f32x2 (&v)[8], LAS f32x2* X, const LAS f32x2* T, const f32x2* K, int tt) {
    f32x2 kv[8];
#pragma unroll
    for (int j = 0; j < 8; ++j) kv[j] = K[8 * tt + j];
    fft_p1_dif(v, tt, T);
#pragma unroll
    for (int m = 0; m < 8; ++m) X[padx(tt + 256 * m)] = v[m];
    __syncthreads();
    fft_mid<64, false>(X, tt, T); __syncthreads();
    fft_mid<8, false>(X, tt, T); __syncthreads();
    f32x2 e[8];
#pragma unroll
    for (int j = 0; j < 8; ++j) e[j] = X[padx(8 * tt + j)];
    r8_dif<1>(e, 0, T);
#pragma unroll
    for (int j = 0; j < 8; ++j) e[j] = cmul(e[j], kv[j]);
    r8_dit<1>(e, 0, T);
#pragma unroll
    for (int j = 0; j < 8; ++j) X[padx(8 * tt + j)] = e[j];
    __syncthreads();
    fft_mid<8, true>(X, tt, T); __syncthreads();
    fft_mid<64, true>(X, tt, T); __syncthreads();
#pragma unroll
    for (int m = 0; m < 8; ++m) v[m] = X[padx(tt + 256 * m)];
    fft_p1_dit(v, tt, T);
}
__device__ __forceinline__ void fft_fwd_store(f32x2 (&v)[8], LAS f32x2* X, const LAS f32x2* T, f32x2* Kout, int tt) {
    fft_p1_dif(v, tt, T);
#pragma unroll
    for (int m = 0; m < 8; ++m) X[padx(tt + 256 * m)] = v[m];
    __syncthreads();
    fft_mid<64, false>(X, tt, T); __syncthreads();
    fft_mid<8, false>(X, tt, T); __syncthreads();
    f32x2 e[8];
#pragma unroll
    for (int j = 0; j < 8; ++j) e[j] = X[padx(8 * tt + j)];
    r8_dif<1>(e, 0, T);
#pragma unroll
    for (int j = 0; j < 8; ++j) Kout[8 * tt + j] = e[j];
    __syncthreads();
}
__device__ __forceinline__ int padx16(int i) { return i + (i >> 4); }
constexpr int XPAD16 = 2048 + 128;
template <int Q> __device__ __forceinline__ void r16_dif(f32x2 (&e)[16], int r, const LAS f32x2* T) {
    constexpr int S2 = 256 / Q;
#pragma unroll
    for (int j = 0; j < 8; ++j) { const f32x2 a = e[j], b = e[j + 8]; e[j] = a + b; e[j + 8] = cmul(a - b, T[S2 * (r + Q * j)]); }
#pragma unroll
    for (int jj = 0; jj < 8; ++jj) { const int j = (jj & 3) + 8 * (jj >> 2); const f32x2 a = e[j], b = e[j + 4]; e[j] = a + b; e[j + 4] = cmul(a - b, T[2 * S2 * (r + Q * (j & 3))]); }
#pragma unroll
    for (int jj = 0; jj < 8; ++jj) { const int j = (jj & 1) + 4 * (jj >> 1); const f32x2 a = e[j], b = e[j + 2]; e[j] = a + b; e[j + 2] = cmul(a - b, T[4 * S2 * (r + Q * (j & 1))]); }
    const f32x2 tw = T[8 * S2 * r];
#pragma unroll
    for (int j = 0; j < 16; j += 2) { const f32x2 a = e[j], b = e[j + 1]; e[j] = a + b; e[j + 1] = cmul(a - b, tw); }
}
template <int Q> __device__ __forceinline__ void r16_dit(f32x2 (&e)[16], int r, const LAS f32x2* T) {
    constexpr int S2 = 256 / Q;
    const f32x2 tw = T[8 * S2 * r];
#pragma unroll
    for (int j = 0; j < 16; j += 2) { const f32x2 a = e[j], b = cmulc(e[j + 1], tw); e[j] = a + b; e[j + 1] = a - b; }
#pragma unroll
    for (int jj = 0; jj < 8; ++jj) { const int j = (jj & 1) + 4 * (jj >> 1); const f32x2 a = e[j], b = cmulc(e[j + 2], T[4 * S2 * (r + Q * (j & 1))]); e[j] = a + b; e[j + 2] = a - b; }
#pragma unroll
    for (int jj = 0; jj < 8; ++jj) { const int j = (jj & 3) + 8 * (jj >> 2); const f32x2 a = e[j], b = cmulc(e[j + 4], T[2 * S2 * (r + Q * (j & 3))]); e[j] = a + b; e[j + 4] = a - b; }
#pragma unroll
    for (int j = 0; j < 8; ++j) { const f32x2 a = e[j], b = cmulc(e[j + 8], T[S2 * (r + Q * j)]); e[j] = a + b; e[j + 8] = a - b; }
}
__device__ __forceinline__ void fft_conv_half16(f32x2 (&v)[16], LAS f32x2* X, const LAS f32x2* T, const f32x2* K, int tt) {
    r16_dif<128>(v, tt, T);
#pragma unroll
    for (int m = 0; m < 16; ++m) X[padx16(tt + 128 * m)] = v[m];
    __syncthreads();
    const int r = tt & 7, base = (tt >> 3) * 128 + r;
#pragma unroll
    for (int j = 0; j < 16; ++j) v[j] = X[padx16(base + 8 * j)];
    r16_dif<8>(v, r, T);
#pragma unroll
    for (int j = 0; j < 16; ++j) X[padx16(base + 8 * j)] = v[j];
    f32x2 kv[16];
#pragma unroll
    for (int j = 0; j < 16; ++j) kv[j] = K[16 * tt + j];
    __syncthreads();
#pragma unroll
    for (int g = 0; g < 2; ++g) { f32x2 e[8];
#pragma unroll
        for (int j = 0; j < 8; ++j) e[j] = X[padx16(16 * tt + 8 * g + j)];
        r8_dif<1>(e, 0, T);
#pragma unroll
        for (int j = 0; j < 8; ++j) e[j] = cmul(e[j], kv[8 * g + j]);
        r8_dit<1>(e, 0, T);
#pragma unroll
        for (int j = 0; j < 8; ++j) X[padx16(16 * tt + 8 * g + j)] = e[j]; }
    __syncthreads();
#pragma unroll
    for (int j = 0; j < 16; ++j) v[j] = X[padx16(base + 8 * j)];
    r16_dit<8>(v, r, T);
#pragma unroll
    for (int j = 0; j < 16; ++j) X[padx16(base + 8 * j)] = v[j];
    __syncthreads();
#pragma unroll
    for (int m = 0; m < 16; ++m) v[m] = X[padx16(tt + 128 * m)];
    r16_dit<128>(v, tt, T);
}
__device__ __forceinline__ void fft_fwd_store16(f32x2 (&v)[16], LAS f32x2* X, const LAS f32x2* T, f32x2* Kout, int tt) {
    r16_dif<128>(v, tt, T);
#pragma unroll
    for (int m = 0; m < 16; ++m) X[padx16(tt + 128 * m)] = v[m];
    __syncthreads();
    const int r = tt & 7, base = (tt >> 3) * 128 + r;
#pragma unroll
    for (int j = 0; j < 16; ++j) v[j] = X[padx16(base + 8 * j)];
    r16_dif<8>(v, r, T);
#pragma unroll
    for (int j = 0; j < 16; ++j) X[padx16(base + 8 * j)] = v[j];
    __syncthreads();
#pragma unroll
    for (int g = 0; g < 2; ++g) { f32x2 e[8];
#pragma unroll
        for (int j = 0; j < 8; ++j) e[j] = X[padx16(16 * tt + 8 * g + j)];
        r8_dif<1>(e, 0, T);
#pragma unroll
        for (int j = 0; j < 8; ++j) Kout[16 * tt + 8 * g + j] = e[j]; }
    __syncthreads();
}
__device__ __forceinline__ void build_twiddles(const Ctx& C, LAS f32x2* T) {
    for (int k = C.tid; k < 2048; k += NTHR) { float s, c; sincospif((float)k * (1.0f / 2048.0f), &s, &c); T[k] = (f32x2){c, -s}; }
}

__device__ __forceinline__ void phase0(const Ctx& C) {
    LAS float* sil = (LAS float*)C.lds;
    LAS float* red = sil + 9 * 1024;
    LAS float* zs = red + 8 * 9 * 64;
    LAS float* h1s = zs + 8 * 40;
    const float* cin = C.in[IN_C]; const float* cctx = C.in[IN_CCTX];
    for (int i = C.tid; i < 9 * 1024; i += NTHR) { const int r = i >> 10, k = i & 1023; const float v = r < 8 ? cin[r * 1024 + k] : cctx[k]; sil[i] = v / (1.0f + expf(-v)); }
    __syncthreads();
    float* mods = WSP(float, WS_MODS);
    const float* wmod = C.in[IN_WMOD]; const float* bmod = C.in[IN_BMOD];
    for (int item = C.bid; item < 4 * 96; item += C.G) {
        const int l = item / 96, cb = item % 96, cc = C.tid & 63, kg = C.tid >> 6;
        const float* w = wmod + ((size_t)l * 1024 + kg * 128) * 6144 + cb * 64 + cc;
        const LAS float* sk = sil + kg * 128;
        float acc[9];
#pragma unroll
        for (int r = 0; r < 9; ++r) acc[r] = 0.f;
#pragma unroll 4
        for (int k = 0; k < 128; ++k) { const float wv = w[(size_t)k * 6144];
#pragma unroll
            for (int r = 0; r < 9; ++r) acc[r] += sk[r * 1024 + k] * wv; }
#pragma unroll
        for (int r = 0; r < 9; ++r) red[(kg * 9 + r) * 64 + cc] = acc[r];
        __syncthreads();
        for (int o = C.tid; o < 576; o += NTHR) { const int r = o >> 6, c2 = o & 63; float s = 0.f;
#pragma unroll
            for (int g = 0; g < 8; ++g) s += red[(g * 9 + r) * 64 + c2];
            mods[(size_t)(l * 9 + r) * 6144 + cb * 64 + c2] = s + bmod[l * 6144 + cb * 64 + c2]; }
        __syncthreads();
    }
    for (int item = C.bid; item < 4 * 288; item += C.G) {
        const int l = item / 288, r = item % 288, isctx = r >= 256;
        const int L = isctx ? 256 : 2048, t0 = (isctx ? r - 256 : r) * 8, tl = C.tid >> 6, j = C.tid & 63, t = t0 + tl;
        if (j < 33) { float z;
            if (j == 0) z = (float)t / (float)(L - 1);
            else { const int fi = (j - 1) & 15; const float freq = 1e-4f + (float)fi * ((15.0f - 1e-4f) / 15.0f);
                const float ang = ((float)(2.0 * 3.14159265358979323846 / L) * (float)t) * freq; z = (j <= 16) ? cosf(ang) : -sinf(ang); }
            zs[tl * 40 + j] = z; }
        __syncthreads();
        { const float* w1 = C.in[IN_W1] + (size_t)l * 33 * 64; float s = C.in[IN_B1][l * 64 + j];
            for (int i = 0; i < 33; ++i) s += zs[tl * 40 + i] * w1[i * 64 + j];
            h1s[tl * 64 + j] = sinf(s); }
        __syncthreads();
        { const float* w2 = C.in[IN_W2] + (size_t)l * 64 * 64; float s = C.in[IN_B2][l * 64 + j];
            for (int i = 0; i < 64; ++i) s += h1s[tl * 64 + i] * w2[i * 64 + j];
            bf16_t* dst = WSP(bf16_t, WS_HPAD) + ((size_t)l * 2304 + (isctx ? 2048 + t : t)) * 128;
            dst[j] = (bf16_t)f2bf(sinf(s)); dst[64 + j] = (bf16_t)0; }
        __syncthreads();
    }
    {
        const float* w3 = C.in[IN_W3]; bf16_t* w3t = WSP(bf16_t, WS_W3T);
        for (int i = C.bid * NTHR + C.tid; i < 4 * 64 * 2048; i += C.G * NTHR) { const int l = i >> 17, k = (i >> 11) & 63, col = i & 2047;
            w3t[((size_t)l * 2048 + col) * 128 + k] = (bf16_t)f2bf(w3[i]); w3t[((size_t)l * 2048 + col) * 128 + 64 + k] = (bf16_t)0; }
    }
    if (C.bid == C.G - 1) {
        const float* lb = C.in[IN_LB]; float* lower = WSP(float, WS_LOWER);
        for (int i = C.tid; i < 1024; i += NTHR) { const int d = i >> 9, c = i & 511; float v[4], mx = -3.4e38f, s = 0.f;
#pragma unroll
            for (int l = 0; l < 4; ++l) { v[l] = lb[(d * 4 + l) * 512 + c]; mx = fmaxf(mx, v[l]); }
#pragma unroll
            for (int l = 0; l < 4; ++l) { v[l] = expf(v[l] - mx); s += v[l]; }
            float cum = 0.f;
#pragma unroll
            for (int l = 0; l < 4; ++l) { if (l > 0) cum += v[l] / s; lower[(d * 4 + l) * 512 + c] = cum; } }
    }
}

__device__ __forceinline__ const float* xrow_src(const Ctx& C, int l, int row) {
    return l == 0 ? (row < NLAT ? C.in[IN_X] + (size_t)row * D : C.in[IN_CTX] + (size_t)(row - NLAT) * D) : WSP(const float, WS_XBUF) + (size_t)row * D;
}
__device__ __forceinline__ void transpose_item(const float* W, int K, int N, bf16_t* WT, LAS float* scr, int item, int lane) {
    const int nblk = N / 32, kb = item / nblk, nb = item % nblk, k0 = 64 * kb, n0 = 32 * nb;
    float wv[32];
#pragma unroll
    for (int i = 0; i < 32; ++i) wv[i] = W[(size_t)(k0 + 2 * i + (lane >> 5)) * N + n0 + (lane & 31)];
#pragma unroll
    for (int i = 0; i < 32; ++i) scr[(2 * i + (lane >> 5)) * 33 + (lane & 31)] = wv[i];
    LDS_WAIT(); asm volatile("" ::: "memory");
    const int c = lane & 7;
#pragma unroll
    for (int j = 0; j < 4; ++j) { const int n = (lane >> 3) + 8 * j; const LAS float* s = scr + (8 * c) * 33 + n;
        u32x4 o; o.x = pk2(s[0 * 33], s[1 * 33]); o.y = pk2(s[2 * 33], s[3 * 33]); o.z = pk2(s[4 * 33], s[5 * 33]); o.w = pk2(s[6 * 33], s[7 * 33]);
        *(u32x4*)(WT + (size_t)(n0 + n) * K + k0 + 8 * c) = o; }
    LDS_WAIT(); asm volatile("" ::: "memory");
}
__device__ __forceinline__ void phase_l1(const Ctx& C, int l) {
    const int gw = C.bid * NWAVES + C.wave, NGW = C.G * NWAVES;
    const float* mods = WSP(const float, WS_MODS) + (size_t)l * 9 * 6144;
    bf16_t* an = WSP(bf16_t, WS_R1);
    f32x4 nv[4];
    if (!(C.dry & 2)) {
    if (gw < NTOK) { const float* src = xrow_src(C, l, gw);
#pragma unroll
        for (int j = 0; j < 4; ++j) nv[j] = *(const f32x4*)(src + C.lane * 4 + 256 * j); }
    for (int row = gw; row < NTOK; row += NGW) {
        const float* md = mods + bidx(row) * 6144;
        f32x4 v[4]; float ss = 0.f;
#pragma unroll
        for (int j = 0; j < 4; ++j) v[j] = nv[j];
        if (row + NGW < NTOK) { const float* src = xrow_src(C, l, row + NGW);
#pragma unroll
            for (int j = 0; j < 4; ++j) nv[j] = *(const f32x4*)(src + C.lane * 4 + 256 * j); }
#pragma unroll
        for (int j = 0; j < 4; ++j) ss += (v[j].x * v[j].x + v[j].y * v[j].y) + (v[j].z * v[j].z + v[j].w * v[j].w);
        ss = wave_sum(ss); const float rinv = 1.0f / sqrtf(ss * (1.0f / D) + EPS);
#pragma unroll
        for (int j = 0; j < 4; ++j) { const int k = C.lane * 4 + 256 * j; const f32x4 sh = *(const f32x4*)(md + k), sc = *(const f32x4*)(md + 1024 + k);
            const f32x4 o = v[j] * rinv * (sc + 1.0f) + sh; u32x2 w; w.x = pk2(o.x, o.y); w.y = pk2(o.z, o.w);
            *(u32x2*)(an + (size_t)row * D + k) = w; }
    }
    }
    if (!(C.dry & 4)) {
        LAS float* scr = (LAS float*)(C.lds + C.wave * 16384);
        constexpr int I_IN = 16 * 128, I_OUT = 16 * 32, I_E = 128;
        constexpr int NIT = I_IN + I_OUT + 3 * 16 * I_E;
        for (int it = gw; it < NIT; it += NGW) {
            int r = it;
            if (r < I_IN) { transpose_item(C.in[IN_WIN] + (size_t)l * D * DIN, D, DIN, WSP(bf16_t, WS_WIN), scr, r, C.lane); continue; } r -= I_IN;
            if (r < I_OUT) { transpose_item(C.in[IN_WOUT] + (size_t)l * D * D, D, D, WSP(bf16_t, WS_WOUT), scr, r, C.lane); continue; } r -= I_OUT;
            if (r < 16 * I_E) { const int e = r / I_E; transpose_item(C.in[IN_WG] + ((size_t)l * NE + e) * D * DE, D, DE, WSP(bf16_t, WS_WG) + (size_t)e * DE * D, scr, r % I_E, C.lane); continue; } r -= 16 * I_E;
            if (r < 16 * I_E) { const int e = r / I_E; transpose_item(C.in[IN_WU] + ((size_t)l * NE + e) * D * DE, D, DE, WSP(bf16_t, WS_WU) + (size_t)e * DE * D, scr, r % I_E, C.lane); continue; } r -= 16 * I_E;
            { const int e = r / I_E; transpose_item(C.in[IN_WD] + ((size_t)l * NE + e) * DE * D, DE, D, WSP(bf16_t, WS_WD) + (size_t)e * D * DE, scr, r % I_E, C.lane); }
        }
    }
    __syncthreads();
    {
        LAS f32x2* T = (LAS f32x2*)C.lds;
        const int team = C.tid >> 7, tt = C.tid & 127;
        LAS f32x2* X = (LAS f32x2*)(C.lds + 16384) + team * XPAD16;
        LAS float* hbs = (LAS float*)(C.lds + 16384 + 4 * XPAD16 * 8) + team * 2048;
        LAS float* reds = (LAS float*)(C.lds + 16384 + 4 * XPAD16 * 8 + 32768);
        build_twiddles(C, T);
        __syncthreads();
        const bf16_t* hfl = WSP(const bf16_t, WS_HF) + (size_t)l * 2048 * 2304;
        f32x2* kspec = WSP(f32x2, WS_KSPEC);
        if (!(C.dry & 8))
        for (int item = C.bid; item < 256; item += C.G) {
            const int idx = item * 4 + team, o = idx >> 9, c = idx & 511;
            const int colf = o * 1024 + c, colb = colf + 512;
            const bf16_t* hfp = hfl + (size_t)colf * 2304; const bf16_t* hbp = hfl + (size_t)colb * 2304;
            float hf[16], hb[16], s = 0.f;
#pragma unroll
            for (int j = 0; j < 16; ++j) { const int t = tt + 128 * j; hf[j] = bf2f(hfp[t]); hb[j] = bf2f(hbp[t]); s += fabsf(hf[j]) + fabsf(hb[j]); }
            s = wave_sum(s);
            if (C.lane == 0) reds[C.wave] = s;
            __syncthreads();
            const float inv = 1.0f / ((reds[team * 2] + reds[team * 2 + 1]) * 4096.0f);
#pragma unroll
            for (int j = 0; j < 16; ++j) { hf[j] *= inv; hbs[tt + 128 * j] = hb[j] * inv; }
            __syncthreads();
            f32x2* kout = kspec + ((size_t)(o * 512 + c) * 2) * 2048;
            f32x2 vv[16];
#pragma unroll
            for (int j = 0; j < 16; ++j) { const int n = tt + 128 * j; const float kb = n > 0 ? hbs[2048 - n] : 0.f; vv[j] = (f32x2){hf[j] + kb, 0.f}; }
            fft_fwd_store16(vv, X, T, kout, tt);
#pragma unroll
            for (int j = 0; j < 16; ++j) { const int n = tt + 128 * j; const float kb = n > 0 ? hbs[2048 - n] : 0.f; const float dd = hf[j] - kb; const f32x2 tw = T[n]; vv[j] = (f32x2){dd * tw.x, dd * tw.y}; }
            fft_fwd_store16(vv, X, T, kout + 2048, tt);
        }
        if (l < DEPTH - 1 && !(C.dry & 16)) {
            f32x2* kspc = WSP(f32x2, WS_KSPC);
            for (int item = C.bid; item < 256; item += C.G) {
                const int idx = item * 4 + team, o = idx >> 9, c = idx & 511;
                const int colf = o * 1024 + c, colb = colf + 512;
                float af0 = bf2f(hfl[(size_t)colf * 2304 + 2048 + tt]), af1 = bf2f(hfl[(size_t)colf * 2304 + 2048 + 128 + tt]);
                float ab0 = bf2f(hfl[(size_t)colb * 2304 + 2048 + tt]), ab1 = bf2f(hfl[(size_t)colb * 2304 + 2048 + 128 + tt]);
                __syncthreads();
                const float s = wave_sum((fabsf(af0) + fabsf(af1)) + (fabsf(ab0) + fabsf(ab1)));
                if (C.lane == 0) reds[C.wave] = s;
                __syncthreads();
                const float inv = 1.0f / ((reds[team * 2] + reds[team * 2 + 1]) * 2048.0f);
                af0 *= inv; af1 *= inv; hbs[tt] = ab0 * inv; hbs[128 + tt] = ab1 * inv;
                __syncthreads();
                f32x2 vk[16];
#pragma unroll
                for (int j = 0; j < 16; ++j) vk[j] = (f32x2){0.f, 0.f};
                vk[0] = (f32x2){af0, 0.f}; vk[1] = (f32x2){af1, 0.f};
                vk[14] = (f32x2){tt > 0 ? hbs[256 - tt] : 0.f, 0.f};
                vk[15] = (f32x2){hbs[128 - tt], 0.f};
                fft_fwd_store16(vk, X, T, kspc + (size_t)(o * 512 + c) * 2048, tt);
            }
        }
    }
}

__device__ __forceinline__ float shortconv(const LAS bf16_t* raw, int t, int mask, int tmax, float w0, float w1, float w2, float bias) {
    const float pm = ((t & mask) != 0) ? bf2f(raw[t - 1]) : 0.f;
    const float pc = bf2f(raw[t]);
    const float pp = ((t & mask) != mask && t < tmax) ? bf2f(raw[t + 1]) : 0.f;
    return w0 * pm + w1 * pc + w2 * pp + bias;
}
constexpr int HY_CH = 4, HY_ITEMS = 4 * (512 / HY_CH), HYC_ITEMS = 512 / 4;
__device__ __forceinline__ void hyena_lat(const Ctx& C, int l, int item) {
    const int bp = item & 3, cg = item >> 2, team = C.tid >> 7, tt = C.tid & 127;
    LAS f32x2* T = (LAS f32x2*)C.lds;
    LAS f32x2* X = (LAS f32x2*)(C.lds + 16384) + team * XPAD16;
    LAS bf16_t* raw = (LAS bf16_t*)(C.lds + 16384 + 4 * XPAD16 * 8) + team * 4096;
    const bf16_t* phyt = WSP(const bf16_t, WS_PHYT);
    const float* cw = C.in[IN_CONVW] + (size_t)l * 3 * NHY; const float* cb = C.in[IN_CONVB] + (size_t)l * NHY;
    const float* hyb = C.in[IN_HYBIAS] + (size_t)l * 2 * DH;
    const f32x2* kspec = WSP(const f32x2, WS_KSPEC);
    const int ba = 2 * bp, c = cg * 4 + team;
    f32x2 z[16], acc[16], v[16];
#pragma unroll 1
    for (int stage = 0; stage < 3; ++stage) {
        const int ch = stage * 512 + c;
        __syncthreads();
#pragma unroll
        for (int k = 0; k < 4; ++k) { const int q = tt + 128 * k, rr = q >> 8, cc = q & 255;
            *(LAS u32x4*)(raw + rr * 2048 + cc * 8) = *(const u32x4*)(phyt + (size_t)ch * NTOK + (size_t)(ba + rr) * 2048 + cc * 8); }
        __syncthreads();
        const float w0 = cw[ch], w1 = cw[NHY + ch], w2 = cw[2 * NHY + ch], bs = cb[ch];
        if (stage == 0) {
#pragma unroll
            for (int j = 0; j < 16; ++j) { const int t = tt + 128 * j; z[j] = (f32x2){shortconv(raw, t, 63, 4096, w0, w1, w2, bs), shortconv(raw + 2048, t, 63, 4096, w0, w1, w2, bs)}; }
        } else {
            const float dsk = hyb[(stage - 1) * DH + c];
#pragma unroll
            for (int j = 0; j < 16; ++j) { const int t = tt + 128 * j; const f32x2 cv = acc[j] + z[j] * dsk;
                z[j] = (f32x2){shortconv(raw, t, 63, 4096, w0, w1, w2, bs) * cv.x, shortconv(raw + 2048, t, 63, 4096, w0, w1, w2, bs) * cv.y}; }
        }
        if (stage == 2) {
            LAS bf16_t* ob = (LAS bf16_t*)X;
#pragma unroll
            for (int j = 0; j < 16; ++j) { const int t = tt + 128 * j; ob[t] = (bf16_t)f2bf(z[j].x); ob[2048 + t] = (bf16_t)f2bf(z[j].y); }
            break;
        }
        const f32x2* K = kspec + ((size_t)(stage * 512 + c) * 2) * 2048;
#pragma unroll
        for (int j = 0; j < 16; ++j) v[j] = z[j];
        fft_conv_half16(v, X, T, K, tt);
#pragma unroll
        for (int j = 0; j < 16; ++j) acc[j] = v[j];
#pragma unroll
        for (int j = 0; j < 16; ++j) v[j] = cmul(z[j], T[tt + 128 * j]);
        fft_conv_half16(v, X, T, K + 2048, tt);
#pragma unroll
        for (int j = 0; j < 16; ++j) acc[j] += cmulc(v[j], T[tt + 128 * j]);
    }
    __syncthreads();
    bf16_t* Y = WSP(bf16_t, WS_R1);
    for (int i = C.tid; i < 4096; i += NTHR) { const int b = i >> 11, t = i & 2047;
        const LAS bf16_t* o0 = (const LAS bf16_t*)((LAS f32x2*)(C.lds + 16384)) + i;
        u32x2 w; w.x = (unsigned)o0[0] | ((unsigned)o0[XPAD16 * 4] << 16); w.y = (unsigned)o0[2 * XPAD16 * 4] | ((unsigned)o0[3 * XPAD16 * 4] << 16);
        *(u32x2*)(Y + ((size_t)(ba + b) * 2048 + t) * D + cg * 4) = w; }
    __syncthreads();
}
__device__ __forceinline__ void hyena_ctx2(const Ctx& C, int l, int item) {
    const int team = C.tid >> 7, tt = C.tid & 127, c = item * 4 + team;
    LAS f32x2* T = (LAS f32x2*)C.lds;
    LAS f32x2* X = (LAS f32x2*)(C.lds + 16384) + team * XPAD16;
    LAS bf16_t* raw = (LAS bf16_t*)(C.lds + 16384 + 4 * XPAD16 * 8) + team * 4096;
    const bf16_t* phyt = WSP(const bf16_t, WS_PHYT);
    const float* cw = C.in[IN_CONVW] + (size_t)l * 3 * NHY; const float* cb = C.in[IN_CONVB] + (size_t)l * NHY;
    const float* hyb = C.in[IN_HYBIAS] + (size_t)l * 2 * DH;
    const f32x2* kspc = WSP(const f32x2, WS_KSPC);
    bf16_t* Y = WSP(bf16_t, WS_R1);
    f32x2 z[16], v[16];
#pragma unroll
    for (int j = 0; j < 16; ++j) { z[j] = (f32x2){0.f, 0.f}; v[j] = (f32x2){0.f, 0.f}; }
#pragma unroll 1
    for (int stage = 0; stage < 3; ++stage) {
        const int ch = stage * 512 + c;
        __syncthreads();
#pragma unroll
        for (int k = 0; k < 2; ++k) { const int q = tt + 128 * k; *(LAS u32x4*)(raw + q * 8) = *(const u32x4*)(phyt + (size_t)ch * NTOK + NLAT + q * 8); }
        __syncthreads();
        const float w0 = cw[ch], w1 = cw[NHY + ch], w2 = cw[2 * NHY + ch], bs = cb[ch];
        const float dsk = stage > 0 ? hyb[(stage - 1) * DH + c] : 0.f;
#pragma unroll
        for (int p = 0; p < 4; ++p)
#pragma unroll
            for (int hh = 0; hh < 2; ++hh) { const int m = 4 * p + hh, tok = hh * 128 + tt;
                const float ua = shortconv(raw, (2 * p) * 256 + tok, 255, 4096, w0, w1, w2, bs), ub = shortconv(raw, (2 * p + 1) * 256 + tok, 255, 4096, w0, w1, w2, bs);
                if (stage == 0) z[m] = (f32x2){ua, ub};
                else { const f32x2 cv = v[m] + z[m] * dsk; z[m] = (f32x2){ua * cv.x, ub * cv.y}; } }
        if (stage == 2) {
#pragma unroll
            for (int p = 0; p < 4; ++p)
#pragma unroll
                for (int hh = 0; hh < 2; ++hh) { const int m = 4 * p + hh, tok = hh * 128 + tt;
                    Y[(size_t)(NLAT + (2 * p) * 256 + tok) * D + c] = (bf16_t)f2bf(z[m].x); Y[(size_t)(NLAT + (2 * p + 1) * 256 + tok) * D + c] = (bf16_t)f2bf(z[m].y); }
            break;
        }
#pragma unroll
        for (int j = 0; j < 16; ++j) v[j] = z[j];
        fft_conv_half16(v, X, T, kspc + (size_t)(stage * 512 + c) * 2048, tt);
    }
}

constexpr int HG_QT = 0, HG_QP = 17408, HG_KP = 34816, HG_ST = 52224, HG_VT = 87040, HG_KH = 105472, HG_P = 123904, HG_SUB = 133120, HG_D = 135168;
__device__ __forceinline__ void hgrn_mfma(const Ctx& C, int item) {
    const int dir = item & 1, h = (item >> 1) & 3, b = item >> 3;
    LAS unsigned char* L = C.lds;
    const int lane = C.lane, w = C.wave, r = lane & 15, quad = lane >> 4;
    const int I = w >> 1, col = (w & 1) * 64 + lane;
    const bf16_t* phg = WSP(const bf16_t, WS_PHG);
    bf16_t* odir = WSP(bf16_t, WS_ODIR) + (size_t)dir * NTOK * 512;
    LAS float* subtot = (LAS float*)(L + HG_SUB); LAS float* Dv = (LAS float*)(L + HG_D);
    __syncthreads();
    unsigned z0_ = 0u; asm volatile("" : "+v"(z0_));
    const u32x4 zv_ = (u32x4){z0_, z0_, z0_, z0_}; const float zff_ = __builtin_bit_cast(float, z0_); const f32x4 zv4f_ = (f32x4){zff_, zff_, zff_, zff_};
    for (int i = C.tid; i < (128 * 272) / 16; i += NTHR) *(LAS u32x4*)(L + HG_ST + i * 16) = zv_;
    for (int i = C.tid; i < (64 * 144) / 16; i += NTHR) *(LAS u32x4*)(L + HG_P + i * 16) = zv_;
    f32x4 sacc[8];
#pragma unroll
    for (int t = 0; t < 8; ++t) sacc[t] = zv4f_;
    unsigned short qr[16], kr[16], vr[16];
    const int rstep = dir ? -1 : 1;
    const size_t colq = (size_t)h * 128 + col, colk = 1536 + (size_t)dir * 512 + h * 128 + col, colv = 512 + (size_t)h * 128 + col;
    auto chunk_row0 = [&](int ch) -> int { return ch < 4 ? NLAT + b * 256 + (dir ? 255 - ch * 64 : ch * 64) : b * 2048 + (dir ? 2047 - (ch - 4) * 64 : (ch - 4) * 64); };
    { const int row0 = chunk_row0(0) + rstep * 16 * I;
#pragma unroll
      for (int i = 0; i < 16; ++i) { const bf16_t* p = phg + (size_t)(row0 + rstep * i) * NHG; qr[i] = p[colq]; kr[i] = p[colk]; vr[i] = p[colv]; } }
    __syncthreads();
#pragma unroll 1
    for (int ch = 0; ch < 36; ++ch) {
        float cum[16]; float cs = 0.f;
#pragma unroll
        for (int i = 0; i < 16; ++i) { cs += __logf(1.0f - bf2f(kr[i])); cum[i] = cs; }
        subtot[I * 128 + col] = cs;
        __syncthreads();
        const float s0 = subtot[col], s1 = subtot[128 + col], s2 = subtot[256 + col], s3 = subtot[384 + col];
        const float pre = (I > 0 ? s0 : 0.f) + (I > 1 ? s1 : 0.f) + (I > 2 ? s2 : 0.f), rho = s0 + s1, tot = (s0 + s1) + (s2 + s3);
        const float erho = __expf(rho), eend = __expf(tot - rho);
        unsigned khp[8], vtp[8];
#pragma unroll
        for (int i = 0; i < 16; ++i) {
            const float bi = pre + cum[i], e1 = __expf(bi - rho), e2 = __expf(rho - bi), qf = bf2f(qr[i]), kf = bf2f(kr[i]);
            const int srow = (16 * I + i) * 272 + col * 2;
            *(LAS bf16_t*)(L + HG_QP + srow) = (bf16_t)f2bf(qf * e1);
            *(LAS bf16_t*)(L + HG_QT + srow) = (bf16_t)f2bf(qf * e1 * erho);
            *(LAS bf16_t*)(L + HG_KP + srow) = (bf16_t)f2bf(kf * e2);
            const unsigned khb = f2bf(kf * e2 * eend);
            if (i & 1) { khp[i >> 1] |= khb << 16; vtp[i >> 1] |= (unsigned)vr[i] << 16; } else { khp[i >> 1] = khb; vtp[i >> 1] = (unsigned)vr[i]; }
        }
        *(LAS u32x4*)(L + HG_KH + col * 144 + I * 32) = (u32x4){khp[0], khp[1], khp[2], khp[3]};
        *(LAS u32x4*)(L + HG_KH + col * 144 + I * 32 + 16) = (u32x4){khp[4], khp[5], khp[6], khp[7]};
        *(LAS u32x4*)(L + HG_VT + col * 144 + I * 32) = (u32x4){vtp[0], vtp[1], vtp[2], vtp[3]};
        *(LAS u32x4*)(L + HG_VT + col * 144 + I * 32 + 16) = (u32x4){vtp[4], vtp[5], vtp[6], vtp[7]};
        if (I == 0) Dv[col] = __expf(tot);
        const int crow0 = chunk_row0(ch);
        if (ch + 1 < 36) { const int row0 = chunk_row0(ch + 1) + rstep * 16 * I;
#pragma unroll
            for (int i = 0; i < 16; ++i) { const bf16_t* p = phg + (size_t)(row0 + rstep * i) * NHG; qr[i] = p[colq]; kr[i] = p[colk]; vr[i] = p[colv]; } }
        __syncthreads();
#pragma unroll 1
        for (int blk = w; blk < 10; blk += 8) {
            const int I2 = blk < 1 ? 0 : (blk < 3 ? 1 : (blk < 6 ? 2 : 3)), J2 = blk - (I2 * (I2 + 1)) / 2;
            f32x4 pa = zv4f_;
#pragma unroll
            for (int kk = 0; kk < 4; ++kk) {
                const bf16x8 a = *(const LAS bf16x8*)(L + HG_KP + (J2 * 16 + r) * 272 + (32 * kk + 8 * quad) * 2);
                const bf16x8 bq = *(const LAS bf16x8*)(L + HG_QP + (I2 * 16 + r) * 272 + (32 * kk + 8 * quad) * 2);
                pa = __builtin_amdgcn_mfma_f32_16x16x32_bf16(a, bq, pa, 0, 0, 0);
            }
            if (I2 == J2) {
#pragma unroll
                for (int rr = 0; rr < 4; ++rr) if (4 * quad + rr > r) pa[rr] = 0.f;
            }
            u32x2 pw; pw.x = pk2(pa[0], pa[1]); pw.y = pk2(pa[2], pa[3]);
            *(LAS u32x2*)(L + HG_P + (I2 * 16 + r) * 144 + (J2 * 16 + 4 * quad) * 2) = pw;
        }
        __syncthreads();
        {
            bf16x8 sfr[4];
#pragma unroll
            for (int kk = 0; kk < 4; ++kk) sfr[kk] = *(const LAS bf16x8*)(L + HG_ST + (16 * w + r) * 272 + (32 * kk + 8 * quad) * 2);
            const bf16x8 vf0 = *(const LAS bf16x8*)(L + HG_VT + (16 * w + r) * 144 + (8 * quad) * 2);
            const bf16x8 vf1 = *(const LAS bf16x8*)(L + HG_VT + (16 * w + r) * 144 + (32 + 8 * quad) * 2);
#pragma unroll
            for (int I3 = 0; I3 < 4; ++I3) {
                f32x4 oa = zv4f_;
#pragma unroll
                for (int kk = 0; kk < 4; ++kk) {
                    const bf16x8 bq = *(const LAS bf16x8*)(L + HG_QT + (I3 * 16 + r) * 272 + (32 * kk + 8 * quad) * 2);
                    oa = __builtin_amdgcn_mfma_f32_16x16x32_bf16(sfr[kk], bq, oa, 0, 0, 0);
                }
                { const bf16x8 bp = *(const LAS bf16x8*)(L + HG_P + (I3 * 16 + r) * 144 + (8 * quad) * 2);
                  oa = __builtin_amdgcn_mfma_f32_16x16x32_bf16(vf0, bp, oa, 0, 0, 0); }
                if (I3 >= 2) { const bf16x8 bp = *(const LAS bf16x8*)(L + HG_P + (I3 * 16 + r) * 144 + (32 + 8 * quad) * 2);
                  oa = __builtin_amdgcn_mfma_f32_16x16x32_bf16(vf1, bp, oa, 0, 0, 0); }
                const int row = crow0 + rstep * (16 * I3 + r);
                u32x2 ow; ow.x = pk2(oa[0], oa[1]); ow.y = pk2(oa[2], oa[3]);
                *(u32x2*)(odir + (size_t)row * 512 + h * 128 + 16 * w + 4 * quad) = ow;
            }
#pragma unroll
            for (int t = 0; t < 8; ++t) {
                const f32x4 dd = *(const LAS f32x4*)(L + HG_D + (16 * t + 4 * quad) * 4);
                f32x4 sa = sacc[t] * dd;
                const bf16x8 a0 = *(const LAS bf16x8*)(L + HG_KH + (16 * t + r) * 144 + (8 * quad) * 2);
                const bf16x8 a1 = *(const LAS bf16x8*)(L + HG_KH + (16 * t + r) * 144 + (32 + 8 * quad) * 2);
                sa = __builtin_amdgcn_mfma_f32_16x16x32_bf16(a0, vf0, sa, 0, 0, 0);
                sa = __builtin_amdgcn_mfma_f32_16x16x32_bf16(a1, vf1, sa, 0, 0, 0);
                sacc[t] = sa;
                u32x2 sw; sw.x = pk2(sa[0], sa[1]); sw.y = pk2(sa[2], sa[3]);
                *(LAS u32x2*)(L + HG_ST + (16 * w + r) * 272 + (16 * t + 4 * quad) * 2) = sw;
            }
        }
    }
    __syncthreads();
}
__device__ __forceinline__ void phase_l3(const Ctx& C, int l) {
    if (C.bid < 64) hgrn_mfma(C, C.bid);
    build_twiddles(C, (LAS f32x2*)C.lds);
    __syncthreads();
    unsigned* qh = WSP(unsigned, WS_CTL) + CW_Q + l * 64 + C.rep * 16;
    volatile LAS int* lc = (volatile LAS int*)(C.lds + LDSCTL_OFF);
    const int nitems = HY_ITEMS + (l < DEPTH - 1 ? HYC_ITEMS : 0);
    for (;;) {
        if (C.tid == 0) lc[LC_Q] = (int)__hip_atomic_fetch_add(qh, 1u, __ATOMIC_RELAXED, __HIP_MEMORY_SCOPE_AGENT);
        __syncthreads();
        const int item = lc[LC_Q];
        __syncthreads();
        if (item >= nitems) break;
        Ctx CI = C; { int t_ = C.tid; asm volatile("" : "+v"(t_)); CI.tid = t_; CI.lane = t_ & 63; }
        if (item < HY_ITEMS) hyena_lat(CI, l, item); else hyena_ctx2(CI, l, item - HY_ITEMS);
    }
}
__device__ __forceinline__ void phase_l3b(const Ctx& C, int l) {
    const int gw = C.bid * NWAVES + C.wave, NGW = C.G * NWAVES;
    const bf16_t* od0 = WSP(const bf16_t, WS_ODIR); const bf16_t* od1 = od0 + (size_t)NTOK * 512;
    const bf16_t* phg = WSP(const bf16_t, WS_PHG); bf16_t* Y = WSP(bf16_t, WS_R1);
    const float* nw = C.in[IN_NORMW] + l * 128;
    const int nrows = (l < DEPTH - 1) ? NTOK : NLAT;
    for (int row = gw; row < nrows; row += NGW) {
        const int idx = C.lane * 8;
        const u32x4 a = *(const u32x4*)(od0 + (size_t)row * 512 + idx), b = *(const u32x4*)(od1 + (size_t)row * 512 + idx), g = *(const u32x4*)(phg + (size_t)row * NHG + 1024 + idx);
        float o[8] = {bflo(a.x) + bflo(b.x), bfhi(a.x) + bfhi(b.x), bflo(a.y) + bflo(b.y), bfhi(a.y) + bfhi(b.y), bflo(a.z) + bflo(b.z), bfhi(a.z) + bfhi(b.z), bflo(a.w) + bflo(b.w), bfhi(a.w) + bfhi(b.w)};
        const float gg[8] = {bflo(g.x), bfhi(g.x), bflo(g.y), bfhi(g.y), bflo(g.z), bfhi(g.z), bflo(g.w), bfhi(g.w)};
        float ss = 0.f;
#pragma unroll
        for (int i = 0; i < 8; ++i) ss += o[i] * o[i];
        ss = row16_sum(ss);
        const float rinv = 1.0f / sqrtf(ss * (1.0f / 128.0f) + EPS);
        float y[8];
#pragma unroll
        for (int i = 0; i < 8; ++i) y[i] = o[i] * rinv * nw[(idx + i) & 127] * siluf_(gg[i]);
        u32x4 w; w.x = pk2(y[0], y[1]); w.y = pk2(y[2], y[3]); w.z = pk2(y[4], y[5]); w.w = pk2(y[6], y[7]);
        *(u32x4*)(Y + (size_t)row * D + 512 + idx) = w;
    }
}

constexpr int RW_PITCH = 1028;
__device__ __forceinline__ void phase_l5a(const Ctx& C, int l) {
    LAS float* rwT = (LAS float*)C.lds;
    LAS int* lcnt = (LAS int*)(C.lds + 16 * RW_PITCH * 4);
    LAS float* wsc = (LAS float*)(C.lds + 16 * RW_PITCH * 4 + 128) + C.wave * 384;
    const float* rw = C.in[IN_RW];
    for (int i = C.tid; i < 16 * 1024; i += NTHR) { const int k = i >> 4, e = i & 15; rwT[e * RW_PITCH + k] = rw[i]; }
    if (C.tid < 32) lcnt[C.tid] = 0;
    __syncthreads();
    const int gw = C.bid * NWAVES + C.wave, NGW = C.G * NWAVES;
    const float* mods = WSP(const float, WS_MODS) + (size_t)l * 9 * 6144;
    const float* bias2 = WSP(const float, WS_BIAS2) + l * 9 * 16;
    const float* xb = WSP(const float, WS_XBUF);
    const float* rbias = C.in[IN_RB];
    unsigned* cnt = WSP(unsigned, WS_CTL) + CW_CNT + l * 32 * 64;
    int* tokinfo = WSP(int, WS_TOKINFO);
    const int ngroups = ((l < DEPTH - 1) ? NTOK : NLAT) / 16;
    const int li = C.lane & 15, kq = C.lane >> 4;
    for (int g = gw; g < ngroups; g += NGW) {
        const int row0 = g * 16, bb = bidx(row0);
        const float* xp = xb + (size_t)(row0 + li) * D + kq * 4;
        const float* scp = mods + bb * 6144 + 4096 + kq * 4;
        const LAS float* bp = rwT + li * RW_PITCH + kq * 4;
        f32x4 acc0 = (f32x4){0.f, 0.f, 0.f, 0.f}, acc1 = acc0, acc2 = acc0, acc3 = acc0; float ss = 0.f;
#pragma unroll 8
        for (int m = 0; m < 64; ++m) {
            const f32x4 xv = *(const f32x4*)(xp + 16 * m), sc = *(const f32x4*)(scp + 16 * m), bv = *(const LAS f32x4*)(bp + 16 * m);
            ss += (xv.x * xv.x + xv.y * xv.y) + (xv.z * xv.z + xv.w * xv.w);
            const f32x4 av = xv * (sc + 1.0f);
            acc0 = __builtin_amdgcn_mfma_f32_16x16x4f32(av.x, bv.x, acc0, 0, 0, 0);
            acc1 = __builtin_amdgcn_mfma_f32_16x16x4f32(av.y, bv.y, acc1, 0, 0, 0);
            acc2 = __builtin_amdgcn_mfma_f32_16x16x4f32(av.z, bv.z, acc2, 0, 0, 0);
            acc3 = __builtin_amdgcn_mfma_f32_16x16x4f32(av.w, bv.w, acc3, 0, 0, 0);
        }
        const f32x4 acc = (acc0 + acc1) + (acc2 + acc3);
        wsc[C.lane] = ss;
#pragma unroll
        for (int r = 0; r < 4; ++r) wsc[64 + (4 * kq + r) * 17 + li] = acc[r];
        LDS_WAIT(); asm volatile("" ::: "memory");
        if (C.lane < 16) {
            const int row = row0 + C.lane;
            const float sst = (wsc[C.lane] + wsc[16 + C.lane]) + (wsc[32 + C.lane] + wsc[48 + C.lane]);
            const float rinv = 1.0f / sqrtf(sst * (1.0f / D) + EPS);
            float lg[16];
#pragma unroll
            for (int e = 0; e < 16; ++e) lg[e] = rinv * wsc[64 + C.lane * 17 + e] + bias2[bb * 16 + e];
            float mx = lg[0];
#pragma unroll
            for (int e = 1; e < 16; ++e) mx = fmaxf(mx, lg[e]);
            float sc[16], se = 0.f;
#pragma unroll
            for (int e = 0; e < 16; ++e) { sc[e] = expf(lg[e] - mx); se += sc[e]; }
            float sel[16];
#pragma unroll
            for (int e = 0; e < 16; ++e) { sc[e] = sc[e] / se; sel[e] = sc[e] + rbias[e]; }
            float bestgs = -3.4e38f; int bg = 0; float bs[4], bsc[4];
#pragma unroll
            for (int gg = 0; gg < 4; ++gg) {
                float m1 = -3.4e38f, m2 = -3.4e38f;
#pragma unroll
                for (int i = 0; i < 4; ++i) { const float x = sel[4 * gg + i]; if (x > m1) { m2 = m1; m1 = x; } else if (x > m2) m2 = x; }
                const float gs = m1 + m2;
                if (gs > bestgs) { bestgs = gs; bg = gg;
#pragma unroll
                    for (int i = 0; i < 4; ++i) { bs[i] = sel[4 * gg + i]; bsc[i] = sc[4 * gg + i]; } }
            }
            int i0 = 0; float b0 = bs[0];
#pragma unroll
            for (int i = 1; i < 4; ++i) if (bs[i] > b0) { b0 = bs[i]; i0 = i; }
            int i1 = -1; float b1 = -3.4e38f;
#pragma unroll
            for (int i = 0; i < 4; ++i) if (i != i0 && bs[i] > b1) { b1 = bs[i]; i1 = i; }
            float w0 = 0.f, w1 = 0.f;
#pragma unroll
            for (int i = 0; i < 4; ++i) { if (i == i0) w0 = bsc[i]; if (i == i1) w1 = bsc[i]; }
            const float wn = w0 + w1; w0 /= wn; w1 /= wn;
            const int lo = i0 < i1 ? i0 : i1, hi = i0 < i1 ? i1 : i0;
            const float wlo = i0 < i1 ? w0 : w1, whi = i0 < i1 ? w1 : w0;
            const int bin = bg * 6 + (lo * (7 - lo)) / 2 + (hi - lo - 1);
            const int slot = __hip_atomic_fetch_add(lcnt + bin, 1, __ATOMIC_RELAXED, __HIP_MEMORY_SCOPE_WORKGROUP);
            *(int4*)(tokinfo + (size_t)row * 4) = make_int4(bin, slot, __float_as_int(wlo), __float_as_int(whi));
        }
        LDS_WAIT(); asm volatile("" ::: "memory");
    }
    __syncthreads();
    if (C.tid < NBIN && !C.dry) { const int n = lcnt[C.tid];
        WSP(int, WS_BLKBASE)[C.bid * 32 + C.tid] = n > 0 ? (int)__hip_atomic_fetch_add(cnt + C.tid * 64, (unsigned)n, __ATOMIC_RELAXED, __HIP_MEMORY_SCOPE_AGENT) : 0; }
}
__device__ __forceinline__ void phase_l5b(const Ctx& C, int l) {
    build_tiletab(C, l);
    const volatile LAS int* lc = (const volatile LAS int*)(C.lds + LDSCTL_OFF);
    const int gw = C.bid * NWAVES + C.wave, NGW = C.G * NWAVES;
    const float* mods = WSP(const float, WS_MODS) + (size_t)l * 9 * 6144;
    const float* xb = WSP(const float, WS_XBUF);
    const int* tokinfo = WSP(const int, WS_TOKINFO); const int* blkbase = WSP(const int, WS_BLKBASE);
    bf16_t* hs = WSP(bf16_t, WS_PHG); int* rowtok = WSP(int, WS_ROWTOK); float* roww = WSP(float, WS_ROWW);
    const int nrows = (l < DEPTH - 1) ? NTOK : NLAT;
    f32x4 nv[4]; int4 nti = make_int4(0, 0, 0, 0);
    if (gw < nrows) { nti = *(const int4*)(tokinfo + (size_t)gw * 4);
#pragma unroll
        for (int j = 0; j < 4; ++j) nv[j] = *(const f32x4*)(xb + (size_t)gw * D + C.lane * 4 + 256 * j); }
    for (int row = gw; row < nrows; row += NGW) {
        const int4 ti = nti;
        const int pos = lc[LC_OFFS + ti.x] + blkbase[(((row >> 4) % NGW) >> 3) * 32 + ti.x] + ti.y;
        const float* md = mods + bidx(row) * 6144;
        f32x4 v[4]; float ss = 0.f;
#pragma unroll
        for (int j = 0; j < 4; ++j) v[j] = nv[j];
        if (row + NGW < nrows) { nti = *(const int4*)(tokinfo + (size_t)(row + NGW) * 4);
#pragma unroll
            for (int j = 0; j < 4; ++j) nv[j] = *(const f32x4*)(xb + (size_t)(row + NGW) * D + C.lane * 4 + 256 * j); }
#pragma unroll
        for (int j = 0; j < 4; ++j) ss += (v[j].x * v[j].x + v[j].y * v[j].y) + (v[j].z * v[j].z + v[j].w * v[j].w);
        ss = wave_sum(ss); const float rinv = 1.0f / sqrtf(ss * (1.0f / D) + EPS);
#pragma unroll
        for (int j = 0; j < 4; ++j) { const int k = C.lane * 4 + 256 * j; const f32x4 sh = *(const f32x4*)(md + 3072 + k), sc = *(const f32x4*)(md + 4096 + k);
            const f32x4 o = v[j] * rinv * (sc + 1.0f) + sh; u32x2 w; w.x = pk2(o.x, o.y); w.y = pk2(o.z, o.w);
            *(u32x2*)(hs + (size_t)pos * D + k) = w; }
        if (C.lane == 0) { rowtok[pos] = row; roww[pos * 2] = __int_as_float(ti.z); roww[pos * 2 + 1] = __int_as_float(ti.w); }
    }
    if (C.bid < NBIN) { const int b = C.bid; const int start = lc[LC_OFFS + b], end = lc[LC_OFFS + b + 1];
        const int n = (int)__hip_atomic_load(WSP(unsigned, WS_CTL) + CW_CNT + (l * 32 + b) * 64, __ATOMIC_RELAXED, __HIP_MEMORY_SCOPE_AGENT);
        float zf_ = 0.f; asm volatile("" : "+v"(zf_));
        for (int p = start + n + C.tid; p < end; p += NTHR) { rowtok[p] = -1; roww[p * 2] = zf_; roww[p * 2 + 1] = zf_; } }
}

__device__ __forceinline__ void phase_final(const Ctx& C) {
    const int gw = C.bid * NWAVES + C.wave, NGW = C.G * NWAVES;
    const float* xb = WSP(const float, WS_XBUF); const float* fw = C.in[IN_FNW];
    f32x4 nv[4];
    if (gw < NLAT) {
#pragma unroll
        for (int j = 0; j < 4; ++j) nv[j] = *(const f32x4*)(xb + (size_t)gw * D + C.lane * 4 + 256 * j); }
    for (int row = gw; row < NLAT; row += NGW) {
        f32x4 v[4]; float ss = 0.f;
#pragma unroll
        for (int j = 0; j < 4; ++j) v[j] = nv[j];
        if (row + NGW < NLAT) {
#pragma unroll
            for (int j = 0; j < 4; ++j) nv[j] = *(const f32x4*)(xb + (size_t)(row + NGW) * D + C.lane * 4 + 256 * j); }
#pragma unroll
        for (int j = 0; j < 4; ++j) ss += (v[j].x * v[j].x + v[j].y * v[j].y) + (v[j].z * v[j].z + v[j].w * v[j].w);
        ss = wave_sum(ss); const float rinv = 1.0f / sqrtf(ss * (1.0f / D) + EPS);
#pragma unroll
        for (int j = 0; j < 4; ++j) { const int k = C.lane * 4 + 256 * j; const f32x4 w = *(const f32x4*)(fw + k);
            *(f32x4*)(C.out + (size_t)row * D + k) = v[j] * rinv * w; }
    }
}

constexpr int PH_PER_LAYER = 8, N_PHASES = 2 + DEPTH * PH_PER_LAYER + 1;
__global__ void __launch_bounds__(NTHR, 2) trunk_fwd(Args args) {
    extern __shared__ __attribute__((aligned(16))) unsigned char lds[];
    Ctx C; C.in = (const CAS fptr_t*)__builtin_amdgcn_kernarg_segment_ptr(); C.out = args.out; C.ws = args.ws; C.lds = (LAS unsigned char*)lds;
    C.tid = threadIdx.x; C.lane = C.tid & 63; C.wave = __builtin_amdgcn_readfirstlane(C.tid >> 6); C.G = gridDim.x; C.bid = blockIdx.x; C.rep = args.rep; C.dry = (args.rep + 1 < (args.pad & 255)) ? (args.pad >> 8) : 0;
    LAS unsigned char* ldsl0 = (LAS unsigned char*)lds;
    if (C.tid < 64) ((LAS unsigned*)(ldsl0 + LDSCTL_OFF))[C.tid] = 0u;
    __syncthreads();
    const int lo = args.ph_lo, hi = args.ph_hi;
    XcdBarrier bar; bar.bar = WSP(unsigned, WS_CTL) + CW_BAR; bar.x = 0; bar.st = (volatile LAS unsigned*)(ldsl0 + LDSCTL_OFF + LC_BAR);
    if (hi - lo > 1) bar = xcd_barrier_post(WSP(unsigned, WS_CTL) + CW_BAR, (volatile LAS unsigned*)(ldsl0 + LDSCTL_OFF + LC_BAR));
#define FRESH_TID (C.wave * 64 + lane_id_opaque())
#define IN(k) (lo <= (k) && (k) < hi)
#define SEAM(k) do { if (IN(k) && IN((k) + 1)) xcd_barrier(bar, FRESH_TID); } while (0)
#ifndef EN
#define EN 0xFFFF
#endif
    if ((EN & 1) && IN(0)) { phase0(C); SEAM(0); }
    if ((EN & 1) && IN(1)) {
        {
            const float* md = WSP(const float, WS_MODS); const float* rw = C.in[IN_RW]; float* b2 = WSP(float, WS_BIAS2);
            for (int o = C.bid * NWAVES + C.wave; o < 4 * 9 * 16; o += C.G * NWAVES) { const int lr = o >> 4, e = o & 15; const float* sh = md + (size_t)lr * 6144 + 3072; float sacc = 0.f;
#pragma unroll
                for (int j = 0; j < 16; ++j) { const int k = C.lane + 64 * j; sacc += sh[k] * rw[k * 16 + e]; }
                sacc = wave_sum(sacc);
                if (C.lane == 0) b2[o] = sacc; }
        }
        SchedFilt S{C.G, C.bid};
        EpiFilt E{WSP(bf16_t, WS_HF), C.in[IN_B3]};
        pg8::gemm_phase<false>(ldsl0, S, E, (const char*)WSP(bf16_t, WS_W3T), (const char*)WSP(bf16_t, WS_HPAD), 128, 128, 128u * 128u * 2u, 128u * 128u * 2u, 2, FRESH_TID);
        SEAM(1);
    }
    const Ctx C0 = C;
#pragma unroll 1
    for (int l = 0; l < DEPTH; ++l) {
        const int p0 = 2 + l * PH_PER_LAYER;
        Ctx C = C0; { int t_ = C0.wave * 64 + lane_id_opaque(); asm volatile("" : "+v"(t_)); C.tid = t_; C.lane = t_ & 63; C.wave = __builtin_amdgcn_readfirstlane(t_ >> 6);
                      int b_ = C0.bid; asm volatile("" : "+s"(b_)); C.bid = b_; int g_ = C0.G; asm volatile("" : "+s"(g_)); C.G = g_; unsigned char* w_ = C0.ws; asm volatile("" : "+s"(w_)); C.ws = w_;
                      const CAS fptr_t* i_ = C0.in; asm volatile("" : "+s"(i_)); C.in = i_;
                      LAS unsigned char* l_ = C0.lds; asm volatile("" : "+s"(l_)); C.lds = l_; }
        LAS unsigned char* const ldsl = C.lds;
        const float* modl = WSP(const float, WS_MODS) + (size_t)l * 9 * 6144;
        if ((EN & 2) && IN(p0 + 0)) { phase_l1(C, l); SEAM(p0 + 0); }
        if ((EN & 4) && IN(p0 + 1)) {
            { pg8::SchedDense S; S.init(NTOK / 256, NHG / 256, C.G, C.bid, D, D);
              EpiHG E{WSP(bf16_t, WS_PHG), WSP(const float, WS_LOWER) + l * 512};
              pg8::gemm_phase<false>(ldsl, S, E, (const char*)WSP(bf16_t, WS_R1), (const char*)(WSP(bf16_t, WS_WIN) + (size_t)NHY * D), D, D, 128u * D * 2u, 128u * D * 2u, D / 64, FRESH_TID); }
            { pg8::SchedDense S; S.init(NHY / 256, NTOK / 256, C.G, C.bid, D, D);
              EpiHY E{WSP(bf16_t, WS_PHYT)};
              pg8::gemm_phase<false>(ldsl, S, E, (const char*)WSP(bf16_t, WS_WIN), (const char*)WSP(bf16_t, WS_R1), D, D, 128u * D * 2u, 128u * D * 2u, D / 64, FRESH_TID); }
            SEAM(p0 + 1);
        }
        if ((EN & 8) && IN(p0 + 2)) { phase_l3(C, l); SEAM(p0 + 2); }
        if ((EN & 16) && IN(p0 + 3)) { phase_l3b(C, l); SEAM(p0 + 3); }
        if ((EN & 32) && IN(p0 + 4)) {
            pg8::SchedDense S; S.init(NTOK / 256, D / 256, C.G, C.bid, D, D);
            EpiOut E{C.in[IN_X], C.in[IN_CTX], WSP(float, WS_XBUF), modl, l == 0 ? 1 : 0, C.dry};
            pg8::gemm_phase<false>(ldsl, S, E, (const char*)WSP(bf16_t, WS_R1), (const char*)WSP(bf16_t, WS_WOUT), D, D, 128u * D * 2u, 128u * D * 2u, D / 64, FRESH_TID);
            SEAM(p0 + 4);
        }
        if ((EN & 64) && IN(p0 + 5)) { phase_l5a(C, l); SEAM(p0 + 5); }
        if ((EN & 128) && IN(p0 + 6)) { phase_l5b(C, l); SEAM(p0 + 6); }
        if ((EN & 256) && IN(p0 + 7)) {
            build_tiletab(C, l);
            const volatile LAS int* lc = (const volatile LAS int*)(ldsl + LDSCTL_OFF);
            const int n6 = 4 * lc[LC_T];
            unsigned* cnt6 = WSP(unsigned, WS_CTL) + CW_T6 + l * 96 * 64;
#pragma unroll 1
            for (int idx = C.bid; idx < n6; idx += C.G) {
                SchedUp1 S{idx, lc + LC_TILEBIN};
                EpiAct E{WSP(bf16_t, WS_R1), WSP(const float, WS_ROWW)};
                pg8::gemm_phase<false>(ldsl, S, E, (const char*)WSP(bf16_t, WS_PHG), (const char*)WSP(bf16_t, WS_WG), D, D, 128u * D * 2u, (unsigned)(WS_WU - WS_WG), D / 64, FRESH_TID);
                asm volatile("s_waitcnt vmcnt(0)" ::: "memory");
                __syncthreads();
                if (C.wave * 64 + lane_id_opaque() == 0) {
                    __hip_atomic_fetch_add(cnt6 + (idx >> 2) * 64, 1u, __ATOMIC_RELAXED, __HIP_MEMORY_SCOPE_AGENT); }
            }
            int nb2 = n6 - C.G; nb2 = nb2 < 0 ? 0 : (nb2 > C.G - 64 ? C.G - 64 : nb2);
            const int nw = C.G - nb2;
            if (C.bid >= nb2) {
#pragma unroll 1
                for (int j = C.bid - nb2; j < n6; j += nw) {
                    if (C.wave * 64 + lane_id_opaque() == 0) { unsigned* cw = cnt6 + (j >> 2) * 64; unsigned sp = 0;
                        while (__hip_atomic_load(cw, __ATOMIC_RELAXED, __HIP_MEMORY_SCOPE_AGENT) < 4u) { __builtin_amdgcn_s_sleep(2); if (++sp > (1u << 22)) break; }
                        __builtin_amdgcn_fence(__ATOMIC_ACQUIRE, "agent"); asm volatile("s_waitcnt vmcnt(0)" ::: "memory"); }
                    __syncthreads();
                    SchedDown1 S{j, lc + LC_TILEBIN};
                    EpiDown E{WSP(float, WS_XBUF), WSP(const int, WS_ROWTOK), modl, C.dry};
                    pg8::gemm_phase<true>(ldsl, S, E, (const char*)WSP(bf16_t, WS_R1), (const char*)WSP(bf16_t, WS_WD), 512, 256, 128u * 512u * 2u, 128u * 256u * 2u, 4, FRESH_TID);
                }
            }
            SEAM(p0 + 7);
        }
    }
    if ((EN & 1024) && IN(N_PHASES - 1)) { Ctx CF = C0; CF.tid = C0.wave * 64 + lane_id_opaque(); CF.lane = CF.tid & 63; phase_final(CF); }
#undef IN
#undef SEAM
}

extern "C" void kernel_launch(void* const* d_in, const int* in_sizes, int n_in, void* d_out, int out_size, void* d_ws, size_t ws_size, hipStream_t stream) {
    static int grid = 0;
    if (grid == 0) {
        if (n_in != N_IN || in_sizes[0] != NLAT * D || out_size != NLAT * D || ws_size < WS_END) { fprintf(stderr, "kernel_launch: unexpected shapes / workspace (%d inputs, ws %zu < %zu)\n", n_in, ws_size, (size_t)WS_END); grid = -1; return; }
        int dev = 0, cus = 0, per_cu = 0;
        if (hipGetDevice(&dev) != hipSuccess || hipDeviceGetAttribute(&cus, hipDeviceAttributeMultiprocessorCount, dev) != hipSuccess) { grid = -1; return; }
        if (hipFuncSetAttribute((const void*)trunk_fwd, hipFuncAttributeMaxDynamicSharedMemorySize, LDS_BYTES) != hipSuccess) { fprintf(stderr, "kernel_launch: hipFuncSetAttribute failed\n"); grid = -1; return; }
        if (hipOccupancyMaxActiveBlocksPerMultiprocessor(&per_cu, (const void*)trunk_fwd, NTHR, LDS_BYTES) != hipSuccess || per_cu < 1) { fprintf(stderr, "kernel_launch: occupancy query says %d\n", per_cu); }
        (void)hipGetLastError();
        grid = cus;
    }
    if (grid < 0) return;
    (void)hipMemsetAsync((char*)d_ws + WS_CTL, 0, CTL_ZERO_BYTES, stream);
    Args a{};
    for (int i = 0; i < N_IN; ++i) a.in[i] = (const float*)d_in[i];
    a.out = (float*)d_out; a.ws = (unsigned char*)d_ws;
#if MK_PER_PHASE
    for (int p = 0; p < N_PHASES; ++p) { a.ph_lo = p; a.ph_hi = p + 1; const int kind = p == 0 ? 0 : (p == 1 ? 11 : (p == N_PHASES - 1 ? 10 : 1 + (p - 2) % PH_PER_LAYER));
        const int nrep = ((PROBE_HOST >> kind) & 1) ? 2 : 1; a.pad = nrep | (PROBE_SKIP << 8);
        for (int rep = 0; rep < nrep; ++rep) { a.rep = rep; hipLaunchKernelGGL(trunk_fwd, dim3(grid), dim3(NTHR), LDS_BYTES, stream, a); } }
#else
    a.ph_lo = 0; a.ph_hi = N_PHASES; a.rep = 0; a.pad = 1;
    hipLaunchKernelGGL(trunk_fwd, dim3(grid), dim3(NTHR), LDS_BYTES, stream, a);
#endif
}
```

```cpp
#include <hip/hip_runtime.h>
#include <cstdio>
#include <cstdint>

#ifndef PROBE_HOST
#define PROBE_HOST 0
#endif
#ifndef PROBE_SKIP
#define PROBE_SKIP 1
#endif
#ifndef MK_PER_PHASE
#define MK_PER_PHASE 0
#endif

#define LAS __attribute__((address_space(3)))
typedef unsigned short bf16_t;
typedef short bf16x8 __attribute__((ext_vector_type(8)));
typedef float f32x4 __attribute__((ext_vector_type(4)));
typedef float f32x2 __attribute__((ext_vector_type(2)));
typedef unsigned u32x4 __attribute__((ext_vector_type(4)));
typedef unsigned u32x2 __attribute__((ext_vector_type(2)));

constexpr int NB = 8, SEQ = 2048, D = 1024, DEPTH = 4, CTXL = 256;
constexpr int NLAT = NB * SEQ, NCTX = NB * CTXL, NTOK = NLAT + NCTX;
constexpr int DH = 512, NHY = 1536, NHG = 2560, DIN = 4096;
constexpr int NE = 16, DE = 256, NBIN = 24, SROWS = 24576;
constexpr float EPS = 1e-6f;
constexpr int NTHR = 512, NWAVES = 8;
enum { IN_X = 0, IN_C, IN_CTX, IN_CCTX, IN_WMOD, IN_BMOD, IN_WIN, IN_WOUT, IN_CONVW, IN_CONVB, IN_W1, IN_B1, IN_W2, IN_B2, IN_W3, IN_B3,
       IN_HYBIAS, IN_LB, IN_NORMW, IN_RW, IN_RB, IN_WG, IN_WU, IN_WD, IN_FNW, N_IN };

constexpr size_t MiB = 1u << 20;
constexpr size_t WS_CTL = 0, CTL_ZERO_BYTES = 1 * MiB;
constexpr size_t WS_MODS = 1 * MiB;
constexpr size_t WS_LOWER = 2 * MiB;
constexpr size_t WS_BIAS2 = 2 * MiB + 64 * 1024;
constexpr size_t WS_HPAD = 3 * MiB;
constexpr size_t WS_TOKINFO = 6 * MiB;
constexpr size_t WS_BLKBASE = 6 * MiB + 320 * 1024;
constexpr size_t WS_ROWTOK = 6 * MiB + 512 * 1024;
constexpr size_t WS_ROWW = 7 * MiB;
constexpr size_t WS_WIN = 8 * MiB;
constexpr size_t WS_WOUT = 16 * MiB;
constexpr size_t WS_WG = 18 * MiB;
constexpr size_t WS_WU = 26 * MiB;
constexpr size_t WS_WD = 34 * MiB;
constexpr size_t WS_KSPEC = 42 * MiB;
constexpr size_t WS_XBUF = 74 * MiB;
constexpr size_t WS_R1 = 146 * MiB;
constexpr size_t WS_PHG = 182 * MiB;
constexpr size_t WS_PHYT = 272 * MiB;
constexpr size_t WS_ODIR = 326 * MiB;
constexpr size_t WS_KSPC = 362 * MiB;
constexpr size_t WS_W3T = 378 * MiB;
constexpr size_t WS_HF = 380 * MiB;
constexpr size_t WS_END = 416 * MiB;
constexpr int CW_BAR = 4096;
constexpr int CW_CNT = 16384;
constexpr int CW_T6 = 65536;
constexpr int CW_Q = 32768;

constexpr int LDS_BYTES = 147456;
constexpr int LDSCTL_OFF = 143 * 1024;
constexpr int LC_BAR = 0;
constexpr int LC_T = 8;
constexpr int LC_Q = 9;
constexpr int LC_OFFS = 16;
constexpr int LC_TILEBIN = 48;

__device__ __forceinline__ unsigned f2bf(float f) { return (unsigned)__builtin_bit_cast(unsigned short, (__bf16)f); }
typedef __bf16 bf16x2v __attribute__((ext_vector_type(2)));
__device__ __forceinline__ unsigned pk2(float lo, float hi) { const f32x2 v = {lo, hi}; return __builtin_bit_cast(unsigned, __builtin_convertvector(v, bf16x2v)); }
__device__ __forceinline__ float bf2f(unsigned b) { return __builtin_bit_cast(float, (b & 0xffffu) << 16); }
__device__ __forceinline__ float bflo(unsigned w) { return __builtin_bit_cast(float, w << 16); }
__device__ __forceinline__ float bfhi(unsigned w) { return __builtin_bit_cast(float, w & 0xffff0000u); }
__device__ __forceinline__ float sigmoidf_(float x) { return __builtin_amdgcn_rcpf(1.0f + __expf(-x)); }
__device__ __forceinline__ float siluf_(float x) { return x * __builtin_amdgcn_rcpf(1.0f + __expf(-x)); }
#define DPP_ADD(v, ctrl, rmask) v += __builtin_bit_cast(float, __builtin_amdgcn_update_dpp(0, __builtin_bit_cast(int, v), ctrl, rmask, 0xF, false))
__device__ __forceinline__ float row16_sum(float v) {
    DPP_ADD(v, 0xB1, 0xF);
    DPP_ADD(v, 0x4E, 0xF);
    DPP_ADD(v, 0x141, 0xF);
    DPP_ADD(v, 0x140, 0xF);
    return v;
}
__device__ __forceinline__ float wave_sum(float v) {
    v = row16_sum(v);
    DPP_ADD(v, 0x142, 0xA);
    DPP_ADD(v, 0x143, 0xC);
    return __builtin_bit_cast(float, __builtin_amdgcn_readlane(__builtin_bit_cast(int, v), 63));
}
__device__ __forceinline__ int lane_id_opaque() { int x; asm volatile("v_mbcnt_lo_u32_b32 %0, -1, 0\n\tv_mbcnt_hi_u32_b32 %0, -1, %0" : "=v"(x)); return x; }
__device__ __forceinline__ int bidx(int row) { return row < NLAT ? (row >> 11) : 8; }
#define LDS_WAIT() asm volatile("s_waitcnt lgkmcnt(0)" ::: "memory")

#define XB_TMO      128
#define XB_XCNT(j)  (256  + 64 * (j))
#define XB_XSUB(j)  (1280 + 64 * (j))
#define XB_XGEN(j)  (2304 + 64 * (j))
#define XB_TOP      3328
#define XB_TOPGEN   3392
#define XCD_BAR_WORDS 3456
#define XB_SPIN_CAP (1u << 18)
__device__ __forceinline__ unsigned xb_ld(unsigned* p)              { return __hip_atomic_load(p, __ATOMIC_RELAXED, __HIP_MEMORY_SCOPE_AGENT); }
__device__ __forceinline__ unsigned xb_add(unsigned* p, unsigned v) { return __hip_atomic_fetch_add(p, v, __ATOMIC_RELAXED, __HIP_MEMORY_SCOPE_AGENT); }
__device__ __forceinline__ unsigned xb_xcc_id() { return (unsigned)__builtin_amdgcn_s_getreg((3 << 11) | 20) & 0xFu; }
#define XB_SPIN(cond, bar) do { unsigned _sp = 0; while (cond) { __builtin_amdgcn_s_sleep(1); \
    if ((++_sp & 255u) == 0u) { if (xb_ld(&(bar)[XB_TMO])) break; if (_sp > XB_SPIN_CAP) { atomicAdd(&(bar)[XB_TMO], 1u); break; } } } } while (0)
struct XcdBarrier { unsigned* bar; unsigned x; volatile LAS unsigned* st; };
__device__ __forceinline__ XcdBarrier xcd_barrier_post(unsigned* bar, volatile LAS unsigned* st) {
    XcdBarrier b; b.bar = bar; b.x = xb_xcc_id(); b.st = st;
    if (threadIdx.x == 0) (void)xb_add(&bar[XB_XCNT(b.x)], 1u);
    return b;
}
__device__ __forceinline__ void xcd_barrier_complete(unsigned* bar, unsigned x, unsigned& nloc, unsigned& nx) {
    const unsigned G = gridDim.x * gridDim.y * gridDim.z;
    unsigned sum, cnt, mine, sp = 0u;
    for (;;) {
        sum = 0u; cnt = 0u; mine = 0u;
#pragma unroll
        for (unsigned j = 0; j < 16; ++j) { const unsigned c = xb_ld(&bar[XB_XCNT(j)]); sum += c; cnt += (c > 0u) ? 1u : 0u; mine = (j == x) ? c : mine; }
        if (sum == G) break;
        __builtin_amdgcn_s_sleep(1);
        if ((++sp & 255u) == 0u) { if (xb_ld(&bar[XB_TMO])) break; if (sp > XB_SPIN_CAP) { atomicAdd(&bar[XB_TMO], 1u); break; } }
    }
    nloc = mine > 0u ? mine : 1u; nx = cnt > 0u ? cnt : 1u;
}
__device__ __forceinline__ void xcd_barrier(const XcdBarrier& b, const int tid0) {
    asm volatile("s_waitcnt vmcnt(0)" ::: "memory");
    __syncthreads();
    if (tid0 == 0) {
        unsigned* bar = b.bar; unsigned bx = b.x;
        asm volatile("" : "+s"(bar), "+s"(bx));
        __builtin_amdgcn_s_waitcnt(0);
        unsigned nloc = b.st[0], nx = b.st[1];
        if (nloc == 0u) { xcd_barrier_complete(bar, bx, nloc, nx); b.st[0] = nloc; b.st[1] = nx; }
        const unsigned old = xb_add(&bar[XB_XSUB(bx)], 1u);
        const unsigned gen = old / nloc;
        if (old + 1u == (gen + 1u) * nloc) {
            __builtin_amdgcn_fence(__ATOMIC_RELEASE, "agent");
            asm volatile("s_waitcnt vmcnt(0)" ::: "memory");
            const unsigned og = xb_add(&bar[XB_TOP], 1u);
            const unsigned tg = og / nx;
            if (og + 1u == (tg + 1u) * nx) xb_add(&bar[XB_TOPGEN], 1u);
            else XB_SPIN(xb_ld(&bar[XB_TOPGEN]) == tg, bar);
            __builtin_amdgcn_fence(__ATOMIC_ACQUIRE, "agent");
            xb_add(&bar[XB_XGEN(bx)], 1u);
            asm volatile("s_waitcnt vmcnt(0)" ::: "memory");
        } else {
            XB_SPIN(xb_ld(&bar[XB_XGEN(bx)]) == gen, bar);
            __builtin_amdgcn_fence(__ATOMIC_ACQUIRE, "agent");
            asm volatile("s_waitcnt vmcnt(0)" ::: "memory");
        }
    }
    __syncthreads();
}

namespace pg8 {
constexpr int BM = 256, BK = 64, HALF = 128, HTB = HALF * BK * 2, STAGE_BYTES = 8 * HTB, NXCD = 8, WGM = 8;
__host__ __device__ __forceinline__ int lds_byte(int r, int c) { const int st = (r >> 4) * 2 + (c >> 5), rr = r & 15, cc = c & 31, ob = rr * 64 + cc * 2; return st * 1024 + (ob ^ (((ob >> 9) & 1) << 5)); }
__host__ __device__ __forceinline__ void stage_rc(int b, int& R, int& C) { const int st = b / 1024, sb = b % 1024, swz = sb ^ (((sb >> 9) & 1) << 5); R = (st >> 1) * 16 + swz / 64; C = (st & 1) * 32 + (swz % 64) / 2; }
__host__ __device__ __forceinline__ int perm32(int rho) { const int n = rho >> 4, i = rho & 15; return 8 * (i >> 2) + 4 * n + (i & 3); }

struct GUnit { unsigned a, b; int last, i0, i1; };

template <bool SUB, class Epi, class Sched>
__device__ __forceinline__ void gemm_phase(LAS unsigned char* lds, const Sched& S, const Epi& E, const char* Abase, const char* Bbase, const int lda, const int ldb, const unsigned ahalf, const unsigned bhalf, const int nt, const int tid_in) {
    int tid_ = tid_in; asm volatile("" : "+v"(tid_));
    const int tid = tid_, wid = __builtin_amdgcn_readfirstlane(tid >> 6), lane = tid & 63, wr = wid >> 2, wc = wid & 3, fr = lane & 15, fq = lane >> 4;
    unsigned voffA[2], voffB[2];
#pragma unroll
    for (int i = 0; i < 2; ++i) { int R, C; stage_rc(tid * 16 + i * 8192, R, C); const int Rb = Epi::PERM ? ((R & ~31) + perm32(R & 31)) : R;
        voffA[i] = (unsigned)(R * lda + C) * 2u; voffB[i] = (unsigned)(Rb * ldb + C) * 2u; }
    constexpr unsigned kstep = BK * 2;
    const unsigned ldsw = (unsigned)wid * 1024u;
    const int aoff = lds_byte(wr * 64 + fr, fq * 8), boff = lds_byte(wc * 32 + fr, fq * 8);
#define PG8_SA(b, h) (((b) * 2 + (h)) * HTB)
#define PG8_SB(b, h) ((4 + (b) * 2 + (h)) * HTB)
#define PG8_STAGE(bufoff, gbase, voff) do { _Pragma("unroll") for (int _i = 0; _i < 2; ++_i) \
        __builtin_amdgcn_global_load_lds((const unsigned*)((const char*)(gbase) + (voff)[_i]), (LAS unsigned*)(lds + (bufoff) + ldsw + _i * 8192), 16, 0, 0); } while (0)
#define PG8_LDA(dst, b, h) do { _Pragma("unroll") for (int m = 0; m < 4; ++m) _Pragma("unroll") for (int k = 0; k < 2; ++k) dst[m][k] = *(const LAS bf16x8*)(lds + PG8_SA(b, h) + aoff + m * 2048 + k * 1024); } while (0)
#define PG8_LDB(dst, b, h) do { _Pragma("unroll") for (int n = 0; n < 2; ++n) _Pragma("unroll") for (int k = 0; k < 2; ++k) dst[n][k] = *(const LAS bf16x8*)(lds + PG8_SB(b, h) + boff + n * 2048 + k * 1024); } while (0)
#define PG8_MMA(ai, bj, At, Bt) do { __builtin_amdgcn_s_setprio(1); _Pragma("unroll") for (int m = 0; m < 4; ++m) _Pragma("unroll") for (int n = 0; n < 2; ++n) _Pragma("unroll") for (int k = 0; k < 2; ++k) \
        acc[ai][bj][m][n] = __builtin_amdgcn_mfma_f32_16x16x32_bf16(Bt[n][k], At[m][k], acc[ai][bj][m][n], 0, 0, 0); __builtin_amdgcn_s_setprio(0); } while (0)
#define PG8_WAIT_V(n) asm volatile("s_waitcnt vmcnt(" #n ")" ::: "memory")
#define PG8_WAIT_L(n) asm volatile("s_waitcnt lgkmcnt(" #n ")" ::: "memory")
#define PG8_BAR __builtin_amdgcn_s_barrier()
#define PG8_SCHED __builtin_amdgcn_sched_barrier(0)
    GUnit cur, nxt; int ui = 0;
    if (!S.next(0, cur)) return;
    f32x4 acc[2][2][4][2];
    float zf_ = 0.f; asm volatile("" : "+v"(zf_));
#pragma unroll
    for (int a = 0; a < 2; ++a)
#pragma unroll
        for (int b = 0; b < 2; ++b)
#pragma unroll
            for (int m = 0; m < 4; ++m)
#pragma unroll
                for (int n = 0; n < 2; ++n) acc[a][b][m][n] = (f32x4){zf_, zf_, zf_, zf_};
    bf16x8 At[4][2], B0[2][2], B1[2][2];
    { const char* cA = Abase + cur.a; const char* cB = Bbase + cur.b;
      PG8_STAGE(PG8_SB(0, 0), cB, voffB); PG8_STAGE(PG8_SB(0, 1), cB + bhalf, voffB); PG8_STAGE(PG8_SA(0, 0), cA, voffA); PG8_STAGE(PG8_SA(0, 1), cA + ahalf, voffA);
      if (wr == 1) PG8_BAR;
      PG8_WAIT_V(2); PG8_BAR;
      PG8_STAGE(PG8_SB(1, 0), cB + kstep, voffB); PG8_STAGE(PG8_SA(1, 0), cA + kstep, voffA); PG8_STAGE(PG8_SB(1, 1), cB + bhalf + kstep, voffB);
      PG8_WAIT_V(6); PG8_BAR; }
    for (;;) {
        const bool has_next = S.next(ui + 1, nxt);
        const char* cA = Abase + cur.a; const char* cB = Bbase + cur.b;
        const char* nA = Abase + (has_next ? nxt.a : cur.a); const char* nB = Bbase + (has_next ? nxt.b : cur.b);
        for (int t = 0; t < nt; t += 2) {
            const bool last = (t == nt - 2);
            const char* a1 = cA + (unsigned)(t + 1) * kstep;
            const char* a2 = last ? nA : cA + (unsigned)(t + 2) * kstep; const char* b2 = last ? nB : cB + (unsigned)(t + 2) * kstep;
            const char* a3 = a2 + kstep; const char* b3 = b2 + kstep;
            PG8_LDB(B0, 0, 0); PG8_LDB(B1, 0, 1); PG8_SCHED; PG8_LDA(At, 0, 0); PG8_STAGE(PG8_SA(1, 1), a1 + ahalf, voffA);
            PG8_WAIT_V(8); PG8_WAIT_L(0); PG8_BAR; PG8_MMA(0, 0, At, B0); PG8_MMA(0, 1, At, B1); PG8_BAR; PG8_SCHED;
            PG8_LDA(At, 0, 1); PG8_STAGE(PG8_SB(0, 0), b2, voffB); PG8_STAGE(PG8_SB(0, 1), b2 + bhalf, voffB); PG8_STAGE(PG8_SA(0, 0), a2, voffA);
            PG8_WAIT_V(8); PG8_WAIT_L(0); PG8_BAR; PG8_MMA(1, 0, At, B0); PG8_MMA(1, 1, At, B1); PG8_BAR; PG8_SCHED;
            PG8_LDB(B0, 1, 0); PG8_LDB(B1, 1, 1); PG8_SCHED; PG8_LDA(At, 1, 0); PG8_STAGE(PG8_SA(0, 1), a2 + ahalf, voffA);
            PG8_WAIT_V(8); PG8_WAIT_L(0); PG8_BAR; PG8_MMA(0, 0, At, B0); PG8_MMA(0, 1, At, B1); PG8_BAR; PG8_SCHED;
            PG8_LDA(At, 1, 1); PG8_STAGE(PG8_SB(1, 0), b3, voffB); PG8_STAGE(PG8_SB(1, 1), b3 + bhalf, voffB); PG8_STAGE(PG8_SA(1, 0), a3, voffA);
            PG8_WAIT_V(8); PG8_WAIT_L(0); PG8_BAR; PG8_MMA(1, 0, At, B0); PG8_MMA(1, 1, At, B1); PG8_BAR; PG8_SCHED;
        }
        const bool fin = SUB ? (cur.last != 0) : true;
        if (fin) { if (wr == 0) PG8_BAR; E(acc, cur, wr, wc, fr, fq); }
        if (!has_next) break;
        if (fin) {
#pragma unroll
            for (int a = 0; a < 2; ++a)
#pragma unroll
                for (int b = 0; b < 2; ++b)
#pragma unroll
                    for (int m = 0; m < 4; ++m)
#pragma unroll
                        for (int n = 0; n < 2; ++n) acc[a][b][m][n] = (f32x4){zf_, zf_, zf_, zf_};
        }
        cur = nxt; ++ui;
        if (fin) { if (wr == 1) PG8_BAR; }
    }
    PG8_WAIT_V(0);
    PG8_BAR;
#undef PG8_SA
#undef PG8_SB
#undef PG8_STAGE
#undef PG8_LDA
#undef PG8_LDB
#undef PG8_MMA
#undef PG8_WAIT_V
#undef PG8_WAIT_L
#undef PG8_BAR
#undef PG8_SCHED
}

struct SchedDense {
    int nM, nN, nwg, G, c; unsigned atile, btile;
    __device__ __forceinline__ void init(int nM_, int nN_, int G_, int c_, int lda, int ldb) {
        nM = nM_; nN = nN_; nwg = nM * nN; G = G_; c = c_; atile = 256u * lda * 2u; btile = 256u * ldb * 2u; }
    __device__ __forceinline__ bool next(int i, GUnit& u) const {
        const int L = i * G + c; if (L >= nwg) return false;
        int wgid = L; { const int q = nwg / NXCD, r = nwg % NXCD, xcd = wgid % NXCD, off = wgid / NXCD; wgid = (xcd < r ? xcd * (q + 1) : r * (q + 1) + (xcd - r) * q) + off; }
        const int nig = WGM * nN, gid = wgid / nig, fm = gid * WGM, gsz = (nM - fm) < WGM ? (nM - fm) : WGM;
        const int pm = fm + ((wgid % nig) % gsz), pn = (wgid % nig) / gsz;
        u.a = (unsigned)pm * atile; u.b = (unsigned)pn * btile; u.last = 1; u.i0 = pm; u.i1 = pn; return true;
    }
};
}

struct Args { const float* in[N_IN]; float* out; unsigned char* ws; int ph_lo, ph_hi, rep, pad; };
static_assert(sizeof(Args) == N_IN * 8 + 8 + 8 + 16, "Args has no padding");

#define CAS __attribute__((address_space(4)))
typedef const float* fptr_t;
struct Ctx {
    const CAS fptr_t* in; float* out; unsigned char* ws; LAS unsigned char* lds; int tid, lane, wave, G, bid, rep, dry;
};
#define WSP(T, off) ((T*)(C.ws + (off)))

__device__ __forceinline__ void build_tiletab(const Ctx& C, int l) {
    volatile LAS int* lc = (volatile LAS int*)(C.lds + LDSCTL_OFF);
    __syncthreads();
    if (C.tid == 0) {
        const unsigned* cnt = WSP(const unsigned, WS_CTL) + CW_CNT + l * 32 * 64;
        int off = 0, t = 0;
        for (int b = 0; b < NBIN; ++b) {
            const int n = (int)__hip_atomic_load(cnt + b * 64, __ATOMIC_RELAXED, __HIP_MEMORY_SCOPE_AGENT);
            lc[LC_OFFS + b] = off;
            const int nt = (n + 255) >> 8;
            for (int k = 0; k < nt; ++k) lc[LC_TILEBIN + t + k] = b;
            t += nt; off += nt * 256;
        }
        lc[LC_OFFS + NBIN] = off; lc[LC_T] = t;
    }
    __syncthreads();
}
__device__ __forceinline__ int expert_of(int bin, int es) {
    const int g = bin / 6, p = bin - g * 6;
    const int lo = p < 3 ? 0 : (p < 5 ? 1 : 2), hi = p < 3 ? p + 1 : (p < 5 ? p - 1 : 3);
    return 4 * g + (es ? hi : lo);
}

struct SchedUp {
    int T, G, c; const volatile LAS int* tilebin;
    __device__ __forceinline__ bool next(int i, pg8::GUnit& u) const {
        const int idx = i * G + c; if (idx >= 4 * T) return false;
        const int rt = idx >> 2, q = idx & 3, es = q >> 1, fb = q & 1;
        const int bin = __builtin_amdgcn_readfirstlane(tilebin[rt]);
        const int e = expert_of(bin, es);
        u.a = (unsigned)rt * 256u * 2048u; u.b = (unsigned)(e * 256 + fb * 128) * 2048u;
        u.last = 1; u.i0 = rt; u.i1 = q; return true;
    }
};
struct SchedDown {
    int T, G, c; const volatile LAS int* tilebin;
    __device__ __forceinline__ bool next(int i, pg8::GUnit& u) const {
        const int idx = (i >> 1) * G + c, sub = i & 1; if (idx >= 4 * T) return false;
        const int rt = idx >> 2, pn = idx & 3;
        const int bin = __builtin_amdgcn_readfirstlane(tilebin[rt]);
        const int e = expert_of(bin, sub);
        u.a = (unsigned)rt * 256u * 1024u + (unsigned)sub * 512u; u.b = (unsigned)(e * 1024 + pn * 256) * 512u;
        u.last = sub; u.i0 = rt; u.i1 = pn; return true;
    }
};

struct SchedUp1 {
    int idx; const volatile LAS int* tilebin;
    __device__ __forceinline__ bool next(int i, pg8::GUnit& u) const {
        if (i != 0) return false;
        const int rt = idx >> 2, q = idx & 3, es = q >> 1, fb = q & 1;
        const int bin = __builtin_amdgcn_readfirstlane(tilebin[rt]);
        const int e = expert_of(bin, es);
        u.a = (unsigned)rt * 256u * 2048u; u.b = (unsigned)(e * 256 + fb * 128) * 2048u;
        u.last = 1; u.i0 = rt; u.i1 = q; return true;
    }
};
struct SchedDown1 {
    int idx; const volatile LAS int* tilebin;
    __device__ __forceinline__ bool next(int i, pg8::GUnit& u) const {
        if (i > 1) return false;
        const int sub = i, rt = idx >> 2, pn = idx & 3;
        const int bin = __builtin_amdgcn_readfirstlane(tilebin[rt]);
        const int e = expert_of(bin, sub);
        u.a = (unsigned)rt * 256u * 1024u + (unsigned)sub * 512u; u.b = (unsigned)(e * 1024 + pn * 256) * 512u;
        u.last = sub; u.i0 = rt; u.i1 = pn; return true;
    }
};

struct EpiHG {
    static constexpr bool PERM = true;
    bf16_t* O; const float* lower;
    __device__ __forceinline__ void operator()(const f32x4 (&acc)[2][2][4][2], const pg8::GUnit& u, int wr, int wc, int fr, int fq) const {
        const int kind = u.i1 >> 1;
        const int row0 = u.i0 * 256 + wr * 64 + fr, colt = u.i1 * 256 + wc * 32 + 8 * fq;
#pragma unroll
        for (int bj = 0; bj < 2; ++bj) {
            const int col = colt + bj * 128;
            float om[8];
#pragma unroll
            for (int j = 0; j < 8; ++j) om[j] = 1.f;
            if (kind >= 3) { const float* lb = lower + (kind - 3) * 2048 + (col & 511);
#pragma unroll
                for (int j = 0; j < 8; ++j) om[j] = 1.f - lb[j]; }
#pragma unroll
            for (int ai = 0; ai < 2; ++ai)
#pragma unroll
                for (int m = 0; m < 4; ++m) {
                    float v[8];
#pragma unroll
                    for (int j = 0; j < 8; ++j) v[j] = acc[ai][bj][m][j >> 2][j & 3];
                    if (kind == 0) {
#pragma unroll
                        for (int j = 0; j < 8; ++j) v[j] = siluf_(v[j]);
                    } else if (kind >= 3) {
#pragma unroll
                        for (int j = 0; j < 8; ++j) v[j] = om[j] * sigmoidf_(-v[j]);
                    }
                    u32x4 w; w.x = pk2(v[0], v[1]); w.y = pk2(v[2], v[3]); w.z = pk2(v[4], v[5]); w.w = pk2(v[6], v[7]);
                    *(u32x4*)(O + (size_t)(row0 + ai * 128 + m * 16) * NHG + col) = w;
                }
        }
    }
};
struct EpiHY {
    static constexpr bool PERM = true;
    bf16_t* O;
    __device__ __forceinline__ void operator()(const f32x4 (&acc)[2][2][4][2], const pg8::GUnit& u, int wr, int wc, int fr, int fq) const {
        const int row0 = u.i0 * 256 + wr * 64 + fr, colt = u.i1 * 256 + wc * 32 + 8 * fq;
#pragma unroll
        for (int ai = 0; ai < 2; ++ai)
#pragma unroll
            for (int m = 0; m < 4; ++m)
#pragma unroll
                for (int bj = 0; bj < 2; ++bj) {
                    const f32x4 v0 = acc[ai][bj][m][0], v1 = acc[ai][bj][m][1];
                    u32x4 w; w.x = pk2(v0[0], v0[1]); w.y = pk2(v0[2], v0[3]); w.z = pk2(v1[0], v1[1]); w.w = pk2(v1[2], v1[3]);
                    *(u32x4*)(O + (size_t)(row0 + ai * 128 + m * 16) * NTOK + colt + bj * 128) = w;
                }
    }
};
struct EpiOut {
    static constexpr bool PERM = false;
    const float* xlat; const float* xctx; float* xo; const float* mods; int first; int dry;
    __device__ __forceinline__ void operator()(const f32x4 (&acc)[2][2][4][2], const pg8::GUnit& u, int wr, int wc, int fr, int fq) const {
        const int row0 = u.i0 * 256 + wr * 64 + fr, col0 = u.i1 * 256 + wc * 32 + 4 * fq;
#pragma unroll
        for (int ai = 0; ai < 2; ++ai)
#pragma unroll
            for (int m = 0; m < 4; ++m) {
                const int row = row0 + ai * 128 + m * 16;
                const float* src = first ? (row < NLAT ? xlat + (size_t)row * D : xctx + (size_t)(row - NLAT) * D) : xo + (size_t)row * D;
                const float* g1 = mods + bidx(row) * 6144 + 2048;
#pragma unroll
                for (int bj = 0; bj < 2; ++bj)
#pragma unroll
                    for (int n = 0; n < 2; ++n) { const int col = col0 + bj * 128 + n * 16;
                        const f32x4 xv = *(const f32x4*)(src + col), gv = *(const f32x4*)(g1 + col);
                        if (!dry) *(f32x4*)(xo + (size_t)row * D + col) = xv + gv * acc[ai][bj][m][n]; }
            }
    }
};
struct EpiAct {
    static constexpr bool PERM = true;
    bf16_t* O; const float* roww;
    __device__ __forceinline__ void operator()(const f32x4 (&acc)[2][2][4][2], const pg8::GUnit& u, int wr, int wc, int fr, int fq) const {
        const int es = u.i1 >> 1; const int pos0 = u.i0 * 256 + wr * 64 + fr, col = u.i1 * 128 + wc * 32 + 8 * fq;
        const __amdgpu_buffer_rsrc_t rsrc = __builtin_amdgcn_make_buffer_rsrc(O, 0, SROWS * 512 * 2, 0x00020000);
#pragma unroll
        for (int ai = 0; ai < 2; ++ai)
#pragma unroll
            for (int m = 0; m < 4; ++m) {
                const int pos = pos0 + ai * 128 + m * 16;
                const float wgt = roww[pos * 2 + es];
                float v[8];
#pragma unroll
                for (int j = 0; j < 8; ++j) v[j] = siluf_(acc[ai][0][m][j >> 2][j & 3]) * acc[ai][1][m][j >> 2][j & 3] * wgt;
                u32x4 w; w.x = pk2(v[0], v[1]); w.y = pk2(v[2], v[3]); w.z = pk2(v[4], v[5]); w.w = pk2(v[6], v[7]);
                __builtin_amdgcn_raw_buffer_store_b128(w, rsrc, (unsigned)(pos * 512 + col) * 2u, 0, 16);
            }
    }
};
struct EpiDown {
    static constexpr bool PERM = false;
    float* xo; const int* rowtok; const float* mods; int dry;
    __device__ __forceinline__ void operator()(const f32x4 (&acc)[2][2][4][2], const pg8::GUnit& u, int wr, int wc, int fr, int fq) const {
        const int pos0 = u.i0 * 256 + wr * 64 + fr, col0 = u.i1 * 256 + wc * 32 + 4 * fq;
#pragma unroll
        for (int ai = 0; ai < 2; ++ai)
#pragma unroll
            for (int m = 0; m < 4; ++m) {
                const int tok = rowtok[pos0 + ai * 128 + m * 16];
                if (tok >= 0) {
                    const float* g2 = mods + bidx(tok) * 6144 + 5120;
                    float* xr = xo + (size_t)tok * D;
#pragma unroll
                    for (int bj = 0; bj < 2; ++bj)
#pragma unroll
                        for (int n = 0; n < 2; ++n) { const int col = col0 + bj * 128 + n * 16;
                            const f32x4 xv = *(const f32x4*)(xr + col), gv = *(const f32x4*)(g2 + col);
                            if (!dry) *(f32x4*)(xr + col) = xv + gv * acc[ai][bj][m][n]; }
                }
            }
    }
};

struct SchedFilt {
    int G, c;
    __device__ __forceinline__ bool next(int i, pg8::GUnit& u) const {
        const int idx = i * G + c; if (idx >= 4 * 72) return false;
        const int l = idx / 72, r = idx - l * 72, pm = r / 9, pn = r - pm * 9;
        u.a = (unsigned)(l * 2048 + pm * 256) * 256u; u.b = (unsigned)(l * 2304 + pn * 256) * 256u; u.last = 1; u.i0 = l * 16 + pm; u.i1 = pn; return true;
    }
};
struct EpiFilt {
    static constexpr bool PERM = true;
    bf16_t* HF; const float* b3;
    __device__ __forceinline__ void operator()(const f32x4 (&acc)[2][2][4][2], const pg8::GUnit& u, int wr, int wc, int fr, int fq) const {
        const int l = u.i0 >> 4, pm = u.i0 & 15;
        const int row0 = pm * 256 + wr * 64 + fr, t00 = u.i1 * 256 + wc * 32 + 8 * fq;
#pragma unroll
        for (int ai = 0; ai < 2; ++ai)
#pragma unroll
            for (int m = 0; m < 4; ++m) {
                const int row = row0 + ai * 128 + m * 16, c = row & 511;
                const float delta = fabsf(logf(1e-2f) / 0.3f + (float)c * ((logf(1e-2f) / 1.5f - logf(1e-2f) / 0.3f) / 511.0f));
                const float bias = b3[l * 2048 + row];
#pragma unroll
                for (int bj = 0; bj < 2; ++bj) {
                    const int t0 = t00 + bj * 128;
                    float v[8];
#pragma unroll
                    for (int j = 0; j < 8; ++j) { const int t = t0 + j; const float tn = t < 2048 ? (float)t / 2047.0f : (float)(t - 2048) / 255.0f;
                        v[j] = (acc[ai][bj][m][j >> 2][j & 3] + bias) * expf(-tn * delta); }
                    u32x4 w; w.x = pk2(v[0], v[1]); w.y = pk2(v[2], v[3]); w.z = pk2(v[4], v[5]); w.w = pk2(v[6], v[7]);
                    *(u32x4*)(HF + ((size_t)(l * 2048 + row)) * 2304 + t0) = w;
                }
            }
    }
};

__device__ __forceinline__ int padx(int i) { return i + (i >> 3); }
__device__ __forceinline__ f32x2 cmul(f32x2 a, f32x2 b) { return (f32x2){a.x * b.x - a.y * b.y, a.x * b.y + a.y * b.x}; }
__device__ __forceinline__ f32x2 cmulc(f32x2 a, f32x2 b) { return (f32x2){a.x * b.x + a.y * b.y, a.y * b.x - a.x * b.y}; }
constexpr int XPAD = 2048 + 256;

__device__ __forceinline__ void fft_p1_dif(f32x2 (&v)[8], int tt, const LAS f32x2* T) {
#pragma unroll
    for (int g = 0; g < 2; ++g) { const int u = tt + 256 * g;
#pragma unroll
        for (int j = 0; j < 2; ++j) { const f32x2 a = v[g + 2 * j], b = v[g + 2 * j + 4]; v[g + 2 * j] = a + b; v[g + 2 * j + 4] = cmul(a - b, T[2 * (u + 512 * j)]); }
        const f32x2 tw = T[4 * u];
        { const f32x2 a = v[g], b = v[g + 2]; v[g] = a + b; v[g + 2] = cmul(a - b, tw); }
        { const f32x2 a = v[g + 4], b = v[g + 6]; v[g + 4] = a + b; v[g + 6] = cmul(a - b, tw); } }
}
__device__ __forceinline__ void fft_p1_dit(f32x2 (&v)[8], int tt, const LAS f32x2* T) {
#pragma unroll
    for (int g = 0; g < 2; ++g) { const int u = tt + 256 * g;
        const f32x2 tw = T[4 * u];
        { const f32x2 a = v[g], b = cmulc(v[g + 2], tw); v[g] = a + b; v[g + 2] = a - b; }
        { const f32x2 a = v[g + 4], b = cmulc(v[g + 6], tw); v[g + 4] = a + b; v[g + 6] = a - b; }
#pragma unroll
        for (int j = 0; j < 2; ++j) { const f32x2 a = v[g + 2 * j], b = cmulc(v[g + 2 * j + 4], T[2 * (u + 512 * j)]); v[g + 2 * j] = a + b; v[g + 2 * j + 4] = a - b; } }
}
template <int Q> __device__ __forceinline__ void r8_dif(f32x2 (&e)[8], int r, const LAS f32x2* T) {
    constexpr int S2 = 512 / Q;
#pragma unroll
    for (int j = 0; j < 4; ++j) { const f32x2 a = e[j], b = e[j + 4]; e[j] = a + b; e[j + 4] = cmul(a - b, T[S2 * (r + Q * j)]); }
#pragma unroll
    for (int jj = 0; jj < 4; ++jj) { const int j = (jj & 1) + 4 * (jj >> 1); const f32x2 a = e[j], b = e[j + 2]; e[j] = a + b; e[j + 2] = cmul(a - b, T[2 * S2 * (r + Q * (j & 1))]); }
    const f32x2 tw = T[4 * S2 * r];
#pragma unroll
    for (int j = 0; j < 8; j += 2) { const f32x2 a = e[j], b = e[j + 1]; e[j] = a + b; e[j + 1] = cmul(a - b, tw); }
}
template <int Q> __device__ __forceinline__ void r8_dit(f32x2 (&e)[8], int r, const LAS f32x2* T) {
    constexpr int S2 = 512 / Q;
    const f32x2 tw = T[4 * S2 * r];
#pragma unroll
    for (int j = 0; j < 8; j += 2) { const f32x2 a = e[j], b = cmulc(e[j + 1], tw); e[j] = a + b; e[j + 1] = a - b; }
#pragma unroll
    for (int jj = 0; jj < 4; ++jj) { const int j = (jj & 1) + 4 * (jj >> 1); const f32x2 a = e[j], b = cmulc(e[j + 2], T[2 * S2 * (r + Q * (j & 1))]); e[j] = a + b; e[j + 2] = a - b; }
#pragma unroll
    for (int j = 0; j < 4; ++j) { const f32x2 a = e[j], b = cmulc(e[j + 4], T[S2 * (r + Q * j)]); e[j] = a + b; e[j + 4] = a - b; }
}
template <int Q, bool INV> __device__ __forceinline__ void fft_mid(LAS f32x2* X, int tt, const LAS f32x2* T) {
    const int blk = tt / Q, r = tt % Q, base = blk * 8 * Q + r;
    f32x2 e[8];
#pragma unroll
    for (int j = 0; j < 8; ++j) e[j] = X[padx(base + Q * j)];
    if (INV) r8_dit<Q>(e, r, T); else r8_dif<Q>(e, r, T);
#pragma unroll
    for (int j = 0; j < 8; ++j) X[padx(base + Q * j)] = e[j];
}
__device__ __forceinline__ void fft_conv_half(f32x2 (&v)[8], LAS f32x2* X, const LAS f32x2* T, const f32x2* K, int tt) {
    f32x2 kv[8];
#pragma unroll
    for (int j = 0; j < 8; ++j) kv[j] = K[8 * tt + j];
    fft_p1_dif(v, tt, T);
#pragma unroll
    for (int m = 0; m < 8; ++m) X[padx(tt + 256 * m)] = v[m];
    __syncthreads();
    fft_mid<64, false>(X, tt, T); __syncthreads();
    fft_mid<8, false>(X, tt, T); __syncthreads();
    f32x2 e[8];
#pragma unroll
    for (int j = 0; j < 8; ++j) e[j] = X[padx(8 * tt + j)];
    r8_dif<1>(e, 0, T);
#pragma unroll
    for (int j = 0; j < 8; ++j) e[j] = cmul(e[j], kv[j]);
    r8_dit<1>(e, 0, T);
#pragma unroll
    for (int j = 0; j < 8; ++j) X[padx(8 * tt + j)] = e[j];
    __syncthreads();
    fft_mid<8, true>(X, tt, T); __syncthreads();
    fft_mid<64, true>(X, tt, T); __syncthreads();
#pragma unroll
    for (int m = 0; m < 8; ++m) v[m] = X[padx(tt + 256 * m)];
    fft_p1_dit(v, tt, T);
}
__device__ __forceinline__ void fft_fwd_store(f32x2 (&v)[8], LAS f32x2* X, const LAS f32x2* T, f32x2* Kout, int tt) {
    fft_p1_dif(v, tt, T);
#pragma unroll
    for (int m = 0; m < 8; ++m) X[padx(tt + 256 * m)] = v[m];
    __syncthreads();
    fft_mid<64, false>(X, tt, T); __syncthreads();
    fft_mid<8, false>(X, tt, T); __syncthreads();
    f32x2 e[8];
#pragma unroll
    for (int j = 0; j < 8; ++j) e[j] = X[padx(8 * tt + j)];
    r8_dif<1>(e, 0, T);
#pragma unroll
    for (int j = 0; j < 8; ++j) Kout[8 * tt + j] = e[j];
    __syncthreads();
}
__device__ __forceinline__ int padx16(int i) { return i + (i >> 4); }
constexpr int XPAD16 = 2048 + 128;
template <int Q> __device__ __forceinline__ void r16_dif(f32x2 (&e)[16], int r, const LAS f32x2* T) {
    constexpr int S2 = 256 / Q;
#pragma unroll
    for (int j = 0; j < 8; ++j) { const f32x2 a = e[j], b = e[j + 8]; e[j] = a + b; e[j + 8] = cmul(a - b, T[S2 * (r + Q * j)]); }
#pragma unroll
    for (int jj = 0; jj < 8; ++jj) { const int j = (jj & 3) + 8 * (jj >> 2); const f32x2 a = e[j], b = e[j + 4]; e[j] = a + b; e[j + 4] = cmul(a - b, T[2 * S2 * (r + Q * (j & 3))]); }
#pragma unroll
    for (int jj = 0; jj < 8; ++jj) { const int j = (jj & 1) + 4 * (jj >> 1); const f32x2 a = e[j], b = e[j + 2]; e[j] = a + b; e[j + 2] = cmul(a - b, T[4 * S2 * (r + Q * (j & 1))]); }
    const f32x2 tw = T[8 * S2 * r];
#pragma unroll
    for (int j = 0; j < 16; j += 2) { const f32x2 a = e[j], b = e[j + 1]; e[j] = a + b; e[j + 1] = cmul(a - b, tw); }
}
template <int Q> __device__ __forceinline__ void r16_dit(f32x2 (&e)[16], int r, const LAS f32x2* T) {
    constexpr int S2 = 256 / Q;
    const f32x2 tw = T[8 * S2 * r];
#pragma unroll
    for (int j = 0; j < 16; j += 2) { const f32x2 a = e[j], b = cmulc(e[j + 1], tw); e[j] = a + b; e[j + 1] = a - b; }
#pragma unroll
    for (int jj = 0; jj < 8; ++jj) { const int j = (jj & 1) + 4 * (jj >> 1); const f32x2 a = e[j], b = cmulc(e[j + 2], T[4 * S2 * (r + Q * (j & 1))]); e[j] = a + b; e[j + 2] = a - b; }
#pragma unroll
    for (int jj = 0; jj < 8; ++jj) { const int j = (jj & 3) + 8 * (jj >> 2); const f32x2 a = e[j], b = cmulc(e[j + 4], T[2 * S2 * (r + Q * (j & 3))]); e[j] = a + b; e[j + 4] = a - b; }
#pragma unroll
    for (int j = 0; j < 8; ++j) { const f32x2 a = e[j], b = cmulc(e[j + 8], T[S2 * (r + Q * j)]); e[j] = a + b; e[j + 8] = a - b; }
}
__device__ __forceinline__ void fft_conv_half16(f32x2 (&v)[16], LAS f32x2* X, const LAS f32x2* T, const f32x2* K, int tt) {
    r16_dif<128>(v, tt, T);
#pragma unroll
    for (int m = 0; m < 16; ++m) X[padx16(tt + 128 * m)] = v[m];
    __syncthreads();
    const int r = tt & 7, base = (tt >> 3) * 128 + r;
#pragma unroll
    for (int j = 0; j < 16; ++j) v[j] = X[padx16(base + 8 * j)];
    r16_dif<8>(v, r, T);
#pragma unroll
    for (int j = 0; j < 16; ++j) X[padx16(base + 8 * j)] = v[j];
    f32x2 kv[16];
#pragma unroll
    for (int j = 0; j < 16; ++j) kv[j] = K[16 * tt + j];
    __syncthreads();
#pragma unroll
    for (int g = 0; g < 2; ++g) { f32x2 e[8];
#pragma unroll
        for (int j = 0; j < 8; ++j) e[j] = X[padx16(16 * tt + 8 * g + j)];
        r8_dif<1>(e, 0, T);
#pragma unroll
        for (int j = 0; j < 8; ++j) e[j] = cmul(e[j], kv[8 * g + j]);
        r8_dit<1>(e, 0, T);
#pragma unroll
        for (int j = 0; j < 8; ++j) X[padx16(16 * tt + 8 * g + j)] = e[j]; }
    __syncthreads();
#pragma unroll
    for (int j = 0; j < 16; ++j) v[j] = X[padx16(base + 8 * j)];
    r16_dit<8>(v, r, T);
#pragma unroll
    for (int j = 0; j < 16; ++j) X[padx16(base + 8 * j)] = v[j];
    __syncthreads();
#pragma unroll
    for (int m = 0; m < 16; ++m) v[m] = X[padx16(tt + 128 * m)];
    r16_dit<128>(v, tt, T);
}
__device__ __forceinline__ void fft_fwd_store16(f32x2 (&v)[16], LAS f32x2* X, const LAS f32x2* T, f32x2* Kout, int tt) {
    r16_dif<128>(v, tt, T);
#pragma unroll
    for (int m = 0; m < 16; ++m) X[padx16(tt + 128 * m)] = v[m];
    __syncthreads();
    const int r = tt & 7, base = (tt >> 3) * 128 + r;
#pragma unroll
    for (int j = 0; j < 16; ++j) v[j] = X[padx16(base + 8 * j)];
    r16_dif<8>(v, r, T);
#pragma unroll
    for (int j = 0; j < 16; ++j) X[padx16(base + 8 * j)] = v[j];
    __syncthreads();
#pragma unroll
    for (int g = 0; g < 2; ++g) { f32x2 e[8];
#pragma unroll
        for (int j = 0; j < 8; ++j) e[j] = X[padx16(16 * tt + 8 * g + j)];
        r8_dif<1>(e, 0, T);
#pragma unroll
        for (int j = 0; j < 8; ++j) Kout[16 * tt + 8 * g + j] = e[j]; }
    __syncthreads();
}
__device__ __forceinline__ void build_twiddles(const Ctx& C, LAS f32x2* T) {
    for (int k = C.tid; k < 2048; k += NTHR) { float s, c; sincospif((float)k * (1.0f / 2048.0f), &s, &c); T[k] = (f32x2){c, -s}; }
}

__device__ __forceinline__ void phase0(const Ctx& C) {
    LAS float* sil = (LAS float*)C.lds;
    LAS float* red = sil + 9 * 1024;
    LAS float* zs = red + 8 * 9 * 64;
    LAS float* h1s = zs + 8 * 40;
    const float* cin = C.in[IN_C]; const float* cctx = C.in[IN_CCTX];
    for (int i = C.tid; i < 9 * 1024; i += NTHR) { const int r = i >> 10, k = i & 1023; const float v = r < 8 ? cin[r * 1024 + k] : cctx[k]; sil[i] = v / (1.0f + expf(-v)); }
    __syncthreads();
    float* mods = WSP(float, WS_MODS);
    const float* wmod = C.in[IN_WMOD]; const float* bmod = C.in[IN_BMOD];
    for (int item = C.bid; item < 4 * 96; item += C.G) {
        const int l = item / 96, cb = item % 96, cc = C.tid & 63, kg = C.tid >> 6;
        const float* w = wmod + ((size_t)l * 1024 + kg * 128) * 6144 + cb * 64 + cc;
        const LAS float* sk = sil + kg * 128;
        float acc[9];
#pragma unroll
        for (int r = 0; r < 9; ++r) acc[r] = 0.f;
#pragma unroll 4
        for (int k = 0; k < 128; ++k) { const float wv = w[(size_t)k * 6144];
#pragma unroll
            for (int r = 0; r < 9; ++r) acc[r] += sk[r * 1024 + k] * wv; }
#pragma unroll
        for (int r = 0; r < 9; ++r) red[(kg * 9 + r) * 64 + cc] = acc[r];
        __syncthreads();
        for (int o = C.tid; o < 576; o += NTHR) { const int r = o >> 6, c2 = o & 63; float s = 0.f;
#pragma unroll
            for (int g = 0; g < 8; ++g) s += red[(g * 9 + r) * 64 + c2];
            mods[(size_t)(l * 9 + r) * 6144 + cb * 64 + c2] = s + bmod[l * 6144 + cb * 64 + c2]; }
        __syncthreads();
    }
    for (int item = C.bid; item < 4 * 288; item += C.G) {
        const int l = item / 288, r = item % 288, isctx = r >= 256;
        const int L = isctx ? 256 : 2048, t0 = (isctx ? r - 256 : r) * 8, tl = C.tid >> 6, j = C.tid & 63, t = t0 + tl;
        if (j < 33) { float z;
            if (j == 0) z = (float)t / (float)(L - 1);
            else { const int fi = (j - 1) & 15; const float freq = 1e-4f + (float)fi * ((15.0f - 1e-4f) / 15.0f);
                const float ang = ((float)(2.0 * 3.14159265358979323846 / L) * (float)t) * freq; z = (j <= 16) ? cosf(ang) : -sinf(ang); }
            zs[tl * 40 + j] = z; }
        __syncthreads();
        { const float* w1 = C.in[IN_W1] + (size_t)l * 33 * 64; float s = C.in[IN_B1][l * 64 + j];
            for (int i = 0; i < 33; ++i) s += zs[tl * 40 + i] * w1[i * 64 + j];
            h1s[tl * 64 + j] = sinf(s); }
        __syncthreads();
        { const float* w2 = C.in[IN_W2] + (size_t)l * 64 * 64; float s = C.in[IN_B2][l * 64 + j];
            for (int i = 0; i < 64; ++i) s += h1s[tl * 64 + i] * w2[i * 64 + j];
            bf16_t* dst = WSP(bf16_t, WS_HPAD) + ((size_t)l * 2304 + (isctx ? 2048 + t : t)) * 128;
            dst[j] = (bf16_t)f2bf(sinf(s)); dst[64 + j] = (bf16_t)0; }
        __syncthreads();
    }
    {
        const float* w3 = C.in[IN_W3]; bf16_t* w3t = WSP(bf16_t, WS_W3T);
        for (int i = C.bid * NTHR + C.tid; i < 4 * 64 * 2048; i += C.G * NTHR) { const int l = i >> 17, k = (i >> 11) & 63, col = i & 2047;
            w3t[((size_t)l * 2048 + col) * 128 + k] = (bf16_t)f2bf(w3[i]); w3t[((size_t)l * 2048 + col) * 128 + 64 + k] = (bf16_t)0; }
    }
    if (C.bid == C.G - 1) {
        const float* lb = C.in[IN_LB]; float* lower = WSP(float, WS_LOWER);
        for (int i = C.tid; i < 1024; i += NTHR) { const int d = i >> 9, c = i & 511; float v[4], mx = -3.4e38f, s = 0.f;
#pragma unroll
            for (int l = 0; l < 4; ++l) { v[l] = lb[(d * 4 + l) * 512 + c]; mx = fmaxf(mx, v[l]); }
#pragma unroll
            for (int l = 0; l < 4; ++l) { v[l] = expf(v[l] - mx); s += v[l]; }
            float cum = 0.f;
#pragma unroll
            for (int l = 0; l < 4; ++l) { if (l > 0) cum += v[l] / s; lower[(d * 4 + l) * 512 + c] = cum; } }
    }
}

__device__ __forceinline__ const float* xrow_src(const Ctx& C, int l, int row) {
    return l == 0 ? (row < NLAT ? C.in[IN_X] + (size_t)row * D : C.in[IN_CTX] + (size_t)(row - NLAT) * D) : WSP(const float, WS_XBUF) + (size_t)row * D;
}
__device__ __forceinline__ void transpose_item(const float* W, int K, int N, bf16_t* WT, LAS float* scr, int item, int lane) {
    const int nblk = N / 32, kb = item / nblk, nb = item % nblk, k0 = 64 * kb, n0 = 32 * nb;
    float wv[32];
#pragma unroll
    for (int i = 0; i < 32; ++i) wv[i] = W[(size_t)(k0 + 2 * i + (lane >> 5)) * N + n0 + (lane & 31)];
#pragma unroll
    for (int i = 0; i < 32; ++i) scr[(2 * i + (lane >> 5)) * 33 + (lane & 31)] = wv[i];
    LDS_WAIT(); asm volatile("" ::: "memory");
    const int c = lane & 7;
#pragma unroll
    for (int j = 0; j < 4; ++j) { const int n = (lane >> 3) + 8 * j; const LAS float* s = scr + (8 * c) * 33 + n;
        u32x4 o; o.x = pk2(s[0 * 33], s[1 * 33]); o.y = pk2(s[2 * 33], s[3 * 33]); o.z = pk2(s[4 * 33], s[5 * 33]); o.w = pk2(s[6 * 33], s[7 * 33]);
        *(u32x4*)(WT + (size_t)(n0 + n) * K + k0 + 8 * c) = o; }
    LDS_WAIT(); asm volatile("" ::: "memory");
}
__device__ __forceinline__ void phase_l1(const Ctx& C, int l) {
    const int gw = C.bid * NWAVES + C.wave, NGW = C.G * NWAVES;
    const float* mods = WSP(const float, WS_MODS) + (size_t)l * 9 * 6144;
    bf16_t* an = WSP(bf16_t, WS_R1);
    f32x4 nv[4];
    if (!(C.dry & 2)) {
    if (gw < NTOK) { const float* src = xrow_src(C, l, gw);
#pragma unroll
        for (int j = 0; j < 4; ++j) nv[j] = *(const f32x4*)(src + C.lane * 4 + 256 * j); }
    for (int row = gw; row < NTOK; row += NGW) {
        const float* md = mods + bidx(row) * 6144;
        f32x4 v[4]; float ss = 0.f;
#pragma unroll
        for (int j = 0; j < 4; ++j) v[j] = nv[j];
        if (row + NGW < NTOK) { const float* src = xrow_src(C, l, row + NGW);
#pragma unroll
            for (int j = 0; j < 4; ++j) nv[j] = *(const f32x4*)(src + C.lane * 4 + 256 * j); }
#pragma unroll
        for (int j = 0; j < 4; ++j) ss += (v[j].x * v[j].x + v[j].y * v[j].y) + (v[j].z * v[j].z + v[j].w * v[j].w);
        ss = wave_sum(ss); const float rinv = 1.0f / sqrtf(ss * (1.0f / D) + EPS);
#pragma unroll
        for (int j = 0; j < 4; ++j) { const int k = C.lane * 4 + 256 * j; const f32x4 sh = *(const f32x4*)(md + k), sc = *(const f32x4*)(md + 1024 + k);
            const f32x4 o = v[j] * rinv * (sc + 1.0f) + sh; u32x2 w; w.x = pk2(o.x, o.y); w.y = pk2(o.z, o.w);
            *(u32x2*)(an + (size_t)row * D + k) = w; }
    }
    }
    if (!(C.dry & 4)) {
        LAS float* scr = (LAS float*)(C.lds + C.wave * 16384);
        constexpr int I_IN = 16 * 128, I_OUT = 16 * 32, I_E = 128;
        constexpr int NIT = I_IN + I_OUT + 3 * 16 * I_E;
        for (int it = gw; it < NIT; it += NGW) {
            int r = it;
            if (r < I_IN) { transpose_item(C.in[IN_WIN] + (size_t)l * D * DIN, D, DIN, WSP(bf16_t, WS_WIN), scr, r, C.lane); continue; } r -= I_IN;
            if (r < I_OUT) { transpose_item(C.in[IN_WOUT] + (size_t)l * D * D, D, D, WSP(bf16_t, WS_WOUT), scr, r, C.lane); continue; } r -= I_OUT;
            if (r < 16 * I_E) { const int e = r / I_E; transpose_item(C.in[IN_WG] + ((size_t)l * NE + e) * D * DE, D, DE, WSP(bf16_t, WS_WG) + (size_t)e * DE * D, scr, r % I_E, C.lane); continue; } r -= 16 * I_E;
            if (r < 16 * I_E) { const int e = r / I_E; transpose_item(C.in[IN_WU] + ((size_t)l * NE + e) * D * DE, D, DE, WSP(bf16_t, WS_WU) + (size_t)e * DE * D, scr, r % I_E, C.lane); continue; } r -= 16 * I_E;
            { const int e = r / I_E; transpose_item(C.in[IN_WD] + ((size_t)l * NE + e) * DE * D, DE, D, WSP(bf16_t, WS_WD) + (size_t)e * D * DE, scr, r % I_E, C.lane); }
        }
    }
    __syncthreads();
    {
        LAS f32x2* T = (LAS f32x2*)C.lds;
        const int team = C.tid >> 7, tt = C.tid & 127;
        LAS f32x2* X = (LAS f32x2*)(C.lds + 16384) + team * XPAD16;
        LAS float* hbs = (LAS float*)(C.lds + 16384 + 4 * XPAD16 * 8) + team * 2048;
        LAS float* reds = (LAS float*)(C.lds + 16384 + 4 * XPAD16 * 8 + 32768);
        build_twiddles(C, T);
        __syncthreads();
        const bf16_t* hfl = WSP(const bf16_t, WS_HF) + (size_t)l * 2048 * 2304;
        f32x2* kspec = WSP(f32x2, WS_KSPEC);
        if (!(C.dry & 8))
        for (int item = C.bid; item < 256; item += C.G) {
            const int idx = item * 4 + team, o = idx >> 9, c = idx & 511;
            const int colf = o * 1024 + c, colb = colf + 512;
            const bf16_t* hfp = hfl + (size_t)colf * 2304; const bf16_t* hbp = hfl + (size_t)colb * 2304;
            float hf[16], hb[16], s = 0.f;
#pragma unroll
            for (int j = 0; j < 16; ++j) { const int t = tt + 128 * j; hf[j] = bf2f(hfp[t]); hb[j] = bf2f(hbp[t]); s += fabsf(hf[j]) + fabsf(hb[j]); }
            s = wave_sum(s);
            if (C.lane == 0) reds[C.wave] = s;
            __syncthreads();
            const float inv = 1.0f / ((reds[team * 2] + reds[team * 2 + 1]) * 4096.0f);
#pragma unroll
            for (int j = 0; j < 16; ++j) { hf[j] *= inv; hbs[tt + 128 * j] = hb[j] * inv; }
            __syncthreads();
            f32x2* kout = kspec + ((size_t)(o * 512 + c) * 2) * 2048;
            f32x2 vv[16];
#pragma unroll
            for (int j = 0; j < 16; ++j) { const int n = tt + 128 * j; const float kb = n > 0 ? hbs[2048 - n] : 0.f; vv[j] = (f32x2){hf[j] + kb, 0.f}; }
            fft_fwd_store16(vv, X, T, kout, tt);
#pragma unroll
            for (int j = 0; j < 16; ++j) { const int n = tt + 128 * j; const float kb = n > 0 ? hbs[2048 - n] : 0.f; const float dd = hf[j] - kb; const f32x2 tw = T[n]; vv[j] = (f32x2){dd * tw.x, dd * tw.y}; }
            fft_fwd_store16(vv, X, T, kout + 2048, tt);
        }
        if (l < DEPTH - 1 && !(C.dry & 16)) {
            f32x2* kspc = WSP(f32x2, WS_KSPC);
            for (int item = C.bid; item < 256; item += C.G) {
                const int idx = item * 4 + team, o = idx >> 9, c = idx & 511;
                const int colf = o * 1024 + c, colb = colf + 512;
                float af0 = bf2f(hfl[(size_t)colf * 2304 + 2048 + tt]), af1 = bf2f(hfl[(size_t)colf * 2304 + 2048 + 128 + tt]);
                float ab0 = bf2f(hfl[(size_t)colb * 2304 + 2048 + tt]), ab1 = bf2f(hfl[(size_t)colb * 2304 + 2048 + 128 + tt]);
                __syncthreads();
                const float s = wave_sum((fabsf(af0) + fabsf(af1)) + (fabsf(ab0) + fabsf(ab1)));
                if (C.lane == 0) reds[C.wave] = s;
                __syncthreads();
                const float inv = 1.0f / ((reds[team * 2] + reds[team * 2 + 1]) * 2048.0f);
                af0 *= inv; af1 *= inv; hbs[tt] = ab0 * inv; hbs[128 + tt] = ab1 * inv;
                __syncthreads();
                f32x2 vk[16];
#pragma unroll
                for (int j = 0; j < 16; ++j) vk[j] = (f32x2){0.f, 0.f};
                vk[0] = (f32x2){af0, 0.f}; vk[1] = (f32x2){af1, 0.f};
                vk[14] = (f32x2){tt > 0 ? hbs[256 - tt] : 0.f, 0.f};
                vk[15] = (f32x2){hbs[128 - tt], 0.f};
                fft_fwd_store16(vk, X, T, kspc + (size_t)(o * 512 + c) * 2048, tt);
            }
        }
    }
}

__device__ __forceinline__ float shortconv(const LAS bf16_t* raw, int t, int mask, int tmax, float w0, float w1, float w2, float bias) {
    const float pm = ((t & mask) != 0) ? bf2f(raw[t - 1]) : 0.f;
    const float pc = bf2f(raw[t]);
    const float pp = ((t & mask) != mask && t < tmax) ? bf2f(raw[t + 1]) : 0.f;
    return w0 * pm + w1 * pc + w2 * pp + bias;
}
constexpr int HY_CH = 4, HY_ITEMS = 4 * (512 / HY_CH), HYC_ITEMS = 512 / 4;
__device__ __forceinline__ void hyena_lat(const Ctx& C, int l, int item) {
    const int bp = item & 3, cg = item >> 2, team = C.tid >> 7, tt = C.tid & 127;
    LAS f32x2* T = (LAS f32x2*)C.lds;
    LAS f32x2* X = (LAS f32x2*)(C.lds + 16384) + team * XPAD16;
    LAS bf16_t* raw = (LAS bf16_t*)(C.lds + 16384 + 4 * XPAD16 * 8) + team * 4096;
    const bf16_t* phyt = WSP(const bf16_t, WS_PHYT);
    const float* cw = C.in[IN_CONVW] + (size_t)l * 3 * NHY; const float* cb = C.in[IN_CONVB] + (size_t)l * NHY;
    const float* hyb = C.in[IN_HYBIAS] + (size_t)l * 2 * DH;
    const f32x2* kspec = WSP(const f32x2, WS_KSPEC);
    const int ba = 2 * bp, c = cg * 4 + team;
    f32x2 z[16], acc[16], v[16];
#pragma unroll 1
    for (int stage = 0; stage < 3; ++stage) {
        const int ch = stage * 512 + c;
        __syncthreads();
#pragma unroll
        for (int k = 0; k < 4; ++k) { const int q = tt + 128 * k, rr = q >> 8, cc = q & 255;
            *(LAS u32x4*)(raw + rr * 2048 + cc * 8) = *(const u32x4*)(phyt + (size_t)ch * NTOK + (size_t)(ba + rr) * 2048 + cc * 8); }
        __syncthreads();
        const float w0 = cw[ch], w1 = cw[NHY + ch], w2 = cw[2 * NHY + ch], bs = cb[ch];
        if (stage == 0) {
#pragma unroll
            for (int j = 0; j < 16; ++j) { const int t = tt + 128 * j; z[j] = (f32x2){shortconv(raw, t, 63, 4096, w0, w1, w2, bs), shortconv(raw + 2048, t, 63, 4096, w0, w1, w2, bs)}; }
        } else {
            const float dsk = hyb[(stage - 1) * DH + c];
#pragma unroll
            for (int j = 0; j < 16; ++j) { const int t = tt + 128 * j; const f32x2 cv = acc[j] + z[j] * dsk;
                z[j] = (f32x2){shortconv(raw, t, 63, 4096, w0, w1, w2, bs) * cv.x, shortconv(raw + 2048, t, 63, 4096, w0, w1, w2, bs) * cv.y}; }
        }
        if (stage == 2) {
            LAS bf16_t* ob = (LAS bf16_t*)X;
#pragma unroll
            for (int j = 0; j < 16; ++j) { const int t = tt + 128 * j; ob[t] = (bf16_t)f2bf(z[j].x); ob[2048 + t] = (bf16_t)f2bf(z[j].y); }
            break;
        }
        const f32x2* K = kspec + ((size_t)(stage * 512 + c) * 2) * 2048;
#pragma unroll
        for (int j = 0; j < 16; ++j) v[j] = z[j];
        fft_conv_half16(v, X, T, K, tt);
#pragma unroll
        for (int j = 0; j < 16; ++j) acc[j] = v[j];
#pragma unroll
        for (int j = 0; j < 16; ++j) v[j] = cmul(z[j], T[tt + 128 * j]);
        fft_conv_half16(v, X, T, K + 2048, tt);
#pragma unroll
        for (int j = 0; j < 16; ++j) acc[j] += cmulc(v[j], T[tt + 128 * j]);
    }
    __syncthreads();
    bf16_t* Y = WSP(bf16_t, WS_R1);
    for (int i = C.tid; i < 4096; i += NTHR) { const int b = i >> 11, t = i & 2047;
        const LAS bf16_t* o0 = (const LAS bf16_t*)((LAS f32x2*)(C.lds + 16384)) + i;
        u32x2 w; w.x = (unsigned)o0[0] | ((unsigned)o0[XPAD16 * 4] << 16); w.y = (unsigned)o0[2 * XPAD16 * 4] | ((unsigned)o0[3 * XPAD16 * 4] << 16);
        *(u32x2*)(Y + ((size_t)(ba + b) * 2048 + t) * D + cg * 4) = w; }
    __syncthreads();
}
__device__ __forceinline__ void hyena_ctx2(const Ctx& C, int l, int item) {
    const int team = C.tid >> 7, tt = C.tid & 127, c = item * 4 + team;
    LAS f32x2* T = (LAS f32x2*)C.lds;
    LAS f32x2* X = (LAS f32x2*)(C.lds + 16384) + team * XPAD16;
    LAS bf16_t* raw = (LAS bf16_t*)(C.lds + 16384 + 4 * XPAD16 * 8) + team * 4096;
    const bf16_t* phyt = WSP(const bf16_t, WS_PHYT);
    const float* cw = C.in[IN_CONVW] + (size_t)l * 3 * NHY; const float* cb = C.in[IN_CONVB] + (size_t)l * NHY;
    const float* hyb = C.in[IN_HYBIAS] + (size_t)l * 2 * DH;
    const f32x2* kspc = WSP(const f32x2, WS_KSPC);
    bf16_t* Y = WSP(bf16_t, WS_R1);
    f32x2 z[16], v[16];
#pragma unroll
    for (int j = 0; j < 16; ++j) { z[j] = (f32x2){0.f, 0.f}; v[j] = (f32x2){0.f, 0.f}; }
#pragma unroll 1
    for (int stage = 0; stage < 3; ++stage) {
        const int ch = stage * 512 + c;
        __syncthreads();
#pragma unroll
        for (int k = 0; k < 2; ++k) { const int q = tt + 128 * k; *(LAS u32x4*)(raw + q * 8) = *(const u32x4*)(phyt + (size_t)ch * NTOK + NLAT + q * 8); }
        __syncthreads();
        const float w0 = cw[ch], w1 = cw[NHY + ch], w2 = cw[2 * NHY + ch], bs = cb[ch];
        const float dsk = stage > 0 ? hyb[(stage - 1) * DH + c] : 0.f;
#pragma unroll
        for (int p = 0; p < 4; ++p)
#pragma unroll
            for (int hh = 0; hh < 2; ++hh) { const int m = 4 * p + hh, tok = hh * 128 + tt;
                const float ua = shortconv(raw, (2 * p) * 256 + tok, 255, 4096, w0, w1, w2, bs), ub = shortconv(raw, (2 * p + 1) * 256 + tok, 255, 4096, w0, w1, w2, bs);
                if (stage == 0) z[m] = (f32x2){ua, ub};
                else { const f32x2 cv = v[m] + z[m] * dsk; z[m] = (f32x2){ua * cv.x, ub * cv.y}; } }
        if (stage == 2) {
#pragma unroll
            for (int p = 0; p < 4; ++p)
#pragma unroll
                for (int hh = 0; hh < 2; ++hh) { const int m = 4 * p + hh, tok = hh * 128 + tt;
                    Y[(size_t)(NLAT + (2 * p) * 256 + tok) * D + c] = (bf16_t)f2bf(z[m].x); Y[(size_t)(NLAT + (2 * p + 1) * 256 + tok) * D + c] = (bf16_t)f2bf(z[m].y); }
            break;
        }
#pragma unroll
        for (int j = 0; j < 16; ++j) v[j] = z[j];
        fft_conv_half16(v, X, T, kspc + (size_t)(stage * 512 + c) * 2048, tt);
    }
}

constexpr int HG_QT = 0, HG_QP = 17408, HG_KP = 34816, HG_ST = 52224, HG_VT = 87040, HG_KH = 105472, HG_P = 123904, HG_SUB = 133120, HG_D = 135168;
__device__ __forceinline__ void hgrn_mfma(const Ctx& C, int item) {
    const int dir = item & 1, h = (item >> 1) & 3, b = item >> 3;
    LAS unsigned char* L = C.lds;
    const int lane = C.lane, w = C.wave, r = lane & 15, quad = lane >> 4;
    const int I = w >> 1, col = (w & 1) * 64 + lane;
    const bf16_t* phg = WSP(const bf16_t, WS_PHG);
    bf16_t* odir = WSP(bf16_t, WS_ODIR) + (size_t)dir * NTOK * 512;
    LAS float* subtot = (LAS float*)(L + HG_SUB); LAS float* Dv = (LAS float*)(L + HG_D);
    __syncthreads();
    unsigned z0_ = 0u; asm volatile("" : "+v"(z0_));
    const u32x4 zv_ = (u32x4){z0_, z0_, z0_, z0_}; const float zff_ = __builtin_bit_cast(float, z0_); const f32x4 zv4f_ = (f32x4){zff_, zff_, zff_, zff_};
    for (int i = C.tid; i < (128 * 272) / 16; i += NTHR) *(LAS u32x4*)(L + HG_ST + i * 16) = zv_;
    for (int i = C.tid; i < (64 * 144) / 16; i += NTHR) *(LAS u32x4*)(L + HG_P + i * 16) = zv_;
    f32x4 sacc[8];
#pragma unroll
    for (int t = 0; t < 8; ++t) sacc[t] = zv4f_;
    unsigned short qr[16], kr[16], vr[16];
    const int rstep = dir ? -1 : 1;
    const size_t colq = (size_t)h * 128 + col, colk = 1536 + (size_t)dir * 512 + h * 128 + col, colv = 512 + (size_t)h * 128 + col;
    auto chunk_row0 = [&](int ch) -> int { return ch < 4 ? NLAT + b * 256 + (dir ? 255 - ch * 64 : ch * 64) : b * 2048 + (dir ? 2047 - (ch - 4) * 64 : (ch - 4) * 64); };
    { const int row0 = chunk_row0(0) + rstep * 16 * I;
#pragma unroll
      for (int i = 0; i < 16; ++i) { const bf16_t* p = phg + (size_t)(row0 + rstep * i) * NHG; qr[i] = p[colq]; kr[i] = p[colk]; vr[i] = p[colv]; } }
    __syncthreads();
#pragma unroll 1
    for (int ch = 0; ch < 36; ++ch) {
        float cp[16]; float cq = 1.0f;
#pragma unroll
        for (int i = 0; i < 16; ++i) { cq *= 1.0f - bf2f(kr[i]); cp[i] = cq; }
        subtot[I * 128 + col] = cq;
        __syncthreads();
        const float s0 = subtot[col], s1 = subtot[128 + col], s2 = subtot[256 + col], s3 = subtot[384 + col];
        const float pre = (I > 0 ? s0 : 1.0f) * (I > 1 ? s1 : 1.0f) * (I > 2 ? s2 : 1.0f), erho = s0 * s1, eend = s2 * s3;
        const float ainv = pre * __builtin_amdgcn_rcpf(erho);
        unsigned khp[8], vtp[8];
#pragma unroll
        for (int i = 0; i < 16; i += 2) {
            const float e1a = cp[i] * ainv, e1b = cp[i + 1] * ainv, e2a = __builtin_amdgcn_rcpf(e1a), e2b = __builtin_amdgcn_rcpf(e1b);
            const float qpa = bf2f(qr[i]) * e1a, qpb = bf2f(qr[i + 1]) * e1b, kpa = bf2f(kr[i]) * e2a, kpb = bf2f(kr[i + 1]) * e2b;
            const unsigned wqp = pk2(qpa, qpb), wqt = pk2(qpa * erho, qpb * erho), wkp = pk2(kpa, kpb);
            const int srow = (16 * I + i) * 272 + col * 2;
            *(LAS bf16_t*)(L + HG_QP + srow) = (bf16_t)(wqp & 0xffffu); *(LAS bf16_t*)(L + HG_QP + srow + 272) = (bf16_t)(wqp >> 16);
            *(LAS bf16_t*)(L + HG_QT + srow) = (bf16_t)(wqt & 0xffffu); *(LAS bf16_t*)(L + HG_QT + srow + 272) = (bf16_t)(wqt >> 16);
            *(LAS bf16_t*)(L + HG_KP + srow) = (bf16_t)(wkp & 0xffffu); *(LAS bf16_t*)(L + HG_KP + srow + 272) = (bf16_t)(wkp >> 16);
            khp[i >> 1] = pk2(kpa * eend, kpb * eend);
            vtp[i >> 1] = (unsigned)vr[i] | ((unsigned)vr[i + 1] << 16);
        }
        *(LAS u32x4*)(L + HG_KH + col * 144 + I * 32) = (u32x4){khp[0], khp[1], khp[2], khp[3]};
        *(LAS u32x4*)(L + HG_KH + col * 144 + I * 32 + 16) = (u32x4){khp[4], khp[5], khp[6], khp[7]};
        *(LAS u32x4*)(L + HG_VT + col * 144 + I * 32) = (u32x4){vtp[0], vtp[1], vtp[2], vtp[3]};
        *(LAS u32x4*)(L + HG_VT + col * 144 + I * 32 + 16) = (u32x4){vtp[4], vtp[5], vtp[6], vtp[7]};
        if (I == 0) Dv[col] = erho * eend;
        const int crow0 = chunk_row0(ch);
        if (ch + 1 < 36) { const int row0 = chunk_row0(ch + 1) + rstep * 16 * I;
#pragma unroll
            for (int i = 0; i < 16; ++i) { const bf16_t* p = phg + (size_t)(row0 + rstep * i) * NHG; qr[i] = p[colq]; kr[i] = p[colk]; vr[i] = p[colv]; } }
        __syncthreads();
#pragma unroll 1
        for (int blk = w; blk < 10; blk += 8) {
            const int I2 = blk < 1 ? 0 : (blk < 3 ? 1 : (blk < 6 ? 2 : 3)), J2 = blk - (I2 * (I2 + 1)) / 2;
            f32x4 pa = zv4f_;
#pragma unroll
            for (int kk = 0; kk < 4; ++kk) {
                const bf16x8 a = *(const LAS bf16x8*)(L + HG_KP + (J2 * 16 + r) * 272 + (32 * kk + 8 * quad) * 2);
                const bf16x8 bq = *(const LAS bf16x8*)(L + HG_QP + (I2 * 16 + r) * 272 + (32 * kk + 8 * quad) * 2);
                pa = __builtin_amdgcn_mfma_f32_16x16x32_bf16(a, bq, pa, 0, 0, 0);
            }
            if (I2 == J2) {
#pragma unroll
                for (int rr = 0; rr < 4; ++rr) if (4 * quad + rr > r) pa[rr] = 0.f;
            }
            u32x2 pw; pw.x = pk2(pa[0], pa[1]); pw.y = pk2(pa[2], pa[3]);
            *(LAS u32x2*)(L + HG_P + (I2 * 16 + r) * 144 + (J2 * 16 + 4 * quad) * 2) = pw;
        }
        __syncthreads();
        {
            bf16x8 sfr[4];
#pragma unroll
            for (int kk = 0; kk < 4; ++kk) sfr[kk] = *(const LAS bf16x8*)(L + HG_ST + (16 * w + r) * 272 + (32 * kk + 8 * quad) * 2);
            const bf16x8 vf0 = *(const LAS bf16x8*)(L + HG_VT + (16 * w + r) * 144 + (8 * quad) * 2);
            const bf16x8 vf1 = *(const LAS bf16x8*)(L + HG_VT + (16 * w + r) * 144 + (32 + 8 * quad) * 2);
#pragma unroll
            for (int I3 = 0; I3 < 4; ++I3) {
                f32x4 oa = zv4f_;
#pragma unroll
                for (int kk = 0; kk < 4; ++kk) {
                    const bf16x8 bq = *(const LAS bf16x8*)(L + HG_QT + (I3 * 16 + r) * 272 + (32 * kk + 8 * quad) * 2);
                    oa = __builtin_amdgcn_mfma_f32_16x16x32_bf16(sfr[kk], bq, oa, 0, 0, 0);
                }
                { const bf16x8 bp = *(const LAS bf16x8*)(L + HG_P + (I3 * 16 + r) * 144 + (8 * quad) * 2);
                  oa = __builtin_amdgcn_mfma_f32_16x16x32_bf16(vf0, bp, oa, 0, 0, 0); }
                if (I3 >= 2) { const bf16x8 bp = *(const LAS bf16x8*)(L + HG_P + (I3 * 16 + r) * 144 + (32 + 8 * quad) * 2);
                  oa = __builtin_amdgcn_mfma_f32_16x16x32_bf16(vf1, bp, oa, 0, 0, 0); }
                const int row = crow0 + rstep * (16 * I3 + r);
                u32x2 ow; ow.x = pk2(oa[0], oa[1]); ow.y = pk2(oa[2], oa[3]);
                *(u32x2*)(odir + (size_t)row * 512 + h * 128 + 16 * w + 4 * quad) = ow;
            }
#pragma unroll
            for (int t = 0; t < 8; ++t) {
                const f32x4 dd = *(const LAS f32x4*)(L + HG_D + (16 * t + 4 * quad) * 4);
                f32x4 sa = sacc[t] * dd;
                const bf16x8 a0 = *(const LAS bf16x8*)(L + HG_KH + (16 * t + r) * 144 + (8 * quad) * 2);
                const bf16x8 a1 = *(const LAS bf16x8*)(L + HG_KH + (16 * t + r) * 144 + (32 + 8 * quad) * 2);
                sa = __builtin_amdgcn_mfma_f32_16x16x32_bf16(a0, vf0, sa, 0, 0, 0);
                sa = __builtin_amdgcn_mfma_f32_16x16x32_bf16(a1, vf1, sa, 0, 0, 0);
                sacc[t] = sa;
                u32x2 sw; sw.x = pk2(sa[0], sa[1]); sw.y = pk2(sa[2], sa[3]);
                *(LAS u32x2*)(L + HG_ST + (16 * w + r) * 272 + (16 * t + 4 * quad) * 2) = sw;
            }
        }
    }
    __syncthreads();
}
__device__ __forceinline__ void phase_l3(const Ctx& C, int l) {
    if (C.bid < 64) hgrn_mfma(C, C.bid);
    build_twiddles(C, (LAS f32x2*)C.lds);
    __syncthreads();
    unsigned* qh = WSP(unsigned, WS_CTL) + CW_Q + l * 64 + C.rep * 16;
    volatile LAS int* lc = (volatile LAS int*)(C.lds + LDSCTL_OFF);
    const int nitems = HY_ITEMS + (l < DEPTH - 1 ? HYC_ITEMS : 0);
    for (;;) {
        if (C.tid == 0) lc[LC_Q] = (int)__hip_atomic_fetch_add(qh, 1u, __ATOMIC_RELAXED, __HIP_MEMORY_SCOPE_AGENT);
        __syncthreads();
        const int item = lc[LC_Q];
        __syncthreads();
        if (item >= nitems) break;
        Ctx CI = C; { int t_ = C.tid; asm volatile("" : "+v"(t_)); CI.tid = t_; CI.lane = t_ & 63; }
        if (item < HY_ITEMS) hyena_lat(CI, l, item); else hyena_ctx2(CI, l, item - HY_ITEMS);
    }
}
__device__ __forceinline__ void phase_l3b(const Ctx& C, int l) {
    const int gw = C.bid * NWAVES + C.wave, NGW = C.G * NWAVES;
    const bf16_t* od0 = WSP(const bf16_t, WS_ODIR); const bf16_t* od1 = od0 + (size_t)NTOK * 512;
    const bf16_t* phg = WSP(const bf16_t, WS_PHG); bf16_t* Y = WSP(bf16_t, WS_R1);
    const float* nw = C.in[IN_NORMW] + l * 128;
    const int nrows = (l < DEPTH - 1) ? NTOK : NLAT;
    for (int row = gw; row < nrows; row += NGW) {
        const int idx = C.lane * 8;
        const u32x4 a = *(const u32x4*)(od0 + (size_t)row * 512 + idx), b = *(const u32x4*)(od1 + (size_t)row * 512 + idx), g = *(const u32x4*)(phg + (size_t)row * NHG + 1024 + idx);
        float o[8] = {bflo(a.x) + bflo(b.x), bfhi(a.x) + bfhi(b.x), bflo(a.y) + bflo(b.y), bfhi(a.y) + bfhi(b.y), bflo(a.z) + bflo(b.z), bfhi(a.z) + bfhi(b.z), bflo(a.w) + bflo(b.w), bfhi(a.w) + bfhi(b.w)};
        const float gg[8] = {bflo(g.x), bfhi(g.x), bflo(g.y), bfhi(g.y), bflo(g.z), bfhi(g.z), bflo(g.w), bfhi(g.w)};
        float ss = 0.f;
#pragma unroll
        for (int i = 0; i < 8; ++i) ss += o[i] * o[i];
        ss = row16_sum(ss);
        const float rinv = 1.0f / sqrtf(ss * (1.0f / 128.0f) + EPS);
        float y[8];
#pragma unroll
        for (int i = 0; i < 8; ++i) y[i] = o[i] * rinv * nw[(idx + i) & 127] * siluf_(gg[i]);
        u32x4 w; w.x = pk2(y[0], y[1]); w.y = pk2(y[2], y[3]); w.z = pk2(y[4], y[5]); w.w = pk2(y[6], y[7]);
        *(u32x4*)(Y + (size_t)row * D + 512 + idx) = w;
    }
}

constexpr int RW_PITCH = 1028;
__device__ __forceinline__ void phase_l5a(const Ctx& C, int l) {
    LAS float* rwT = (LAS float*)C.lds;
    LAS int* lcnt = (LAS int*)(C.lds + 16 * RW_PITCH * 4);
    LAS float* wsc = (LAS float*)(C.lds + 16 * RW_PITCH * 4 + 128) + C.wave * 384;
    const float* rw = C.in[IN_RW];
    for (int i = C.tid; i < 16 * 1024; i += NTHR) { const int k = i >> 4, e = i & 15; rwT[e * RW_PITCH + k] = rw[i]; }
    if (C.tid < 32) lcnt[C.tid] = 0;
    __syncthreads();
    const int gw = C.bid * NWAVES + C.wave, NGW = C.G * NWAVES;
    const float* mods = WSP(const float, WS_MODS) + (size_t)l * 9 * 6144;
    const float* bias2 = WSP(const float, WS_BIAS2) + l * 9 * 16;
    const float* xb = WSP(const float, WS_XBUF);
    const float* rbias = C.in[IN_RB];
    unsigned* cnt = WSP(unsigned, WS_CTL) + CW_CNT + l * 32 * 64;
    int* tokinfo = WSP(int, WS_TOKINFO);
    const int ngroups = ((l < DEPTH - 1) ? NTOK : NLAT) / 16;
    const int li = C.lane & 15, kq = C.lane >> 4;
    for (int g = gw; g < ngroups; g += NGW) {
        const int row0 = g * 16, bb = bidx(row0);
        const float* xp = xb + (size_t)(row0 + li) * D + kq * 4;
        const float* scp = mods + bb * 6144 + 4096 + kq * 4;
        const LAS float* bp = rwT + li * RW_PITCH + kq * 4;
        f32x4 acc0 = (f32x4){0.f, 0.f, 0.f, 0.f}, acc1 = acc0, acc2 = acc0, acc3 = acc0; float ss = 0.f;
#pragma unroll 8
        for (int m = 0; m < 64; ++m) {
            const f32x4 xv = *(const f32x4*)(xp + 16 * m), sc = *(const f32x4*)(scp + 16 * m), bv = *(const LAS f32x4*)(bp + 16 * m);
            ss += (xv.x * xv.x + xv.y * xv.y) + (xv.z * xv.z + xv.w * xv.w);
            const f32x4 av = xv * (sc + 1.0f);
            acc0 = __builtin_amdgcn_mfma_f32_16x16x4f32(av.x, bv.x, acc0, 0, 0, 0);
            acc1 = __builtin_amdgcn_mfma_f32_16x16x4f32(av.y, bv.y, acc1, 0, 0, 0);
            acc2 = __builtin_amdgcn_mfma_f32_16x16x4f32(av.z, bv.z, acc2, 0, 0, 0);
            acc3 = __builtin_amdgcn_mfma_f32_16x16x4f32(av.w, bv.w, acc3, 0, 0, 0);
        }
        const f32x4 acc = (acc0 + acc1) + (acc2 + acc3);
        wsc[C.lane] = ss;
#pragma unroll
        for (int r = 0; r < 4; ++r) wsc[64 + (4 * kq + r) * 17 + li] = acc[r];
        LDS_WAIT(); asm volatile("" ::: "memory");
        if (C.lane < 16) {
            const int row = row0 + C.lane;
            const float sst = (wsc[C.lane] + wsc[16 + C.lane]) + (wsc[32 + C.lane] + wsc[48 + C.lane]);
            const float rinv = 1.0f / sqrtf(sst * (1.0f / D) + EPS);
            float lg[16];
#pragma unroll
            for (int e = 0; e < 16; ++e) lg[e] = rinv * wsc[64 + C.lane * 17 + e] + bias2[bb * 16 + e];
            float mx = lg[0];
#pragma unroll
            for (int e = 1; e < 16; ++e) mx = fmaxf(mx, lg[e]);
            float sc[16], se = 0.f;
#pragma unroll
            for (int e = 0; e < 16; ++e) { sc[e] = expf(lg[e] - mx); se += sc[e]; }
            float sel[16];
#pragma unroll
            for (int e = 0; e < 16; ++e) { sc[e] = sc[e] / se; sel[e] = sc[e] + rbias[e]; }
            float bestgs = -3.4e38f; int bg = 0; float bs[4], bsc[4];
#pragma unroll
            for (int gg = 0; gg < 4; ++gg) {
                float m1 = -3.4e38f, m2 = -3.4e38f;
#pragma unroll
                for (int i = 0; i < 4; ++i) { const float x = sel[4 * gg + i]; if (x > m1) { m2 = m1; m1 = x; } else if (x > m2) m2 = x; }
                const float gs = m1 + m2;
                if (gs > bestgs) { bestgs = gs; bg = gg;
#pragma unroll
                    for (int i = 0; i < 4; ++i) { bs[i] = sel[4 * gg + i]; bsc[i] = sc[4 * gg + i]; } }
            }
            int i0 = 0; float b0 = bs[0];
#pragma unroll
            for (int i = 1; i < 4; ++i) if (bs[i] > b0) { b0 = bs[i]; i0 = i; }
            int i1 = -1; float b1 = -3.4e38f;
#pragma unroll
            for (int i = 0; i < 4; ++i) if (i != i0 && bs[i] > b1) { b1 = bs[i]; i1 = i; }
            float w0 = 0.f, w1 = 0.f;
#pragma unroll
            for (int i = 0; i < 4; ++i) { if (i == i0) w0 = bsc[i]; if (i == i1) w1 = bsc[i]; }
            const float wn = w0 + w1; w0 /= wn; w1 /= wn;
            const int lo = i0 < i1 ? i0 : i1, hi = i0 < i1 ? i1 : i0;
            const float wlo = i0 < i1 ? w0 : w1, whi = i0 < i1 ? w1 : w0;
            const int bin = bg * 6 + (lo * (7 - lo)) / 2 + (hi - lo - 1);
            const int slot = __hip_atomic_fetch_add(lcnt + bin, 1, __ATOMIC_RELAXED, __HIP_MEMORY_SCOPE_WORKGROUP);
            *(int4*)(tokinfo + (size_t)row * 4) = make_int4(bin, slot, __float_as_int(wlo), __float_as_int(whi));
        }
        LDS_WAIT(); asm volatile("" ::: "memory");
    }
    __syncthreads();
    if (C.tid < NBIN && !C.dry) { const int n = lcnt[C.tid];
        WSP(int, WS_BLKBASE)[C.bid * 32 + C.tid] = n > 0 ? (int)__hip_atomic_fetch_add(cnt + C.tid * 64, (unsigned)n, __ATOMIC_RELAXED, __HIP_MEMORY_SCOPE_AGENT) : 0; }
}
__device__ __forceinline__ void phase_l5b(const Ctx& C, int l) {
    build_tiletab(C, l);
    const volatile LAS int* lc = (const volatile LAS int*)(C.lds + LDSCTL_OFF);
    const int gw = C.bid * NWAVES + C.wave, NGW = C.G * NWAVES;
    const float* mods = WSP(const float, WS_MODS) + (size_t)l * 9 * 6144;
    const float* xb = WSP(const float, WS_XBUF);
    const int* tokinfo = WSP(const int, WS_TOKINFO); const int* blkbase = WSP(const int, WS_BLKBASE);
    bf16_t* hs = WSP(bf16_t, WS_PHG); int* rowtok = WSP(int, WS_ROWTOK); float* roww = WSP(float, WS_ROWW);
    const int nrows = (l < DEPTH - 1) ? NTOK : NLAT;
    f32x4 nv[4]; int4 nti = make_int4(0, 0, 0, 0);
    if (gw < nrows) { nti = *(const int4*)(tokinfo + (size_t)gw * 4);
#pragma unroll
        for (int j = 0; j < 4; ++j) nv[j] = *(const f32x4*)(xb + (size_t)gw * D + C.lane * 4 + 256 * j); }
    for (int row = gw; row < nrows; row += NGW) {
        const int4 ti = nti;
        const int pos = lc[LC_OFFS + ti.x] + blkbase[(((row >> 4) % NGW) >> 3) * 32 + ti.x] + ti.y;
        const float* md = mods + bidx(row) * 6144;
        f32x4 v[4]; float ss = 0.f;
#pragma unroll
        for (int j = 0; j < 4; ++j) v[j] = nv[j];
        if (row + NGW < nrows) { nti = *(const int4*)(tokinfo + (size_t)(row + NGW) * 4);
#pragma unroll
            for (int j = 0; j < 4; ++j) nv[j] = *(const f32x4*)(xb + (size_t)(row + NGW) * D + C.lane * 4 + 256 * j); }
#pragma unroll
        for (int j = 0; j < 4; ++j) ss += (v[j].x * v[j].x + v[j].y * v[j].y) + (v[j].z * v[j].z + v[j].w * v[j].w);
        ss = wave_sum(ss); const float rinv = 1.0f / sqrtf(ss * (1.0f / D) + EPS);
#pragma unroll
        for (int j = 0; j < 4; ++j) { const int k = C.lane * 4 + 256 * j; const f32x4 sh = *(const f32x4*)(md + 3072 + k), sc = *(const f32x4*)(md + 4096 + k);
            const f32x4 o = v[j] * rinv * (sc + 1.0f) + sh; u32x2 w; w.x = pk2(o.x, o.y); w.y = pk2(o.z, o.w);
            *(u32x2*)(hs + (size_t)pos * D + k) = w; }
        if (C.lane == 0) { rowtok[pos] = row; roww[pos * 2] = __int_as_float(ti.z); roww[pos * 2 + 1] = __int_as_float(ti.w); }
    }
    if (C.bid < NBIN) { const int b = C.bid; const int start = lc[LC_OFFS + b], end = lc[LC_OFFS + b + 1];
        const int n = (int)__hip_atomic_load(WSP(unsigned, WS_CTL) + CW_CNT + (l * 32 + b) * 64, __ATOMIC_RELAXED, __HIP_MEMORY_SCOPE_AGENT);
        float zf_ = 0.f; asm volatile("" : "+v"(zf_));
        for (int p = start + n + C.tid; p < end; p += NTHR) { rowtok[p] = -1; roww[p * 2] = zf_; roww[p * 2 + 1] = zf_; } }
}

__device__ __forceinline__ void phase_final(const Ctx& C) {
    const int gw = C.bid * NWAVES + C.wave, NGW = C.G * NWAVES;
    const float* xb = WSP(const float, WS_XBUF); const float* fw = C.in[IN_FNW];
    f32x4 nv[4];
    if (gw < NLAT) {
#pragma unroll
        for (int j = 0; j < 4; ++j) nv[j] = *(const f32x4*)(xb + (size_t)gw * D + C.lane * 4 + 256 * j); }
    for (int row = gw; row < NLAT; row += NGW) {
        f32x4 v[4]; float ss = 0.f;
#pragma unroll
        for (int j = 0; j < 4; ++j) v[j] = nv[j];
        if (row + NGW < NLAT) {
#pragma unroll
            for (int j = 0; j < 4; ++j) nv[j] = *(const f32x4*)(xb + (size_t)(row + NGW) * D + C.lane * 4 + 256 * j); }
#pragma unroll
        for (int j = 0; j < 4; ++j) ss += (v[j].x * v[j].x + v[j].y * v[j].y) + (v[j].z * v[j].z + v[j].w * v[j].w);
        ss = wave_sum(ss); const float rinv = 1.0f / sqrtf(ss * (1.0f / D) + EPS);
#pragma unroll
        for (int j = 0; j < 4; ++j) { const int k = C.lane * 4 + 256 * j; const f32x4 w = *(const f32x4*)(fw + k);
            *(f32x4*)(C.out + (size_t)row * D + k) = v[j] * rinv * w; }
    }
}

constexpr int PH_PER_LAYER = 8, N_PHASES = 2 + DEPTH * PH_PER_LAYER + 1;
__global__ void __launch_bounds__(NTHR, 2) trunk_fwd(Args args) {
    extern __shared__ __attribute__((aligned(16))) unsigned char lds[];
    Ctx C; C.in = (const CAS fptr_t*)__builtin_amdgcn_kernarg_segment_ptr(); C.out = args.out; C.ws = args.ws; C.lds = (LAS unsigned char*)lds;
    C.tid = threadIdx.x; C.lane = C.tid & 63; C.wave = __builtin_amdgcn_readfirstlane(C.tid >> 6); C.G = gridDim.x; C.bid = blockIdx.x; C.rep = args.rep; C.dry = (args.rep + 1 < (args.pad & 255)) ? (args.pad >> 8) : 0;
    LAS unsigned char* ldsl0 = (LAS unsigned char*)lds;
    if (C.tid < 64) ((LAS unsigned*)(ldsl0 + LDSCTL_OFF))[C.tid] = 0u;
    __syncthreads();
    const int lo = args.ph_lo, hi = args.ph_hi;
    XcdBarrier bar; bar.bar = WSP(unsigned, WS_CTL) + CW_BAR; bar.x = 0; bar.st = (volatile LAS unsigned*)(ldsl0 + LDSCTL_OFF + LC_BAR);
    if (hi - lo > 1) bar = xcd_barrier_post(WSP(unsigned, WS_CTL) + CW_BAR, (volatile LAS unsigned*)(ldsl0 + LDSCTL_OFF + LC_BAR));
#define FRESH_TID (C.wave * 64 + lane_id_opaque())
#define IN(k) (lo <= (k) && (k) < hi)
#define SEAM(k) do { if (IN(k) && IN((k) + 1)) xcd_barrier(bar, FRESH_TID); } while (0)
#ifndef EN
#define EN 0xFFFF
#endif
    if ((EN & 1) && IN(0)) { phase0(C); SEAM(0); }
    if ((EN & 1) && IN(1)) {
        {
            const float* md = WSP(const float, WS_MODS); const float* rw = C.in[IN_RW]; float* b2 = WSP(float, WS_BIAS2);
            for (int o = C.bid * NWAVES + C.wave; o < 4 * 9 * 16; o += C.G * NWAVES) { const int lr = o >> 4, e = o & 15; const float* sh = md + (size_t)lr * 6144 + 3072; float sacc = 0.f;
#pragma unroll
                for (int j = 0; j < 16; ++j) { const int k = C.lane + 64 * j; sacc += sh[k] * rw[k * 16 + e]; }
                sacc = wave_sum(sacc);
                if (C.lane == 0) b2[o] = sacc; }
        }
        SchedFilt S{C.G, C.bid};
        EpiFilt E{WSP(bf16_t, WS_HF), C.in[IN_B3]};
        pg8::gemm_phase<false>(ldsl0, S, E, (const char*)WSP(bf16_t, WS_W3T), (const char*)WSP(bf16_t, WS_HPAD), 128, 128, 128u * 128u * 2u, 128u * 128u * 2u, 2, FRESH_TID);
        SEAM(1);
    }
    const Ctx C0 = C;
#pragma unroll 1
    for (int l = 0; l < DEPTH; ++l) {
        const int p0 = 2 + l * PH_PER_LAYER;
        Ctx C = C0; { int t_ = C0.wave * 64 + lane_id_opaque(); asm volatile("" : "+v"(t_)); C.tid = t_; C.lane = t_ & 63; C.wave = __builtin_amdgcn_readfirstlane(t_ >> 6);
                      int b_ = C0.bid; asm volatile("" : "+s"(b_)); C.bid = b_; int g_ = C0.G; asm volatile("" : "+s"(g_)); C.G = g_; unsigned char* w_ = C0.ws; asm volatile("" : "+s"(w_)); C.ws = w_;
                      const CAS fptr_t* i_ = C0.in; asm volatile("" : "+s"(i_)); C.in = i_;
                      LAS unsigned char* l_ = C0.lds; asm volatile("" : "+s"(l_)); C.lds = l_; }
        LAS unsigned char* const ldsl = C.lds;
        const float* modl = WSP(const float, WS_MODS) + (size_t)l * 9 * 6144;
        if ((EN & 2) && IN(p0 + 0)) { phase_l1(C, l); SEAM(p0 + 0); }
        if ((EN & 4) && IN(p0 + 1)) {
            { pg8::SchedDense S; S.init(NTOK / 256, NHG / 256, C.G, C.bid, D, D);
              EpiHG E{WSP(bf16_t, WS_PHG), WSP(const float, WS_LOWER) + l * 512};
              pg8::gemm_phase<false>(ldsl, S, E, (const char*)WSP(bf16_t, WS_R1), (const char*)(WSP(bf16_t, WS_WIN) + (size_t)NHY * D), D, D, 128u * D * 2u, 128u * D * 2u, D / 64, FRESH_TID); }
            { pg8::SchedDense S; S.init(NHY / 256, NTOK / 256, C.G, C.bid, D, D);
              EpiHY E{WSP(bf16_t, WS_PHYT)};
              pg8::gemm_phase<false>(ldsl, S, E, (const char*)WSP(bf16_t, WS_WIN), (const char*)WSP(bf16_t, WS_R1), D, D, 128u * D * 2u, 128u * D * 2u, D / 64, FRESH_TID); }
            SEAM(p0 + 1);
        }
        if ((EN & 8) && IN(p0 + 2)) { phase_l3(C, l); SEAM(p0 + 2); }
        if ((EN & 16) && IN(p0 + 3)) { phase_l3b(C, l); SEAM(p0 + 3); }
        if ((EN & 32) && IN(p0 + 4)) {
            pg8::SchedDense S; S.init(NTOK / 256, D / 256, C.G, C.bid, D, D);
            EpiOut E{C.in[IN_X], C.in[IN_CTX], WSP(float, WS_XBUF), modl, l == 0 ? 1 : 0, C.dry};
            pg8::gemm_phase<false>(ldsl, S, E, (const char*)WSP(bf16_t, WS_R1), (const char*)WSP(bf16_t, WS_WOUT), D, D, 128u * D * 2u, 128u * D * 2u, D / 64, FRESH_TID);
            SEAM(p0 + 4);
        }
        if ((EN & 64) && IN(p0 + 5)) { phase_l5a(C, l); SEAM(p0 + 5); }
        if ((EN & 128) && IN(p0 + 6)) { phase_l5b(C, l); SEAM(p0 + 6); }
        if ((EN & 256) && IN(p0 + 7)) {
            build_tiletab(C, l);
            const volatile LAS int* lc = (const volatile LAS int*)(ldsl + LDSCTL_OFF);
            const int n6 = 4 * lc[LC_T];
            unsigned* cnt6 = WSP(unsigned, WS_CTL) + CW_T6 + l * 96 * 64;
#pragma unroll 1
            for (int idx = C.bid; idx < n6; idx += C.G) {
                SchedUp1 S{idx, lc + LC_TILEBIN};
                EpiAct E{WSP(bf16_t, WS_R1), WSP(const float, WS_ROWW)};
                pg8::gemm_phase<false>(ldsl, S, E, (const char*)WSP(bf16_t, WS_PHG), (const char*)WSP(bf16_t, WS_WG), D, D, 128u * D * 2u, (unsigned)(WS_WU - WS_WG), D / 64, FRESH_TID);
                asm volatile("s_waitcnt vmcnt(0)" ::: "memory");
                __syncthreads();
                if (C.wave * 64 + lane_id_opaque() == 0) {
                    __hip_atomic_fetch_add(cnt6 + (idx >> 2) * 64, 1u, __ATOMIC_RELAXED, __HIP_MEMORY_SCOPE_AGENT); }
            }
            int nb2 = n6 - C.G; nb2 = nb2 < 0 ? 0 : (nb2 > C.G - 64 ? C.G - 64 : nb2);
            const int nw = C.G - nb2;
            if (C.bid >= nb2) {
#pragma unroll 1
                for (int j = C.bid - nb2; j < n6; j += nw) {
                    if (C.wave * 64 + lane_id_opaque() == 0) { unsigned* cw = cnt6 + (j >> 2) * 64; unsigned sp = 0;
                        while (__hip_atomic_load(cw, __ATOMIC_RELAXED, __HIP_MEMORY_SCOPE_AGENT) < 4u) { __builtin_amdgcn_s_sleep(2); if (++sp > (1u << 22)) break; }
                        __builtin_amdgcn_fence(__ATOMIC_ACQUIRE, "agent"); asm volatile("s_waitcnt vmcnt(0)" ::: "memory"); }
                    __syncthreads();
                    SchedDown1 S{j, lc + LC_TILEBIN};
                    EpiDown E{WSP(float, WS_XBUF), WSP(const int, WS_ROWTOK), modl, C.dry};
                    pg8::gemm_phase<true>(ldsl, S, E, (const char*)WSP(bf16_t, WS_R1), (const char*)WSP(bf16_t, WS_WD), 512, 256, 128u * 512u * 2u, 128u * 256u * 2u, 4, FRESH_TID);
                }
            }
            SEAM(p0 + 7);
        }
    }
    if ((EN & 1024) && IN(N_PHASES - 1)) { Ctx CF = C0; CF.tid = C0.wave * 64 + lane_id_opaque(); CF.lane = CF.tid & 63; phase_final(CF); }
#undef IN
#undef SEAM
}

extern "C" void kernel_launch(void* const* d_in, const int* in_sizes, int n_in, void* d_out, int out_size, void* d_ws, size_t ws_size, hipStream_t stream) {
    static int grid = 0;
    if (grid == 0) {
        if (n_in != N_IN || in_sizes[0] != NLAT * D || out_size != NLAT * D || ws_size < WS_END) { fprintf(stderr, "kernel_launch: unexpected shapes / workspace (%d inputs, ws %zu < %zu)\n", n_in, ws_size, (size_t)WS_END); grid = -1; return; }
        int dev = 0, cus = 0, per_cu = 0;
        if (hipGetDevice(&dev) != hipSuccess || hipDeviceGetAttribute(&cus, hipDeviceAttributeMultiprocessorCount, dev) != hipSuccess) { grid = -1; return; }
        if (hipFuncSetAttribute((const void*)trunk_fwd, hipFuncAttributeMaxDynamicSharedMemorySize, LDS_BYTES) != hipSuccess) { fprintf(stderr, "kernel_launch: hipFuncSetAttribute failed\n"); grid = -1; return; }
        if (hipOccupancyMaxActiveBlocksPerMultiprocessor(&per_cu, (const void*)trunk_fwd, NTHR, LDS_BYTES) != hipSuccess || per_cu < 1) { fprintf(stderr, "kernel_launch: occupancy query says %d\n", per_cu); }
        (void)hipGetLastError();
        grid = cus;
    }
    if (grid < 0) return;
    (void)hipMemsetAsync((char*)d_ws + WS_CTL, 0, CTL_ZERO_BYTES, stream);
    Args a{};
    for (int i = 0; i < N_IN; ++i) a.in[i] = (const float*)d_in[i];
    a.out = (float*)d_out; a.ws = (unsigned char*)d_ws;
#if MK_PER_PHASE
    for (int p = 0; p < N_PHASES; ++p) { a.ph_lo = p; a.ph_hi = p + 1; const int kind = p == 0 ? 0 : (p == 1 ? 11 : (p == N_PHASES - 1 ? 10 : 1 + (p - 2) % PH_PER_LAYER));
        const int nrep = ((PROBE_HOST >> kind) & 1) ? 2 : 1; a.pad = nrep | (PROBE_SKIP << 8);
        for (int rep = 0; rep < nrep; ++rep) { a.rep = rep; hipLaunchKernelGGL(trunk_fwd, dim3(grid), dim3(NTHR), LDS_BYTES, stream, a); } }
#else
    a.ph_lo = 0; a.ph_hi = N_PHASES; a.rep = 0; a.pad = 1;
    hipLaunchKernelGGL(trunk_fwd, dim3(grid), dim3(NTHR), LDS_BYTES, stream, a);
#endif
}
```

```cpp
#include <hip/hip_runtime.h>
#include <cstdio>
#include <cstdint>

#ifndef PROBE_HOST
#define PROBE_HOST 0
#endif
#ifndef PROBE_SKIP
#define PROBE_SKIP 1
#endif
#ifndef MK_PER_PHASE
#define MK_PER_PHASE 0
#endif

#define LAS __attribute__((address_space(3)))
#define GAS __attribute__((address_space(1)))
typedef unsigned short bf16_t;
typedef short bf16x8 __attribute__((ext_vector_type(8)));
typedef float f32x4 __attribute__((ext_vector_type(4)));
typedef float f32x2 __attribute__((ext_vector_type(2)));
typedef unsigned u32x4 __attribute__((ext_vector_type(4)));
typedef unsigned u32x2 __attribute__((ext_vector_type(2)));

constexpr int NB = 8, SEQ = 2048, D = 1024, DEPTH = 4, CTXL = 256;
constexpr int NLAT = NB * SEQ, NCTX = NB * CTXL, NTOK = NLAT + NCTX;
constexpr int DH = 512, NHY = 1536, NHG = 2560, DIN = 4096;
constexpr int NE = 16, DE = 256, NBIN = 24, SROWS = 24576;
constexpr float EPS = 1e-6f;
constexpr int NTHR = 512, NWAVES = 8;
enum { IN_X = 0, IN_C, IN_CTX, IN_CCTX, IN_WMOD, IN_BMOD, IN_WIN, IN_WOUT, IN_CONVW, IN_CONVB, IN_W1, IN_B1, IN_W2, IN_B2, IN_W3, IN_B3,
       IN_HYBIAS, IN_LB, IN_NORMW, IN_RW, IN_RB, IN_WG, IN_WU, IN_WD, IN_FNW, N_IN };

constexpr size_t MiB = 1u << 20;
constexpr size_t WS_CTL = 0, CTL_ZERO_BYTES = 1 * MiB;
constexpr size_t WS_MODS = 1 * MiB;
constexpr size_t WS_LOWER = 2 * MiB;
constexpr size_t WS_BIAS2 = 2 * MiB + 64 * 1024;
constexpr size_t WS_HPAD = 3 * MiB;
constexpr size_t WS_TOKINFO = 6 * MiB;
constexpr size_t WS_BLKBASE = 6 * MiB + 320 * 1024;
constexpr size_t WS_ROWTOK = 6 * MiB + 512 * 1024;
constexpr size_t WS_ROWW = 7 * MiB;
constexpr size_t WS_WIN = 8 * MiB;
constexpr size_t WS_WOUT = 16 * MiB;
constexpr size_t WS_WG = 18 * MiB;
constexpr size_t WS_WU = 26 * MiB;
constexpr size_t WS_WD = 34 * MiB;
constexpr size_t WS_KSPEC = 42 * MiB;
constexpr size_t WS_XBUF = 74 * MiB;
constexpr size_t WS_R1 = 146 * MiB;
constexpr size_t WS_PHG = 182 * MiB;
constexpr size_t WS_PHYT = 272 * MiB;
constexpr size_t WS_ODIR = 326 * MiB;
constexpr size_t WS_KSPC = 362 * MiB;
constexpr size_t WS_W3T = 378 * MiB;
constexpr size_t WS_HF = 380 * MiB;
constexpr size_t WS_END = 416 * MiB;
constexpr int CW_BAR = 4096;
constexpr int CW_CNT = 16384;
constexpr int CW_T6 = 65536;
constexpr int CW_Q = 32768;

constexpr int LDS_BYTES = 147456;
constexpr int LDSCTL_OFF = 143 * 1024;
constexpr int LC_BAR = 0;
constexpr int LC_T = 8;
constexpr int LC_Q = 9;
constexpr int LC_OFFS = 16;
constexpr int LC_TILEBIN = 48;

__device__ __forceinline__ unsigned f2bf(float f) { return (unsigned)__builtin_bit_cast(unsigned short, (__bf16)f); }
typedef __bf16 bf16x2v __attribute__((ext_vector_type(2)));
__device__ __forceinline__ unsigned pk2(float lo, float hi) { const f32x2 v = {lo, hi}; return __builtin_bit_cast(unsigned, __builtin_convertvector(v, bf16x2v)); }
__device__ __forceinline__ float bf2f(unsigned b) { return __builtin_bit_cast(float, (b & 0xffffu) << 16); }
__device__ __forceinline__ float bflo(unsigned w) { return __builtin_bit_cast(float, w << 16); }
__device__ __forceinline__ float bfhi(unsigned w) { return __builtin_bit_cast(float, w & 0xffff0000u); }
__device__ __forceinline__ float sigmoidf_(float x) { return __builtin_amdgcn_rcpf(1.0f + __expf(-x)); }
__device__ __forceinline__ float siluf_(float x) { return x * __builtin_amdgcn_rcpf(1.0f + __expf(-x)); }
#define DPP_ADD(v, ctrl, rmask) v += __builtin_bit_cast(float, __builtin_amdgcn_update_dpp(0, __builtin_bit_cast(int, v), ctrl, rmask, 0xF, false))
__device__ __forceinline__ float row16_sum(float v) {
    DPP_ADD(v, 0xB1, 0xF);
    DPP_ADD(v, 0x4E, 0xF);
    DPP_ADD(v, 0x141, 0xF);
    DPP_ADD(v, 0x140, 0xF);
    return v;
}
__device__ __forceinline__ float wave_sum(float v) {
    v = row16_sum(v);
    DPP_ADD(v, 0x142, 0xA);
    DPP_ADD(v, 0x143, 0xC);
    return __builtin_bit_cast(float, __builtin_amdgcn_readlane(__builtin_bit_cast(int, v), 63));
}
__device__ __forceinline__ int lane_id_opaque() { int x; asm volatile("v_mbcnt_lo_u32_b32 %0, -1, 0\n\tv_mbcnt_hi_u32_b32 %0, -1, %0" : "=v"(x)); return x; }
__device__ __forceinline__ int bidx(int row) { return row < NLAT ? (row >> 11) : 8; }
#define LDS_WAIT() asm volatile("s_waitcnt lgkmcnt(0)" ::: "memory")

#define XB_TMO      128
#define XB_XCNT(j)  (256  + 64 * (j))
#define XB_XSUB(j)  (1280 + 64 * (j))
#define XB_XGEN(j)  (2304 + 64 * (j))
#define XB_TOP      3328
#define XB_TOPGEN   3392
#define XCD_BAR_WORDS 3456
#define XB_SPIN_CAP (1u << 18)
__device__ __forceinline__ unsigned xb_ld(unsigned* p)              { return __hip_atomic_load(p, __ATOMIC_RELAXED, __HIP_MEMORY_SCOPE_AGENT); }
__device__ __forceinline__ unsigned xb_add(unsigned* p, unsigned v) { return __hip_atomic_fetch_add(p, v, __ATOMIC_RELAXED, __HIP_MEMORY_SCOPE_AGENT); }
__device__ __forceinline__ unsigned xb_xcc_id() { return (unsigned)__builtin_amdgcn_s_getreg((3 << 11) | 20) & 0xFu; }
#define XB_SPIN(cond, bar) do { unsigned _sp = 0; while (cond) { __builtin_amdgcn_s_sleep(1); \
    if ((++_sp & 255u) == 0u) { if (xb_ld(&(bar)[XB_TMO])) break; if (_sp > XB_SPIN_CAP) { atomicAdd(&(bar)[XB_TMO], 1u); break; } } } } while (0)
struct XcdBarrier { unsigned* bar; unsigned x; volatile LAS unsigned* st; };
__device__ __forceinline__ XcdBarrier xcd_barrier_post(unsigned* bar, volatile LAS unsigned* st) {
    XcdBarrier b; b.bar = bar; b.x = xb_xcc_id(); b.st = st;
    if (threadIdx.x == 0) (void)xb_add(&bar[XB_XCNT(b.x)], 1u);
    return b;
}
__device__ __forceinline__ void xcd_barrier_complete(unsigned* bar, unsigned x, unsigned& nloc, unsigned& nx) {
    const unsigned G = gridDim.x * gridDim.y * gridDim.z;
    unsigned sum, cnt, mine, sp = 0u;
    for (;;) {
        sum = 0u; cnt = 0u; mine = 0u;
#pragma unroll
        for (unsigned j = 0; j < 16; ++j) { const unsigned c = xb_ld(&bar[XB_XCNT(j)]); sum += c; cnt += (c > 0u) ? 1u : 0u; mine = (j == x) ? c : mine; }
        if (sum == G) break;
        __builtin_amdgcn_s_sleep(1);
        if ((++sp & 255u) == 0u) { if (xb_ld(&bar[XB_TMO])) break; if (sp > XB_SPIN_CAP) { atomicAdd(&bar[XB_TMO], 1u); break; } }
    }
    nloc = mine > 0u ? mine : 1u; nx = cnt > 0u ? cnt : 1u;
}
__device__ __forceinline__ void xcd_barrier(const XcdBarrier& b, const int tid0) {
    asm volatile("s_waitcnt vmcnt(0)" ::: "memory");
    __syncthreads();
    if (tid0 == 0) {
        unsigned bx = b.x; unsigned blo_ = __builtin_amdgcn_readfirstlane((unsigned)(unsigned long long)b.bar), bhi_ = __builtin_amdgcn_readfirstlane((unsigned)((unsigned long long)b.bar >> 32));
        asm volatile("" : "+s"(blo_), "+s"(bhi_), "+s"(bx));
        unsigned* bar = (unsigned*)(((unsigned long long)bhi_ << 32) | blo_);
        __builtin_amdgcn_s_waitcnt(0);
        unsigned nloc = b.st[0], nx = b.st[1];
        if (nloc == 0u) { xcd_barrier_complete(bar, bx, nloc, nx); b.st[0] = nloc; b.st[1] = nx; }
        const unsigned old = xb_add(&bar[XB_XSUB(bx)], 1u);
        const unsigned gen = old / nloc;
        if (old + 1u == (gen + 1u) * nloc) {
            __builtin_amdgcn_fence(__ATOMIC_RELEASE, "agent");
            asm volatile("s_waitcnt vmcnt(0)" ::: "memory");
            const unsigned og = xb_add(&bar[XB_TOP], 1u);
            const unsigned tg = og / nx;
            if (og + 1u == (tg + 1u) * nx) xb_add(&bar[XB_TOPGEN], 1u);
            else XB_SPIN(xb_ld(&bar[XB_TOPGEN]) == tg, bar);
            __builtin_amdgcn_fence(__ATOMIC_ACQUIRE, "agent");
            xb_add(&bar[XB_XGEN(bx)], 1u);
            asm volatile("s_waitcnt vmcnt(0)" ::: "memory");
        } else {
            XB_SPIN(xb_ld(&bar[XB_XGEN(bx)]) == gen, bar);
            __builtin_amdgcn_fence(__ATOMIC_ACQUIRE, "agent");
            asm volatile("s_waitcnt vmcnt(0)" ::: "memory");
        }
    }
    __syncthreads();
}

namespace pg8 {
constexpr int BM = 256, BK = 64, HALF = 128, HTB = HALF * BK * 2, STAGE_BYTES = 8 * HTB, NXCD = 8, WGM = 8;
__host__ __device__ __forceinline__ int lds_byte(int r, int c) { const int st = (r >> 4) * 2 + (c >> 5), rr = r & 15, cc = c & 31, ob = rr * 64 + cc * 2; return st * 1024 + (ob ^ (((ob >> 9) & 1) << 5)); }
__host__ __device__ __forceinline__ void stage_rc(int b, int& R, int& C) { const int st = b / 1024, sb = b % 1024, swz = sb ^ (((sb >> 9) & 1) << 5); R = (st >> 1) * 16 + swz / 64; C = (st & 1) * 32 + (swz % 64) / 2; }
__host__ __device__ __forceinline__ int perm32(int rho) { const int n = rho >> 4, i = rho & 15; return 8 * (i >> 2) + 4 * n + (i & 3); }

struct GUnit { unsigned a, b; int last, i0, i1; };

template <bool SUB, class Epi, class Sched>
__device__ __forceinline__ void gemm_phase(LAS unsigned char* lds, const Sched& S, const Epi& E, const char* Abase, const char* Bbase, const int lda, const int ldb, const unsigned ahalf, const unsigned bhalf, const int nt, const int tid_in) {
    int tid_ = tid_in; asm volatile("" : "+v"(tid_));
    const int tid = tid_, wid = __builtin_amdgcn_readfirstlane(tid >> 6), lane = tid & 63, wr = wid >> 2, wc = wid & 3, fr = lane & 15, fq = lane >> 4;
    unsigned voffA[2], voffB[2];
#pragma unroll
    for (int i = 0; i < 2; ++i) { int R, C; stage_rc(tid * 16 + i * 8192, R, C); const int Rb = Epi::PERM ? ((R & ~31) + perm32(R & 31)) : R;
        voffA[i] = (unsigned)(R * lda + C) * 2u; voffB[i] = (unsigned)(Rb * ldb + C) * 2u; }
    constexpr unsigned kstep = BK * 2;
    const unsigned ldsw = (unsigned)wid * 1024u;
    const int aoff = lds_byte(wr * 64 + fr, fq * 8), boff = lds_byte(wc * 32 + fr, fq * 8);
#define PG8_SA(b, h) (((b) * 2 + (h)) * HTB)
#define PG8_SB(b, h) ((4 + (b) * 2 + (h)) * HTB)
#define PG8_STAGE(bufoff, gbase, voff) do { _Pragma("unroll") for (int _i = 0; _i < 2; ++_i) \
        __builtin_amdgcn_global_load_lds((const unsigned*)((const char*)(gbase) + (voff)[_i]), (LAS unsigned*)(lds + (bufoff) + ldsw + _i * 8192), 16, 0, 0); } while (0)
#define PG8_LDA(dst, b, h) do { _Pragma("unroll") for (int m = 0; m < 4; ++m) _Pragma("unroll") for (int k = 0; k < 2; ++k) dst[m][k] = *(const LAS bf16x8*)(lds + PG8_SA(b, h) + aoff + m * 2048 + k * 1024); } while (0)
#define PG8_LDB(dst, b, h) do { _Pragma("unroll") for (int n = 0; n < 2; ++n) _Pragma("unroll") for (int k = 0; k < 2; ++k) dst[n][k] = *(const LAS bf16x8*)(lds + PG8_SB(b, h) + boff + n * 2048 + k * 1024); } while (0)
#define PG8_MMA(ai, bj, At, Bt) do { __builtin_amdgcn_s_setprio(1); _Pragma("unroll") for (int m = 0; m < 4; ++m) _Pragma("unroll") for (int n = 0; n < 2; ++n) _Pragma("unroll") for (int k = 0; k < 2; ++k) \
        acc[ai][bj][m][n] = __builtin_amdgcn_mfma_f32_16x16x32_bf16(Bt[n][k], At[m][k], acc[ai][bj][m][n], 0, 0, 0); __builtin_amdgcn_s_setprio(0); } while (0)
#define PG8_WAIT_V(n) asm volatile("s_waitcnt vmcnt(" #n ")" ::: "memory")
#define PG8_WAIT_L(n) asm volatile("s_waitcnt lgkmcnt(" #n ")" ::: "memory")
#define PG8_BAR __builtin_amdgcn_s_barrier()
#define PG8_SCHED __builtin_amdgcn_sched_barrier(0)
    GUnit cur, nxt; int ui = 0;
    if (!S.next(0, cur)) return;
    f32x4 acc[2][2][4][2];
    float zf_ = 0.f; asm volatile("" : "+v"(zf_));
#pragma unroll
    for (int a = 0; a < 2; ++a)
#pragma unroll
        for (int b = 0; b < 2; ++b)
#pragma unroll
            for (int m = 0; m < 4; ++m)
#pragma unroll
                for (int n = 0; n < 2; ++n) acc[a][b][m][n] = (f32x4){zf_, zf_, zf_, zf_};
    bf16x8 At[4][2], B0[2][2], B1[2][2];
    { const char* cA = Abase + cur.a; const char* cB = Bbase + cur.b;
      PG8_STAGE(PG8_SB(0, 0), cB, voffB); PG8_STAGE(PG8_SB(0, 1), cB + bhalf, voffB); PG8_STAGE(PG8_SA(0, 0), cA, voffA); PG8_STAGE(PG8_SA(0, 1), cA + ahalf, voffA);
      if (wr == 1) PG8_BAR;
      PG8_WAIT_V(2); PG8_BAR;
      PG8_STAGE(PG8_SB(1, 0), cB + kstep, voffB); PG8_STAGE(PG8_SA(1, 0), cA + kstep, voffA); PG8_STAGE(PG8_SB(1, 1), cB + bhalf + kstep, voffB);
      PG8_WAIT_V(6); PG8_BAR; }
    for (;;) {
        const bool has_next = S.next(ui + 1, nxt);
        const char* cA = Abase + cur.a; const char* cB = Bbase + cur.b;
        const char* nA = Abase + (has_next ? nxt.a : cur.a); const char* nB = Bbase + (has_next ? nxt.b : cur.b);
        for (int t = 0; t < nt; t += 2) {
            const bool last = (t == nt - 2);
            const char* a1 = cA + (unsigned)(t + 1) * kstep;
            const char* a2 = last ? nA : cA + (unsigned)(t + 2) * kstep; const char* b2 = last ? nB : cB + (unsigned)(t + 2) * kstep;
            const char* a3 = a2 + kstep; const char* b3 = b2 + kstep;
            PG8_LDB(B0, 0, 0); PG8_LDB(B1, 0, 1); PG8_SCHED; PG8_LDA(At, 0, 0); PG8_STAGE(PG8_SA(1, 1), a1 + ahalf, voffA);
            PG8_WAIT_V(8); PG8_WAIT_L(0); PG8_BAR; PG8_MMA(0, 0, At, B0); PG8_MMA(0, 1, At, B1); PG8_BAR; PG8_SCHED;
            PG8_LDA(At, 0, 1); PG8_STAGE(PG8_SB(0, 0), b2, voffB); PG8_STAGE(PG8_SB(0, 1), b2 + bhalf, voffB); PG8_STAGE(PG8_SA(0, 0), a2, voffA);
            PG8_WAIT_V(8); PG8_WAIT_L(0); PG8_BAR; PG8_MMA(1, 0, At, B0); PG8_MMA(1, 1, At, B1); PG8_BAR; PG8_SCHED;
            PG8_LDB(B0, 1, 0); PG8_LDB(B1, 1, 1); PG8_SCHED; PG8_LDA(At, 1, 0); PG8_STAGE(PG8_SA(0, 1), a2 + ahalf, voffA);
            PG8_WAIT_V(8); PG8_WAIT_L(0); PG8_BAR; PG8_MMA(0, 0, At, B0); PG8_MMA(0, 1, At, B1); PG8_BAR; PG8_SCHED;
            PG8_LDA(At, 1, 1); PG8_STAGE(PG8_SB(1, 0), b3, voffB); PG8_STAGE(PG8_SB(1, 1), b3 + bhalf, voffB); PG8_STAGE(PG8_SA(1, 0), a3, voffA);
            PG8_WAIT_V(8); PG8_WAIT_L(0); PG8_BAR; PG8_MMA(1, 0, At, B0); PG8_MMA(1, 1, At, B1); PG8_BAR; PG8_SCHED;
        }
        const bool fin = SUB ? (cur.last != 0) : true;
        if (fin) { if (wr == 0) PG8_BAR; E(acc, cur, wr, wc, fr, fq); }
        if (!has_next) break;
        if (fin) {
#pragma unroll
            for (int a = 0; a < 2; ++a)
#pragma unroll
                for (int b = 0; b < 2; ++b)
#pragma unroll
                    for (int m = 0; m < 4; ++m)
#pragma unroll
                        for (int n = 0; n < 2; ++n) acc[a][b][m][n] = (f32x4){zf_, zf_, zf_, zf_};
        }
        cur = nxt; ++ui;
        if (fin) { if (wr == 1) PG8_BAR; }
    }
    PG8_WAIT_V(0);
    PG8_BAR;
#undef PG8_SA
#undef PG8_SB
#undef PG8_STAGE
#undef PG8_LDA
#undef PG8_LDB
#undef PG8_MMA
#undef PG8_WAIT_V
#undef PG8_WAIT_L
#undef PG8_BAR
#undef PG8_SCHED
}

struct SchedDense {
    int nM, nN, nwg, G, c; unsigned atile, btile;
    __device__ __forceinline__ void init(int nM_, int nN_, int G_, int c_, int lda, int ldb) {
        nM = nM_; nN = nN_; nwg = nM * nN; G = G_; c = c_; atile = 256u * lda * 2u; btile = 256u * ldb * 2u; }
    __device__ __forceinline__ bool next(int i, GUnit& u) const {
        const int L = i * G + c; if (L >= nwg) return false;
        int wgid = L; { const int q = nwg / NXCD, r = nwg % NXCD, xcd = wgid % NXCD, off = wgid / NXCD; wgid = (xcd < r ? xcd * (q + 1) : r * (q + 1) + (xcd - r) * q) + off; }
        const int nig = WGM * nN, gid = wgid / nig, fm = gid * WGM, gsz = (nM - fm) < WGM ? (nM - fm) : WGM;
        const int pm = fm + ((wgid % nig) % gsz), pn = (wgid % nig) / gsz;
        u.a = (unsigned)pm * atile; u.b = (unsigned)pn * btile; u.last = 1; u.i0 = pm; u.i1 = pn; return true;
    }
};
}

struct Args { const float* in[N_IN]; float* out; unsigned char* ws; int ph_lo, ph_hi, rep, pad; };
static_assert(sizeof(Args) == N_IN * 8 + 8 + 8 + 16, "Args has no padding");

#define CAS __attribute__((address_space(4)))
typedef const float* fptr_t;
struct Ctx {
    const CAS fptr_t* in; float* out; GAS unsigned char* ws; LAS unsigned char* lds; int tid, lane, wave, G, bid, rep, dry;
};
#define WSP(T, off) ((T*)(GAS T*)(C.ws + (off)))
#define GIN(k) ((const float*)(const GAS float*)C.in[k])

__device__ __forceinline__ void build_tiletab(const Ctx& C, int l) {
    volatile LAS int* lc = (volatile LAS int*)(C.lds + LDSCTL_OFF);
    __syncthreads();
    if (C.tid == 0) {
        const unsigned* cnt = WSP(const unsigned, WS_CTL) + CW_CNT + l * 32 * 64;
        int off = 0, t = 0;
        for (int b = 0; b < NBIN; ++b) {
            const int n = (int)__hip_atomic_load(cnt + b * 64, __ATOMIC_RELAXED, __HIP_MEMORY_SCOPE_AGENT);
            lc[LC_OFFS + b] = off;
            const int nt = (n + 255) >> 8;
            for (int k = 0; k < nt; ++k) lc[LC_TILEBIN + t + k] = b;
            t += nt; off += nt * 256;
        }
        lc[LC_OFFS + NBIN] = off; lc[LC_T] = t;
    }
    __syncthreads();
}
__device__ __forceinline__ int expert_of(int bin, int es) {
    const int g = bin / 6, p = bin - g * 6;
    const int lo = p < 3 ? 0 : (p < 5 ? 1 : 2), hi = p < 3 ? p + 1 : (p < 5 ? p - 1 : 3);
    return 4 * g + (es ? hi : lo);
}

struct SchedUp {
    int T, G, c; const volatile LAS int* tilebin;
    __device__ __forceinline__ bool next(int i, pg8::GUnit& u) const {
        const int idx = i * G + c; if (idx >= 4 * T) return false;
        const int rt = idx >> 2, q = idx & 3, es = q >> 1, fb = q & 1;
        const int bin = __builtin_amdgcn_readfirstlane(tilebin[rt]);
        const int e = expert_of(bin, es);
        u.a = (unsigned)rt * 256u * 2048u; u.b = (unsigned)(e * 256 + fb * 128) * 2048u;
        u.last = 1; u.i0 = rt; u.i1 = q; return true;
    }
};
struct SchedDown {
    int T, G, c; const volatile LAS int* tilebin;
    __device__ __forceinline__ bool next(int i, pg8::GUnit& u) const {
        const int idx = (i >> 1) * G + c, sub = i & 1; if (idx >= 4 * T) return false;
        const int rt = idx >> 2, pn = idx & 3;
        const int bin = __builtin_amdgcn_readfirstlane(tilebin[rt]);
        const int e = expert_of(bin, sub);
        u.a = (unsigned)rt * 256u * 1024u + (unsigned)sub * 512u; u.b = (unsigned)(e * 1024 + pn * 256) * 512u;
        u.last = sub; u.i0 = rt; u.i1 = pn; return true;
    }
};

struct SchedUp1 {
    int idx; const volatile LAS int* tilebin;
    __device__ __forceinline__ bool next(int i, pg8::GUnit& u) const {
        if (i != 0) return false;
        const int rt = idx >> 2, q = idx & 3, es = q >> 1, fb = q & 1;
        const int bin = __builtin_amdgcn_readfirstlane(tilebin[rt]);
        const int e = expert_of(bin, es);
        u.a = (unsigned)rt * 256u * 2048u; u.b = (unsigned)(e * 256 + fb * 128) * 2048u;
        u.last = 1; u.i0 = rt; u.i1 = q; return true;
    }
};
struct SchedDown1 {
    int idx; const volatile LAS int* tilebin;
    __device__ __forceinline__ bool next(int i, pg8::GUnit& u) const {
        if (i > 1) return false;
        const int sub = i, rt = idx >> 2, pn = idx & 3;
        const int bin = __builtin_amdgcn_readfirstlane(tilebin[rt]);
        const int e = expert_of(bin, sub);
        u.a = (unsigned)rt * 256u * 1024u + (unsigned)sub * 512u; u.b = (unsigned)(e * 1024 + pn * 256) * 512u;
        u.last = sub; u.i0 = rt; u.i1 = pn; return true;
    }
};

struct EpiHG {
    static constexpr bool PERM = true;
    bf16_t* O; const float* lower;
    __device__ __forceinline__ void operator()(const f32x4 (&acc)[2][2][4][2], const pg8::GUnit& u, int wr, int wc, int fr, int fq) const {
        const int kind = u.i1 >> 1;
        const int row0 = u.i0 * 256 + wr * 64 + fr, colt = u.i1 * 256 + wc * 32 + 8 * fq;
#pragma unroll
        for (int bj = 0; bj < 2; ++bj) {
            const int col = colt + bj * 128;
            float om[8];
#pragma unroll
            for (int j = 0; j < 8; ++j) om[j] = 1.f;
            if (kind >= 3) { const float* lb = lower + (kind - 3) * 2048 + (col & 511);
#pragma unroll
                for (int j = 0; j < 8; ++j) om[j] = 1.f - lb[j]; }
#pragma unroll
            for (int ai = 0; ai < 2; ++ai)
#pragma unroll
                for (int m = 0; m < 4; ++m) {
                    float v[8];
#pragma unroll
                    for (int j = 0; j < 8; ++j) v[j] = acc[ai][bj][m][j >> 2][j & 3];
                    if (kind == 0) {
#pragma unroll
                        for (int j = 0; j < 8; ++j) v[j] = siluf_(v[j]);
                    } else if (kind >= 3) {
#pragma unroll
                        for (int j = 0; j < 8; ++j) v[j] = om[j] * sigmoidf_(-v[j]);
                    }
                    u32x4 w; w.x = pk2(v[0], v[1]); w.y = pk2(v[2], v[3]); w.z = pk2(v[4], v[5]); w.w = pk2(v[6], v[7]);
                    *(u32x4*)(O + (size_t)(row0 + ai * 128 + m * 16) * NHG + col) = w;
                }
        }
    }
};
struct EpiHY {
    static constexpr bool PERM = true;
    bf16_t* O;
    __device__ __forceinline__ void operator()(const f32x4 (&acc)[2][2][4][2], const pg8::GUnit& u, int wr, int wc, int fr, int fq) const {
        const int row0 = u.i0 * 256 + wr * 64 + fr, colt = u.i1 * 256 + wc * 32 + 8 * fq;
#pragma unroll
        for (int ai = 0; ai < 2; ++ai)
#pragma unroll
            for (int m = 0; m < 4; ++m)
#pragma unroll
                for (int bj = 0; bj < 2; ++bj) {
                    const f32x4 v0 = acc[ai][bj][m][0], v1 = acc[ai][bj][m][1];
                    u32x4 w; w.x = pk2(v0[0], v0[1]); w.y = pk2(v0[2], v0[3]); w.z = pk2(v1[0], v1[1]); w.w = pk2(v1[2], v1[3]);
                    *(u32x4*)(O + (size_t)(row0 + ai * 128 + m * 16) * NTOK + colt + bj * 128) = w;
                }
    }
};
struct EpiOut {
    static constexpr bool PERM = false;
    const float* xlat; const float* xctx; float* xo; const float* mods; int first; int dry;
    __device__ __forceinline__ void operator()(const f32x4 (&acc)[2][2][4][2], const pg8::GUnit& u, int wr, int wc, int fr, int fq) const {
        const int row0 = u.i0 * 256 + wr * 64 + fr, col0 = u.i1 * 256 + wc * 32 + 4 * fq;
#pragma unroll
        for (int ai = 0; ai < 2; ++ai)
#pragma unroll
            for (int m = 0; m < 4; ++m) {
                const int row = row0 + ai * 128 + m * 16;
                const float* src = first ? (row < NLAT ? xlat + (size_t)row * D : xctx + (size_t)(row - NLAT) * D) : xo + (size_t)row * D;
                const float* g1 = mods + bidx(row) * 6144 + 2048;
#pragma unroll
                for (int bj = 0; bj < 2; ++bj)
#pragma unroll
                    for (int n = 0; n < 2; ++n) { const int col = col0 + bj * 128 + n * 16;
                        const f32x4 xv = *(const f32x4*)(src + col), gv = *(const f32x4*)(g1 + col);
                        if (!dry) *(f32x4*)(xo + (size_t)row * D + col) = xv + gv * acc[ai][bj][m][n]; }
            }
    }
};
struct EpiAct {
    static constexpr bool PERM = true;
    bf16_t* O; const float* roww;
    __device__ __forceinline__ void operator()(const f32x4 (&acc)[2][2][4][2], const pg8::GUnit& u, int wr, int wc, int fr, int fq) const {
        const int es = u.i1 >> 1; const int pos0 = u.i0 * 256 + wr * 64 + fr, col = u.i1 * 128 + wc * 32 + 8 * fq;
        const __amdgpu_buffer_rsrc_t rsrc = __builtin_amdgcn_make_buffer_rsrc(O, 0, SROWS * 512 * 2, 0x00020000);
#pragma unroll
        for (int ai = 0; ai < 2; ++ai)
#pragma unroll
            for (int m = 0; m < 4; ++m) {
                const int pos = pos0 + ai * 128 + m * 16;
                const float wgt = roww[pos * 2 + es];
                float v[8];
#pragma unroll
                for (int j = 0; j < 8; ++j) v[j] = siluf_(acc[ai][0][m][j >> 2][j & 3]) * acc[ai][1][m][j >> 2][j & 3] * wgt;
                u32x4 w; w.x = pk2(v[0], v[1]); w.y = pk2(v[2], v[3]); w.z = pk2(v[4], v[5]); w.w = pk2(v[6], v[7]);
                __builtin_amdgcn_raw_buffer_store_b128(w, rsrc, (unsigned)(pos * 512 + col) * 2u, 0, 16);
            }
    }
};
struct EpiDown {
    static constexpr bool PERM = false;
    float* xo; const int* rowtok; const float* mods; int dry;
    __device__ __forceinline__ void operator()(const f32x4 (&acc)[2][2][4][2], const pg8::GUnit& u, int wr, int wc, int fr, int fq) const {
        const int pos0 = u.i0 * 256 + wr * 64 + fr, col0 = u.i1 * 256 + wc * 32 + 4 * fq;
#pragma unroll
        for (int ai = 0; ai < 2; ++ai)
#pragma unroll
            for (int m = 0; m < 4; ++m) {
                const int tok = rowtok[pos0 + ai * 128 + m * 16];
                if (tok >= 0) {
                    const float* g2 = mods + bidx(tok) * 6144 + 5120;
                    float* xr = xo + (size_t)tok * D;
#pragma unroll
                    for (int bj = 0; bj < 2; ++bj)
#pragma unroll
                        for (int n = 0; n < 2; ++n) { const int col = col0 + bj * 128 + n * 16;
                            const f32x4 xv = *(const f32x4*)(xr + col), gv = *(const f32x4*)(g2 + col);
                            if (!dry) *(f32x4*)(xr + col) = xv + gv * acc[ai][bj][m][n]; }
                }
            }
    }
};

struct SchedFilt {
    int G, c;
    __device__ __forceinline__ bool next(int i, pg8::GUnit& u) const {
        const int idx = i * G + c; if (idx >= 4 * 72) return false;
        const int l = idx / 72, r = idx - l * 72, pm = r / 9, pn = r - pm * 9;
        u.a = (unsigned)(l * 2048 + pm * 256) * 256u; u.b = (unsigned)(l * 2304 + pn * 256) * 256u; u.last = 1; u.i0 = l * 16 + pm; u.i1 = pn; return true;
    }
};
struct EpiFilt {
    static constexpr bool PERM = true;
    bf16_t* HF; const float* b3;
    __device__ __forceinline__ void operator()(const f32x4 (&acc)[2][2][4][2], const pg8::GUnit& u, int wr, int wc, int fr, int fq) const {
        const int l = u.i0 >> 4, pm = u.i0 & 15;
        const int row0 = pm * 256 + wr * 64 + fr, t00 = u.i1 * 256 + wc * 32 + 8 * fq;
#pragma unroll
        for (int ai = 0; ai < 2; ++ai)
#pragma unroll
            for (int m = 0; m < 4; ++m) {
                const int row = row0 + ai * 128 + m * 16, c = row & 511;
                const float delta = fabsf(logf(1e-2f) / 0.3f + (float)c * ((logf(1e-2f) / 1.5f - logf(1e-2f) / 0.3f) / 511.0f));
                const float bias = b3[l * 2048 + row];
#pragma unroll
                for (int bj = 0; bj < 2; ++bj) {
                    const int t0 = t00 + bj * 128;
                    float v[8];
#pragma unroll
                    for (int j = 0; j < 8; ++j) { const int t = t0 + j; const float tn = t < 2048 ? (float)t / 2047.0f : (float)(t - 2048) / 255.0f;
                        v[j] = (acc[ai][bj][m][j >> 2][j & 3] + bias) * expf(-tn * delta); }
                    u32x4 w; w.x = pk2(v[0], v[1]); w.y = pk2(v[2], v[3]); w.z = pk2(v[4], v[5]); w.w = pk2(v[6], v[7]);
                    *(u32x4*)(HF + ((size_t)(l * 2048 + row)) * 2304 + t0) = w;
                }
            }
    }
};

__device__ __forceinline__ int padx(int i) { return i + (i >> 3); }
__device__ __forceinline__ f32x2 cmul(f32x2 a, f32x2 b) { return (f32x2){a.x * b.x - a.y * b.y, a.x * b.y + a.y * b.x}; }
__device__ __forceinline__ f32x2 cmulc(f32x2 a, f32x2 b) { return (f32x2){a.x * b.x + a.y * b.y, a.y * b.x - a.x * b.y}; }
constexpr int XPAD = 2048 + 256;

__device__ __forceinline__ void fft_p1_dif(f32x2 (&v)[8], int tt, const LAS f32x2* T) {
#pragma unroll
    for (int g = 0; g < 2; ++g) { const int u = tt + 256 * g;
#pragma unroll
        for (int j = 0; j < 2; ++j) { const f32x2 a = v[g + 2 * j], b = v[g + 2 * j + 4]; v[g + 2 * j] = a + b; v[g + 2 * j + 4] = cmul(a - b, T[2 * (u + 512 * j)]); }
        const f32x2 tw = T[4 * u];
        { const f32x2 a = v[g], b = v[g + 2]; v[g] = a + b; v[g + 2] = cmul(a - b, tw); }
        { const f32x2 a = v[g + 4], b = v[g + 6]; v[g + 4] = a + b; v[g + 6] = cmul(a - b, tw); } }
}
__device__ __forceinline__ void fft_p1_dit(f32x2 (&v)[8], int tt, const LAS f32x2* T) {
#pragma unroll
    for (int g = 0; g < 2; ++g) { const int u = tt + 256 * g;
        const f32x2 tw = T[4 * u];
        { const f32x2 a = v[g], b = cmulc(v[g + 2], tw); v[g] = a + b; v[g + 2] = a - b; }
        { const f32x2 a = v[g + 4], b = cmulc(v[g + 6], tw); v[g + 4] = a + b; v[g + 6] = a - b; }
#pragma unroll
        for (int j = 0; j < 2; ++j) { const f32x2 a = v[g + 2 * j], b = cmulc(v[g + 2 * j + 4], T[2 * (u + 512 * j)]); v[g + 2 * j] = a + b; v[g + 2 * j + 4] = a - b; } }
}
template <int Q> __device__ __forceinline__ void r8_dif(f32x2 (&e)[8], int r, const LAS f32x2* T) {
    constexpr int S2 = 512 / Q;
#pragma unroll
    for (int j = 0; j < 4; ++j) { const f32x2 a = e[j], b = e[j + 4]; e[j] = a + b; e[j + 4] = cmul(a - b, T[S2 * (r + Q * j)]); }
#pragma unroll
    for (int jj = 0; jj < 4; ++jj) { const int j = (jj & 1) + 4 * (jj >> 1); const f32x2 a = e[j], b = e[j + 2]; e[j] = a + b; e[j + 2] = cmul(a - b, T[2 * S2 * (r + Q * (j & 1))]); }
    const f32x2 tw = T[4 * S2 * r];
#pragma unroll
    for (int j = 0; j < 8; j += 2) { const f32x2 a = e[j], b = e[j + 1]; e[j] = a + b; e[j + 1] = cmul(a - b, tw); }
}
template <int Q> __device__ __forceinline__ void r8_dit(f32x2 (&e)[8], int r, const LAS f32x2* T) {
    constexpr int S2 = 512 / Q;
    const f32x2 tw = T[4 * S2 * r];
#pragma unroll
    for (int j = 0; j < 8; j += 2) { const f32x2 a = e[j], b = cmulc(e[j + 1], tw); e[j] = a + b; e[j + 1] = a - b; }
#pragma unroll
    for (int jj = 0; jj < 4; ++jj) { const int j = (jj & 1) + 4 * (jj >> 1); const f32x2 a = e[j], b = cmulc(e[j + 2], T[2 * S2 * (r + Q * (j & 1))]); e[j] = a + b; e[j + 2] = a - b; }
#pragma unroll
    for (int j = 0; j < 4; ++j) { const f32x2 a = e[j], b = cmulc(e[j + 4], T[S2 * (r + Q * j)]); e[j] = a + b; e[j + 4] = a - b; }
}
template <int Q, bool INV> __device__ __forceinline__ void fft_mid(LAS f32x2* X, int tt, const LAS f32x2* T) {
    const int blk = tt / Q, r = tt % Q, base = blk * 8 * Q + r;
    f32x2 e[8];
#pragma unroll
    for (int j = 0; j < 8; ++j) e[j] = X[padx(base + Q * j)];
    if (INV) r8_dit<Q>(e, r, T); else r8_dif<Q>(e, r, T);
#pragma unroll
    for (int j = 0; j < 8; ++j) X[padx(base + Q * j)] = e[j];
}
__device__ __forceinline__ void fft_conv_half(f32x2 (&v)[8], LAS f32x2* X, const LAS f32x2* T, const f32x2* K, int tt) {
    f32x2 kv[8];
#pragma unroll
    for (int j = 0; j < 8; ++j) kv[j] = K[8 * tt + j];
    fft_p1_dif(v, tt, T);
#pragma unroll
    for (int m = 0; m < 8; ++m) X[padx(tt + 256 * m)] = v[m];
    __syncthreads();
    fft_mid<64, false>(X, tt, T); __syncthreads();
    fft_mid<8, false>(X, tt, T); __syncthreads();
    f32x2 e[8];
#pragma unroll
    for (int j = 0; j < 8; ++j) e[j] = X[padx(8 * tt + j)];
    r8_dif<1>(e, 0, T);
#pragma unroll
    for (int j = 0; j < 8; ++j) e[j] = cmul(e[j], kv[j]);
    r8_dit<1>(e, 0, T);
#pragma unroll
    for (int j = 0; j < 8; ++j) X[padx(8 * tt + j)] = e[j];
    __syncthreads();
    fft_mid<8, true>(X, tt, T); __syncthreads();
    fft_mid<64, true>(X, tt, T); __syncthreads();
#pragma unroll
    for (int m = 0; m < 8; ++m) v[m] = X[padx(tt + 256 * m)];
    fft_p1_dit(v, tt, T);
}
__device__ __forceinline__ void fft_fwd_store(f32x2 (&v)[8], LAS f32x2* X, const LAS f32x2* T, f32x2* Kout, int tt) {
    fft_p1_dif(v, tt, T);
#pragma unroll
    for (int m = 0; m < 8; ++m) X[padx(tt + 256 * m)] = v[m];
    __syncthreads();
    fft_mid<64, false>(X, tt, T); __syncthreads();
    fft_mid<8, false>(X, tt, T); __syncthreads();
    f32x2 e[8];
#pragma unroll
    for (int j = 0; j < 8; ++j) e[j] = X[padx(8 * tt + j)];
    r8_dif<1>(e, 0, T);
#pragma unroll
    for (int j = 0; j < 8; ++j) Kout[8 * tt + j] = e[j];
    __syncthreads();
}
__device__ __forceinline__ int padx16(int i) { return i + (i >> 4); }
constexpr int XPAD16 = 2048 + 128;
template <int Q> __device__ __forceinline__ void r16_dif(f32x2 (&e)[16], int r, const LAS f32x2* T) {
    constexpr int S2 = 256 / Q;
#pragma unroll
    for (int j = 0; j < 8; ++j) { const f32x2 a = e[j], b = e[j + 8]; e[j] = a + b; e[j + 8] = cmul(a - b, T[S2 * (r + Q * j)]); }
#pragma unroll
    for (int jj = 0; jj < 8; ++jj) { const int j = (jj & 3) + 8 * (jj >> 2); const f32x2 a = e[j], b = e[j + 4]; e[j] = a + b; e[j + 4] = cmul(a - b, T[2 * S2 * (r + Q * (j & 3))]); }
#pragma unroll
    for (int jj = 0; jj < 8; ++jj) { const int j = (jj & 1) + 4 * (jj >> 1); const f32x2 a = e[j], b = e[j + 2]; e[j] = a + b; e[j + 2] = cmul(a - b, T[4 * S2 * (r + Q * (j & 1))]); }
    const f32x2 tw = T[8 * S2 * r];
#pragma unroll
    for (int j = 0; j < 16; j += 2) { const f32x2 a = e[j], b = e[j + 1]; e[j] = a + b; e[j + 1] = cmul(a - b, tw); }
}
template <int Q> __device__ __forceinline__ void r16_dit(f32x2 (&e)[16], int r, const LAS f32x2* T) {
    constexpr int S2 = 256 / Q;
    const f32x2 tw = T[8 * S2 * r];
#pragma unroll
    for (int j = 0; j < 16; j += 2) { const f32x2 a = e[j], b = cmulc(e[j + 1], tw); e[j] = a + b; e[j + 1] = a - b; }
#pragma unroll
    for (int jj = 0; jj < 8; ++jj) { const int j = (jj & 1) + 4 * (jj >> 1); const f32x2 a = e[j], b = cmulc(e[j + 2], T[4 * S2 * (r + Q * (j & 1))]); e[j] = a + b; e[j + 2] = a - b; }
#pragma unroll
    for (int jj = 0; jj < 8; ++jj) { const int j = (jj & 3) + 8 * (jj >> 2); const f32x2 a = e[j], b = cmulc(e[j + 4], T[2 * S2 * (r + Q * (j & 3))]); e[j] = a + b; e[j + 4] = a - b; }
#pragma unroll
    for (int j = 0; j < 8; ++j) { const f32x2 a = e[j], b = cmulc(e[j + 8], T[S2 * (r + Q * j)]); e[j] = a + b; e[j + 8] = a - b; }
}
__device__ __forceinline__ void fft_conv_half16(f32x2 (&v)[16], LAS f32x2* X, const LAS f32x2* T, const f32x2* K, int tt) {
    r16_dif<128>(v, tt, T);
#pragma unroll
    for (int m = 0; m < 16; ++m) X[padx16(tt + 128 * m)] = v[m];
    __syncthreads();
    const int r = tt & 7, base = (tt >> 3) * 128 + r;
#pragma unroll
    for (int j = 0; j < 16; ++j) v[j] = X[padx16(base + 8 * j)];
    r16_dif<8>(v, r, T);
#pragma unroll
    for (int j = 0; j < 16; ++j) X[padx16(base + 8 * j)] = v[j];
    f32x2 kv[16];
#pragma unroll
    for (int j = 0; j < 16; ++j) kv[j] = K[16 * tt + j];
    __syncthreads();
#pragma unroll
    for (int g = 0; g < 2; ++g) { f32x2 e[8];
#pragma unroll
        for (int j = 0; j < 8; ++j) e[j] = X[padx16(16 * tt + 8 * g + j)];
        r8_dif<1>(e, 0, T);
#pragma unroll
        for (int j = 0; j < 8; ++j) e[j] = cmul(e[j], kv[8 * g + j]);
        r8_dit<1>(e, 0, T);
#pragma unroll
        for (int j = 0; j < 8; ++j) X[padx16(16 * tt + 8 * g + j)] = e[j]; }
    __syncthreads();
#pragma unroll
    for (int j = 0; j < 16; ++j) v[j] = X[padx16(base + 8 * j)];
    r16_dit<8>(v, r, T);
#pragma unroll
    for (int j = 0; j < 16; ++j) X[padx16(base + 8 * j)] = v[j];
    __syncthreads();
#pragma unroll
    for (int m = 0; m < 16; ++m) v[m] = X[padx16(tt + 128 * m)];
    r16_dit<128>(v, tt, T);
}
__device__ __forceinline__ void fft_fwd_store16(f32x2 (&v)[16], LAS f32x2* X, const LAS f32x2* T, f32x2* Kout, int tt) {
    r16_dif<128>(v, tt, T);
#pragma unroll
    for (int m = 0; m < 16; ++m) X[padx16(tt + 128 * m)] = v[m];
    __syncthreads();
    const int r = tt & 7, base = (tt >> 3) * 128 + r;
#pragma unroll
    for (int j = 0; j < 16; ++j) v[j] = X[padx16(base + 8 * j)];
    r16_dif<8>(v, r, T);
#pragma unroll
    for (int j = 0; j < 16; ++j) X[padx16(base + 8 * j)] = v[j];
    __syncthreads();
#pragma unroll
    for (int g = 0; g < 2; ++g) { f32x2 e[8];
#pragma unroll
        for (int j = 0; j < 8; ++j) e[j] = X[padx16(16 * tt + 8 * g + j)];
        r8_dif<1>(e, 0, T);
#pragma unroll
        for (int j = 0; j < 8; ++j) Kout[16 * tt + 8 * g + j] = e[j]; }
    __syncthreads();
}
__device__ __forceinline__ void build_twiddles(const Ctx& C, LAS f32x2* T) {
    for (int k = C.tid; k < 2048; k += NTHR) { float s, c; sincospif((float)k * (1.0f / 2048.0f), &s, &c); T[k] = (f32x2){c, -s}; }
}

__device__ __forceinline__ void phase0(const Ctx& C) {
    LAS float* sil = (LAS float*)C.lds;
    LAS float* red = sil + 9 * 1024;
    LAS float* zs = red + 8 * 9 * 64;
    LAS float* h1s = zs + 8 * 40;
    const float* cin = GIN(IN_C); const float* cctx = GIN(IN_CCTX);
    for (int i = C.tid; i < 9 * 1024; i += NTHR) { const int r = i >> 10, k = i & 1023; const float v = r < 8 ? cin[r * 1024 + k] : cctx[k]; sil[i] = v / (1.0f + expf(-v)); }
    __syncthreads();
    float* mods = WSP(float, WS_MODS);
    const float* wmod = GIN(IN_WMOD); const float* bmod = GIN(IN_BMOD);
    for (int item = C.bid; item < 4 * 96; item += C.G) {
        const int l = item / 96, cb = item % 96, cc = C.tid & 63, kg = C.tid >> 6;
        const float* w = wmod + ((size_t)l * 1024 + kg * 128) * 6144 + cb * 64 + cc;
        const LAS float* sk = sil + kg * 128;
        float acc[9];
#pragma unroll
        for (int r = 0; r < 9; ++r) acc[r] = 0.f;
#pragma unroll 4
        for (int k = 0; k < 128; ++k) { const float wv = w[(size_t)k * 6144];
#pragma unroll
            for (int r = 0; r < 9; ++r) acc[r] += sk[r * 1024 + k] * wv; }
#pragma unroll
        for (int r = 0; r < 9; ++r) red[(kg * 9 + r) * 64 + cc] = acc[r];
        __syncthreads();
        for (int o = C.tid; o < 576; o += NTHR) { const int r = o >> 6, c2 = o & 63; float s = 0.f;
#pragma unroll
            for (int g = 0; g < 8; ++g) s += red[(g * 9 + r) * 64 + c2];
            mods[(size_t)(l * 9 + r) * 6144 + cb * 64 + c2] = s + bmod[l * 6144 + cb * 64 + c2]; }
        __syncthreads();
    }
    for (int item = C.bid; item < 4 * 288; item += C.G) {
        const int l = item / 288, r = item % 288, isctx = r >= 256;
        const int L = isctx ? 256 : 2048, t0 = (isctx ? r - 256 : r) * 8, tl = C.tid >> 6, j = C.tid & 63, t = t0 + tl;
        if (j < 33) { float z;
            if (j == 0) z = (float)t / (float)(L - 1);
            else { const int fi = (j - 1) & 15; const float freq = 1e-4f + (float)fi * ((15.0f - 1e-4f) / 15.0f);
                const float ang = ((float)(2.0 * 3.14159265358979323846 / L) * (float)t) * freq; z = (j <= 16) ? cosf(ang) : -sinf(ang); }
            zs[tl * 40 + j] = z; }
        __syncthreads();
        { const float* w1 = GIN(IN_W1) + (size_t)l * 33 * 64; float s = GIN(IN_B1)[l * 64 + j];
            for (int i = 0; i < 33; ++i) s += zs[tl * 40 + i] * w1[i * 64 + j];
            h1s[tl * 64 + j] = sinf(s); }
        __syncthreads();
        { const float* w2 = GIN(IN_W2) + (size_t)l * 64 * 64; float s = GIN(IN_B2)[l * 64 + j];
            for (int i = 0; i < 64; ++i) s += h1s[tl * 64 + i] * w2[i * 64 + j];
            bf16_t* dst = WSP(bf16_t, WS_HPAD) + ((size_t)l * 2304 + (isctx ? 2048 + t : t)) * 128;
            dst[j] = (bf16_t)f2bf(sinf(s)); dst[64 + j] = (bf16_t)0; }
        __syncthreads();
    }
    {
        const float* w3 = GIN(IN_W3); bf16_t* w3t = WSP(bf16_t, WS_W3T);
        for (int i = C.bid * NTHR + C.tid; i < 4 * 64 * 2048; i += C.G * NTHR) { const int l = i >> 17, k = (i >> 11) & 63, col = i & 2047;
            w3t[((size_t)l * 2048 + col) * 128 + k] = (bf16_t)f2bf(w3[i]); w3t[((size_t)l * 2048 + col) * 128 + 64 + k] = (bf16_t)0; }
    }
    if (C.bid == C.G - 1) {
        const float* lb = GIN(IN_LB); float* lower = WSP(float, WS_LOWER);
        for (int i = C.tid; i < 1024; i += NTHR) { const int d = i >> 9, c = i & 511; float v[4], mx = -3.4e38f, s = 0.f;
#pragma unroll
            for (int l = 0; l < 4; ++l) { v[l] = lb[(d * 4 + l) * 512 + c]; mx = fmaxf(mx, v[l]); }
#pragma unroll
            for (int l = 0; l < 4; ++l) { v[l] = expf(v[l] - mx); s += v[l]; }
            float cum = 0.f;
#pragma unroll
            for (int l = 0; l < 4; ++l) { if (l > 0) cum += v[l] / s; lower[(d * 4 + l) * 512 + c] = cum; } }
    }
}

__device__ __forceinline__ const float* xrow_src(const Ctx& C, int l, int row) {
    return l == 0 ? (row < NLAT ? GIN(IN_X) + (size_t)row * D : GIN(IN_CTX) + (size_t)(row - NLAT) * D) : WSP(const float, WS_XBUF) + (size_t)row * D;
}
__device__ __forceinline__ void transpose_item(const float* W, int K, int N, bf16_t* WT, LAS float* scr, int item, int lane) {
    const int nblk = N / 32, kb = item / nblk, nb = item % nblk, k0 = 64 * kb, n0 = 32 * nb;
    float wv[32];
#pragma unroll
    for (int i = 0; i < 32; ++i) wv[i] = W[(size_t)(k0 + 2 * i + (lane >> 5)) * N + n0 + (lane & 31)];
#pragma unroll
    for (int i = 0; i < 32; ++i) scr[(2 * i + (lane >> 5)) * 33 + (lane & 31)] = wv[i];
    LDS_WAIT(); asm volatile("" ::: "memory");
    const int c = lane & 7;
#pragma unroll
    for (int j = 0; j < 4; ++j) { const int n = (lane >> 3) + 8 * j; const LAS float* s = scr + (8 * c) * 33 + n;
        u32x4 o; o.x = pk2(s[0 * 33], s[1 * 33]); o.y = pk2(s[2 * 33], s[3 * 33]); o.z = pk2(s[4 * 33], s[5 * 33]); o.w = pk2(s[6 * 33], s[7 * 33]);
        *(u32x4*)(WT + (size_t)(n0 + n) * K + k0 + 8 * c) = o; }
    LDS_WAIT(); asm volatile("" ::: "memory");
}
__device__ __forceinline__ void phase_l1(const Ctx& C, int l) {
    const int gw = C.bid * NWAVES + C.wave, NGW = C.G * NWAVES;
    const float* mods = WSP(const float, WS_MODS) + (size_t)l * 9 * 6144;
    bf16_t* an = WSP(bf16_t, WS_R1);
    f32x4 nv[4];
    if (!(C.dry & 2)) {
    if (gw < NTOK) { const float* src = xrow_src(C, l, gw);
#pragma unroll
        for (int j = 0; j < 4; ++j) nv[j] = *(const f32x4*)(src + C.lane * 4 + 256 * j); }
    for (int row = gw; row < NTOK; row += NGW) {
        const float* md = mods + bidx(row) * 6144;
        f32x4 v[4]; float ss = 0.f;
#pragma unroll
        for (int j = 0; j < 4; ++j) v[j] = nv[j];
        if (row + NGW < NTOK) { const float* src = xrow_src(C, l, row + NGW);
#pragma unroll
            for (int j = 0; j < 4; ++j) nv[j] = *(const f32x4*)(src + C.lane * 4 + 256 * j); }
#pragma unroll
        for (int j = 0; j < 4; ++j) ss += (v[j].x * v[j].x + v[j].y * v[j].y) + (v[j].z * v[j].z + v[j].w * v[j].w);
        ss = wave_sum(ss); const float rinv = 1.0f / sqrtf(ss * (1.0f / D) + EPS);
#pragma unroll
        for (int j = 0; j < 4; ++j) { const int k = C.lane * 4 + 256 * j; const f32x4 sh = *(const f32x4*)(md + k), sc = *(const f32x4*)(md + 1024 + k);
            const f32x4 o = v[j] * rinv * (sc + 1.0f) + sh; u32x2 w; w.x = pk2(o.x, o.y); w.y = pk2(o.z, o.w);
            *(u32x2*)(an + (size_t)row * D + k) = w; }
    }
    }
    if (!(C.dry & 4)) {
        LAS float* scr = (LAS float*)(C.lds + C.wave * 16384);
        constexpr int I_IN = 16 * 128, I_OUT = 16 * 32, I_E = 128;
        constexpr int NIT = I_IN + I_OUT + 3 * 16 * I_E;
        for (int it = gw; it < NIT; it += NGW) {
            int r = it;
            if (r < I_IN) { transpose_item(GIN(IN_WIN) + (size_t)l * D * DIN, D, DIN, WSP(bf16_t, WS_WIN), scr, r, C.lane); continue; } r -= I_IN;
            if (r < I_OUT) { transpose_item(GIN(IN_WOUT) + (size_t)l * D * D, D, D, WSP(bf16_t, WS_WOUT), scr, r, C.lane); continue; } r -= I_OUT;
            if (r < 16 * I_E) { const int e = r / I_E; transpose_item(GIN(IN_WG) + ((size_t)l * NE + e) * D * DE, D, DE, WSP(bf16_t, WS_WG) + (size_t)e * DE * D, scr, r % I_E, C.lane); continue; } r -= 16 * I_E;
            if (r < 16 * I_E) { const int e = r / I_E; transpose_item(GIN(IN_WU) + ((size_t)l * NE + e) * D * DE, D, DE, WSP(bf16_t, WS_WU) + (size_t)e * DE * D, scr, r % I_E, C.lane); continue; } r -= 16 * I_E;
            { const int e = r / I_E; transpose_item(GIN(IN_WD) + ((size_t)l * NE + e) * DE * D, DE, D, WSP(bf16_t, WS_WD) + (size_t)e * D * DE, scr, r % I_E, C.lane); }
        }
    }
    __syncthreads();
    {
        LAS f32x2* T = (LAS f32x2*)C.lds;
        const int team = C.tid >> 7, tt = C.tid & 127;
        LAS f32x2* X = (LAS f32x2*)(C.lds + 16384) + team * XPAD16;
        LAS float* hbs = (LAS float*)(C.lds + 16384 + 4 * XPAD16 * 8) + team * 2048;
        LAS float* reds = (LAS float*)(C.lds + 16384 + 4 * XPAD16 * 8 + 32768);
        build_twiddles(C, T);
        __syncthreads();
        const bf16_t* hfl = WSP(const bf16_t, WS_HF) + (size_t)l * 2048 * 2304;
        f32x2* kspec = WSP(f32x2, WS_KSPEC);
        if (!(C.dry & 8))
        for (int item = C.bid; item < 256; item += C.G) {
            const int idx = item * 4 + team, o = idx >> 9, c = idx & 511;
            const int colf = o * 1024 + c, colb = colf + 512;
            const bf16_t* hfp = hfl + (size_t)colf * 2304; const bf16_t* hbp = hfl + (size_t)colb * 2304;
            float hf[16], hb[16], s = 0.f;
#pragma unroll
            for (int j = 0; j < 16; ++j) { const int t = tt + 128 * j; hf[j] = bf2f(hfp[t]); hb[j] = bf2f(hbp[t]); s += fabsf(hf[j]) + fabsf(hb[j]); }
            s = wave_sum(s);
            if (C.lane == 0) reds[C.wave] = s;
            __syncthreads();
            const float inv = 1.0f / ((reds[team * 2] + reds[team * 2 + 1]) * 4096.0f);
#pragma unroll
            for (int j = 0; j < 16; ++j) { hf[j] *= inv; hbs[tt + 128 * j] = hb[j] * inv; }
            __syncthreads();
            f32x2* kout = kspec + ((size_t)(o * 512 + c) * 2) * 2048;
            f32x2 vv[16];
#pragma unroll
            for (int j = 0; j < 16; ++j) { const int n = tt + 128 * j; const float kb = n > 0 ? hbs[2048 - n] : 0.f; vv[j] = (f32x2){hf[j] + kb, 0.f}; }
            fft_fwd_store16(vv, X, T, kout, tt);
#pragma unroll
            for (int j = 0; j < 16; ++j) { const int n = tt + 128 * j; const float kb = n > 0 ? hbs[2048 - n] : 0.f; const float dd = hf[j] - kb; const f32x2 tw = T[n]; vv[j] = (f32x2){dd * tw.x, dd * tw.y}; }
            fft_fwd_store16(vv, X, T, kout + 2048, tt);
        }
        if (l < DEPTH - 1 && !(C.dry & 16)) {
            f32x2* kspc = WSP(f32x2, WS_KSPC);
            for (int item = C.bid; item < 256; item += C.G) {
                const int idx = item * 4 + team, o = idx >> 9, c = idx & 511;
                const int colf = o * 1024 + c, colb = colf + 512;
                float af0 = bf2f(hfl[(size_t)colf * 2304 + 2048 + tt]), af1 = bf2f(hfl[(size_t)colf * 2304 + 2048 + 128 + tt]);
                float ab0 = bf2f(hfl[(size_t)colb * 2304 + 2048 + tt]), ab1 = bf2f(hfl[(size_t)colb * 2304 + 2048 + 128 + tt]);
                __syncthreads();
                const float s = wave_sum((fabsf(af0) + fabsf(af1)) + (fabsf(ab0) + fabsf(ab1)));
                if (C.lane == 0) reds[C.wave] = s;
                __syncthreads();
                const float inv = 1.0f / ((reds[team * 2] + reds[team * 2 + 1]) * 2048.0f);
                af0 *= inv; af1 *= inv; hbs[tt] = ab0 * inv; hbs[128 + tt] = ab1 * inv;
                __syncthreads();
                f32x2 vk[16];
#pragma unroll
                for (int j = 0; j < 16; ++j) vk[j] = (f32x2){0.f, 0.f};
                vk[0] = (f32x2){af0, 0.f}; vk[1] = (f32x2){af1, 0.f};
                vk[14] = (f32x2){tt > 0 ? hbs[256 - tt] : 0.f, 0.f};
                vk[15] = (f32x2){hbs[128 - tt], 0.f};
                fft_fwd_store16(vk, X, T, kspc + (size_t)(o * 512 + c) * 2048, tt);
            }
        }
    }
}

struct Taps { unsigned w1, wx; };
struct TapSel { unsigned m, c, p; };
__device__ __forceinline__ Taps sc_load(const LAS bf16_t* raw, int t) { const int e = t & ~1; Taps r; r.w1 = *(const LAS unsigned*)(raw + e); r.wx = *(const LAS unsigned*)(raw + e - 2 + 4 * (t & 1)); return r; }
__device__ __forceinline__ TapSel sc_sel(int t, bool has_m, bool has_p) { TapSel s; const bool odd = (t & 1) != 0;
    s.m = has_m ? (odd ? 0x01000c0cu : 0x07060c0cu) : 0x0c0c0c0cu; s.c = odd ? 0x03020c0cu : 0x01000c0cu; s.p = has_p ? (odd ? 0x05040c0cu : 0x03020c0cu) : 0x0c0c0c0cu; return s; }
__device__ __forceinline__ float sc_eval(const Taps r, const TapSel s, float w0, float w1, float w2, float bias) {
    const float pm = __builtin_bit_cast(float, __builtin_amdgcn_perm(r.wx, r.w1, s.m)), pc = __builtin_bit_cast(float, __builtin_amdgcn_perm(r.wx, r.w1, s.c)), pp = __builtin_bit_cast(float, __builtin_amdgcn_perm(r.wx, r.w1, s.p));
    return w0 * pm + w1 * pc + w2 * pp + bias; }
constexpr int HY_CH = 4, HY_ITEMS = 4 * (512 / HY_CH), HYC_ITEMS = 512 / 4;
__device__ __forceinline__ void hyena_lat(const Ctx& C, int l, int item) {
    const int bp = item & 3, cg = item >> 2, team = C.tid >> 7, tt = C.tid & 127;
    LAS f32x2* T = (LAS f32x2*)C.lds;
    LAS f32x2* X = (LAS f32x2*)(C.lds + 16384) + team * XPAD16;
    LAS bf16_t* raw = (LAS bf16_t*)(C.lds + 16384 + 4 * XPAD16 * 8) + team * 4096;
    const bf16_t* phyt = WSP(const bf16_t, WS_PHYT);
    const float* cw = GIN(IN_CONVW) + (size_t)l * 3 * NHY; const float* cb = GIN(IN_CONVB) + (size_t)l * NHY;
    const float* hyb = GIN(IN_HYBIAS) + (size_t)l * 2 * DH;
    const f32x2* kspec = WSP(const f32x2, WS_KSPEC);
    const int ba = 2 * bp, c = cg * 4 + team;
    f32x2 z[16], acc[16], v[16];
#pragma unroll 1
    for (int stage = 0; stage < 3; ++stage) {
        const int ch = stage * 512 + c;
        __syncthreads();
#pragma unroll
        for (int k = 0; k < 4; ++k) { const int q = tt + 128 * k, rr = q >> 8, cc = q & 255;
            *(LAS u32x4*)(raw + rr * 2048 + cc * 8) = *(const u32x4*)(phyt + (size_t)ch * NTOK + (size_t)(ba + rr) * 2048 + cc * 8); }
        __syncthreads();
        const float w0 = cw[ch], w1 = cw[NHY + ch], w2 = cw[2 * NHY + ch], bs = cb[ch];
        const float dsk = stage > 0 ? hyb[(stage - 1) * DH + c] : 0.f;
        const TapSel ts = sc_sel(tt, (tt & 63) != 0, (tt & 63) != 63);
#pragma unroll
        for (int hb = 0; hb < 2; ++hb) {
            Taps ra[8], rb[8];
#pragma unroll
            for (int j = 0; j < 8; ++j) { const int t = tt + 128 * (8 * hb + j); ra[j] = sc_load(raw, t); rb[j] = sc_load(raw + 2048, t); }
            __builtin_amdgcn_sched_barrier(0); asm volatile("s_waitcnt lgkmcnt(0)" ::: "memory"); __builtin_amdgcn_sched_barrier(0);
#pragma unroll
            for (int j = 0; j < 8; ++j) { const int jj = 8 * hb + j;
                const float sa = sc_eval(ra[j], ts, w0, w1, w2, bs), sb = sc_eval(rb[j], ts, w0, w1, w2, bs);
                if (stage == 0) z[jj] = (f32x2){sa, sb};
                else { const f32x2 cv = acc[jj] + z[jj] * dsk; z[jj] = (f32x2){sa * cv.x, sb * cv.y}; } }
        }
        if (stage == 2) {
            LAS bf16_t* ob = (LAS bf16_t*)X;
#pragma unroll
            for (int j = 0; j < 16; ++j) { const int t = tt + 128 * j; ob[t] = (bf16_t)f2bf(z[j].x); ob[2048 + t] = (bf16_t)f2bf(z[j].y); }
            break;
        }
        const f32x2* K = kspec + ((size_t)(stage * 512 + c) * 2) * 2048;
#pragma unroll
        for (int j = 0; j < 16; ++j) v[j] = z[j];
        fft_conv_half16(v, X, T, K, tt);
#pragma unroll
        for (int j = 0; j < 16; ++j) acc[j] = v[j];
#pragma unroll
        for (int j = 0; j < 16; ++j) v[j] = cmul(z[j], T[tt + 128 * j]);
        fft_conv_half16(v, X, T, K + 2048, tt);
#pragma unroll
        for (int j = 0; j < 16; ++j) acc[j] += cmulc(v[j], T[tt + 128 * j]);
    }
    __syncthreads();
    bf16_t* Y = WSP(bf16_t, WS_R1);
    for (int i = C.tid; i < 4096; i += NTHR) { const int b = i >> 11, t = i & 2047;
        const LAS bf16_t* o0 = (const LAS bf16_t*)((LAS f32x2*)(C.lds + 16384)) + i;
        u32x2 w; w.x = (unsigned)o0[0] | ((unsigned)o0[XPAD16 * 4] << 16); w.y = (unsigned)o0[2 * XPAD16 * 4] | ((unsigned)o0[3 * XPAD16 * 4] << 16);
        *(u32x2*)(Y + ((size_t)(ba + b) * 2048 + t) * D + cg * 4) = w; }
    __syncthreads();
}
__device__ __forceinline__ void hyena_ctx2(const Ctx& C, int l, int item) {
    const int team = C.tid >> 7, tt = C.tid & 127, c = item * 4 + team;
    LAS f32x2* T = (LAS f32x2*)C.lds;
    LAS f32x2* X = (LAS f32x2*)(C.lds + 16384) + team * XPAD16;
    LAS bf16_t* raw = (LAS bf16_t*)(C.lds + 16384 + 4 * XPAD16 * 8) + team * 4096;
    const bf16_t* phyt = WSP(const bf16_t, WS_PHYT);
    const float* cw = GIN(IN_CONVW) + (size_t)l * 3 * NHY; const float* cb = GIN(IN_CONVB) + (size_t)l * NHY;
    const float* hyb = GIN(IN_HYBIAS) + (size_t)l * 2 * DH;
    const f32x2* kspc = WSP(const f32x2, WS_KSPC);
    bf16_t* Y = WSP(bf16_t, WS_R1);
    f32x2 z[16], v[16];
#pragma unroll
    for (int j = 0; j < 16; ++j) { z[j] = (f32x2){0.f, 0.f}; v[j] = (f32x2){0.f, 0.f}; }
#pragma unroll 1
    for (int stage = 0; stage < 3; ++stage) {
        const int ch = stage * 512 + c;
        __syncthreads();
#pragma unroll
        for (int k = 0; k < 2; ++k) { const int q = tt + 128 * k; *(LAS u32x4*)(raw + q * 8) = *(const u32x4*)(phyt + (size_t)ch * NTOK + NLAT + q * 8); }
        __syncthreads();
        const float w0 = cw[ch], w1 = cw[NHY + ch], w2 = cw[2 * NHY + ch], bs = cb[ch];
        const float dsk = stage > 0 ? hyb[(stage - 1) * DH + c] : 0.f;
        Taps ra[8], rb[8];
#pragma unroll
        for (int p = 0; p < 4; ++p)
#pragma unroll
            for (int hh = 0; hh < 2; ++hh) { const int tok = hh * 128 + tt; ra[2 * p + hh] = sc_load(raw, (2 * p) * 256 + tok); rb[2 * p + hh] = sc_load(raw, (2 * p + 1) * 256 + tok); }
        __builtin_amdgcn_sched_barrier(0); asm volatile("s_waitcnt lgkmcnt(0)" ::: "memory"); __builtin_amdgcn_sched_barrier(0);
        const TapSel ts0 = sc_sel(tt, tt != 0, true), ts1 = sc_sel(tt, true, tt != 127);
#pragma unroll
        for (int p = 0; p < 4; ++p)
#pragma unroll
            for (int hh = 0; hh < 2; ++hh) { const int m = 4 * p + hh;
                const TapSel ts = hh ? ts1 : ts0;
                const float ua = sc_eval(ra[2 * p + hh], ts, w0, w1, w2, bs), ub = sc_eval(rb[2 * p + hh], ts, w0, w1, w2, bs);
                if (stage == 0) z[m] = (f32x2){ua, ub};
                else { const f32x2 cv = v[m] + z[m] * dsk; z[m] = (f32x2){ua * cv.x, ub * cv.y}; } }
        if (stage == 2) {
#pragma unroll
            for (int p = 0; p < 4; ++p)
#pragma unroll
                for (int hh = 0; hh < 2; ++hh) { const int m = 4 * p + hh, tok = hh * 128 + tt;
                    Y[(size_t)(NLAT + (2 * p) * 256 + tok) * D + c] = (bf16_t)f2bf(z[m].x); Y[(size_t)(NLAT + (2 * p + 1) * 256 + tok) * D + c] = (bf16_t)f2bf(z[m].y); }
            break;
        }
#pragma unroll
        for (int j = 0; j < 16; ++j) v[j] = z[j];
        fft_conv_half16(v, X, T, kspc + (size_t)(stage * 512 + c) * 2048, tt);
    }
}

constexpr int HG_QT = 0, HG_QP = 17408, HG_KP = 34816, HG_ST = 52224, HG_VT = 87040, HG_KH = 105472, HG_P = 123904, HG_SUB = 133120, HG_D = 135168;
__device__ __forceinline__ void hgrn_mfma(const Ctx& C, int item) {
    const int dir = item & 1, h = (item >> 1) & 3, b = item >> 3;
    LAS unsigned char* L = C.lds;
    const int lane = C.lane, w = C.wave, r = lane & 15, quad = lane >> 4;
    const int I = w >> 1, col = (w & 1) * 64 + lane;
    const bf16_t* phg = WSP(const bf16_t, WS_PHG);
    bf16_t* odir = WSP(bf16_t, WS_ODIR) + (size_t)dir * NTOK * 512;
    LAS float* subtot = (LAS float*)(L + HG_SUB); LAS float* Dv = (LAS float*)(L + HG_D);
    __syncthreads();
    unsigned z0_ = 0u; asm volatile("" : "+v"(z0_));
    const u32x4 zv_ = (u32x4){z0_, z0_, z0_, z0_}; const float zff_ = __builtin_bit_cast(float, z0_); const f32x4 zv4f_ = (f32x4){zff_, zff_, zff_, zff_};
    for (int i = C.tid; i < (128 * 272) / 16; i += NTHR) *(LAS u32x4*)(L + HG_ST + i * 16) = zv_;
    for (int i = C.tid; i < (64 * 144) / 16; i += NTHR) *(LAS u32x4*)(L + HG_P + i * 16) = zv_;
    f32x4 sacc[8];
#pragma unroll
    for (int t = 0; t < 8; ++t) sacc[t] = zv4f_;
    unsigned short qr[16], kr[16], vr[16];
    const int rstep = dir ? -1 : 1;
    const size_t colq = (size_t)h * 128 + col, colk = 1536 + (size_t)dir * 512 + h * 128 + col, colv = 512 + (size_t)h * 128 + col;
    auto chunk_row0 = [&](int ch) -> int { return ch < 4 ? NLAT + b * 256 + (dir ? 255 - ch * 64 : ch * 64) : b * 2048 + (dir ? 2047 - (ch - 4) * 64 : (ch - 4) * 64); };
    { const int row0 = chunk_row0(0) + rstep * 16 * I;
#pragma unroll
      for (int i = 0; i < 16; ++i) { const bf16_t* p = phg + (size_t)(row0 + rstep * i) * NHG; qr[i] = p[colq]; kr[i] = p[colk]; vr[i] = p[colv]; } }
    __syncthreads();
#pragma unroll 1
    for (int ch = 0; ch < 36; ++ch) {
        float cp[16]; float cq = 1.0f;
#pragma unroll
        for (int i = 0; i < 16; ++i) { cq *= 1.0f - bf2f(kr[i]); cp[i] = cq; }
        subtot[I * 128 + col] = cq;
        __syncthreads();
        const float s0 = subtot[col], s1 = subtot[128 + col], s2 = subtot[256 + col], s3 = subtot[384 + col];
        const float pre = (I > 0 ? s0 : 1.0f) * (I > 1 ? s1 : 1.0f) * (I > 2 ? s2 : 1.0f), erho = s0 * s1, eend = s2 * s3;
        const float ainv = pre * __builtin_amdgcn_rcpf(erho);
        unsigned khp[8], vtp[8];
#pragma unroll
        for (int i = 0; i < 16; i += 2) {
            const float e1a = cp[i] * ainv, e1b = cp[i + 1] * ainv, e2a = __builtin_amdgcn_rcpf(e1a), e2b = __builtin_amdgcn_rcpf(e1b);
            const float qpa = bf2f(qr[i]) * e1a, qpb = bf2f(qr[i + 1]) * e1b, kpa = bf2f(kr[i]) * e2a, kpb = bf2f(kr[i + 1]) * e2b;
            const unsigned wqp = pk2(qpa, qpb), wqt = pk2(qpa * erho, qpb * erho), wkp = pk2(kpa, kpb);
            const int srow = (16 * I + i) * 272 + col * 2;
            *(LAS bf16_t*)(L + HG_QP + srow) = (bf16_t)(wqp & 0xffffu); *(LAS bf16_t*)(L + HG_QP + srow + 272) = (bf16_t)(wqp >> 16);
            *(LAS bf16_t*)(L + HG_QT + srow) = (bf16_t)(wqt & 0xffffu); *(LAS bf16_t*)(L + HG_QT + srow + 272) = (bf16_t)(wqt >> 16);
            *(LAS bf16_t*)(L + HG_KP + srow) = (bf16_t)(wkp & 0xffffu); *(LAS bf16_t*)(L + HG_KP + srow + 272) = (bf16_t)(wkp >> 16);
            khp[i >> 1] = pk2(kpa * eend, kpb * eend);
            vtp[i >> 1] = (unsigned)vr[i] | ((unsigned)vr[i + 1] << 16);
        }
        *(LAS u32x4*)(L + HG_KH + col * 144 + I * 32) = (u32x4){khp[0], khp[1], khp[2], khp[3]};
        *(LAS u32x4*)(L + HG_KH + col * 144 + I * 32 + 16) = (u32x4){khp[4], khp[5], khp[6], khp[7]};
        *(LAS u32x4*)(L + HG_VT + col * 144 + I * 32) = (u32x4){vtp[0], vtp[1], vtp[2], vtp[3]};
        *(LAS u32x4*)(L + HG_VT + col * 144 + I * 32 + 16) = (u32x4){vtp[4], vtp[5], vtp[6], vtp[7]};
        if (I == 0) Dv[col] = erho * eend;
        const int crow0 = chunk_row0(ch);
        if (ch + 1 < 36) { const int row0 = chunk_row0(ch + 1) + rstep * 16 * I;
#pragma unroll
            for (int i = 0; i < 16; ++i) { const bf16_t* p = phg + (size_t)(row0 + rstep * i) * NHG; qr[i] = p[colq]; kr[i] = p[colk]; vr[i] = p[colv]; } }
        __syncthreads();
#pragma unroll 1
        for (int blk = w; blk < 10; blk += 8) {
            const int I2 = blk < 1 ? 0 : (blk < 3 ? 1 : (blk < 6 ? 2 : 3)), J2 = blk - (I2 * (I2 + 1)) / 2;
            f32x4 pa = zv4f_;
#pragma unroll
            for (int kk = 0; kk < 4; ++kk) {
                const bf16x8 a = *(const LAS bf16x8*)(L + HG_KP + (J2 * 16 + r) * 272 + (32 * kk + 8 * quad) * 2);
                const bf16x8 bq = *(const LAS bf16x8*)(L + HG_QP + (I2 * 16 + r) * 272 + (32 * kk + 8 * quad) * 2);
                pa = __builtin_amdgcn_mfma_f32_16x16x32_bf16(a, bq, pa, 0, 0, 0);
            }
            if (I2 == J2) {
#pragma unroll
                for (int rr = 0; rr < 4; ++rr) if (4 * quad + rr > r) pa[rr] = 0.f;
            }
            u32x2 pw; pw.x = pk2(pa[0], pa[1]); pw.y = pk2(pa[2], pa[3]);
            *(LAS u32x2*)(L + HG_P + (I2 * 16 + r) * 144 + (J2 * 16 + 4 * quad) * 2) = pw;
        }
        __syncthreads();
        {
            bf16x8 sfr[4];
#pragma unroll
            for (int kk = 0; kk < 4; ++kk) sfr[kk] = *(const LAS bf16x8*)(L + HG_ST + (16 * w + r) * 272 + (32 * kk + 8 * quad) * 2);
            const bf16x8 vf0 = *(const LAS bf16x8*)(L + HG_VT + (16 * w + r) * 144 + (8 * quad) * 2);
            const bf16x8 vf1 = *(const LAS bf16x8*)(L + HG_VT + (16 * w + r) * 144 + (32 + 8 * quad) * 2);
#pragma unroll
            for (int I3 = 0; I3 < 4; ++I3) {
                f32x4 oa = zv4f_;
#pragma unroll
                for (int kk = 0; kk < 4; ++kk) {
                    const bf16x8 bq = *(const LAS bf16x8*)(L + HG_QT + (I3 * 16 + r) * 272 + (32 * kk + 8 * quad) * 2);
                    oa = __builtin_amdgcn_mfma_f32_16x16x32_bf16(sfr[kk], bq, oa, 0, 0, 0);
                }
                { const bf16x8 bp = *(const LAS bf16x8*)(L + HG_P + (I3 * 16 + r) * 144 + (8 * quad) * 2);
                  oa = __builtin_amdgcn_mfma_f32_16x16x32_bf16(vf0, bp, oa, 0, 0, 0); }
                if (I3 >= 2) { const bf16x8 bp = *(const LAS bf16x8*)(L + HG_P + (I3 * 16 + r) * 144 + (32 + 8 * quad) * 2);
                  oa = __builtin_amdgcn_mfma_f32_16x16x32_bf16(vf1, bp, oa, 0, 0, 0); }
                const int row = crow0 + rstep * (16 * I3 + r);
                u32x2 ow; ow.x = pk2(oa[0], oa[1]); ow.y = pk2(oa[2], oa[3]);
                *(u32x2*)(odir + (size_t)row * 512 + h * 128 + 16 * w + 4 * quad) = ow;
            }
#pragma unroll
            for (int t = 0; t < 8; ++t) {
                const f32x4 dd = *(const LAS f32x4*)(L + HG_D + (16 * t + 4 * quad) * 4);
                f32x4 sa = sacc[t] * dd;
                const bf16x8 a0 = *(const LAS bf16x8*)(L + HG_KH + (16 * t + r) * 144 + (8 * quad) * 2);
                const bf16x8 a1 = *(const LAS bf16x8*)(L + HG_KH + (16 * t + r) * 144 + (32 + 8 * quad) * 2);
                sa = __builtin_amdgcn_mfma_f32_16x16x32_bf16(a0, vf0, sa, 0, 0, 0);
                sa = __builtin_amdgcn_mfma_f32_16x16x32_bf16(a1, vf1, sa, 0, 0, 0);
                sacc[t] = sa;
                u32x2 sw; sw.x = pk2(sa[0], sa[1]); sw.y = pk2(sa[2], sa[3]);
                *(LAS u32x2*)(L + HG_ST + (16 * w + r) * 272 + (16 * t + 4 * quad) * 2) = sw;
            }
        }
    }
    __syncthreads();
}
__device__ __forceinline__ void phase_l3(const Ctx& C, int l) {
    if (C.bid < 64) hgrn_mfma(C, C.bid);
    build_twiddles(C, (LAS f32x2*)C.lds);
    __syncthreads();
    unsigned* qh = WSP(unsigned, WS_CTL) + CW_Q + l * 64 + C.rep * 16;
    volatile LAS int* lc = (volatile LAS int*)(C.lds + LDSCTL_OFF);
    const int nitems = HY_ITEMS + (l < DEPTH - 1 ? HYC_ITEMS : 0);
    for (;;) {
        if (C.tid == 0) lc[LC_Q] = (int)__hip_atomic_fetch_add(qh, 1u, __ATOMIC_RELAXED, __HIP_MEMORY_SCOPE_AGENT);
        __syncthreads();
        const int item = lc[LC_Q];
        __syncthreads();
        if (item >= nitems) break;
        Ctx CI = C; { int t_ = C.tid; asm volatile("" : "+v"(t_)); CI.tid = t_; CI.lane = t_ & 63; }
        if (item < HY_ITEMS) hyena_lat(CI, l, item); else hyena_ctx2(CI, l, item - HY_ITEMS);
    }
}
__device__ __forceinline__ void phase_l3b(const Ctx& C, int l) {
    const int gw = C.bid * NWAVES + C.wave, NGW = C.G * NWAVES;
    const bf16_t* od0 = WSP(const bf16_t, WS_ODIR); const bf16_t* od1 = od0 + (size_t)NTOK * 512;
    const bf16_t* phg = WSP(const bf16_t, WS_PHG); bf16_t* Y = WSP(bf16_t, WS_R1);
    const float* nw = GIN(IN_NORMW) + l * 128;
    const int nrows = (l < DEPTH - 1) ? NTOK : NLAT;
    for (int row = gw; row < nrows; row += NGW) {
        const int idx = C.lane * 8;
        const u32x4 a = *(const u32x4*)(od0 + (size_t)row * 512 + idx), b = *(const u32x4*)(od1 + (size_t)row * 512 + idx), g = *(const u32x4*)(phg + (size_t)row * NHG + 1024 + idx);
        float o[8] = {bflo(a.x) + bflo(b.x), bfhi(a.x) + bfhi(b.x), bflo(a.y) + bflo(b.y), bfhi(a.y) + bfhi(b.y), bflo(a.z) + bflo(b.z), bfhi(a.z) + bfhi(b.z), bflo(a.w) + bflo(b.w), bfhi(a.w) + bfhi(b.w)};
        const float gg[8] = {bflo(g.x), bfhi(g.x), bflo(g.y), bfhi(g.y), bflo(g.z), bfhi(g.z), bflo(g.w), bfhi(g.w)};
        float ss = 0.f;
#pragma unroll
        for (int i = 0; i < 8; ++i) ss += o[i] * o[i];
        ss = row16_sum(ss);
        const float rinv = 1.0f / sqrtf(ss * (1.0f / 128.0f) + EPS);
        float y[8];
#pragma unroll
        for (int i = 0; i < 8; ++i) y[i] = o[i] * rinv * nw[(idx + i) & 127] * siluf_(gg[i]);
        u32x4 w; w.x = pk2(y[0], y[1]); w.y = pk2(y[2], y[3]); w.z = pk2(y[4], y[5]); w.w = pk2(y[6], y[7]);
        *(u32x4*)(Y + (size_t)row * D + 512 + idx) = w;
    }
}

constexpr int RW_PITCH = 1028;
__device__ __forceinline__ void phase_l5a(const Ctx& C, int l) {
    LAS float* rwT = (LAS float*)C.lds;
    LAS int* lcnt = (LAS int*)(C.lds + 16 * RW_PITCH * 4);
    LAS float* wsc = (LAS float*)(C.lds + 16 * RW_PITCH * 4 + 128) + C.wave * 384;
    const float* rw = GIN(IN_RW);
    for (int i = C.tid; i < 16 * 1024; i += NTHR) { const int k = i >> 4, e = i & 15; rwT[e * RW_PITCH + k] = rw[i]; }
    if (C.tid < 32) lcnt[C.tid] = 0;
    __syncthreads();
    const int gw = C.bid * NWAVES + C.wave, NGW = C.G * NWAVES;
    const float* mods = WSP(const float, WS_MODS) + (size_t)l * 9 * 6144;
    const float* bias2 = WSP(const float, WS_BIAS2) + l * 9 * 16;
    const float* xb = WSP(const float, WS_XBUF);
    const float* rbias = GIN(IN_RB);
    unsigned* cnt = WSP(unsigned, WS_CTL) + CW_CNT + l * 32 * 64;
    int* tokinfo = WSP(int, WS_TOKINFO);
    const int ngroups = ((l < DEPTH - 1) ? NTOK : NLAT) / 16;
    const int li = C.lane & 15, kq = C.lane >> 4;
    for (int g = gw; g < ngroups; g += NGW) {
        const int row0 = g * 16, bb = bidx(row0);
        const float* xp = xb + (size_t)(row0 + li) * D + kq * 4;
        const float* scp = mods + bb * 6144 + 4096 + kq * 4;
        const LAS float* bp = rwT + li * RW_PITCH + kq * 4;
        f32x4 acc0 = (f32x4){0.f, 0.f, 0.f, 0.f}, acc1 = acc0, acc2 = acc0, acc3 = acc0; float ss = 0.f;
#pragma unroll 8
        for (int m = 0; m < 64; ++m) {
            const f32x4 xv = *(const f32x4*)(xp + 16 * m), sc = *(const f32x4*)(scp + 16 * m), bv = *(const LAS f32x4*)(bp + 16 * m);
            ss += (xv.x * xv.x + xv.y * xv.y) + (xv.z * xv.z + xv.w * xv.w);
            const f32x4 av = xv * (sc + 1.0f);
            acc0 = __builtin_amdgcn_mfma_f32_16x16x4f32(av.x, bv.x, acc0, 0, 0, 0);
            acc1 = __builtin_amdgcn_mfma_f32_16x16x4f32(av.y, bv.y, acc1, 0, 0, 0);
            acc2 = __builtin_amdgcn_mfma_f32_16x16x4f32(av.z, bv.z, acc2, 0, 0, 0);
            acc3 = __builtin_amdgcn_mfma_f32_16x16x4f32(av.w, bv.w, acc3, 0, 0, 0);
        }
        const f32x4 acc = (acc0 + acc1) + (acc2 + acc3);
        wsc[C.lane] = ss;
#pragma unroll
        for (int r = 0; r < 4; ++r) wsc[64 + (4 * kq + r) * 17 + li] = acc[r];
        LDS_WAIT(); asm volatile("" ::: "memory");
        if (C.lane < 16) {
            const int row = row0 + C.lane;
            const float sst = (wsc[C.lane] + wsc[16 + C.lane]) + (wsc[32 + C.lane] + wsc[48 + C.lane]);
            const float rinv = 1.0f / sqrtf(sst * (1.0f / D) + EPS);
            float lg[16];
#pragma unroll
            for (int e = 0; e < 16; ++e) lg[e] = rinv * wsc[64 + C.lane * 17 + e] + bias2[bb * 16 + e];
            float mx = lg[0];
#pragma unroll
            for (int e = 1; e < 16; ++e) mx = fmaxf(mx, lg[e]);
            float sc[16], se = 0.f;
#pragma unroll
            for (int e = 0; e < 16; ++e) { sc[e] = expf(lg[e] - mx); se += sc[e]; }
            float sel[16];
#pragma unroll
            for (int e = 0; e < 16; ++e) { sc[e] = sc[e] / se; sel[e] = sc[e] + rbias[e]; }
            float bestgs = -3.4e38f; int bg = 0; float bs[4], bsc[4];
#pragma unroll
            for (int gg = 0; gg < 4; ++gg) {
                float m1 = -3.4e38f, m2 = -3.4e38f;
#pragma unroll
                for (int i = 0; i < 4; ++i) { const float x = sel[4 * gg + i]; if (x > m1) { m2 = m1; m1 = x; } else if (x > m2) m2 = x; }
                const float gs = m1 + m2;
                if (gs > bestgs) { bestgs = gs; bg = gg;
#pragma unroll
                    for (int i = 0; i < 4; ++i) { bs[i] = sel[4 * gg + i]; bsc[i] = sc[4 * gg + i]; } }
            }
            int i0 = 0; float b0 = bs[0];
#pragma unroll
            for (int i = 1; i < 4; ++i) if (bs[i] > b0) { b0 = bs[i]; i0 = i; }
            int i1 = -1; float b1 = -3.4e38f;
#pragma unroll
            for (int i = 0; i < 4; ++i) if (i != i0 && bs[i] > b1) { b1 = bs[i]; i1 = i; }
            float w0 = 0.f, w1 = 0.f;
#pragma unroll
            for (int i = 0; i < 4; ++i) { if (i == i0) w0 = bsc[i]; if (i == i1) w1 = bsc[i]; }
            const float wn = w0 + w1; w0 /= wn; w1 /= wn;
            const int lo = i0 < i1 ? i0 : i1, hi = i0 < i1 ? i1 : i0;
            const float wlo = i0 < i1 ? w0 : w1, whi = i0 < i1 ? w1 : w0;
            const int bin = bg * 6 + (lo * (7 - lo)) / 2 + (hi - lo - 1);
            const int slot = __hip_atomic_fetch_add(lcnt + bin, 1, __ATOMIC_RELAXED, __HIP_MEMORY_SCOPE_WORKGROUP);
            *(int4*)(tokinfo + (size_t)row * 4) = make_int4(bin, slot, __float_as_int(wlo), __float_as_int(whi));
        }
        LDS_WAIT(); asm volatile("" ::: "memory");
    }
    __syncthreads();
    if (C.tid < NBIN && !C.dry) { const int n = lcnt[C.tid];
        WSP(int, WS_BLKBASE)[C.bid * 32 + C.tid] = n > 0 ? (int)__hip_atomic_fetch_add(cnt + C.tid * 64, (unsigned)n, __ATOMIC_RELAXED, __HIP_MEMORY_SCOPE_AGENT) : 0; }
}
__device__ __forceinline__ void phase_l5b(const Ctx& C, int l) {
    build_tiletab(C, l);
    const volatile LAS int* lc = (const volatile LAS int*)(C.lds + LDSCTL_OFF);
    const int gw = C.bid * NWAVES + C.wave, NGW = C.G * NWAVES;
    const float* mods = WSP(const float, WS_MODS) + (size_t)l * 9 * 6144;
    const float* xb = WSP(const float, WS_XBUF);
    const int* tokinfo = WSP(const int, WS_TOKINFO); const int* blkbase = WSP(const int, WS_BLKBASE);
    bf16_t* hs = WSP(bf16_t, WS_PHG); int* rowtok = WSP(int, WS_ROWTOK); float* roww = WSP(float, WS_ROWW);
    const int nrows = (l < DEPTH - 1) ? NTOK : NLAT;
    f32x4 nv[4]; int4 nti = make_int4(0, 0, 0, 0);
    if (gw < nrows) { nti = *(const int4*)(tokinfo + (size_t)gw * 4);
#pragma unroll
        for (int j = 0; j < 4; ++j) nv[j] = *(const f32x4*)(xb + (size_t)gw * D + C.lane * 4 + 256 * j); }
    for (int row = gw; row < nrows; row += NGW) {
        const int4 ti = nti;
        const int pos = lc[LC_OFFS + ti.x] + blkbase[(((row >> 4) % NGW) >> 3) * 32 + ti.x] + ti.y;
        const float* md = mods + bidx(row) * 6144;
        f32x4 v[4]; float ss = 0.f;
#pragma unroll
        for (int j = 0; j < 4; ++j) v[j] = nv[j];
        if (row + NGW < nrows) { nti = *(const int4*)(tokinfo + (size_t)(row + NGW) * 4);
#pragma unroll
            for (int j = 0; j < 4; ++j) nv[j] = *(const f32x4*)(xb + (size_t)(row + NGW) * D + C.lane * 4 + 256 * j); }
#pragma unroll
        for (int j = 0; j < 4; ++j) ss += (v[j].x * v[j].x + v[j].y * v[j].y) + (v[j].z * v[j].z + v[j].w * v[j].w);
        ss = wave_sum(ss); const float rinv = 1.0f / sqrtf(ss * (1.0f / D) + EPS);
#pragma unroll
        for (int j = 0; j < 4; ++j) { const int k = C.lane * 4 + 256 * j; const f32x4 sh = *(const f32x4*)(md + 3072 + k), sc = *(const f32x4*)(md + 4096 + k);
            const f32x4 o = v[j] * rinv * (sc + 1.0f) + sh; u32x2 w; w.x = pk2(o.x, o.y); w.y = pk2(o.z, o.w);
            *(u32x2*)(hs + (size_t)pos * D + k) = w; }
        if (C.lane == 0) { rowtok[pos] = row; roww[pos * 2] = __int_as_float(ti.z); roww[pos * 2 + 1] = __int_as_float(ti.w); }
    }
    if (C.bid < NBIN) { const int b = C.bid; const int start = lc[LC_OFFS + b], end = lc[LC_OFFS + b + 1];
        const int n = (int)__hip_atomic_load(WSP(unsigned, WS_CTL) + CW_CNT + (l * 32 + b) * 64, __ATOMIC_RELAXED, __HIP_MEMORY_SCOPE_AGENT);
        float zf_ = 0.f; asm volatile("" : "+v"(zf_));
        for (int p = start + n + C.tid; p < end; p += NTHR) { rowtok[p] = -1; roww[p * 2] = zf_; roww[p * 2 + 1] = zf_; } }
}

__device__ __forceinline__ void phase_final(const Ctx& C) {
    const int gw = C.bid * NWAVES + C.wave, NGW = C.G * NWAVES;
    const float* xb = WSP(const float, WS_XBUF); const float* fw = GIN(IN_FNW);
    f32x4 nv[4];
    if (gw < NLAT) {
#pragma unroll
        for (int j = 0; j < 4; ++j) nv[j] = *(const f32x4*)(xb + (size_t)gw * D + C.lane * 4 + 256 * j); }
    for (int row = gw; row < NLAT; row += NGW) {
        f32x4 v[4]; float ss = 0.f;
#pragma unroll
        for (int j = 0; j < 4; ++j) v[j] = nv[j];
        if (row + NGW < NLAT) {
#pragma unroll
            for (int j = 0; j < 4; ++j) nv[j] = *(const f32x4*)(xb + (size_t)(row + NGW) * D + C.lane * 4 + 256 * j); }
#pragma unroll
        for (int j = 0; j < 4; ++j) ss += (v[j].x * v[j].x + v[j].y * v[j].y) + (v[j].z * v[j].z + v[j].w * v[j].w);
        ss = wave_sum(ss); const float rinv = 1.0f / sqrtf(ss * (1.0f / D) + EPS);
#pragma unroll
        for (int j = 0; j < 4; ++j) { const int k = C.lane * 4 + 256 * j; const f32x4 w = *(const f32x4*)(fw + k);
            *(f32x4*)(C.out + (size_t)row * D + k) = v[j] * rinv * w; }
    }
}

constexpr int PH_PER_LAYER = 8, N_PHASES = 2 + DEPTH * PH_PER_LAYER + 1;
__global__ void __launch_bounds__(NTHR, 2) trunk_fwd(Args args) {
    extern __shared__ __attribute__((aligned(16))) unsigned char lds[];
    Ctx C; C.in = (const CAS fptr_t*)__builtin_amdgcn_kernarg_segment_ptr(); C.out = args.out; C.ws = (GAS unsigned char*)args.ws; C.lds = (LAS unsigned char*)lds;
    C.tid = threadIdx.x; C.lane = C.tid & 63; C.wave = __builtin_amdgcn_readfirstlane(C.tid >> 6); C.G = gridDim.x; C.bid = blockIdx.x; C.rep = args.rep; C.dry = (args.rep + 1 < (args.pad & 255)) ? (args.pad >> 8) : 0;
    LAS unsigned char* ldsl0 = (LAS unsigned char*)lds;
    if (C.tid < 64) ((LAS unsigned*)(ldsl0 + LDSCTL_OFF))[C.tid] = 0u;
    __syncthreads();
    const int lo = args.ph_lo, hi = args.ph_hi;
    XcdBarrier bar; bar.bar = WSP(unsigned, WS_CTL) + CW_BAR; bar.x = 0; bar.st = (volatile LAS unsigned*)(ldsl0 + LDSCTL_OFF + LC_BAR);
    if (hi - lo > 1) bar = xcd_barrier_post(WSP(unsigned, WS_CTL) + CW_BAR, (volatile LAS unsigned*)(ldsl0 + LDSCTL_OFF + LC_BAR));
    { unsigned blo_ = __builtin_amdgcn_readfirstlane((unsigned)(unsigned long long)bar.bar), bhi_ = __builtin_amdgcn_readfirstlane((unsigned)((unsigned long long)bar.bar >> 32));
      asm volatile("" : "+s"(blo_), "+s"(bhi_)); bar.bar = (unsigned*)(((unsigned long long)bhi_ << 32) | blo_); }
#define FRESH_TID (C.wave * 64 + lane_id_opaque())
#define IN(k) (lo <= (k) && (k) < hi)
#define SEAM(k) do { if (IN(k) && IN((k) + 1)) xcd_barrier(bar, FRESH_TID); } while (0)
#ifndef EN
#define EN 0xFFFF
#endif
    if ((EN & 1) && IN(0)) { phase0(C); SEAM(0); }
    if ((EN & 1) && IN(1)) {
        {
            const float* md = WSP(const float, WS_MODS); const float* rw = GIN(IN_RW); float* b2 = WSP(float, WS_BIAS2);
            for (int o = C.bid * NWAVES + C.wave; o < 4 * 9 * 16; o += C.G * NWAVES) { const int lr = o >> 4, e = o & 15; const float* sh = md + (size_t)lr * 6144 + 3072; float sacc = 0.f;
#pragma unroll
                for (int j = 0; j < 16; ++j) { const int k = C.lane + 64 * j; sacc += sh[k] * rw[k * 16 + e]; }
                sacc = wave_sum(sacc);
                if (C.lane == 0) b2[o] = sacc; }
        }
        SchedFilt S{C.G, C.bid};
        EpiFilt E{WSP(bf16_t, WS_HF), GIN(IN_B3)};
        pg8::gemm_phase<false>(ldsl0, S, E, (const char*)WSP(bf16_t, WS_W3T), (const char*)WSP(bf16_t, WS_HPAD), 128, 128, 128u * 128u * 2u, 128u * 128u * 2u, 2, FRESH_TID);
        SEAM(1);
    }
    const Ctx C0 = C;
#pragma unroll 1
    for (int l = 0; l < DEPTH; ++l) {
        const int p0 = 2 + l * PH_PER_LAYER;
        Ctx C = C0; { int t_ = C0.wave * 64 + lane_id_opaque(); asm volatile("" : "+v"(t_)); C.tid = t_; C.lane = t_ & 63; C.wave = __builtin_amdgcn_readfirstlane(t_ >> 6);
                      int b_ = C0.bid; asm volatile("" : "+s"(b_)); C.bid = b_; int g_ = C0.G; asm volatile("" : "+s"(g_)); C.G = g_; GAS unsigned char* w_ = C0.ws; asm volatile("" : "+s"(w_)); C.ws = w_;
                      const CAS fptr_t* i_ = C0.in; asm volatile("" : "+s"(i_)); C.in = i_;
                      LAS unsigned char* l_ = C0.lds; asm volatile("" : "+s"(l_)); C.lds = l_; }
        LAS unsigned char* const ldsl = C.lds;
        const float* modl = WSP(const float, WS_MODS) + (size_t)l * 9 * 6144;
        if ((EN & 2) && IN(p0 + 0)) { phase_l1(C, l); SEAM(p0 + 0); }
        if ((EN & 4) && IN(p0 + 1)) {
            { pg8::SchedDense S; S.init(NTOK / 256, NHG / 256, C.G, C.bid, D, D);
              EpiHG E{WSP(bf16_t, WS_PHG), WSP(const float, WS_LOWER) + l * 512};
              pg8::gemm_phase<false>(ldsl, S, E, (const char*)WSP(bf16_t, WS_R1), (const char*)(WSP(bf16_t, WS_WIN) + (size_t)NHY * D), D, D, 128u * D * 2u, 128u * D * 2u, D / 64, FRESH_TID); }
            { pg8::SchedDense S; S.init(NHY / 256, NTOK / 256, C.G, C.bid, D, D);
              EpiHY E{WSP(bf16_t, WS_PHYT)};
              pg8::gemm_phase<false>(ldsl, S, E, (const char*)WSP(bf16_t, WS_WIN), (const char*)WSP(bf16_t, WS_R1), D, D, 128u * D * 2u, 128u * D * 2u, D / 64, FRESH_TID); }
            SEAM(p0 + 1);
        }
        if ((EN & 8) && IN(p0 + 2)) { phase_l3(C, l); SEAM(p0 + 2); }
        if ((EN & 16) && IN(p0 + 3)) { phase_l3b(C, l); SEAM(p0 + 3); }
        if ((EN & 32) && IN(p0 + 4)) {
            pg8::SchedDense S; S.init(NTOK / 256, D / 256, C.G, C.bid, D, D);
            EpiOut E{GIN(IN_X), GIN(IN_CTX), WSP(float, WS_XBUF), modl, l == 0 ? 1 : 0, C.dry};
            pg8::gemm_phase<false>(ldsl, S, E, (const char*)WSP(bf16_t, WS_R1), (const char*)WSP(bf16_t, WS_WOUT), D, D, 128u * D * 2u, 128u * D * 2u, D / 64, FRESH_TID);
            SEAM(p0 + 4);
        }
        if ((EN & 64) && IN(p0 + 5)) { phase_l5a(C, l); SEAM(p0 + 5); }
        if ((EN & 128) && IN(p0 + 6)) { phase_l5b(C, l); SEAM(p0 + 6); }
        if ((EN & 256) && IN(p0 + 7)) {
            build_tiletab(C, l);
            const volatile LAS int* lc = (const volatile LAS int*)(ldsl + LDSCTL_OFF);
            const int n6 = 4 * lc[LC_T];
            unsigned* cnt6 = WSP(unsigned, WS_CTL) + CW_T6 + l * 96 * 64;
#pragma unroll 1
            for (int idx = C.bid; idx < n6; idx += C.G) {
                SchedUp1 S{idx, lc + LC_TILEBIN};
                EpiAct E{WSP(bf16_t, WS_R1), WSP(const float, WS_ROWW)};
                pg8::gemm_phase<false>(ldsl, S, E, (const char*)WSP(bf16_t, WS_PHG), (const char*)WSP(bf16_t, WS_WG), D, D, 128u * D * 2u, (unsigned)(WS_WU - WS_WG), D / 64, FRESH_TID);
                asm volatile("s_waitcnt vmcnt(0)" ::: "memory");
                __syncthreads();
                if (C.wave * 64 + lane_id_opaque() == 0) {
                    __hip_atomic_fetch_add(cnt6 + (idx >> 2) * 64, 1u, __ATOMIC_RELAXED, __HIP_MEMORY_SCOPE_AGENT); }
            }
            int nb2 = n6 - C.G; nb2 = nb2 < 0 ? 0 : (nb2 > C.G - 64 ? C.G - 64 : nb2);
            const int nw = C.G - nb2;
            if (C.bid >= nb2) {
#pragma unroll 1
                for (int j = C.bid - nb2; j < n6; j += nw) {
                    if (C.wave * 64 + lane_id_opaque() == 0) { unsigned* cw = cnt6 + (j >> 2) * 64; unsigned sp = 0;
                        while (__hip_atomic_load(cw, __ATOMIC_RELAXED, __HIP_MEMORY_SCOPE_AGENT) < 4u) { __builtin_amdgcn_s_sleep(2); if (++sp > (1u << 22)) break; }
                        __builtin_amdgcn_fence(__ATOMIC_ACQUIRE, "agent"); asm volatile("s_waitcnt vmcnt(0)" ::: "memory"); }
                    __syncthreads();
                    SchedDown1 S{j, lc + LC_TILEBIN};
                    EpiDown E{WSP(float, WS_XBUF), WSP(const int, WS_ROWTOK), modl, C.dry};
                    pg8::gemm_phase<true>(ldsl, S, E, (const char*)WSP(bf16_t, WS_R1), (const char*)WSP(bf16_t, WS_WD), 512, 256, 128u * 512u * 2u, 128u * 256u * 2u, 4, FRESH_TID);
                }
            }
            SEAM(p0 + 7);
        }
    }
    if ((EN & 1024) && IN(N_PHASES - 1)) { Ctx CF = C0; CF.tid = C0.wave * 64 + lane_id_opaque(); CF.lane = CF.tid & 63; phase_final(CF); }
#undef IN
#undef SEAM
}

extern "C" void kernel_launch(void* const* d_in, const int* in_sizes, int n_in, void* d_out, int out_size, void* d_ws, size_t ws_size, hipStream_t stream) {
    static int grid = 0;
    if (grid == 0) {
        if (n_in != N_IN || in_sizes[0] != NLAT * D || out_size != NLAT * D || ws_size < WS_END) { fprintf(stderr, "kernel_launch: unexpected shapes / workspace (%d inputs, ws %zu < %zu)\n", n_in, ws_size, (size_t)WS_END); grid = -1; return; }
        int dev = 0, cus = 0, per_cu = 0;
        if (hipGetDevice(&dev) != hipSuccess || hipDeviceGetAttribute(&cus, hipDeviceAttributeMultiprocessorCount, dev) != hipSuccess) { grid = -1; return; }
        if (hipFuncSetAttribute((const void*)trunk_fwd, hipFuncAttributeMaxDynamicSharedMemorySize, LDS_BYTES) != hipSuccess) { fprintf(stderr, "kernel_launch: hipFuncSetAttribute failed\n"); grid = -1; return; }
        if (hipOccupancyMaxActiveBlocksPerMultiprocessor(&per_cu, (const void*)trunk_fwd, NTHR, LDS_BYTES) != hipSuccess || per_cu < 1) { fprintf(stderr, "kernel_launch: occupancy query says %d\n", per_cu); }
        (void)hipGetLastError();
        grid = cus;
    }
    if (grid < 0) return;
    (void)hipMemsetAsync((char*)d_ws + WS_CTL, 0, CTL_ZERO_BYTES, stream);
    Args a{};
    for (int i = 0; i < N_IN; ++i) a.in[i] = (const float*)d_in[i];
    a.out = (float*)d_out; a.ws = (unsigned char*)d_ws;
#if MK_PER_PHASE
    for (int p = 0; p < N_PHASES; ++p) { a.ph_lo = p; a.ph_hi = p + 1; const int kind = p == 0 ? 0 : (p == 1 ? 11 : (p == N_PHASES - 1 ? 10 : 1 + (p - 2) % PH_PER_LAYER));
        const int nrep = ((PROBE_HOST >> kind) & 1) ? 2 : 1; a.pad = nrep | (PROBE_SKIP << 8);
        for (int rep = 0; rep < nrep; ++rep) { a.rep = rep; hipLaunchKernelGGL(trunk_fwd, dim3(grid), dim3(NTHR), LDS_BYTES, stream, a); } }
#else
    a.ph_lo = 0; a.ph_hi = N_PHASES; a.rep = 0; a.pad = 1;
    hipLaunchKernelGGL(trunk_fwd, dim3(grid), dim3(NTHR), LDS_BYTES, stream, a);
#endif
}
```

```cpp
#include <hip/hip_runtime.h>
#include <cstdio>
#include <cstdint>

#ifndef PROBE_HOST
#define PROBE_HOST 0
#endif
#ifndef PROBE_SKIP
#define PROBE_SKIP 1
#endif
#ifndef MK_PER_PHASE
#define MK_PER_PHASE 0
#endif

#define LAS __attribute__((address_space(3)))
#define GAS __attribute__((address_space(1)))
typedef unsigned short bf16_t;
typedef short bf16x8 __attribute__((ext_vector_type(8)));
typedef float f32x4 __attribute__((ext_vector_type(4)));
typedef float f32x2 __attribute__((ext_vector_type(2)));
typedef unsigned u32x4 __attribute__((ext_vector_type(4)));
typedef unsigned u32x2 __attribute__((ext_vector_type(2)));

constexpr int NB = 8, SEQ = 2048, D = 1024, DEPTH = 4, CTXL = 256;
constexpr int NLAT = NB * SEQ, NCTX = NB * CTXL, NTOK = NLAT + NCTX;
constexpr int DH = 512, NHY = 1536, NHG = 2560, DIN = 4096;
constexpr int NE = 16, DE = 256, NBIN = 24, SROWS = 24576;
constexpr float EPS = 1e-6f;
constexpr int NTHR = 512, NWAVES = 8;
enum { IN_X = 0, IN_C, IN_CTX, IN_CCTX, IN_WMOD, IN_BMOD, IN_WIN, IN_WOUT, IN_CONVW, IN_CONVB, IN_W1, IN_B1, IN_W2, IN_B2, IN_W3, IN_B3,
       IN_HYBIAS, IN_LB, IN_NORMW, IN_RW, IN_RB, IN_WG, IN_WU, IN_WD, IN_FNW, N_IN };

constexpr size_t MiB = 1u << 20;
constexpr size_t WS_CTL = 0, CTL_ZERO_BYTES = 1 * MiB;
constexpr size_t WS_MODS = 1 * MiB;
constexpr size_t WS_LOWER = 2 * MiB;
constexpr size_t WS_BIAS2 = 2 * MiB + 64 * 1024;
constexpr size_t WS_HPAD = 3 * MiB;
constexpr size_t WS_TOKINFO = 6 * MiB;
constexpr size_t WS_BLKBASE = 6 * MiB + 320 * 1024;
constexpr size_t WS_ROWTOK = 6 * MiB + 512 * 1024;
constexpr size_t WS_ROWW = 7 * MiB;
constexpr size_t WS_WIN = 8 * MiB;
constexpr size_t WS_WOUT = 16 * MiB;
constexpr size_t WS_WG = 18 * MiB;
constexpr size_t WS_WU = 26 * MiB;
constexpr size_t WS_WD = 34 * MiB;
constexpr size_t WS_KSPEC = 42 * MiB;
constexpr size_t WS_XBUF = 74 * MiB;
constexpr size_t WS_R1 = 146 * MiB;
constexpr size_t WS_PHG = 182 * MiB;
constexpr size_t WS_PHYT = 272 * MiB;
constexpr size_t WS_ODIR = 326 * MiB;
constexpr size_t WS_KSPC = 362 * MiB;
constexpr size_t WS_W3T = 378 * MiB;
constexpr size_t WS_HF = 380 * MiB;
constexpr size_t WS_END = 416 * MiB;
constexpr int CW_BAR = 4096;
constexpr int CW_CNT = 16384;
constexpr int CW_T6 = 65536;
constexpr int CW_Q = 32768;

constexpr int LDS_BYTES = 147456;
constexpr int LDSCTL_OFF = 143 * 1024;
constexpr int LC_BAR = 0;
constexpr int LC_T = 8;
constexpr int LC_Q = 9;
constexpr int LC_OFFS = 16;
constexpr int LC_TILEBIN = 48;

__device__ __forceinline__ unsigned f2bf(float f) { return (unsigned)__builtin_bit_cast(unsigned short, (__bf16)f); }
typedef __bf16 bf16x2v __attribute__((ext_vector_type(2)));
__device__ __forceinline__ unsigned pk2(float lo, float hi) { const f32x2 v = {lo, hi}; return __builtin_bit_cast(unsigned, __builtin_convertvector(v, bf16x2v)); }
__device__ __forceinline__ float bf2f(unsigned b) { return __builtin_bit_cast(float, (b & 0xffffu) << 16); }
__device__ __forceinline__ float bflo(unsigned w) { return __builtin_bit_cast(float, w << 16); }
__device__ __forceinline__ float bfhi(unsigned w) { return __builtin_bit_cast(float, w & 0xffff0000u); }
__device__ __forceinline__ float sigmoidf_(float x) { return __builtin_amdgcn_rcpf(1.0f + __expf(-x)); }
__device__ __forceinline__ float siluf_(float x) { return x * __builtin_amdgcn_rcpf(1.0f + __expf(-x)); }
#define DPP_ADD(v, ctrl, rmask) v += __builtin_bit_cast(float, __builtin_amdgcn_update_dpp(0, __builtin_bit_cast(int, v), ctrl, rmask, 0xF, false))
__device__ __forceinline__ float row16_sum(float v) {
    DPP_ADD(v, 0xB1, 0xF);
    DPP_ADD(v, 0x4E, 0xF);
    DPP_ADD(v, 0x141, 0xF);
    DPP_ADD(v, 0x140, 0xF);
    return v;
}
__device__ __forceinline__ float wave_sum(float v) {
    v = row16_sum(v);
    DPP_ADD(v, 0x142, 0xA);
    DPP_ADD(v, 0x143, 0xC);
    return __builtin_bit_cast(float, __builtin_amdgcn_readlane(__builtin_bit_cast(int, v), 63));
}
__device__ __forceinline__ int lane_id_opaque() { int x; asm volatile("v_mbcnt_lo_u32_b32 %0, -1, 0\n\tv_mbcnt_hi_u32_b32 %0, -1, %0" : "=v"(x)); return x; }
__device__ __forceinline__ int bidx(int row) { return row < NLAT ? (row >> 11) : 8; }
#define LDS_WAIT() asm volatile("s_waitcnt lgkmcnt(0)" ::: "memory")

#define XB_TMO      128
#define XB_XCNT(j)  (256  + 64 * (j))
#define XB_XSUB(j)  (1280 + 64 * (j))
#define XB_XGEN(j)  (2304 + 64 * (j))
#define XB_TOP      3328
#define XB_TOPGEN   3392
#define XCD_BAR_WORDS 3456
#define XB_SPIN_CAP (1u << 18)
__device__ __forceinline__ unsigned xb_ld(unsigned* p)              { return __hip_atomic_load(p, __ATOMIC_RELAXED, __HIP_MEMORY_SCOPE_AGENT); }
__device__ __forceinline__ unsigned xb_add(unsigned* p, unsigned v) { return __hip_atomic_fetch_add(p, v, __ATOMIC_RELAXED, __HIP_MEMORY_SCOPE_AGENT); }
__device__ __forceinline__ unsigned xb_xcc_id() { return (unsigned)__builtin_amdgcn_s_getreg((3 << 11) | 20) & 0xFu; }
#define XB_SPIN(cond, bar) do { unsigned _sp = 0; while (cond) { __builtin_amdgcn_s_sleep(1); \
    if ((++_sp & 255u) == 0u) { if (xb_ld(&(bar)[XB_TMO])) break; if (_sp > XB_SPIN_CAP) { atomicAdd(&(bar)[XB_TMO], 1u); break; } } } } while (0)
struct XcdBarrier { unsigned* bar; unsigned x; volatile LAS unsigned* st; };
__device__ __forceinline__ XcdBarrier xcd_barrier_post(unsigned* bar, volatile LAS unsigned* st) {
    XcdBarrier b; b.bar = bar; b.x = xb_xcc_id(); b.st = st;
    if (threadIdx.x == 0) (void)xb_add(&bar[XB_XCNT(b.x)], 1u);
    return b;
}
__device__ __forceinline__ void xcd_barrier_complete(unsigned* bar, unsigned x, unsigned& nloc, unsigned& nx) {
    const unsigned G = gridDim.x * gridDim.y * gridDim.z;
    unsigned sum, cnt, mine, sp = 0u;
    for (;;) {
        sum = 0u; cnt = 0u; mine = 0u;
#pragma unroll
        for (unsigned j = 0; j < 16; ++j) { const unsigned c = xb_ld(&bar[XB_XCNT(j)]); sum += c; cnt += (c > 0u) ? 1u : 0u; mine = (j == x) ? c : mine; }
        if (sum == G) break;
        __builtin_amdgcn_s_sleep(1);
        if ((++sp & 255u) == 0u) { if (xb_ld(&bar[XB_TMO])) break; if (sp > XB_SPIN_CAP) { atomicAdd(&bar[XB_TMO], 1u); break; } }
    }
    nloc = mine > 0u ? mine : 1u; nx = cnt > 0u ? cnt : 1u;
}
__device__ __forceinline__ void xcd_barrier(const XcdBarrier& b, const int tid0) {
    asm volatile("s_waitcnt vmcnt(0)" ::: "memory");
    __syncthreads();
    if (tid0 == 0) {
        unsigned bx = b.x; unsigned blo_ = __builtin_amdgcn_readfirstlane((unsigned)(unsigned long long)b.bar), bhi_ = __builtin_amdgcn_readfirstlane((unsigned)((unsigned long long)b.bar >> 32));
        asm volatile("" : "+s"(blo_), "+s"(bhi_), "+s"(bx));
        unsigned* bar = (unsigned*)(((unsigned long long)bhi_ << 32) | blo_);
        __builtin_amdgcn_s_waitcnt(0);
        unsigned nloc = b.st[0], nx = b.st[1];
        if (nloc == 0u) { xcd_barrier_complete(bar, bx, nloc, nx); b.st[0] = nloc; b.st[1] = nx; }
        const unsigned old = xb_add(&bar[XB_XSUB(bx)], 1u);
        const unsigned gen = old / nloc;
        if (old + 1u == (gen + 1u) * nloc) {
            __builtin_amdgcn_fence(__ATOMIC_RELEASE, "agent");
            asm volatile("s_waitcnt vmcnt(0)" ::: "memory");
            const unsigned og = xb_add(&bar[XB_TOP], 1u);
            const unsigned tg = og / nx;
            if (og + 1u == (tg + 1u) * nx) xb_add(&bar[XB_TOPGEN], 1u);
            else XB_SPIN(xb_ld(&bar[XB_TOPGEN]) == tg, bar);
            __builtin_amdgcn_fence(__ATOMIC_ACQUIRE, "agent");
            xb_add(&bar[XB_XGEN(bx)], 1u);
            asm volatile("s_waitcnt vmcnt(0)" ::: "memory");
        } else {
            XB_SPIN(xb_ld(&bar[XB_XGEN(bx)]) == gen, bar);
            __builtin_amdgcn_fence(__ATOMIC_ACQUIRE, "agent");
            asm volatile("s_waitcnt vmcnt(0)" ::: "memory");
        }
    }
    __syncthreads();
}

namespace pg8 {
constexpr int BM = 256, BK = 64, HALF = 128, HTB = HALF * BK * 2, STAGE_BYTES = 8 * HTB, NXCD = 8, WGM = 8;
__host__ __device__ __forceinline__ int lds_byte(int r, int c) { const int st = (r >> 4) * 2 + (c >> 5), rr = r & 15, cc = c & 31, ob = rr * 64 + cc * 2; return st * 1024 + (ob ^ (((ob >> 9) & 1) << 5)); }
__host__ __device__ __forceinline__ void stage_rc(int b, int& R, int& C) { const int st = b / 1024, sb = b % 1024, swz = sb ^ (((sb >> 9) & 1) << 5); R = (st >> 1) * 16 + swz / 64; C = (st & 1) * 32 + (swz % 64) / 2; }
__host__ __device__ __forceinline__ int perm32(int rho) { const int n = rho >> 4, i = rho & 15; return 8 * (i >> 2) + 4 * n + (i & 3); }

struct GUnit { unsigned a, b; int last, i0, i1; };

template <bool SUB, class Epi, class Sched>
__device__ __forceinline__ void gemm_phase(LAS unsigned char* lds, const Sched& S, const Epi& E, const char* Abase, const char* Bbase, const int lda, const int ldb, const unsigned ahalf, const unsigned bhalf, const int nt, const int tid_in) {
    int tid_ = tid_in; asm volatile("" : "+v"(tid_));
    const int tid = tid_, wid = __builtin_amdgcn_readfirstlane(tid >> 6), lane = tid & 63, wr = wid >> 2, wc = wid & 3, fr = lane & 15, fq = lane >> 4;
    unsigned voffA[2], voffB[2];
#pragma unroll
    for (int i = 0; i < 2; ++i) { int R, C; stage_rc(tid * 16 + i * 8192, R, C); const int Rb = Epi::PERM ? ((R & ~31) + perm32(R & 31)) : R;
        voffA[i] = (unsigned)(R * lda + C) * 2u; voffB[i] = (unsigned)(Rb * ldb + C) * 2u; }
    constexpr unsigned kstep = BK * 2;
    const unsigned ldsw = (unsigned)wid * 1024u;
    const int aoff = lds_byte(wr * 64 + fr, fq * 8), boff = lds_byte(wc * 32 + fr, fq * 8);
#define PG8_SA(b, h) (((b) * 2 + (h)) * HTB)
#define PG8_SB(b, h) ((4 + (b) * 2 + (h)) * HTB)
#define PG8_STAGE(bufoff, gbase, voff) do { _Pragma("unroll") for (int _i = 0; _i < 2; ++_i) \
        __builtin_amdgcn_global_load_lds((const unsigned*)((const char*)(gbase) + (voff)[_i]), (LAS unsigned*)(lds + (bufoff) + ldsw + _i * 8192), 16, 0, 0); } while (0)
#define PG8_LDA(dst, b, h) do { _Pragma("unroll") for (int m = 0; m < 4; ++m) _Pragma("unroll") for (int k = 0; k < 2; ++k) dst[m][k] = *(const LAS bf16x8*)(lds + PG8_SA(b, h) + aoff + m * 2048 + k * 1024); } while (0)
#define PG8_LDB(dst, b, h) do { _Pragma("unroll") for (int n = 0; n < 2; ++n) _Pragma("unroll") for (int k = 0; k < 2; ++k) dst[n][k] = *(const LAS bf16x8*)(lds + PG8_SB(b, h) + boff + n * 2048 + k * 1024); } while (0)
#define PG8_MMA(ai, bj, At, Bt) do { __builtin_amdgcn_s_setprio(1); _Pragma("unroll") for (int m = 0; m < 4; ++m) _Pragma("unroll") for (int n = 0; n < 2; ++n) _Pragma("unroll") for (int k = 0; k < 2; ++k) \
        acc[ai][bj][m][n] = __builtin_amdgcn_mfma_f32_16x16x32_bf16(Bt[n][k], At[m][k], acc[ai][bj][m][n], 0, 0, 0); __builtin_amdgcn_s_setprio(0); } while (0)
#define PG8_WAIT_V(n) asm volatile("s_waitcnt vmcnt(" #n ")" ::: "memory")
#define PG8_WAIT_L(n) asm volatile("s_waitcnt lgkmcnt(" #n ")" ::: "memory")
#define PG8_BAR __builtin_amdgcn_s_barrier()
#define PG8_SCHED __builtin_amdgcn_sched_barrier(0)
    GUnit cur, nxt; int ui = 0;
    if (!S.next(0, cur)) return;
    f32x4 acc[2][2][4][2];
    float zf_ = 0.f; asm volatile("" : "+v"(zf_));
#pragma unroll
    for (int a = 0; a < 2; ++a)
#pragma unroll
        for (int b = 0; b < 2; ++b)
#pragma unroll
            for (int m = 0; m < 4; ++m)
#pragma unroll
                for (int n = 0; n < 2; ++n) acc[a][b][m][n] = (f32x4){zf_, zf_, zf_, zf_};
    bf16x8 At[4][2], B0[2][2], B1[2][2];
    { const char* cA = Abase + cur.a; const char* cB = Bbase + cur.b;
      PG8_STAGE(PG8_SB(0, 0), cB, voffB); PG8_STAGE(PG8_SB(0, 1), cB + bhalf, voffB); PG8_STAGE(PG8_SA(0, 0), cA, voffA); PG8_STAGE(PG8_SA(0, 1), cA + ahalf, voffA);
      if (wr == 1) PG8_BAR;
      PG8_WAIT_V(2); PG8_BAR;
      PG8_STAGE(PG8_SB(1, 0), cB + kstep, voffB); PG8_STAGE(PG8_SA(1, 0), cA + kstep, voffA); PG8_STAGE(PG8_SB(1, 1), cB + bhalf + kstep, voffB);
      PG8_WAIT_V(6); PG8_BAR; }
    for (;;) {
        const bool has_next = S.next(ui + 1, nxt);
        const char* cA = Abase + cur.a; const char* cB = Bbase + cur.b;
        const char* nA = Abase + (has_next ? nxt.a : cur.a); const char* nB = Bbase + (has_next ? nxt.b : cur.b);
        for (int t = 0; t < nt; t += 2) {
            const bool last = (t == nt - 2);
            const char* a1 = cA + (unsigned)(t + 1) * kstep;
            const char* a2 = last ? nA : cA + (unsigned)(t + 2) * kstep; const char* b2 = last ? nB : cB + (unsigned)(t + 2) * kstep;
            const char* a3 = a2 + kstep; const char* b3 = b2 + kstep;
            PG8_LDB(B0, 0, 0); PG8_LDB(B1, 0, 1); PG8_SCHED; PG8_LDA(At, 0, 0); PG8_STAGE(PG8_SA(1, 1), a1 + ahalf, voffA);
            PG8_WAIT_V(8); PG8_WAIT_L(0); PG8_BAR; PG8_MMA(0, 0, At, B0); PG8_MMA(0, 1, At, B1); PG8_BAR; PG8_SCHED;
            PG8_LDA(At, 0, 1); PG8_STAGE(PG8_SB(0, 0), b2, voffB); PG8_STAGE(PG8_SB(0, 1), b2 + bhalf, voffB); PG8_STAGE(PG8_SA(0, 0), a2, voffA);
            PG8_WAIT_V(8); PG8_WAIT_L(0); PG8_BAR; PG8_MMA(1, 0, At, B0); PG8_MMA(1, 1, At, B1); PG8_BAR; PG8_SCHED;
            PG8_LDB(B0, 1, 0); PG8_LDB(B1, 1, 1); PG8_SCHED; PG8_LDA(At, 1, 0); PG8_STAGE(PG8_SA(0, 1), a2 + ahalf, voffA);
            PG8_WAIT_V(8); PG8_WAIT_L(0); PG8_BAR; PG8_MMA(0, 0, At, B0); PG8_MMA(0, 1, At, B1); PG8_BAR; PG8_SCHED;
            PG8_LDA(At, 1, 1); PG8_STAGE(PG8_SB(1, 0), b3, voffB); PG8_STAGE(PG8_SB(1, 1), b3 + bhalf, voffB); PG8_STAGE(PG8_SA(1, 0), a3, voffA);
            PG8_WAIT_V(8); PG8_WAIT_L(0); PG8_BAR; PG8_MMA(1, 0, At, B0); PG8_MMA(1, 1, At, B1); PG8_BAR; PG8_SCHED;
        }
        const bool fin = SUB ? (cur.last != 0) : true;
        if (fin) { if (wr == 0) PG8_BAR; E(acc, cur, wr, wc, fr, fq); }
        if (!has_next) break;
        if (fin) {
#pragma unroll
            for (int a = 0; a < 2; ++a)
#pragma unroll
                for (int b = 0; b < 2; ++b)
#pragma unroll
                    for (int m = 0; m < 4; ++m)
#pragma unroll
                        for (int n = 0; n < 2; ++n) acc[a][b][m][n] = (f32x4){zf_, zf_, zf_, zf_};
        }
        cur = nxt; ++ui;
        if (fin) { if (wr == 1) PG8_BAR; }
    }
    PG8_WAIT_V(0);
    PG8_BAR;
#undef PG8_SA
#undef PG8_SB
#undef PG8_STAGE
#undef PG8_LDA
#undef PG8_LDB
#undef PG8_MMA
#undef PG8_WAIT_V
#undef PG8_WAIT_L
#undef PG8_BAR
#undef PG8_SCHED
}

struct SchedDense {
    int nM, nN, nwg, G, c; unsigned atile, btile;
    __device__ __forceinline__ void init(int nM_, int nN_, int G_, int c_, int lda, int ldb) {
        nM = nM_; nN = nN_; nwg = nM * nN; G = G_; c = c_; atile = 256u * lda * 2u; btile = 256u * ldb * 2u; }
    __device__ __forceinline__ bool next(int i, GUnit& u) const {
        const int L = i * G + c; if (L >= nwg) return false;
        int wgid = L; { const int q = nwg / NXCD, r = nwg % NXCD, xcd = wgid % NXCD, off = wgid / NXCD; wgid = (xcd < r ? xcd * (q + 1) : r * (q + 1) + (xcd - r) * q) + off; }
        const int nig = WGM * nN, gid = wgid / nig, fm = gid * WGM, gsz = (nM - fm) < WGM ? (nM - fm) : WGM;
        const int pm = fm + ((wgid % nig) % gsz), pn = (wgid % nig) / gsz;
        u.a = (unsigned)pm * atile; u.b = (unsigned)pn * btile; u.last = 1; u.i0 = pm; u.i1 = pn; return true;
    }
};
}

struct Args { const float* in[N_IN]; float* out; unsigned char* ws; int ph_lo, ph_hi, rep, pad; };
static_assert(sizeof(Args) == N_IN * 8 + 8 + 8 + 16, "Args has no padding");

#define CAS __attribute__((address_space(4)))
typedef const float* fptr_t;
struct Ctx {
    const CAS fptr_t* in; float* out; GAS unsigned char* ws; LAS unsigned char* lds; int tid, lane, wave, G, bid, rep, dry;
};
#define WSP(T, off) ((T*)(GAS T*)(C.ws + (off)))
#define GIN(k) ((const float*)(const GAS float*)C.in[k])

__device__ __forceinline__ void build_tiletab(const Ctx& C, int l) {
    volatile LAS int* lc = (volatile LAS int*)(C.lds + LDSCTL_OFF);
    __syncthreads();
    if (C.tid == 0) {
        const unsigned* cnt = WSP(const unsigned, WS_CTL) + CW_CNT + l * 32 * 64;
        int off = 0, t = 0;
        for (int b = 0; b < NBIN; ++b) {
            const int n = (int)__hip_atomic_load(cnt + b * 64, __ATOMIC_RELAXED, __HIP_MEMORY_SCOPE_AGENT);
            lc[LC_OFFS + b] = off;
            const int nt = (n + 255) >> 8;
            for (int k = 0; k < nt; ++k) lc[LC_TILEBIN + t + k] = b;
            t += nt; off += nt * 256;
        }
        lc[LC_OFFS + NBIN] = off; lc[LC_T] = t;
    }
    __syncthreads();
}
__device__ __forceinline__ int expert_of(int bin, int es) {
    const int g = bin / 6, p = bin - g * 6;
    const int lo = p < 3 ? 0 : (p < 5 ? 1 : 2), hi = p < 3 ? p + 1 : (p < 5 ? p - 1 : 3);
    return 4 * g + (es ? hi : lo);
}

struct SchedUp {
    int T, G, c; const volatile LAS int* tilebin;
    __device__ __forceinline__ bool next(int i, pg8::GUnit& u) const {
        const int idx = i * G + c; if (idx >= 4 * T) return false;
        const int rt = idx >> 2, q = idx & 3, es = q >> 1, fb = q & 1;
        const int bin = __builtin_amdgcn_readfirstlane(tilebin[rt]);
        const int e = expert_of(bin, es);
        u.a = (unsigned)rt * 256u * 2048u; u.b = (unsigned)(e * 256 + fb * 128) * 2048u;
        u.last = 1; u.i0 = rt; u.i1 = q; return true;
    }
};
struct SchedDown {
    int T, G, c; const volatile LAS int* tilebin;
    __device__ __forceinline__ bool next(int i, pg8::GUnit& u) const {
        const int idx = (i >> 1) * G + c, sub = i & 1; if (idx >= 4 * T) return false;
        const int rt = idx >> 2, pn = idx & 3;
        const int bin = __builtin_amdgcn_readfirstlane(tilebin[rt]);
        const int e = expert_of(bin, sub);
        u.a = (unsigned)rt * 256u * 1024u + (unsigned)sub * 512u; u.b = (unsigned)(e * 1024 + pn * 256) * 512u;
        u.last = sub; u.i0 = rt; u.i1 = pn; return true;
    }
};

struct SchedUp1 {
    int idx; const volatile LAS int* tilebin;
    __device__ __forceinline__ bool next(int i, pg8::GUnit& u) const {
        if (i != 0) return false;
        const int rt = idx >> 2, q = idx & 3, es = q >> 1, fb = q & 1;
        const int bin = __builtin_amdgcn_readfirstlane(tilebin[rt]);
        const int e = expert_of(bin, es);
        u.a = (unsigned)rt * 256u * 2048u; u.b = (unsigned)(e * 256 + fb * 128) * 2048u;
        u.last = 1; u.i0 = rt; u.i1 = q; return true;
    }
};
struct SchedDown1 {
    int idx; const volatile LAS int* tilebin;
    __device__ __forceinline__ bool next(int i, pg8::GUnit& u) const {
        if (i > 1) return false;
        const int sub = i, rt = idx >> 2, pn = idx & 3;
        const int bin = __builtin_amdgcn_readfirstlane(tilebin[rt]);
        const int e = expert_of(bin, sub);
        u.a = (unsigned)rt * 256u * 1024u + (unsigned)sub * 512u; u.b = (unsigned)(e * 1024 + pn * 256) * 512u;
        u.last = sub; u.i0 = rt; u.i1 = pn; return true;
    }
};

struct EpiHG {
    static constexpr bool PERM = true;
    bf16_t* O; const float* lower;
    __device__ __forceinline__ void operator()(const f32x4 (&acc)[2][2][4][2], const pg8::GUnit& u, int wr, int wc, int fr, int fq) const {
        const int kind = u.i1 >> 1;
        const int row0 = u.i0 * 256 + wr * 64 + fr, colt = u.i1 * 256 + wc * 32 + 8 * fq;
#pragma unroll
        for (int bj = 0; bj < 2; ++bj) {
            const int col = colt + bj * 128;
            float om[8];
#pragma unroll
            for (int j = 0; j < 8; ++j) om[j] = 1.f;
            if (kind >= 3) { const float* lb = lower + (kind - 3) * 2048 + (col & 511);
#pragma unroll
                for (int j = 0; j < 8; ++j) om[j] = 1.f - lb[j]; }
#pragma unroll
            for (int ai = 0; ai < 2; ++ai)
#pragma unroll
                for (int m = 0; m < 4; ++m) {
                    float v[8];
#pragma unroll
                    for (int j = 0; j < 8; ++j) v[j] = acc[ai][bj][m][j >> 2][j & 3];
                    if (kind == 0) {
#pragma unroll
                        for (int j = 0; j < 8; ++j) v[j] = siluf_(v[j]);
                    } else if (kind >= 3) {
#pragma unroll
                        for (int j = 0; j < 8; ++j) v[j] = om[j] * sigmoidf_(-v[j]);
                    }
                    u32x4 w; w.x = pk2(v[0], v[1]); w.y = pk2(v[2], v[3]); w.z = pk2(v[4], v[5]); w.w = pk2(v[6], v[7]);
                    *(u32x4*)(O + (size_t)(row0 + ai * 128 + m * 16) * NHG + col) = w;
                }
        }
    }
};
struct EpiHY {
    static constexpr bool PERM = true;
    bf16_t* O;
    __device__ __forceinline__ void operator()(const f32x4 (&acc)[2][2][4][2], const pg8::GUnit& u, int wr, int wc, int fr, int fq) const {
        const int row0 = u.i0 * 256 + wr * 64 + fr, colt = u.i1 * 256 + wc * 32 + 8 * fq;
#pragma unroll
        for (int ai = 0; ai < 2; ++ai)
#pragma unroll
            for (int m = 0; m < 4; ++m)
#pragma unroll
                for (int bj = 0; bj < 2; ++bj) {
                    const f32x4 v0 = acc[ai][bj][m][0], v1 = acc[ai][bj][m][1];
                    u32x4 w; w.x = pk2(v0[0], v0[1]); w.y = pk2(v0[2], v0[3]); w.z = pk2(v1[0], v1[1]); w.w = pk2(v1[2], v1[3]);
                    *(u32x4*)(O + (size_t)(row0 + ai * 128 + m * 16) * NTOK + colt + bj * 128) = w;
                }
    }
};
struct EpiOut {
    static constexpr bool PERM = false;
    const float* xlat; const float* xctx; float* xo; const float* mods; int first; int dry;
    __device__ __forceinline__ void operator()(const f32x4 (&acc)[2][2][4][2], const pg8::GUnit& u, int wr, int wc, int fr, int fq) const {
        const int row0 = u.i0 * 256 + wr * 64 + fr, col0 = u.i1 * 256 + wc * 32 + 4 * fq;
#pragma unroll
        for (int ai = 0; ai < 2; ++ai)
#pragma unroll
            for (int m = 0; m < 4; ++m) {
                const int row = row0 + ai * 128 + m * 16;
                const float* src = first ? (row < NLAT ? xlat + (size_t)row * D : xctx + (size_t)(row - NLAT) * D) : xo + (size_t)row * D;
                const float* g1 = mods + bidx(row) * 6144 + 2048;
#pragma unroll
                for (int bj = 0; bj < 2; ++bj)
#pragma unroll
                    for (int n = 0; n < 2; ++n) { const int col = col0 + bj * 128 + n * 16;
                        const f32x4 xv = *(const f32x4*)(src + col), gv = *(const f32x4*)(g1 + col);
                        if (!dry) *(f32x4*)(xo + (size_t)row * D + col) = xv + gv * acc[ai][bj][m][n]; }
            }
    }
};
struct EpiAct {
    static constexpr bool PERM = true;
    bf16_t* O; const float* roww;
    __device__ __forceinline__ void operator()(const f32x4 (&acc)[2][2][4][2], const pg8::GUnit& u, int wr, int wc, int fr, int fq) const {
        const int es = u.i1 >> 1; const int pos0 = u.i0 * 256 + wr * 64 + fr, col = u.i1 * 128 + wc * 32 + 8 * fq;
        const __amdgpu_buffer_rsrc_t rsrc = __builtin_amdgcn_make_buffer_rsrc(O, 0, SROWS * 512 * 2, 0x00020000);
#pragma unroll
        for (int ai = 0; ai < 2; ++ai)
#pragma unroll
            for (int m = 0; m < 4; ++m) {
                const int pos = pos0 + ai * 128 + m * 16;
                const float wgt = roww[pos * 2 + es];
                float v[8];
#pragma unroll
                for (int j = 0; j < 8; ++j) v[j] = siluf_(acc[ai][0][m][j >> 2][j & 3]) * acc[ai][1][m][j >> 2][j & 3] * wgt;
                u32x4 w; w.x = pk2(v[0], v[1]); w.y = pk2(v[2], v[3]); w.z = pk2(v[4], v[5]); w.w = pk2(v[6], v[7]);
                __builtin_amdgcn_raw_buffer_store_b128(w, rsrc, (unsigned)(pos * 512 + col) * 2u, 0, 16);
            }
    }
};
struct EpiDown {
    static constexpr bool PERM = false;
    float* xo; const int* rowtok; const float* mods; int dry;
    __device__ __forceinline__ void operator()(const f32x4 (&acc)[2][2][4][2], const pg8::GUnit& u, int wr, int wc, int fr, int fq) const {
        const int pos0 = u.i0 * 256 + wr * 64 + fr, col0 = u.i1 * 256 + wc * 32 + 4 * fq;
#pragma unroll
        for (int ai = 0; ai < 2; ++ai)
#pragma unroll
            for (int m = 0; m < 4; ++m) {
                const int tok = rowtok[pos0 + ai * 128 + m * 16];
                if (tok >= 0) {
                    const float* g2 = mods + bidx(tok) * 6144 + 5120;
                    float* xr = xo + (size_t)tok * D;
#pragma unroll
                    for (int bj = 0; bj < 2; ++bj)
#pragma unroll
                        for (int n = 0; n < 2; ++n) { const int col = col0 + bj * 128 + n * 16;
                            const f32x4 xv = *(const f32x4*)(xr + col), gv = *(const f32x4*)(g2 + col);
                            if (!dry) *(f32x4*)(xr + col) = xv + gv * acc[ai][bj][m][n]; }
                }
            }
    }
};

struct SchedFilt {
    int G, c;
    __device__ __forceinline__ bool next(int i, pg8::GUnit& u) const {
        const int idx = i * G + c; if (idx >= 4 * 72) return false;
        const int l = idx / 72, r = idx - l * 72, pm = r / 9, pn = r - pm * 9;
        u.a = (unsigned)(l * 2048 + pm * 256) * 256u; u.b = (unsigned)(l * 2304 + pn * 256) * 256u; u.last = 1; u.i0 = l * 16 + pm; u.i1 = pn; return true;
    }
};
struct EpiFilt {
    static constexpr bool PERM = true;
    bf16_t* HF; const float* b3;
    __device__ __forceinline__ void operator()(const f32x4 (&acc)[2][2][4][2], const pg8::GUnit& u, int wr, int wc, int fr, int fq) const {
        const int l = u.i0 >> 4, pm = u.i0 & 15;
        const int row0 = pm * 256 + wr * 64 + fr, t00 = u.i1 * 256 + wc * 32 + 8 * fq;
#pragma unroll
        for (int ai = 0; ai < 2; ++ai)
#pragma unroll
            for (int m = 0; m < 4; ++m) {
                const int row = row0 + ai * 128 + m * 16, c = row & 511;
                const float delta = fabsf(logf(1e-2f) / 0.3f + (float)c * ((logf(1e-2f) / 1.5f - logf(1e-2f) / 0.3f) / 511.0f));
                const float bias = b3[l * 2048 + row];
#pragma unroll
                for (int bj = 0; bj < 2; ++bj) {
                    const int t0 = t00 + bj * 128;
                    float v[8];
#pragma unroll
                    for (int j = 0; j < 8; ++j) { const int t = t0 + j; const float tn = t < 2048 ? (float)t / 2047.0f : (float)(t - 2048) / 255.0f;
                        v[j] = (acc[ai][bj][m][j >> 2][j & 3] + bias) * expf(-tn * delta); }
                    u32x4 w; w.x = pk2(v[0], v[1]); w.y = pk2(v[2], v[3]); w.z = pk2(v[4], v[5]); w.w = pk2(v[6], v[7]);
                    *(u32x4*)(HF + ((size_t)(l * 2048 + row)) * 2304 + t0) = w;
                }
            }
    }
};

__device__ __forceinline__ int padx(int i) { return i + (i >> 3); }
__device__ __forceinline__ f32x2 cmul(f32x2 a, f32x2 b) { return (f32x2){a.x * b.x - a.y * b.y, a.x * b.y + a.y * b.x}; }
__device__ __forceinline__ f32x2 cmulc(f32x2 a, f32x2 b) { return (f32x2){a.x * b.x + a.y * b.y, a.y * b.x - a.x * b.y}; }
constexpr int XPAD = 2048 + 256;

__device__ __forceinline__ void fft_p1_dif(f32x2 (&v)[8], int tt, const LAS f32x2* T) {
#pragma unroll
    for (int g = 0; g < 2; ++g) { const int u = tt + 256 * g;
#pragma unroll
        for (int j = 0; j < 2; ++j) { const f32x2 a = v[g + 2 * j], b = v[g + 2 * j + 4]; v[g + 2 * j] = a + b; v[g + 2 * j + 4] = cmul(a - b, T[2 * (u + 512 * j)]); }
        const f32x2 tw = T[4 * u];
        { const f32x2 a = v[g], b = v[g + 2]; v[g] = a + b; v[g + 2] = cmul(a - b, tw); }
        { const f32x2 a = v[g + 4], b = v[g + 6]; v[g + 4] = a + b; v[g + 6] = cmul(a - b, tw); } }
}
__device__ __forceinline__ void fft_p1_dit(f32x2 (&v)[8], int tt, const LAS f32x2* T) {
#pragma unroll
    for (int g = 0; g < 2; ++g) { const int u = tt + 256 * g;
        const f32x2 tw = T[4 * u];
        { const f32x2 a = v[g], b = cmulc(v[g + 2], tw); v[g] = a + b; v[g + 2] = a - b; }
        { const f32x2 a = v[g + 4], b = cmulc(v[g + 6], tw); v[g + 4] = a + b; v[g + 6] = a - b; }
#pragma unroll
        for (int j = 0; j < 2; ++j) { const f32x2 a = v[g + 2 * j], b = cmulc(v[g + 2 * j + 4], T[2 * (u + 512 * j)]); v[g + 2 * j] = a + b; v[g + 2 * j + 4] = a - b; } }
}
template <int Q> __device__ __forceinline__ void r8_dif(f32x2 (&e)[8], int r, const LAS f32x2* T) {
    constexpr int S2 = 512 / Q;
#pragma unroll
    for (int j = 0; j < 4; ++j) { const f32x2 a = e[j], b = e[j + 4]; e[j] = a + b; e[j + 4] = cmul(a - b, T[S2 * (r + Q * j)]); }
#pragma unroll
    for (int jj = 0; jj < 4; ++jj) { const int j = (jj & 1) + 4 * (jj >> 1); const f32x2 a = e[j], b = e[j + 2]; e[j] = a + b; e[j + 2] = cmul(a - b, T[2 * S2 * (r + Q * (j & 1))]); }
    const f32x2 tw = T[4 * S2 * r];
#pragma unroll
    for (int j = 0; j < 8; j += 2) { const f32x2 a = e[j], b = e[j + 1]; e[j] = a + b; e[j + 1] = cmul(a - b, tw); }
}
template <int Q> __device__ __forceinline__ void r8_dit(f32x2 (&e)[8], int r, const LAS f32x2* T) {
    constexpr int S2 = 512 / Q;
    const f32x2 tw = T[4 * S2 * r];
#pragma unroll
    for (int j = 0; j < 8; j += 2) { const f32x2 a = e[j], b = cmulc(e[j + 1], tw); e[j] = a + b; e[j + 1] = a - b; }
#pragma unroll
    for (int jj = 0; jj < 4; ++jj) { const int j = (jj & 1) + 4 * (jj >> 1); const f32x2 a = e[j], b = cmulc(e[j + 2], T[2 * S2 * (r + Q * (j & 1))]); e[j] = a + b; e[j + 2] = a - b; }
#pragma unroll
    for (int j = 0; j < 4; ++j) { const f32x2 a = e[j], b = cmulc(e[j + 4], T[S2 * (r + Q * j)]); e[j] = a + b; e[j + 4] = a - b; }
}
template <int Q, bool INV> __device__ __forceinline__ void fft_mid(LAS f32x2* X, int tt, const LAS f32x2* T) {
    const int blk = tt / Q, r = tt % Q, base = blk * 8 * Q + r;
    f32x2 e[8];
#pragma unroll
    for (int j = 0; j < 8; ++j) e[j] = X[padx(base + Q * j)];
    if (INV) r8_dit<Q>(e, r, T); else r8_dif<Q>(e, r, T);
#pragma unroll
    for (int j = 0; j < 8; ++j) X[padx(base + Q * j)] = e[j];
}
__device__ __forceinline__ void fft_conv_half(f32x2 (&v)[8], LAS f32x2* X, const LAS f32x2* T, const f32x2* K, int tt) {
    f32x2 kv[8];
#pragma unroll
    for (int j = 0; j < 8; ++j) kv[j] = K[8 * tt + j];
    fft_p1_dif(v, tt, T);
#pragma unroll
    for (int m = 0; m < 8; ++m) X[padx(tt + 256 * m)] = v[m];
    __syncthreads();
    fft_mid<64, false>(X, tt, T); __syncthreads();
    fft_mid<8, false>(X, tt, T); __syncthreads();
    f32x2 e[8];
#pragma unroll
    for (int j = 0; j < 8; ++j) e[j] = X[padx(8 * tt + j)];
    r8_dif<1>(e, 0, T);
#pragma unroll
    for (int j = 0; j < 8; ++j) e[j] = cmul(e[j], kv[j]);
    r8_dit<1>(e, 0, T);
#pragma unroll
    for (int j = 0; j < 8; ++j) X[padx(8 * tt + j)] = e[j];
    __syncthreads();
    fft_mid<8, true>(X, tt, T); __syncthreads();
    fft_mid<64, true>(X, tt, T); __syncthreads();
#pragma unroll
    for (int m = 0; m < 8; ++m) v[m] = X[padx(tt + 256 * m)];
    fft_p1_dit(v, tt, T);
}
__device__ __forceinline__ void fft_fwd_store(f32x2 (&v)[8], LAS f32x2* X, const LAS f32x2* T, f32x2* Kout, int tt) {
    fft_p1_dif(v, tt, T);
#pragma unroll
    for (int m = 0; m < 8; ++m) X[padx(tt + 256 * m)] = v[m];
    __syncthreads();
    fft_mid<64, false>(X, tt, T); __syncthreads();
    fft_mid<8, false>(X, tt, T); __syncthreads();
    f32x2 e[8];
#pragma unroll
    for (int j = 0; j < 8; ++j) e[j] = X[padx(8 * tt + j)];
    r8_dif<1>(e, 0, T);
#pragma unroll
    for (int j = 0; j < 8; ++j) Kout[8 * tt + j] = e[j];
    __syncthreads();
}
__device__ __forceinline__ int padx16(int i) { return i + (i >> 4); }
constexpr int XPAD16 = 2048 + 128;
template <int Q> __device__ __forceinline__ void r16_dif(f32x2 (&e)[16], int r, const LAS f32x2* T) {
    constexpr int S2 = 256 / Q;
#pragma unroll
    for (int j = 0; j < 8; ++j) { const f32x2 a = e[j], b = e[j + 8]; e[j] = a + b; e[j + 8] = cmul(a - b, T[S2 * (r + Q * j)]); }
#pragma unroll
    for (int jj = 0; jj < 8; ++jj) { const int j = (jj & 3) + 8 * (jj >> 2); const f32x2 a = e[j], b = e[j + 4]; e[j] = a + b; e[j + 4] = cmul(a - b, T[2 * S2 * (r + Q * (j & 3))]); }
#pragma unroll
    for (int jj = 0; jj < 8; ++jj) { const int j = (jj & 1) + 4 * (jj >> 1); const f32x2 a = e[j], b = e[j + 2]; e[j] = a + b; e[j + 2] = cmul(a - b, T[4 * S2 * (r + Q * (j & 1))]); }
    const f32x2 tw = T[8 * S2 * r];
#pragma unroll
    for (int j = 0; j < 16; j += 2) { const f32x2 a = e[j], b = e[j + 1]; e[j] = a + b; e[j + 1] = cmul(a - b, tw); }
}
template <int Q> __device__ __forceinline__ void r16_dit(f32x2 (&e)[16], int r, const LAS f32x2* T) {
    constexpr int S2 = 256 / Q;
    const f32x2 tw = T[8 * S2 * r];
#pragma unroll
    for (int j = 0; j < 16; j += 2) { const f32x2 a = e[j], b = cmulc(e[j + 1], tw); e[j] = a + b; e[j + 1] = a - b; }
#pragma unroll
    for (int jj = 0; jj < 8; ++jj) { const int j = (jj & 1) + 4 * (jj >> 1); const f32x2 a = e[j], b = cmulc(e[j + 2], T[4 * S2 * (r + Q * (j & 1))]); e[j] = a + b; e[j + 2] = a - b; }
#pragma unroll
    for (int jj = 0; jj < 8; ++jj) { const int j = (jj & 3) + 8 * (jj >> 2); const f32x2 a = e[j], b = cmulc(e[j + 4], T[2 * S2 * (r + Q * (j & 3))]); e[j] = a + b; e[j + 4] = a - b; }
#pragma unroll
    for (int j = 0; j < 8; ++j) { const f32x2 a = e[j], b = cmulc(e[j + 8], T[S2 * (r + Q * j)]); e[j] = a + b; e[j + 8] = a - b; }
}
__device__ __forceinline__ void fft_conv_half16(f32x2 (&v)[16], LAS f32x2* X, const LAS f32x2* T, const f32x2* K, int tt) {
    r16_dif<128>(v, tt, T);
#pragma unroll
    for (int m = 0; m < 16; ++m) X[padx16(tt + 128 * m)] = v[m];
    __syncthreads();
    const int r = tt & 7, base = (tt >> 3) * 128 + r;
#pragma unroll
    for (int j = 0; j < 16; ++j) v[j] = X[padx16(base + 8 * j)];
    r16_dif<8>(v, r, T);
#pragma unroll
    for (int j = 0; j < 16; ++j) X[padx16(base + 8 * j)] = v[j];
    f32x2 kv[16];
#pragma unroll
    for (int j = 0; j < 16; ++j) kv[j] = K[((j >> 1) * 128 + tt) * 2 + (j & 1)];
    __syncthreads();
#pragma unroll
    for (int g = 0; g < 2; ++g) { f32x2 e[8];
#pragma unroll
        for (int j = 0; j < 8; ++j) e[j] = X[padx16(16 * tt + 8 * g + j)];
        r8_dif<1>(e, 0, T);
#pragma unroll
        for (int j = 0; j < 8; ++j) e[j] = cmul(e[j], kv[8 * g + j]);
        r8_dit<1>(e, 0, T);
#pragma unroll
        for (int j = 0; j < 8; ++j) X[padx16(16 * tt + 8 * g + j)] = e[j]; }
    __syncthreads();
#pragma unroll
    for (int j = 0; j < 16; ++j) v[j] = X[padx16(base + 8 * j)];
    r16_dit<8>(v, r, T);
#pragma unroll
    for (int j = 0; j < 16; ++j) X[padx16(base + 8 * j)] = v[j];
    __syncthreads();
#pragma unroll
    for (int m = 0; m < 16; ++m) v[m] = X[padx16(tt + 128 * m)];
    r16_dit<128>(v, tt, T);
}
__device__ __forceinline__ void fft_fwd_store16(f32x2 (&v)[16], LAS f32x2* X, const LAS f32x2* T, f32x2* Kout, int tt) {
    r16_dif<128>(v, tt, T);
#pragma unroll
    for (int m = 0; m < 16; ++m) X[padx16(tt + 128 * m)] = v[m];
    __syncthreads();
    const int r = tt & 7, base = (tt >> 3) * 128 + r;
#pragma unroll
    for (int j = 0; j < 16; ++j) v[j] = X[padx16(base + 8 * j)];
    r16_dif<8>(v, r, T);
#pragma unroll
    for (int j = 0; j < 16; ++j) X[padx16(base + 8 * j)] = v[j];
    __syncthreads();
#pragma unroll
    for (int g = 0; g < 2; ++g) { f32x2 e[8];
#pragma unroll
        for (int j = 0; j < 8; ++j) e[j] = X[padx16(16 * tt + 8 * g + j)];
        r8_dif<1>(e, 0, T);
#pragma unroll
        for (int j = 0; j < 8; ++j) Kout[(((8 * g + j) >> 1) * 128 + tt) * 2 + (j & 1)] = e[j]; }
    __syncthreads();
}
__device__ __forceinline__ void build_twiddles(const Ctx& C, LAS f32x2* T) {
    for (int k = C.tid; k < 2048; k += NTHR) { float s, c; sincospif((float)k * (1.0f / 2048.0f), &s, &c); T[k] = (f32x2){c, -s}; }
}

__device__ __forceinline__ void phase0(const Ctx& C) {
    LAS float* sil = (LAS float*)C.lds;
    LAS float* red = sil + 9 * 1024;
    LAS float* zs = red + 8 * 9 * 64;
    LAS float* h1s = zs + 8 * 40;
    const float* cin = GIN(IN_C); const float* cctx = GIN(IN_CCTX);
    for (int i = C.tid; i < 9 * 1024; i += NTHR) { const int r = i >> 10, k = i & 1023; const float v = r < 8 ? cin[r * 1024 + k] : cctx[k]; sil[i] = v / (1.0f + expf(-v)); }
    __syncthreads();
    float* mods = WSP(float, WS_MODS);
    const float* wmod = GIN(IN_WMOD); const float* bmod = GIN(IN_BMOD);
    for (int item = C.bid; item < 4 * 96; item += C.G) {
        const int l = item / 96, cb = item % 96, cc = C.tid & 63, kg = C.tid >> 6;
        const float* w = wmod + ((size_t)l * 1024 + kg * 128) * 6144 + cb * 64 + cc;
        const LAS float* sk = sil + kg * 128;
        float acc[9];
#pragma unroll
        for (int r = 0; r < 9; ++r) acc[r] = 0.f;
#pragma unroll 4
        for (int k = 0; k < 128; ++k) { const float wv = w[(size_t)k * 6144];
#pragma unroll
            for (int r = 0; r < 9; ++r) acc[r] += sk[r * 1024 + k] * wv; }
#pragma unroll
        for (int r = 0; r < 9; ++r) red[(kg * 9 + r) * 64 + cc] = acc[r];
        __syncthreads();
        for (int o = C.tid; o < 576; o += NTHR) { const int r = o >> 6, c2 = o & 63; float s = 0.f;
#pragma unroll
            for (int g = 0; g < 8; ++g) s += red[(g * 9 + r) * 64 + c2];
            mods[(size_t)(l * 9 + r) * 6144 + cb * 64 + c2] = s + bmod[l * 6144 + cb * 64 + c2]; }
        __syncthreads();
    }
    for (int item = C.bid; item < 4 * 288; item += C.G) {
        const int l = item / 288, r = item % 288, isctx = r >= 256;
        const int L = isctx ? 256 : 2048, t0 = (isctx ? r - 256 : r) * 8, tl = C.tid >> 6, j = C.tid & 63, t = t0 + tl;
        if (j < 33) { float z;
            if (j == 0) z = (float)t / (float)(L - 1);
            else { const int fi = (j - 1) & 15; const float freq = 1e-4f + (float)fi * ((15.0f - 1e-4f) / 15.0f);
                const float ang = ((float)(2.0 * 3.14159265358979323846 / L) * (float)t) * freq; z = (j <= 16) ? cosf(ang) : -sinf(ang); }
            zs[tl * 40 + j] = z; }
        __syncthreads();
        { const float* w1 = GIN(IN_W1) + (size_t)l * 33 * 64; float s = GIN(IN_B1)[l * 64 + j];
            for (int i = 0; i < 33; ++i) s += zs[tl * 40 + i] * w1[i * 64 + j];
            h1s[tl * 64 + j] = sinf(s); }
        __syncthreads();
        { const float* w2 = GIN(IN_W2) + (size_t)l * 64 * 64; float s = GIN(IN_B2)[l * 64 + j];
            for (int i = 0; i < 64; ++i) s += h1s[tl * 64 + i] * w2[i * 64 + j];
            bf16_t* dst = WSP(bf16_t, WS_HPAD) + ((size_t)l * 2304 + (isctx ? 2048 + t : t)) * 128;
            dst[j] = (bf16_t)f2bf(sinf(s)); dst[64 + j] = (bf16_t)0; }
        __syncthreads();
    }
    {
        const float* w3 = GIN(IN_W3); bf16_t* w3t = WSP(bf16_t, WS_W3T);
        for (int i = C.bid * NTHR + C.tid; i < 4 * 64 * 2048; i += C.G * NTHR) { const int l = i >> 17, k = (i >> 11) & 63, col = i & 2047;
            w3t[((size_t)l * 2048 + col) * 128 + k] = (bf16_t)f2bf(w3[i]); w3t[((size_t)l * 2048 + col) * 128 + 64 + k] = (bf16_t)0; }
    }
    if (C.bid == C.G - 1) {
        const float* lb = GIN(IN_LB); float* lower = WSP(float, WS_LOWER);
        for (int i = C.tid; i < 1024; i += NTHR) { const int d = i >> 9, c = i & 511; float v[4], mx = -3.4e38f, s = 0.f;
#pragma unroll
            for (int l = 0; l < 4; ++l) { v[l] = lb[(d * 4 + l) * 512 + c]; mx = fmaxf(mx, v[l]); }
#pragma unroll
            for (int l = 0; l < 4; ++l) { v[l] = expf(v[l] - mx); s += v[l]; }
            float cum = 0.f;
#pragma unroll
            for (int l = 0; l < 4; ++l) { if (l > 0) cum += v[l] / s; lower[(d * 4 + l) * 512 + c] = cum; } }
    }
}

__device__ __forceinline__ const float* xrow_src(const Ctx& C, int l, int row) {
    return l == 0 ? (row < NLAT ? GIN(IN_X) + (size_t)row * D : GIN(IN_CTX) + (size_t)(row - NLAT) * D) : WSP(const float, WS_XBUF) + (size_t)row * D;
}
__device__ __forceinline__ void transpose_item(const float* W, int K, int N, bf16_t* WT, LAS float* scr, int item, int lane) {
    const int nblk = N / 32, kb = item / nblk, nb = item % nblk, k0 = 64 * kb, n0 = 32 * nb;
    float wv[32];
#pragma unroll
    for (int i = 0; i < 32; ++i) wv[i] = W[(size_t)(k0 + 2 * i + (lane >> 5)) * N + n0 + (lane & 31)];
#pragma unroll
    for (int i = 0; i < 32; ++i) scr[(2 * i + (lane >> 5)) * 33 + (lane & 31)] = wv[i];
    LDS_WAIT(); asm volatile("" ::: "memory");
    const int c = lane & 7;
#pragma unroll
    for (int j = 0; j < 4; ++j) { const int n = (lane >> 3) + 8 * j; const LAS float* s = scr + (8 * c) * 33 + n;
        u32x4 o; o.x = pk2(s[0 * 33], s[1 * 33]); o.y = pk2(s[2 * 33], s[3 * 33]); o.z = pk2(s[4 * 33], s[5 * 33]); o.w = pk2(s[6 * 33], s[7 * 33]);
        *(u32x4*)(WT + (size_t)(n0 + n) * K + k0 + 8 * c) = o; }
    LDS_WAIT(); asm volatile("" ::: "memory");
}
__device__ __forceinline__ void phase_l1(const Ctx& C, int l) {
    const int gw = C.bid * NWAVES + C.wave, NGW = C.G * NWAVES;
    const float* mods = WSP(const float, WS_MODS) + (size_t)l * 9 * 6144;
    bf16_t* an = WSP(bf16_t, WS_R1);
    f32x4 nv[4];
    if (!(C.dry & 2)) {
    if (gw < NTOK) { const float* src = xrow_src(C, l, gw);
#pragma unroll
        for (int j = 0; j < 4; ++j) nv[j] = *(const f32x4*)(src + C.lane * 4 + 256 * j); }
    for (int row = gw; row < NTOK; row += NGW) {
        const float* md = mods + bidx(row) * 6144;
        f32x4 v[4]; float ss = 0.f;
#pragma unroll
        for (int j = 0; j < 4; ++j) v[j] = nv[j];
        if (row + NGW < NTOK) { const float* src = xrow_src(C, l, row + NGW);
#pragma unroll
            for (int j = 0; j < 4; ++j) nv[j] = *(const f32x4*)(src + C.lane * 4 + 256 * j); }
#pragma unroll
        for (int j = 0; j < 4; ++j) ss += (v[j].x * v[j].x + v[j].y * v[j].y) + (v[j].z * v[j].z + v[j].w * v[j].w);
        ss = wave_sum(ss); const float rinv = 1.0f / sqrtf(ss * (1.0f / D) + EPS);
#pragma unroll
        for (int j = 0; j < 4; ++j) { const int k = C.lane * 4 + 256 * j; const f32x4 sh = *(const f32x4*)(md + k), sc = *(const f32x4*)(md + 1024 + k);
            const f32x4 o = v[j] * rinv * (sc + 1.0f) + sh; u32x2 w; w.x = pk2(o.x, o.y); w.y = pk2(o.z, o.w);
            *(u32x2*)(an + (size_t)row * D + k) = w; }
    }
    }
    if (!(C.dry & 4)) {
        LAS float* scr = (LAS float*)(C.lds + C.wave * 16384);
        constexpr int I_IN = 16 * 128, I_OUT = 16 * 32, I_E = 128;
        constexpr int NIT = I_IN + I_OUT + 3 * 16 * I_E;
        for (int it = gw; it < NIT; it += NGW) {
            int r = it;
            if (r < I_IN) { transpose_item(GIN(IN_WIN) + (size_t)l * D * DIN, D, DIN, WSP(bf16_t, WS_WIN), scr, r, C.lane); continue; } r -= I_IN;
            if (r < I_OUT) { transpose_item(GIN(IN_WOUT) + (size_t)l * D * D, D, D, WSP(bf16_t, WS_WOUT), scr, r, C.lane); continue; } r -= I_OUT;
            if (r < 16 * I_E) { const int e = r / I_E; transpose_item(GIN(IN_WG) + ((size_t)l * NE + e) * D * DE, D, DE, WSP(bf16_t, WS_WG) + (size_t)e * DE * D, scr, r % I_E, C.lane); continue; } r -= 16 * I_E;
            if (r < 16 * I_E) { const int e = r / I_E; transpose_item(GIN(IN_WU) + ((size_t)l * NE + e) * D * DE, D, DE, WSP(bf16_t, WS_WU) + (size_t)e * DE * D, scr, r % I_E, C.lane); continue; } r -= 16 * I_E;
            { const int e = r / I_E; transpose_item(GIN(IN_WD) + ((size_t)l * NE + e) * DE * D, DE, D, WSP(bf16_t, WS_WD) + (size_t)e * D * DE, scr, r % I_E, C.lane); }
        }
    }
    __syncthreads();
    {
        LAS f32x2* T = (LAS f32x2*)C.lds;
        const int team = C.tid >> 7, tt = C.tid & 127;
        LAS f32x2* X = (LAS f32x2*)(C.lds + 16384) + team * XPAD16;
        LAS float* hbs = (LAS float*)(C.lds + 16384 + 4 * XPAD16 * 8) + team * 2048;
        LAS float* reds = (LAS float*)(C.lds + 16384 + 4 * XPAD16 * 8 + 32768);
        build_twiddles(C, T);
        __syncthreads();
        const bf16_t* hfl = WSP(const bf16_t, WS_HF) + (size_t)l * 2048 * 2304;
        f32x2* kspec = WSP(f32x2, WS_KSPEC);
        if (!(C.dry & 8))
        for (int item = C.bid; item < 256; item += C.G) {
            const int idx = item * 4 + team, o = idx >> 9, c = idx & 511;
            const int colf = o * 1024 + c, colb = colf + 512;
            const bf16_t* hfp = hfl + (size_t)colf * 2304; const bf16_t* hbp = hfl + (size_t)colb * 2304;
            float hf[16], hb[16], s = 0.f;
#pragma unroll
            for (int j = 0; j < 16; ++j) { const int t = tt + 128 * j; hf[j] = bf2f(hfp[t]); hb[j] = bf2f(hbp[t]); s += fabsf(hf[j]) + fabsf(hb[j]); }
            s = wave_sum(s);
            if (C.lane == 0) reds[C.wave] = s;
            __syncthreads();
            const float inv = 1.0f / ((reds[team * 2] + reds[team * 2 + 1]) * 4096.0f);
#pragma unroll
            for (int j = 0; j < 16; ++j) { hf[j] *= inv; hbs[tt + 128 * j] = hb[j] * inv; }
            __syncthreads();
            f32x2* kout = kspec + ((size_t)(o * 512 + c) * 2) * 2048;
            f32x2 vv[16];
#pragma unroll
            for (int j = 0; j < 16; ++j) { const int n = tt + 128 * j; const float kb = n > 0 ? hbs[2048 - n] : 0.f; vv[j] = (f32x2){hf[j] + kb, 0.f}; }
            fft_fwd_store16(vv, X, T, kout, tt);
#pragma unroll
            for (int j = 0; j < 16; ++j) { const int n = tt + 128 * j; const float kb = n > 0 ? hbs[2048 - n] : 0.f; const float dd = hf[j] - kb; const f32x2 tw = T[n]; vv[j] = (f32x2){dd * tw.x, dd * tw.y}; }
            fft_fwd_store16(vv, X, T, kout + 2048, tt);
        }
        if (l < DEPTH - 1 && !(C.dry & 16)) {
            f32x2* kspc = WSP(f32x2, WS_KSPC);
            for (int item = C.bid; item < 256; item += C.G) {
                const int idx = item * 4 + team, o = idx >> 9, c = idx & 511;
                const int colf = o * 1024 + c, colb = colf + 512;
                float af0 = bf2f(hfl[(size_t)colf * 2304 + 2048 + tt]), af1 = bf2f(hfl[(size_t)colf * 2304 + 2048 + 128 + tt]);
                float ab0 = bf2f(hfl[(size_t)colb * 2304 + 2048 + tt]), ab1 = bf2f(hfl[(size_t)colb * 2304 + 2048 + 128 + tt]);
                __syncthreads();
                const float s = wave_sum((fabsf(af0) + fabsf(af1)) + (fabsf(ab0) + fabsf(ab1)));
                if (C.lane == 0) reds[C.wave] = s;
                __syncthreads();
                const float inv = 1.0f / ((reds[team * 2] + reds[team * 2 + 1]) * 2048.0f);
                af0 *= inv; af1 *= inv; hbs[tt] = ab0 * inv; hbs[128 + tt] = ab1 * inv;
                __syncthreads();
                f32x2 vk[16];
#pragma unroll
                for (int j = 0; j < 16; ++j) vk[j] = (f32x2){0.f, 0.f};
                vk[0] = (f32x2){af0, 0.f}; vk[1] = (f32x2){af1, 0.f};
                vk[14] = (f32x2){tt > 0 ? hbs[256 - tt] : 0.f, 0.f};
                vk[15] = (f32x2){hbs[128 - tt], 0.f};
                fft_fwd_store16(vk, X, T, kspc + (size_t)(o * 512 + c) * 2048, tt);
            }
        }
    }
}

struct Taps { unsigned w1, wx; };
struct TapSel { unsigned m, c, p; };
__device__ __forceinline__ Taps sc_load(const LAS bf16_t* raw, int t) { const int e = t & ~1; Taps r; r.w1 = *(const LAS unsigned*)(raw + e); r.wx = *(const LAS unsigned*)(raw + e - 2 + 4 * (t & 1)); return r; }
__device__ __forceinline__ TapSel sc_sel(int t, bool has_m, bool has_p) { TapSel s; const bool odd = (t & 1) != 0;
    s.m = has_m ? (odd ? 0x01000c0cu : 0x07060c0cu) : 0x0c0c0c0cu; s.c = odd ? 0x03020c0cu : 0x01000c0cu; s.p = has_p ? (odd ? 0x05040c0cu : 0x03020c0cu) : 0x0c0c0c0cu; return s; }
__device__ __forceinline__ float sc_eval(const Taps r, const TapSel s, float w0, float w1, float w2, float bias) {
    const float pm = __builtin_bit_cast(float, __builtin_amdgcn_perm(r.wx, r.w1, s.m)), pc = __builtin_bit_cast(float, __builtin_amdgcn_perm(r.wx, r.w1, s.c)), pp = __builtin_bit_cast(float, __builtin_amdgcn_perm(r.wx, r.w1, s.p));
    return w0 * pm + w1 * pc + w2 * pp + bias; }
constexpr int HY_CH = 4, HY_ITEMS = 4 * (512 / HY_CH), HYC_ITEMS = 512 / 4;
__device__ __forceinline__ void hyena_lat(const Ctx& C, int l, int item) {
    const int bp = item & 3, cg = item >> 2, team = C.tid >> 7, tt = C.tid & 127;
    LAS f32x2* T = (LAS f32x2*)C.lds;
    LAS f32x2* X = (LAS f32x2*)(C.lds + 16384) + team * XPAD16;
    LAS bf16_t* raw = (LAS bf16_t*)(C.lds + 16384 + 4 * XPAD16 * 8) + team * 4096;
    const bf16_t* phyt = WSP(const bf16_t, WS_PHYT);
    const float* cw = GIN(IN_CONVW) + (size_t)l * 3 * NHY; const float* cb = GIN(IN_CONVB) + (size_t)l * NHY;
    const float* hyb = GIN(IN_HYBIAS) + (size_t)l * 2 * DH;
    const f32x2* kspec = WSP(const f32x2, WS_KSPEC);
    const int ba = 2 * bp, c = cg * 4 + team;
    f32x2 z[16], acc[16], v[16];
#pragma unroll 1
    for (int stage = 0; stage < 3; ++stage) {
        const int ch = stage * 512 + c;
        __syncthreads();
#pragma unroll
        for (int k = 0; k < 4; ++k) { const int q = tt + 128 * k, rr = q >> 8, cc = q & 255;
            *(LAS u32x4*)(raw + rr * 2048 + cc * 8) = *(const u32x4*)(phyt + (size_t)ch * NTOK + (size_t)(ba + rr) * 2048 + cc * 8); }
        __syncthreads();
        const float w0 = cw[ch], w1 = cw[NHY + ch], w2 = cw[2 * NHY + ch], bs = cb[ch];
        const float dsk = stage > 0 ? hyb[(stage - 1) * DH + c] : 0.f;
        const TapSel ts = sc_sel(tt, (tt & 63) != 0, (tt & 63) != 63);
#pragma unroll
        for (int hb = 0; hb < 2; ++hb) {
            Taps ra[8], rb[8];
#pragma unroll
            for (int j = 0; j < 8; ++j) { const int t = tt + 128 * (8 * hb + j); ra[j] = sc_load(raw, t); rb[j] = sc_load(raw + 2048, t); }
            __builtin_amdgcn_sched_barrier(0); asm volatile("s_waitcnt lgkmcnt(0)" ::: "memory"); __builtin_amdgcn_sched_barrier(0);
#pragma unroll
            for (int j = 0; j < 8; ++j) { const int jj = 8 * hb + j;
                const float sa = sc_eval(ra[j], ts, w0, w1, w2, bs), sb = sc_eval(rb[j], ts, w0, w1, w2, bs);
                if (stage == 0) z[jj] = (f32x2){sa, sb};
                else { const f32x2 cv = acc[jj] + z[jj] * dsk; z[jj] = (f32x2){sa * cv.x, sb * cv.y}; } }
        }
        if (stage == 2) {
            LAS bf16_t* ob = (LAS bf16_t*)X;
#pragma unroll
            for (int j = 0; j < 16; ++j) { const int t = tt + 128 * j; ob[t] = (bf16_t)f2bf(z[j].x); ob[2048 + t] = (bf16_t)f2bf(z[j].y); }
            break;
        }
        const f32x2* K = kspec + ((size_t)(stage * 512 + c) * 2) * 2048;
#pragma unroll
        for (int j = 0; j < 16; ++j) v[j] = z[j];
        fft_conv_half16(v, X, T, K, tt);
#pragma unroll
        for (int j = 0; j < 16; ++j) acc[j] = v[j];
#pragma unroll
        for (int j = 0; j < 16; ++j) v[j] = cmul(z[j], T[tt + 128 * j]);
        fft_conv_half16(v, X, T, K + 2048, tt);
#pragma unroll
        for (int j = 0; j < 16; ++j) acc[j] += cmulc(v[j], T[tt + 128 * j]);
    }
    __syncthreads();
    bf16_t* Y = WSP(bf16_t, WS_R1);
    for (int i = C.tid; i < 4096; i += NTHR) { const int b = i >> 11, t = i & 2047;
        const LAS bf16_t* o0 = (const LAS bf16_t*)((LAS f32x2*)(C.lds + 16384)) + i;
        u32x2 w; w.x = (unsigned)o0[0] | ((unsigned)o0[XPAD16 * 4] << 16); w.y = (unsigned)o0[2 * XPAD16 * 4] | ((unsigned)o0[3 * XPAD16 * 4] << 16);
        *(u32x2*)(Y + ((size_t)(ba + b) * 2048 + t) * D + cg * 4) = w; }
    __syncthreads();
}
__device__ __forceinline__ void hyena_ctx2(const Ctx& C, int l, int item) {
    const int team = C.tid >> 7, tt = C.tid & 127, c = item * 4 + team;
    LAS f32x2* T = (LAS f32x2*)C.lds;
    LAS f32x2* X = (LAS f32x2*)(C.lds + 16384) + team * XPAD16;
    LAS bf16_t* raw = (LAS bf16_t*)(C.lds + 16384 + 4 * XPAD16 * 8) + team * 4096;
    const bf16_t* phyt = WSP(const bf16_t, WS_PHYT);
    const float* cw = GIN(IN_CONVW) + (size_t)l * 3 * NHY; const float* cb = GIN(IN_CONVB) + (size_t)l * NHY;
    const float* hyb = GIN(IN_HYBIAS) + (size_t)l * 2 * DH;
    const f32x2* kspc = WSP(const f32x2, WS_KSPC);
    bf16_t* Y = WSP(bf16_t, WS_R1);
    f32x2 z[16], v[16];
#pragma unroll
    for (int j = 0; j < 16; ++j) { z[j] = (f32x2){0.f, 0.f}; v[j] = (f32x2){0.f, 0.f}; }
#pragma unroll 1
    for (int stage = 0; stage < 3; ++stage) {
        const int ch = stage * 512 + c;
        __syncthreads();
#pragma unroll
        for (int k = 0; k < 2; ++k) { const int q = tt + 128 * k; *(LAS u32x4*)(raw + q * 8) = *(const u32x4*)(phyt + (size_t)ch * NTOK + NLAT + q * 8); }
        __syncthreads();
        const float w0 = cw[ch], w1 = cw[NHY + ch], w2 = cw[2 * NHY + ch], bs = cb[ch];
        const float dsk = stage > 0 ? hyb[(stage - 1) * DH + c] : 0.f;
        Taps ra[8], rb[8];
#pragma unroll
        for (int p = 0; p < 4; ++p)
#pragma unroll
            for (int hh = 0; hh < 2; ++hh) { const int tok = hh * 128 + tt; ra[2 * p + hh] = sc_load(raw, (2 * p) * 256 + tok); rb[2 * p + hh] = sc_load(raw, (2 * p + 1) * 256 + tok); }
        __builtin_amdgcn_sched_barrier(0); asm volatile("s_waitcnt lgkmcnt(0)" ::: "memory"); __builtin_amdgcn_sched_barrier(0);
        const TapSel ts0 = sc_sel(tt, tt != 0, true), ts1 = sc_sel(tt, true, tt != 127);
#pragma unroll
        for (int p = 0; p < 4; ++p)
#pragma unroll
            for (int hh = 0; hh < 2; ++hh) { const int m = 4 * p + hh;
                const TapSel ts = hh ? ts1 : ts0;
                const float ua = sc_eval(ra[2 * p + hh], ts, w0, w1, w2, bs), ub = sc_eval(rb[2 * p + hh], ts, w0, w1, w2, bs);
                if (stage == 0) z[m] = (f32x2){ua, ub};
                else { const f32x2 cv = v[m] + z[m] * dsk; z[m] = (f32x2){ua * cv.x, ub * cv.y}; } }
        if (stage == 2) {
#pragma unroll
            for (int p = 0; p < 4; ++p)
#pragma unroll
                for (int hh = 0; hh < 2; ++hh) { const int m = 4 * p + hh, tok = hh * 128 + tt;
                    Y[(size_t)(NLAT + (2 * p) * 256 + tok) * D + c] = (bf16_t)f2bf(z[m].x); Y[(size_t)(NLAT + (2 * p + 1) * 256 + tok) * D + c] = (bf16_t)f2bf(z[m].y); }
            break;
        }
#pragma unroll
        for (int j = 0; j < 16; ++j) v[j] = z[j];
        fft_conv_half16(v, X, T, kspc + (size_t)(stage * 512 + c) * 2048, tt);
    }
}

constexpr int HG_QT = 0, HG_QP = 17408, HG_KP = 34816, HG_ST = 52224, HG_VT = 87040, HG_KH = 105472, HG_P = 123904, HG_SUB = 133120, HG_D = 135168;
__device__ __forceinline__ void hgrn_mfma(const Ctx& C, int item) {
    const int dir = item & 1, h = (item >> 1) & 3, b = item >> 3;
    LAS unsigned char* L = C.lds;
    const int lane = C.lane, w = C.wave, r = lane & 15, quad = lane >> 4;
    const int I = w >> 1, col = (w & 1) * 64 + lane;
    const bf16_t* phg = WSP(const bf16_t, WS_PHG);
    bf16_t* odir = WSP(bf16_t, WS_ODIR) + (size_t)dir * NTOK * 512;
    LAS float* subtot = (LAS float*)(L + HG_SUB); LAS float* Dv = (LAS float*)(L + HG_D);
    __syncthreads();
    unsigned z0_ = 0u; asm volatile("" : "+v"(z0_));
    const u32x4 zv_ = (u32x4){z0_, z0_, z0_, z0_}; const float zff_ = __builtin_bit_cast(float, z0_); const f32x4 zv4f_ = (f32x4){zff_, zff_, zff_, zff_};
    for (int i = C.tid; i < (128 * 272) / 16; i += NTHR) *(LAS u32x4*)(L + HG_ST + i * 16) = zv_;
    for (int i = C.tid; i < (64 * 144) / 16; i += NTHR) *(LAS u32x4*)(L + HG_P + i * 16) = zv_;
    f32x4 sacc[8];
#pragma unroll
    for (int t = 0; t < 8; ++t) sacc[t] = zv4f_;
    unsigned short qr[16], kr[16], vr[16];
    const int rstep = dir ? -1 : 1;
    const size_t colq = (size_t)h * 128 + col, colk = 1536 + (size_t)dir * 512 + h * 128 + col, colv = 512 + (size_t)h * 128 + col;
    auto chunk_row0 = [&](int ch) -> int { return ch < 4 ? NLAT + b * 256 + (dir ? 255 - ch * 64 : ch * 64) : b * 2048 + (dir ? 2047 - (ch - 4) * 64 : (ch - 4) * 64); };
    { const int row0 = chunk_row0(0) + rstep * 16 * I;
#pragma unroll
      for (int i = 0; i < 16; ++i) { const bf16_t* p = phg + (size_t)(row0 + rstep * i) * NHG; qr[i] = p[colq]; kr[i] = p[colk]; vr[i] = p[colv]; } }
    __syncthreads();
#pragma unroll 1
    for (int ch = 0; ch < 36; ++ch) {
        float cp[16]; float cq = 1.0f;
#pragma unroll
        for (int i = 0; i < 16; ++i) { cq *= 1.0f - bf2f(kr[i]); cp[i] = cq; }
        subtot[I * 128 + col] = cq;
        __syncthreads();
        const float s0 = subtot[col], s1 = subtot[128 + col], s2 = subtot[256 + col], s3 = subtot[384 + col];
        const float pre = (I > 0 ? s0 : 1.0f) * (I > 1 ? s1 : 1.0f) * (I > 2 ? s2 : 1.0f), erho = s0 * s1, eend = s2 * s3;
        const float ainv = pre * __builtin_amdgcn_rcpf(erho);
        unsigned khp[8], vtp[8];
#pragma unroll
        for (int i = 0; i < 16; i += 2) {
            const float e1a = cp[i] * ainv, e1b = cp[i + 1] * ainv, e2a = __builtin_amdgcn_rcpf(e1a), e2b = __builtin_amdgcn_rcpf(e1b);
            const float qpa = bf2f(qr[i]) * e1a, qpb = bf2f(qr[i + 1]) * e1b, kpa = bf2f(kr[i]) * e2a, kpb = bf2f(kr[i + 1]) * e2b;
            const unsigned wqp = pk2(qpa, qpb), wqt = pk2(qpa * erho, qpb * erho), wkp = pk2(kpa, kpb);
            const int srow = (16 * I + i) * 272 + col * 2;
            *(LAS bf16_t*)(L + HG_QP + srow) = (bf16_t)(wqp & 0xffffu); *(LAS bf16_t*)(L + HG_QP + srow + 272) = (bf16_t)(wqp >> 16);
            *(LAS bf16_t*)(L + HG_QT + srow) = (bf16_t)(wqt & 0xffffu); *(LAS bf16_t*)(L + HG_QT + srow + 272) = (bf16_t)(wqt >> 16);
            *(LAS bf16_t*)(L + HG_KP + srow) = (bf16_t)(wkp & 0xffffu); *(LAS bf16_t*)(L + HG_KP + srow + 272) = (bf16_t)(wkp >> 16);
            khp[i >> 1] = pk2(kpa * eend, kpb * eend);
            vtp[i >> 1] = (unsigned)vr[i] | ((unsigned)vr[i + 1] << 16);
        }
        *(LAS u32x4*)(L + HG_KH + col * 144 + I * 32) = (u32x4){khp[0], khp[1], khp[2], khp[3]};
        *(LAS u32x4*)(L + HG_KH + col * 144 + I * 32 + 16) = (u32x4){khp[4], khp[5], khp[6], khp[7]};
        *(LAS u32x4*)(L + HG_VT + col * 144 + I * 32) = (u32x4){vtp[0], vtp[1], vtp[2], vtp[3]};
        *(LAS u32x4*)(L + HG_VT + col * 144 + I * 32 + 16) = (u32x4){vtp[4], vtp[5], vtp[6], vtp[7]};
        if (I == 0) Dv[col] = erho * eend;
        const int crow0 = chunk_row0(ch);
        if (ch + 1 < 36) { const int row0 = chunk_row0(ch + 1) + rstep * 16 * I;
#pragma unroll
            for (int i = 0; i < 16; ++i) { const bf16_t* p = phg + (size_t)(row0 + rstep * i) * NHG; qr[i] = p[colq]; kr[i] = p[colk]; vr[i] = p[colv]; } }
        __syncthreads();
#pragma unroll 1
        for (int blk = w; blk < 10; blk += 8) {
            const int I2 = blk < 1 ? 0 : (blk < 3 ? 1 : (blk < 6 ? 2 : 3)), J2 = blk - (I2 * (I2 + 1)) / 2;
            f32x4 pa = zv4f_;
#pragma unroll
            for (int kk = 0; kk < 4; ++kk) {
                const bf16x8 a = *(const LAS bf16x8*)(L + HG_KP + (J2 * 16 + r) * 272 + (32 * kk + 8 * quad) * 2);
                const bf16x8 bq = *(const LAS bf16x8*)(L + HG_QP + (I2 * 16 + r) * 272 + (32 * kk + 8 * quad) * 2);
                pa = __builtin_amdgcn_mfma_f32_16x16x32_bf16(a, bq, pa, 0, 0, 0);
            }
            if (I2 == J2) {
#pragma unroll
                for (int rr = 0; rr < 4; ++rr) if (4 * quad + rr > r) pa[rr] = 0.f;
            }
            u32x2 pw; pw.x = pk2(pa[0], pa[1]); pw.y = pk2(pa[2], pa[3]);
            *(LAS u32x2*)(L + HG_P + (I2 * 16 + r) * 144 + (J2 * 16 + 4 * quad) * 2) = pw;
        }
        __syncthreads();
        {
            bf16x8 sfr[4];
#pragma unroll
            for (int kk = 0; kk < 4; ++kk) sfr[kk] = *(const LAS bf16x8*)(L + HG_ST + (16 * w + r) * 272 + (32 * kk + 8 * quad) * 2);
            const bf16x8 vf0 = *(const LAS bf16x8*)(L + HG_VT + (16 * w + r) * 144 + (8 * quad) * 2);
            const bf16x8 vf1 = *(const LAS bf16x8*)(L + HG_VT + (16 * w + r) * 144 + (32 + 8 * quad) * 2);
#pragma unroll
            for (int I3 = 0; I3 < 4; ++I3) {
                f32x4 oa = zv4f_;
#pragma unroll
                for (int kk = 0; kk < 4; ++kk) {
                    const bf16x8 bq = *(const LAS bf16x8*)(L + HG_QT + (I3 * 16 + r) * 272 + (32 * kk + 8 * quad) * 2);
                    oa = __builtin_amdgcn_mfma_f32_16x16x32_bf16(sfr[kk], bq, oa, 0, 0, 0);
                }
                { const bf16x8 bp = *(const LAS bf16x8*)(L + HG_P + (I3 * 16 + r) * 144 + (8 * quad) * 2);
                  oa = __builtin_amdgcn_mfma_f32_16x16x32_bf16(vf0, bp, oa, 0, 0, 0); }
                if (I3 >= 2) { const bf16x8 bp = *(const LAS bf16x8*)(L + HG_P + (I3 * 16 + r) * 144 + (32 + 8 * quad) * 2);
                  oa = __builtin_amdgcn_mfma_f32_16x16x32_bf16(vf1, bp, oa, 0, 0, 0); }
                const int row = crow0 + rstep * (16 * I3 + r);
                u32x2 ow; ow.x = pk2(oa[0], oa[1]); ow.y = pk2(oa[2], oa[3]);
                *(u32x2*)(odir + (size_t)row * 512 + h * 128 + 16 * w + 4 * quad) = ow;
            }
#pragma unroll
            for (int t = 0; t < 8; ++t) {
                const f32x4 dd = *(const LAS f32x4*)(L + HG_D + (16 * t + 4 * quad) * 4);
                f32x4 sa = sacc[t] * dd;
                const bf16x8 a0 = *(const LAS bf16x8*)(L + HG_KH + (16 * t + r) * 144 + (8 * quad) * 2);
                const bf16x8 a1 = *(const LAS bf16x8*)(L + HG_KH + (16 * t + r) * 144 + (32 + 8 * quad) * 2);
                sa = __builtin_amdgcn_mfma_f32_16x16x32_bf16(a0, vf0, sa, 0, 0, 0);
                sa = __builtin_amdgcn_mfma_f32_16x16x32_bf16(a1, vf1, sa, 0, 0, 0);
                sacc[t] = sa;
                u32x2 sw; sw.x = pk2(sa[0], sa[1]); sw.y = pk2(sa[2], sa[3]);
                *(LAS u32x2*)(L + HG_ST + (16 * w + r) * 272 + (16 * t + 4 * quad) * 2) = sw;
            }
        }
    }
    __syncthreads();
}
__device__ __forceinline__ void phase_l3(const Ctx& C, int l) {
    if (C.bid < 64) hgrn_mfma(C, C.bid);
    build_twiddles(C, (LAS f32x2*)C.lds);
    __syncthreads();
    unsigned* qh = WSP(unsigned, WS_CTL) + CW_Q + l * 64 + C.rep * 16;
    volatile LAS int* lc = (volatile LAS int*)(C.lds + LDSCTL_OFF);
    const int nitems = HY_ITEMS + (l < DEPTH - 1 ? HYC_ITEMS : 0);
    for (;;) {
        if (C.tid == 0) lc[LC_Q] = (int)__hip_atomic_fetch_add(qh, 1u, __ATOMIC_RELAXED, __HIP_MEMORY_SCOPE_AGENT);
        __syncthreads();
        const int item = lc[LC_Q];
        __syncthreads();
        if (item >= nitems) break;
        Ctx CI = C; { int t_ = C.tid; asm volatile("" : "+v"(t_)); CI.tid = t_; CI.lane = t_ & 63; }
        if (item < HY_ITEMS) hyena_lat(CI, l, item); else hyena_ctx2(CI, l, item - HY_ITEMS);
    }
}
__device__ __forceinline__ void phase_l3b(const Ctx& C, int l) {
    const int gw = C.bid * NWAVES + C.wave, NGW = C.G * NWAVES;
    const bf16_t* od0 = WSP(const bf16_t, WS_ODIR); const bf16_t* od1 = od0 + (size_t)NTOK * 512;
    const bf16_t* phg = WSP(const bf16_t, WS_PHG); bf16_t* Y = WSP(bf16_t, WS_R1);
    const float* nw = GIN(IN_NORMW) + l * 128;
    const int nrows = (l < DEPTH - 1) ? NTOK : NLAT;
    for (int row = gw; row < nrows; row += NGW) {
        const int idx = C.lane * 8;
        const u32x4 a = *(const u32x4*)(od0 + (size_t)row * 512 + idx), b = *(const u32x4*)(od1 + (size_t)row * 512 + idx), g = *(const u32x4*)(phg + (size_t)row * NHG + 1024 + idx);
        float o[8] = {bflo(a.x) + bflo(b.x), bfhi(a.x) + bfhi(b.x), bflo(a.y) + bflo(b.y), bfhi(a.y) + bfhi(b.y), bflo(a.z) + bflo(b.z), bfhi(a.z) + bfhi(b.z), bflo(a.w) + bflo(b.w), bfhi(a.w) + bfhi(b.w)};
        const float gg[8] = {bflo(g.x), bfhi(g.x), bflo(g.y), bfhi(g.y), bflo(g.z), bfhi(g.z), bflo(g.w), bfhi(g.w)};
        float ss = 0.f;
#pragma unroll
        for (int i = 0; i < 8; ++i) ss += o[i] * o[i];
        ss = row16_sum(ss);
        const float rinv = 1.0f / sqrtf(ss * (1.0f / 128.0f) + EPS);
        float y[8];
#pragma unroll
        for (int i = 0; i < 8; ++i) y[i] = o[i] * rinv * nw[(idx + i) & 127] * siluf_(gg[i]);
        u32x4 w; w.x = pk2(y[0], y[1]); w.y = pk2(y[2], y[3]); w.z = pk2(y[4], y[5]); w.w = pk2(y[6], y[7]);
        *(u32x4*)(Y + (size_t)row * D + 512 + idx) = w;
    }
}

constexpr int RW_PITCH = 1028;
__device__ __forceinline__ void phase_l5a(const Ctx& C, int l) {
    LAS float* rwT = (LAS float*)C.lds;
    LAS int* lcnt = (LAS int*)(C.lds + 16 * RW_PITCH * 4);
    LAS float* wsc = (LAS float*)(C.lds + 16 * RW_PITCH * 4 + 128) + C.wave * 384;
    const float* rw = GIN(IN_RW);
    for (int i = C.tid; i < 16 * 1024; i += NTHR) { const int k = i >> 4, e = i & 15; rwT[e * RW_PITCH + k] = rw[i]; }
    if (C.tid < 32) lcnt[C.tid] = 0;
    __syncthreads();
    const int gw = C.bid * NWAVES + C.wave, NGW = C.G * NWAVES;
    const float* mods = WSP(const float, WS_MODS) + (size_t)l * 9 * 6144;
    const float* bias2 = WSP(const float, WS_BIAS2) + l * 9 * 16;
    const float* xb = WSP(const float, WS_XBUF);
    const float* rbias = GIN(IN_RB);
    unsigned* cnt = WSP(unsigned, WS_CTL) + CW_CNT + l * 32 * 64;
    int* tokinfo = WSP(int, WS_TOKINFO);
    const int ngroups = ((l < DEPTH - 1) ? NTOK : NLAT) / 16;
    const int li = C.lane & 15, kq = C.lane >> 4;
    for (int g = gw; g < ngroups; g += NGW) {
        const int row0 = g * 16, bb = bidx(row0);
        const float* xp = xb + (size_t)(row0 + li) * D + kq * 4;
        const float* scp = mods + bb * 6144 + 4096 + kq * 4;
        const LAS float* bp = rwT + li * RW_PITCH + kq * 4;
        f32x4 acc0 = (f32x4){0.f, 0.f, 0.f, 0.f}, acc1 = acc0, acc2 = acc0, acc3 = acc0; float ss = 0.f;
#pragma unroll 8
        for (int m = 0; m < 64; ++m) {
            const f32x4 xv = *(const f32x4*)(xp + 16 * m), sc = *(const f32x4*)(scp + 16 * m), bv = *(const LAS f32x4*)(bp + 16 * m);
            ss += (xv.x * xv.x + xv.y * xv.y) + (xv.z * xv.z + xv.w * xv.w);
            const f32x4 av = xv * (sc + 1.0f);
            acc0 = __builtin_amdgcn_mfma_f32_16x16x4f32(av.x, bv.x, acc0, 0, 0, 0);
            acc1 = __builtin_amdgcn_mfma_f32_16x16x4f32(av.y, bv.y, acc1, 0, 0, 0);
            acc2 = __builtin_amdgcn_mfma_f32_16x16x4f32(av.z, bv.z, acc2, 0, 0, 0);
            acc3 = __builtin_amdgcn_mfma_f32_16x16x4f32(av.w, bv.w, acc3, 0, 0, 0);
        }
        const f32x4 acc = (acc0 + acc1) + (acc2 + acc3);
        wsc[C.lane] = ss;
#pragma unroll
        for (int r = 0; r < 4; ++r) wsc[64 + (4 * kq + r) * 17 + li] = acc[r];
        LDS_WAIT(); asm volatile("" ::: "memory");
        if (C.lane < 16) {
            const int row = row0 + C.lane;
            const float sst = (wsc[C.lane] + wsc[16 + C.lane]) + (wsc[32 + C.lane] + wsc[48 + C.lane]);
            const float rinv = 1.0f / sqrtf(sst * (1.0f / D) + EPS);
            float lg[16];
#pragma unroll
            for (int e = 0; e < 16; ++e) lg[e] = rinv * wsc[64 + C.lane * 17 + e] + bias2[bb * 16 + e];
            float mx = lg[0];
#pragma unroll
            for (int e = 1; e < 16; ++e) mx = fmaxf(mx, lg[e]);
            float sc[16], se = 0.f;
#pragma unroll
            for (int e = 0; e < 16; ++e) { sc[e] = expf(lg[e] - mx); se += sc[e]; }
            float sel[16];
#pragma unroll
            for (int e = 0; e < 16; ++e) { sc[e] = sc[e] / se; sel[e] = sc[e] + rbias[e]; }
            float bestgs = -3.4e38f; int bg = 0; float bs[4], bsc[4];
#pragma unroll
            for (int gg = 0; gg < 4; ++gg) {
                float m1 = -3.4e38f, m2 = -3.4e38f;
#pragma unroll
                for (int i = 0; i < 4; ++i) { const float x = sel[4 * gg + i]; if (x > m1) { m2 = m1; m1 = x; } else if (x > m2) m2 = x; }
                const float gs = m1 + m2;
                if (gs > bestgs) { bestgs = gs; bg = gg;
#pragma unroll
                    for (int i = 0; i < 4; ++i) { bs[i] = sel[4 * gg + i]; bsc[i] = sc[4 * gg + i]; } }
            }
            int i0 = 0; float b0 = bs[0];
#pragma unroll
            for (int i = 1; i < 4; ++i) if (bs[i] > b0) { b0 = bs[i]; i0 = i; }
            int i1 = -1; float b1 = -3.4e38f;
#pragma unroll
            for (int i = 0; i < 4; ++i) if (i != i0 && bs[i] > b1) { b1 = bs[i]; i1 = i; }
            float w0 = 0.f, w1 = 0.f;
#pragma unroll
            for (int i = 0; i < 4; ++i) { if (i == i0) w0 = bsc[i]; if (i == i1) w1 = bsc[i]; }
            const float wn = w0 + w1; w0 /= wn; w1 /= wn;
            const int lo = i0 < i1 ? i0 : i1, hi = i0 < i1 ? i1 : i0;
            const float wlo = i0 < i1 ? w0 : w1, whi = i0 < i1 ? w1 : w0;
            const int bin = bg * 6 + (lo * (7 - lo)) / 2 + (hi - lo - 1);
            const int slot = __hip_atomic_fetch_add(lcnt + bin, 1, __ATOMIC_RELAXED, __HIP_MEMORY_SCOPE_WORKGROUP);
            *(int4*)(tokinfo + (size_t)row * 4) = make_int4(bin, slot, __float_as_int(wlo), __float_as_int(whi));
        }
        LDS_WAIT(); asm volatile("" ::: "memory");
    }
    __syncthreads();
    if (C.tid < NBIN && !C.dry) { const int n = lcnt[C.tid];
        WSP(int, WS_BLKBASE)[C.bid * 32 + C.tid] = n > 0 ? (int)__hip_atomic_fetch_add(cnt + C.tid * 64, (unsigned)n, __ATOMIC_RELAXED, __HIP_MEMORY_SCOPE_AGENT) : 0; }
}
__device__ __forceinline__ void phase_l5b(const Ctx& C, int l) {
    build_tiletab(C, l);
    const volatile LAS int* lc = (const volatile LAS int*)(C.lds + LDSCTL_OFF);
    const int gw = C.bid * NWAVES + C.wave, NGW = C.G * NWAVES;
    const float* mods = WSP(const float, WS_MODS) + (size_t)l * 9 * 6144;
    const float* xb = WSP(const float, WS_XBUF);
    const int* tokinfo = WSP(const int, WS_TOKINFO); const int* blkbase = WSP(const int, WS_BLKBASE);
    bf16_t* hs = WSP(bf16_t, WS_PHG); int* rowtok = WSP(int, WS_ROWTOK); float* roww = WSP(float, WS_ROWW);
    const int nrows = (l < DEPTH - 1) ? NTOK : NLAT;
    f32x4 nv[4]; int4 nti = make_int4(0, 0, 0, 0);
    if (gw < nrows) { nti = *(const int4*)(tokinfo + (size_t)gw * 4);
#pragma unroll
        for (int j = 0; j < 4; ++j) nv[j] = *(const f32x4*)(xb + (size_t)gw * D + C.lane * 4 + 256 * j); }
    for (int row = gw; row < nrows; row += NGW) {
        const int4 ti = nti;
        const int pos = lc[LC_OFFS + ti.x] + blkbase[(((row >> 4) % NGW) >> 3) * 32 + ti.x] + ti.y;
        const float* md = mods + bidx(row) * 6144;
        f32x4 v[4]; float ss = 0.f;
#pragma unroll
        for (int j = 0; j < 4; ++j) v[j] = nv[j];
        if (row + NGW < nrows) { nti = *(const int4*)(tokinfo + (size_t)(row + NGW) * 4);
#pragma unroll
            for (int j = 0; j < 4; ++j) nv[j] = *(const f32x4*)(xb + (size_t)(row + NGW) * D + C.lane * 4 + 256 * j); }
#pragma unroll
        for (int j = 0; j < 4; ++j) ss += (v[j].x * v[j].x + v[j].y * v[j].y) + (v[j].z * v[j].z + v[j].w * v[j].w);
        ss = wave_sum(ss); const float rinv = 1.0f / sqrtf(ss * (1.0f / D) + EPS);
#pragma unroll
        for (int j = 0; j < 4; ++j) { const int k = C.lane * 4 + 256 * j; const f32x4 sh = *(const f32x4*)(md + 3072 + k), sc = *(const f32x4*)(md + 4096 + k);
            const f32x4 o = v[j] * rinv * (sc + 1.0f) + sh; u32x2 w; w.x = pk2(o.x, o.y); w.y = pk2(o.z, o.w);
            *(u32x2*)(hs + (size_t)pos * D + k) = w; }
        if (C.lane == 0) { rowtok[pos] = row; roww[pos * 2] = __int_as_float(ti.z); roww[pos * 2 + 1] = __int_as_float(ti.w); }
    }
    if (C.bid < NBIN) { const int b = C.bid; const int start = lc[LC_OFFS + b], end = lc[LC_OFFS + b + 1];
        const int n = (int)__hip_atomic_load(WSP(unsigned, WS_CTL) + CW_CNT + (l * 32 + b) * 64, __ATOMIC_RELAXED, __HIP_MEMORY_SCOPE_AGENT);
        float zf_ = 0.f; asm volatile("" : "+v"(zf_));
        for (int p = start + n + C.tid; p < end; p += NTHR) { rowtok[p] = -1; roww[p * 2] = zf_; roww[p * 2 + 1] = zf_; } }
}

__device__ __forceinline__ void phase_final(const Ctx& C) {
    const int gw = C.bid * NWAVES + C.wave, NGW = C.G * NWAVES;
    const float* xb = WSP(const float, WS_XBUF); const float* fw = GIN(IN_FNW);
    f32x4 nv[4];
    if (gw < NLAT) {
#pragma unroll
        for (int j = 0; j < 4; ++j) nv[j] = *(const f32x4*)(xb + (size_t)gw * D + C.lane * 4 + 256 * j); }
    for (int row = gw; row < NLAT; row += NGW) {
        f32x4 v[4]; float ss = 0.f;
#pragma unroll
        for (int j = 0; j < 4; ++j) v[j] = nv[j];
        if (row + NGW < NLAT) {
#pragma unroll
            for (int j = 0; j < 4; ++j) nv[j] = *(const f32x4*)(xb + (size_t)(row + NGW) * D + C.lane * 4 + 256 * j); }
#pragma unroll
        for (int j = 0; j < 4; ++j) ss += (v[j].x * v[j].x + v[j].y * v[j].y) + (v[j].z * v[j].z + v[j].w * v[j].w);
        ss = wave_sum(ss); const float rinv = 1.0f / sqrtf(ss * (1.0f / D) + EPS);
#pragma unroll
        for (int j = 0; j < 4; ++j) { const int k = C.lane * 4 + 256 * j; const f32x4 w = *(const f32x4*)(fw + k);
            *(f32x4*)(C.out + (size_t)row * D + k) = v[j] * rinv * w; }
    }
}

constexpr int PH_PER_LAYER = 8, N_PHASES = 2 + DEPTH * PH_PER_LAYER + 1;
__global__ void __launch_bounds__(NTHR, 2) trunk_fwd(Args args) {
    extern __shared__ __attribute__((aligned(16))) unsigned char lds[];
    Ctx C; C.in = (const CAS fptr_t*)__builtin_amdgcn_kernarg_segment_ptr(); C.out = args.out; C.ws = (GAS unsigned char*)args.ws; C.lds = (LAS unsigned char*)lds;
    C.tid = threadIdx.x; C.lane = C.tid & 63; C.wave = __builtin_amdgcn_readfirstlane(C.tid >> 6); C.G = gridDim.x; C.bid = blockIdx.x; C.rep = args.rep; C.dry = (args.rep + 1 < (args.pad & 255)) ? (args.pad >> 8) : 0;
    LAS unsigned char* ldsl0 = (LAS unsigned char*)lds;
    if (C.tid < 64) ((LAS unsigned*)(ldsl0 + LDSCTL_OFF))[C.tid] = 0u;
    __syncthreads();
    const int lo = args.ph_lo, hi = args.ph_hi;
    XcdBarrier bar; bar.bar = WSP(unsigned, WS_CTL) + CW_BAR; bar.x = 0; bar.st = (volatile LAS unsigned*)(ldsl0 + LDSCTL_OFF + LC_BAR);
    if (hi - lo > 1) bar = xcd_barrier_post(WSP(unsigned, WS_CTL) + CW_BAR, (volatile LAS unsigned*)(ldsl0 + LDSCTL_OFF + LC_BAR));
    { unsigned blo_ = __builtin_amdgcn_readfirstlane((unsigned)(unsigned long long)bar.bar), bhi_ = __builtin_amdgcn_readfirstlane((unsigned)((unsigned long long)bar.bar >> 32));
      asm volatile("" : "+s"(blo_), "+s"(bhi_)); bar.bar = (unsigned*)(((unsigned long long)bhi_ << 32) | blo_); }
#define FRESH_TID (C.wave * 64 + lane_id_opaque())
#define IN(k) (lo <= (k) && (k) < hi)
#define CPH(name) Ctx name = C; { int t_ = FRESH_TID; asm volatile("" : "+v"(t_)); name.tid = t_; name.lane = t_ & 63; }
#define SEAM(k) do { if (IN(k) && IN((k) + 1)) xcd_barrier(bar, FRESH_TID); } while (0)
#ifndef EN
#define EN 0xFFFF
#endif
    if ((EN & 1) && IN(0)) { phase0(C); SEAM(0); }
    if ((EN & 1) && IN(1)) {
        {
            const float* md = WSP(const float, WS_MODS); const float* rw = GIN(IN_RW); float* b2 = WSP(float, WS_BIAS2);
            for (int o = C.bid * NWAVES + C.wave; o < 4 * 9 * 16; o += C.G * NWAVES) { const int lr = o >> 4, e = o & 15; const float* sh = md + (size_t)lr * 6144 + 3072; float sacc = 0.f;
#pragma unroll
                for (int j = 0; j < 16; ++j) { const int k = C.lane + 64 * j; sacc += sh[k] * rw[k * 16 + e]; }
                sacc = wave_sum(sacc);
                if (C.lane == 0) b2[o] = sacc; }
        }
        SchedFilt S{C.G, C.bid};
        EpiFilt E{WSP(bf16_t, WS_HF), GIN(IN_B3)};
        pg8::gemm_phase<false>(ldsl0, S, E, (const char*)WSP(bf16_t, WS_W3T), (const char*)WSP(bf16_t, WS_HPAD), 128, 128, 128u * 128u * 2u, 128u * 128u * 2u, 2, FRESH_TID);
        SEAM(1);
    }
    const Ctx C0 = C;
#pragma unroll 1
    for (int l = 0; l < DEPTH; ++l) {
        const int p0 = 2 + l * PH_PER_LAYER;
        Ctx C = C0; { int t_ = C0.wave * 64 + lane_id_opaque(); asm volatile("" : "+v"(t_)); C.tid = t_; C.lane = t_ & 63; C.wave = __builtin_amdgcn_readfirstlane(t_ >> 6);
                      int b_ = C0.bid; asm volatile("" : "+s"(b_)); C.bid = b_; int g_ = C0.G; asm volatile("" : "+s"(g_)); C.G = g_; GAS unsigned char* w_ = C0.ws; asm volatile("" : "+s"(w_)); C.ws = w_;
                      const CAS fptr_t* i_ = C0.in; asm volatile("" : "+s"(i_)); C.in = i_;
                      LAS unsigned char* l_ = C0.lds; asm volatile("" : "+s"(l_)); C.lds = l_; }
        LAS unsigned char* const ldsl = C.lds;
        const float* modl = WSP(const float, WS_MODS) + (size_t)l * 9 * 6144;
        if ((EN & 2) && IN(p0 + 0)) { CPH(CP); phase_l1(CP, l); SEAM(p0 + 0); }
        if ((EN & 4) && IN(p0 + 1)) {
            { pg8::SchedDense S; S.init(NTOK / 256, NHG / 256, C.G, C.bid, D, D);
              EpiHG E{WSP(bf16_t, WS_PHG), WSP(const float, WS_LOWER) + l * 512};
              pg8::gemm_phase<false>(ldsl, S, E, (const char*)WSP(bf16_t, WS_R1), (const char*)(WSP(bf16_t, WS_WIN) + (size_t)NHY * D), D, D, 128u * D * 2u, 128u * D * 2u, D / 64, FRESH_TID); }
            { pg8::SchedDense S; S.init(NHY / 256, NTOK / 256, C.G, C.bid, D, D);
              EpiHY E{WSP(bf16_t, WS_PHYT)};
              pg8::gemm_phase<false>(ldsl, S, E, (const char*)WSP(bf16_t, WS_WIN), (const char*)WSP(bf16_t, WS_R1), D, D, 128u * D * 2u, 128u * D * 2u, D / 64, FRESH_TID); }
            SEAM(p0 + 1);
        }
        if ((EN & 8) && IN(p0 + 2)) { CPH(CP); phase_l3(CP, l); SEAM(p0 + 2); }
        if ((EN & 16) && IN(p0 + 3)) { CPH(CP); phase_l3b(CP, l); SEAM(p0 + 3); }
        if ((EN & 32) && IN(p0 + 4)) {
            pg8::SchedDense S; S.init(NTOK / 256, D / 256, C.G, C.bid, D, D);
            EpiOut E{GIN(IN_X), GIN(IN_CTX), WSP(float, WS_XBUF), modl, l == 0 ? 1 : 0, C.dry};
            pg8::gemm_phase<false>(ldsl, S, E, (const char*)WSP(bf16_t, WS_R1), (const char*)WSP(bf16_t, WS_WOUT), D, D, 128u * D * 2u, 128u * D * 2u, D / 64, FRESH_TID);
            SEAM(p0 + 4);
        }
        if ((EN & 64) && IN(p0 + 5)) { CPH(CP); phase_l5a(CP, l); SEAM(p0 + 5); }
        if ((EN & 128) && IN(p0 + 6)) { CPH(CP); phase_l5b(CP, l); SEAM(p0 + 6); }
        if ((EN & 256) && IN(p0 + 7)) {
            { CPH(CP); build_tiletab(CP, l); }
            const volatile LAS int* lc = (const volatile LAS int*)(ldsl + LDSCTL_OFF);
            const int n6 = 4 * lc[LC_T];
            unsigned* cnt6 = WSP(unsigned, WS_CTL) + CW_T6 + l * 96 * 64;
#pragma unroll 1
            for (int idx = C.bid; idx < n6; idx += C.G) {
                SchedUp1 S{idx, lc + LC_TILEBIN};
                EpiAct E{WSP(bf16_t, WS_R1), WSP(const float, WS_ROWW)};
                pg8::gemm_phase<false>(ldsl, S, E, (const char*)WSP(bf16_t, WS_PHG), (const char*)WSP(bf16_t, WS_WG), D, D, 128u * D * 2u, (unsigned)(WS_WU - WS_WG), D / 64, FRESH_TID);
                asm volatile("s_waitcnt vmcnt(0)" ::: "memory");
                __syncthreads();
                if (C.wave * 64 + lane_id_opaque() == 0) {
                    __hip_atomic_fetch_add(cnt6 + (idx >> 2) * 64, 1u, __ATOMIC_RELAXED, __HIP_MEMORY_SCOPE_AGENT); }
            }
            int nb2 = n6 - C.G; nb2 = nb2 < 0 ? 0 : (nb2 > C.G - 64 ? C.G - 64 : nb2);
            const int nw = C.G - nb2;
            if (C.bid >= nb2) {
#pragma unroll 1
                for (int j = C.bid - nb2; j < n6; j += nw) {
                    if (C.wave * 64 + lane_id_opaque() == 0) { unsigned* cw = cnt6 + (j >> 2) * 64; unsigned sp = 0;
                        while (__hip_atomic_load(cw, __ATOMIC_RELAXED, __HIP_MEMORY_SCOPE_AGENT) < 4u) { __builtin_amdgcn_s_sleep(2); if (++sp > (1u << 22)) break; }
                        __builtin_amdgcn_fence(__ATOMIC_ACQUIRE, "agent"); asm volatile("s_waitcnt vmcnt(0)" ::: "memory"); }
                    __syncthreads();
                    SchedDown1 S{j, lc + LC_TILEBIN};
                    EpiDown E{WSP(float, WS_XBUF), WSP(const int, WS_ROWTOK), modl, C.dry};
                    pg8::gemm_phase<true>(ldsl, S, E, (const char*)WSP(bf16_t, WS_R1), (const char*)WSP(bf16_t, WS_WD), 512, 256, 128u * 512u * 2u, 128u * 256u * 2u, 4, FRESH_TID);
                }
            }
            SEAM(p0 + 7);
        }
    }
    if ((EN & 1024) && IN(N_PHASES - 1)) { Ctx CF = C0; CF.tid = C0.wave * 64 + lane_id_opaque(); CF.lane = CF.tid & 63; phase_final(CF); }
#undef IN
#undef SEAM
}

extern "C" void kernel_launch(void* const* d_in, const int* in_sizes, int n_in, void* d_out, int out_size, void* d_ws, size_t ws_size, hipStream_t stream) {
    static int grid = 0;
    if (grid == 0) {
        if (n_in != N_IN || in_sizes[0] != NLAT * D || out_size != NLAT * D || ws_size < WS_END) { fprintf(stderr, "kernel_launch: unexpected shapes / workspace (%d inputs, ws %zu < %zu)\n", n_in, ws_size, (size_t)WS_END); grid = -1; return; }
        int dev = 0, cus = 0, per_cu = 0;
        if (hipGetDevice(&dev) != hipSuccess || hipDeviceGetAttribute(&cus, hipDeviceAttributeMultiprocessorCount, dev) != hipSuccess) { grid = -1; return; }
        if (hipFuncSetAttribute((const void*)trunk_fwd, hipFuncAttributeMaxDynamicSharedMemorySize, LDS_BYTES) != hipSuccess) { fprintf(stderr, "kernel_launch: hipFuncSetAttribute failed\n"); grid = -1; return; }
        if (hipOccupancyMaxActiveBlocksPerMultiprocessor(&per_cu, (const void*)trunk_fwd, NTHR, LDS_BYTES) != hipSuccess || per_cu < 1) { fprintf(stderr, "kernel_launch: occupancy query says %d\n", per_cu); }
        (void)hipGetLastError();
        grid = cus;
    }
    if (grid < 0) return;
    (void)hipMemsetAsync((char*)d_ws + WS_CTL, 0, CTL_ZERO_BYTES, stream);
    Args a{};
    for (int i = 0; i < N_IN; ++i) a.in[i] = (const float*)d_in[i];
    a.out = (float*)d_out; a.ws = (unsigned char*)d_ws;
#if MK_PER_PHASE
    for (int p = 0; p < N_PHASES; ++p) { a.ph_lo = p; a.ph_hi = p + 1; const int kind = p == 0 ? 0 : (p == 1 ? 11 : (p == N_PHASES - 1 ? 10 : 1 + (p - 2) % PH_PER_LAYER));
        const int nrep = ((PROBE_HOST >> kind) & 1) ? 2 : 1; a.pad = nrep | (PROBE_SKIP << 8);
        for (int rep = 0; rep < nrep; ++rep) { a.rep = rep; hipLaunchKernelGGL(trunk_fwd, dim3(grid), dim3(NTHR), LDS_BYTES, stream, a); } }
#else
    a.ph_lo = 0; a.ph_hi = N_PHASES; a.rep = 0; a.pad = 1;
    hipLaunchKernelGGL(trunk_fwd, dim3(grid), dim3(NTHR), LDS_BYTES, stream, a);
#endif
}
```

```cpp
#include <hip/hip_runtime.h>
#include <cstdio>
#include <cstdint>

#ifndef PROBE_HOST
#define PROBE_HOST 0
#endif
#ifndef PROBE_SKIP
#define PROBE_SKIP 1
#endif
#ifndef MK_PER_PHASE
#define MK_PER_PHASE 0
#endif

#define LAS __attribute__((address_space(3)))
#define GAS __attribute__((address_space(1)))
typedef unsigned short bf16_t;
typedef short bf16x8 __attribute__((ext_vector_type(8)));
typedef float f32x4 __attribute__((ext_vector_type(4)));
typedef float f32x2 __attribute__((ext_vector_type(2)));
typedef unsigned u32x4 __attribute__((ext_vector_type(4)));
typedef unsigned u32x2 __attribute__((ext_vector_type(2)));

constexpr int NB = 8, SEQ = 2048, D = 1024, DEPTH = 4, CTXL = 256;
constexpr int NLAT = NB * SEQ, NCTX = NB * CTXL, NTOK = NLAT + NCTX;
constexpr int DH = 512, NHY = 1536, NHG = 2560, DIN = 4096;
constexpr int NE = 16, DE = 256, NBIN = 24, SROWS = 24576;
constexpr float EPS = 1e-6f;
constexpr int NTHR = 512, NWAVES = 8;
enum { IN_X = 0, IN_C, IN_CTX, IN_CCTX, IN_WMOD, IN_BMOD, IN_WIN, IN_WOUT, IN_CONVW, IN_CONVB, IN_W1, IN_B1, IN_W2, IN_B2, IN_W3, IN_B3,
       IN_HYBIAS, IN_LB, IN_NORMW, IN_RW, IN_RB, IN_WG, IN_WU, IN_WD, IN_FNW, N_IN };

constexpr size_t MiB = 1u << 20;
constexpr size_t WS_CTL = 0, CTL_ZERO_BYTES = 1 * MiB;
constexpr size_t WS_MODS = 1 * MiB;
constexpr size_t WS_LOWER = 2 * MiB;
constexpr size_t WS_BIAS2 = 2 * MiB + 64 * 1024;
constexpr size_t WS_HPAD = 3 * MiB;
constexpr size_t WS_TOKINFO = 6 * MiB;
constexpr size_t WS_BLKBASE = 6 * MiB + 320 * 1024;
constexpr size_t WS_ROWTOK = 6 * MiB + 512 * 1024;
constexpr size_t WS_ROWW = 7 * MiB;
constexpr size_t WS_WIN = 8 * MiB;
constexpr size_t WS_WOUT = 16 * MiB;
constexpr size_t WS_WG = 18 * MiB;
constexpr size_t WS_WU = 26 * MiB;
constexpr size_t WS_WD = 34 * MiB;
constexpr size_t WS_KSPEC = 42 * MiB;
constexpr size_t WS_XBUF = 74 * MiB;
constexpr size_t WS_R1 = 146 * MiB;
constexpr size_t WS_PHG = 182 * MiB;
constexpr size_t WS_PHYT = 272 * MiB;
constexpr size_t WS_ODIR = 326 * MiB;
constexpr size_t WS_KSPC = 362 * MiB;
constexpr size_t WS_W3T = 378 * MiB;
constexpr size_t WS_HF = 380 * MiB;
constexpr size_t WS_END = 416 * MiB;
constexpr int CW_BAR = 4096;
constexpr int CW_CNT = 16384;
constexpr int CW_T6 = 65536;
constexpr int CW_HYD = 40960;
constexpr int CW_Q = 32768;

constexpr int LDS_BYTES = 147456;
constexpr int LDSCTL_OFF = 143 * 1024;
constexpr int LC_BAR = 0;
constexpr int LC_T = 8;
constexpr int LC_Q = 9;
constexpr int LC_OFFS = 16;
constexpr int LC_TILEBIN = 48;

__device__ __forceinline__ unsigned f2bf(float f) { return (unsigned)__builtin_bit_cast(unsigned short, (__bf16)f); }
typedef __bf16 bf16x2v __attribute__((ext_vector_type(2)));
__device__ __forceinline__ unsigned pk2(float lo, float hi) { const f32x2 v = {lo, hi}; return __builtin_bit_cast(unsigned, __builtin_convertvector(v, bf16x2v)); }
__device__ __forceinline__ float bf2f(unsigned b) { return __builtin_bit_cast(float, (b & 0xffffu) << 16); }
__device__ __forceinline__ float bflo(unsigned w) { return __builtin_bit_cast(float, w << 16); }
__device__ __forceinline__ float bfhi(unsigned w) { return __builtin_bit_cast(float, w & 0xffff0000u); }
__device__ __forceinline__ float sigmoidf_(float x) { return __builtin_amdgcn_rcpf(1.0f + __expf(-x)); }
__device__ __forceinline__ float siluf_(float x) { return x * __builtin_amdgcn_rcpf(1.0f + __expf(-x)); }
#define DPP_ADD(v, ctrl, rmask) v += __builtin_bit_cast(float, __builtin_amdgcn_update_dpp(0, __builtin_bit_cast(int, v), ctrl, rmask, 0xF, false))
__device__ __forceinline__ float row16_sum(float v) {
    DPP_ADD(v, 0xB1, 0xF);
    DPP_ADD(v, 0x4E, 0xF);
    DPP_ADD(v, 0x141, 0xF);
    DPP_ADD(v, 0x140, 0xF);
    return v;
}
__device__ __forceinline__ float wave_sum(float v) {
    v = row16_sum(v);
    DPP_ADD(v, 0x142, 0xA);
    DPP_ADD(v, 0x143, 0xC);
    return __builtin_bit_cast(float, __builtin_amdgcn_readlane(__builtin_bit_cast(int, v), 63));
}
__device__ __forceinline__ int lane_id_opaque() { int x; asm volatile("v_mbcnt_lo_u32_b32 %0, -1, 0\n\tv_mbcnt_hi_u32_b32 %0, -1, %0" : "=v"(x)); return x; }
__device__ __forceinline__ int bidx(int row) { return row < NLAT ? (row >> 11) : 8; }
#define LDS_WAIT() asm volatile("s_waitcnt lgkmcnt(0)" ::: "memory")

#define XB_TMO      128
#define XB_XCNT(j)  (256  + 64 * (j))
#define XB_XSUB(j)  (1280 + 64 * (j))
#define XB_XGEN(j)  (2304 + 64 * (j))
#define XB_TOP      3328
#define XB_TOPGEN   3392
#define XCD_BAR_WORDS 3456
#define XB_SPIN_CAP (1u << 18)
__device__ __forceinline__ unsigned xb_ld(unsigned* p)              { return __hip_atomic_load(p, __ATOMIC_RELAXED, __HIP_MEMORY_SCOPE_AGENT); }
__device__ __forceinline__ unsigned xb_add(unsigned* p, unsigned v) { return __hip_atomic_fetch_add(p, v, __ATOMIC_RELAXED, __HIP_MEMORY_SCOPE_AGENT); }
__device__ __forceinline__ unsigned xb_xcc_id() { return (unsigned)__builtin_amdgcn_s_getreg((3 << 11) | 20) & 0xFu; }
#define XB_SPIN(cond, bar) do { unsigned _sp = 0; while (cond) { __builtin_amdgcn_s_sleep(1); \
    if ((++_sp & 255u) == 0u) { if (xb_ld(&(bar)[XB_TMO])) break; if (_sp > XB_SPIN_CAP) { atomicAdd(&(bar)[XB_TMO], 1u); break; } } } } while (0)
struct XcdBarrier { unsigned* bar; unsigned x; volatile LAS unsigned* st; };
__device__ __forceinline__ XcdBarrier xcd_barrier_post(unsigned* bar, volatile LAS unsigned* st) {
    XcdBarrier b; b.bar = bar; b.x = xb_xcc_id(); b.st = st;
    if (threadIdx.x == 0) (void)xb_add(&bar[XB_XCNT(b.x)], 1u);
    return b;
}
__device__ __forceinline__ void xcd_barrier_complete(unsigned* bar, unsigned x, unsigned& nloc, unsigned& nx) {
    const unsigned G = gridDim.x * gridDim.y * gridDim.z;
    unsigned sum, cnt, mine, sp = 0u;
    for (;;) {
        sum = 0u; cnt = 0u; mine = 0u;
#pragma unroll
        for (unsigned j = 0; j < 16; ++j) { const unsigned c = xb_ld(&bar[XB_XCNT(j)]); sum += c; cnt += (c > 0u) ? 1u : 0u; mine = (j == x) ? c : mine; }
        if (sum == G) break;
        __builtin_amdgcn_s_sleep(1);
        if ((++sp & 255u) == 0u) { if (xb_ld(&bar[XB_TMO])) break; if (sp > XB_SPIN_CAP) { atomicAdd(&bar[XB_TMO], 1u); break; } }
    }
    nloc = mine > 0u ? mine : 1u; nx = cnt > 0u ? cnt : 1u;
}
__device__ __forceinline__ void xcd_barrier(const XcdBarrier& b, const int tid0) {
    asm volatile("s_waitcnt vmcnt(0)" ::: "memory");
    __syncthreads();
    if (tid0 == 0) {
        unsigned bx = b.x; unsigned blo_ = __builtin_amdgcn_readfirstlane((unsigned)(unsigned long long)b.bar), bhi_ = __builtin_amdgcn_readfirstlane((unsigned)((unsigned long long)b.bar >> 32));
        asm volatile("" : "+s"(blo_), "+s"(bhi_), "+s"(bx));
        unsigned* bar = (unsigned*)(((unsigned long long)bhi_ << 32) | blo_);
        __builtin_amdgcn_s_waitcnt(0);
        unsigned nloc = b.st[0], nx = b.st[1];
        if (nloc == 0u) { xcd_barrier_complete(bar, bx, nloc, nx); b.st[0] = nloc; b.st[1] = nx; }
        const unsigned old = xb_add(&bar[XB_XSUB(bx)], 1u);
        const unsigned gen = old / nloc;
        if (old + 1u == (gen + 1u) * nloc) {
            __builtin_amdgcn_fence(__ATOMIC_RELEASE, "agent");
            asm volatile("s_waitcnt vmcnt(0)" ::: "memory");
            const unsigned og = xb_add(&bar[XB_TOP], 1u);
            const unsigned tg = og / nx;
            if (og + 1u == (tg + 1u) * nx) xb_add(&bar[XB_TOPGEN], 1u);
            else XB_SPIN(xb_ld(&bar[XB_TOPGEN]) == tg, bar);
            __builtin_amdgcn_fence(__ATOMIC_ACQUIRE, "agent");
            xb_add(&bar[XB_XGEN(bx)], 1u);
            asm volatile("s_waitcnt vmcnt(0)" ::: "memory");
        } else {
            XB_SPIN(xb_ld(&bar[XB_XGEN(bx)]) == gen, bar);
            __builtin_amdgcn_fence(__ATOMIC_ACQUIRE, "agent");
            asm volatile("s_waitcnt vmcnt(0)" ::: "memory");
        }
    }
    __syncthreads();
}

namespace pg8 {
constexpr int BM = 256, BK = 64, HALF = 128, HTB = HALF * BK * 2, STAGE_BYTES = 8 * HTB, NXCD = 8, WGM = 8;
__host__ __device__ __forceinline__ int lds_byte(int r, int c) { const int st = (r >> 4) * 2 + (c >> 5), rr = r & 15, cc = c & 31, ob = rr * 64 + cc * 2; return st * 1024 + (ob ^ (((ob >> 9) & 1) << 5)); }
__host__ __device__ __forceinline__ void stage_rc(int b, int& R, int& C) { const int st = b / 1024, sb = b % 1024, swz = sb ^ (((sb >> 9) & 1) << 5); R = (st >> 1) * 16 + swz / 64; C = (st & 1) * 32 + (swz % 64) / 2; }
__host__ __device__ __forceinline__ int perm32(int rho) { const int n = rho >> 4, i = rho & 15; return 8 * (i >> 2) + 4 * n + (i & 3); }

struct GUnit { unsigned a, b; int last, i0, i1; };

template <bool SUB, class Epi, class Sched>
__device__ __forceinline__ void gemm_phase(LAS unsigned char* lds, const Sched& S, const Epi& E, const char* Abase, const char* Bbase, const int lda, const int ldb, const unsigned ahalf, const unsigned bhalf, const int nt, const int tid_in) {
    int tid_ = tid_in; asm volatile("" : "+v"(tid_));
    const int tid = tid_, wid = __builtin_amdgcn_readfirstlane(tid >> 6), lane = tid & 63, wr = wid >> 2, wc = wid & 3, fr = lane & 15, fq = lane >> 4;
    unsigned voffA[2], voffB[2];
#pragma unroll
    for (int i = 0; i < 2; ++i) { int R, C; stage_rc(tid * 16 + i * 8192, R, C); const int Rb = Epi::PERM ? ((R & ~31) + perm32(R & 31)) : R;
        voffA[i] = (unsigned)(R * lda + C) * 2u; voffB[i] = (unsigned)(Rb * ldb + C) * 2u; }
    constexpr unsigned kstep = BK * 2;
    const unsigned ldsw = (unsigned)wid * 1024u;
    const int aoff = lds_byte(wr * 64 + fr, fq * 8), boff = lds_byte(wc * 32 + fr, fq * 8);
#define PG8_SA(b, h) (((b) * 2 + (h)) * HTB)
#define PG8_SB(b, h) ((4 + (b) * 2 + (h)) * HTB)
#define PG8_STAGE(bufoff, gbase, voff) do { _Pragma("unroll") for (int _i = 0; _i < 2; ++_i) \
        __builtin_amdgcn_global_load_lds((const unsigned*)((const char*)(gbase) + (voff)[_i]), (LAS unsigned*)(lds + (bufoff) + ldsw + _i * 8192), 16, 0, 0); } while (0)
#define PG8_LDA(dst, b, h) do { _Pragma("unroll") for (int m = 0; m < 4; ++m) _Pragma("unroll") for (int k = 0; k < 2; ++k) dst[m][k] = *(const LAS bf16x8*)(lds + PG8_SA(b, h) + aoff + m * 2048 + k * 1024); } while (0)
#define PG8_LDB(dst, b, h) do { _Pragma("unroll") for (int n = 0; n < 2; ++n) _Pragma("unroll") for (int k = 0; k < 2; ++k) dst[n][k] = *(const LAS bf16x8*)(lds + PG8_SB(b, h) + boff + n * 2048 + k * 1024); } while (0)
#define PG8_MMA(ai, bj, At, Bt) do { __builtin_amdgcn_s_setprio(1); _Pragma("unroll") for (int m = 0; m < 4; ++m) _Pragma("unroll") for (int n = 0; n < 2; ++n) _Pragma("unroll") for (int k = 0; k < 2; ++k) \
        acc[ai][bj][m][n] = __builtin_amdgcn_mfma_f32_16x16x32_bf16(Bt[n][k], At[m][k], acc[ai][bj][m][n], 0, 0, 0); __builtin_amdgcn_s_setprio(0); } while (0)
#define PG8_WAIT_V(n) asm volatile("s_waitcnt vmcnt(" #n ")" ::: "memory")
#define PG8_WAIT_L(n) asm volatile("s_waitcnt lgkmcnt(" #n ")" ::: "memory")
#define PG8_BAR __builtin_amdgcn_s_barrier()
#define PG8_SCHED __builtin_amdgcn_sched_barrier(0)
    GUnit cur, nxt; int ui = 0;
    if (!S.next(0, cur)) return;
    f32x4 acc[2][2][4][2];
    float zf_ = 0.f; asm volatile("" : "+v"(zf_));
#pragma unroll
    for (int a = 0; a < 2; ++a)
#pragma unroll
        for (int b = 0; b < 2; ++b)
#pragma unroll
            for (int m = 0; m < 4; ++m)
#pragma unroll
                for (int n = 0; n < 2; ++n) acc[a][b][m][n] = (f32x4){zf_, zf_, zf_, zf_};
    bf16x8 At[4][2], B0[2][2], B1[2][2];
    { const char* cA = Abase + cur.a; const char* cB = Bbase + cur.b;
      PG8_STAGE(PG8_SB(0, 0), cB, voffB); PG8_STAGE(PG8_SB(0, 1), cB + bhalf, voffB); PG8_STAGE(PG8_SA(0, 0), cA, voffA); PG8_STAGE(PG8_SA(0, 1), cA + ahalf, voffA);
      if (wr == 1) PG8_BAR;
      PG8_WAIT_V(2); PG8_BAR;
      PG8_STAGE(PG8_SB(1, 0), cB + kstep, voffB); PG8_STAGE(PG8_SA(1, 0), cA + kstep, voffA); PG8_STAGE(PG8_SB(1, 1), cB + bhalf + kstep, voffB);
      PG8_WAIT_V(6); PG8_BAR; }
    for (;;) {
        const bool has_next = S.next(ui + 1, nxt);
        const char* cA = Abase + cur.a; const char* cB = Bbase + cur.b;
        const char* nA = Abase + (has_next ? nxt.a : cur.a); const char* nB = Bbase + (has_next ? nxt.b : cur.b);
        for (int t = 0; t < nt; t += 2) {
            const bool last = (t == nt - 2);
            const char* a1 = cA + (unsigned)(t + 1) * kstep;
            const char* a2 = last ? nA : cA + (unsigned)(t + 2) * kstep; const char* b2 = last ? nB : cB + (unsigned)(t + 2) * kstep;
            const char* a3 = a2 + kstep; const char* b3 = b2 + kstep;
            PG8_LDB(B0, 0, 0); PG8_LDB(B1, 0, 1); PG8_SCHED; PG8_LDA(At, 0, 0); PG8_STAGE(PG8_SA(1, 1), a1 + ahalf, voffA);
            PG8_WAIT_V(8); PG8_WAIT_L(0); PG8_BAR; PG8_MMA(0, 0, At, B0); PG8_MMA(0, 1, At, B1); PG8_BAR; PG8_SCHED;
            PG8_LDA(At, 0, 1); PG8_STAGE(PG8_SB(0, 0), b2, voffB); PG8_STAGE(PG8_SB(0, 1), b2 + bhalf, voffB); PG8_STAGE(PG8_SA(0, 0), a2, voffA);
            PG8_WAIT_V(8); PG8_WAIT_L(0); PG8_BAR; PG8_MMA(1, 0, At, B0); PG8_MMA(1, 1, At, B1); PG8_BAR; PG8_SCHED;
            PG8_LDB(B0, 1, 0); PG8_LDB(B1, 1, 1); PG8_SCHED; PG8_LDA(At, 1, 0); PG8_STAGE(PG8_SA(0, 1), a2 + ahalf, voffA);
            PG8_WAIT_V(8); PG8_WAIT_L(0); PG8_BAR; PG8_MMA(0, 0, At, B0); PG8_MMA(0, 1, At, B1); PG8_BAR; PG8_SCHED;
            PG8_LDA(At, 1, 1); PG8_STAGE(PG8_SB(1, 0), b3, voffB); PG8_STAGE(PG8_SB(1, 1), b3 + bhalf, voffB); PG8_STAGE(PG8_SA(1, 0), a3, voffA);
            PG8_WAIT_V(8); PG8_WAIT_L(0); PG8_BAR; PG8_MMA(1, 0, At, B0); PG8_MMA(1, 1, At, B1); PG8_BAR; PG8_SCHED;
        }
        const bool fin = SUB ? (cur.last != 0) : true;
        if (fin) { if (wr == 0) PG8_BAR; E(acc, cur, wr, wc, fr, fq); }
        if (!has_next) break;
        if (fin) {
#pragma unroll
            for (int a = 0; a < 2; ++a)
#pragma unroll
                for (int b = 0; b < 2; ++b)
#pragma unroll
                    for (int m = 0; m < 4; ++m)
#pragma unroll
                        for (int n = 0; n < 2; ++n) acc[a][b][m][n] = (f32x4){zf_, zf_, zf_, zf_};
        }
        cur = nxt; ++ui;
        if (fin) { if (wr == 1) PG8_BAR; }
    }
    PG8_WAIT_V(0);
    PG8_BAR;
#undef PG8_SA
#undef PG8_SB
#undef PG8_STAGE
#undef PG8_LDA
#undef PG8_LDB
#undef PG8_MMA
#undef PG8_WAIT_V
#undef PG8_WAIT_L
#undef PG8_BAR
#undef PG8_SCHED
}

struct SchedDense {
    int nM, nN, nwg, G, c, lend; unsigned atile, btile;
    __device__ __forceinline__ void init(int nM_, int nN_, int G_, int c_, int lda, int ldb) {
        nM = nM_; nN = nN_; nwg = nM * nN; G = G_; c = c_; lend = nwg; atile = 256u * lda * 2u; btile = 256u * ldb * 2u; }
    __device__ __forceinline__ void range(int first, int stride, int end) { c = first; G = stride; lend = end < nwg ? end : nwg; }
    __device__ __forceinline__ bool next(int i, GUnit& u) const {
        const int L = i * G + c; if (L >= lend) return false;
        int wgid = L; { const int q = nwg / NXCD, r = nwg % NXCD, xcd = wgid % NXCD, off = wgid / NXCD; wgid = (xcd < r ? xcd * (q + 1) : r * (q + 1) + (xcd - r) * q) + off; }
        const int nig = WGM * nN, gid = wgid / nig, fm = gid * WGM, gsz = (nM - fm) < WGM ? (nM - fm) : WGM;
        const int pm = fm + ((wgid % nig) % gsz), pn = (wgid % nig) / gsz;
        u.a = (unsigned)pm * atile; u.b = (unsigned)pn * btile; u.last = 1; u.i0 = pm; u.i1 = pn; return true;
    }
};
}

struct Args { const float* in[N_IN]; float* out; unsigned char* ws; int ph_lo, ph_hi, rep, pad; };
static_assert(sizeof(Args) == N_IN * 8 + 8 + 8 + 16, "Args has no padding");

#define CAS __attribute__((address_space(4)))
typedef const float* fptr_t;
struct Ctx {
    const CAS fptr_t* in; float* out; GAS unsigned char* ws; LAS unsigned char* lds; int tid, lane, wave, G, bid, rep, dry;
};
#define WSP(T, off) ((T*)(GAS T*)(C.ws + (off)))
#define GIN(k) ((const float*)(const GAS float*)C.in[k])

__device__ __forceinline__ void build_tiletab(const Ctx& C, int l) {
    volatile LAS int* lc = (volatile LAS int*)(C.lds + LDSCTL_OFF);
    __syncthreads();
    if (C.tid == 0) {
        const unsigned* cnt = WSP(const unsigned, WS_CTL) + CW_CNT + l * 32 * 64;
        int off = 0, t = 0;
        for (int b = 0; b < NBIN; ++b) {
            const int n = (int)__hip_atomic_load(cnt + b * 64, __ATOMIC_RELAXED, __HIP_MEMORY_SCOPE_AGENT);
            lc[LC_OFFS + b] = off;
            const int nt = (n + 255) >> 8;
            for (int k = 0; k < nt; ++k) lc[LC_TILEBIN + t + k] = b;
            t += nt; off += nt * 256;
        }
        lc[LC_OFFS + NBIN] = off; lc[LC_T] = t;
    }
    __syncthreads();
}
__device__ __forceinline__ int expert_of(int bin, int es) {
    const int g = bin / 6, p = bin - g * 6;
    const int lo = p < 3 ? 0 : (p < 5 ? 1 : 2), hi = p < 3 ? p + 1 : (p < 5 ? p - 1 : 3);
    return 4 * g + (es ? hi : lo);
}

struct SchedUp {
    int T, G, c; const volatile LAS int* tilebin;
    __device__ __forceinline__ bool next(int i, pg8::GUnit& u) const {
        const int idx = i * G + c; if (idx >= 4 * T) return false;
        const int rt = idx >> 2, q = idx & 3, es = q >> 1, fb = q & 1;
        const int bin = __builtin_amdgcn_readfirstlane(tilebin[rt]);
        const int e = expert_of(bin, es);
        u.a = (unsigned)rt * 256u * 2048u; u.b = (unsigned)(e * 256 + fb * 128) * 2048u;
        u.last = 1; u.i0 = rt; u.i1 = q; return true;
    }
};
struct SchedDown {
    int T, G, c; const volatile LAS int* tilebin;
    __device__ __forceinline__ bool next(int i, pg8::GUnit& u) const {
        const int idx = (i >> 1) * G + c, sub = i & 1; if (idx >= 4 * T) return false;
        const int rt = idx >> 2, pn = idx & 3;
        const int bin = __builtin_amdgcn_readfirstlane(tilebin[rt]);
        const int e = expert_of(bin, sub);
        u.a = (unsigned)rt * 256u * 1024u + (unsigned)sub * 512u; u.b = (unsigned)(e * 1024 + pn * 256) * 512u;
        u.last = sub; u.i0 = rt; u.i1 = pn; return true;
    }
};

struct SchedUp1 {
    int idx; const volatile LAS int* tilebin;
    __device__ __forceinline__ bool next(int i, pg8::GUnit& u) const {
        if (i != 0) return false;
        const int rt = idx >> 2, q = idx & 3, es = q >> 1, fb = q & 1;
        const int bin = __builtin_amdgcn_readfirstlane(tilebin[rt]);
        const int e = expert_of(bin, es);
        u.a = (unsigned)rt * 256u * 2048u; u.b = (unsigned)(e * 256 + fb * 128) * 2048u;
        u.last = 1; u.i0 = rt; u.i1 = q; return true;
    }
};
struct SchedDown1 {
    int idx; const volatile LAS int* tilebin;
    __device__ __forceinline__ bool next(int i, pg8::GUnit& u) const {
        if (i > 1) return false;
        const int sub = i, rt = idx >> 2, pn = idx & 3;
        const int bin = __builtin_amdgcn_readfirstlane(tilebin[rt]);
        const int e = expert_of(bin, sub);
        u.a = (unsigned)rt * 256u * 1024u + (unsigned)sub * 512u; u.b = (unsigned)(e * 1024 + pn * 256) * 512u;
        u.last = sub; u.i0 = rt; u.i1 = pn; return true;
    }
};

struct EpiHG {
    static constexpr bool PERM = true;
    bf16_t* O; const float* lower;
    __device__ __forceinline__ void operator()(const f32x4 (&acc)[2][2][4][2], const pg8::GUnit& u, int wr, int wc, int fr, int fq) const {
        const int kind = u.i1 >> 1;
        const int row0 = u.i0 * 256 + wr * 64 + fr, colt = u.i1 * 256 + wc * 32 + 8 * fq;
#pragma unroll
        for (int bj = 0; bj < 2; ++bj) {
            const int col = colt + bj * 128;
            float om[8];
#pragma unroll
            for (int j = 0; j < 8; ++j) om[j] = 1.f;
            if (kind >= 3) { const float* lb = lower + (kind - 3) * 2048 + (col & 511);
#pragma unroll
                for (int j = 0; j < 8; ++j) om[j] = 1.f - lb[j]; }
#pragma unroll
            for (int ai = 0; ai < 2; ++ai)
#pragma unroll
                for (int m = 0; m < 4; ++m) {
                    float v[8];
#pragma unroll
                    for (int j = 0; j < 8; ++j) v[j] = acc[ai][bj][m][j >> 2][j & 3];
                    if (kind == 0) {
#pragma unroll
                        for (int j = 0; j < 8; ++j) v[j] = siluf_(v[j]);
                    } else if (kind >= 3) {
#pragma unroll
                        for (int j = 0; j < 8; ++j) v[j] = om[j] * sigmoidf_(-v[j]);
                    }
                    u32x4 w; w.x = pk2(v[0], v[1]); w.y = pk2(v[2], v[3]); w.z = pk2(v[4], v[5]); w.w = pk2(v[6], v[7]);
                    *(u32x4*)(O + (size_t)(row0 + ai * 128 + m * 16) * NHG + col) = w;
                }
        }
    }
};
struct EpiHY {
    static constexpr bool PERM = true;
    bf16_t* O;
    __device__ __forceinline__ void operator()(const f32x4 (&acc)[2][2][4][2], const pg8::GUnit& u, int wr, int wc, int fr, int fq) const {
        const int row0 = u.i0 * 256 + wr * 64 + fr, colt = u.i1 * 256 + wc * 32 + 8 * fq;
#pragma unroll
        for (int ai = 0; ai < 2; ++ai)
#pragma unroll
            for (int m = 0; m < 4; ++m)
#pragma unroll
                for (int bj = 0; bj < 2; ++bj) {
                    const f32x4 v0 = acc[ai][bj][m][0], v1 = acc[ai][bj][m][1];
                    u32x4 w; w.x = pk2(v0[0], v0[1]); w.y = pk2(v0[2], v0[3]); w.z = pk2(v1[0], v1[1]); w.w = pk2(v1[2], v1[3]);
                    *(u32x4*)(O + (size_t)(row0 + ai * 128 + m * 16) * NTOK + colt + bj * 128) = w;
                }
    }
};
struct EpiOut {
    static constexpr bool PERM = false;
    const float* xlat; const float* xctx; float* xo; const float* mods; int first; int dry;
    __device__ __forceinline__ void operator()(const f32x4 (&acc)[2][2][4][2], const pg8::GUnit& u, int wr, int wc, int fr, int fq) const {
        const int row0 = u.i0 * 256 + wr * 64 + fr, col0 = u.i1 * 256 + wc * 32 + 4 * fq;
#pragma unroll
        for (int ai = 0; ai < 2; ++ai)
#pragma unroll
            for (int m = 0; m < 4; ++m) {
                const int row = row0 + ai * 128 + m * 16;
                const float* src = first ? (row < NLAT ? xlat + (size_t)row * D : xctx + (size_t)(row - NLAT) * D) : xo + (size_t)row * D;
                const float* g1 = mods + bidx(row) * 6144 + 2048;
#pragma unroll
                for (int bj = 0; bj < 2; ++bj)
#pragma unroll
                    for (int n = 0; n < 2; ++n) { const int col = col0 + bj * 128 + n * 16;
                        const f32x4 xv = *(const f32x4*)(src + col), gv = *(const f32x4*)(g1 + col);
                        if (!dry) *(f32x4*)(xo + (size_t)row * D + col) = xv + gv * acc[ai][bj][m][n]; }
            }
    }
};
struct EpiAct {
    static constexpr bool PERM = true;
    bf16_t* O; const float* roww;
    __device__ __forceinline__ void operator()(const f32x4 (&acc)[2][2][4][2], const pg8::GUnit& u, int wr, int wc, int fr, int fq) const {
        const int es = u.i1 >> 1; const int pos0 = u.i0 * 256 + wr * 64 + fr, col = u.i1 * 128 + wc * 32 + 8 * fq;
        const __amdgpu_buffer_rsrc_t rsrc = __builtin_amdgcn_make_buffer_rsrc(O, 0, SROWS * 512 * 2, 0x00020000);
#pragma unroll
        for (int ai = 0; ai < 2; ++ai)
#pragma unroll
            for (int m = 0; m < 4; ++m) {
                const int pos = pos0 + ai * 128 + m * 16;
                const float wgt = roww[pos * 2 + es];
                float v[8];
#pragma unroll
                for (int j = 0; j < 8; ++j) v[j] = siluf_(acc[ai][0][m][j >> 2][j & 3]) * acc[ai][1][m][j >> 2][j & 3] * wgt;
                u32x4 w; w.x = pk2(v[0], v[1]); w.y = pk2(v[2], v[3]); w.z = pk2(v[4], v[5]); w.w = pk2(v[6], v[7]);
                __builtin_amdgcn_raw_buffer_store_b128(w, rsrc, (unsigned)(pos * 512 + col) * 2u, 0, 16);
            }
    }
};
struct EpiDown {
    static constexpr bool PERM = false;
    float* xo; const int* rowtok; const float* mods; int dry;
    __device__ __forceinline__ void operator()(const f32x4 (&acc)[2][2][4][2], const pg8::GUnit& u, int wr, int wc, int fr, int fq) const {
        const int pos0 = u.i0 * 256 + wr * 64 + fr, col0 = u.i1 * 256 + wc * 32 + 4 * fq;
#pragma unroll
        for (int ai = 0; ai < 2; ++ai)
#pragma unroll
            for (int m = 0; m < 4; ++m) {
                const int tok = rowtok[pos0 + ai * 128 + m * 16];
                if (tok >= 0) {
                    const float* g2 = mods + bidx(tok) * 6144 + 5120;
                    float* xr = xo + (size_t)tok * D;
#pragma unroll
                    for (int bj = 0; bj < 2; ++bj)
#pragma unroll
                        for (int n = 0; n < 2; ++n) { const int col = col0 + bj * 128 + n * 16;
                            const f32x4 xv = *(const f32x4*)(xr + col), gv = *(const f32x4*)(g2 + col);
                            if (!dry) *(f32x4*)(xr + col) = xv + gv * acc[ai][bj][m][n]; }
                }
            }
    }
};

struct SchedFilt {
    int G, c;
    __device__ __forceinline__ bool next(int i, pg8::GUnit& u) const {
        const int idx = i * G + c; if (idx >= 4 * 72) return false;
        const int l = idx / 72, r = idx - l * 72, pm = r / 9, pn = r - pm * 9;
        u.a = (unsigned)(l * 2048 + pm * 256) * 256u; u.b = (unsigned)(l * 2304 + pn * 256) * 256u; u.last = 1; u.i0 = l * 16 + pm; u.i1 = pn; return true;
    }
};
struct EpiFilt {
    static constexpr bool PERM = true;
    bf16_t* HF; const float* b3;
    __device__ __forceinline__ void operator()(const f32x4 (&acc)[2][2][4][2], const pg8::GUnit& u, int wr, int wc, int fr, int fq) const {
        const int l = u.i0 >> 4, pm = u.i0 & 15;
        const int row0 = pm * 256 + wr * 64 + fr, t00 = u.i1 * 256 + wc * 32 + 8 * fq;
#pragma unroll
        for (int ai = 0; ai < 2; ++ai)
#pragma unroll
            for (int m = 0; m < 4; ++m) {
                const int row = row0 + ai * 128 + m * 16, c = row & 511;
                const float delta = fabsf(logf(1e-2f) / 0.3f + (float)c * ((logf(1e-2f) / 1.5f - logf(1e-2f) / 0.3f) / 511.0f));
                const float bias = b3[l * 2048 + row];
#pragma unroll
                for (int bj = 0; bj < 2; ++bj) {
                    const int t0 = t00 + bj * 128;
                    float v[8];
#pragma unroll
                    for (int j = 0; j < 8; ++j) { const int t = t0 + j; const float tn = t < 2048 ? (float)t / 2047.0f : (float)(t - 2048) / 255.0f;
                        v[j] = (acc[ai][bj][m][j >> 2][j & 3] + bias) * expf(-tn * delta); }
                    u32x4 w; w.x = pk2(v[0], v[1]); w.y = pk2(v[2], v[3]); w.z = pk2(v[4], v[5]); w.w = pk2(v[6], v[7]);
                    *(u32x4*)(HF + ((size_t)(l * 2048 + row)) * 2304 + t0) = w;
                }
            }
    }
};

__device__ __forceinline__ int padx(int i) { return i + (i >> 3); }
__device__ __forceinline__ f32x2 cmul(f32x2 a, f32x2 b) { return (f32x2){a.x * b.x - a.y * b.y, a.x * b.y + a.y * b.x}; }
__device__ __forceinline__ f32x2 cmulc(f32x2 a, f32x2 b) { return (f32x2){a.x * b.x + a.y * b.y, a.y * b.x - a.x * b.y}; }
constexpr int XPAD = 2048 + 256;

__device__ __forceinline__ void fft_p1_dif(f32x2 (&v)[8], int tt, const LAS f32x2* T) {
#pragma unroll
    for (int g = 0; g < 2; ++g) { const int u = tt + 256 * g;
#pragma unroll
        for (int j = 0; j < 2; ++j) { const f32x2 a = v[g + 2 * j], b = v[g + 2 * j + 4]; v[g + 2 * j] = a + b; v[g + 2 * j + 4] = cmul(a - b, T[2 * (u + 512 * j)]); }
        const f32x2 tw = T[4 * u];
        { const f32x2 a = v[g], b = v[g + 2]; v[g] = a + b; v[g + 2] = cmul(a - b, tw); }
        { const f32x2 a = v[g + 4], b = v[g + 6]; v[g + 4] = a + b; v[g + 6] = cmul(a - b, tw); } }
}
__device__ __forceinline__ void fft_p1_dit(f32x2 (&v)[8], int tt, const LAS f32x2* T) {
#pragma unroll
    for (int g = 0; g < 2; ++g) { const int u = tt + 256 * g;
        const f32x2 tw = T[4 * u];
        { const f32x2 a = v[g], b = cmulc(v[g + 2], tw); v[g] = a + b; v[g + 2] = a - b; }
        { const f32x2 a = v[g + 4], b = cmulc(v[g + 6], tw); v[g + 4] = a + b; v[g + 6] = a - b; }
#pragma unroll
        for (int j = 0; j < 2; ++j) { const f32x2 a = v[g + 2 * j], b = cmulc(v[g + 2 * j + 4], T[2 * (u + 512 * j)]); v[g + 2 * j] = a + b; v[g + 2 * j + 4] = a - b; } }
}
template <int Q> __device__ __forceinline__ void r8_dif(f32x2 (&e)[8], int r, const LAS f32x2* T) {
    constexpr int S2 = 512 / Q;
#pragma unroll
    for (int j = 0; j < 4; ++j) { const f32x2 a = e[j], b = e[j + 4]; e[j] = a + b; e[j + 4] = cmul(a - b, T[S2 * (r + Q * j)]); }
#pragma unroll
    for (int jj = 0; jj < 4; ++jj) { const int j = (jj & 1) + 4 * (jj >> 1); const f32x2 a = e[j], b = e[j + 2]; e[j] = a + b; e[j + 2] = cmul(a - b, T[2 * S2 * (r + Q * (j & 1))]); }
    const f32x2 tw = T[4 * S2 * r];
#pragma unroll
    for (int j = 0; j < 8; j += 2) { const f32x2 a = e[j], b = e[j + 1]; e[j] = a + b; e[j + 1] = cmul(a - b, tw); }
}
template <int Q> __device__ __forceinline__ void r8_dit(f32x2 (&e)[8], int r, const LAS f32x2* T) {
    constexpr int S2 = 512 / Q;
    const f32x2 tw = T[4 * S2 * r];
#pragma unroll
    for (int j = 0; j < 8; j += 2) { const f32x2 a = e[j], b = cmulc(e[j + 1], tw); e[j] = a + b; e[j + 1] = a - b; }
#pragma unroll
    for (int jj = 0; jj < 4; ++jj) { const int j = (jj & 1) + 4 * (jj >> 1); const f32x2 a = e[j], b = cmulc(e[j + 2], T[2 * S2 * (r + Q * (j & 1))]); e[j] = a + b; e[j + 2] = a - b; }
#pragma unroll
    for (int j = 0; j < 4; ++j) { const f32x2 a = e[j], b = cmulc(e[j + 4], T[S2 * (r + Q * j)]); e[j] = a + b; e[j + 4] = a - b; }
}
template <int Q, bool INV> __device__ __forceinline__ void fft_mid(LAS f32x2* X, int tt, const LAS f32x2* T) {
    const int blk = tt / Q, r = tt % Q, base = blk * 8 * Q + r;
    f32x2 e[8];
#pragma unroll
    for (int j = 0; j < 8; ++j) e[j] = X[padx(base + Q * j)];
    if (INV) r8_dit<Q>(e, r, T); else r8_dif<Q>(e, r, T);
#pragma unroll
    for (int j = 0; j < 8; ++j) X[padx(base + Q * j)] = e[j];
}
__device__ __forceinline__ void fft_conv_half(f32x2 (&v)[8], LAS f32x2* X, const LAS f32x2* T, const f32x2* K, int tt) {
    f32x2 kv[8];
#pragma unroll
    for (int j = 0; j < 8; ++j) kv[j] = K[8 * tt + j];
    fft_p1_dif(v, tt, T);
#pragma unroll
    for (int m = 0; m < 8; ++m) X[padx(tt + 256 * m)] = v[m];
    __syncthreads();
    fft_mid<64, false>(X, tt, T); __syncthreads();
    fft_mid<8, false>(X, tt, T); __syncthreads();
    f32x2 e[8];
#pragma unroll
    for (int j = 0; j < 8; ++j) e[j] = X[padx(8 * tt + j)];
    r8_dif<1>(e, 0, T);
#pragma unroll
    for (int j = 0; j < 8; ++j) e[j] = cmul(e[j], kv[j]);
    r8_dit<1>(e, 0, T);
#pragma unroll
    for (int j = 0; j < 8; ++j) X[padx(8 * tt + j)] = e[j];
    __syncthreads();
    fft_mid<8, true>(X, tt, T); __syncthreads();
    fft_mid<64, true>(X, tt, T); __syncthreads();
#pragma unroll
    for (int m = 0; m < 8; ++m) v[m] = X[padx(tt + 256 * m)];
    fft_p1_dit(v, tt, T);
}
__device__ __forceinline__ void fft_fwd_store(f32x2 (&v)[8], LAS f32x2* X, const LAS f32x2* T, f32x2* Kout, int tt) {
    fft_p1_dif(v, tt, T);
#pragma unroll
    for (int m = 0; m < 8; ++m) X[padx(tt + 256 * m)] = v[m];
    __syncthreads();
    fft_mid<64, false>(X, tt, T); __syncthreads();
    fft_mid<8, false>(X, tt, T); __syncthreads();
    f32x2 e[8];
#pragma unroll
    for (int j = 0; j < 8; ++j) e[j] = X[padx(8 * tt + j)];
    r8_dif<1>(e, 0, T);
#pragma unroll
    for (int j = 0; j < 8; ++j) Kout[8 * tt + j] = e[j];
    __syncthreads();
}
__device__ __forceinline__ int padx16(int i) { return i + (i >> 4); }
constexpr int XPAD16 = 2048 + 128;
constexpr int TC_A1 = 0, TC_A2 = 1024, TC_A3 = 1536, TC_A4 = 1792, TC_B1 = 1920, TC_B2 = 1984, TC_B3 = 2016, TC_B4 = 2032, TC_N = 2040;
template <int Q> __device__ __forceinline__ void r16_dif(f32x2 (&e)[16], int r, const LAS f32x2* TC) {
    const LAS f32x2* P1 = TC + (Q == 128 ? TC_A1 : TC_B1); const LAS f32x2* P2 = TC + (Q == 128 ? TC_A2 : TC_B2);
    const LAS f32x2* P3 = TC + (Q == 128 ? TC_A3 : TC_B3); const LAS f32x2* P4 = TC + (Q == 128 ? TC_A4 : TC_B4);
#pragma unroll
    for (int j = 0; j < 8; ++j) { const f32x2 a = e[j], b = e[j + 8]; e[j] = a + b; e[j + 8] = cmul(a - b, P1[r + Q * j]); }
#pragma unroll
    for (int jj = 0; jj < 8; ++jj) { const int j = (jj & 3) + 8 * (jj >> 2); const f32x2 a = e[j], b = e[j + 4]; e[j] = a + b; e[j + 4] = cmul(a - b, P2[r + Q * (j & 3)]); }
#pragma unroll
    for (int jj = 0; jj < 8; ++jj) { const int j = (jj & 1) + 4 * (jj >> 1); const f32x2 a = e[j], b = e[j + 2]; e[j] = a + b; e[j + 2] = cmul(a - b, P3[r + Q * (j & 1)]); }
    const f32x2 tw = P4[r];
#pragma unroll
    for (int j = 0; j < 16; j += 2) { const f32x2 a = e[j], b = e[j + 1]; e[j] = a + b; e[j + 1] = cmul(a - b, tw); }
}
template <int Q> __device__ __forceinline__ void r16_dit(f32x2 (&e)[16], int r, const LAS f32x2* TC) {
    const LAS f32x2* P1 = TC + (Q == 128 ? TC_A1 : TC_B1); const LAS f32x2* P2 = TC + (Q == 128 ? TC_A2 : TC_B2);
    const LAS f32x2* P3 = TC + (Q == 128 ? TC_A3 : TC_B3); const LAS f32x2* P4 = TC + (Q == 128 ? TC_A4 : TC_B4);
    const f32x2 tw = P4[r];
#pragma unroll
    for (int j = 0; j < 16; j += 2) { const f32x2 a = e[j], b = cmulc(e[j + 1], tw); e[j] = a + b; e[j + 1] = a - b; }
#pragma unroll
    for (int jj = 0; jj < 8; ++jj) { const int j = (jj & 1) + 4 * (jj >> 1); const f32x2 a = e[j], b = cmulc(e[j + 2], P3[r + Q * (j & 1)]); e[j] = a + b; e[j + 2] = a - b; }
#pragma unroll
    for (int jj = 0; jj < 8; ++jj) { const int j = (jj & 3) + 8 * (jj >> 2); const f32x2 a = e[j], b = cmulc(e[j + 4], P2[r + Q * (j & 3)]); e[j] = a + b; e[j + 4] = a - b; }
#pragma unroll
    for (int j = 0; j < 8; ++j) { const f32x2 a = e[j], b = cmulc(e[j + 8], P1[r + Q * j]); e[j] = a + b; e[j + 8] = a - b; }
}
__device__ __forceinline__ f32x2 mul_mi(f32x2 a) { return (f32x2){a.y, -a.x}; }
__device__ __forceinline__ f32x2 mul_pi(f32x2 a) { return (f32x2){-a.y, a.x}; }
__device__ __forceinline__ void r8_dif_c(f32x2 (&e)[8]) {
    constexpr float h = 0.70710678118654752440f;
    { const f32x2 a = e[0], b = e[4]; e[0] = a + b; e[4] = a - b; }
    { const f32x2 a = e[1], b = e[5]; e[1] = a + b; const f32x2 d = a - b; e[5] = (f32x2){(d.x + d.y) * h, (d.y - d.x) * h}; }
    { const f32x2 a = e[2], b = e[6]; e[2] = a + b; e[6] = mul_mi(a - b); }
    { const f32x2 a = e[3], b = e[7]; e[3] = a + b; const f32x2 d = a - b; e[7] = (f32x2){(d.y - d.x) * h, -(d.x + d.y) * h}; }
#pragma unroll
    for (int g = 0; g < 8; g += 4) {
        { const f32x2 a = e[g], b = e[g + 2]; e[g] = a + b; e[g + 2] = a - b; }
        { const f32x2 a = e[g + 1], b = e[g + 3]; e[g + 1] = a + b; e[g + 3] = mul_mi(a - b); } }
#pragma unroll
    for (int j = 0; j < 8; j += 2) { const f32x2 a = e[j], b = e[j + 1]; e[j] = a + b; e[j + 1] = a - b; }
}
__device__ __forceinline__ void r8_dit_c(f32x2 (&e)[8]) {
    constexpr float h = 0.70710678118654752440f;
#pragma unroll
    for (int j = 0; j < 8; j += 2) { const f32x2 a = e[j], b = e[j + 1]; e[j] = a + b; e[j + 1] = a - b; }
#pragma unroll
    for (int g = 0; g < 8; g += 4) {
        { const f32x2 a = e[g], b = e[g + 2]; e[g] = a + b; e[g + 2] = a - b; }
        { const f32x2 a = e[g + 1], b = mul_pi(e[g + 3]); e[g + 1] = a + b; e[g + 3] = a - b; } }
    { const f32x2 a = e[0], b = e[4]; e[0] = a + b; e[4] = a - b; }
    { const f32x2 a = e[1], d = e[5]; const f32x2 b = (f32x2){(d.x - d.y) * h, (d.x + d.y) * h}; e[1] = a + b; e[5] = a - b; }
    { const f32x2 a = e[2], b = mul_pi(e[6]); e[2] = a + b; e[6] = a - b; }
    { const f32x2 a = e[3], d = e[7]; const f32x2 b = (f32x2){-(d.x + d.y) * h, (d.x - d.y) * h}; e[3] = a + b; e[7] = a - b; }
}
__device__ __forceinline__ void fft_conv_half16(f32x2 (&v)[16], LAS f32x2* X, const LAS f32x2* TC, const f32x2* K, int tt) {
    r16_dif<128>(v, tt, TC);
#pragma unroll
    for (int m = 0; m < 16; ++m) X[padx16(tt + 128 * m)] = v[m];
    __syncthreads();
    const int r = tt & 7, base = (tt >> 3) * 128 + r;
#pragma unroll
    for (int j = 0; j < 16; ++j) v[j] = X[padx16(base + 8 * j)];
    r16_dif<8>(v, r, TC);
#pragma unroll
    for (int j = 0; j < 16; ++j) X[padx16(base + 8 * j)] = v[j];
    f32x2 kv[16];
#pragma unroll
    for (int j = 0; j < 16; ++j) kv[j] = K[((j >> 1) * 128 + tt) * 2 + (j & 1)];
    __syncthreads();
#pragma unroll
    for (int g = 0; g < 2; ++g) { f32x2 e[8];
#pragma unroll
        for (int j = 0; j < 8; ++j) e[j] = X[padx16(16 * tt + 8 * g + j)];
        r8_dif_c(e);
#pragma unroll
        for (int j = 0; j < 8; ++j) e[j] = cmul(e[j], kv[8 * g + j]);
        r8_dit_c(e);
#pragma unroll
        for (int j = 0; j < 8; ++j) X[padx16(16 * tt + 8 * g + j)] = e[j]; }
    __syncthreads();
#pragma unroll
    for (int j = 0; j < 16; ++j) v[j] = X[padx16(base + 8 * j)];
    r16_dit<8>(v, r, TC);
#pragma unroll
    for (int j = 0; j < 16; ++j) X[padx16(base + 8 * j)] = v[j];
    __syncthreads();
#pragma unroll
    for (int m = 0; m < 16; ++m) v[m] = X[padx16(tt + 128 * m)];
    r16_dit<128>(v, tt, TC);
}
__device__ __forceinline__ void fft_fwd_store16(f32x2 (&v)[16], LAS f32x2* X, const LAS f32x2* TC, f32x2* Kout, int tt) {
    r16_dif<128>(v, tt, TC);
#pragma unroll
    for (int m = 0; m < 16; ++m) X[padx16(tt + 128 * m)] = v[m];
    __syncthreads();
    const int r = tt & 7, base = (tt >> 3) * 128 + r;
#pragma unroll
    for (int j = 0; j < 16; ++j) v[j] = X[padx16(base + 8 * j)];
    r16_dif<8>(v, r, TC);
#pragma unroll
    for (int j = 0; j < 16; ++j) X[padx16(base + 8 * j)] = v[j];
    __syncthreads();
#pragma unroll
    for (int g = 0; g < 2; ++g) { f32x2 e[8];
#pragma unroll
        for (int j = 0; j < 8; ++j) e[j] = X[padx16(16 * tt + 8 * g + j)];
        r8_dif_c(e);
#pragma unroll
        for (int j = 0; j < 8; ++j) Kout[(((8 * g + j) >> 1) * 128 + tt) * 2 + (j & 1)] = e[j]; }
    __syncthreads();
}
constexpr int HY_TC_OFF = 122880;
__device__ __forceinline__ void build_twiddles(const Ctx& C, LAS f32x2* T) {
    for (int k = C.tid; k < 2048; k += NTHR) { float s, c; sincospif((float)k * (1.0f / 2048.0f), &s, &c); T[k] = (f32x2){c, -s}; }
    __syncthreads();
    LAS f32x2* TC = (LAS f32x2*)(C.lds + HY_TC_OFF);
    for (int k = C.tid; k < TC_N; k += NTHR) {
        const int src = k < TC_A2 ? 2 * k : k < TC_A3 ? 4 * (k - TC_A2) : k < TC_A4 ? 8 * (k - TC_A3) : k < TC_B1 ? 16 * (k - TC_A4) : k < TC_B2 ? 32 * (k - TC_B1) : k < TC_B3 ? 64 * (k - TC_B2) : k < TC_B4 ? 128 * (k - TC_B3) : 256 * (k - TC_B4);
        TC[k] = T[src]; }
}

__device__ __forceinline__ void phase0(const Ctx& C) {
    LAS float* sil = (LAS float*)C.lds;
    LAS float* red = sil + 9 * 1024;
    LAS float* zs = red + 8 * 9 * 64;
    LAS float* h1s = zs + 8 * 40;
    const float* cin = GIN(IN_C); const float* cctx = GIN(IN_CCTX);
    for (int i = C.tid; i < 9 * 1024; i += NTHR) { const int r = i >> 10, k = i & 1023; const float v = r < 8 ? cin[r * 1024 + k] : cctx[k]; sil[i] = v / (1.0f + expf(-v)); }
    __syncthreads();
    float* mods = WSP(float, WS_MODS);
    const float* wmod = GIN(IN_WMOD); const float* bmod = GIN(IN_BMOD);
    for (int item = C.bid; item < 4 * 96; item += C.G) {
        const int l = item / 96, cb = item % 96, cc = C.tid & 63, kg = C.tid >> 6;
        const float* w = wmod + ((size_t)l * 1024 + kg * 128) * 6144 + cb * 64 + cc;
        const LAS float* sk = sil + kg * 128;
        float acc[9];
#pragma unroll
        for (int r = 0; r < 9; ++r) acc[r] = 0.f;
#pragma unroll 4
        for (int k = 0; k < 128; ++k) { const float wv = w[(size_t)k * 6144];
#pragma unroll
            for (int r = 0; r < 9; ++r) acc[r] += sk[r * 1024 + k] * wv; }
#pragma unroll
        for (int r = 0; r < 9; ++r) red[(kg * 9 + r) * 64 + cc] = acc[r];
        __syncthreads();
        for (int o = C.tid; o < 576; o += NTHR) { const int r = o >> 6, c2 = o & 63; float s = 0.f;
#pragma unroll
            for (int g = 0; g < 8; ++g) s += red[(g * 9 + r) * 64 + c2];
            mods[(size_t)(l * 9 + r) * 6144 + cb * 64 + c2] = s + bmod[l * 6144 + cb * 64 + c2]; }
        __syncthreads();
    }
    for (int item = C.bid; item < 4 * 288; item += C.G) {
        const int l = item / 288, r = item % 288, isctx = r >= 256;
        const int L = isctx ? 256 : 2048, t0 = (isctx ? r - 256 : r) * 8, tl = C.tid >> 6, j = C.tid & 63, t = t0 + tl;
        if (j < 33) { float z;
            if (j == 0) z = (float)t / (float)(L - 1);
            else { const int fi = (j - 1) & 15; const float freq = 1e-4f + (float)fi * ((15.0f - 1e-4f) / 15.0f);
                const float ang = ((float)(2.0 * 3.14159265358979323846 / L) * (float)t) * freq; z = (j <= 16) ? cosf(ang) : -sinf(ang); }
            zs[tl * 40 + j] = z; }
        __syncthreads();
        { const float* w1 = GIN(IN_W1) + (size_t)l * 33 * 64; float s = GIN(IN_B1)[l * 64 + j];
            for (int i = 0; i < 33; ++i) s += zs[tl * 40 + i] * w1[i * 64 + j];
            h1s[tl * 64 + j] = sinf(s); }
        __syncthreads();
        { const float* w2 = GIN(IN_W2) + (size_t)l * 64 * 64; float s = GIN(IN_B2)[l * 64 + j];
            for (int i = 0; i < 64; ++i) s += h1s[tl * 64 + i] * w2[i * 64 + j];
            bf16_t* dst = WSP(bf16_t, WS_HPAD) + ((size_t)l * 2304 + (isctx ? 2048 + t : t)) * 128;
            dst[j] = (bf16_t)f2bf(sinf(s)); dst[64 + j] = (bf16_t)0; }
        __syncthreads();
    }
    {
        const float* w3 = GIN(IN_W3); bf16_t* w3t = WSP(bf16_t, WS_W3T);
        for (int i = C.bid * NTHR + C.tid; i < 4 * 64 * 2048; i += C.G * NTHR) { const int l = i >> 17, k = (i >> 11) & 63, col = i & 2047;
            w3t[((size_t)l * 2048 + col) * 128 + k] = (bf16_t)f2bf(w3[i]); w3t[((size_t)l * 2048 + col) * 128 + 64 + k] = (bf16_t)0; }
    }
    if (C.bid == C.G - 1) {
        const float* lb = GIN(IN_LB); float* lower = WSP(float, WS_LOWER);
        for (int i = C.tid; i < 1024; i += NTHR) { const int d = i >> 9, c = i & 511; float v[4], mx = -3.4e38f, s = 0.f;
#pragma unroll
            for (int l = 0; l < 4; ++l) { v[l] = lb[(d * 4 + l) * 512 + c]; mx = fmaxf(mx, v[l]); }
#pragma unroll
            for (int l = 0; l < 4; ++l) { v[l] = expf(v[l] - mx); s += v[l]; }
            float cum = 0.f;
#pragma unroll
            for (int l = 0; l < 4; ++l) { if (l > 0) cum += v[l] / s; lower[(d * 4 + l) * 512 + c] = cum; } }
    }
}

__device__ __forceinline__ const float* xrow_src(const Ctx& C, int l, int row) {
    return l == 0 ? (row < NLAT ? GIN(IN_X) + (size_t)row * D : GIN(IN_CTX) + (size_t)(row - NLAT) * D) : WSP(const float, WS_XBUF) + (size_t)row * D;
}
__device__ __forceinline__ void transpose_item(const float* W, int K, int N, bf16_t* WT, LAS float* scr, int item, int lane) {
    const int nblk = N / 32, kb = item / nblk, nb = item % nblk, k0 = 64 * kb, n0 = 32 * nb;
    float wv[32];
#pragma unroll
    for (int i = 0; i < 32; ++i) wv[i] = W[(size_t)(k0 + 2 * i + (lane >> 5)) * N + n0 + (lane & 31)];
#pragma unroll
    for (int i = 0; i < 32; ++i) scr[(2 * i + (lane >> 5)) * 33 + (lane & 31)] = wv[i];
    LDS_WAIT(); asm volatile("" ::: "memory");
    const int c = lane & 7;
#pragma unroll
    for (int j = 0; j < 4; ++j) { const int n = (lane >> 3) + 8 * j; const LAS float* s = scr + (8 * c) * 33 + n;
        u32x4 o; o.x = pk2(s[0 * 33], s[1 * 33]); o.y = pk2(s[2 * 33], s[3 * 33]); o.z = pk2(s[4 * 33], s[5 * 33]); o.w = pk2(s[6 * 33], s[7 * 33]);
        *(u32x4*)(WT + (size_t)(n0 + n) * K + k0 + 8 * c) = o; }
    LDS_WAIT(); asm volatile("" ::: "memory");
}
__device__ __forceinline__ void phase_l1(const Ctx& C, int l) {
    const int gw = C.bid * NWAVES + C.wave, NGW = C.G * NWAVES;
    const float* mods = WSP(const float, WS_MODS) + (size_t)l * 9 * 6144;
    bf16_t* an = WSP(bf16_t, WS_R1);
    f32x4 nv[4];
    if (!(C.dry & 2)) {
    if (gw < NTOK) { const float* src = xrow_src(C, l, gw);
#pragma unroll
        for (int j = 0; j < 4; ++j) nv[j] = *(const f32x4*)(src + C.lane * 4 + 256 * j); }
    for (int row = gw; row < NTOK; row += NGW) {
        const float* md = mods + bidx(row) * 6144;
        f32x4 v[4]; float ss = 0.f;
#pragma unroll
        for (int j = 0; j < 4; ++j) v[j] = nv[j];
        if (row + NGW < NTOK) { const float* src = xrow_src(C, l, row + NGW);
#pragma unroll
            for (int j = 0; j < 4; ++j) nv[j] = *(const f32x4*)(src + C.lane * 4 + 256 * j); }
#pragma unroll
        for (int j = 0; j < 4; ++j) ss += (v[j].x * v[j].x + v[j].y * v[j].y) + (v[j].z * v[j].z + v[j].w * v[j].w);
        ss = wave_sum(ss); const float rinv = 1.0f / sqrtf(ss * (1.0f / D) + EPS);
#pragma unroll
        for (int j = 0; j < 4; ++j) { const int k = C.lane * 4 + 256 * j; const f32x4 sh = *(const f32x4*)(md + k), sc = *(const f32x4*)(md + 1024 + k);
            const f32x4 o = v[j] * rinv * (sc + 1.0f) + sh; u32x2 w; w.x = pk2(o.x, o.y); w.y = pk2(o.z, o.w);
            *(u32x2*)(an + (size_t)row * D + k) = w; }
    }
    }
    if (!(C.dry & 4)) {
        LAS float* scr = (LAS float*)(C.lds + C.wave * 16384);
        constexpr int I_IN = 16 * 128, I_OUT = 16 * 32, I_E = 128;
        constexpr int NIT = I_IN + I_OUT + 3 * 16 * I_E;
        for (int it = gw; it < NIT; it += NGW) {
            int r = it;
            if (r < I_IN) { transpose_item(GIN(IN_WIN) + (size_t)l * D * DIN, D, DIN, WSP(bf16_t, WS_WIN), scr, r, C.lane); continue; } r -= I_IN;
            if (r < I_OUT) { transpose_item(GIN(IN_WOUT) + (size_t)l * D * D, D, D, WSP(bf16_t, WS_WOUT), scr, r, C.lane); continue; } r -= I_OUT;
            if (r < 16 * I_E) { const int e = r / I_E; transpose_item(GIN(IN_WG) + ((size_t)l * NE + e) * D * DE, D, DE, WSP(bf16_t, WS_WG) + (size_t)e * DE * D, scr, r % I_E, C.lane); continue; } r -= 16 * I_E;
            if (r < 16 * I_E) { const int e = r / I_E; transpose_item(GIN(IN_WU) + ((size_t)l * NE + e) * D * DE, D, DE, WSP(bf16_t, WS_WU) + (size_t)e * DE * D, scr, r % I_E, C.lane); continue; } r -= 16 * I_E;
            { const int e = r / I_E; transpose_item(GIN(IN_WD) + ((size_t)l * NE + e) * DE * D, DE, D, WSP(bf16_t, WS_WD) + (size_t)e * D * DE, scr, r % I_E, C.lane); }
        }
    }
    __syncthreads();
    {
        LAS f32x2* T = (LAS f32x2*)C.lds;
        const LAS f32x2* TC = (const LAS f32x2*)(C.lds + HY_TC_OFF);
        const int team = C.tid >> 7, tt = C.tid & 127;
        LAS f32x2* X = (LAS f32x2*)(C.lds + 16384) + team * XPAD16;
        LAS float* hbs = (LAS float*)(C.lds + 16384 + 4 * XPAD16 * 8) + team * 2048;
        LAS float* reds = (LAS float*)(C.lds + 16384 + 4 * XPAD16 * 8 + 32768);
        build_twiddles(C, T);
        __syncthreads();
        const bf16_t* hfl = WSP(const bf16_t, WS_HF) + (size_t)l * 2048 * 2304;
        f32x2* kspec = WSP(f32x2, WS_KSPEC);
        if (!(C.dry & 8))
        for (int item = C.bid; item < 256; item += C.G) {
            const int idx = item * 4 + team, o = idx >> 9, c = idx & 511;
            const int colf = o * 1024 + c, colb = colf + 512;
            const bf16_t* hfp = hfl + (size_t)colf * 2304; const bf16_t* hbp = hfl + (size_t)colb * 2304;
            float hf[16], hb[16], s = 0.f;
#pragma unroll
            for (int j = 0; j < 16; ++j) { const int t = tt + 128 * j; hf[j] = bf2f(hfp[t]); hb[j] = bf2f(hbp[t]); s += fabsf(hf[j]) + fabsf(hb[j]); }
            s = wave_sum(s);
            if (C.lane == 0) reds[C.wave] = s;
            __syncthreads();
            const float inv = 1.0f / ((reds[team * 2] + reds[team * 2 + 1]) * 4096.0f);
#pragma unroll
            for (int j = 0; j < 16; ++j) { hf[j] *= inv; hbs[tt + 128 * j] = hb[j] * inv; }
            __syncthreads();
            f32x2* kout = kspec + ((size_t)(o * 512 + c) * 2) * 2048;
            f32x2 vv[16];
#pragma unroll
            for (int j = 0; j < 16; ++j) { const int n = tt + 128 * j; const float kb = n > 0 ? hbs[2048 - n] : 0.f; vv[j] = (f32x2){hf[j] + kb, 0.f}; }
            fft_fwd_store16(vv, X, TC, kout, tt);
#pragma unroll
            for (int j = 0; j < 16; ++j) { const int n = tt + 128 * j; const float kb = n > 0 ? hbs[2048 - n] : 0.f; const float dd = hf[j] - kb; const f32x2 tw = T[n]; vv[j] = (f32x2){dd * tw.x, dd * tw.y}; }
            fft_fwd_store16(vv, X, TC, kout + 2048, tt);
        }
        if (l < DEPTH - 1 && !(C.dry & 16)) {
            f32x2* kspc = WSP(f32x2, WS_KSPC);
            for (int item = C.bid; item < 256; item += C.G) {
                const int idx = item * 4 + team, o = idx >> 9, c = idx & 511;
                const int colf = o * 1024 + c, colb = colf + 512;
                float af0 = bf2f(hfl[(size_t)colf * 2304 + 2048 + tt]), af1 = bf2f(hfl[(size_t)colf * 2304 + 2048 + 128 + tt]);
                float ab0 = bf2f(hfl[(size_t)colb * 2304 + 2048 + tt]), ab1 = bf2f(hfl[(size_t)colb * 2304 + 2048 + 128 + tt]);
                __syncthreads();
                const float s = wave_sum((fabsf(af0) + fabsf(af1)) + (fabsf(ab0) + fabsf(ab1)));
                if (C.lane == 0) reds[C.wave] = s;
                __syncthreads();
                const float inv = 1.0f / ((reds[team * 2] + reds[team * 2 + 1]) * 2048.0f);
                af0 *= inv; af1 *= inv; hbs[tt] = ab0 * inv; hbs[128 + tt] = ab1 * inv;
                __syncthreads();
                f32x2 vk[16];
#pragma unroll
                for (int j = 0; j < 16; ++j) vk[j] = (f32x2){0.f, 0.f};
                vk[0] = (f32x2){af0, 0.f}; vk[1] = (f32x2){af1, 0.f};
                vk[14] = (f32x2){tt > 0 ? hbs[256 - tt] : 0.f, 0.f};
                vk[15] = (f32x2){hbs[128 - tt], 0.f};
                fft_fwd_store16(vk, X, TC, kspc + (size_t)(o * 512 + c) * 2048, tt);
            }
        }
    }
}

struct Taps { unsigned w1, wx; };
struct TapSel { unsigned m, c, p; };
__device__ __forceinline__ Taps sc_load(const LAS bf16_t* raw, int t) { const int e = t & ~1; Taps r; r.w1 = *(const LAS unsigned*)(raw + e); r.wx = *(const LAS unsigned*)(raw + e - 2 + 4 * (t & 1)); return r; }
__device__ __forceinline__ TapSel sc_sel(int t, bool has_m, bool has_p) { TapSel s; const bool odd = (t & 1) != 0;
    s.m = has_m ? (odd ? 0x01000c0cu : 0x07060c0cu) : 0x0c0c0c0cu; s.c = odd ? 0x03020c0cu : 0x01000c0cu; s.p = has_p ? (odd ? 0x05040c0cu : 0x03020c0cu) : 0x0c0c0c0cu; return s; }
__device__ __forceinline__ float sc_eval(const Taps r, const TapSel s, float w0, float w1, float w2, float bias) {
    const float pm = __builtin_bit_cast(float, __builtin_amdgcn_perm(r.wx, r.w1, s.m)), pc = __builtin_bit_cast(float, __builtin_amdgcn_perm(r.wx, r.w1, s.c)), pp = __builtin_bit_cast(float, __builtin_amdgcn_perm(r.wx, r.w1, s.p));
    return w0 * pm + w1 * pc + w2 * pp + bias; }
constexpr int HY_CH = 4, HY_ITEMS = 4 * (512 / HY_CH), HYC_ITEMS = 512 / 4;
__device__ __forceinline__ void hyena_lat(const Ctx& C, int l, int item) {
    const int bp = item & 3, cg = item >> 2, team = C.tid >> 7, tt = C.tid & 127;
    LAS f32x2* T = (LAS f32x2*)C.lds;
    const LAS f32x2* TC = (const LAS f32x2*)(C.lds + HY_TC_OFF);
    LAS f32x2* X = (LAS f32x2*)(C.lds + 16384) + team * XPAD16;
    LAS bf16_t* raw = (LAS bf16_t*)(C.lds + 16384 + 4 * XPAD16 * 8) + team * 4096;
    const bf16_t* phyt = WSP(const bf16_t, WS_PHYT);
    const float* cw = GIN(IN_CONVW) + (size_t)l * 3 * NHY; const float* cb = GIN(IN_CONVB) + (size_t)l * NHY;
    const float* hyb = GIN(IN_HYBIAS) + (size_t)l * 2 * DH;
    const f32x2* kspec = WSP(const f32x2, WS_KSPEC);
    const int ba = 2 * bp, c = cg * 4 + team;
    f32x2 z[16], acc[16], v[16];
#pragma unroll 1
    for (int stage = 0; stage < 3; ++stage) {
        const int ch = stage * 512 + c;
        __syncthreads();
#pragma unroll
        for (int k = 0; k < 4; ++k) { const int q = tt + 128 * k, rr = q >> 8, cc = q & 255;
            *(LAS u32x4*)(raw + rr * 2048 + cc * 8) = *(const u32x4*)(phyt + (size_t)ch * NTOK + (size_t)(ba + rr) * 2048 + cc * 8); }
        __syncthreads();
        const float w0 = cw[ch], w1 = cw[NHY + ch], w2 = cw[2 * NHY + ch], bs = cb[ch];
        const float dsk = stage > 0 ? hyb[(stage - 1) * DH + c] : 0.f;
        const TapSel ts = sc_sel(tt, (tt & 63) != 0, (tt & 63) != 63);
#pragma unroll
        for (int hb = 0; hb < 2; ++hb) {
            Taps ra[8], rb[8];
#pragma unroll
            for (int j = 0; j < 8; ++j) { const int t = tt + 128 * (8 * hb + j); ra[j] = sc_load(raw, t); rb[j] = sc_load(raw + 2048, t); }
            __builtin_amdgcn_sched_barrier(0); asm volatile("s_waitcnt lgkmcnt(0)" ::: "memory"); __builtin_amdgcn_sched_barrier(0);
#pragma unroll
            for (int j = 0; j < 8; ++j) { const int jj = 8 * hb + j;
                const float sa = sc_eval(ra[j], ts, w0, w1, w2, bs), sb = sc_eval(rb[j], ts, w0, w1, w2, bs);
                if (stage == 0) z[jj] = (f32x2){sa, sb};
                else { const f32x2 cv = acc[jj] + z[jj] * dsk; z[jj] = (f32x2){sa * cv.x, sb * cv.y}; } }
        }
        if (stage == 2) {
            LAS bf16_t* ob = (LAS bf16_t*)X;
#pragma unroll
            for (int j = 0; j < 16; ++j) { const int t = tt + 128 * j; ob[t] = (bf16_t)f2bf(z[j].x); ob[2048 + t] = (bf16_t)f2bf(z[j].y); }
            break;
        }
        const f32x2* K = kspec + ((size_t)(stage * 512 + c) * 2) * 2048;
#pragma unroll
        for (int j = 0; j < 16; ++j) v[j] = z[j];
        fft_conv_half16(v, X, TC, K, tt);
#pragma unroll
        for (int j = 0; j < 16; ++j) acc[j] = v[j];
#pragma unroll
        for (int j = 0; j < 16; ++j) v[j] = cmul(z[j], T[tt + 128 * j]);
        fft_conv_half16(v, X, TC, K + 2048, tt);
#pragma unroll
        for (int j = 0; j < 16; ++j) acc[j] += cmulc(v[j], T[tt + 128 * j]);
    }
    __syncthreads();
    bf16_t* Y = WSP(bf16_t, WS_R1);
    for (int i = C.tid; i < 4096; i += NTHR) { const int b = i >> 11, t = i & 2047;
        const LAS bf16_t* o0 = (const LAS bf16_t*)((LAS f32x2*)(C.lds + 16384)) + i;
        u32x2 w; w.x = (unsigned)o0[0] | ((unsigned)o0[XPAD16 * 4] << 16); w.y = (unsigned)o0[2 * XPAD16 * 4] | ((unsigned)o0[3 * XPAD16 * 4] << 16);
        *(u32x2*)(Y + ((size_t)(ba + b) * 2048 + t) * D + cg * 4) = w; }
    __syncthreads();
}
__device__ __forceinline__ void hyena_ctx2(const Ctx& C, int l, int item) {
    const int team = C.tid >> 7, tt = C.tid & 127, c = item * 4 + team;
    const LAS f32x2* TC = (const LAS f32x2*)(C.lds + HY_TC_OFF);
    LAS f32x2* X = (LAS f32x2*)(C.lds + 16384) + team * XPAD16;
    LAS bf16_t* raw = (LAS bf16_t*)(C.lds + 16384 + 4 * XPAD16 * 8) + team * 4096;
    const bf16_t* phyt = WSP(const bf16_t, WS_PHYT);
    const float* cw = GIN(IN_CONVW) + (size_t)l * 3 * NHY; const float* cb = GIN(IN_CONVB) + (size_t)l * NHY;
    const float* hyb = GIN(IN_HYBIAS) + (size_t)l * 2 * DH;
    const f32x2* kspc = WSP(const f32x2, WS_KSPC);
    bf16_t* Y = WSP(bf16_t, WS_R1);
    f32x2 z[16], v[16];
#pragma unroll
    for (int j = 0; j < 16; ++j) { z[j] = (f32x2){0.f, 0.f}; v[j] = (f32x2){0.f, 0.f}; }
#pragma unroll 1
    for (int stage = 0; stage < 3; ++stage) {
        const int ch = stage * 512 + c;
        __syncthreads();
#pragma unroll
        for (int k = 0; k < 2; ++k) { const int q = tt + 128 * k; *(LAS u32x4*)(raw + q * 8) = *(const u32x4*)(phyt + (size_t)ch * NTOK + NLAT + q * 8); }
        __syncthreads();
        const float w0 = cw[ch], w1 = cw[NHY + ch], w2 = cw[2 * NHY + ch], bs = cb[ch];
        const float dsk = stage > 0 ? hyb[(stage - 1) * DH + c] : 0.f;
        Taps ra[8], rb[8];
#pragma unroll
        for (int p = 0; p < 4; ++p)
#pragma unroll
            for (int hh = 0; hh < 2; ++hh) { const int tok = hh * 128 + tt; ra[2 * p + hh] = sc_load(raw, (2 * p) * 256 + tok); rb[2 * p + hh] = sc_load(raw, (2 * p + 1) * 256 + tok); }
        __builtin_amdgcn_sched_barrier(0); asm volatile("s_waitcnt lgkmcnt(0)" ::: "memory"); __builtin_amdgcn_sched_barrier(0);
        const TapSel ts0 = sc_sel(tt, tt != 0, true), ts1 = sc_sel(tt, true, tt != 127);
#pragma unroll
        for (int p = 0; p < 4; ++p)
#pragma unroll
            for (int hh = 0; hh < 2; ++hh) { const int m = 4 * p + hh;
                const TapSel ts = hh ? ts1 : ts0;
                const float ua = sc_eval(ra[2 * p + hh], ts, w0, w1, w2, bs), ub = sc_eval(rb[2 * p + hh], ts, w0, w1, w2, bs);
                if (stage == 0) z[m] = (f32x2){ua, ub};
                else { const f32x2 cv = v[m] + z[m] * dsk; z[m] = (f32x2){ua * cv.x, ub * cv.y}; } }
        if (stage == 2) {
#pragma unroll
            for (int p = 0; p < 4; ++p)
#pragma unroll
                for (int hh = 0; hh < 2; ++hh) { const int m = 4 * p + hh, tok = hh * 128 + tt;
                    Y[(size_t)(NLAT + (2 * p) * 256 + tok) * D + c] = (bf16_t)f2bf(z[m].x); Y[(size_t)(NLAT + (2 * p + 1) * 256 + tok) * D + c] = (bf16_t)f2bf(z[m].y); }
            break;
        }
#pragma unroll
        for (int j = 0; j < 16; ++j) v[j] = z[j];
        fft_conv_half16(v, X, TC, kspc + (size_t)(stage * 512 + c) * 2048, tt);
    }
}

constexpr int HG_QT = 0, HG_QP = 17408, HG_KP = 34816, HG_ST = 52224, HG_VT = 87040, HG_KH = 105472, HG_P = 123904, HG_SUB = 133120, HG_D = 135168;
__device__ __forceinline__ void hgrn_mfma(const Ctx& C, int item) {
    const int dir = item & 1, h = (item >> 1) & 3, b = item >> 3;
    LAS unsigned char* L = C.lds;
    const int lane = C.lane, w = C.wave, r = lane & 15, quad = lane >> 4;
    const int I = w >> 1, col = (w & 1) * 64 + lane;
    const bf16_t* phg = WSP(const bf16_t, WS_PHG);
    bf16_t* odir = WSP(bf16_t, WS_ODIR) + (size_t)dir * NTOK * 512;
    LAS float* subtot = (LAS float*)(L + HG_SUB); LAS float* Dv = (LAS float*)(L + HG_D);
    __syncthreads();
    unsigned z0_ = 0u; asm volatile("" : "+v"(z0_));
    const u32x4 zv_ = (u32x4){z0_, z0_, z0_, z0_}; const float zff_ = __builtin_bit_cast(float, z0_); const f32x4 zv4f_ = (f32x4){zff_, zff_, zff_, zff_};
    for (int i = C.tid; i < (128 * 272) / 16; i += NTHR) *(LAS u32x4*)(L + HG_ST + i * 16) = zv_;
    for (int i = C.tid; i < (64 * 144) / 16; i += NTHR) *(LAS u32x4*)(L + HG_P + i * 16) = zv_;
    f32x4 sacc[8];
#pragma unroll
    for (int t = 0; t < 8; ++t) sacc[t] = zv4f_;
    unsigned short qr[16], kr[16], vr[16];
    const int rstep = dir ? -1 : 1;
    const size_t colq = (size_t)h * 128 + col, colk = 1536 + (size_t)dir * 512 + h * 128 + col, colv = 512 + (size_t)h * 128 + col;
    auto chunk_row0 = [&](int ch) -> int { return ch < 4 ? NLAT + b * 256 + (dir ? 255 - ch * 64 : ch * 64) : b * 2048 + (dir ? 2047 - (ch - 4) * 64 : (ch - 4) * 64); };
    { const int row0 = chunk_row0(0) + rstep * 16 * I;
#pragma unroll
      for (int i = 0; i < 16; ++i) { const bf16_t* p = phg + (size_t)(row0 + rstep * i) * NHG; qr[i] = p[colq]; kr[i] = p[colk]; vr[i] = p[colv]; } }
    __syncthreads();
#pragma unroll 1
    for (int ch = 0; ch < 36; ++ch) {
        float cp[16]; float cq = 1.0f;
#pragma unroll
        for (int i = 0; i < 16; ++i) { cq *= 1.0f - bf2f(kr[i]); cp[i] = cq; }
        subtot[I * 128 + col] = cq;
        __syncthreads();
        const float s0 = subtot[col], s1 = subtot[128 + col], s2 = subtot[256 + col], s3 = subtot[384 + col];
        const float pre = (I > 0 ? s0 : 1.0f) * (I > 1 ? s1 : 1.0f) * (I > 2 ? s2 : 1.0f), erho = s0 * s1, eend = s2 * s3;
        const float ainv = pre * __builtin_amdgcn_rcpf(erho);
        unsigned khp[8], vtp[8];
#pragma unroll
        for (int i = 0; i < 16; i += 2) {
            const float e1a = cp[i] * ainv, e1b = cp[i + 1] * ainv, e2a = __builtin_amdgcn_rcpf(e1a), e2b = __builtin_amdgcn_rcpf(e1b);
            const float qpa = bf2f(qr[i]) * e1a, qpb = bf2f(qr[i + 1]) * e1b, kpa = bf2f(kr[i]) * e2a, kpb = bf2f(kr[i + 1]) * e2b;
            const unsigned wqp = pk2(qpa, qpb), wqt = pk2(qpa * erho, qpb * erho), wkp = pk2(kpa, kpb);
            const int srow = (16 * I + i) * 272 + col * 2;
            *(LAS bf16_t*)(L + HG_QP + srow) = (bf16_t)(wqp & 0xffffu); *(LAS bf16_t*)(L + HG_QP + srow + 272) = (bf16_t)(wqp >> 16);
            *(LAS bf16_t*)(L + HG_QT + srow) = (bf16_t)(wqt & 0xffffu); *(LAS bf16_t*)(L + HG_QT + srow + 272) = (bf16_t)(wqt >> 16);
            *(LAS bf16_t*)(L + HG_KP + srow) = (bf16_t)(wkp & 0xffffu); *(LAS bf16_t*)(L + HG_KP + srow + 272) = (bf16_t)(wkp >> 16);
            khp[i >> 1] = pk2(kpa * eend, kpb * eend);
            vtp[i >> 1] = (unsigned)vr[i] | ((unsigned)vr[i + 1] << 16);
        }
        *(LAS u32x4*)(L + HG_KH + col * 144 + I * 32) = (u32x4){khp[0], khp[1], khp[2], khp[3]};
        *(LAS u32x4*)(L + HG_KH + col * 144 + I * 32 + 16) = (u32x4){khp[4], khp[5], khp[6], khp[7]};
        *(LAS u32x4*)(L + HG_VT + col * 144 + I * 32) = (u32x4){vtp[0], vtp[1], vtp[2], vtp[3]};
        *(LAS u32x4*)(L + HG_VT + col * 144 + I * 32 + 16) = (u32x4){vtp[4], vtp[5], vtp[6], vtp[7]};
        if (I == 0) Dv[col] = erho * eend;
        const int crow0 = chunk_row0(ch);
        if (ch + 1 < 36) { const int row0 = chunk_row0(ch + 1) + rstep * 16 * I;
#pragma unroll
            for (int i = 0; i < 16; ++i) { const bf16_t* p = phg + (size_t)(row0 + rstep * i) * NHG; qr[i] = p[colq]; kr[i] = p[colk]; vr[i] = p[colv]; } }
        __syncthreads();
#pragma unroll 1
        for (int blk = w; blk < 10; blk += 8) {
            const int I2 = blk < 1 ? 0 : (blk < 3 ? 1 : (blk < 6 ? 2 : 3)), J2 = blk - (I2 * (I2 + 1)) / 2;
            f32x4 pa = zv4f_;
#pragma unroll
            for (int kk = 0; kk < 4; ++kk) {
                const bf16x8 a = *(const LAS bf16x8*)(L + HG_KP + (J2 * 16 + r) * 272 + (32 * kk + 8 * quad) * 2);
                const bf16x8 bq = *(const LAS bf16x8*)(L + HG_QP + (I2 * 16 + r) * 272 + (32 * kk + 8 * quad) * 2);
                pa = __builtin_amdgcn_mfma_f32_16x16x32_bf16(a, bq, pa, 0, 0, 0);
            }
            if (I2 == J2) {
#pragma unroll
                for (int rr = 0; rr < 4; ++rr) if (4 * quad + rr > r) pa[rr] = 0.f;
            }
            u32x2 pw; pw.x = pk2(pa[0], pa[1]); pw.y = pk2(pa[2], pa[3]);
            *(LAS u32x2*)(L + HG_P + (I2 * 16 + r) * 144 + (J2 * 16 + 4 * quad) * 2) = pw;
        }
        __syncthreads();
        {
            bf16x8 sfr[4];
#pragma unroll
            for (int kk = 0; kk < 4; ++kk) sfr[kk] = *(const LAS bf16x8*)(L + HG_ST + (16 * w + r) * 272 + (32 * kk + 8 * quad) * 2);
            const bf16x8 vf0 = *(const LAS bf16x8*)(L + HG_VT + (16 * w + r) * 144 + (8 * quad) * 2);
            const bf16x8 vf1 = *(const LAS bf16x8*)(L + HG_VT + (16 * w + r) * 144 + (32 + 8 * quad) * 2);
#pragma unroll
            for (int I3 = 0; I3 < 4; ++I3) {
                f32x4 oa = zv4f_;
#pragma unroll
                for (int kk = 0; kk < 4; ++kk) {
                    const bf16x8 bq = *(const LAS bf16x8*)(L + HG_QT + (I3 * 16 + r) * 272 + (32 * kk + 8 * quad) * 2);
                    oa = __builtin_amdgcn_mfma_f32_16x16x32_bf16(sfr[kk], bq, oa, 0, 0, 0);
                }
                { const bf16x8 bp = *(const LAS bf16x8*)(L + HG_P + (I3 * 16 + r) * 144 + (8 * quad) * 2);
                  oa = __builtin_amdgcn_mfma_f32_16x16x32_bf16(vf0, bp, oa, 0, 0, 0); }
                if (I3 >= 2) { const bf16x8 bp = *(const LAS bf16x8*)(L + HG_P + (I3 * 16 + r) * 144 + (32 + 8 * quad) * 2);
                  oa = __builtin_amdgcn_mfma_f32_16x16x32_bf16(vf1, bp, oa, 0, 0, 0); }
                const int row = crow0 + rstep * (16 * I3 + r);
                u32x2 ow; ow.x = pk2(oa[0], oa[1]); ow.y = pk2(oa[2], oa[3]);
                *(u32x2*)(odir + (size_t)row * 512 + h * 128 + 16 * w + 4 * quad) = ow;
            }
#pragma unroll
            for (int t = 0; t < 8; ++t) {
                const f32x4 dd = *(const LAS f32x4*)(L + HG_D + (16 * t + 4 * quad) * 4);
                f32x4 sa = sacc[t] * dd;
                const bf16x8 a0 = *(const LAS bf16x8*)(L + HG_KH + (16 * t + r) * 144 + (8 * quad) * 2);
                const bf16x8 a1 = *(const LAS bf16x8*)(L + HG_KH + (16 * t + r) * 144 + (32 + 8 * quad) * 2);
                sa = __builtin_amdgcn_mfma_f32_16x16x32_bf16(a0, vf0, sa, 0, 0, 0);
                sa = __builtin_amdgcn_mfma_f32_16x16x32_bf16(a1, vf1, sa, 0, 0, 0);
                sacc[t] = sa;
                u32x2 sw; sw.x = pk2(sa[0], sa[1]); sw.y = pk2(sa[2], sa[3]);
                *(LAS u32x2*)(L + HG_ST + (16 * w + r) * 272 + (16 * t + 4 * quad) * 2) = sw;
            }
        }
    }
    __syncthreads();
}
__device__ __forceinline__ void phase_l3(const Ctx& C, int l, unsigned* hyd) {
    if (C.bid < 64) hgrn_mfma(C, C.bid);
    build_twiddles(C, (LAS f32x2*)C.lds);
    if (C.tid == 0) { unsigned sp = 0; const unsigned need = (unsigned)(C.G - 64);
        while (__hip_atomic_load(hyd, __ATOMIC_RELAXED, __HIP_MEMORY_SCOPE_AGENT) < need) { __builtin_amdgcn_s_sleep(4); if (++sp > (1u << 22)) break; }
        __builtin_amdgcn_fence(__ATOMIC_ACQUIRE, "agent"); asm volatile("s_waitcnt vmcnt(0)" ::: "memory"); }
    __syncthreads();
    unsigned* qh = WSP(unsigned, WS_CTL) + CW_Q + l * 64 + C.rep * 16;
    volatile LAS int* lc = (volatile LAS int*)(C.lds + LDSCTL_OFF);
    const int nitems = HY_ITEMS + (l < DEPTH - 1 ? HYC_ITEMS : 0);
    for (;;) {
        if (C.tid == 0) lc[LC_Q] = (int)__hip_atomic_fetch_add(qh, 1u, __ATOMIC_RELAXED, __HIP_MEMORY_SCOPE_AGENT);
        __syncthreads();
        const int item = lc[LC_Q];
        __syncthreads();
        if (item >= nitems) break;
        Ctx CI = C; { int t_ = C.tid; asm volatile("" : "+v"(t_)); CI.tid = t_; CI.lane = t_ & 63; }
        if (item < HY_ITEMS) hyena_lat(CI, l, item); else hyena_ctx2(CI, l, item - HY_ITEMS);
    }
}
__device__ __forceinline__ void phase_l3b(const Ctx& C, int l) {
    const int gw = C.bid * NWAVES + C.wave, NGW = C.G * NWAVES;
    const bf16_t* od0 = WSP(const bf16_t, WS_ODIR); const bf16_t* od1 = od0 + (size_t)NTOK * 512;
    const bf16_t* phg = WSP(const bf16_t, WS_PHG); bf16_t* Y = WSP(bf16_t, WS_R1);
    const float* nw = GIN(IN_NORMW) + l * 128;
    const int nrows = (l < DEPTH - 1) ? NTOK : NLAT;
    for (int row = gw; row < nrows; row += NGW) {
        const int idx = C.lane * 8;
        const u32x4 a = *(const u32x4*)(od0 + (size_t)row * 512 + idx), b = *(const u32x4*)(od1 + (size_t)row * 512 + idx), g = *(const u32x4*)(phg + (size_t)row * NHG + 1024 + idx);
        float o[8] = {bflo(a.x) + bflo(b.x), bfhi(a.x) + bfhi(b.x), bflo(a.y) + bflo(b.y), bfhi(a.y) + bfhi(b.y), bflo(a.z) + bflo(b.z), bfhi(a.z) + bfhi(b.z), bflo(a.w) + bflo(b.w), bfhi(a.w) + bfhi(b.w)};
        const float gg[8] = {bflo(g.x), bfhi(g.x), bflo(g.y), bfhi(g.y), bflo(g.z), bfhi(g.z), bflo(g.w), bfhi(g.w)};
        float ss = 0.f;
#pragma unroll
        for (int i = 0; i < 8; ++i) ss += o[i] * o[i];
        ss = row16_sum(ss);
        const float rinv = 1.0f / sqrtf(ss * (1.0f / 128.0f) + EPS);
        float y[8];
#pragma unroll
        for (int i = 0; i < 8; ++i) y[i] = o[i] * rinv * nw[(idx + i) & 127] * siluf_(gg[i]);
        u32x4 w; w.x = pk2(y[0], y[1]); w.y = pk2(y[2], y[3]); w.z = pk2(y[4], y[5]); w.w = pk2(y[6], y[7]);
        *(u32x4*)(Y + (size_t)row * D + 512 + idx) = w;
    }
}

constexpr int RW_PITCH = 1028;
__device__ __forceinline__ void phase_l5a(const Ctx& C, int l) {
    LAS float* rwT = (LAS float*)C.lds;
    LAS int* lcnt = (LAS int*)(C.lds + 16 * RW_PITCH * 4);
    LAS float* wsc = (LAS float*)(C.lds + 16 * RW_PITCH * 4 + 128) + C.wave * 384;
    const float* rw = GIN(IN_RW);
    for (int i = C.tid; i < 16 * 1024; i += NTHR) { const int k = i >> 4, e = i & 15; rwT[e * RW_PITCH + k] = rw[i]; }
    if (C.tid < 32) lcnt[C.tid] = 0;
    __syncthreads();
    const int gw = C.bid * NWAVES + C.wave, NGW = C.G * NWAVES;
    const float* mods = WSP(const float, WS_MODS) + (size_t)l * 9 * 6144;
    const float* bias2 = WSP(const float, WS_BIAS2) + l * 9 * 16;
    const float* xb = WSP(const float, WS_XBUF);
    const float* rbias = GIN(IN_RB);
    unsigned* cnt = WSP(unsigned, WS_CTL) + CW_CNT + l * 32 * 64;
    int* tokinfo = WSP(int, WS_TOKINFO);
    const int ngroups = ((l < DEPTH - 1) ? NTOK : NLAT) / 16;
    const int li = C.lane & 15, kq = C.lane >> 4;
    for (int g = gw; g < ngroups; g += NGW) {
        const int row0 = g * 16, bb = bidx(row0);
        const float* xp = xb + (size_t)(row0 + li) * D + kq * 4;
        const float* scp = mods + bb * 6144 + 4096 + kq * 4;
        const LAS float* bp = rwT + li * RW_PITCH + kq * 4;
        f32x4 acc0 = (f32x4){0.f, 0.f, 0.f, 0.f}, acc1 = acc0, acc2 = acc0, acc3 = acc0; float ss = 0.f;
#pragma unroll 8
        for (int m = 0; m < 64; ++m) {
            const f32x4 xv = *(const f32x4*)(xp + 16 * m), sc = *(const f32x4*)(scp + 16 * m), bv = *(const LAS f32x4*)(bp + 16 * m);
            ss += (xv.x * xv.x + xv.y * xv.y) + (xv.z * xv.z + xv.w * xv.w);
            const f32x4 av = xv * (sc + 1.0f);
            acc0 = __builtin_amdgcn_mfma_f32_16x16x4f32(av.x, bv.x, acc0, 0, 0, 0);
            acc1 = __builtin_amdgcn_mfma_f32_16x16x4f32(av.y, bv.y, acc1, 0, 0, 0);
            acc2 = __builtin_amdgcn_mfma_f32_16x16x4f32(av.z, bv.z, acc2, 0, 0, 0);
            acc3 = __builtin_amdgcn_mfma_f32_16x16x4f32(av.w, bv.w, acc3, 0, 0, 0);
        }
        const f32x4 acc = (acc0 + acc1) + (acc2 + acc3);
        wsc[C.lane] = ss;
#pragma unroll
        for (int r = 0; r < 4; ++r) wsc[64 + (4 * kq + r) * 17 + li] = acc[r];
        LDS_WAIT(); asm volatile("" ::: "memory");
        if (C.lane < 16) {
            const int row = row0 + C.lane;
            const float sst = (wsc[C.lane] + wsc[16 + C.lane]) + (wsc[32 + C.lane] + wsc[48 + C.lane]);
            const float rinv = 1.0f / sqrtf(sst * (1.0f / D) + EPS);
            float lg[16];
#pragma unroll
            for (int e = 0; e < 16; ++e) lg[e] = rinv * wsc[64 + C.lane * 17 + e] + bias2[bb * 16 + e];
            float mx = lg[0];
#pragma unroll
            for (int e = 1; e < 16; ++e) mx = fmaxf(mx, lg[e]);
            float sc[16], se = 0.f;
#pragma unroll
            for (int e = 0; e < 16; ++e) { sc[e] = expf(lg[e] - mx); se += sc[e]; }
            float sel[16];
#pragma unroll
            for (int e = 0; e < 16; ++e) { sc[e] = sc[e] / se; sel[e] = sc[e] + rbias[e]; }
            float bestgs = -3.4e38f; int bg = 0; float bs[4], bsc[4];
#pragma unroll
            for (int gg = 0; gg < 4; ++gg) {
                float m1 = -3.4e38f, m2 = -3.4e38f;
#pragma unroll
                for (int i = 0; i < 4; ++i) { const float x = sel[4 * gg + i]; if (x > m1) { m2 = m1; m1 = x; } else if (x > m2) m2 = x; }
                const float gs = m1 + m2;
                if (gs > bestgs) { bestgs = gs; bg = gg;
#pragma unroll
                    for (int i = 0; i < 4; ++i) { bs[i] = sel[4 * gg + i]; bsc[i] = sc[4 * gg + i]; } }
            }
            int i0 = 0; float b0 = bs[0];
#pragma unroll
            for (int i = 1; i < 4; ++i) if (bs[i] > b0) { b0 = bs[i]; i0 = i; }
            int i1 = -1; float b1 = -3.4e38f;
#pragma unroll
            for (int i = 0; i < 4; ++i) if (i != i0 && bs[i] > b1) { b1 = bs[i]; i1 = i; }
            float w0 = 0.f, w1 = 0.f;
#pragma unroll
            for (int i = 0; i < 4; ++i) { if (i == i0) w0 = bsc[i]; if (i == i1) w1 = bsc[i]; }
            const float wn = w0 + w1; w0 /= wn; w1 /= wn;
            const int lo = i0 < i1 ? i0 : i1, hi = i0 < i1 ? i1 : i0;
            const float wlo = i0 < i1 ? w0 : w1, whi = i0 < i1 ? w1 : w0;
            const int bin = bg * 6 + (lo * (7 - lo)) / 2 + (hi - lo - 1);
            const int slot = __hip_atomic_fetch_add(lcnt + bin, 1, __ATOMIC_RELAXED, __HIP_MEMORY_SCOPE_WORKGROUP);
            *(int4*)(tokinfo + (size_t)row * 4) = make_int4(bin, slot, __float_as_int(wlo), __float_as_int(whi));
        }
        LDS_WAIT(); asm volatile("" ::: "memory");
    }
    __syncthreads();
    if (C.tid < NBIN && !C.dry) { const int n = lcnt[C.tid];
        WSP(int, WS_BLKBASE)[C.bid * 32 + C.tid] = n > 0 ? (int)__hip_atomic_fetch_add(cnt + C.tid * 64, (unsigned)n, __ATOMIC_RELAXED, __HIP_MEMORY_SCOPE_AGENT) : 0; }
}
__device__ __forceinline__ void phase_l5b(const Ctx& C, int l) {
    build_tiletab(C, l);
    const volatile LAS int* lc = (const volatile LAS int*)(C.lds + LDSCTL_OFF);
    const int gw = C.bid * NWAVES + C.wave, NGW = C.G * NWAVES;
    const float* mods = WSP(const float, WS_MODS) + (size_t)l * 9 * 6144;
    const float* xb = WSP(const float, WS_XBUF);
    const int* tokinfo = WSP(const int, WS_TOKINFO); const int* blkbase = WSP(const int, WS_BLKBASE);
    bf16_t* hs = WSP(bf16_t, WS_PHG); int* rowtok = WSP(int, WS_ROWTOK); float* roww = WSP(float, WS_ROWW);
    const int nrows = (l < DEPTH - 1) ? NTOK : NLAT;
    f32x4 nv[4]; int4 nti = make_int4(0, 0, 0, 0);
    if (gw < nrows) { nti = *(const int4*)(tokinfo + (size_t)gw * 4);
#pragma unroll
        for (int j = 0; j < 4; ++j) nv[j] = *(const f32x4*)(xb + (size_t)gw * D + C.lane * 4 + 256 * j); }
    for (int row = gw; row < nrows; row += NGW) {
        const int4 ti = nti;
        const int pos = lc[LC_OFFS + ti.x] + blkbase[(((row >> 4) % NGW) >> 3) * 32 + ti.x] + ti.y;
        const float* md = mods + bidx(row) * 6144;
        f32x4 v[4]; float ss = 0.f;
#pragma unroll
        for (int j = 0; j < 4; ++j) v[j] = nv[j];
        if (row + NGW < nrows) { nti = *(const int4*)(tokinfo + (size_t)(row + NGW) * 4);
#pragma unroll
            for (int j = 0; j < 4; ++j) nv[j] = *(const f32x4*)(xb + (size_t)(row + NGW) * D + C.lane * 4 + 256 * j); }
#pragma unroll
        for (int j = 0; j < 4; ++j) ss += (v[j].x * v[j].x + v[j].y * v[j].y) + (v[j].z * v[j].z + v[j].w * v[j].w);
        ss = wave_sum(ss); const float rinv = 1.0f / sqrtf(ss * (1.0f / D) + EPS);
#pragma unroll
        for (int j = 0; j < 4; ++j) { const int k = C.lane * 4 + 256 * j; const f32x4 sh = *(const f32x4*)(md + 3072 + k), sc = *(const f32x4*)(md + 4096 + k);
            const f32x4 o = v[j] * rinv * (sc + 1.0f) + sh; u32x2 w; w.x = pk2(o.x, o.y); w.y = pk2(o.z, o.w);
            *(u32x2*)(hs + (size_t)pos * D + k) = w; }
        if (C.lane == 0) { rowtok[pos] = row; roww[pos * 2] = __int_as_float(ti.z); roww[pos * 2 + 1] = __int_as_float(ti.w); }
    }
    if (C.bid < NBIN) { const int b = C.bid; const int start = lc[LC_OFFS + b], end = lc[LC_OFFS + b + 1];
        const int n = (int)__hip_atomic_load(WSP(unsigned, WS_CTL) + CW_CNT + (l * 32 + b) * 64, __ATOMIC_RELAXED, __HIP_MEMORY_SCOPE_AGENT);
        float zf_ = 0.f; asm volatile("" : "+v"(zf_));
        for (int p = start + n + C.tid; p < end; p += NTHR) { rowtok[p] = -1; roww[p * 2] = zf_; roww[p * 2 + 1] = zf_; } }
}

__device__ __forceinline__ void phase_final(const Ctx& C) {
    const int gw = C.bid * NWAVES + C.wave, NGW = C.G * NWAVES;
    const float* xb = WSP(const float, WS_XBUF); const float* fw = GIN(IN_FNW);
    f32x4 nv[4];
    if (gw < NLAT) {
#pragma unroll
        for (int j = 0; j < 4; ++j) nv[j] = *(const f32x4*)(xb + (size_t)gw * D + C.lane * 4 + 256 * j); }
    for (int row = gw; row < NLAT; row += NGW) {
        f32x4 v[4]; float ss = 0.f;
#pragma unroll
        for (int j = 0; j < 4; ++j) v[j] = nv[j];
        if (row + NGW < NLAT) {
#pragma unroll
            for (int j = 0; j < 4; ++j) nv[j] = *(const f32x4*)(xb + (size_t)(row + NGW) * D + C.lane * 4 + 256 * j); }
#pragma unroll
        for (int j = 0; j < 4; ++j) ss += (v[j].x * v[j].x + v[j].y * v[j].y) + (v[j].z * v[j].z + v[j].w * v[j].w);
        ss = wave_sum(ss); const float rinv = 1.0f / sqrtf(ss * (1.0f / D) + EPS);
#pragma unroll
        for (int j = 0; j < 4; ++j) { const int k = C.lane * 4 + 256 * j; const f32x4 w = *(const f32x4*)(fw + k);
            *(f32x4*)(C.out + (size_t)row * D + k) = v[j] * rinv * w; }
    }
}

constexpr int PH_PER_LAYER = 8, N_PHASES = 2 + DEPTH * PH_PER_LAYER + 1;
__global__ void __launch_bounds__(NTHR, 2) trunk_fwd(Args args) {
    extern __shared__ __attribute__((aligned(16))) unsigned char lds[];
    Ctx C; C.in = (const CAS fptr_t*)__builtin_amdgcn_kernarg_segment_ptr(); C.out = args.out; C.ws = (GAS unsigned char*)args.ws; C.lds = (LAS unsigned char*)lds;
    C.tid = threadIdx.x; C.lane = C.tid & 63; C.wave = __builtin_amdgcn_readfirstlane(C.tid >> 6); C.G = gridDim.x; C.bid = blockIdx.x; C.rep = args.rep; C.dry = (args.rep + 1 < (args.pad & 255)) ? (args.pad >> 8) : 0;
    LAS unsigned char* ldsl0 = (LAS unsigned char*)lds;
    if (C.tid < 64) ((LAS unsigned*)(ldsl0 + LDSCTL_OFF))[C.tid] = 0u;
    __syncthreads();
    const int lo = args.ph_lo, hi = args.ph_hi;
    XcdBarrier bar; bar.bar = WSP(unsigned, WS_CTL) + CW_BAR; bar.x = 0; bar.st = (volatile LAS unsigned*)(ldsl0 + LDSCTL_OFF + LC_BAR);
    if (hi - lo > 1) bar = xcd_barrier_post(WSP(unsigned, WS_CTL) + CW_BAR, (volatile LAS unsigned*)(ldsl0 + LDSCTL_OFF + LC_BAR));
    { unsigned blo_ = __builtin_amdgcn_readfirstlane((unsigned)(unsigned long long)bar.bar), bhi_ = __builtin_amdgcn_readfirstlane((unsigned)((unsigned long long)bar.bar >> 32));
      asm volatile("" : "+s"(blo_), "+s"(bhi_)); bar.bar = (unsigned*)(((unsigned long long)bhi_ << 32) | blo_); }
#define FRESH_TID (C.wave * 64 + lane_id_opaque())
#define IN(k) (lo <= (k) && (k) < hi)
#define CPH(name) Ctx name = C; { int t_ = FRESH_TID; asm volatile("" : "+v"(t_)); name.tid = t_; name.lane = t_ & 63; }
#define SEAM(k) do { if (IN(k) && IN((k) + 1)) xcd_barrier(bar, FRESH_TID); } while (0)
#ifndef EN
#define EN 0xFFFF
#endif
    if ((EN & 1) && IN(0)) { phase0(C); SEAM(0); }
    if ((EN & 1) && IN(1)) {
        {
            const float* md = WSP(const float, WS_MODS); const float* rw = GIN(IN_RW); float* b2 = WSP(float, WS_BIAS2);
            for (int o = C.bid * NWAVES + C.wave; o < 4 * 9 * 16; o += C.G * NWAVES) { const int lr = o >> 4, e = o & 15; const float* sh = md + (size_t)lr * 6144 + 3072; float sacc = 0.f;
#pragma unroll
                for (int j = 0; j < 16; ++j) { const int k = C.lane + 64 * j; sacc += sh[k] * rw[k * 16 + e]; }
                sacc = wave_sum(sacc);
                if (C.lane == 0) b2[o] = sacc; }
        }
        SchedFilt S{C.G, C.bid};
        EpiFilt E{WSP(bf16_t, WS_HF), GIN(IN_B3)};
        pg8::gemm_phase<false>(ldsl0, S, E, (const char*)WSP(bf16_t, WS_W3T), (const char*)WSP(bf16_t, WS_HPAD), 128, 128, 128u * 128u * 2u, 128u * 128u * 2u, 2, FRESH_TID);
        SEAM(1);
    }
    const Ctx C0 = C;
#pragma unroll 1
    for (int l = 0; l < DEPTH; ++l) {
        const int p0 = 2 + l * PH_PER_LAYER;
        Ctx C = C0; { int t_ = C0.wave * 64 + lane_id_opaque(); asm volatile("" : "+v"(t_)); C.tid = t_; C.lane = t_ & 63; C.wave = __builtin_amdgcn_readfirstlane(t_ >> 6);
                      int b_ = C0.bid; asm volatile("" : "+s"(b_)); C.bid = b_; int g_ = C0.G; asm volatile("" : "+s"(g_)); C.G = g_; GAS unsigned char* w_ = C0.ws; asm volatile("" : "+s"(w_)); C.ws = w_;
                      const CAS fptr_t* i_ = C0.in; asm volatile("" : "+s"(i_)); C.in = i_;
                      LAS unsigned char* l_ = C0.lds; asm volatile("" : "+s"(l_)); C.lds = l_; }
        LAS unsigned char* const ldsl = C.lds;
        const float* modl = WSP(const float, WS_MODS) + (size_t)l * 9 * 6144;
        if ((EN & 2) && IN(p0 + 0)) { CPH(CP); phase_l1(CP, l); SEAM(p0 + 0); }
        if ((EN & 4) && IN(p0 + 1)) {
            { pg8::SchedDense S; S.init(NTOK / 256, NHG / 256, C.G, C.bid, D, D);
              EpiHG E{WSP(bf16_t, WS_PHG), WSP(const float, WS_LOWER) + l * 512};
              pg8::gemm_phase<false>(ldsl, S, E, (const char*)WSP(bf16_t, WS_R1), (const char*)(WSP(bf16_t, WS_WIN) + (size_t)NHY * D), D, D, 128u * D * 2u, 128u * D * 2u, D / 64, FRESH_TID); }
            { const int nhg = (NTOK / 256) * (NHG / 256), rem = nhg % C.G, nfree = rem ? C.G - rem : 0;
              if (nfree && C.bid >= rem) { pg8::SchedDense S; S.init(NHY / 256, NTOK / 256, C.G, C.bid, D, D); S.range(C.bid - rem, 1 << 20, nfree);
                EpiHY E{WSP(bf16_t, WS_PHYT)};
                pg8::gemm_phase<false>(ldsl, S, E, (const char*)WSP(bf16_t, WS_WIN), (const char*)WSP(bf16_t, WS_R1), D, D, 128u * D * 2u, 128u * D * 2u, D / 64, FRESH_TID); } }
            SEAM(p0 + 1);
        }
        if ((EN & 8) && IN(p0 + 2)) {
            const int nhg = (NTOK / 256) * (NHG / 256), rem = nhg % C.G, nfree = rem ? C.G - rem : 0, nhy = (NHY / 256) * (NTOK / 256);
            unsigned* hyd = WSP(unsigned, WS_CTL) + CW_HYD + l * 64 + C.rep * 16;
            if (C.bid >= 64) {
                pg8::SchedDense S; S.init(NHY / 256, NTOK / 256, C.G, C.bid, D, D); S.range((nfree < nhy ? nfree : nhy) + (C.bid - 64), C.G - 64, nhy);
                EpiHY E{WSP(bf16_t, WS_PHYT)};
                pg8::gemm_phase<false>(ldsl, S, E, (const char*)WSP(bf16_t, WS_WIN), (const char*)WSP(bf16_t, WS_R1), D, D, 128u * D * 2u, 128u * D * 2u, D / 64, FRESH_TID);
                asm volatile("s_waitcnt vmcnt(0)" ::: "memory");
                __syncthreads();
                if (C.wave * 64 + lane_id_opaque() == 0) { __builtin_amdgcn_fence(__ATOMIC_RELEASE, "agent"); asm volatile("s_waitcnt vmcnt(0)" ::: "memory");
                    __hip_atomic_fetch_add(hyd, 1u, __ATOMIC_RELAXED, __HIP_MEMORY_SCOPE_AGENT); }
            }
            { CPH(CP); phase_l3(CP, l, hyd); }
            SEAM(p0 + 2);
        }
        if ((EN & 16) && IN(p0 + 3)) { CPH(CP); phase_l3b(CP, l); SEAM(p0 + 3); }
        if ((EN & 32) && IN(p0 + 4)) {
            pg8::SchedDense S; S.init(NTOK / 256, D / 256, C.G, C.bid, D, D);
            EpiOut E{GIN(IN_X), GIN(IN_CTX), WSP(float, WS_XBUF), modl, l == 0 ? 1 : 0, C.dry};
            pg8::gemm_phase<false>(ldsl, S, E, (const char*)WSP(bf16_t, WS_R1), (const char*)WSP(bf16_t, WS_WOUT), D, D, 128u * D * 2u, 128u * D * 2u, D / 64, FRESH_TID);
            SEAM(p0 + 4);
        }
        if ((EN & 64) && IN(p0 + 5)) { CPH(CP); phase_l5a(CP, l); SEAM(p0 + 5); }
        if ((EN & 128) && IN(p0 + 6)) { CPH(CP); phase_l5b(CP, l); SEAM(p0 + 6); }
        if ((EN & 256) && IN(p0 + 7)) {
            { CPH(CP); build_tiletab(CP, l); }
            const volatile LAS int* lc = (const volatile LAS int*)(ldsl + LDSCTL_OFF);
            const int n6 = 4 * lc[LC_T];
            unsigned* cnt6 = WSP(unsigned, WS_CTL) + CW_T6 + l * 96 * 64;
#pragma unroll 1
            for (int idx = C.bid; idx < n6; idx += C.G) {
                SchedUp1 S{idx, lc + LC_TILEBIN};
                EpiAct E{WSP(bf16_t, WS_R1), WSP(const float, WS_ROWW)};
                pg8::gemm_phase<false>(ldsl, S, E, (const char*)WSP(bf16_t, WS_PHG), (const char*)WSP(bf16_t, WS_WG), D, D, 128u * D * 2u, (unsigned)(WS_WU - WS_WG), D / 64, FRESH_TID);
                asm volatile("s_waitcnt vmcnt(0)" ::: "memory");
                __syncthreads();
                if (C.wave * 64 + lane_id_opaque() == 0) {
                    __hip_atomic_fetch_add(cnt6 + (idx >> 2) * 64, 1u, __ATOMIC_RELAXED, __HIP_MEMORY_SCOPE_AGENT); }
            }
            int nb2 = n6 - C.G; nb2 = nb2 < 0 ? 0 : (nb2 > C.G - 64 ? C.G - 64 : nb2);
            const int nw = C.G - nb2;
            if (C.bid >= nb2) {
#pragma unroll 1
                for (int j = C.bid - nb2; j < n6; j += nw) {
                    if (C.wave * 64 + lane_id_opaque() == 0) { unsigned* cw = cnt6 + (j >> 2) * 64; unsigned sp = 0;
                        while (__hip_atomic_load(cw, __ATOMIC_RELAXED, __HIP_MEMORY_SCOPE_AGENT) < 4u) { __builtin_amdgcn_s_sleep(2); if (++sp > (1u << 22)) break; }
                        __builtin_amdgcn_fence(__ATOMIC_ACQUIRE, "agent"); asm volatile("s_waitcnt vmcnt(0)" ::: "memory"); }
                    __syncthreads();
                    SchedDown1 S{j, lc + LC_TILEBIN};
                    EpiDown E{WSP(float, WS_XBUF), WSP(const int, WS_ROWTOK), modl, C.dry};
                    pg8::gemm_phase<true>(ldsl, S, E, (const char*)WSP(bf16_t, WS_R1), (const char*)WSP(bf16_t, WS_WD), 512, 256, 128u * 512u * 2u, 128u * 256u * 2u, 4, FRESH_TID);
                }
            }
            SEAM(p0 + 7);
        }
    }
    if ((EN & 1024) && IN(N_PHASES - 1)) { Ctx CF = C0; CF.tid = C0.wave * 64 + lane_id_opaque(); CF.lane = CF.tid & 63; phase_final(CF); }
#undef IN
#undef SEAM
}

extern "C" void kernel_launch(void* const* d_in, const int* in_sizes, int n_in, void* d_out, int out_size, void* d_ws, size_t ws_size, hipStream_t stream) {
    static int grid = 0;
    if (grid == 0) {
        if (n_in != N_IN || in_sizes[0] != NLAT * D || out_size != NLAT * D || ws_size < WS_END) { fprintf(stderr, "kernel_launch: unexpected shapes / workspace (%d inputs, ws %zu < %zu)\n", n_in, ws_size, (size_t)WS_END); grid = -1; return; }
        int dev = 0, cus = 0, per_cu = 0;
        if (hipGetDevice(&dev) != hipSuccess || hipDeviceGetAttribute(&cus, hipDeviceAttributeMultiprocessorCount, dev) != hipSuccess) { grid = -1; return; }
        if (hipFuncSetAttribute((const void*)trunk_fwd, hipFuncAttributeMaxDynamicSharedMemorySize, LDS_BYTES) != hipSuccess) { fprintf(stderr, "kernel_launch: hipFuncSetAttribute failed\n"); grid = -1; return; }
        if (hipOccupancyMaxActiveBlocksPerMultiprocessor(&per_cu, (const void*)trunk_fwd, NTHR, LDS_BYTES) != hipSuccess || per_cu < 1) { fprintf(stderr, "kernel_launch: occupancy query says %d\n", per_cu); }
        (void)hipGetLastError();
        grid = cus;
    }
    if (grid < 0) return;
    (void)hipMemsetAsync((char*)d_ws + WS_CTL, 0, CTL_ZERO_BYTES, stream);
    Args a{};
    for (int i = 0; i < N_IN; ++i) a.in[i] = (const float*)d_in[i];
    a.out = (float*)d_out; a.ws = (unsigned char*)d_ws;
#if MK_PER_PHASE
    for (int p = 0; p < N_PHASES; ++p) { a.ph_lo = p; a.ph_hi = p + 1; const int kind = p == 0 ? 0 : (p == 1 ? 11 : (p == N_PHASES - 1 ? 10 : 1 + (p - 2) % PH_PER_LAYER));
        const int nrep = ((PROBE_HOST >> kind) & 1) ? 2 : 1; a.pad = nrep | (PROBE_SKIP << 8);
        for (int rep = 0; rep < nrep; ++rep) { a.rep = rep; hipLaunchKernelGGL(trunk_fwd, dim3(grid), dim3(NTHR), LDS_BYTES, stream, a); } }
#else
    a.ph_lo = 0; a.ph_hi = N_PHASES; a.rep = 0; a.pad = 1;
    hipLaunchKernelGGL(trunk_fwd, dim3(grid), dim3(NTHR), LDS_BYTES, stream, a);
#endif
}
```

```cpp
#include <hip/hip_runtime.h>
#include <cstdio>
#include <cstdint>

#ifndef PROBE_HOST
#define PROBE_HOST 0
#endif
#ifndef PROBE_SKIP
#define PROBE_SKIP 1
#endif
#ifndef MK_PER_PHASE
#define MK_PER_PHASE 0
#endif

#define LAS __attribute__((address_space(3)))
#define GAS __attribute__((address_space(1)))
typedef unsigned short bf16_t;
typedef short bf16x8 __attribute__((ext_vector_type(8)));
typedef float f32x4 __attribute__((ext_vector_type(4)));
typedef float f32x2 __attribute__((ext_vector_type(2)));
typedef unsigned u32x4 __attribute__((ext_vector_type(4)));
typedef unsigned u32x2 __attribute__((ext_vector_type(2)));

constexpr int NB = 8, SEQ = 2048, D = 1024, DEPTH = 4, CTXL = 256;
constexpr int NLAT = NB * SEQ, NCTX = NB * CTXL, NTOK = NLAT + NCTX;
constexpr int DH = 512, NHY = 1536, NHG = 2560, DIN = 4096;
constexpr int NE = 16, DE = 256, NBIN = 24, SROWS = 24576;
constexpr float EPS = 1e-6f;
constexpr int NTHR = 512, NWAVES = 8;
enum { IN_X = 0, IN_C, IN_CTX, IN_CCTX, IN_WMOD, IN_BMOD, IN_WIN, IN_WOUT, IN_CONVW, IN_CONVB, IN_W1, IN_B1, IN_W2, IN_B2, IN_W3, IN_B3,
       IN_HYBIAS, IN_LB, IN_NORMW, IN_RW, IN_RB, IN_WG, IN_WU, IN_WD, IN_FNW, N_IN };

constexpr size_t MiB = 1u << 20;
constexpr size_t WS_CTL = 0, CTL_ZERO_BYTES = 1 * MiB;
constexpr size_t WS_MODS = 1 * MiB;
constexpr size_t WS_LOWER = 2 * MiB;
constexpr size_t WS_BIAS2 = 2 * MiB + 64 * 1024;
constexpr size_t WS_HPAD = 3 * MiB;
constexpr size_t WS_TOKINFO = 6 * MiB;
constexpr size_t WS_BLKBASE = 6 * MiB + 320 * 1024;
constexpr size_t WS_ROWTOK = 6 * MiB + 512 * 1024;
constexpr size_t WS_ROWW = 7 * MiB;
constexpr size_t WS_WIN = 8 * MiB;
constexpr size_t WS_WOUT = 16 * MiB;
constexpr size_t WS_WG = 18 * MiB;
constexpr size_t WS_WU = 26 * MiB;
constexpr size_t WS_WD = 34 * MiB;
constexpr size_t WS_KSPEC = 42 * MiB;
constexpr size_t WS_XBUF = 74 * MiB;
constexpr size_t WS_R1 = 146 * MiB;
constexpr size_t WS_PHG = 182 * MiB;
constexpr size_t WS_PHYT = 272 * MiB;
constexpr size_t WS_ODIR = 326 * MiB;
constexpr size_t WS_KSPC = 362 * MiB;
constexpr size_t WS_W3T = 378 * MiB;
constexpr size_t WS_HF = 380 * MiB;
constexpr size_t WS_END = 416 * MiB;
constexpr int CW_BAR = 4096;
constexpr int CW_CNT = 16384;
constexpr int CW_T6 = 65536;
constexpr int CW_HYD = 40960;
constexpr int CW_Q = 32768;

constexpr int LDS_BYTES = 147456;
constexpr int LDSCTL_OFF = 143 * 1024;
constexpr int LC_BAR = 0;
constexpr int LC_T = 8;
constexpr int LC_Q = 9;
constexpr int LC_OFFS = 16;
constexpr int LC_TILEBIN = 48;

__device__ __forceinline__ unsigned f2bf(float f) { return (unsigned)__builtin_bit_cast(unsigned short, (__bf16)f); }
typedef __bf16 bf16x2v __attribute__((ext_vector_type(2)));
__device__ __forceinline__ unsigned pk2(float lo, float hi) { const f32x2 v = {lo, hi}; return __builtin_bit_cast(unsigned, __builtin_convertvector(v, bf16x2v)); }
__device__ __forceinline__ float bf2f(unsigned b) { return __builtin_bit_cast(float, (b & 0xffffu) << 16); }
__device__ __forceinline__ float bflo(unsigned w) { return __builtin_bit_cast(float, w << 16); }
__device__ __forceinline__ float bfhi(unsigned w) { return __builtin_bit_cast(float, w & 0xffff0000u); }
__device__ __forceinline__ float sigmoidf_(float x) { return __builtin_amdgcn_rcpf(1.0f + __expf(-x)); }
__device__ __forceinline__ float siluf_(float x) { return x * __builtin_amdgcn_rcpf(1.0f + __expf(-x)); }
#define DPP_ADD(v, ctrl, rmask) v += __builtin_bit_cast(float, __builtin_amdgcn_update_dpp(0, __builtin_bit_cast(int, v), ctrl, rmask, 0xF, false))
__device__ __forceinline__ float row16_sum(float v) {
    DPP_ADD(v, 0xB1, 0xF);
    DPP_ADD(v, 0x4E, 0xF);
    DPP_ADD(v, 0x141, 0xF);
    DPP_ADD(v, 0x140, 0xF);
    return v;
}
__device__ __forceinline__ float wave_sum(float v) {
    v = row16_sum(v);
    DPP_ADD(v, 0x142, 0xA);
    DPP_ADD(v, 0x143, 0xC);
    return __builtin_bit_cast(float, __builtin_amdgcn_readlane(__builtin_bit_cast(int, v), 63));
}
__device__ __forceinline__ int lane_id_opaque() { int x; asm volatile("v_mbcnt_lo_u32_b32 %0, -1, 0\n\tv_mbcnt_hi_u32_b32 %0, -1, %0" : "=v"(x)); return x; }
__device__ __forceinline__ int bidx(int row) { return row < NLAT ? (row >> 11) : 8; }
#define LDS_WAIT() asm volatile("s_waitcnt lgkmcnt(0)" ::: "memory")

#define XB_TMO      128
#define XB_XCNT(j)  (256  + 64 * (j))
#define XB_XSUB(j)  (1280 + 64 * (j))
#define XB_XGEN(j)  (2304 + 64 * (j))
#define XB_TOP      3328
#define XB_TOPGEN   3392
#define XCD_BAR_WORDS 3456
#define XB_SPIN_CAP (1u << 18)
__device__ __forceinline__ unsigned xb_ld(unsigned* p)              { return __hip_atomic_load(p, __ATOMIC_RELAXED, __HIP_MEMORY_SCOPE_AGENT); }
__device__ __forceinline__ unsigned xb_add(unsigned* p, unsigned v) { return __hip_atomic_fetch_add(p, v, __ATOMIC_RELAXED, __HIP_MEMORY_SCOPE_AGENT); }
__device__ __forceinline__ unsigned xb_xcc_id() { return (unsigned)__builtin_amdgcn_s_getreg((3 << 11) | 20) & 0xFu; }
#define XB_SPIN(cond, bar) do { unsigned _sp = 0; while (cond) { __builtin_amdgcn_s_sleep(1); \
    if ((++_sp & 255u) == 0u) { if (xb_ld(&(bar)[XB_TMO])) break; if (_sp > XB_SPIN_CAP) { atomicAdd(&(bar)[XB_TMO], 1u); break; } } } } while (0)
struct XcdBarrier { unsigned* bar; unsigned x; volatile LAS unsigned* st; };
__device__ __forceinline__ XcdBarrier xcd_barrier_post(unsigned* bar, volatile LAS unsigned* st) {
    XcdBarrier b; b.bar = bar; b.x = xb_xcc_id(); b.st = st;
    if (threadIdx.x == 0) (void)xb_add(&bar[XB_XCNT(b.x)], 1u);
    return b;
}
__device__ __forceinline__ void xcd_barrier_complete(unsigned* bar, unsigned x, unsigned& nloc, unsigned& nx) {
    const unsigned G = gridDim.x * gridDim.y * gridDim.z;
    unsigned sum, cnt, mine, sp = 0u;
    for (;;) {
        sum = 0u; cnt = 0u; mine = 0u;
#pragma unroll
        for (unsigned j = 0; j < 16; ++j) { const unsigned c = xb_ld(&bar[XB_XCNT(j)]); sum += c; cnt += (c > 0u) ? 1u : 0u; mine = (j == x) ? c : mine; }
        if (sum == G) break;
        __builtin_amdgcn_s_sleep(1);
        if ((++sp & 255u) == 0u) { if (xb_ld(&bar[XB_TMO])) break; if (sp > XB_SPIN_CAP) { atomicAdd(&bar[XB_TMO], 1u); break; } }
    }
    nloc = mine > 0u ? mine : 1u; nx = cnt > 0u ? cnt : 1u;
}
__device__ __forceinline__ void xcd_barrier(const XcdBarrier& b, const int tid0) {
    asm volatile("s_waitcnt vmcnt(0)" ::: "memory");
    __syncthreads();
    if (tid0 == 0) {
        unsigned bx = b.x; unsigned blo_ = __builtin_amdgcn_readfirstlane((unsigned)(unsigned long long)b.bar), bhi_ = __builtin_amdgcn_readfirstlane((unsigned)((unsigned long long)b.bar >> 32));
        asm volatile("" : "+s"(blo_), "+s"(bhi_), "+s"(bx));
        unsigned* bar = (unsigned*)(((unsigned long long)bhi_ << 32) | blo_);
        __builtin_amdgcn_s_waitcnt(0);
        unsigned nloc = b.st[0], nx = b.st[1];
        if (nloc == 0u) { xcd_barrier_complete(bar, bx, nloc, nx); b.st[0] = nloc; b.st[1] = nx; }
        const unsigned old = xb_add(&bar[XB_XSUB(bx)], 1u);
        const unsigned gen = old / nloc;
        if (old + 1u == (gen + 1u) * nloc) {
            __builtin_amdgcn_fence(__ATOMIC_RELEASE, "agent");
            asm volatile("s_waitcnt vmcnt(0)" ::: "memory");
            const unsigned og = xb_add(&bar[XB_TOP], 1u);
            const unsigned tg = og / nx;
            if (og + 1u == (tg + 1u) * nx) xb_add(&bar[XB_TOPGEN], 1u);
            else XB_SPIN(xb_ld(&bar[XB_TOPGEN]) == tg, bar);
            __builtin_amdgcn_fence(__ATOMIC_ACQUIRE, "agent");
            xb_add(&bar[XB_XGEN(bx)], 1u);
            asm volatile("s_waitcnt vmcnt(0)" ::: "memory");
        } else {
            XB_SPIN(xb_ld(&bar[XB_XGEN(bx)]) == gen, bar);
            __builtin_amdgcn_fence(__ATOMIC_ACQUIRE, "agent");
            asm volatile("s_waitcnt vmcnt(0)" ::: "memory");
        }
    }
    __syncthreads();
}

namespace pg8 {
constexpr int BM = 256, BK = 64, HALF = 128, HTB = HALF * BK * 2, STAGE_BYTES = 8 * HTB, NXCD = 8, WGM = 8;
__host__ __device__ __forceinline__ int lds_byte(int r, int c) { const int st = (r >> 4) * 2 + (c >> 5), rr = r & 15, cc = c & 31, ob = rr * 64 + cc * 2; return st * 1024 + (ob ^ (((ob >> 9) & 1) << 5)); }
__host__ __device__ __forceinline__ void stage_rc(int b, int& R, int& C) { const int st = b / 1024, sb = b % 1024, swz = sb ^ (((sb >> 9) & 1) << 5); R = (st >> 1) * 16 + swz / 64; C = (st & 1) * 32 + (swz % 64) / 2; }
__host__ __device__ __forceinline__ int perm32(int rho) { const int n = rho >> 4, i = rho & 15; return 8 * (i >> 2) + 4 * n + (i & 3); }

struct GUnit { unsigned a, b; int last, i0, i1; };

template <bool SUB, class Epi, class Sched>
__device__ __forceinline__ void gemm_phase(LAS unsigned char* lds, const Sched& S, const Epi& E, const char* Abase, const char* Bbase, const int lda, const int ldb, const unsigned ahalf, const unsigned bhalf, const int nt, const int tid_in) {
    int tid_ = tid_in; asm volatile("" : "+v"(tid_));
    const int tid = tid_, wid = __builtin_amdgcn_readfirstlane(tid >> 6), lane = tid & 63, wr = wid >> 2, wc = wid & 3, fr = lane & 15, fq = lane >> 4;
    unsigned voffA[2], voffB[2];
#pragma unroll
    for (int i = 0; i < 2; ++i) { int R, C; stage_rc(tid * 16 + i * 8192, R, C); const int Rb = Epi::PERM ? ((R & ~31) + perm32(R & 31)) : R;
        voffA[i] = (unsigned)(R * lda + C) * 2u; voffB[i] = (unsigned)(Rb * ldb + C) * 2u; }
    constexpr unsigned kstep = BK * 2;
    const unsigned ldsw = (unsigned)wid * 1024u;
    const int aoff = lds_byte(wr * 64 + fr, fq * 8), boff = lds_byte(wc * 32 + fr, fq * 8);
#define PG8_SA(b, h) (((b) * 2 + (h)) * HTB)
#define PG8_SB(b, h) ((4 + (b) * 2 + (h)) * HTB)
#define PG8_STAGE(bufoff, gbase, voff) do { _Pragma("unroll") for (int _i = 0; _i < 2; ++_i) \
        __builtin_amdgcn_global_load_lds((const unsigned*)((const char*)(gbase) + (voff)[_i]), (LAS unsigned*)(lds + (bufoff) + ldsw + _i * 8192), 16, 0, 0); } while (0)
#define PG8_LDA(dst, b, h) do { _Pragma("unroll") for (int m = 0; m < 4; ++m) _Pragma("unroll") for (int k = 0; k < 2; ++k) dst[m][k] = *(const LAS bf16x8*)(lds + PG8_SA(b, h) + aoff + m * 2048 + k * 1024); } while (0)
#define PG8_LDB(dst, b, h) do { _Pragma("unroll") for (int n = 0; n < 2; ++n) _Pragma("unroll") for (int k = 0; k < 2; ++k) dst[n][k] = *(const LAS bf16x8*)(lds + PG8_SB(b, h) + boff + n * 2048 + k * 1024); } while (0)
#define PG8_MMA(ai, bj, At, Bt) do { __builtin_amdgcn_s_setprio(1); _Pragma("unroll") for (int m = 0; m < 4; ++m) _Pragma("unroll") for (int n = 0; n < 2; ++n) _Pragma("unroll") for (int k = 0; k < 2; ++k) \
        acc[ai][bj][m][n] = __builtin_amdgcn_mfma_f32_16x16x32_bf16(Bt[n][k], At[m][k], acc[ai][bj][m][n], 0, 0, 0); __builtin_amdgcn_s_setprio(0); } while (0)
#define PG8_WAIT_V(n) asm volatile("s_waitcnt vmcnt(" #n ")" ::: "memory")
#define PG8_WAIT_L(n) asm volatile("s_waitcnt lgkmcnt(" #n ")" ::: "memory")
#define PG8_BAR __builtin_amdgcn_s_barrier()
#define PG8_SCHED __builtin_amdgcn_sched_barrier(0)
    GUnit cur, nxt; int ui = 0;
    if (!S.next(0, cur)) return;
    f32x4 acc[2][2][4][2];
    float zf_ = 0.f; asm volatile("" : "+v"(zf_));
#pragma unroll
    for (int a = 0; a < 2; ++a)
#pragma unroll
        for (int b = 0; b < 2; ++b)
#pragma unroll
            for (int m = 0; m < 4; ++m)
#pragma unroll
                for (int n = 0; n < 2; ++n) acc[a][b][m][n] = (f32x4){zf_, zf_, zf_, zf_};
    bf16x8 At[4][2], B0[2][2], B1[2][2];
    { const char* cA = Abase + cur.a; const char* cB = Bbase + cur.b;
      PG8_STAGE(PG8_SB(0, 0), cB, voffB); PG8_STAGE(PG8_SB(0, 1), cB + bhalf, voffB); PG8_STAGE(PG8_SA(0, 0), cA, voffA); PG8_STAGE(PG8_SA(0, 1), cA + ahalf, voffA);
      if (wr == 1) PG8_BAR;
      PG8_WAIT_V(2); PG8_BAR;
      PG8_STAGE(PG8_SB(1, 0), cB + kstep, voffB); PG8_STAGE(PG8_SA(1, 0), cA + kstep, voffA); PG8_STAGE(PG8_SB(1, 1), cB + bhalf + kstep, voffB);
      PG8_WAIT_V(6); PG8_BAR; }
    for (;;) {
        const bool has_next = S.next(ui + 1, nxt);
        const char* cA = Abase + cur.a; const char* cB = Bbase + cur.b;
        const char* nA = Abase + (has_next ? nxt.a : cur.a); const char* nB = Bbase + (has_next ? nxt.b : cur.b);
        for (int t = 0; t < nt; t += 2) {
            const bool last = (t == nt - 2);
            const char* a1 = cA + (unsigned)(t + 1) * kstep;
            const char* a2 = last ? nA : cA + (unsigned)(t + 2) * kstep; const char* b2 = last ? nB : cB + (unsigned)(t + 2) * kstep;
            const char* a3 = a2 + kstep; const char* b3 = b2 + kstep;
            PG8_LDB(B0, 0, 0); PG8_LDB(B1, 0, 1); PG8_SCHED; PG8_LDA(At, 0, 0); PG8_STAGE(PG8_SA(1, 1), a1 + ahalf, voffA);
            PG8_WAIT_V(8); PG8_WAIT_L(0); PG8_BAR; PG8_MMA(0, 0, At, B0); PG8_MMA(0, 1, At, B1); PG8_BAR; PG8_SCHED;
            PG8_LDA(At, 0, 1); PG8_STAGE(PG8_SB(0, 0), b2, voffB); PG8_STAGE(PG8_SB(0, 1), b2 + bhalf, voffB); PG8_STAGE(PG8_SA(0, 0), a2, voffA);
            PG8_WAIT_V(8); PG8_WAIT_L(0); PG8_BAR; PG8_MMA(1, 0, At, B0); PG8_MMA(1, 1, At, B1); PG8_BAR; PG8_SCHED;
            PG8_LDB(B0, 1, 0); PG8_LDB(B1, 1, 1); PG8_SCHED; PG8_LDA(At, 1, 0); PG8_STAGE(PG8_SA(0, 1), a2 + ahalf, voffA);
            PG8_WAIT_V(8); PG8_WAIT_L(0); PG8_BAR; PG8_MMA(0, 0, At, B0); PG8_MMA(0, 1, At, B1); PG8_BAR; PG8_SCHED;
            PG8_LDA(At, 1, 1); PG8_STAGE(PG8_SB(1, 0), b3, voffB); PG8_STAGE(PG8_SB(1, 1), b3 + bhalf, voffB); PG8_STAGE(PG8_SA(1, 0), a3, voffA);
            PG8_WAIT_V(8); PG8_WAIT_L(0); PG8_BAR; PG8_MMA(1, 0, At, B0); PG8_MMA(1, 1, At, B1); PG8_BAR; PG8_SCHED;
        }
        const bool fin = SUB ? (cur.last != 0) : true;
        if (fin) { if (wr == 0) PG8_BAR; E(acc, cur, wr, wc, fr, fq); }
        if (!has_next) break;
        if (fin) {
#pragma unroll
            for (int a = 0; a < 2; ++a)
#pragma unroll
                for (int b = 0; b < 2; ++b)
#pragma unroll
                    for (int m = 0; m < 4; ++m)
#pragma unroll
                        for (int n = 0; n < 2; ++n) acc[a][b][m][n] = (f32x4){zf_, zf_, zf_, zf_};
        }
        cur = nxt; ++ui;
        if (fin) { if (wr == 1) PG8_BAR; }
    }
    PG8_WAIT_V(0);
    PG8_BAR;
#undef PG8_SA
#undef PG8_SB
#undef PG8_STAGE
#undef PG8_LDA
#undef PG8_LDB
#undef PG8_MMA
#undef PG8_WAIT_V
#undef PG8_WAIT_L
#undef PG8_BAR
#undef PG8_SCHED
}

struct SchedDense {
    int nM, nN, nwg, G, c, lend; unsigned atile, btile;
    __device__ __forceinline__ void init(int nM_, int nN_, int G_, int c_, int lda, int ldb) {
        nM = nM_; nN = nN_; nwg = nM * nN; G = G_; c = c_; lend = nwg; atile = 256u * lda * 2u; btile = 256u * ldb * 2u; }
    __device__ __forceinline__ void range(int first, int stride, int end) { c = first; G = stride; lend = end < nwg ? end : nwg; }
    __device__ __forceinline__ bool next(int i, GUnit& u) const {
        const int L = i * G + c; if (L >= lend) return false;
        int wgid = L; { const int q = nwg / NXCD, r = nwg % NXCD, xcd = wgid % NXCD, off = wgid / NXCD; wgid = (xcd < r ? xcd * (q + 1) : r * (q + 1) + (xcd - r) * q) + off; }
        const int nig = WGM * nN, gid = wgid / nig, fm = gid * WGM, gsz = (nM - fm) < WGM ? (nM - fm) : WGM;
        const int pm = fm + ((wgid % nig) % gsz), pn = (wgid % nig) / gsz;
        u.a = (unsigned)pm * atile; u.b = (unsigned)pn * btile; u.last = 1; u.i0 = pm; u.i1 = pn; return true;
    }
};
}

struct Args { const float* in[N_IN]; float* out; unsigned char* ws; int ph_lo, ph_hi, rep, pad; };
static_assert(sizeof(Args) == N_IN * 8 + 8 + 8 + 16, "Args has no padding");

#define CAS __attribute__((address_space(4)))
typedef const float* fptr_t;
struct Ctx {
    const CAS fptr_t* in; float* out; GAS unsigned char* ws; LAS unsigned char* lds; int tid, lane, wave, G, bid, rep, dry;
};
#define WSP(T, off) ((T*)(GAS T*)(C.ws + (off)))
#define GIN(k) ((const float*)(const GAS float*)C.in[k])

__device__ __forceinline__ void build_tiletab(const Ctx& C, int l) {
    volatile LAS int* lc = (volatile LAS int*)(C.lds + LDSCTL_OFF);
    __syncthreads();
    if (C.tid == 0) {
        const unsigned* cnt = WSP(const unsigned, WS_CTL) + CW_CNT + l * 32 * 64;
        int off = 0, t = 0;
        for (int b = 0; b < NBIN; ++b) {
            const int n = (int)__hip_atomic_load(cnt + b * 64, __ATOMIC_RELAXED, __HIP_MEMORY_SCOPE_AGENT);
            lc[LC_OFFS + b] = off;
            const int nt = (n + 255) >> 8;
            for (int k = 0; k < nt; ++k) lc[LC_TILEBIN + t + k] = b;
            t += nt; off += nt * 256;
        }
        lc[LC_OFFS + NBIN] = off; lc[LC_T] = t;
    }
    __syncthreads();
}
__device__ __forceinline__ int expert_of(int bin, int es) {
    const int g = bin / 6, p = bin - g * 6;
    const int lo = p < 3 ? 0 : (p < 5 ? 1 : 2), hi = p < 3 ? p + 1 : (p < 5 ? p - 1 : 3);
    return 4 * g + (es ? hi : lo);
}

struct SchedUp {
    int T, G, c; const volatile LAS int* tilebin;
    __device__ __forceinline__ bool next(int i, pg8::GUnit& u) const {
        const int idx = i * G + c; if (idx >= 4 * T) return false;
        const int rt = idx >> 2, q = idx & 3, es = q >> 1, fb = q & 1;
        const int bin = __builtin_amdgcn_readfirstlane(tilebin[rt]);
        const int e = expert_of(bin, es);
        u.a = (unsigned)rt * 256u * 2048u; u.b = (unsigned)(e * 256 + fb * 128) * 2048u;
        u.last = 1; u.i0 = rt; u.i1 = q; return true;
    }
};
struct SchedDown {
    int T, G, c; const volatile LAS int* tilebin;
    __device__ __forceinline__ bool next(int i, pg8::GUnit& u) const {
        const int idx = (i >> 1) * G + c, sub = i & 1; if (idx >= 4 * T) return false;
        const int rt = idx >> 2, pn = idx & 3;
        const int bin = __builtin_amdgcn_readfirstlane(tilebin[rt]);
        const int e = expert_of(bin, sub);
        u.a = (unsigned)rt * 256u * 1024u + (unsigned)sub * 512u; u.b = (unsigned)(e * 1024 + pn * 256) * 512u;
        u.last = sub; u.i0 = rt; u.i1 = pn; return true;
    }
};

struct SchedUp1 {
    int idx; const volatile LAS int* tilebin;
    __device__ __forceinline__ bool next(int i, pg8::GUnit& u) const {
        if (i != 0) return false;
        const int rt = idx >> 2, q = idx & 3, es = q >> 1, fb = q & 1;
        const int bin = __builtin_amdgcn_readfirstlane(tilebin[rt]);
        const int e = expert_of(bin, es);
        u.a = (unsigned)rt * 256u * 2048u; u.b = (unsigned)(e * 256 + fb * 128) * 2048u;
        u.last = 1; u.i0 = rt; u.i1 = q; return true;
    }
};
struct SchedDown1 {
    int idx; const volatile LAS int* tilebin;
    __device__ __forceinline__ bool next(int i, pg8::GUnit& u) const {
        if (i > 1) return false;
        const int sub = i, rt = idx >> 2, pn = idx & 3;
        const int bin = __builtin_amdgcn_readfirstlane(tilebin[rt]);
        const int e = expert_of(bin, sub);
        u.a = (unsigned)rt * 256u * 1024u + (unsigned)sub * 512u; u.b = (unsigned)(e * 1024 + pn * 256) * 512u;
        u.last = sub; u.i0 = rt; u.i1 = pn; return true;
    }
};

struct EpiHG {
    static constexpr bool PERM = true;
    bf16_t* O; const float* lower;
    __device__ __forceinline__ void operator()(const f32x4 (&acc)[2][2][4][2], const pg8::GUnit& u, int wr, int wc, int fr, int fq) const {
        const int kind = u.i1 >> 1;
        const int row0 = u.i0 * 256 + wr * 64 + fr, colt = u.i1 * 256 + wc * 32 + 8 * fq;
#pragma unroll
        for (int bj = 0; bj < 2; ++bj) {
            const int col = colt + bj * 128;
            float om[8];
#pragma unroll
            for (int j = 0; j < 8; ++j) om[j] = 1.f;
            if (kind >= 3) { const float* lb = lower + (kind - 3) * 2048 + (col & 511);
#pragma unroll
                for (int j = 0; j < 8; ++j) om[j] = 1.f - lb[j]; }
#pragma unroll
            for (int ai = 0; ai < 2; ++ai)
#pragma unroll
                for (int m = 0; m < 4; ++m) {
                    float v[8];
#pragma unroll
                    for (int j = 0; j < 8; ++j) v[j] = acc[ai][bj][m][j >> 2][j & 3];
                    if (kind == 0) {
#pragma unroll
                        for (int j = 0; j < 8; ++j) v[j] = siluf_(v[j]);
                    } else if (kind >= 3) {
#pragma unroll
                        for (int j = 0; j < 8; ++j) v[j] = om[j] * sigmoidf_(-v[j]);
                    }
                    u32x4 w; w.x = pk2(v[0], v[1]); w.y = pk2(v[2], v[3]); w.z = pk2(v[4], v[5]); w.w = pk2(v[6], v[7]);
                    *(u32x4*)(O + (size_t)(row0 + ai * 128 + m * 16) * NHG + col) = w;
                }
        }
    }
};
struct EpiHY {
    static constexpr bool PERM = true;
    bf16_t* O;
    __device__ __forceinline__ void operator()(const f32x4 (&acc)[2][2][4][2], const pg8::GUnit& u, int wr, int wc, int fr, int fq) const {
        const int row0 = u.i0 * 256 + wr * 64 + fr, colt = u.i1 * 256 + wc * 32 + 8 * fq;
#pragma unroll
        for (int ai = 0; ai < 2; ++ai)
#pragma unroll
            for (int m = 0; m < 4; ++m)
#pragma unroll
                for (int bj = 0; bj < 2; ++bj) {
                    const f32x4 v0 = acc[ai][bj][m][0], v1 = acc[ai][bj][m][1];
                    u32x4 w; w.x = pk2(v0[0], v0[1]); w.y = pk2(v0[2], v0[3]); w.z = pk2(v1[0], v1[1]); w.w = pk2(v1[2], v1[3]);
                    *(u32x4*)(O + (size_t)(row0 + ai * 128 + m * 16) * NTOK + colt + bj * 128) = w;
                }
    }
};
struct EpiOut {
    static constexpr bool PERM = false;
    const float* xlat; const float* xctx; float* xo; const float* mods; int first; int dry;
    __device__ __forceinline__ void operator()(const f32x4 (&acc)[2][2][4][2], const pg8::GUnit& u, int wr, int wc, int fr, int fq) const {
        const int row0 = u.i0 * 256 + wr * 64 + fr, col0 = u.i1 * 256 + wc * 32 + 4 * fq;
#pragma unroll
        for (int ai = 0; ai < 2; ++ai)
#pragma unroll
            for (int m = 0; m < 4; ++m) {
                const int row = row0 + ai * 128 + m * 16;
                const float* src = first ? (row < NLAT ? xlat + (size_t)row * D : xctx + (size_t)(row - NLAT) * D) : xo + (size_t)row * D;
                const float* g1 = mods + bidx(row) * 6144 + 2048;
#pragma unroll
                for (int bj = 0; bj < 2; ++bj)
#pragma unroll
                    for (int n = 0; n < 2; ++n) { const int col = col0 + bj * 128 + n * 16;
                        const f32x4 xv = *(const f32x4*)(src + col), gv = *(const f32x4*)(g1 + col);
                        if (!dry) *(f32x4*)(xo + (size_t)row * D + col) = xv + gv * acc[ai][bj][m][n]; }
            }
    }
};
struct EpiAct {
    static constexpr bool PERM = true;
    bf16_t* O; const float* roww;
    __device__ __forceinline__ void operator()(const f32x4 (&acc)[2][2][4][2], const pg8::GUnit& u, int wr, int wc, int fr, int fq) const {
        const int es = u.i1 >> 1; const int pos0 = u.i0 * 256 + wr * 64 + fr, col = u.i1 * 128 + wc * 32 + 8 * fq;
        const __amdgpu_buffer_rsrc_t rsrc = __builtin_amdgcn_make_buffer_rsrc(O, 0, SROWS * 512 * 2, 0x00020000);
#pragma unroll
        for (int ai = 0; ai < 2; ++ai)
#pragma unroll
            for (int m = 0; m < 4; ++m) {
                const int pos = pos0 + ai * 128 + m * 16;
                const float wgt = roww[pos * 2 + es];
                float v[8];
#pragma unroll
                for (int j = 0; j < 8; ++j) v[j] = siluf_(acc[ai][0][m][j >> 2][j & 3]) * acc[ai][1][m][j >> 2][j & 3] * wgt;
                u32x4 w; w.x = pk2(v[0], v[1]); w.y = pk2(v[2], v[3]); w.z = pk2(v[4], v[5]); w.w = pk2(v[6], v[7]);
                __builtin_amdgcn_raw_buffer_store_b128(w, rsrc, (unsigned)(pos * 512 + col) * 2u, 0, 16);
            }
    }
};
struct EpiDown {
    static constexpr bool PERM = false;
    float* xo; const int* rowtok; const float* mods; int dry;
    __device__ __forceinline__ void operator()(const f32x4 (&acc)[2][2][4][2], const pg8::GUnit& u, int wr, int wc, int fr, int fq) const {
        const int pos0 = u.i0 * 256 + wr * 64 + fr, col0 = u.i1 * 256 + wc * 32 + 4 * fq;
#pragma unroll
        for (int ai = 0; ai < 2; ++ai)
#pragma unroll
            for (int m = 0; m < 4; ++m) {
                const int tok = rowtok[pos0 + ai * 128 + m * 16];
                if (tok >= 0) {
                    const float* g2 = mods + bidx(tok) * 6144 + 5120;
                    float* xr = xo + (size_t)tok * D;
#pragma unroll
                    for (int bj = 0; bj < 2; ++bj)
#pragma unroll
                        for (int n = 0; n < 2; ++n) { const int col = col0 + bj * 128 + n * 16;
                            const f32x4 xv = *(const f32x4*)(xr + col), gv = *(const f32x4*)(g2 + col);
                            if (!dry) *(f32x4*)(xr + col) = xv + gv * acc[ai][bj][m][n]; }
                }
            }
    }
};

struct SchedFilt {
    int G, c;
    __device__ __forceinline__ bool next(int i, pg8::GUnit& u) const {
        const int idx = i * G + c; if (idx >= 4 * 72) return false;
        const int l = idx / 72, r = idx - l * 72, pm = r / 9, pn = r - pm * 9;
        u.a = (unsigned)(l * 2048 + pm * 256) * 256u; u.b = (unsigned)(l * 2304 + pn * 256) * 256u; u.last = 1; u.i0 = l * 16 + pm; u.i1 = pn; return true;
    }
};
struct EpiFilt {
    static constexpr bool PERM = true;
    bf16_t* HF; const float* b3;
    __device__ __forceinline__ void operator()(const f32x4 (&acc)[2][2][4][2], const pg8::GUnit& u, int wr, int wc, int fr, int fq) const {
        const int l = u.i0 >> 4, pm = u.i0 & 15;
        const int row0 = pm * 256 + wr * 64 + fr, t00 = u.i1 * 256 + wc * 32 + 8 * fq;
#pragma unroll
        for (int ai = 0; ai < 2; ++ai)
#pragma unroll
            for (int m = 0; m < 4; ++m) {
                const int row = row0 + ai * 128 + m * 16, c = row & 511;
                const float delta = fabsf(logf(1e-2f) / 0.3f + (float)c * ((logf(1e-2f) / 1.5f - logf(1e-2f) / 0.3f) / 511.0f));
                const float bias = b3[l * 2048 + row];
#pragma unroll
                for (int bj = 0; bj < 2; ++bj) {
                    const int t0 = t00 + bj * 128;
                    float v[8];
#pragma unroll
                    for (int j = 0; j < 8; ++j) { const int t = t0 + j; const float tn = t < 2048 ? (float)t / 2047.0f : (float)(t - 2048) / 255.0f;
                        v[j] = (acc[ai][bj][m][j >> 2][j & 3] + bias) * expf(-tn * delta); }
                    u32x4 w; w.x = pk2(v[0], v[1]); w.y = pk2(v[2], v[3]); w.z = pk2(v[4], v[5]); w.w = pk2(v[6], v[7]);
                    *(u32x4*)(HF + ((size_t)(l * 2048 + row)) * 2304 + t0) = w;
                }
            }
    }
};

__device__ __forceinline__ int padx(int i) { return i + (i >> 3); }
__device__ __forceinline__ f32x2 cmul(f32x2 a, f32x2 b) { return (f32x2){a.x * b.x - a.y * b.y, a.x * b.y + a.y * b.x}; }
__device__ __forceinline__ f32x2 cmulc(f32x2 a, f32x2 b) { return (f32x2){a.x * b.x + a.y * b.y, a.y * b.x - a.x * b.y}; }
constexpr int XPAD = 2048 + 256;

__device__ __forceinline__ void fft_p1_dif(f32x2 (&v)[8], int tt, const LAS f32x2* T) {
#pragma unroll
    for (int g = 0; g < 2; ++g) { const int u = tt + 256 * g;
#pragma unroll
        for (int j = 0; j < 2; ++j) { const f32x2 a = v[g + 2 * j], b = v[g + 2 * j + 4]; v[g + 2 * j] = a + b; v[g + 2 * j + 4] = cmul(a - b, T[2 * (u + 512 * j)]); }
        const f32x2 tw = T[4 * u];
        { const f32x2 a = v[g], b = v[g + 2]; v[g] = a + b; v[g + 2] = cmul(a - b, tw); }
        { const f32x2 a = v[g + 4], b = v[g + 6]; v[g + 4] = a + b; v[g + 6] = cmul(a - b, tw); } }
}
__device__ __forceinline__ void fft_p1_dit(f32x2 (&v)[8], int tt, const LAS f32x2* T) {
#pragma unroll
    for (int g = 0; g < 2; ++g) { const int u = tt + 256 * g;
        const f32x2 tw = T[4 * u];
        { const f32x2 a = v[g], b = cmulc(v[g + 2], tw); v[g] = a + b; v[g + 2] = a - b; }
        { const f32x2 a = v[g + 4], b = cmulc(v[g + 6], tw); v[g + 4] = a + b; v[g + 6] = a - b; }
#pragma unroll
        for (int j = 0; j < 2; ++j) { const f32x2 a = v[g + 2 * j], b = cmulc(v[g + 2 * j + 4], T[2 * (u + 512 * j)]); v[g + 2 * j] = a + b; v[g + 2 * j + 4] = a - b; } }
}
template <int Q> __device__ __forceinline__ void r8_dif(f32x2 (&e)[8], int r, const LAS f32x2* T) {
    constexpr int S2 = 512 / Q;
#pragma unroll
    for (int j = 0; j < 4; ++j) { const f32x2 a = e[j], b = e[j + 4]; e[j] = a + b; e[j + 4] = cmul(a - b, T[S2 * (r + Q * j)]); }
#pragma unroll
    for (int jj = 0; jj < 4; ++jj) { const int j = (jj & 1) + 4 * (jj >> 1); const f32x2 a = e[j], b = e[j + 2]; e[j] = a + b; e[j + 2] = cmul(a - b, T[2 * S2 * (r + Q * (j & 1))]); }
    const f32x2 tw = T[4 * S2 * r];
#pragma unroll
    for (int j = 0; j < 8; j += 2) { const f32x2 a = e[j], b = e[j + 1]; e[j] = a + b; e[j + 1] = cmul(a - b, tw); }
}
template <int Q> __device__ __forceinline__ void r8_dit(f32x2 (&e)[8], int r, const LAS f32x2* T) {
    constexpr int S2 = 512 / Q;
    const f32x2 tw = T[4 * S2 * r];
#pragma unroll
    for (int j = 0; j < 8; j += 2) { const f32x2 a = e[j], b = cmulc(e[j + 1], tw); e[j] = a + b; e[j + 1] = a - b; }
#pragma unroll
    for (int jj = 0; jj < 4; ++jj) { const int j = (jj & 1) + 4 * (jj >> 1); const f32x2 a = e[j], b = cmulc(e[j + 2], T[2 * S2 * (r + Q * (j & 1))]); e[j] = a + b; e[j + 2] = a - b; }
#pragma unroll
    for (int j = 0; j < 4; ++j) { const f32x2 a = e[j], b = cmulc(e[j + 4], T[S2 * (r + Q * j)]); e[j] = a + b; e[j + 4] = a - b; }
}
template <int Q, bool INV> __device__ __forceinline__ void fft_mid(LAS f32x2* X, int tt, const LAS f32x2* T) {
    const int blk = tt / Q, r = tt % Q, base = blk * 8 * Q + r;
    f32x2 e[8];
#pragma unroll
    for (int j = 0; j < 8; ++j) e[j] = X[padx(base + Q * j)];
    if (INV) r8_dit<Q>(e, r, T); else r8_dif<Q>(e, r, T);
#pragma unroll
    for (int j = 0; j < 8; ++j) X[padx(base + Q * j)] = e[j];
}
__device__ __forceinline__ void fft_conv_half(f32x2 (&v)[8], LAS f32x2* X, const LAS f32x2* T, const f32x2* K, int tt) {
    f32x2 kv[8];
#pragma unroll
    for (int j = 0; j < 8; ++j) kv[j] = K[8 * tt + j];
    fft_p1_dif(v, tt, T);
#pragma unroll
    for (int m = 0; m < 8; ++m) X[padx(tt + 256 * m)] = v[m];
    __syncthreads();
    fft_mid<64, false>(X, tt, T); __syncthreads();
    fft_mid<8, false>(X, tt, T); __syncthreads();
    f32x2 e[8];
#pragma unroll
    for (int j = 0; j < 8; ++j) e[j] = X[padx(8 * tt + j)];
    r8_dif<1>(e, 0, T);
#pragma unroll
    for (int j = 0; j < 8; ++j) e[j] = cmul(e[j], kv[j]);
    r8_dit<1>(e, 0, T);
#pragma unroll
    for (int j = 0; j < 8; ++j) X[padx(8 * tt + j)] = e[j];
    __syncthreads();
    fft_mid<8, true>(X, tt, T); __syncthreads();
    fft_mid<64, true>(X, tt, T); __syncthreads();
#pragma unroll
    for (int m = 0; m < 8; ++m) v[m] = X[padx(tt + 256 * m)];
    fft_p1_dit(v, tt, T);
}
__device__ __forceinline__ void fft_fwd_store(f32x2 (&v)[8], LAS f32x2* X, const LAS f32x2* T, f32x2* Kout, int tt) {
    fft_p1_dif(v, tt, T);
#pragma unroll
    for (int m = 0; m < 8; ++m) X[padx(tt + 256 * m)] = v[m];
    __syncthreads();
    fft_mid<64, false>(X, tt, T); __syncthreads();
    fft_mid<8, false>(X, tt, T); __syncthreads();
    f32x2 e[8];
#pragma unroll
    for (int j = 0; j < 8; ++j) e[j] = X[padx(8 * tt + j)];
    r8_dif<1>(e, 0, T);
#pragma unroll
    for (int j = 0; j < 8; ++j) Kout[8 * tt + j] = e[j];
    __syncthreads();
}
__device__ __forceinline__ int padx16(int i) { return i + (i >> 4); }
constexpr int XPAD16 = 2048 + 128;
constexpr int TC_A1 = 0, TC_A2 = 1024, TC_A3 = 1536, TC_A4 = 1792, TC_B1 = 1920, TC_B2 = 1984, TC_B3 = 2016, TC_B4 = 2032, TC_N = 2040;
template <int Q> __device__ __forceinline__ void r16_dif(f32x2 (&e)[16], int r, const LAS f32x2* TC) {
    const LAS f32x2* P1 = TC + (Q == 128 ? TC_A1 : TC_B1); const LAS f32x2* P2 = TC + (Q == 128 ? TC_A2 : TC_B2);
    const LAS f32x2* P3 = TC + (Q == 128 ? TC_A3 : TC_B3); const LAS f32x2* P4 = TC + (Q == 128 ? TC_A4 : TC_B4);
#pragma unroll
    for (int j = 0; j < 8; ++j) { const f32x2 a = e[j], b = e[j + 8]; e[j] = a + b; e[j + 8] = cmul(a - b, P1[r + Q * j]); }
#pragma unroll
    for (int jj = 0; jj < 8; ++jj) { const int j = (jj & 3) + 8 * (jj >> 2); const f32x2 a = e[j], b = e[j + 4]; e[j] = a + b; e[j + 4] = cmul(a - b, P2[r + Q * (j & 3)]); }
#pragma unroll
    for (int jj = 0; jj < 8; ++jj) { const int j = (jj & 1) + 4 * (jj >> 1); const f32x2 a = e[j], b = e[j + 2]; e[j] = a + b; e[j + 2] = cmul(a - b, P3[r + Q * (j & 1)]); }
    const f32x2 tw = P4[r];
#pragma unroll
    for (int j = 0; j < 16; j += 2) { const f32x2 a = e[j], b = e[j + 1]; e[j] = a + b; e[j + 1] = cmul(a - b, tw); }
}
template <int Q> __device__ __forceinline__ void r16_dit(f32x2 (&e)[16], int r, const LAS f32x2* TC) {
    const LAS f32x2* P1 = TC + (Q == 128 ? TC_A1 : TC_B1); const LAS f32x2* P2 = TC + (Q == 128 ? TC_A2 : TC_B2);
    const LAS f32x2* P3 = TC + (Q == 128 ? TC_A3 : TC_B3); const LAS f32x2* P4 = TC + (Q == 128 ? TC_A4 : TC_B4);
    const f32x2 tw = P4[r];
#pragma unroll
    for (int j = 0; j < 16; j += 2) { const f32x2 a = e[j], b = cmulc(e[j + 1], tw); e[j] = a + b; e[j + 1] = a - b; }
#pragma unroll
    for (int jj = 0; jj < 8; ++jj) { const int j = (jj & 1) + 4 * (jj >> 1); const f32x2 a = e[j], b = cmulc(e[j + 2], P3[r + Q * (j & 1)]); e[j] = a + b; e[j + 2] = a - b; }
#pragma unroll
    for (int jj = 0; jj < 8; ++jj) { const int j = (jj & 3) + 8 * (jj >> 2); const f32x2 a = e[j], b = cmulc(e[j + 4], P2[r + Q * (j & 3)]); e[j] = a + b; e[j + 4] = a - b; }
#pragma unroll
    for (int j = 0; j < 8; ++j) { const f32x2 a = e[j], b = cmulc(e[j + 8], P1[r + Q * j]); e[j] = a + b; e[j + 8] = a - b; }
}
__device__ __forceinline__ f32x2 mul_mi(f32x2 a) { return (f32x2){a.y, -a.x}; }
__device__ __forceinline__ f32x2 mul_pi(f32x2 a) { return (f32x2){-a.y, a.x}; }
__device__ __forceinline__ void r8_dif_c(f32x2 (&e)[8]) {
    constexpr float h = 0.70710678118654752440f;
    { const f32x2 a = e[0], b = e[4]; e[0] = a + b; e[4] = a - b; }
    { const f32x2 a = e[1], b = e[5]; e[1] = a + b; const f32x2 d = a - b; e[5] = (f32x2){(d.x + d.y) * h, (d.y - d.x) * h}; }
    { const f32x2 a = e[2], b = e[6]; e[2] = a + b; e[6] = mul_mi(a - b); }
    { const f32x2 a = e[3], b = e[7]; e[3] = a + b; const f32x2 d = a - b; e[7] = (f32x2){(d.y - d.x) * h, -(d.x + d.y) * h}; }
#pragma unroll
    for (int g = 0; g < 8; g += 4) {
        { const f32x2 a = e[g], b = e[g + 2]; e[g] = a + b; e[g + 2] = a - b; }
        { const f32x2 a = e[g + 1], b = e[g + 3]; e[g + 1] = a + b; e[g + 3] = mul_mi(a - b); } }
#pragma unroll
    for (int j = 0; j < 8; j += 2) { const f32x2 a = e[j], b = e[j + 1]; e[j] = a + b; e[j + 1] = a - b; }
}
__device__ __forceinline__ void r8_dit_c(f32x2 (&e)[8]) {
    constexpr float h = 0.70710678118654752440f;
#pragma unroll
    for (int j = 0; j < 8; j += 2) { const f32x2 a = e[j], b = e[j + 1]; e[j] = a + b; e[j + 1] = a - b; }
#pragma unroll
    for (int g = 0; g < 8; g += 4) {
        { const f32x2 a = e[g], b = e[g + 2]; e[g] = a + b; e[g + 2] = a - b; }
        { const f32x2 a = e[g + 1], b = mul_pi(e[g + 3]); e[g + 1] = a + b; e[g + 3] = a - b; } }
    { const f32x2 a = e[0], b = e[4]; e[0] = a + b; e[4] = a - b; }
    { const f32x2 a = e[1], d = e[5]; const f32x2 b = (f32x2){(d.x - d.y) * h, (d.x + d.y) * h}; e[1] = a + b; e[5] = a - b; }
    { const f32x2 a = e[2], b = mul_pi(e[6]); e[2] = a + b; e[6] = a - b; }
    { const f32x2 a = e[3], d = e[7]; const f32x2 b = (f32x2){-(d.x + d.y) * h, (d.x - d.y) * h}; e[3] = a + b; e[7] = a - b; }
}
struct NoHook { __device__ __forceinline__ void operator()() const {} };
template <class Hook = NoHook>
__device__ __forceinline__ void fft_conv_half16(f32x2 (&v)[16], LAS f32x2* X, const LAS f32x2* TC, const f32x2* K, int tt, const Hook& after_b1 = Hook()) {
    r16_dif<128>(v, tt, TC);
#pragma unroll
    for (int m = 0; m < 16; ++m) X[padx16(tt + 128 * m)] = v[m];
    __syncthreads();
    after_b1();
    const int r = tt & 7, base = (tt >> 3) * 128 + r;
#pragma unroll
    for (int j = 0; j < 16; ++j) v[j] = X[padx16(base + 8 * j)];
    r16_dif<8>(v, r, TC);
#pragma unroll
    for (int j = 0; j < 16; ++j) X[padx16(base + 8 * j)] = v[j];
    f32x2 kv[16];
#pragma unroll
    for (int j = 0; j < 16; ++j) kv[j] = K[((j >> 1) * 128 + tt) * 2 + (j & 1)];
    __syncthreads();
#pragma unroll
    for (int g = 0; g < 2; ++g) { f32x2 e[8];
#pragma unroll
        for (int j = 0; j < 8; ++j) e[j] = X[padx16(16 * tt + 8 * g + j)];
        r8_dif_c(e);
#pragma unroll
        for (int j = 0; j < 8; ++j) e[j] = cmul(e[j], kv[8 * g + j]);
        r8_dit_c(e);
#pragma unroll
        for (int j = 0; j < 8; ++j) X[padx16(16 * tt + 8 * g + j)] = e[j]; }
    __syncthreads();
#pragma unroll
    for (int j = 0; j < 16; ++j) v[j] = X[padx16(base + 8 * j)];
    r16_dit<8>(v, r, TC);
#pragma unroll
    for (int j = 0; j < 16; ++j) X[padx16(base + 8 * j)] = v[j];
    __syncthreads();
#pragma unroll
    for (int m = 0; m < 16; ++m) v[m] = X[padx16(tt + 128 * m)];
    r16_dit<128>(v, tt, TC);
}
__device__ __forceinline__ void fft_fwd_store16(f32x2 (&v)[16], LAS f32x2* X, const LAS f32x2* TC, f32x2* Kout, int tt) {
    r16_dif<128>(v, tt, TC);
#pragma unroll
    for (int m = 0; m < 16; ++m) X[padx16(tt + 128 * m)] = v[m];
    __syncthreads();
    const int r = tt & 7, base = (tt >> 3) * 128 + r;
#pragma unroll
    for (int j = 0; j < 16; ++j) v[j] = X[padx16(base + 8 * j)];
    r16_dif<8>(v, r, TC);
#pragma unroll
    for (int j = 0; j < 16; ++j) X[padx16(base + 8 * j)] = v[j];
    __syncthreads();
#pragma unroll
    for (int g = 0; g < 2; ++g) { f32x2 e[8];
#pragma unroll
        for (int j = 0; j < 8; ++j) e[j] = X[padx16(16 * tt + 8 * g + j)];
        r8_dif_c(e);
#pragma unroll
        for (int j = 0; j < 8; ++j) Kout[(((8 * g + j) >> 1) * 128 + tt) * 2 + (j & 1)] = e[j]; }
    __syncthreads();
}
constexpr int HY_TC_OFF = 122880;
__device__ __forceinline__ void build_twiddles(const Ctx& C, LAS f32x2* T) {
    for (int k = C.tid; k < 2048; k += NTHR) { float s, c; sincospif((float)k * (1.0f / 2048.0f), &s, &c); T[k] = (f32x2){c, -s}; }
    __syncthreads();
    LAS f32x2* TC = (LAS f32x2*)(C.lds + HY_TC_OFF);
    for (int k = C.tid; k < TC_N; k += NTHR) {
        const int src = k < TC_A2 ? 2 * k : k < TC_A3 ? 4 * (k - TC_A2) : k < TC_A4 ? 8 * (k - TC_A3) : k < TC_B1 ? 16 * (k - TC_A4) : k < TC_B2 ? 32 * (k - TC_B1) : k < TC_B3 ? 64 * (k - TC_B2) : k < TC_B4 ? 128 * (k - TC_B3) : 256 * (k - TC_B4);
        TC[k] = T[src]; }
}

__device__ __forceinline__ void phase0(const Ctx& C) {
    LAS float* sil = (LAS float*)C.lds;
    LAS float* red = sil + 9 * 1024;
    LAS float* zs = red + 8 * 9 * 64;
    LAS float* h1s = zs + 8 * 40;
    const float* cin = GIN(IN_C); const float* cctx = GIN(IN_CCTX);
    for (int i = C.tid; i < 9 * 1024; i += NTHR) { const int r = i >> 10, k = i & 1023; const float v = r < 8 ? cin[r * 1024 + k] : cctx[k]; sil[i] = v / (1.0f + expf(-v)); }
    __syncthreads();
    float* mods = WSP(float, WS_MODS);
    const float* wmod = GIN(IN_WMOD); const float* bmod = GIN(IN_BMOD);
    for (int item = C.bid; item < 4 * 96; item += C.G) {
        const int l = item / 96, cb = item % 96, cc = C.tid & 63, kg = C.tid >> 6;
        const float* w = wmod + ((size_t)l * 1024 + kg * 128) * 6144 + cb * 64 + cc;
        const LAS float* sk = sil + kg * 128;
        float acc[9];
#pragma unroll
        for (int r = 0; r < 9; ++r) acc[r] = 0.f;
#pragma unroll 4
        for (int k = 0; k < 128; ++k) { const float wv = w[(size_t)k * 6144];
#pragma unroll
            for (int r = 0; r < 9; ++r) acc[r] += sk[r * 1024 + k] * wv; }
#pragma unroll
        for (int r = 0; r < 9; ++r) red[(kg * 9 + r) * 64 + cc] = acc[r];
        __syncthreads();
        for (int o = C.tid; o < 576; o += NTHR) { const int r = o >> 6, c2 = o & 63; float s = 0.f;
#pragma unroll
            for (int g = 0; g < 8; ++g) s += red[(g * 9 + r) * 64 + c2];
            mods[(size_t)(l * 9 + r) * 6144 + cb * 64 + c2] = s + bmod[l * 6144 + cb * 64 + c2]; }
        __syncthreads();
    }
    for (int item = C.bid; item < 4 * 288; item += C.G) {
        const int l = item / 288, r = item % 288, isctx = r >= 256;
        const int L = isctx ? 256 : 2048, t0 = (isctx ? r - 256 : r) * 8, tl = C.tid >> 6, j = C.tid & 63, t = t0 + tl;
        if (j < 33) { float z;
            if (j == 0) z = (float)t / (float)(L - 1);
            else { const int fi = (j - 1) & 15; const float freq = 1e-4f + (float)fi * ((15.0f - 1e-4f) / 15.0f);
                const float ang = ((float)(2.0 * 3.14159265358979323846 / L) * (float)t) * freq; z = (j <= 16) ? cosf(ang) : -sinf(ang); }
            zs[tl * 40 + j] = z; }
        __syncthreads();
        { const float* w1 = GIN(IN_W1) + (size_t)l * 33 * 64; float s = GIN(IN_B1)[l * 64 + j];
            for (int i = 0; i < 33; ++i) s += zs[tl * 40 + i] * w1[i * 64 + j];
            h1s[tl * 64 + j] = sinf(s); }
        __syncthreads();
        { const float* w2 = GIN(IN_W2) + (size_t)l * 64 * 64; float s = GIN(IN_B2)[l * 64 + j];
            for (int i = 0; i < 64; ++i) s += h1s[tl * 64 + i] * w2[i * 64 + j];
            bf16_t* dst = WSP(bf16_t, WS_HPAD) + ((size_t)l * 2304 + (isctx ? 2048 + t : t)) * 128;
            dst[j] = (bf16_t)f2bf(sinf(s)); dst[64 + j] = (bf16_t)0; }
        __syncthreads();
    }
    {
        const float* w3 = GIN(IN_W3); bf16_t* w3t = WSP(bf16_t, WS_W3T);
        for (int i = C.bid * NTHR + C.tid; i < 4 * 64 * 2048; i += C.G * NTHR) { const int l = i >> 17, k = (i >> 11) & 63, col = i & 2047;
            w3t[((size_t)l * 2048 + col) * 128 + k] = (bf16_t)f2bf(w3[i]); w3t[((size_t)l * 2048 + col) * 128 + 64 + k] = (bf16_t)0; }
    }
    if (C.bid == C.G - 1) {
        const float* lb = GIN(IN_LB); float* lower = WSP(float, WS_LOWER);
        for (int i = C.tid; i < 1024; i += NTHR) { const int d = i >> 9, c = i & 511; float v[4], mx = -3.4e38f, s = 0.f;
#pragma unroll
            for (int l = 0; l < 4; ++l) { v[l] = lb[(d * 4 + l) * 512 + c]; mx = fmaxf(mx, v[l]); }
#pragma unroll
            for (int l = 0; l < 4; ++l) { v[l] = expf(v[l] - mx); s += v[l]; }
            float cum = 0.f;
#pragma unroll
            for (int l = 0; l < 4; ++l) { if (l > 0) cum += v[l] / s; lower[(d * 4 + l) * 512 + c] = cum; } }
    }
}

__device__ __forceinline__ const float* xrow_src(const Ctx& C, int l, int row) {
    return l == 0 ? (row < NLAT ? GIN(IN_X) + (size_t)row * D : GIN(IN_CTX) + (size_t)(row - NLAT) * D) : WSP(const float, WS_XBUF) + (size_t)row * D;
}
__device__ __forceinline__ void transpose_item(const float* W, int K, int N, bf16_t* WT, LAS float* scr, int item, int lane) {
    const int nblk = N / 32, kb = item / nblk, nb = item % nblk, k0 = 64 * kb, n0 = 32 * nb;
    float wv[32];
#pragma unroll
    for (int i = 0; i < 32; ++i) wv[i] = W[(size_t)(k0 + 2 * i + (lane >> 5)) * N + n0 + (lane & 31)];
#pragma unroll
    for (int i = 0; i < 32; ++i) scr[(2 * i + (lane >> 5)) * 33 + (lane & 31)] = wv[i];
    LDS_WAIT(); asm volatile("" ::: "memory");
    const int c = lane & 7;
#pragma unroll
    for (int j = 0; j < 4; ++j) { const int n = (lane >> 3) + 8 * j; const LAS float* s = scr + (8 * c) * 33 + n;
        u32x4 o; o.x = pk2(s[0 * 33], s[1 * 33]); o.y = pk2(s[2 * 33], s[3 * 33]); o.z = pk2(s[4 * 33], s[5 * 33]); o.w = pk2(s[6 * 33], s[7 * 33]);
        *(u32x4*)(WT + (size_t)(n0 + n) * K + k0 + 8 * c) = o; }
    LDS_WAIT(); asm volatile("" ::: "memory");
}
__device__ __forceinline__ void phase_l1(const Ctx& C, int l) {
    const int gw = C.bid * NWAVES + C.wave, NGW = C.G * NWAVES;
    const float* mods = WSP(const float, WS_MODS) + (size_t)l * 9 * 6144;
    bf16_t* an = WSP(bf16_t, WS_R1);
    f32x4 nv[4];
    if (!(C.dry & 2)) {
    if (gw < NTOK) { const float* src = xrow_src(C, l, gw);
#pragma unroll
        for (int j = 0; j < 4; ++j) nv[j] = *(const f32x4*)(src + C.lane * 4 + 256 * j); }
    for (int row = gw; row < NTOK; row += NGW) {
        const float* md = mods + bidx(row) * 6144;
        f32x4 v[4]; float ss = 0.f;
#pragma unroll
        for (int j = 0; j < 4; ++j) v[j] = nv[j];
        if (row + NGW < NTOK) { const float* src = xrow_src(C, l, row + NGW);
#pragma unroll
            for (int j = 0; j < 4; ++j) nv[j] = *(const f32x4*)(src + C.lane * 4 + 256 * j); }
#pragma unroll
        for (int j = 0; j < 4; ++j) ss += (v[j].x * v[j].x + v[j].y * v[j].y) + (v[j].z * v[j].z + v[j].w * v[j].w);
        ss = wave_sum(ss); const float rinv = 1.0f / sqrtf(ss * (1.0f / D) + EPS);
#pragma unroll
        for (int j = 0; j < 4; ++j) { const int k = C.lane * 4 + 256 * j; const f32x4 sh = *(const f32x4*)(md + k), sc = *(const f32x4*)(md + 1024 + k);
            const f32x4 o = v[j] * rinv * (sc + 1.0f) + sh; u32x2 w; w.x = pk2(o.x, o.y); w.y = pk2(o.z, o.w);
            *(u32x2*)(an + (size_t)row * D + k) = w; }
    }
    }
    if (!(C.dry & 4)) {
        LAS float* scr = (LAS float*)(C.lds + C.wave * 16384);
        constexpr int I_IN = 16 * 128, I_OUT = 16 * 32, I_E = 128;
        constexpr int NIT = I_IN + I_OUT + 3 * 16 * I_E;
        for (int it = gw; it < NIT; it += NGW) {
            int r = it;
            if (r < I_IN) { transpose_item(GIN(IN_WIN) + (size_t)l * D * DIN, D, DIN, WSP(bf16_t, WS_WIN), scr, r, C.lane); continue; } r -= I_IN;
            if (r < I_OUT) { transpose_item(GIN(IN_WOUT) + (size_t)l * D * D, D, D, WSP(bf16_t, WS_WOUT), scr, r, C.lane); continue; } r -= I_OUT;
            if (r < 16 * I_E) { const int e = r / I_E; transpose_item(GIN(IN_WG) + ((size_t)l * NE + e) * D * DE, D, DE, WSP(bf16_t, WS_WG) + (size_t)e * DE * D, scr, r % I_E, C.lane); continue; } r -= 16 * I_E;
            if (r < 16 * I_E) { const int e = r / I_E; transpose_item(GIN(IN_WU) + ((size_t)l * NE + e) * D * DE, D, DE, WSP(bf16_t, WS_WU) + (size_t)e * DE * D, scr, r % I_E, C.lane); continue; } r -= 16 * I_E;
            { const int e = r / I_E; transpose_item(GIN(IN_WD) + ((size_t)l * NE + e) * DE * D, DE, D, WSP(bf16_t, WS_WD) + (size_t)e * D * DE, scr, r % I_E, C.lane); }
        }
    }
    __syncthreads();
    {
        LAS f32x2* T = (LAS f32x2*)C.lds;
        const LAS f32x2* TC = (const LAS f32x2*)(C.lds + HY_TC_OFF);
        const int team = C.tid >> 7, tt = C.tid & 127;
        LAS f32x2* X = (LAS f32x2*)(C.lds + 16384) + team * XPAD16;
        LAS float* hbs = (LAS float*)(C.lds + 16384 + 4 * XPAD16 * 8) + team * 2048;
        LAS float* reds = (LAS float*)(C.lds + 16384 + 4 * XPAD16 * 8 + 32768);
        build_twiddles(C, T);
        __syncthreads();
        const bf16_t* hfl = WSP(const bf16_t, WS_HF) + (size_t)l * 2048 * 2304;
        f32x2* kspec = WSP(f32x2, WS_KSPEC);
        if (!(C.dry & 8))
        for (int item = C.bid; item < 256; item += C.G) {
            const int idx = item * 4 + team, o = idx >> 9, c = idx & 511;
            const int colf = o * 1024 + c, colb = colf + 512;
            const bf16_t* hfp = hfl + (size_t)colf * 2304; const bf16_t* hbp = hfl + (size_t)colb * 2304;
            float hf[16], hb[16], s = 0.f;
#pragma unroll
            for (int j = 0; j < 16; ++j) { const int t = tt + 128 * j; hf[j] = bf2f(hfp[t]); hb[j] = bf2f(hbp[t]); s += fabsf(hf[j]) + fabsf(hb[j]); }
            s = wave_sum(s);
            if (C.lane == 0) reds[C.wave] = s;
            __syncthreads();
            const float inv = 1.0f / ((reds[team * 2] + reds[team * 2 + 1]) * 4096.0f);
#pragma unroll
            for (int j = 0; j < 16; ++j) { hf[j] *= inv; hbs[tt + 128 * j] = hb[j] * inv; }
            __syncthreads();
            f32x2* kout = kspec + ((size_t)(o * 512 + c) * 2) * 2048;
            f32x2 vv[16];
#pragma unroll
            for (int j = 0; j < 16; ++j) { const int n = tt + 128 * j; const float kb = n > 0 ? hbs[2048 - n] : 0.f; vv[j] = (f32x2){hf[j] + kb, 0.f}; }
            fft_fwd_store16(vv, X, TC, kout, tt);
#pragma unroll
            for (int j = 0; j < 16; ++j) { const int n = tt + 128 * j; const float kb = n > 0 ? hbs[2048 - n] : 0.f; const float dd = hf[j] - kb; const f32x2 tw = T[n]; vv[j] = (f32x2){dd * tw.x, dd * tw.y}; }
            fft_fwd_store16(vv, X, TC, kout + 2048, tt);
        }
        if (l < DEPTH - 1 && !(C.dry & 16)) {
            f32x2* kspc = WSP(f32x2, WS_KSPC);
            for (int item = C.bid; item < 256; item += C.G) {
                const int idx = item * 4 + team, o = idx >> 9, c = idx & 511;
                const int colf = o * 1024 + c, colb = colf + 512;
                float af0 = bf2f(hfl[(size_t)colf * 2304 + 2048 + tt]), af1 = bf2f(hfl[(size_t)colf * 2304 + 2048 + 128 + tt]);
                float ab0 = bf2f(hfl[(size_t)colb * 2304 + 2048 + tt]), ab1 = bf2f(hfl[(size_t)colb * 2304 + 2048 + 128 + tt]);
                __syncthreads();
                const float s = wave_sum((fabsf(af0) + fabsf(af1)) + (fabsf(ab0) + fabsf(ab1)));
                if (C.lane == 0) reds[C.wave] = s;
                __syncthreads();
                const float inv = 1.0f / ((reds[team * 2] + reds[team * 2 + 1]) * 2048.0f);
                af0 *= inv; af1 *= inv; hbs[tt] = ab0 * inv; hbs[128 + tt] = ab1 * inv;
                __syncthreads();
                f32x2 vk[16];
#pragma unroll
                for (int j = 0; j < 16; ++j) vk[j] = (f32x2){0.f, 0.f};
                vk[0] = (f32x2){af0, 0.f}; vk[1] = (f32x2){af1, 0.f};
                vk[14] = (f32x2){tt > 0 ? hbs[256 - tt] : 0.f, 0.f};
                vk[15] = (f32x2){hbs[128 - tt], 0.f};
                fft_fwd_store16(vk, X, TC, kspc + (size_t)(o * 512 + c) * 2048, tt);
            }
        }
    }
}

struct Taps { unsigned w1, wx; };
struct TapSel { unsigned m, c, p; };
__device__ __forceinline__ Taps sc_load(const LAS bf16_t* raw, int t) { const int e = t & ~1; Taps r; r.w1 = *(const LAS unsigned*)(raw + e); r.wx = *(const LAS unsigned*)(raw + e - 2 + 4 * (t & 1)); return r; }
__device__ __forceinline__ TapSel sc_sel(int t, bool has_m, bool has_p) { TapSel s; const bool odd = (t & 1) != 0;
    s.m = has_m ? (odd ? 0x01000c0cu : 0x07060c0cu) : 0x0c0c0c0cu; s.c = odd ? 0x03020c0cu : 0x01000c0cu; s.p = has_p ? (odd ? 0x05040c0cu : 0x03020c0cu) : 0x0c0c0c0cu; return s; }
__device__ __forceinline__ float sc_eval(const Taps r, const TapSel s, float w0, float w1, float w2, float bias) {
    const float pm = __builtin_bit_cast(float, __builtin_amdgcn_perm(r.wx, r.w1, s.m)), pc = __builtin_bit_cast(float, __builtin_amdgcn_perm(r.wx, r.w1, s.c)), pp = __builtin_bit_cast(float, __builtin_amdgcn_perm(r.wx, r.w1, s.p));
    return w0 * pm + w1 * pc + w2 * pp + bias; }
constexpr int HY_CH = 4, HY_ITEMS = 4 * (512 / HY_CH), HYC_ITEMS = 512 / 4;
__device__ __forceinline__ void hyena_lat(const Ctx& C, int l, int item) {
    const int bp = item & 3, cg = item >> 2, team = C.tid >> 7, tt = C.tid & 127;
    LAS f32x2* T = (LAS f32x2*)C.lds;
    const LAS f32x2* TC = (const LAS f32x2*)(C.lds + HY_TC_OFF);
    LAS f32x2* X = (LAS f32x2*)(C.lds + 16384) + team * XPAD16;
    LAS bf16_t* raw = (LAS bf16_t*)(C.lds + 16384 + 4 * XPAD16 * 8) + team * 4096;
    const bf16_t* phyt = WSP(const bf16_t, WS_PHYT);
    const float* cw = GIN(IN_CONVW) + (size_t)l * 3 * NHY; const float* cb = GIN(IN_CONVB) + (size_t)l * NHY;
    const float* hyb = GIN(IN_HYBIAS) + (size_t)l * 2 * DH;
    const f32x2* kspec = WSP(const f32x2, WS_KSPEC);
    const int ba = 2 * bp, c = cg * 4 + team;
    f32x2 z[16], acc[16], v[16];
    LAS unsigned char* rawdma = C.lds + 16384 + 4 * XPAD16 * 8 + (C.wave >> 1) * 8192 + (C.wave & 1) * 1024;
    auto raw_request = [&](int st) {
#pragma unroll
        for (int k = 0; k < 4; ++k) { const int q = tt + 128 * k, rr = q >> 8, cc = q & 255;
            __builtin_amdgcn_global_load_lds((const unsigned*)(phyt + (size_t)(st * 512 + c) * NTOK + (size_t)(ba + rr) * 2048 + cc * 8), (LAS unsigned*)(rawdma + k * 2048), 16, 0, 0); } };
    raw_request(0);
    float wn0 = cw[c], wn1 = cw[NHY + c], wn2 = cw[2 * NHY + c], wnb = cb[c];
#pragma unroll 1
    for (int stage = 0; stage < 3; ++stage) {
        const float w0 = wn0, w1 = wn1, w2 = wn2, bs = wnb;
        const float dsk = stage > 0 ? hyb[(stage - 1) * DH + c] : 0.f;
        asm volatile("s_waitcnt vmcnt(0)" ::: "memory");
        __syncthreads();
        if (stage < 2) { const int chn = (stage + 1) * 512 + c; wn0 = cw[chn]; wn1 = cw[NHY + chn]; wn2 = cw[2 * NHY + chn]; wnb = cb[chn]; }
        const TapSel ts = sc_sel(tt, (tt & 63) != 0, (tt & 63) != 63);
#pragma unroll
        for (int hb = 0; hb < 2; ++hb) {
            Taps ra[8], rb[8];
#pragma unroll
            for (int j = 0; j < 8; ++j) { const int t = tt + 128 * (8 * hb + j); ra[j] = sc_load(raw, t); rb[j] = sc_load(raw + 2048, t); }
            __builtin_amdgcn_sched_barrier(0); asm volatile("s_waitcnt lgkmcnt(0)" ::: "memory"); __builtin_amdgcn_sched_barrier(0);
#pragma unroll
            for (int j = 0; j < 8; ++j) { const int jj = 8 * hb + j;
                const float sa = sc_eval(ra[j], ts, w0, w1, w2, bs), sb = sc_eval(rb[j], ts, w0, w1, w2, bs);
                if (stage == 0) z[jj] = (f32x2){sa, sb};
                else { const f32x2 cv = acc[jj] + z[jj] * dsk; z[jj] = (f32x2){sa * cv.x, sb * cv.y}; } }
        }
        if (stage == 2) {
            LAS bf16_t* ob = (LAS bf16_t*)X;
#pragma unroll
            for (int j = 0; j < 16; ++j) { const int t = tt + 128 * j; ob[t] = (bf16_t)f2bf(z[j].x); ob[2048 + t] = (bf16_t)f2bf(z[j].y); }
            break;
        }
        const f32x2* K = kspec + ((size_t)(stage * 512 + c) * 2) * 2048;
#pragma unroll
        for (int j = 0; j < 16; ++j) v[j] = z[j];
        { const int stn = stage + 1; fft_conv_half16(v, X, TC, K, tt, [&]() { raw_request(stn); }); }
#pragma unroll
        for (int j = 0; j < 16; ++j) acc[j] = v[j];
#pragma unroll
        for (int j = 0; j < 16; ++j) v[j] = cmul(z[j], T[tt + 128 * j]);
        fft_conv_half16(v, X, TC, K + 2048, tt);
#pragma unroll
        for (int j = 0; j < 16; ++j) acc[j] += cmulc(v[j], T[tt + 128 * j]);
    }
    __syncthreads();
    bf16_t* Y = WSP(bf16_t, WS_R1);
    for (int i = C.tid; i < 4096; i += NTHR) { const int b = i >> 11, t = i & 2047;
        const LAS bf16_t* o0 = (const LAS bf16_t*)((LAS f32x2*)(C.lds + 16384)) + i;
        u32x2 w; w.x = (unsigned)o0[0] | ((unsigned)o0[XPAD16 * 4] << 16); w.y = (unsigned)o0[2 * XPAD16 * 4] | ((unsigned)o0[3 * XPAD16 * 4] << 16);
        *(u32x2*)(Y + ((size_t)(ba + b) * 2048 + t) * D + cg * 4) = w; }
    __syncthreads();
}
__device__ __forceinline__ void hyena_ctx2(const Ctx& C, int l, int item) {
    const int team = C.tid >> 7, tt = C.tid & 127, c = item * 4 + team;
    const LAS f32x2* TC = (const LAS f32x2*)(C.lds + HY_TC_OFF);
    LAS f32x2* X = (LAS f32x2*)(C.lds + 16384) + team * XPAD16;
    LAS bf16_t* raw = (LAS bf16_t*)(C.lds + 16384 + 4 * XPAD16 * 8) + team * 4096;
    const bf16_t* phyt = WSP(const bf16_t, WS_PHYT);
    const float* cw = GIN(IN_CONVW) + (size_t)l * 3 * NHY; const float* cb = GIN(IN_CONVB) + (size_t)l * NHY;
    const float* hyb = GIN(IN_HYBIAS) + (size_t)l * 2 * DH;
    const f32x2* kspc = WSP(const f32x2, WS_KSPC);
    bf16_t* Y = WSP(bf16_t, WS_R1);
    f32x2 z[16], v[16];
#pragma unroll
    for (int j = 0; j < 16; ++j) { z[j] = (f32x2){0.f, 0.f}; v[j] = (f32x2){0.f, 0.f}; }
#pragma unroll 1
    for (int stage = 0; stage < 3; ++stage) {
        const int ch = stage * 512 + c;
        __syncthreads();
#pragma unroll
        for (int k = 0; k < 2; ++k) { const int q = tt + 128 * k; *(LAS u32x4*)(raw + q * 8) = *(const u32x4*)(phyt + (size_t)ch * NTOK + NLAT + q * 8); }
        __syncthreads();
        const float w0 = cw[ch], w1 = cw[NHY + ch], w2 = cw[2 * NHY + ch], bs = cb[ch];
        const float dsk = stage > 0 ? hyb[(stage - 1) * DH + c] : 0.f;
        Taps ra[8], rb[8];
#pragma unroll
        for (int p = 0; p < 4; ++p)
#pragma unroll
            for (int hh = 0; hh < 2; ++hh) { const int tok = hh * 128 + tt; ra[2 * p + hh] = sc_load(raw, (2 * p) * 256 + tok); rb[2 * p + hh] = sc_load(raw, (2 * p + 1) * 256 + tok); }
        __builtin_amdgcn_sched_barrier(0); asm volatile("s_waitcnt lgkmcnt(0)" ::: "memory"); __builtin_amdgcn_sched_barrier(0);
        const TapSel ts0 = sc_sel(tt, tt != 0, true), ts1 = sc_sel(tt, true, tt != 127);
#pragma unroll
        for (int p = 0; p < 4; ++p)
#pragma unroll
            for (int hh = 0; hh < 2; ++hh) { const int m = 4 * p + hh;
                const TapSel ts = hh ? ts1 : ts0;
                const float ua = sc_eval(ra[2 * p + hh], ts, w0, w1, w2, bs), ub = sc_eval(rb[2 * p + hh], ts, w0, w1, w2, bs);
                if (stage == 0) z[m] = (f32x2){ua, ub};
                else { const f32x2 cv = v[m] + z[m] * dsk; z[m] = (f32x2){ua * cv.x, ub * cv.y}; } }
        if (stage == 2) {
#pragma unroll
            for (int p = 0; p < 4; ++p)
#pragma unroll
                for (int hh = 0; hh < 2; ++hh) { const int m = 4 * p + hh, tok = hh * 128 + tt;
                    Y[(size_t)(NLAT + (2 * p) * 256 + tok) * D + c] = (bf16_t)f2bf(z[m].x); Y[(size_t)(NLAT + (2 * p + 1) * 256 + tok) * D + c] = (bf16_t)f2bf(z[m].y); }
            break;
        }
#pragma unroll
        for (int j = 0; j < 16; ++j) v[j] = z[j];
        fft_conv_half16(v, X, TC, kspc + (size_t)(stage * 512 + c) * 2048, tt);
    }
}

constexpr int HG_QT = 0, HG_QP = 17408, HG_KP = 34816, HG_ST = 52224, HG_VT = 87040, HG_KH = 105472, HG_P = 123904, HG_SUB = 133120, HG_D = 137216;
__device__ __forceinline__ void hgrn_mfma(const Ctx& C, int item) {
    const int dir = item & 1, h = (item >> 1) & 3, b = item >> 3;
    LAS unsigned char* L = C.lds;
    const int lane = C.lane, w = C.wave, r = lane & 15, quad = lane >> 4;
    const bf16_t* phg = WSP(const bf16_t, WS_PHG);
    bf16_t* odir = WSP(bf16_t, WS_ODIR) + (size_t)dir * NTOK * 512;
    LAS float* subtot = (LAS float*)(L + HG_SUB); LAS float* Dv = (LAS float*)(L + HG_D);
    __syncthreads();
    unsigned z0_ = 0u; asm volatile("" : "+v"(z0_));
    const u32x4 zv_ = (u32x4){z0_, z0_, z0_, z0_}; const float zff_ = __builtin_bit_cast(float, z0_); const f32x4 zv4f_ = (f32x4){zff_, zff_, zff_, zff_};
    for (int i = C.tid; i < (128 * 272) / 16; i += NTHR) *(LAS u32x4*)(L + HG_ST + i * 16) = zv_;
    for (int i = C.tid; i < (64 * 144) / 16; i += NTHR) *(LAS u32x4*)(L + HG_P + i * 16) = zv_;
    f32x4 sacc[8];
#pragma unroll
    for (int t = 0; t < 8; ++t) sacc[t] = zv4f_;
    unsigned qw[8], kw[8], vw[8];
    const int rstep = dir ? -1 : 1;
    const size_t colq = (size_t)h * 128 + 2 * lane, colk = 1536 + (size_t)dir * 512 + h * 128 + 2 * lane, colv = 512 + (size_t)h * 128 + 2 * lane;
    auto chunk_row0 = [&](int ch) -> int { return ch < 4 ? NLAT + b * 256 + (dir ? 255 - ch * 64 : ch * 64) : b * 2048 + (dir ? 2047 - (ch - 4) * 64 : (ch - 4) * 64); };
    { const int row0 = chunk_row0(0) + rstep * 8 * w;
#pragma unroll
      for (int i = 0; i < 8; ++i) { const bf16_t* p = phg + (size_t)(row0 + rstep * i) * NHG; qw[i] = *(const unsigned*)(p + colq); kw[i] = *(const unsigned*)(p + colk); vw[i] = *(const unsigned*)(p + colv); } }
    __syncthreads();
#pragma unroll 1
    for (int ch = 0; ch < 36; ++ch) {
        f32x2 cp[8]; f32x2 cq = (f32x2){1.0f, 1.0f};
#pragma unroll
        for (int i = 0; i < 8; ++i) { cq *= (f32x2){1.0f - bflo(kw[i]), 1.0f - bfhi(kw[i])}; cp[i] = cq; }
        *(LAS f32x2*)(subtot + w * 128 + 2 * lane) = cq;
        __syncthreads();
        f32x2 sg[8];
#pragma unroll
        for (int g = 0; g < 8; ++g) sg[g] = *(const LAS f32x2*)(subtot + g * 128 + 2 * lane);
        f32x2 pre = (f32x2){1.0f, 1.0f};
#pragma unroll
        for (int g = 0; g < 7; ++g) if (g < w) pre *= sg[g];
        const f32x2 erho = (sg[0] * sg[1]) * (sg[2] * sg[3]), eend = (sg[4] * sg[5]) * (sg[6] * sg[7]);
        const f32x2 ainv = pre * (f32x2){__builtin_amdgcn_rcpf(erho.x), __builtin_amdgcn_rcpf(erho.y)};
        unsigned kha[4], khb[4], vta[4], vtb[4];
#pragma unroll
        for (int i = 0; i < 8; ++i) {
            const f32x2 e1 = cp[i] * ainv, e2 = (f32x2){__builtin_amdgcn_rcpf(e1.x), __builtin_amdgcn_rcpf(e1.y)};
            const f32x2 qp = (f32x2){bflo(qw[i]), bfhi(qw[i])} * e1, kp = (f32x2){bflo(kw[i]), bfhi(kw[i])} * e2, qt = qp * erho, kh = kp * eend;
            const int srow = (8 * w + i) * 272 + lane * 4;
            *(LAS unsigned*)(L + HG_QP + srow) = pk2(qp.x, qp.y);
            *(LAS unsigned*)(L + HG_QT + srow) = pk2(qt.x, qt.y);
            *(LAS unsigned*)(L + HG_KP + srow) = pk2(kp.x, kp.y);
            const unsigned khw = pk2(kh.x, kh.y);
            if (i & 1) { kha[i >> 1] = __builtin_amdgcn_perm(khw, kha[i >> 1], 0x05040100u); khb[i >> 1] = __builtin_amdgcn_perm(khw, khb[i >> 1], 0x07060100u);
                         vta[i >> 1] = __builtin_amdgcn_perm(vw[i], vta[i >> 1], 0x05040100u); vtb[i >> 1] = __builtin_amdgcn_perm(vw[i], vtb[i >> 1], 0x07060100u); }
            else { kha[i >> 1] = khw & 0xffffu; khb[i >> 1] = khw >> 16; vta[i >> 1] = vw[i] & 0xffffu; vtb[i >> 1] = vw[i] >> 16; }
        }
        *(LAS u32x4*)(L + HG_KH + (2 * lane) * 144 + w * 16) = (u32x4){kha[0], kha[1], kha[2], kha[3]};
        *(LAS u32x4*)(L + HG_KH + (2 * lane + 1) * 144 + w * 16) = (u32x4){khb[0], khb[1], khb[2], khb[3]};
        *(LAS u32x4*)(L + HG_VT + (2 * lane) * 144 + w * 16) = (u32x4){vta[0], vta[1], vta[2], vta[3]};
        *(LAS u32x4*)(L + HG_VT + (2 * lane + 1) * 144 + w * 16) = (u32x4){vtb[0], vtb[1], vtb[2], vtb[3]};
        if (w == 0) *(LAS f32x2*)(Dv + 2 * lane) = erho * eend;
        const int crow0 = chunk_row0(ch);
        if (ch + 1 < 36) { const int row0 = chunk_row0(ch + 1) + rstep * 8 * w;
#pragma unroll
            for (int i = 0; i < 8; ++i) { const bf16_t* p = phg + (size_t)(row0 + rstep * i) * NHG; qw[i] = *(const unsigned*)(p + colq); kw[i] = *(const unsigned*)(p + colk); vw[i] = *(const unsigned*)(p + colv); } }
        __syncthreads();
#pragma unroll 1
        for (int blk = w; blk < 10; blk += 8) {
            const int I2 = blk < 1 ? 0 : (blk < 3 ? 1 : (blk < 6 ? 2 : 3)), J2 = blk - (I2 * (I2 + 1)) / 2;
            bf16x8 pa_[4], pb_[4];
#pragma unroll
            for (int kk = 0; kk < 4; ++kk) {
                pa_[kk] = *(const LAS bf16x8*)(L + HG_KP + (J2 * 16 + r) * 272 + (32 * kk + 8 * quad) * 2);
                pb_[kk] = *(const LAS bf16x8*)(L + HG_QP + (I2 * 16 + r) * 272 + (32 * kk + 8 * quad) * 2); }
            __builtin_amdgcn_sched_barrier(0);
            f32x4 pa = zv4f_;
#pragma unroll
            for (int kk = 0; kk < 4; ++kk) pa = __builtin_amdgcn_mfma_f32_16x16x32_bf16(pa_[kk], pb_[kk], pa, 0, 0, 0);
            if (I2 == J2) {
#pragma unroll
                for (int rr = 0; rr < 4; ++rr) if (4 * quad + rr > r) pa[rr] = 0.f;
            }
            u32x2 pw; pw.x = pk2(pa[0], pa[1]); pw.y = pk2(pa[2], pa[3]);
            *(LAS u32x2*)(L + HG_P + (I2 * 16 + r) * 144 + (J2 * 16 + 4 * quad) * 2) = pw;
        }
        __syncthreads();
        {
            bf16x8 sfr[4];
#pragma unroll
            for (int kk = 0; kk < 4; ++kk) sfr[kk] = *(const LAS bf16x8*)(L + HG_ST + (16 * w + r) * 272 + (32 * kk + 8 * quad) * 2);
            const bf16x8 vf0 = *(const LAS bf16x8*)(L + HG_VT + (16 * w + r) * 144 + (8 * quad) * 2);
            const bf16x8 vf1 = *(const LAS bf16x8*)(L + HG_VT + (16 * w + r) * 144 + (32 + 8 * quad) * 2);
            bf16x8 ob_[2][6];
#pragma unroll
            for (int kk = 0; kk < 4; ++kk) ob_[0][kk] = *(const LAS bf16x8*)(L + HG_QT + r * 272 + (32 * kk + 8 * quad) * 2);
            ob_[0][4] = *(const LAS bf16x8*)(L + HG_P + r * 144 + (8 * quad) * 2);
#pragma unroll
            for (int I3 = 0; I3 < 4; ++I3) {
                const int cb = I3 & 1, nb = cb ^ 1;
                if (I3 < 3) {
#pragma unroll
                    for (int kk = 0; kk < 4; ++kk) ob_[nb][kk] = *(const LAS bf16x8*)(L + HG_QT + ((I3 + 1) * 16 + r) * 272 + (32 * kk + 8 * quad) * 2);
                    ob_[nb][4] = *(const LAS bf16x8*)(L + HG_P + ((I3 + 1) * 16 + r) * 144 + (8 * quad) * 2);
                    if (I3 + 1 >= 2) ob_[nb][5] = *(const LAS bf16x8*)(L + HG_P + ((I3 + 1) * 16 + r) * 144 + (32 + 8 * quad) * 2);
                }
                __builtin_amdgcn_sched_barrier(0);
                f32x4 oa = zv4f_;
#pragma unroll
                for (int kk = 0; kk < 4; ++kk) oa = __builtin_amdgcn_mfma_f32_16x16x32_bf16(sfr[kk], ob_[cb][kk], oa, 0, 0, 0);
                oa = __builtin_amdgcn_mfma_f32_16x16x32_bf16(vf0, ob_[cb][4], oa, 0, 0, 0);
                if (I3 >= 2) oa = __builtin_amdgcn_mfma_f32_16x16x32_bf16(vf1, ob_[cb][5], oa, 0, 0, 0);
                const int row = crow0 + rstep * (16 * I3 + r);
                u32x2 ow; ow.x = pk2(oa[0], oa[1]); ow.y = pk2(oa[2], oa[3]);
                *(u32x2*)(odir + (size_t)row * 512 + h * 128 + 16 * w + 4 * quad) = ow;
                __builtin_amdgcn_sched_barrier(0);
            }
            f32x4 sd_[2]; bf16x8 sa_[2][2];
            sd_[0] = *(const LAS f32x4*)(L + HG_D + (4 * quad) * 4);
            sa_[0][0] = *(const LAS bf16x8*)(L + HG_KH + r * 144 + (8 * quad) * 2);
            sa_[0][1] = *(const LAS bf16x8*)(L + HG_KH + r * 144 + (32 + 8 * quad) * 2);
#pragma unroll
            for (int t = 0; t < 8; ++t) {
                const int cb = t & 1, nb = cb ^ 1;
                if (t < 7) {
                    sd_[nb] = *(const LAS f32x4*)(L + HG_D + (16 * (t + 1) + 4 * quad) * 4);
                    sa_[nb][0] = *(const LAS bf16x8*)(L + HG_KH + (16 * (t + 1) + r) * 144 + (8 * quad) * 2);
                    sa_[nb][1] = *(const LAS bf16x8*)(L + HG_KH + (16 * (t + 1) + r) * 144 + (32 + 8 * quad) * 2);
                }
                __builtin_amdgcn_sched_barrier(0);
                f32x4 sa = sacc[t] * sd_[cb];
                sa = __builtin_amdgcn_mfma_f32_16x16x32_bf16(sa_[cb][0], vf0, sa, 0, 0, 0);
                sa = __builtin_amdgcn_mfma_f32_16x16x32_bf16(sa_[cb][1], vf1, sa, 0, 0, 0);
                sacc[t] = sa;
                u32x2 sw; sw.x = pk2(sa[0], sa[1]); sw.y = pk2(sa[2], sa[3]);
                *(LAS u32x2*)(L + HG_ST + (16 * w + r) * 272 + (16 * t + 4 * quad) * 2) = sw;
                __builtin_amdgcn_sched_barrier(0);
            }
        }
    }
    __syncthreads();
}
__device__ __forceinline__ void phase_l3(const Ctx& C, int l, unsigned* hyd) {
    if (C.bid < 64) hgrn_mfma(C, C.bid);
    build_twiddles(C, (LAS f32x2*)C.lds);
    if (C.tid == 0) { unsigned sp = 0; const unsigned need = (unsigned)(C.G - 64);
        while (__hip_atomic_load(hyd, __ATOMIC_RELAXED, __HIP_MEMORY_SCOPE_AGENT) < need) { __builtin_amdgcn_s_sleep(4); if (++sp > (1u << 22)) break; }
        __builtin_amdgcn_fence(__ATOMIC_ACQUIRE, "agent"); asm volatile("s_waitcnt vmcnt(0)" ::: "memory"); }
    __syncthreads();
    unsigned* qh = WSP(unsigned, WS_CTL) + CW_Q + l * 64 + C.rep * 16;
    volatile LAS int* lc = (volatile LAS int*)(C.lds + LDSCTL_OFF);
    const int nitems = HY_ITEMS + (l < DEPTH - 1 ? HYC_ITEMS : 0);
    for (;;) {
        if (C.tid == 0) lc[LC_Q] = (int)__hip_atomic_fetch_add(qh, 1u, __ATOMIC_RELAXED, __HIP_MEMORY_SCOPE_AGENT);
        __syncthreads();
        const int item = lc[LC_Q];
        __syncthreads();
        if (item >= nitems) break;
        Ctx CI = C; { int t_ = C.tid; asm volatile("" : "+v"(t_)); CI.tid = t_; CI.lane = t_ & 63; }
        if (item < HY_ITEMS) hyena_lat(CI, l, item); else hyena_ctx2(CI, l, item - HY_ITEMS);
    }
}
__device__ __forceinline__ void phase_l3b(const Ctx& C, int l) {
    const int gw = C.bid * NWAVES + C.wave, NGW = C.G * NWAVES;
    const bf16_t* od0 = WSP(const bf16_t, WS_ODIR); const bf16_t* od1 = od0 + (size_t)NTOK * 512;
    const bf16_t* phg = WSP(const bf16_t, WS_PHG); bf16_t* Y = WSP(bf16_t, WS_R1);
    const float* nw = GIN(IN_NORMW) + l * 128;
    const int nrows = (l < DEPTH - 1) ? NTOK : NLAT;
    for (int row = gw; row < nrows; row += NGW) {
        const int idx = C.lane * 8;
        const u32x4 a = *(const u32x4*)(od0 + (size_t)row * 512 + idx), b = *(const u32x4*)(od1 + (size_t)row * 512 + idx), g = *(const u32x4*)(phg + (size_t)row * NHG + 1024 + idx);
        float o[8] = {bflo(a.x) + bflo(b.x), bfhi(a.x) + bfhi(b.x), bflo(a.y) + bflo(b.y), bfhi(a.y) + bfhi(b.y), bflo(a.z) + bflo(b.z), bfhi(a.z) + bfhi(b.z), bflo(a.w) + bflo(b.w), bfhi(a.w) + bfhi(b.w)};
        const float gg[8] = {bflo(g.x), bfhi(g.x), bflo(g.y), bfhi(g.y), bflo(g.z), bfhi(g.z), bflo(g.w), bfhi(g.w)};
        float ss = 0.f;
#pragma unroll
        for (int i = 0; i < 8; ++i) ss += o[i] * o[i];
        ss = row16_sum(ss);
        const float rinv = 1.0f / sqrtf(ss * (1.0f / 128.0f) + EPS);
        float y[8];
#pragma unroll
        for (int i = 0; i < 8; ++i) y[i] = o[i] * rinv * nw[(idx + i) & 127] * siluf_(gg[i]);
        u32x4 w; w.x = pk2(y[0], y[1]); w.y = pk2(y[2], y[3]); w.z = pk2(y[4], y[5]); w.w = pk2(y[6], y[7]);
        *(u32x4*)(Y + (size_t)row * D + 512 + idx) = w;
    }
}

constexpr int RW_PITCH = 1028;
__device__ __forceinline__ void phase_l5a(const Ctx& C, int l) {
    LAS float* rwT = (LAS float*)C.lds;
    LAS int* lcnt = (LAS int*)(C.lds + 16 * RW_PITCH * 4);
    LAS float* wsc = (LAS float*)(C.lds + 16 * RW_PITCH * 4 + 128) + C.wave * 384;
    const float* rw = GIN(IN_RW);
    for (int i = C.tid; i < 16 * 1024; i += NTHR) { const int k = i >> 4, e = i & 15; rwT[e * RW_PITCH + k] = rw[i]; }
    if (C.tid < 32) lcnt[C.tid] = 0;
    __syncthreads();
    const int gw = C.bid * NWAVES + C.wave, NGW = C.G * NWAVES;
    const float* mods = WSP(const float, WS_MODS) + (size_t)l * 9 * 6144;
    const float* bias2 = WSP(const float, WS_BIAS2) + l * 9 * 16;
    const float* xb = WSP(const float, WS_XBUF);
    const float* rbias = GIN(IN_RB);
    unsigned* cnt = WSP(unsigned, WS_CTL) + CW_CNT + l * 32 * 64;
    int* tokinfo = WSP(int, WS_TOKINFO);
    const int ngroups = ((l < DEPTH - 1) ? NTOK : NLAT) / 16;
    const int li = C.lane & 15, kq = C.lane >> 4;
    for (int g = gw; g < ngroups; g += NGW) {
        const int row0 = g * 16, bb = bidx(row0);
        const float* xp = xb + (size_t)(row0 + li) * D + kq * 4;
        const float* scp = mods + bb * 6144 + 4096 + kq * 4;
        const LAS float* bp = rwT + li * RW_PITCH + kq * 4;
        f32x4 acc0 = (f32x4){0.f, 0.f, 0.f, 0.f}, acc1 = acc0, acc2 = acc0, acc3 = acc0; float ss = 0.f;
#pragma unroll 8
        for (int m = 0; m < 64; ++m) {
            const f32x4 xv = *(const f32x4*)(xp + 16 * m), sc = *(const f32x4*)(scp + 16 * m), bv = *(const LAS f32x4*)(bp + 16 * m);
            ss += (xv.x * xv.x + xv.y * xv.y) + (xv.z * xv.z + xv.w * xv.w);
            const f32x4 av = xv * (sc + 1.0f);
            acc0 = __builtin_amdgcn_mfma_f32_16x16x4f32(av.x, bv.x, acc0, 0, 0, 0);
            acc1 = __builtin_amdgcn_mfma_f32_16x16x4f32(av.y, bv.y, acc1, 0, 0, 0);
            acc2 = __builtin_amdgcn_mfma_f32_16x16x4f32(av.z, bv.z, acc2, 0, 0, 0);
            acc3 = __builtin_amdgcn_mfma_f32_16x16x4f32(av.w, bv.w, acc3, 0, 0, 0);
        }
        const f32x4 acc = (acc0 + acc1) + (acc2 + acc3);
        wsc[C.lane] = ss;
#pragma unroll
        for (int r = 0; r < 4; ++r) wsc[64 + (4 * kq + r) * 17 + li] = acc[r];
        LDS_WAIT(); asm volatile("" ::: "memory");
        if (C.lane < 16) {
            const int row = row0 + C.lane;
            const float sst = (wsc[C.lane] + wsc[16 + C.lane]) + (wsc[32 + C.lane] + wsc[48 + C.lane]);
            const float rinv = 1.0f / sqrtf(sst * (1.0f / D) + EPS);
            float lg[16];
#pragma unroll
            for (int e = 0; e < 16; ++e) lg[e] = rinv * wsc[64 + C.lane * 17 + e] + bias2[bb * 16 + e];
            float mx = lg[0];
#pragma unroll
            for (int e = 1; e < 16; ++e) mx = fmaxf(mx, lg[e]);
            float sc[16], se = 0.f;
#pragma unroll
            for (int e = 0; e < 16; ++e) { sc[e] = expf(lg[e] - mx); se += sc[e]; }
            float sel[16];
#pragma unroll
            for (int e = 0; e < 16; ++e) { sc[e] = sc[e] / se; sel[e] = sc[e] + rbias[e]; }
            float bestgs = -3.4e38f; int bg = 0; float bs[4], bsc[4];
#pragma unroll
            for (int gg = 0; gg < 4; ++gg) {
                float m1 = -3.4e38f, m2 = -3.4e38f;
#pragma unroll
                for (int i = 0; i < 4; ++i) { const float x = sel[4 * gg + i]; if (x > m1) { m2 = m1; m1 = x; } else if (x > m2) m2 = x; }
                const float gs = m1 + m2;
                if (gs > bestgs) { bestgs = gs; bg = gg;
#pragma unroll
                    for (int i = 0; i < 4; ++i) { bs[i] = sel[4 * gg + i]; bsc[i] = sc[4 * gg + i]; } }
            }
            int i0 = 0; float b0 = bs[0];
#pragma unroll
            for (int i = 1; i < 4; ++i) if (bs[i] > b0) { b0 = bs[i]; i0 = i; }
            int i1 = -1; float b1 = -3.4e38f;
#pragma unroll
            for (int i = 0; i < 4; ++i) if (i != i0 && bs[i] > b1) { b1 = bs[i]; i1 = i; }
            float w0 = 0.f, w1 = 0.f;
#pragma unroll
            for (int i = 0; i < 4; ++i) { if (i == i0) w0 = bsc[i]; if (i == i1) w1 = bsc[i]; }
            const float wn = w0 + w1; w0 /= wn; w1 /= wn;
            const int lo = i0 < i1 ? i0 : i1, hi = i0 < i1 ? i1 : i0;
            const float wlo = i0 < i1 ? w0 : w1, whi = i0 < i1 ? w1 : w0;
            const int bin = bg * 6 + (lo * (7 - lo)) / 2 + (hi - lo - 1);
            const int slot = __hip_atomic_fetch_add(lcnt + bin, 1, __ATOMIC_RELAXED, __HIP_MEMORY_SCOPE_WORKGROUP);
            *(int4*)(tokinfo + (size_t)row * 4) = make_int4(bin, slot, __float_as_int(wlo), __float_as_int(whi));
        }
        LDS_WAIT(); asm volatile("" ::: "memory");
    }
    __syncthreads();
    if (C.tid < NBIN && !C.dry) { const int n = lcnt[C.tid];
        WSP(int, WS_BLKBASE)[C.bid * 32 + C.tid] = n > 0 ? (int)__hip_atomic_fetch_add(cnt + C.tid * 64, (unsigned)n, __ATOMIC_RELAXED, __HIP_MEMORY_SCOPE_AGENT) : 0; }
}
__device__ __forceinline__ void phase_l5b(const Ctx& C, int l) {
    build_tiletab(C, l);
    const volatile LAS int* lc = (const volatile LAS int*)(C.lds + LDSCTL_OFF);
    const int gw = C.bid * NWAVES + C.wave, NGW = C.G * NWAVES;
    const float* mods = WSP(const float, WS_MODS) + (size_t)l * 9 * 6144;
    const float* xb = WSP(const float, WS_XBUF);
    const int* tokinfo = WSP(const int, WS_TOKINFO); const int* blkbase = WSP(const int, WS_BLKBASE);
    bf16_t* hs = WSP(bf16_t, WS_PHG); int* rowtok = WSP(int, WS_ROWTOK); float* roww = WSP(float, WS_ROWW);
    const int nrows = (l < DEPTH - 1) ? NTOK : NLAT;
    f32x4 nv[4]; int4 nti = make_int4(0, 0, 0, 0);
    if (gw < nrows) { nti = *(const int4*)(tokinfo + (size_t)gw * 4);
#pragma unroll
        for (int j = 0; j < 4; ++j) nv[j] = *(const f32x4*)(xb + (size_t)gw * D + C.lane * 4 + 256 * j); }
    for (int row = gw; row < nrows; row += NGW) {
        const int4 ti = nti;
        const int pos = lc[LC_OFFS + ti.x] + blkbase[(((row >> 4) % NGW) >> 3) * 32 + ti.x] + ti.y;
        const float* md = mods + bidx(row) * 6144;
        f32x4 v[4]; float ss = 0.f;
#pragma unroll
        for (int j = 0; j < 4; ++j) v[j] = nv[j];
        if (row + NGW < nrows) { nti = *(const int4*)(tokinfo + (size_t)(row + NGW) * 4);
#pragma unroll
            for (int j = 0; j < 4; ++j) nv[j] = *(const f32x4*)(xb + (size_t)(row + NGW) * D + C.lane * 4 + 256 * j); }
#pragma unroll
        for (int j = 0; j < 4; ++j) ss += (v[j].x * v[j].x + v[j].y * v[j].y) + (v[j].z * v[j].z + v[j].w * v[j].w);
        ss = wave_sum(ss); const float rinv = 1.0f / sqrtf(ss * (1.0f / D) + EPS);
#pragma unroll
        for (int j = 0; j < 4; ++j) { const int k = C.lane * 4 + 256 * j; const f32x4 sh = *(const f32x4*)(md + 3072 + k), sc = *(const f32x4*)(md + 4096 + k);
            const f32x4 o = v[j] * rinv * (sc + 1.0f) + sh; u32x2 w; w.x = pk2(o.x, o.y); w.y = pk2(o.z, o.w);
            *(u32x2*)(hs + (size_t)pos * D + k) = w; }
        if (C.lane == 0) { rowtok[pos] = row; roww[pos * 2] = __int_as_float(ti.z); roww[pos * 2 + 1] = __int_as_float(ti.w); }
    }
    if (C.bid < NBIN) { const int b = C.bid; const int start = lc[LC_OFFS + b], end = lc[LC_OFFS + b + 1];
        const int n = (int)__hip_atomic_load(WSP(unsigned, WS_CTL) + CW_CNT + (l * 32 + b) * 64, __ATOMIC_RELAXED, __HIP_MEMORY_SCOPE_AGENT);
        float zf_ = 0.f; asm volatile("" : "+v"(zf_));
        for (int p = start + n + C.tid; p < end; p += NTHR) { rowtok[p] = -1; roww[p * 2] = zf_; roww[p * 2 + 1] = zf_; } }
}

__device__ __forceinline__ void phase_final(const Ctx& C) {
    const int gw = C.bid * NWAVES + C.wave, NGW = C.G * NWAVES;
    const float* xb = WSP(const float, WS_XBUF); const float* fw = GIN(IN_FNW);
    f32x4 nv[4];
    if (gw < NLAT) {
#pragma unroll
        for (int j = 0; j < 4; ++j) nv[j] = *(const f32x4*)(xb + (size_t)gw * D + C.lane * 4 + 256 * j); }
    for (int row = gw; row < NLAT; row += NGW) {
        f32x4 v[4]; float ss = 0.f;
#pragma unroll
        for (int j = 0; j < 4; ++j) v[j] = nv[j];
        if (row + NGW < NLAT) {
#pragma unroll
            for (int j = 0; j < 4; ++j) nv[j] = *(const f32x4*)(xb + (size_t)(row + NGW) * D + C.lane * 4 + 256 * j); }
#pragma unroll
        for (int j = 0; j < 4; ++j) ss += (v[j].x * v[j].x + v[j].y * v[j].y) + (v[j].z * v[j].z + v[j].w * v[j].w);
        ss = wave_sum(ss); const float rinv = 1.0f / sqrtf(ss * (1.0f / D) + EPS);
#pragma unroll
        for (int j = 0; j < 4; ++j) { const int k = C.lane * 4 + 256 * j; const f32x4 w = *(const f32x4*)(fw + k);
            *(f32x4*)(C.out + (size_t)row * D + k) = v[j] * rinv * w; }
    }
}

constexpr int PH_PER_LAYER = 8, N_PHASES = 2 + DEPTH * PH_PER_LAYER + 1;
__global__ void __launch_bounds__(NTHR, 2) trunk_fwd(Args args) {
    extern __shared__ __attribute__((aligned(16))) unsigned char lds[];
    Ctx C; C.in = (const CAS fptr_t*)__builtin_amdgcn_kernarg_segment_ptr(); C.out = args.out; C.ws = (GAS unsigned char*)args.ws; C.lds = (LAS unsigned char*)lds;
    C.tid = threadIdx.x; C.lane = C.tid & 63; C.wave = __builtin_amdgcn_readfirstlane(C.tid >> 6); C.G = gridDim.x; C.bid = blockIdx.x; C.rep = args.rep; C.dry = (args.rep + 1 < (args.pad & 255)) ? (args.pad >> 8) : 0;
    LAS unsigned char* ldsl0 = (LAS unsigned char*)lds;
    if (C.tid < 64) ((LAS unsigned*)(ldsl0 + LDSCTL_OFF))[C.tid] = 0u;
    __syncthreads();
    const int lo = args.ph_lo, hi = args.ph_hi;
    XcdBarrier bar; bar.bar = WSP(unsigned, WS_CTL) + CW_BAR; bar.x = 0; bar.st = (volatile LAS unsigned*)(ldsl0 + LDSCTL_OFF + LC_BAR);
    if (hi - lo > 1) bar = xcd_barrier_post(WSP(unsigned, WS_CTL) + CW_BAR, (volatile LAS unsigned*)(ldsl0 + LDSCTL_OFF + LC_BAR));
    { unsigned blo_ = __builtin_amdgcn_readfirstlane((unsigned)(unsigned long long)bar.bar), bhi_ = __builtin_amdgcn_readfirstlane((unsigned)((unsigned long long)bar.bar >> 32));
      asm volatile("" : "+s"(blo_), "+s"(bhi_)); bar.bar = (unsigned*)(((unsigned long long)bhi_ << 32) | blo_); }
#define FRESH_TID (C.wave * 64 + lane_id_opaque())
#define IN(k) (lo <= (k) && (k) < hi)
#define CPH(name) Ctx name = C; { int t_ = FRESH_TID; asm volatile("" : "+v"(t_)); name.tid = t_; name.lane = t_ & 63; }
#define SEAM(k) do { if (IN(k) && IN((k) + 1)) xcd_barrier(bar, FRESH_TID); } while (0)
#ifndef EN
#define EN 0xFFFF
#endif
    if ((EN & 1) && IN(0)) { phase0(C); SEAM(0); }
    if ((EN & 1) && IN(1)) {
        {
            const float* md = WSP(const float, WS_MODS); const float* rw = GIN(IN_RW); float* b2 = WSP(float, WS_BIAS2);
            for (int o = C.bid * NWAVES + C.wave; o < 4 * 9 * 16; o += C.G * NWAVES) { const int lr = o >> 4, e = o & 15; const float* sh = md + (size_t)lr * 6144 + 3072; float sacc = 0.f;
#pragma unroll
                for (int j = 0; j < 16; ++j) { const int k = C.lane + 64 * j; sacc += sh[k] * rw[k * 16 + e]; }
                sacc = wave_sum(sacc);
                if (C.lane == 0) b2[o] = sacc; }
        }
        SchedFilt S{C.G, C.bid};
        EpiFilt E{WSP(bf16_t, WS_HF), GIN(IN_B3)};
        pg8::gemm_phase<false>(ldsl0, S, E, (const char*)WSP(bf16_t, WS_W3T), (const char*)WSP(bf16_t, WS_HPAD), 128, 128, 128u * 128u * 2u, 128u * 128u * 2u, 2, FRESH_TID);
        SEAM(1);
    }
    const Ctx C0 = C;
#pragma unroll 1
    for (int l = 0; l < DEPTH; ++l) {
        const int p0 = 2 + l * PH_PER_LAYER;
        Ctx C = C0; { int t_ = C0.wave * 64 + lane_id_opaque(); asm volatile("" : "+v"(t_)); C.tid = t_; C.lane = t_ & 63; C.wave = __builtin_amdgcn_readfirstlane(t_ >> 6);
                      int b_ = C0.bid; asm volatile("" : "+s"(b_)); C.bid = b_; int g_ = C0.G; asm volatile("" : "+s"(g_)); C.G = g_; GAS unsigned char* w_ = C0.ws; asm volatile("" : "+s"(w_)); C.ws = w_;
                      const CAS fptr_t* i_ = C0.in; asm volatile("" : "+s"(i_)); C.in = i_;
                      LAS unsigned char* l_ = C0.lds; asm volatile("" : "+s"(l_)); C.lds = l_; }
        LAS unsigned char* const ldsl = C.lds;
        const float* modl = WSP(const float, WS_MODS) + (size_t)l * 9 * 6144;
        if ((EN & 2) && IN(p0 + 0)) { CPH(CP); phase_l1(CP, l); SEAM(p0 + 0); }
        if ((EN & 4) && IN(p0 + 1)) {
            { pg8::SchedDense S; S.init(NTOK / 256, NHG / 256, C.G, C.bid, D, D);
              EpiHG E{WSP(bf16_t, WS_PHG), WSP(const float, WS_LOWER) + l * 512};
              pg8::gemm_phase<false>(ldsl, S, E, (const char*)WSP(bf16_t, WS_R1), (const char*)(WSP(bf16_t, WS_WIN) + (size_t)NHY * D), D, D, 128u * D * 2u, 128u * D * 2u, D / 64, FRESH_TID); }
            { const int nhg = (NTOK / 256) * (NHG / 256), rem = nhg % C.G, nfree = rem ? C.G - rem : 0;
              if (nfree && C.bid >= rem) { pg8::SchedDense S; S.init(NHY / 256, NTOK / 256, C.G, C.bid, D, D); S.range(C.bid - rem, 1 << 20, nfree);
                EpiHY E{WSP(bf16_t, WS_PHYT)};
                pg8::gemm_phase<false>(ldsl, S, E, (const char*)WSP(bf16_t, WS_WIN), (const char*)WSP(bf16_t, WS_R1), D, D, 128u * D * 2u, 128u * D * 2u, D / 64, FRESH_TID); } }
            SEAM(p0 + 1);
        }
        if ((EN & 8) && IN(p0 + 2)) {
            const int nhg = (NTOK / 256) * (NHG / 256), rem = nhg % C.G, nfree = rem ? C.G - rem : 0, nhy = (NHY / 256) * (NTOK / 256);
            unsigned* hyd = WSP(unsigned, WS_CTL) + CW_HYD + l * 64 + C.rep * 16;
            if (C.bid >= 64) {
                pg8::SchedDense S; S.init(NHY / 256, NTOK / 256, C.G, C.bid, D, D); S.range((nfree < nhy ? nfree : nhy) + (C.bid - 64), C.G - 64, nhy);
                EpiHY E{WSP(bf16_t, WS_PHYT)};
                pg8::gemm_phase<false>(ldsl, S, E, (const char*)WSP(bf16_t, WS_WIN), (const char*)WSP(bf16_t, WS_R1), D, D, 128u * D * 2u, 128u * D * 2u, D / 64, FRESH_TID);
                asm volatile("s_waitcnt vmcnt(0)" ::: "memory");
                __syncthreads();
                if (C.wave * 64 + lane_id_opaque() == 0) { __builtin_amdgcn_fence(__ATOMIC_RELEASE, "agent"); asm volatile("s_waitcnt vmcnt(0)" ::: "memory");
                    __hip_atomic_fetch_add(hyd, 1u, __ATOMIC_RELAXED, __HIP_MEMORY_SCOPE_AGENT); }
            }
            { CPH(CP); phase_l3(CP, l, hyd); }
            SEAM(p0 + 2);
        }
        if ((EN & 16) && IN(p0 + 3)) { CPH(CP); phase_l3b(CP, l); SEAM(p0 + 3); }
        if ((EN & 32) && IN(p0 + 4)) {
            pg8::SchedDense S; S.init(NTOK / 256, D / 256, C.G, C.bid, D, D);
            EpiOut E{GIN(IN_X), GIN(IN_CTX), WSP(float, WS_XBUF), modl, l == 0 ? 1 : 0, C.dry};
            pg8::gemm_phase<false>(ldsl, S, E, (const char*)WSP(bf16_t, WS_R1), (const char*)WSP(bf16_t, WS_WOUT), D, D, 128u * D * 2u, 128u * D * 2u, D / 64, FRESH_TID);
            SEAM(p0 + 4);
        }
        if ((EN & 64) && IN(p0 + 5)) { CPH(CP); phase_l5a(CP, l); SEAM(p0 + 5); }
        if ((EN & 128) && IN(p0 + 6)) { CPH(CP); phase_l5b(CP, l); SEAM(p0 + 6); }
        if ((EN & 256) && IN(p0 + 7)) {
            { CPH(CP); build_tiletab(CP, l); }
            const volatile LAS int* lc = (const volatile LAS int*)(ldsl + LDSCTL_OFF);
            const int n6 = 4 * lc[LC_T];
            unsigned* cnt6 = WSP(unsigned, WS_CTL) + CW_T6 + l * 96 * 64;
#pragma unroll 1
            for (int idx = C.bid; idx < n6; idx += C.G) {
                SchedUp1 S{idx, lc + LC_TILEBIN};
                EpiAct E{WSP(bf16_t, WS_R1), WSP(const float, WS_ROWW)};
                pg8::gemm_phase<false>(ldsl, S, E, (const char*)WSP(bf16_t, WS_PHG), (const char*)WSP(bf16_t, WS_WG), D, D, 128u * D * 2u, (unsigned)(WS_WU - WS_WG), D / 64, FRESH_TID);
                asm volatile("s_waitcnt vmcnt(0)" ::: "memory");
                __syncthreads();
                if (C.wave * 64 + lane_id_opaque() == 0) {
                    __hip_atomic_fetch_add(cnt6 + (idx >> 2) * 64, 1u, __ATOMIC_RELAXED, __HIP_MEMORY_SCOPE_AGENT); }
            }
            int nb2 = n6 - C.G; nb2 = nb2 < 0 ? 0 : (nb2 > C.G - 64 ? C.G - 64 : nb2);
            const int nw = C.G - nb2;
            if (C.bid >= nb2) {
#pragma unroll 1
                for (int j = C.bid - nb2; j < n6; j += nw) {
                    if (C.wave * 64 + lane_id_opaque() == 0) { unsigned* cw = cnt6 + (j >> 2) * 64; unsigned sp = 0;
                        while (__hip_atomic_load(cw, __ATOMIC_RELAXED, __HIP_MEMORY_SCOPE_AGENT) < 4u) { __builtin_amdgcn_s_sleep(2); if (++sp > (1u << 22)) break; }
                        __builtin_amdgcn_fence(__ATOMIC_ACQUIRE, "agent"); asm volatile("s_waitcnt vmcnt(0)" ::: "memory"); }
                    __syncthreads();
                    SchedDown1 S{j, lc + LC_TILEBIN};
                    EpiDown E{WSP(float, WS_XBUF), WSP(const int, WS_ROWTOK), modl, C.dry};
                    pg8::gemm_phase<true>(ldsl, S, E, (const char*)WSP(bf16_t, WS_R1), (const char*)WSP(bf16_t, WS_WD), 512, 256, 128u * 512u * 2u, 128u * 256u * 2u, 4, FRESH_TID);
                }
            }
            SEAM(p0 + 7);
        }
    }
    if ((EN & 1024) && IN(N_PHASES - 1)) { Ctx CF = C0; CF.tid = C0.wave * 64 + lane_id_opaque(); CF.lane = CF.tid & 63; phase_final(CF); }
#undef IN
#undef SEAM
}

extern "C" void kernel_launch(void* const* d_in, const int* in_sizes, int n_in, void* d_out, int out_size, void* d_ws, size_t ws_size, hipStream_t stream) {
    static int grid = 0;
    if (grid == 0) {
        if (n_in != N_IN || in_sizes[0] != NLAT * D || out_size != NLAT * D || ws_size < WS_END) { fprintf(stderr, "kernel_launch: unexpected shapes / workspace (%d inputs, ws %zu < %zu)\n", n_in, ws_size, (size_t)WS_END); grid = -1; return; }
        int dev = 0, cus = 0, per_cu = 0;
        if (hipGetDevice(&dev) != hipSuccess || hipDeviceGetAttribute(&cus, hipDeviceAttributeMultiprocessorCount, dev) != hipSuccess) { grid = -1; return; }
        if (hipFuncSetAttribute((const void*)trunk_fwd, hipFuncAttributeMaxDynamicSharedMemorySize, LDS_BYTES) != hipSuccess) { fprintf(stderr, "kernel_launch: hipFuncSetAttribute failed\n"); grid = -1; return; }
        if (hipOccupancyMaxActiveBlocksPerMultiprocessor(&per_cu, (const void*)trunk_fwd, NTHR, LDS_BYTES) != hipSuccess || per_cu < 1) { fprintf(stderr, "kernel_launch: occupancy query says %d\n", per_cu); }
        (void)hipGetLastError();
        grid = cus;
    }
    if (grid < 0) return;
    (void)hipMemsetAsync((char*)d_ws + WS_CTL, 0, CTL_ZERO_BYTES, stream);
    Args a{};
    for (int i = 0; i < N_IN; ++i) a.in[i] = (const float*)d_in[i];
    a.out = (float*)d_out; a.ws = (unsigned char*)d_ws;
#if MK_PER_PHASE
    for (int p = 0; p < N_PHASES; ++p) { a.ph_lo = p; a.ph_hi = p + 1; const int kind = p == 0 ? 0 : (p == 1 ? 11 : (p == N_PHASES - 1 ? 10 : 1 + (p - 2) % PH_PER_LAYER));
        const int nrep = ((PROBE_HOST >> kind) & 1) ? 2 : 1; a.pad = nrep | (PROBE_SKIP << 8);
        for (int rep = 0; rep < nrep; ++rep) { a.rep = rep; hipLaunchKernelGGL(trunk_fwd, dim3(grid), dim3(NTHR), LDS_BYTES, stream, a); } }
#else
    a.ph_lo = 0; a.ph_hi = N_PHASES; a.rep = 0; a.pad = 1;
    hipLaunchKernelGGL(trunk_fwd, dim3(grid), dim3(NTHR), LDS_BYTES, stream, a);
#endif
}
```

```cpp
#include <hip/hip_runtime.h>
#include <cstdio>
#include <cstdint>

#ifndef PROBE_HOST
#define PROBE_HOST 0
#endif
#ifndef PROBE_SKIP
#define PROBE_SKIP 1
#endif
#ifndef MK_PER_PHASE
#define MK_PER_PHASE 0
#endif

#define LAS __attribute__((address_space(3)))
#define GAS __attribute__((address_space(1)))
typedef unsigned short bf16_t;
typedef short bf16x8 __attribute__((ext_vector_type(8)));
typedef float f32x4 __attribute__((ext_vector_type(4)));
typedef float f32x2 __attribute__((ext_vector_type(2)));
typedef unsigned u32x4 __attribute__((ext_vector_type(4)));
typedef unsigned u32x2 __attribute__((ext_vector_type(2)));

constexpr int NB = 8, SEQ = 2048, D = 1024, DEPTH = 4, CTXL = 256;
constexpr int NLAT = NB * SEQ, NCTX = NB * CTXL, NTOK = NLAT + NCTX;
constexpr int DH = 512, NHY = 1536, NHG = 2560, DIN = 4096;
constexpr int NE = 16, DE = 256, NBIN = 24, SROWS = 24576;
constexpr float EPS = 1e-6f;
constexpr int NTHR = 512, NWAVES = 8;
enum { IN_X = 0, IN_C, IN_CTX, IN_CCTX, IN_WMOD, IN_BMOD, IN_WIN, IN_WOUT, IN_CONVW, IN_CONVB, IN_W1, IN_B1, IN_W2, IN_B2, IN_W3, IN_B3,
       IN_HYBIAS, IN_LB, IN_NORMW, IN_RW, IN_RB, IN_WG, IN_WU, IN_WD, IN_FNW, N_IN };

constexpr size_t MiB = 1u << 20;
constexpr size_t WS_CTL = 0, CTL_ZERO_BYTES = 384 * 1024;
static_assert((size_t)(65536 + 4 * 96 * 64) * 4 <= CTL_ZERO_BYTES, "control words fit the zeroed region");
constexpr size_t WS_MODS = 1 * MiB;
constexpr size_t WS_LOWER = 2 * MiB;
constexpr size_t WS_BIAS2 = 2 * MiB + 64 * 1024;
constexpr size_t WS_HPAD = 3 * MiB;
constexpr size_t WS_TOKINFO = 6 * MiB;
constexpr size_t WS_BLKBASE = 6 * MiB + 320 * 1024;
constexpr size_t WS_ROWTOK = 6 * MiB + 512 * 1024;
constexpr size_t WS_ROWW = 7 * MiB;
constexpr size_t WS_WIN = 8 * MiB;
constexpr size_t WS_WOUT = 16 * MiB;
constexpr size_t WS_WG = 18 * MiB;
constexpr size_t WS_WU = 26 * MiB;
constexpr size_t WS_WD = 34 * MiB;
constexpr size_t WS_KSPEC = 42 * MiB;
constexpr size_t WS_XBUF = 74 * MiB;
constexpr size_t WS_R1 = 146 * MiB;
constexpr size_t WS_PHG = 182 * MiB;
constexpr size_t WS_PHYT = 272 * MiB;
constexpr size_t WS_ODIR = 326 * MiB;
constexpr size_t WS_KSPC = 362 * MiB;
constexpr size_t WS_W3T = 378 * MiB;
constexpr size_t WS_HF = 380 * MiB;
constexpr size_t WS_END = 416 * MiB;
constexpr int CW_BAR = 4096;
constexpr int CW_CNT = 16384;
constexpr int CW_T6 = 65536;
constexpr int CW_HYD = 40960;
constexpr int CW_L4 = 45056;
constexpr int CW_Q = 32768;

constexpr int LDS_BYTES = 147456;
constexpr int LDSCTL_OFF = 143 * 1024;
constexpr int LC_BAR = 0;
constexpr int LC_T = 8;
constexpr int LC_Q = 9;
constexpr int LC_OFFS = 16;
constexpr int LC_TILEBIN = 48;

__device__ __forceinline__ unsigned f2bf(float f) { return (unsigned)__builtin_bit_cast(unsigned short, (__bf16)f); }
typedef __bf16 bf16x2v __attribute__((ext_vector_type(2)));
__device__ __forceinline__ unsigned pk2(float lo, float hi) { const f32x2 v = {lo, hi}; return __builtin_bit_cast(unsigned, __builtin_convertvector(v, bf16x2v)); }
__device__ __forceinline__ float bf2f(unsigned b) { return __builtin_bit_cast(float, (b & 0xffffu) << 16); }
__device__ __forceinline__ float bflo(unsigned w) { return __builtin_bit_cast(float, w << 16); }
__device__ __forceinline__ float bfhi(unsigned w) { return __builtin_bit_cast(float, w & 0xffff0000u); }
__device__ __forceinline__ f32x4 bf4_to_f32(u32x2 w) { return (f32x4){bflo(w.x), bfhi(w.x), bflo(w.y), bfhi(w.y)}; }
__device__ __forceinline__ u32x2 f32_to_bf4(f32x4 v) { u32x2 w; w.x = pk2(v.x, v.y); w.y = pk2(v.z, v.w); return w; }
__device__ __forceinline__ float sigmoidf_(float x) { return __builtin_amdgcn_rcpf(1.0f + __expf(-x)); }
__device__ __forceinline__ float siluf_(float x) { return x * __builtin_amdgcn_rcpf(1.0f + __expf(-x)); }
#define DPP_ADD(v, ctrl, rmask) v += __builtin_bit_cast(float, __builtin_amdgcn_update_dpp(0, __builtin_bit_cast(int, v), ctrl, rmask, 0xF, false))
__device__ __forceinline__ float row16_sum(float v) {
    DPP_ADD(v, 0xB1, 0xF);
    DPP_ADD(v, 0x4E, 0xF);
    DPP_ADD(v, 0x141, 0xF);
    DPP_ADD(v, 0x140, 0xF);
    return v;
}
__device__ __forceinline__ float wave_sum(float v) {
    v = row16_sum(v);
    DPP_ADD(v, 0x142, 0xA);
    DPP_ADD(v, 0x143, 0xC);
    return __builtin_bit_cast(float, __builtin_amdgcn_readlane(__builtin_bit_cast(int, v), 63));
}
__device__ __forceinline__ int lane_id_opaque() { int x; asm volatile("v_mbcnt_lo_u32_b32 %0, -1, 0\n\tv_mbcnt_hi_u32_b32 %0, -1, %0" : "=v"(x)); return x; }
__device__ __forceinline__ int bidx(int row) { return row < NLAT ? (row >> 11) : 8; }
#define LDS_WAIT() asm volatile("s_waitcnt lgkmcnt(0)" ::: "memory")

#define XB_TMO      128
#define XB_XCNT(j)  (256  + 64 * (j))
#define XB_XSUB(j)  (1280 + 64 * (j))
#define XB_XGEN(j)  (2304 + 64 * (j))
#define XB_TOP      3328
#define XB_TOPGEN   3392
#define XCD_BAR_WORDS 3456
#define XB_SPIN_CAP (1u << 18)
__device__ __forceinline__ unsigned xb_ld(unsigned* p)              { return __hip_atomic_load(p, __ATOMIC_RELAXED, __HIP_MEMORY_SCOPE_AGENT); }
__device__ __forceinline__ unsigned xb_add(unsigned* p, unsigned v) { return __hip_atomic_fetch_add(p, v, __ATOMIC_RELAXED, __HIP_MEMORY_SCOPE_AGENT); }
__device__ __forceinline__ unsigned xb_xcc_id() { return (unsigned)__builtin_amdgcn_s_getreg((3 << 11) | 20) & 0xFu; }
#define XB_SPIN(cond, bar) do { unsigned _sp = 0; while (cond) { __builtin_amdgcn_s_sleep(1); \
    if ((++_sp & 255u) == 0u) { if (xb_ld(&(bar)[XB_TMO])) break; if (_sp > XB_SPIN_CAP) { atomicAdd(&(bar)[XB_TMO], 1u); break; } } } } while (0)
struct XcdBarrier { unsigned* bar; unsigned x; volatile LAS unsigned* st; };
__device__ __forceinline__ XcdBarrier xcd_barrier_post(unsigned* bar, volatile LAS unsigned* st) {
    XcdBarrier b; b.bar = bar; b.x = xb_xcc_id(); b.st = st;
    if (threadIdx.x == 0) (void)xb_add(&bar[XB_XCNT(b.x)], 1u);
    return b;
}
__device__ __forceinline__ void xcd_barrier_complete(unsigned* bar, unsigned x, unsigned& nloc, unsigned& nx) {
    const unsigned G = gridDim.x * gridDim.y * gridDim.z;
    unsigned sum, cnt, mine, sp = 0u;
    for (;;) {
        sum = 0u; cnt = 0u; mine = 0u;
#pragma unroll
        for (unsigned j = 0; j < 16; ++j) { const unsigned c = xb_ld(&bar[XB_XCNT(j)]); sum += c; cnt += (c > 0u) ? 1u : 0u; mine = (j == x) ? c : mine; }
        if (sum == G) break;
        __builtin_amdgcn_s_sleep(1);
        if ((++sp & 255u) == 0u) { if (xb_ld(&bar[XB_TMO])) break; if (sp > XB_SPIN_CAP) { atomicAdd(&bar[XB_TMO], 1u); break; } }
    }
    nloc = mine > 0u ? mine : 1u; nx = cnt > 0u ? cnt : 1u;
}
__device__ __forceinline__ void xcd_barrier(const XcdBarrier& b, const int tid0) {
    asm volatile("s_waitcnt vmcnt(0)" ::: "memory");
    __syncthreads();
    if (tid0 == 0) {
        unsigned bx = b.x; unsigned blo_ = __builtin_amdgcn_readfirstlane((unsigned)(unsigned long long)b.bar), bhi_ = __builtin_amdgcn_readfirstlane((unsigned)((unsigned long long)b.bar >> 32));
        asm volatile("" : "+s"(blo_), "+s"(bhi_), "+s"(bx));
        unsigned* bar = (unsigned*)(((unsigned long long)bhi_ << 32) | blo_);
        __builtin_amdgcn_s_waitcnt(0);
        unsigned nloc = b.st[0], nx = b.st[1];
        if (nloc == 0u) { xcd_barrier_complete(bar, bx, nloc, nx); b.st[0] = nloc; b.st[1] = nx; }
        const unsigned old = xb_add(&bar[XB_XSUB(bx)], 1u);
        const unsigned gen = old / nloc;
        if (old + 1u == (gen + 1u) * nloc) {
            __builtin_amdgcn_fence(__ATOMIC_RELEASE, "agent");
            asm volatile("s_waitcnt vmcnt(0)" ::: "memory");
            const unsigned og = xb_add(&bar[XB_TOP], 1u);
            const unsigned target = (gen + 1u) * nx;
            if (og + 1u < target) XB_SPIN(xb_ld(&bar[XB_TOP]) < target, bar);
            __builtin_amdgcn_fence(__ATOMIC_ACQUIRE, "agent");
            asm volatile("s_waitcnt vmcnt(0)" ::: "memory");
        } else {
            const unsigned target = (gen + 1u) * nx;
            XB_SPIN(xb_ld(&bar[XB_TOP]) < target, bar);
            __builtin_amdgcn_fence(__ATOMIC_ACQUIRE, "agent");
            asm volatile("s_waitcnt vmcnt(0)" ::: "memory");
        }
    }
    __syncthreads();
}

namespace pg8 {
constexpr int BM = 256, BK = 64, HALF = 128, HTB = HALF * BK * 2, STAGE_BYTES = 8 * HTB, NXCD = 8, WGM = 8;
__host__ __device__ __forceinline__ int lds_byte(int r, int c) { const int st = (r >> 4) * 2 + (c >> 5), rr = r & 15, cc = c & 31, ob = rr * 64 + cc * 2; return st * 1024 + (ob ^ (((ob >> 9) & 1) << 5)); }
__host__ __device__ __forceinline__ void stage_rc(int b, int& R, int& C) { const int st = b / 1024, sb = b % 1024, swz = sb ^ (((sb >> 9) & 1) << 5); R = (st >> 1) * 16 + swz / 64; C = (st & 1) * 32 + (swz % 64) / 2; }
__host__ __device__ __forceinline__ int perm32(int rho) { const int n = rho >> 4, i = rho & 15; return 8 * (i >> 2) + 4 * n + (i & 3); }

struct GUnit { unsigned a, b; int last, i0, i1; };

template <bool SUB, class Epi, class Sched>
__device__ __forceinline__ void gemm_phase(LAS unsigned char* lds, const Sched& S, const Epi& E, const char* Abase, const char* Bbase, const int lda, const int ldb, const unsigned ahalf, const unsigned bhalf, const int nt, const int tid_in) {
    int tid_ = tid_in; asm volatile("" : "+v"(tid_));
    const int tid = tid_, wid = __builtin_amdgcn_readfirstlane(tid >> 6), lane = tid & 63, wr = wid >> 2, wc = wid & 3, fr = lane & 15, fq = lane >> 4;
    unsigned voffA[2], voffB[2];
#pragma unroll
    for (int i = 0; i < 2; ++i) { int R, C; stage_rc(tid * 16 + i * 8192, R, C); const int Rb = Epi::PERM ? ((R & ~31) + perm32(R & 31)) : R;
        voffA[i] = (unsigned)(R * lda + C) * 2u; voffB[i] = (unsigned)(Rb * ldb + C) * 2u; }
    constexpr unsigned kstep = BK * 2;
    const unsigned ldsw = (unsigned)wid * 1024u;
    const int aoff = lds_byte(wr * 64 + fr, fq * 8), boff = lds_byte(wc * 32 + fr, fq * 8);
#define PG8_SA(b, h) (((b) * 2 + (h)) * HTB)
#define PG8_SB(b, h) ((4 + (b) * 2 + (h)) * HTB)
#define PG8_STAGE(bufoff, gbase, voff) do { _Pragma("unroll") for (int _i = 0; _i < 2; ++_i) \
        __builtin_amdgcn_global_load_lds((const unsigned*)((const char*)(gbase) + (voff)[_i]), (LAS unsigned*)(lds + (bufoff) + ldsw + _i * 8192), 16, 0, 0); } while (0)
#define PG8_LDA(dst, b, h) do { _Pragma("unroll") for (int m = 0; m < 4; ++m) _Pragma("unroll") for (int k = 0; k < 2; ++k) dst[m][k] = *(const LAS bf16x8*)(lds + PG8_SA(b, h) + aoff + m * 2048 + k * 1024); } while (0)
#define PG8_LDB(dst, b, h) do { _Pragma("unroll") for (int n = 0; n < 2; ++n) _Pragma("unroll") for (int k = 0; k < 2; ++k) dst[n][k] = *(const LAS bf16x8*)(lds + PG8_SB(b, h) + boff + n * 2048 + k * 1024); } while (0)
#define PG8_MMA(ai, bj, At, Bt) do { __builtin_amdgcn_s_setprio(1); _Pragma("unroll") for (int m = 0; m < 4; ++m) _Pragma("unroll") for (int n = 0; n < 2; ++n) _Pragma("unroll") for (int k = 0; k < 2; ++k) \
        acc[ai][bj][m][n] = __builtin_amdgcn_mfma_f32_16x16x32_bf16(Bt[n][k], At[m][k], acc[ai][bj][m][n], 0, 0, 0); __builtin_amdgcn_s_setprio(0); } while (0)
#define PG8_WAIT_V(n) asm volatile("s_waitcnt vmcnt(" #n ")" ::: "memory")
#define PG8_WAIT_L(n) asm volatile("s_waitcnt lgkmcnt(" #n ")" ::: "memory")
#define PG8_BAR __builtin_amdgcn_s_barrier()
#define PG8_SCHED __builtin_amdgcn_sched_barrier(0)
    GUnit cur, nxt; int ui = 0;
    if (!S.next(0, cur)) return;
    f32x4 acc[2][2][4][2];
    float zf_ = 0.f; asm volatile("" : "+v"(zf_));
#pragma unroll
    for (int a = 0; a < 2; ++a)
#pragma unroll
        for (int b = 0; b < 2; ++b)
#pragma unroll
            for (int m = 0; m < 4; ++m)
#pragma unroll
                for (int n = 0; n < 2; ++n) acc[a][b][m][n] = (f32x4){zf_, zf_, zf_, zf_};
    bf16x8 At[4][2], B0[2][2], B1[2][2];
    { const char* cA = Abase + cur.a; const char* cB = Bbase + cur.b;
      PG8_STAGE(PG8_SB(0, 0), cB, voffB); PG8_STAGE(PG8_SB(0, 1), cB + bhalf, voffB); PG8_STAGE(PG8_SA(0, 0), cA, voffA); PG8_STAGE(PG8_SA(0, 1), cA + ahalf, voffA);
      if (wr == 1) PG8_BAR;
      PG8_WAIT_V(2); PG8_BAR;
      PG8_STAGE(PG8_SB(1, 0), cB + kstep, voffB); PG8_STAGE(PG8_SA(1, 0), cA + kstep, voffA); PG8_STAGE(PG8_SB(1, 1), cB + bhalf + kstep, voffB);
      PG8_WAIT_V(6); PG8_BAR; }
    for (;;) {
        const bool has_next = S.next(ui + 1, nxt);
        const char* cA = Abase + cur.a; const char* cB = Bbase + cur.b;
        const char* nA = Abase + (has_next ? nxt.a : cur.a); const char* nB = Bbase + (has_next ? nxt.b : cur.b);
        for (int t = 0; t < nt; t += 2) {
            const bool last = (t == nt - 2);
            const char* a1 = cA + (unsigned)(t + 1) * kstep;
            const char* a2 = last ? nA : cA + (unsigned)(t + 2) * kstep; const char* b2 = last ? nB : cB + (unsigned)(t + 2) * kstep;
            const char* a3 = a2 + kstep; const char* b3 = b2 + kstep;
            PG8_LDB(B0, 0, 0); PG8_LDB(B1, 0, 1); PG8_SCHED; PG8_LDA(At, 0, 0); PG8_STAGE(PG8_SA(1, 1), a1 + ahalf, voffA);
            PG8_WAIT_V(8); PG8_WAIT_L(0); PG8_BAR; PG8_MMA(0, 0, At, B0); PG8_MMA(0, 1, At, B1); PG8_BAR; PG8_SCHED;
            PG8_LDA(At, 0, 1); PG8_STAGE(PG8_SB(0, 0), b2, voffB); PG8_STAGE(PG8_SB(0, 1), b2 + bhalf, voffB); PG8_STAGE(PG8_SA(0, 0), a2, voffA);
            PG8_WAIT_V(8); PG8_WAIT_L(0); PG8_BAR; PG8_MMA(1, 0, At, B0); PG8_MMA(1, 1, At, B1); PG8_BAR; PG8_SCHED;
            PG8_LDB(B0, 1, 0); PG8_LDB(B1, 1, 1); PG8_SCHED; PG8_LDA(At, 1, 0); PG8_STAGE(PG8_SA(0, 1), a2 + ahalf, voffA);
            PG8_WAIT_V(8); PG8_WAIT_L(0); PG8_BAR; PG8_MMA(0, 0, At, B0); PG8_MMA(0, 1, At, B1); PG8_BAR; PG8_SCHED;
            PG8_LDA(At, 1, 1); PG8_STAGE(PG8_SB(1, 0), b3, voffB); PG8_STAGE(PG8_SB(1, 1), b3 + bhalf, voffB); PG8_STAGE(PG8_SA(1, 0), a3, voffA);
            PG8_WAIT_V(8); PG8_WAIT_L(0); PG8_BAR; PG8_MMA(1, 0, At, B0); PG8_MMA(1, 1, At, B1); PG8_BAR; PG8_SCHED;
        }
        const bool fin = SUB ? (cur.last != 0) : true;
        if (fin) { if (wr == 0) PG8_BAR; E(acc, cur, wr, wc, fr, fq); }
        if (!has_next) break;
        if (fin) {
#pragma unroll
            for (int a = 0; a < 2; ++a)
#pragma unroll
                for (int b = 0; b < 2; ++b)
#pragma unroll
                    for (int m = 0; m < 4; ++m)
#pragma unroll
                        for (int n = 0; n < 2; ++n) acc[a][b][m][n] = (f32x4){zf_, zf_, zf_, zf_};
        }
        cur = nxt; ++ui;
        if (fin) { if (wr == 1) PG8_BAR; }
    }
    PG8_WAIT_V(0);
    PG8_BAR;
#undef PG8_SA
#undef PG8_SB
#undef PG8_STAGE
#undef PG8_LDA
#undef PG8_LDB
#undef PG8_MMA
#undef PG8_WAIT_V
#undef PG8_WAIT_L
#undef PG8_BAR
#undef PG8_SCHED
}

struct SchedOne {
    int pm, pn; unsigned atile, btile;
    __device__ __forceinline__ bool next(int i, GUnit& u) const { if (i != 0) return false; u.a = (unsigned)pm * atile; u.b = (unsigned)pn * btile; u.last = 1; u.i0 = pm; u.i1 = pn; return true; }
};
struct SchedDense {
    int nM, nN, nwg, G, c, lend; unsigned atile, btile;
    __device__ __forceinline__ void init(int nM_, int nN_, int G_, int c_, int lda, int ldb) {
        nM = nM_; nN = nN_; nwg = nM * nN; G = G_; c = c_; lend = nwg; atile = 256u * lda * 2u; btile = 256u * ldb * 2u; }
    __device__ __forceinline__ void range(int first, int stride, int end) { c = first; G = stride; lend = end < nwg ? end : nwg; }
    __device__ __forceinline__ bool next(int i, GUnit& u) const {
        const int L = i * G + c; if (L >= lend) return false;
        int wgid = L; { const int q = nwg / NXCD, r = nwg % NXCD, xcd = wgid % NXCD, off = wgid / NXCD; wgid = (xcd < r ? xcd * (q + 1) : r * (q + 1) + (xcd - r) * q) + off; }
        const int nig = WGM * nN, gid = wgid / nig, fm = gid * WGM, gsz = (nM - fm) < WGM ? (nM - fm) : WGM;
        const int pm = fm + ((wgid % nig) % gsz), pn = (wgid % nig) / gsz;
        u.a = (unsigned)pm * atile; u.b = (unsigned)pn * btile; u.last = 1; u.i0 = pm; u.i1 = pn; return true;
    }
};
}

struct Args { const float* in[N_IN]; float* out; unsigned char* ws; int ph_lo, ph_hi, rep, pad; };
static_assert(sizeof(Args) == N_IN * 8 + 8 + 8 + 16, "Args has no padding");

#define CAS __attribute__((address_space(4)))
typedef const float* fptr_t;
struct Ctx {
    const CAS fptr_t* in; float* out; GAS unsigned char* ws; LAS unsigned char* lds; int tid, lane, wave, G, bid, rep, dry;
};
#define WSP(T, off) ((T*)(GAS T*)(C.ws + (off)))
#define GIN(k) ((const float*)(const GAS float*)C.in[k])

__device__ __forceinline__ void build_tiletab(const Ctx& C, int l) {
    volatile LAS int* lc = (volatile LAS int*)(C.lds + LDSCTL_OFF);
    __syncthreads();
    { const unsigned* cnt = WSP(const unsigned, WS_CTL) + CW_CNT + l * 32 * 64;
      if (C.tid < NBIN) lc[LC_OFFS + C.tid] = ((int)__hip_atomic_load(cnt + C.tid * 64, __ATOMIC_RELAXED, __HIP_MEMORY_SCOPE_AGENT) + 255) >> 8; }
    __syncthreads();
    if (C.tid == 0) {
        int off = 0, t = 0;
        for (int b = 0; b < NBIN; ++b) {
            const int nt = lc[LC_OFFS + b];
            lc[LC_OFFS + b] = off;
            for (int k = 0; k < nt; ++k) lc[LC_TILEBIN + t + k] = b;
            t += nt; off += nt * 256;
        }
        lc[LC_OFFS + NBIN] = off; lc[LC_T] = t;
    }
    __syncthreads();
}
__device__ __forceinline__ int expert_of(int bin, int es) {
    const int g = bin / 6, p = bin - g * 6;
    const int lo = p < 3 ? 0 : (p < 5 ? 1 : 2), hi = p < 3 ? p + 1 : (p < 5 ? p - 1 : 3);
    return 4 * g + (es ? hi : lo);
}

struct SchedUp {
    int T, G, c; const volatile LAS int* tilebin;
    __device__ __forceinline__ bool next(int i, pg8::GUnit& u) const {
        const int idx = i * G + c; if (idx >= 4 * T) return false;
        const int rt = idx >> 2, q = idx & 3, es = q >> 1, fb = q & 1;
        const int bin = __builtin_amdgcn_readfirstlane(tilebin[rt]);
        const int e = expert_of(bin, es);
        u.a = (unsigned)rt * 256u * 2048u; u.b = (unsigned)(e * 256 + fb * 128) * 2048u;
        u.last = 1; u.i0 = rt; u.i1 = q; return true;
    }
};
struct SchedDown {
    int T, G, c; const volatile LAS int* tilebin;
    __device__ __forceinline__ bool next(int i, pg8::GUnit& u) const {
        const int idx = (i >> 1) * G + c, sub = i & 1; if (idx >= 4 * T) return false;
        const int rt = idx >> 2, pn = idx & 3;
        const int bin = __builtin_amdgcn_readfirstlane(tilebin[rt]);
        const int e = expert_of(bin, sub);
        u.a = (unsigned)rt * 256u * 1024u + (unsigned)sub * 512u; u.b = (unsigned)(e * 1024 + pn * 256) * 512u;
        u.last = sub; u.i0 = rt; u.i1 = pn; return true;
    }
};

struct SchedUp1 {
    int idx; const volatile LAS int* tilebin;
    __device__ __forceinline__ bool next(int i, pg8::GUnit& u) const {
        if (i != 0) return false;
        const int rt = idx >> 2, q = idx & 3, es = q >> 1, fb = q & 1;
        const int bin = __builtin_amdgcn_readfirstlane(tilebin[rt]);
        const int e = expert_of(bin, es);
        u.a = (unsigned)rt * 256u * 2048u; u.b = (unsigned)(e * 256 + fb * 128) * 2048u;
        u.last = 1; u.i0 = rt; u.i1 = q; return true;
    }
};
struct SchedDown1 {
    int idx; const volatile LAS int* tilebin;
    __device__ __forceinline__ bool next(int i, pg8::GUnit& u) const {
        if (i > 1) return false;
        const int sub = i, rt = idx >> 2, pn = idx & 3;
        const int bin = __builtin_amdgcn_readfirstlane(tilebin[rt]);
        const int e = expert_of(bin, sub);
        u.a = (unsigned)rt * 256u * 1024u + (unsigned)sub * 512u; u.b = (unsigned)(e * 1024 + pn * 256) * 512u;
        u.last = sub; u.i0 = rt; u.i1 = pn; return true;
    }
};

struct EpiHG {
    static constexpr bool PERM = true;
    bf16_t* O; const float* lower;
    __device__ __forceinline__ void operator()(const f32x4 (&acc)[2][2][4][2], const pg8::GUnit& u, int wr, int wc, int fr, int fq) const {
        const int kind = u.i1 >> 1;
        const int row0 = u.i0 * 256 + wr * 64 + fr, colt = u.i1 * 256 + wc * 32 + 8 * fq;
#pragma unroll
        for (int bj = 0; bj < 2; ++bj) {
            const int col = colt + bj * 128;
            float om[8];
#pragma unroll
            for (int j = 0; j < 8; ++j) om[j] = 1.f;
            if (kind >= 3) { const float* lb = lower + (kind - 3) * 2048 + (col & 511);
#pragma unroll
                for (int j = 0; j < 8; ++j) om[j] = 1.f - lb[j]; }
#pragma unroll
            for (int ai = 0; ai < 2; ++ai)
#pragma unroll
                for (int m = 0; m < 4; ++m) {
                    float v[8];
#pragma unroll
                    for (int j = 0; j < 8; ++j) v[j] = acc[ai][bj][m][j >> 2][j & 3];
                    if (kind == 0) {
#pragma unroll
                        for (int j = 0; j < 8; ++j) v[j] = siluf_(v[j]);
                    } else if (kind >= 3) {
#pragma unroll
                        for (int j = 0; j < 8; ++j) v[j] = om[j] * sigmoidf_(-v[j]);
                    }
                    u32x4 w; w.x = pk2(v[0], v[1]); w.y = pk2(v[2], v[3]); w.z = pk2(v[4], v[5]); w.w = pk2(v[6], v[7]);
                    *(u32x4*)(O + (size_t)(row0 + ai * 128 + m * 16) * NHG + col) = w;
                }
        }
    }
};
struct EpiHY {
    static constexpr bool PERM = true;
    bf16_t* O;
    __device__ __forceinline__ void operator()(const f32x4 (&acc)[2][2][4][2], const pg8::GUnit& u, int wr, int wc, int fr, int fq) const {
        const int row0 = u.i0 * 256 + wr * 64 + fr, colt = u.i1 * 256 + wc * 32 + 8 * fq;
        const __amdgpu_buffer_rsrc_t rsrc = __builtin_amdgcn_make_buffer_rsrc(O, 0, NHY * NTOK * 2, 0x00020000);
#pragma unroll
        for (int ai = 0; ai < 2; ++ai)
#pragma unroll
            for (int m = 0; m < 4; ++m)
#pragma unroll
                for (int bj = 0; bj < 2; ++bj) {
                    const f32x4 v0 = acc[ai][bj][m][0], v1 = acc[ai][bj][m][1];
                    u32x4 w; w.x = pk2(v0[0], v0[1]); w.y = pk2(v0[2], v0[3]); w.z = pk2(v1[0], v1[1]); w.w = pk2(v1[2], v1[3]);
                    __builtin_amdgcn_raw_buffer_store_b128(w, rsrc, (unsigned)((row0 + ai * 128 + m * 16) * NTOK + colt + bj * 128) * 2u, 0, 16);
                }
    }
};
struct EpiOut {
    static constexpr bool PERM = true;
    bf16_t* xo; const float* mods; int dry;
    __device__ __forceinline__ void operator()(const f32x4 (&acc)[2][2][4][2], const pg8::GUnit& u, int wr, int wc, int fr, int fq) const {
        const int row0 = u.i0 * 256 + wr * 64 + fr, col0 = u.i1 * 256 + wc * 32 + 8 * fq;
        const float* g1 = mods + bidx(u.i0 * 256) * 6144 + 2048;
        const __amdgpu_buffer_rsrc_t rsrc = __builtin_amdgcn_make_buffer_rsrc(xo, 0, NTOK * D * 2, 0x00020000);
        f32x4 gv_[2][2];
#pragma unroll
        for (int bj = 0; bj < 2; ++bj) { gv_[bj][0] = *(const f32x4*)(g1 + col0 + bj * 128); gv_[bj][1] = *(const f32x4*)(g1 + col0 + bj * 128 + 4); }
#pragma unroll
        for (int ai = 0; ai < 2; ++ai) {
            u32x4 xw[4][2];
#pragma unroll
            for (int m = 0; m < 4; ++m)
#pragma unroll
                for (int bj = 0; bj < 2; ++bj) xw[m][bj] = *(const u32x4*)(xo + (size_t)(row0 + ai * 128 + m * 16) * D + col0 + bj * 128);
            __builtin_amdgcn_sched_barrier(0);
#pragma unroll
            for (int m = 0; m < 4; ++m)
#pragma unroll
                for (int bj = 0; bj < 2; ++bj) { const int row = row0 + ai * 128 + m * 16, col = col0 + bj * 128;
                    const f32x4 oa = bf4_to_f32((u32x2){xw[m][bj].x, xw[m][bj].y}) + gv_[bj][0] * acc[ai][bj][m][0], ob = bf4_to_f32((u32x2){xw[m][bj].z, xw[m][bj].w}) + gv_[bj][1] * acc[ai][bj][m][1];
                    const u32x2 wa = f32_to_bf4(oa), wb = f32_to_bf4(ob);
                    if (!dry) __builtin_amdgcn_raw_buffer_store_b128((u32x4){wa.x, wa.y, wb.x, wb.y}, rsrc, (unsigned)(row * D + col) * 2u, 0, 16); }
            __builtin_amdgcn_sched_barrier(0);
        }
    }
};
struct EpiAct {
    static constexpr bool PERM = true;
    bf16_t* O; const float* roww;
    __device__ __forceinline__ void operator()(const f32x4 (&acc)[2][2][4][2], const pg8::GUnit& u, int wr, int wc, int fr, int fq) const {
        const int es = u.i1 >> 1; const int pos0 = u.i0 * 256 + wr * 64 + fr, col = u.i1 * 128 + wc * 32 + 8 * fq;
        const __amdgpu_buffer_rsrc_t rsrc = __builtin_amdgcn_make_buffer_rsrc(O, 0, SROWS * 512 * 2, 0x00020000);
        float wg_[2][4];
#pragma unroll
        for (int ai = 0; ai < 2; ++ai)
#pragma unroll
            for (int m = 0; m < 4; ++m) wg_[ai][m] = roww[(pos0 + ai * 128 + m * 16) * 2 + es];
        __builtin_amdgcn_sched_barrier(0);
#pragma unroll
        for (int ai = 0; ai < 2; ++ai)
#pragma unroll
            for (int m = 0; m < 4; ++m) {
                const int pos = pos0 + ai * 128 + m * 16;
                const float wgt = wg_[ai][m];
                float v[8];
#pragma unroll
                for (int j = 0; j < 8; ++j) v[j] = siluf_(acc[ai][0][m][j >> 2][j & 3]) * acc[ai][1][m][j >> 2][j & 3] * wgt;
                u32x4 w; w.x = pk2(v[0], v[1]); w.y = pk2(v[2], v[3]); w.z = pk2(v[4], v[5]); w.w = pk2(v[6], v[7]);
                __builtin_amdgcn_raw_buffer_store_b128(w, rsrc, (unsigned)(pos * 512 + col) * 2u, 0, 16);
            }
    }
};
struct EpiDown {
    static constexpr bool PERM = true;
    bf16_t* xo; const int* rowtok; const float* mods; int dry;
    __device__ __forceinline__ void operator()(const f32x4 (&acc)[2][2][4][2], const pg8::GUnit& u, int wr, int wc, int fr, int fq) const {
        const int pos0 = u.i0 * 256 + wr * 64 + fr, col0 = u.i1 * 256 + wc * 32 + 8 * fq;
        int tk_[2][4];
#pragma unroll
        for (int ai = 0; ai < 2; ++ai)
#pragma unroll
            for (int m = 0; m < 4; ++m) tk_[ai][m] = rowtok[pos0 + ai * 128 + m * 16];
        __builtin_amdgcn_sched_barrier(0);
#pragma unroll
        for (int ai = 0; ai < 2; ++ai)
#pragma unroll
            for (int m = 0; m < 4; ++m) {
                const int tok = tk_[ai][m];
                if (tok >= 0) {
                    const float* g2 = mods + bidx(tok) * 6144 + 5120;
                    bf16_t* xr = xo + (size_t)tok * D;
#pragma unroll
                    for (int bj = 0; bj < 2; ++bj) { const int col = col0 + bj * 128;
                        const u32x4 xw = *(const u32x4*)(xr + col);
                        const f32x4 ga = *(const f32x4*)(g2 + col), gb = *(const f32x4*)(g2 + col + 4);
                        const f32x4 oa = bf4_to_f32((u32x2){xw.x, xw.y}) + ga * acc[ai][bj][m][0], ob = bf4_to_f32((u32x2){xw.z, xw.w}) + gb * acc[ai][bj][m][1];
                        const u32x2 wa = f32_to_bf4(oa), wb = f32_to_bf4(ob);
                        if (!dry) *(u32x4*)(xr + col) = (u32x4){wa.x, wa.y, wb.x, wb.y}; }
                }
            }
    }
};

struct SchedFilt {
    int G, c;
    __device__ __forceinline__ bool next(int i, pg8::GUnit& u) const {
        const int idx = i * G + c; if (idx >= 4 * 72) return false;
        const int l = idx / 72, r = idx - l * 72, pm = r / 9, pn = r - pm * 9;
        u.a = (unsigned)(l * 2048 + pm * 256) * 256u; u.b = (unsigned)(l * 2304 + pn * 256) * 256u; u.last = 1; u.i0 = l * 16 + pm; u.i1 = pn; return true;
    }
};
struct EpiFilt {
    static constexpr bool PERM = true;
    bf16_t* HF; const float* b3;
    __device__ __forceinline__ void operator()(const f32x4 (&acc)[2][2][4][2], const pg8::GUnit& u, int wr, int wc, int fr, int fq) const {
        const int l = u.i0 >> 4, pm = u.i0 & 15;
        const int row0 = pm * 256 + wr * 64 + fr, t00 = u.i1 * 256 + wc * 32 + 8 * fq;
        float bias_[2][4];
#pragma unroll
        for (int ai = 0; ai < 2; ++ai)
#pragma unroll
            for (int m = 0; m < 4; ++m) bias_[ai][m] = b3[l * 2048 + row0 + ai * 128 + m * 16];
        __builtin_amdgcn_sched_barrier(0);
#pragma unroll
        for (int ai = 0; ai < 2; ++ai)
#pragma unroll
            for (int m = 0; m < 4; ++m) {
                const int row = row0 + ai * 128 + m * 16, c = row & 511;
                const float delta = fabsf(logf(1e-2f) / 0.3f + (float)c * ((logf(1e-2f) / 1.5f - logf(1e-2f) / 0.3f) / 511.0f));
                const float bias = bias_[ai][m];
#pragma unroll
                for (int bj = 0; bj < 2; ++bj) {
                    const int t0 = t00 + bj * 128;
                    float v[8];
#pragma unroll
                    for (int j = 0; j < 8; ++j) { const int t = t0 + j; const float tn = t < 2048 ? (float)t / 2047.0f : (float)(t - 2048) / 255.0f;
                        v[j] = (acc[ai][bj][m][j >> 2][j & 3] + bias) * expf(-tn * delta); }
                    u32x4 w; w.x = pk2(v[0], v[1]); w.y = pk2(v[2], v[3]); w.z = pk2(v[4], v[5]); w.w = pk2(v[6], v[7]);
                    *(u32x4*)(HF + ((size_t)(l * 2048 + row)) * 2304 + t0) = w;
                }
            }
    }
};

__device__ __forceinline__ int padx(int i) { return i + (i >> 3); }
__device__ __forceinline__ f32x2 cmul(f32x2 a, f32x2 b) { return (f32x2){a.x * b.x - a.y * b.y, a.x * b.y + a.y * b.x}; }
__device__ __forceinline__ f32x2 cmulc(f32x2 a, f32x2 b) { return (f32x2){a.x * b.x + a.y * b.y, a.y * b.x - a.x * b.y}; }
constexpr int XPAD = 2048 + 256;

__device__ __forceinline__ void fft_p1_dif(f32x2 (&v)[8], int tt, const LAS f32x2* T) {
#pragma unroll
    for (int g = 0; g < 2; ++g) { const int u = tt + 256 * g;
#pragma unroll
        for (int j = 0; j < 2; ++j) { const f32x2 a = v[g + 2 * j], b = v[g + 2 * j + 4]; v[g + 2 * j] = a + b; v[g + 2 * j + 4] = cmul(a - b, T[2 * (u + 512 * j)]); }
        const f32x2 tw = T[4 * u];
        { const f32x2 a = v[g], b = v[g + 2]; v[g] = a + b; v[g + 2] = cmul(a - b, tw); }
        { const f32x2 a = v[g + 4], b = v[g + 6]; v[g + 4] = a + b; v[g + 6] = cmul(a - b, tw); } }
}
__device__ __forceinline__ void fft_p1_dit(f32x2 (&v)[8], int tt, const LAS f32x2* T) {
#pragma unroll
    for (int g = 0; g < 2; ++g) { const int u = tt + 256 * g;
        const f32x2 tw = T[4 * u];
        { const f32x2 a = v[g], b = cmulc(v[g + 2], tw); v[g] = a + b; v[g + 2] = a - b; }
        { const f32x2 a = v[g + 4], b = cmulc(v[g + 6], tw); v[g + 4] = a + b; v[g + 6] = a - b; }
#pragma unroll
        for (int j = 0; j < 2; ++j) { const f32x2 a = v[g + 2 * j], b = cmulc(v[g + 2 * j + 4], T[2 * (u + 512 * j)]); v[g + 2 * j] = a + b; v[g + 2 * j + 4] = a - b; } }
}
template <int Q> __device__ __forceinline__ void r8_dif(f32x2 (&e)[8], int r, const LAS f32x2* T) {
    constexpr int S2 = 512 / Q;
#pragma unroll
    for (int j = 0; j < 4; ++j) { const f32x2 a = e[j], b = e[j + 4]; e[j] = a + b; e[j + 4] = cmul(a - b, T[S2 * (r + Q * j)]); }
#pragma unroll
    for (int jj = 0; jj < 4; ++jj) { const int j = (jj & 1) + 4 * (jj >> 1); const f32x2 a = e[j], b = e[j + 2]; e[j] = a + b; e[j + 2] = cmul(a - b, T[2 * S2 * (r + Q * (j & 1))]); }
    const f32x2 tw = T[4 * S2 * r];
#pragma unroll
    for (int j = 0; j < 8; j += 2) { const f32x2 a = e[j], b = e[j + 1]; e[j] = a + b; e[j + 1] = cmul(a - b, tw); }
}
template <int Q> __device__ __forceinline__ void r8_dit(f32x2 (&e)[8], int r, const LAS f32x2* T) {
    constexpr int S2 = 512 / Q;
    const f32x2 tw = T[4 * S2 * r];
#pragma unroll
    for (int j = 0; j < 8; j += 2) { const f32x2 a = e[j], b = cmulc(e[j + 1], tw); e[j] = a + b; e[j + 1] = a - b; }
#pragma unroll
    for (int jj = 0; jj < 4; ++jj) { const int j = (jj & 1) + 4 * (jj >> 1); const f32x2 a = e[j], b = cmulc(e[j + 2], T[2 * S2 * (r + Q * (j & 1))]); e[j] = a + b; e[j + 2] = a - b; }
#pragma unroll
    for (int j = 0; j < 4; ++j) { const f32x2 a = e[j], b = cmulc(e[j + 4], T[S2 * (r + Q * j)]); e[j] = a + b; e[j + 4] = a - b; }
}
template <int Q, bool INV> __device__ __forceinline__ void fft_mid(LAS f32x2* X, int tt, const LAS f32x2* T) {
    const int blk = tt / Q, r = tt % Q, base = blk * 8 * Q + r;
    f32x2 e[8];
#pragma unroll
    for (int j = 0; j < 8; ++j) e[j] = X[padx(base + Q * j)];
    if (INV) r8_dit<Q>(e, r, T); else r8_dif<Q>(e, r, T);
#pragma unroll
    for (int j = 0; j < 8; ++j) X[padx(base + Q * j)] = e[j];
}
__device__ __forceinline__ void fft_conv_half(f32x2 (&v)[8], LAS f32x2* X, const LAS f32x2* T, const f32x2* K, int tt) {
    f32x2 kv[8];
#pragma unroll
    for (int j = 0; j < 8; ++j) kv[j] = K[8 * tt + j];
    fft_p1_dif(v, tt, T);
#pragma unroll
    for (int m = 0; m < 8; ++m) X[padx(tt + 256 * m)] = v[m];
    __syncthreads();
    fft_mid<64, false>(X, tt, T); __syncthreads();
    fft_mid<8, false>(X, tt, T); __syncthreads();
    f32x2 e[8];
#pragma unroll
    for (int j = 0; j < 8; ++j) e[j] = X[padx(8 * tt + j)];
    r8_dif<1>(e, 0, T);
#pragma unroll
    for (int j = 0; j < 8; ++j) e[j] = cmul(e[j], kv[j]);
    r8_dit<1>(e, 0, T);
#pragma unroll
    for (int j = 0; j < 8; ++j) X[padx(8 * tt + j)] = e[j];
    __syncthreads();
    fft_mid<8, true>(X, tt, T); __syncthreads();
    fft_mid<64, true>(X, tt, T); __syncthreads();
#pragma unroll
    for (int m = 0; m < 8; ++m) v[m] = X[padx(tt + 256 * m)];
    fft_p1_dit(v, tt, T);
}
__device__ __forceinline__ void fft_fwd_store(f32x2 (&v)[8], LAS f32x2* X, const LAS f32x2* T, f32x2* Kout, int tt) {
    fft_p1_dif(v, tt, T);
#pragma unroll
    for (int m = 0; m < 8; ++m) X[padx(tt + 256 * m)] = v[m];
    __syncthreads();
    fft_mid<64, false>(X, tt, T); __syncthreads();
    fft_mid<8, false>(X, tt, T); __syncthreads();
    f32x2 e[8];
#pragma unroll
    for (int j = 0; j < 8; ++j) e[j] = X[padx(8 * tt + j)];
    r8_dif<1>(e, 0, T);
#pragma unroll
    for (int j = 0; j < 8; ++j) Kout[8 * tt + j] = e[j];
    __syncthreads();
}
__device__ __forceinline__ int padx16(int i) { return i + (i >> 4); }
constexpr int XPAD16 = 2048 + 128;
constexpr int TC_A1 = 0, TC_A2 = 1024, TC_A3 = 1536, TC_A4 = 1792, TC_B1 = 1920, TC_B2 = 1984, TC_B3 = 2016, TC_B4 = 2032, TC_N = 2040;
template <int Q> __device__ __forceinline__ void r16_dif(f32x2 (&e)[16], int r, const LAS f32x2* TC) {
    const LAS f32x2* P1 = TC + (Q == 128 ? TC_A1 : TC_B1); const LAS f32x2* P2 = TC + (Q == 128 ? TC_A2 : TC_B2);
    const LAS f32x2* P3 = TC + (Q == 128 ? TC_A3 : TC_B3); const LAS f32x2* P4 = TC + (Q == 128 ? TC_A4 : TC_B4);
#pragma unroll
    for (int j = 0; j < 8; ++j) { const f32x2 a = e[j], b = e[j + 8]; e[j] = a + b; e[j + 8] = cmul(a - b, P1[r + Q * j]); }
#pragma unroll
    for (int jj = 0; jj < 8; ++jj) { const int j = (jj & 3) + 8 * (jj >> 2); const f32x2 a = e[j], b = e[j + 4]; e[j] = a + b; e[j + 4] = cmul(a - b, P2[r + Q * (j & 3)]); }
#pragma unroll
    for (int jj = 0; jj < 8; ++jj) { const int j = (jj & 1) + 4 * (jj >> 1); const f32x2 a = e[j], b = e[j + 2]; e[j] = a + b; e[j + 2] = cmul(a - b, P3[r + Q * (j & 1)]); }
    const f32x2 tw = P4[r];
#pragma unroll
    for (int j = 0; j < 16; j += 2) { const f32x2 a = e[j], b = e[j + 1]; e[j] = a + b; e[j + 1] = cmul(a - b, tw); }
}
template <int Q> __device__ __forceinline__ void r16_dit(f32x2 (&e)[16], int r, const LAS f32x2* TC) {
    const LAS f32x2* P1 = TC + (Q == 128 ? TC_A1 : TC_B1); const LAS f32x2* P2 = TC + (Q == 128 ? TC_A2 : TC_B2);
    const LAS f32x2* P3 = TC + (Q == 128 ? TC_A3 : TC_B3); const LAS f32x2* P4 = TC + (Q == 128 ? TC_A4 : TC_B4);
    const f32x2 tw = P4[r];
#pragma unroll
    for (int j = 0; j < 16; j += 2) { const f32x2 a = e[j], b = cmulc(e[j + 1], tw); e[j] = a + b; e[j + 1] = a - b; }
#pragma unroll
    for (int jj = 0; jj < 8; ++jj) { const int j = (jj & 1) + 4 * (jj >> 1); const f32x2 a = e[j], b = cmulc(e[j + 2], P3[r + Q * (j & 1)]); e[j] = a + b; e[j + 2] = a - b; }
#pragma unroll
    for (int jj = 0; jj < 8; ++jj) { const int j = (jj & 3) + 8 * (jj >> 2); const f32x2 a = e[j], b = cmulc(e[j + 4], P2[r + Q * (j & 3)]); e[j] = a + b; e[j + 4] = a - b; }
#pragma unroll
    for (int j = 0; j < 8; ++j) { const f32x2 a = e[j], b = cmulc(e[j + 8], P1[r + Q * j]); e[j] = a + b; e[j + 8] = a - b; }
}
__device__ __forceinline__ f32x2 mul_mi(f32x2 a) { return (f32x2){a.y, -a.x}; }
__device__ __forceinline__ f32x2 mul_pi(f32x2 a) { return (f32x2){-a.y, a.x}; }
__device__ __forceinline__ void r8_dif_c(f32x2 (&e)[8]) {
    constexpr float h = 0.70710678118654752440f;
    { const f32x2 a = e[0], b = e[4]; e[0] = a + b; e[4] = a - b; }
    { const f32x2 a = e[1], b = e[5]; e[1] = a + b; const f32x2 d = a - b; e[5] = (f32x2){(d.x + d.y) * h, (d.y - d.x) * h}; }
    { const f32x2 a = e[2], b = e[6]; e[2] = a + b; e[6] = mul_mi(a - b); }
    { const f32x2 a = e[3], b = e[7]; e[3] = a + b; const f32x2 d = a - b; e[7] = (f32x2){(d.y - d.x) * h, -(d.x + d.y) * h}; }
#pragma unroll
    for (int g = 0; g < 8; g += 4) {
        { const f32x2 a = e[g], b = e[g + 2]; e[g] = a + b; e[g + 2] = a - b; }
        { const f32x2 a = e[g + 1], b = e[g + 3]; e[g + 1] = a + b; e[g + 3] = mul_mi(a - b); } }
#pragma unroll
    for (int j = 0; j < 8; j += 2) { const f32x2 a = e[j], b = e[j + 1]; e[j] = a + b; e[j + 1] = a - b; }
}
__device__ __forceinline__ void r8_dit_c(f32x2 (&e)[8]) {
    constexpr float h = 0.70710678118654752440f;
#pragma unroll
    for (int j = 0; j < 8; j += 2) { const f32x2 a = e[j], b = e[j + 1]; e[j] = a + b; e[j + 1] = a - b; }
#pragma unroll
    for (int g = 0; g < 8; g += 4) {
        { const f32x2 a = e[g], b = e[g + 2]; e[g] = a + b; e[g + 2] = a - b; }
        { const f32x2 a = e[g + 1], b = mul_pi(e[g + 3]); e[g + 1] = a + b; e[g + 3] = a - b; } }
    { const f32x2 a = e[0], b = e[4]; e[0] = a + b; e[4] = a - b; }
    { const f32x2 a = e[1], d = e[5]; const f32x2 b = (f32x2){(d.x - d.y) * h, (d.x + d.y) * h}; e[1] = a + b; e[5] = a - b; }
    { const f32x2 a = e[2], b = mul_pi(e[6]); e[2] = a + b; e[6] = a - b; }
    { const f32x2 a = e[3], d = e[7]; const f32x2 b = (f32x2){-(d.x + d.y) * h, (d.x - d.y) * h}; e[3] = a + b; e[7] = a - b; }
}
struct NoHook { __device__ __forceinline__ void operator()() const {} };
template <class Hook = NoHook>
__device__ __forceinline__ void fft_conv_half16(f32x2 (&v)[16], LAS f32x2* X, const LAS f32x2* TC, const f32x2* K, int tt, const Hook& after_b1 = Hook()) {
    r16_dif<128>(v, tt, TC);
#pragma unroll
    for (int m = 0; m < 16; ++m) X[padx16(tt + 128 * m)] = v[m];
    __syncthreads();
    after_b1();
    const int r = tt & 7, base = (tt >> 3) * 128 + r;
#pragma unroll
    for (int j = 0; j < 16; ++j) v[j] = X[padx16(base + 8 * j)];
    r16_dif<8>(v, r, TC);
#pragma unroll
    for (int j = 0; j < 16; ++j) X[padx16(base + 8 * j)] = v[j];
    f32x2 kv[16];
#pragma unroll
    for (int j = 0; j < 16; ++j) kv[j] = K[((j >> 1) * 128 + tt) * 2 + (j & 1)];
    __syncthreads();
#pragma unroll
    for (int g = 0; g < 2; ++g) { f32x2 e[8];
#pragma unroll
        for (int j = 0; j < 8; ++j) e[j] = X[padx16(16 * tt + 8 * g + j)];
        r8_dif_c(e);
#pragma unroll
        for (int j = 0; j < 8; ++j) e[j] = cmul(e[j], kv[8 * g + j]);
        r8_dit_c(e);
#pragma unroll
        for (int j = 0; j < 8; ++j) X[padx16(16 * tt + 8 * g + j)] = e[j]; }
    __syncthreads();
#pragma unroll
    for (int j = 0; j < 16; ++j) v[j] = X[padx16(base + 8 * j)];
    r16_dit<8>(v, r, TC);
#pragma unroll
    for (int j = 0; j < 16; ++j) X[padx16(base + 8 * j)] = v[j];
    __syncthreads();
#pragma unroll
    for (int m = 0; m < 16; ++m) v[m] = X[padx16(tt + 128 * m)];
    r16_dit<128>(v, tt, TC);
}
__device__ __forceinline__ void fft_fwd_store16(f32x2 (&v)[16], LAS f32x2* X, const LAS f32x2* TC, f32x2* Kout, int tt) {
    r16_dif<128>(v, tt, TC);
#pragma unroll
    for (int m = 0; m < 16; ++m) X[padx16(tt + 128 * m)] = v[m];
    __syncthreads();
    const int r = tt & 7, base = (tt >> 3) * 128 + r;
#pragma unroll
    for (int j = 0; j < 16; ++j) v[j] = X[padx16(base + 8 * j)];
    r16_dif<8>(v, r, TC);
#pragma unroll
    for (int j = 0; j < 16; ++j) X[padx16(base + 8 * j)] = v[j];
    __syncthreads();
#pragma unroll
    for (int g = 0; g < 2; ++g) { f32x2 e[8];
#pragma unroll
        for (int j = 0; j < 8; ++j) e[j] = X[padx16(16 * tt + 8 * g + j)];
        r8_dif_c(e);
#pragma unroll
        for (int j = 0; j < 8; ++j) Kout[(((8 * g + j) >> 1) * 128 + tt) * 2 + (j & 1)] = e[j]; }
    __syncthreads();
}
constexpr int HY_TC_OFF = 122880;
__device__ __forceinline__ void build_twiddles(const Ctx& C, LAS f32x2* T) {
    for (int k = C.tid; k < 2048; k += NTHR) { float s, c; sincospif((float)k * (1.0f / 2048.0f), &s, &c); T[k] = (f32x2){c, -s}; }
    __syncthreads();
    LAS f32x2* TC = (LAS f32x2*)(C.lds + HY_TC_OFF);
    for (int k = C.tid; k < TC_N; k += NTHR) {
        const int src = k < TC_A2 ? 2 * k : k < TC_A3 ? 4 * (k - TC_A2) : k < TC_A4 ? 8 * (k - TC_A3) : k < TC_B1 ? 16 * (k - TC_A4) : k < TC_B2 ? 32 * (k - TC_B1) : k < TC_B3 ? 64 * (k - TC_B2) : k < TC_B4 ? 128 * (k - TC_B3) : 256 * (k - TC_B4);
        TC[k] = T[src]; }
}

__device__ __forceinline__ void phase0(const Ctx& C) {
    LAS float* sil = (LAS float*)C.lds;
    LAS float* red = sil + 9 * 1024;
    LAS float* zs = red + 8 * 9 * 64;
    LAS float* h1s = zs + 8 * 40;
    const float* cin = GIN(IN_C); const float* cctx = GIN(IN_CCTX);
    { float cv[18];
#pragma unroll
      for (int q = 0; q < 18; ++q) { const int i = C.tid + NTHR * q, r = i >> 10, k = i & 1023; cv[q] = r < 8 ? cin[r * 1024 + k] : cctx[k]; }
      __builtin_amdgcn_sched_barrier(0);
#pragma unroll
      for (int q = 0; q < 18; ++q) { const float v = cv[q]; sil[C.tid + NTHR * q] = v / (1.0f + expf(-v)); } }
    __syncthreads();
    float* mods = WSP(float, WS_MODS);
    const float* wmod = GIN(IN_WMOD); const float* bmod = GIN(IN_BMOD);
    for (int item = C.bid; item < 4 * 192; item += C.G) {
        const int l = item / 192, cb = item % 192, cc = C.tid & 31, kg = C.tid >> 5;
        const float* w = wmod + ((size_t)l * 1024 + kg * 64) * 6144 + cb * 32 + cc;
        const LAS float* sk = sil + kg * 64;
        float acc[9];
#pragma unroll
        for (int r = 0; r < 9; ++r) acc[r] = 0.f;
#pragma unroll 2
        for (int k = 0; k < 64; k += 4) {
            const float w0 = w[(size_t)k * 6144], w1 = w[(size_t)(k + 1) * 6144], w2 = w[(size_t)(k + 2) * 6144], w3v = w[(size_t)(k + 3) * 6144];
#pragma unroll
            for (int r = 0; r < 9; ++r) { const f32x4 sv = *(const LAS f32x4*)(sk + r * 1024 + k); acc[r] += (sv.x * w0 + sv.y * w1) + (sv.z * w2 + sv.w * w3v); } }
#pragma unroll
        for (int r = 0; r < 9; ++r) red[(kg * 9 + r) * 32 + cc] = acc[r];
        __syncthreads();
        for (int o = C.tid; o < 288; o += NTHR) { const int r = o >> 5, c2 = o & 31; float s = 0.f;
#pragma unroll
            for (int g = 0; g < 16; ++g) s += red[(g * 9 + r) * 32 + c2];
            mods[(size_t)(l * 9 + r) * 6144 + cb * 32 + c2] = s + bmod[l * 6144 + cb * 32 + c2]; }
        __syncthreads();
    }
    { const int bpl = C.G >= 4 ? C.G / 4 : 1, l = C.G >= 4 ? C.bid / bpl : 0, j = C.tid & 63, tl = C.tid >> 6;
      const int nl = C.G >= 4 ? 1 : 4;
      if (l < 4)
#pragma unroll 1
      for (int ll = l; ll < l + nl; ++ll) {
        const float* w1 = GIN(IN_W1) + (size_t)ll * 33 * 64; const float* w2 = GIN(IN_W2) + (size_t)ll * 64 * 64;
        float w1c[33], w2c[64];
#pragma unroll
        for (int i = 0; i < 33; ++i) w1c[i] = w1[i * 64 + j];
#pragma unroll
        for (int i = 0; i < 64; ++i) w2c[i] = w2[i * 64 + j];
        const float b1v = GIN(IN_B1)[ll * 64 + j], b2v = GIN(IN_B2)[ll * 64 + j];
#pragma unroll 1
        for (int r = C.G >= 4 ? C.bid % bpl : C.bid; r < 288; r += (C.G >= 4 ? bpl : C.G)) {
            const int isctx = r >= 256;
            const int L = isctx ? 256 : 2048, t0 = (isctx ? r - 256 : r) * 8, t = t0 + tl;
            if (j < 33) { float z;
                if (j == 0) z = (float)t / (float)(L - 1);
                else { const int fi = (j - 1) & 15; const float freq = 1e-4f + (float)fi * ((15.0f - 1e-4f) / 15.0f);
                    const float ang = ((float)(2.0 * 3.14159265358979323846 / L) * (float)t) * freq; z = (j <= 16) ? cosf(ang) : -sinf(ang); }
                zs[tl * 40 + j] = z; }
            __syncthreads();
            { float s = b1v;
#pragma unroll
                for (int i = 0; i < 33; ++i) s += zs[tl * 40 + i] * w1c[i];
                h1s[tl * 64 + j] = sinf(s); }
            __syncthreads();
            { float s = b2v;
#pragma unroll
                for (int i = 0; i < 64; ++i) s += h1s[tl * 64 + i] * w2c[i];
                bf16_t* dst = WSP(bf16_t, WS_HPAD) + ((size_t)ll * 2304 + (isctx ? 2048 + t : t)) * 128;
                dst[j] = (bf16_t)f2bf(sinf(s)); dst[64 + j] = (bf16_t)0; }
            __syncthreads();
        }
      }
    }
    {
        const float* w3 = GIN(IN_W3); bf16_t* w3t = WSP(bf16_t, WS_W3T);
        for (int i = C.bid * NTHR + C.tid; i < 4 * 64 * 2048; i += C.G * NTHR) { const int l = i >> 17, col = (i >> 6) & 2047, k = i & 63;
            w3t[((size_t)l * 2048 + col) * 128 + k] = (bf16_t)f2bf(w3[((size_t)l * 64 + k) * 2048 + col]); w3t[((size_t)l * 2048 + col) * 128 + 64 + k] = (bf16_t)0; }
    }
    if (C.bid == C.G - 1) {
        const float* lb = GIN(IN_LB); float* lower = WSP(float, WS_LOWER);
        for (int i = C.tid; i < 1024; i += NTHR) { const int d = i >> 9, c = i & 511; float v[4], mx = -3.4e38f, s = 0.f;
#pragma unroll
            for (int l = 0; l < 4; ++l) { v[l] = lb[(d * 4 + l) * 512 + c]; mx = fmaxf(mx, v[l]); }
#pragma unroll
            for (int l = 0; l < 4; ++l) { v[l] = expf(v[l] - mx); s += v[l]; }
            float cum = 0.f;
#pragma unroll
            for (int l = 0; l < 4; ++l) { if (l > 0) cum += v[l] / s; lower[(d * 4 + l) * 512 + c] = cum; } }
    }
}

__device__ __forceinline__ const float* xrow_in(const Ctx& C, int row) { return row < NLAT ? GIN(IN_X) + (size_t)row * D : GIN(IN_CTX) + (size_t)(row - NLAT) * D; }
__device__ __forceinline__ void transpose_item(const float* W, int K, int N, bf16_t* WT, LAS float* scr, int item, int lane) {
    const int nblk = N / 32, kb = item / nblk, nb = item % nblk, k0 = 64 * kb, n0 = 32 * nb;
    float wv[32];
#pragma unroll
    for (int i = 0; i < 32; ++i) wv[i] = W[(size_t)(k0 + 2 * i + (lane >> 5)) * N + n0 + (lane & 31)];
#pragma unroll
    for (int i = 0; i < 32; ++i) scr[(2 * i + (lane >> 5)) * 33 + (lane & 31)] = wv[i];
    LDS_WAIT(); asm volatile("" ::: "memory");
    const int c = lane & 7;
#pragma unroll
    for (int j = 0; j < 4; ++j) { const int n = (lane >> 3) + 8 * j; const LAS float* s = scr + (8 * c) * 33 + n;
        u32x4 o; o.x = pk2(s[0 * 33], s[1 * 33]); o.y = pk2(s[2 * 33], s[3 * 33]); o.z = pk2(s[4 * 33], s[5 * 33]); o.w = pk2(s[6 * 33], s[7 * 33]);
        *(u32x4*)(WT + (size_t)(n0 + n) * K + k0 + 8 * c) = o; }
    LDS_WAIT(); asm volatile("" ::: "memory");
}
constexpr int CV_I_IN = 16 * 128, CV_I_OUT = 16 * 32, CV_I_E = 128, CV_NIT = CV_I_IN + CV_I_OUT + 3 * 16 * CV_I_E;
__device__ __forceinline__ void convert_weights(const Ctx& C, int l, int it0, int it1, int wk, int nworkers) {
    LAS float* scr = (LAS float*)(C.lds + C.wave * 16384);
    for (int it = it0 + wk; it < it1; it += nworkers) {
        int r = it;
        if (r < CV_I_IN) { transpose_item(GIN(IN_WIN) + (size_t)l * D * DIN, D, DIN, WSP(bf16_t, WS_WIN), scr, r, C.lane); continue; } r -= CV_I_IN;
        if (r < CV_I_OUT) { transpose_item(GIN(IN_WOUT) + (size_t)l * D * D, D, D, WSP(bf16_t, WS_WOUT), scr, r, C.lane); continue; } r -= CV_I_OUT;
        if (r < 16 * CV_I_E) { const int e = r / CV_I_E; transpose_item(GIN(IN_WG) + ((size_t)l * NE + e) * D * DE, D, DE, WSP(bf16_t, WS_WG) + (size_t)e * DE * D, scr, r % CV_I_E, C.lane); continue; } r -= 16 * CV_I_E;
        if (r < 16 * CV_I_E) { const int e = r / CV_I_E; transpose_item(GIN(IN_WU) + ((size_t)l * NE + e) * D * DE, D, DE, WSP(bf16_t, WS_WU) + (size_t)e * DE * D, scr, r % CV_I_E, C.lane); continue; } r -= 16 * CV_I_E;
        { const int e = r / CV_I_E; transpose_item(GIN(IN_WD) + ((size_t)l * NE + e) * DE * D, DE, D, WSP(bf16_t, WS_WD) + (size_t)e * D * DE, scr, r % CV_I_E, C.lane); }
    }
}
__device__ __forceinline__ void phase_l1(const Ctx& C, int l) {
    const int gw = C.bid * NWAVES + C.wave, NGW = C.G * NWAVES;
    const float* mods = WSP(const float, WS_MODS) + (size_t)l * 9 * 6144;
    bf16_t* an = WSP(bf16_t, WS_R1);
    bf16_t* xb = WSP(bf16_t, WS_XBUF);
    const int RPW = (NTOK + NGW - 1) / NGW, r0 = gw * RPW, r1 = (r0 + RPW < NTOK) ? r0 + RPW : NTOK;
    f32x4 shv[4], scv[4]; int curb = -1;
    if (l == 0) {
        f32x4 nv[4];
        if (r0 < r1) { const float* src = xrow_in(C, r0);
#pragma unroll
            for (int j = 0; j < 4; ++j) nv[j] = *(const f32x4*)(src + C.lane * 4 + 256 * j); }
        for (int row = r0; row < r1; ++row) {
            f32x4 v[4]; float ss = 0.f;
#pragma unroll
            for (int j = 0; j < 4; ++j) v[j] = nv[j];
            if (row + 1 < r1) { const float* src = xrow_in(C, row + 1);
#pragma unroll
                for (int j = 0; j < 4; ++j) nv[j] = *(const f32x4*)(src + C.lane * 4 + 256 * j); }
            const int bb = bidx(row);
            if (bb != curb) { curb = bb; const float* md = mods + bb * 6144;
#pragma unroll
                for (int j = 0; j < 4; ++j) { const int k = C.lane * 4 + 256 * j; shv[j] = *(const f32x4*)(md + k); scv[j] = *(const f32x4*)(md + 1024 + k) + 1.0f; } }
#pragma unroll
            for (int j = 0; j < 4; ++j) ss += (v[j].x * v[j].x + v[j].y * v[j].y) + (v[j].z * v[j].z + v[j].w * v[j].w);
            ss = wave_sum(ss); const float rinv = 1.0f / sqrtf(ss * (1.0f / D) + EPS);
#pragma unroll
            for (int j = 0; j < 4; ++j) { const int k = C.lane * 4 + 256 * j;
                const f32x4 o = v[j] * rinv * scv[j] + shv[j];
                *(u32x2*)(an + (size_t)row * D + k) = f32_to_bf4(o);
                *(u32x2*)(xb + (size_t)row * D + k) = f32_to_bf4(v[j]); }
        }
    } else {
        u32x2 nw[4];
        if (r0 < r1) {
#pragma unroll
            for (int j = 0; j < 4; ++j) nw[j] = *(const u32x2*)(xb + (size_t)r0 * D + C.lane * 4 + 256 * j); }
        for (int row = r0; row < r1; ++row) {
            f32x4 v[4]; float ss = 0.f;
#pragma unroll
            for (int j = 0; j < 4; ++j) v[j] = bf4_to_f32(nw[j]);
            if (row + 1 < r1) {
#pragma unroll
                for (int j = 0; j < 4; ++j) nw[j] = *(const u32x2*)(xb + (size_t)(row + 1) * D + C.lane * 4 + 256 * j); }
            const int bb = bidx(row);
            if (bb != curb) { curb = bb; const float* md = mods + bb * 6144;
#pragma unroll
                for (int j = 0; j < 4; ++j) { const int k = C.lane * 4 + 256 * j; shv[j] = *(const f32x4*)(md + k); scv[j] = *(const f32x4*)(md + 1024 + k) + 1.0f; } }
#pragma unroll
            for (int j = 0; j < 4; ++j) ss += (v[j].x * v[j].x + v[j].y * v[j].y) + (v[j].z * v[j].z + v[j].w * v[j].w);
            ss = wave_sum(ss); const float rinv = 1.0f / sqrtf(ss * (1.0f / D) + EPS);
#pragma unroll
            for (int j = 0; j < 4; ++j) { const int k = C.lane * 4 + 256 * j;
                const f32x4 o = v[j] * rinv * scv[j] + shv[j];
                *(u32x2*)(an + (size_t)row * D + k) = f32_to_bf4(o); }
        }
    }
    if (l > 0 || !(4 * 72 > C.G && 4 * 72 < 2 * C.G)) convert_weights(C, l, 0, CV_I_IN + CV_I_OUT, gw, NGW);
    __syncthreads();
    {
        LAS f32x2* T = (LAS f32x2*)C.lds;
        const LAS f32x2* TC = (const LAS f32x2*)(C.lds + HY_TC_OFF);
        const int team = C.tid >> 7, tt = C.tid & 127;
        LAS f32x2* X = (LAS f32x2*)(C.lds + 16384) + team * XPAD16;
        LAS float* hbs = (LAS float*)(C.lds + 16384 + 4 * XPAD16 * 8) + team * 2048;
        LAS float* reds = (LAS float*)(C.lds + 16384 + 4 * XPAD16 * 8 + 32768);
        build_twiddles(C, T);
        __syncthreads();
        const bf16_t* hfl = WSP(const bf16_t, WS_HF) + (size_t)l * 2048 * 2304;
        f32x2* kspec = WSP(f32x2, WS_KSPEC);
        if (!(C.dry & 8))
        for (int item = C.bid; item < 256; item += C.G) {
            const int idx = item * 4 + team, o = idx >> 9, c = idx & 511;
            const int colf = o * 1024 + c, colb = colf + 512;
            const bf16_t* hfp = hfl + (size_t)colf * 2304; const bf16_t* hbp = hfl + (size_t)colb * 2304;
            float hf[16], hb[16], s = 0.f;
            { unsigned rf[16], rbk[16];
#pragma unroll
              for (int j = 0; j < 16; ++j) { const int t = tt + 128 * j; rf[j] = hfp[t]; rbk[j] = hbp[t]; }
              __builtin_amdgcn_sched_barrier(0);
#pragma unroll
              for (int j = 0; j < 16; ++j) { hf[j] = bf2f(rf[j]); hb[j] = bf2f(rbk[j]); s += fabsf(hf[j]) + fabsf(hb[j]); } }
            s = wave_sum(s);
            if (C.lane == 0) reds[C.wave] = s;
            __syncthreads();
            const float inv = 1.0f / ((reds[team * 2] + reds[team * 2 + 1]) * 4096.0f);
#pragma unroll
            for (int j = 0; j < 16; ++j) { hf[j] *= inv; hbs[tt + 128 * j] = hb[j] * inv; }
            __syncthreads();
            f32x2* kout = kspec + ((size_t)(o * 512 + c) * 2) * 2048;
            f32x2 vv[16];
#pragma unroll
            for (int j = 0; j < 16; ++j) { const int n = tt + 128 * j; const float kb = n > 0 ? hbs[2048 - n] : 0.f; vv[j] = (f32x2){hf[j] + kb, 0.f}; }
            fft_fwd_store16(vv, X, TC, kout, tt);
#pragma unroll
            for (int j = 0; j < 16; ++j) { const int n = tt + 128 * j; const float kb = n > 0 ? hbs[2048 - n] : 0.f; const float dd = hf[j] - kb; const f32x2 tw = T[n]; vv[j] = (f32x2){dd * tw.x, dd * tw.y}; }
            fft_fwd_store16(vv, X, TC, kout + 2048, tt);
        }
        if (l < DEPTH - 1 && !(C.dry & 16)) {
            f32x2* kspc = WSP(f32x2, WS_KSPC);
            for (int item = C.bid; item < 256; item += C.G) {
                const int idx = item * 4 + team, o = idx >> 9, c = idx & 511;
                const int colf = o * 1024 + c, colb = colf + 512;
                float af0 = bf2f(hfl[(size_t)colf * 2304 + 2048 + tt]), af1 = bf2f(hfl[(size_t)colf * 2304 + 2048 + 128 + tt]);
                float ab0 = bf2f(hfl[(size_t)colb * 2304 + 2048 + tt]), ab1 = bf2f(hfl[(size_t)colb * 2304 + 2048 + 128 + tt]);
                __syncthreads();
                const float s = wave_sum((fabsf(af0) + fabsf(af1)) + (fabsf(ab0) + fabsf(ab1)));
                if (C.lane == 0) reds[C.wave] = s;
                __syncthreads();
                const float inv = 1.0f / ((reds[team * 2] + reds[team * 2 + 1]) * 2048.0f);
                af0 *= inv; af1 *= inv; hbs[tt] = ab0 * inv; hbs[128 + tt] = ab1 * inv;
                __syncthreads();
                f32x2 vk[16];
#pragma unroll
                for (int j = 0; j < 16; ++j) vk[j] = (f32x2){0.f, 0.f};
                vk[0] = (f32x2){af0, 0.f}; vk[1] = (f32x2){af1, 0.f};
                vk[14] = (f32x2){tt > 0 ? hbs[256 - tt] : 0.f, 0.f};
                vk[15] = (f32x2){hbs[128 - tt], 0.f};
                fft_fwd_store16(vk, X, TC, kspc + (size_t)(o * 512 + c) * 2048, tt);
            }
        }
    }
}

struct Taps { unsigned w1, wx; };
struct TapSel { unsigned m, c, p; };
__device__ __forceinline__ Taps sc_load(const LAS bf16_t* raw, int t) { const int e = t & ~1; Taps r; r.w1 = *(const LAS unsigned*)(raw + e); r.wx = *(const LAS unsigned*)(raw + e - 2 + 4 * (t & 1)); return r; }
__device__ __forceinline__ TapSel sc_sel(int t, bool has_m, bool has_p) { TapSel s; const bool odd = (t & 1) != 0;
    s.m = has_m ? (odd ? 0x01000c0cu : 0x07060c0cu) : 0x0c0c0c0cu; s.c = odd ? 0x03020c0cu : 0x01000c0cu; s.p = has_p ? (odd ? 0x05040c0cu : 0x03020c0cu) : 0x0c0c0c0cu; return s; }
__device__ __forceinline__ float sc_eval(const Taps r, const TapSel s, float w0, float w1, float w2, float bias) {
    const float pm = __builtin_bit_cast(float, __builtin_amdgcn_perm(r.wx, r.w1, s.m)), pc = __builtin_bit_cast(float, __builtin_amdgcn_perm(r.wx, r.w1, s.c)), pp = __builtin_bit_cast(float, __builtin_amdgcn_perm(r.wx, r.w1, s.p));
    return w0 * pm + w1 * pc + w2 * pp + bias; }
constexpr int HY_CH = 4, HY_ITEMS = 4 * (512 / HY_CH), HYC_ITEMS = 512 / 4;
__device__ __forceinline__ void hyena_lat(const Ctx& C, int l, int item) {
    const int bp = item & 3, cg = item >> 2, team = C.tid >> 7, tt = C.tid & 127;
    LAS f32x2* T = (LAS f32x2*)C.lds;
    const LAS f32x2* TC = (const LAS f32x2*)(C.lds + HY_TC_OFF);
    LAS f32x2* X = (LAS f32x2*)(C.lds + 16384) + team * XPAD16;
    LAS bf16_t* raw = (LAS bf16_t*)(C.lds + 16384 + 4 * XPAD16 * 8) + team * 4096;
    const bf16_t* phyt = WSP(const bf16_t, WS_PHYT);
    const float* cw = GIN(IN_CONVW) + (size_t)l * 3 * NHY; const float* cb = GIN(IN_CONVB) + (size_t)l * NHY;
    const float* hyb = GIN(IN_HYBIAS) + (size_t)l * 2 * DH;
    const f32x2* kspec = WSP(const f32x2, WS_KSPEC);
    const int ba = 2 * bp, c = cg * 4 + team;
    f32x2 z[16], acc[16], v[16];
    LAS unsigned char* rawdma = C.lds + 16384 + 4 * XPAD16 * 8 + (C.wave >> 1) * 8192 + (C.wave & 1) * 1024;
    auto raw_request = [&](int st) {
#pragma unroll
        for (int k = 0; k < 4; ++k) { const int q = tt + 128 * k, rr = q >> 8, cc = q & 255;
            __builtin_amdgcn_global_load_lds((const unsigned*)(phyt + (size_t)(st * 512 + c) * NTOK + (size_t)(ba + rr) * 2048 + cc * 8), (LAS unsigned*)(rawdma + k * 2048), 16, 0, 0); } };
    raw_request(0);
    float wn0 = cw[c], wn1 = cw[NHY + c], wn2 = cw[2 * NHY + c], wnb = cb[c];
#pragma unroll 1
    for (int stage = 0; stage < 3; ++stage) {
        const float w0 = wn0, w1 = wn1, w2 = wn2, bs = wnb;
        const float dsk = stage > 0 ? hyb[(stage - 1) * DH + c] : 0.f;
        asm volatile("s_waitcnt vmcnt(0)" ::: "memory");
        __syncthreads();
        if (stage < 2) { const int chn = (stage + 1) * 512 + c; wn0 = cw[chn]; wn1 = cw[NHY + chn]; wn2 = cw[2 * NHY + chn]; wnb = cb[chn]; }
        const TapSel ts = sc_sel(tt, (tt & 63) != 0, (tt & 63) != 63);
#pragma unroll
        for (int hb = 0; hb < 2; ++hb) {
            Taps ra[8], rb[8];
#pragma unroll
            for (int j = 0; j < 8; ++j) { const int t = tt + 128 * (8 * hb + j); ra[j] = sc_load(raw, t); rb[j] = sc_load(raw + 2048, t); }
            __builtin_amdgcn_sched_barrier(0); asm volatile("s_waitcnt lgkmcnt(0)" ::: "memory"); __builtin_amdgcn_sched_barrier(0);
#pragma unroll
            for (int j = 0; j < 8; ++j) { const int jj = 8 * hb + j;
                const float sa = sc_eval(ra[j], ts, w0, w1, w2, bs), sb = sc_eval(rb[j], ts, w0, w1, w2, bs);
                if (stage == 0) z[jj] = (f32x2){sa, sb};
                else { const f32x2 cv = acc[jj] + z[jj] * dsk; z[jj] = (f32x2){sa * cv.x, sb * cv.y}; } }
        }
        if (stage == 2) {
            LAS bf16_t* ob = (LAS bf16_t*)X;
#pragma unroll
            for (int j = 0; j < 16; ++j) { const int t = tt + 128 * j; ob[t] = (bf16_t)f2bf(z[j].x); ob[2048 + t] = (bf16_t)f2bf(z[j].y); }
            break;
        }
        const f32x2* K = kspec + ((size_t)(stage * 512 + c) * 2) * 2048;
#pragma unroll
        for (int j = 0; j < 16; ++j) v[j] = z[j];
        { const int stn = stage + 1; fft_conv_half16(v, X, TC, K, tt, [&]() { raw_request(stn); }); }
#pragma unroll
        for (int j = 0; j < 16; ++j) acc[j] = v[j];
#pragma unroll
        for (int j = 0; j < 16; ++j) v[j] = cmul(z[j], T[tt + 128 * j]);
        fft_conv_half16(v, X, TC, K + 2048, tt);
#pragma unroll
        for (int j = 0; j < 16; ++j) acc[j] += cmulc(v[j], T[tt + 128 * j]);
    }
    __syncthreads();
    bf16_t* Y = WSP(bf16_t, WS_R1);
    for (int i = C.tid; i < 4096; i += NTHR) { const int b = i >> 11, t = i & 2047;
        const LAS bf16_t* o0 = (const LAS bf16_t*)((LAS f32x2*)(C.lds + 16384)) + i;
        u32x2 w; w.x = (unsigned)o0[0] | ((unsigned)o0[XPAD16 * 4] << 16); w.y = (unsigned)o0[2 * XPAD16 * 4] | ((unsigned)o0[3 * XPAD16 * 4] << 16);
        *(u32x2*)(Y + ((size_t)(ba + b) * 2048 + t) * D + cg * 4) = w; }
    __syncthreads();
}
__device__ __forceinline__ void hyena_ctx2(const Ctx& C, int l, int item) {
    const int team = C.tid >> 7, tt = C.tid & 127, c = item * 4 + team;
    const LAS f32x2* TC = (const LAS f32x2*)(C.lds + HY_TC_OFF);
    LAS f32x2* X = (LAS f32x2*)(C.lds + 16384) + team * XPAD16;
    LAS bf16_t* raw = (LAS bf16_t*)(C.lds + 16384 + 4 * XPAD16 * 8) + team * 4096;
    const bf16_t* phyt = WSP(const bf16_t, WS_PHYT);
    const float* cw = GIN(IN_CONVW) + (size_t)l * 3 * NHY; const float* cb = GIN(IN_CONVB) + (size_t)l * NHY;
    const float* hyb = GIN(IN_HYBIAS) + (size_t)l * 2 * DH;
    const f32x2* kspc = WSP(const f32x2, WS_KSPC);
    bf16_t* Y = WSP(bf16_t, WS_R1);
    f32x2 z[16], v[16];
#pragma unroll
    for (int j = 0; j < 16; ++j) { z[j] = (f32x2){0.f, 0.f}; v[j] = (f32x2){0.f, 0.f}; }
#pragma unroll 1
    for (int stage = 0; stage < 3; ++stage) {
        const int ch = stage * 512 + c;
        __syncthreads();
#pragma unroll
        for (int k = 0; k < 2; ++k) { const int q = tt + 128 * k; *(LAS u32x4*)(raw + q * 8) = *(const u32x4*)(phyt + (size_t)ch * NTOK + NLAT + q * 8); }
        __syncthreads();
        const float w0 = cw[ch], w1 = cw[NHY + ch], w2 = cw[2 * NHY + ch], bs = cb[ch];
        const float dsk = stage > 0 ? hyb[(stage - 1) * DH + c] : 0.f;
        Taps ra[8], rb[8];
#pragma unroll
        for (int p = 0; p < 4; ++p)
#pragma unroll
            for (int hh = 0; hh < 2; ++hh) { const int tok = hh * 128 + tt; ra[2 * p + hh] = sc_load(raw, (2 * p) * 256 + tok); rb[2 * p + hh] = sc_load(raw, (2 * p + 1) * 256 + tok); }
        __builtin_amdgcn_sched_barrier(0); asm volatile("s_waitcnt lgkmcnt(0)" ::: "memory"); __builtin_amdgcn_sched_barrier(0);
        const TapSel ts0 = sc_sel(tt, tt != 0, true), ts1 = sc_sel(tt, true, tt != 127);
#pragma unroll
        for (int p = 0; p < 4; ++p)
#pragma unroll
            for (int hh = 0; hh < 2; ++hh) { const int m = 4 * p + hh;
                const TapSel ts = hh ? ts1 : ts0;
                const float ua = sc_eval(ra[2 * p + hh], ts, w0, w1, w2, bs), ub = sc_eval(rb[2 * p + hh], ts, w0, w1, w2, bs);
                if (stage == 0) z[m] = (f32x2){ua, ub};
                else { const f32x2 cv = v[m] + z[m] * dsk; z[m] = (f32x2){ua * cv.x, ub * cv.y}; } }
        if (stage == 2) {
#pragma unroll
            for (int p = 0; p < 4; ++p)
#pragma unroll
                for (int hh = 0; hh < 2; ++hh) { const int m = 4 * p + hh, tok = hh * 128 + tt;
                    Y[(size_t)(NLAT + (2 * p) * 256 + tok) * D + c] = (bf16_t)f2bf(z[m].x); Y[(size_t)(NLAT + (2 * p + 1) * 256 + tok) * D + c] = (bf16_t)f2bf(z[m].y); }
            break;
        }
#pragma unroll
        for (int j = 0; j < 16; ++j) v[j] = z[j];
        fft_conv_half16(v, X, TC, kspc + (size_t)(stage * 512 + c) * 2048, tt);
    }
}

constexpr int HG_QT = 0, HG_QP = 17408, HG_KP = 34816, HG_ST = 52224, HG_VT = 87040, HG_KH = 105472, HG_P = 123904, HG_SUB = 133120, HG_D = 137216;
__device__ __forceinline__ void hgrn_mfma(const Ctx& C, int item) {
    const int dir = item & 1, h = (item >> 1) & 3, b = item >> 3;
    LAS unsigned char* L = C.lds;
    const int lane = C.lane, w = C.wave, r = lane & 15, quad = lane >> 4;
    const bf16_t* phg = WSP(const bf16_t, WS_PHG);
    bf16_t* odir = WSP(bf16_t, WS_ODIR) + (size_t)dir * NTOK * 512;
    LAS float* subtot = (LAS float*)(L + HG_SUB); LAS float* Dv = (LAS float*)(L + HG_D);
    __syncthreads();
    unsigned z0_ = 0u; asm volatile("" : "+v"(z0_));
    const u32x4 zv_ = (u32x4){z0_, z0_, z0_, z0_}; const float zff_ = __builtin_bit_cast(float, z0_); const f32x4 zv4f_ = (f32x4){zff_, zff_, zff_, zff_};
    for (int i = C.tid; i < (128 * 272) / 16; i += NTHR) *(LAS u32x4*)(L + HG_ST + i * 16) = zv_;
    for (int i = C.tid; i < (64 * 144) / 16; i += NTHR) *(LAS u32x4*)(L + HG_P + i * 16) = zv_;
    f32x4 sacc[8];
#pragma unroll
    for (int t = 0; t < 8; ++t) sacc[t] = zv4f_;
    unsigned qw[8], kw[8], vw[8];
    const int rstep = dir ? -1 : 1;
    const size_t colq = (size_t)h * 128 + 2 * lane, colk = 1536 + (size_t)dir * 512 + h * 128 + 2 * lane, colv = 512 + (size_t)h * 128 + 2 * lane;
    auto chunk_row0 = [&](int ch) -> int { return ch < 4 ? NLAT + b * 256 + (dir ? 255 - ch * 64 : ch * 64) : b * 2048 + (dir ? 2047 - (ch - 4) * 64 : (ch - 4) * 64); };
    { const int row0 = chunk_row0(0) + rstep * 8 * w;
#pragma unroll
      for (int i = 0; i < 8; ++i) { const bf16_t* p = phg + (size_t)(row0 + rstep * i) * NHG; qw[i] = *(const unsigned*)(p + colq); kw[i] = *(const unsigned*)(p + colk); vw[i] = *(const unsigned*)(p + colv); } }
    __syncthreads();
#pragma unroll 1
    for (int ch = 0; ch < 36; ++ch) {
        f32x2 cp[8]; f32x2 cq = (f32x2){1.0f, 1.0f};
#pragma unroll
        for (int i = 0; i < 8; ++i) { cq *= (f32x2){1.0f - bflo(kw[i]), 1.0f - bfhi(kw[i])}; cp[i] = cq; }
        *(LAS f32x2*)(subtot + w * 128 + 2 * lane) = cq;
        __syncthreads();
        f32x2 sg[8];
#pragma unroll
        for (int g = 0; g < 8; ++g) sg[g] = *(const LAS f32x2*)(subtot + g * 128 + 2 * lane);
        f32x2 pre = (f32x2){1.0f, 1.0f};
#pragma unroll
        for (int g = 0; g < 7; ++g) if (g < w) pre *= sg[g];
        const f32x2 erho = (sg[0] * sg[1]) * (sg[2] * sg[3]), eend = (sg[4] * sg[5]) * (sg[6] * sg[7]);
        const f32x2 ainv = pre * (f32x2){__builtin_amdgcn_rcpf(fmaxf(erho.x, 1e-30f)), __builtin_amdgcn_rcpf(fmaxf(erho.y, 1e-30f))};
        unsigned kha[4], khb[4], vta[4], vtb[4];
#pragma unroll
        for (int i = 0; i < 8; ++i) {
            const f32x2 e1 = cp[i] * ainv, e2 = (f32x2){__builtin_amdgcn_rcpf(fmaxf(e1.x, 1e-30f)), __builtin_amdgcn_rcpf(fmaxf(e1.y, 1e-30f))};
            const f32x2 qp = (f32x2){bflo(qw[i]), bfhi(qw[i])} * e1, kp = (f32x2){bflo(kw[i]), bfhi(kw[i])} * e2, qt = qp * erho, kh = kp * eend;
            const int srow = (8 * w + i) * 272 + lane * 4;
            *(LAS unsigned*)(L + HG_QP + srow) = pk2(qp.x, qp.y);
            *(LAS unsigned*)(L + HG_QT + srow) = pk2(qt.x, qt.y);
            *(LAS unsigned*)(L + HG_KP + srow) = pk2(kp.x, kp.y);
            const unsigned khw = pk2(kh.x, kh.y);
            if (i & 1) { kha[i >> 1] = __builtin_amdgcn_perm(khw, kha[i >> 1], 0x05040100u); khb[i >> 1] = __builtin_amdgcn_perm(khw, khb[i >> 1], 0x07060100u);
                         vta[i >> 1] = __builtin_amdgcn_perm(vw[i], vta[i >> 1], 0x05040100u); vtb[i >> 1] = __builtin_amdgcn_perm(vw[i], vtb[i >> 1], 0x07060100u); }
            else { kha[i >> 1] = khw & 0xffffu; khb[i >> 1] = khw >> 16; vta[i >> 1] = vw[i] & 0xffffu; vtb[i >> 1] = vw[i] >> 16; }
        }
        *(LAS u32x4*)(L + HG_KH + (2 * lane) * 144 + w * 16) = (u32x4){kha[0], kha[1], kha[2], kha[3]};
        *(LAS u32x4*)(L + HG_KH + (2 * lane + 1) * 144 + w * 16) = (u32x4){khb[0], khb[1], khb[2], khb[3]};
        *(LAS u32x4*)(L + HG_VT + (2 * lane) * 144 + w * 16) = (u32x4){vta[0], vta[1], vta[2], vta[3]};
        *(LAS u32x4*)(L + HG_VT + (2 * lane + 1) * 144 + w * 16) = (u32x4){vtb[0], vtb[1], vtb[2], vtb[3]};
        if (w == 0) *(LAS f32x2*)(Dv + 2 * lane) = erho * eend;
        const int crow0 = chunk_row0(ch);
        if (ch + 1 < 36) { const int row0 = chunk_row0(ch + 1) + rstep * 8 * w;
#pragma unroll
            for (int i = 0; i < 8; ++i) { const bf16_t* p = phg + (size_t)(row0 + rstep * i) * NHG; qw[i] = *(const unsigned*)(p + colq); kw[i] = *(const unsigned*)(p + colk); vw[i] = *(const unsigned*)(p + colv); } }
        __syncthreads();
#pragma unroll 1
        for (int blk = w; blk < 10; blk += 8) {
            const int I2 = blk < 1 ? 0 : (blk < 3 ? 1 : (blk < 6 ? 2 : 3)), J2 = blk - (I2 * (I2 + 1)) / 2;
            bf16x8 pa_[4], pb_[4];
#pragma unroll
            for (int kk = 0; kk < 4; ++kk) {
                pa_[kk] = *(const LAS bf16x8*)(L + HG_KP + (J2 * 16 + r) * 272 + (32 * kk + 8 * quad) * 2);
                pb_[kk] = *(const LAS bf16x8*)(L + HG_QP + (I2 * 16 + r) * 272 + (32 * kk + 8 * quad) * 2); }
            __builtin_amdgcn_sched_barrier(0);
            f32x4 pa = zv4f_;
#pragma unroll
            for (int kk = 0; kk < 4; ++kk) pa = __builtin_amdgcn_mfma_f32_16x16x32_bf16(pa_[kk], pb_[kk], pa, 0, 0, 0);
            if (I2 == J2) {
#pragma unroll
                for (int rr = 0; rr < 4; ++rr) if (4 * quad + rr > r) pa[rr] = 0.f;
            }
            u32x2 pw; pw.x = pk2(pa[0], pa[1]); pw.y = pk2(pa[2], pa[3]);
            *(LAS u32x2*)(L + HG_P + (I2 * 16 + r) * 144 + (J2 * 16 + 4 * quad) * 2) = pw;
        }
        __syncthreads();
        {
            bf16x8 sfr[4];
#pragma unroll
            for (int kk = 0; kk < 4; ++kk) sfr[kk] = *(const LAS bf16x8*)(L + HG_ST + (16 * w + r) * 272 + (32 * kk + 8 * quad) * 2);
            const bf16x8 vf0 = *(const LAS bf16x8*)(L + HG_VT + (16 * w + r) * 144 + (8 * quad) * 2);
            const bf16x8 vf1 = *(const LAS bf16x8*)(L + HG_VT + (16 * w + r) * 144 + (32 + 8 * quad) * 2);
            bf16x8 ob_[2][6];
#pragma unroll
            for (int kk = 0; kk < 4; ++kk) ob_[0][kk] = *(const LAS bf16x8*)(L + HG_QT + r * 272 + (32 * kk + 8 * quad) * 2);
            ob_[0][4] = *(const LAS bf16x8*)(L + HG_P + r * 144 + (8 * quad) * 2);
#pragma unroll
            for (int I3 = 0; I3 < 4; ++I3) {
                const int cb = I3 & 1, nb = cb ^ 1;
                if (I3 < 3) {
#pragma unroll
                    for (int kk = 0; kk < 4; ++kk) ob_[nb][kk] = *(const LAS bf16x8*)(L + HG_QT + ((I3 + 1) * 16 + r) * 272 + (32 * kk + 8 * quad) * 2);
                    ob_[nb][4] = *(const LAS bf16x8*)(L + HG_P + ((I3 + 1) * 16 + r) * 144 + (8 * quad) * 2);
                    if (I3 + 1 >= 2) ob_[nb][5] = *(const LAS bf16x8*)(L + HG_P + ((I3 + 1) * 16 + r) * 144 + (32 + 8 * quad) * 2);
                }
                __builtin_amdgcn_sched_barrier(0);
                f32x4 oa = zv4f_;
#pragma unroll
                for (int kk = 0; kk < 4; ++kk) oa = __builtin_amdgcn_mfma_f32_16x16x32_bf16(sfr[kk], ob_[cb][kk], oa, 0, 0, 0);
                oa = __builtin_amdgcn_mfma_f32_16x16x32_bf16(vf0, ob_[cb][4], oa, 0, 0, 0);
                if (I3 >= 2) oa = __builtin_amdgcn_mfma_f32_16x16x32_bf16(vf1, ob_[cb][5], oa, 0, 0, 0);
                const int row = crow0 + rstep * (16 * I3 + r);
                u32x2 ow; ow.x = pk2(oa[0], oa[1]); ow.y = pk2(oa[2], oa[3]);
                *(u32x2*)(odir + (size_t)row * 512 + h * 128 + 16 * w + 4 * quad) = ow;
                __builtin_amdgcn_sched_barrier(0);
            }
            f32x4 sd_[2]; bf16x8 sa_[2][2];
            sd_[0] = *(const LAS f32x4*)(L + HG_D + (4 * quad) * 4);
            sa_[0][0] = *(const LAS bf16x8*)(L + HG_KH + r * 144 + (8 * quad) * 2);
            sa_[0][1] = *(const LAS bf16x8*)(L + HG_KH + r * 144 + (32 + 8 * quad) * 2);
#pragma unroll
            for (int t = 0; t < 8; ++t) {
                const int cb = t & 1, nb = cb ^ 1;
                if (t < 7) {
                    sd_[nb] = *(const LAS f32x4*)(L + HG_D + (16 * (t + 1) + 4 * quad) * 4);
                    sa_[nb][0] = *(const LAS bf16x8*)(L + HG_KH + (16 * (t + 1) + r) * 144 + (8 * quad) * 2);
                    sa_[nb][1] = *(const LAS bf16x8*)(L + HG_KH + (16 * (t + 1) + r) * 144 + (32 + 8 * quad) * 2);
                }
                __builtin_amdgcn_sched_barrier(0);
                f32x4 sa = sacc[t] * sd_[cb];
                sa = __builtin_amdgcn_mfma_f32_16x16x32_bf16(sa_[cb][0], vf0, sa, 0, 0, 0);
                sa = __builtin_amdgcn_mfma_f32_16x16x32_bf16(sa_[cb][1], vf1, sa, 0, 0, 0);
                sacc[t] = sa;
                u32x2 sw; sw.x = pk2(sa[0], sa[1]); sw.y = pk2(sa[2], sa[3]);
                *(LAS u32x2*)(L + HG_ST + (16 * w + r) * 272 + (16 * t + 4 * quad) * 2) = sw;
                __builtin_amdgcn_sched_barrier(0);
            }
        }
    }
    __syncthreads();
}
__device__ __forceinline__ void phase_l3(const Ctx& C, int l, unsigned* hyd) {
    if (C.bid < 64) hgrn_mfma(C, C.bid);
    build_twiddles(C, (LAS f32x2*)C.lds);
    if (C.tid == 0) { unsigned sp = 0; const unsigned need = (unsigned)(C.G - 64);
        while (__hip_atomic_load(hyd, __ATOMIC_RELAXED, __HIP_MEMORY_SCOPE_AGENT) < need) { __builtin_amdgcn_s_sleep(4); if (++sp > (1u << 22)) break; }
        __builtin_amdgcn_fence(__ATOMIC_ACQUIRE, "agent"); asm volatile("s_waitcnt vmcnt(0)" ::: "memory"); }
    __syncthreads();
    unsigned* qh = WSP(unsigned, WS_CTL) + CW_Q + l * 64 + C.rep * 16;
    volatile LAS int* lc = (volatile LAS int*)(C.lds + LDSCTL_OFF);
    const int nitems = HY_ITEMS + (l < DEPTH - 1 ? HYC_ITEMS : 0);
    for (;;) {
        if (C.tid == 0) lc[LC_Q] = (int)__hip_atomic_fetch_add(qh, 1u, __ATOMIC_RELAXED, __HIP_MEMORY_SCOPE_AGENT);
        __syncthreads();
        const int item = lc[LC_Q];
        __syncthreads();
        if (item >= nitems) break;
        Ctx CI = C; { int t_ = C.tid; asm volatile("" : "+v"(t_)); CI.tid = t_; CI.lane = t_ & 63; }
        if (item < HY_ITEMS) hyena_lat(CI, l, item); else hyena_ctx2(CI, l, item - HY_ITEMS);
    }
}
__device__ __forceinline__ void phase_l3b(const Ctx& C, int l) {
    const int gw = C.bid * NWAVES + C.wave, NGW = C.G * NWAVES;
    const bf16_t* od0 = WSP(const bf16_t, WS_ODIR); const bf16_t* od1 = od0 + (size_t)NTOK * 512;
    const bf16_t* phg = WSP(const bf16_t, WS_PHG); bf16_t* Y = WSP(bf16_t, WS_R1);
    const float* nw = GIN(IN_NORMW) + l * 128;
    const int nrows = (l < DEPTH - 1) ? NTOK : NLAT;
    const int idx = C.lane * 8;
    float nwv[8];
#pragma unroll
    for (int i = 0; i < 8; ++i) nwv[i] = nw[(idx + i) & 127];
    const int RPW = (nrows + NGW - 1) / NGW, r0 = gw * RPW, r1 = (r0 + RPW < nrows) ? r0 + RPW : nrows;
    u32x4 na = (u32x4){0u, 0u, 0u, 0u}, nb = na, ng = na;
    if (r0 < r1) { na = *(const u32x4*)(od0 + (size_t)r0 * 512 + idx); nb = *(const u32x4*)(od1 + (size_t)r0 * 512 + idx); ng = *(const u32x4*)(phg + (size_t)r0 * NHG + 1024 + idx); }
    for (int row = r0; row < r1; ++row) {
        const u32x4 a = na, b = nb, g = ng;
        if (row + 1 < r1) { const int r2 = row + 1; na = *(const u32x4*)(od0 + (size_t)r2 * 512 + idx); nb = *(const u32x4*)(od1 + (size_t)r2 * 512 + idx); ng = *(const u32x4*)(phg + (size_t)r2 * NHG + 1024 + idx); }
        float o[8] = {bflo(a.x) + bflo(b.x), bfhi(a.x) + bfhi(b.x), bflo(a.y) + bflo(b.y), bfhi(a.y) + bfhi(b.y), bflo(a.z) + bflo(b.z), bfhi(a.z) + bfhi(b.z), bflo(a.w) + bflo(b.w), bfhi(a.w) + bfhi(b.w)};
        const float gg[8] = {bflo(g.x), bfhi(g.x), bflo(g.y), bfhi(g.y), bflo(g.z), bfhi(g.z), bflo(g.w), bfhi(g.w)};
        float ss = 0.f;
#pragma unroll
        for (int i = 0; i < 8; ++i) ss += o[i] * o[i];
        ss = row16_sum(ss);
        const float rinv = 1.0f / sqrtf(ss * (1.0f / 128.0f) + EPS);
        float y[8];
#pragma unroll
        for (int i = 0; i < 8; ++i) y[i] = o[i] * rinv * nwv[i] * siluf_(gg[i]);
        u32x4 w; w.x = pk2(y[0], y[1]); w.y = pk2(y[2], y[3]); w.z = pk2(y[4], y[5]); w.w = pk2(y[6], y[7]);
        *(u32x4*)(Y + (size_t)row * D + 512 + idx) = w;
    }
}

constexpr int RWB_PITCH = 1032;
constexpr int RW_PITCH = 1028;
__device__ __forceinline__ void phase_l5a(const Ctx& C, int l, int g0, int gstep, int g1, unsigned* gate, unsigned need, int gpb = NWAVES) {
    LAS bf16_t* rwH = (LAS bf16_t*)C.lds; LAS bf16_t* rwL = rwH + 16 * RWB_PITCH;
    LAS int* lcnt = (LAS int*)(C.lds + 2 * 16 * RWB_PITCH * 2);
    LAS float* wsc = (LAS float*)(C.lds + 2 * 16 * RWB_PITCH * 2 + 128) + C.wave * 384;
    const float* rw = GIN(IN_RW);
    const float* mods = WSP(const float, WS_MODS) + (size_t)l * 9 * 6144;
    if (C.tid < 32) lcnt[C.tid] = 0;
    int curb = -1;
    auto build_table = [&](int bb) {
        __syncthreads();
        { float rv[32], sv[32];
          const int tb_ = C.wave * 64 + lane_id_opaque();
#pragma unroll
          for (int q = 0; q < 32; ++q) { const int i = tb_ + NTHR * q; rv[q] = rw[i]; sv[q] = mods[bb * 6144 + 4096 + (i >> 4)]; }
          __builtin_amdgcn_sched_barrier(0);
#pragma unroll
          for (int q = 0; q < 32; ++q) { const int i = tb_ + NTHR * q, k = i >> 4, e = i & 15; const float v = rv[q] * (sv[q] + 1.0f); const unsigned h = f2bf(v);
              rwH[e * RWB_PITCH + k] = (bf16_t)h; rwL[e * RWB_PITCH + k] = (bf16_t)f2bf(v - bf2f(h)); } }
        __syncthreads(); };
    if (g0 - C.wave < g1) { curb = bidx((g0 - C.wave) * 16); build_table(curb); }
    if (C.tid == 0) { unsigned sp = 0;
        while (__hip_atomic_load(gate, __ATOMIC_RELAXED, __HIP_MEMORY_SCOPE_AGENT) < need) { __builtin_amdgcn_s_sleep(2); if (++sp > (1u << 22)) break; }
        __builtin_amdgcn_fence(__ATOMIC_ACQUIRE, "agent"); asm volatile("s_waitcnt vmcnt(0)" ::: "memory"); }
    __syncthreads();
    const float* bias2 = WSP(const float, WS_BIAS2) + l * 9 * 16;
    const bf16_t* xb = WSP(const bf16_t, WS_XBUF);
    const float* rbias = GIN(IN_RB);
    unsigned* cnt = WSP(unsigned, WS_CTL) + CW_CNT + l * 32 * 64;
    int* tokinfo = WSP(int, WS_TOKINFO);
    const int li = C.lane & 15, kq = C.lane >> 4;
#pragma unroll 1
    for (int gb = g0 - C.wave; gb < g1; gb += gstep) {
        const int g = gb + C.wave, bb = bidx(gb * 16);
        if (bb != curb) { curb = bb; build_table(bb); }
        if (g >= g1 || C.wave >= gpb) continue;
        const int row0 = g * 16;
        const bf16_t* xp = xb + (size_t)(row0 + li) * D + kq * 8;
        const LAS bf16_t* bph = rwH + li * RWB_PITCH + kq * 8; const LAS bf16_t* bpl = rwL + li * RWB_PITCH + kq * 8;
        f32x4 acc0 = (f32x4){0.f, 0.f, 0.f, 0.f}, acc1 = acc0; float ss = 0.f;
#pragma unroll 1
        for (int mb = 0; mb < 32; mb += 16) {
            u32x4 xwv[16];
#pragma unroll
            for (int q = 0; q < 16; ++q) xwv[q] = *(const u32x4*)(xp + 32 * (mb + q));
            __builtin_amdgcn_sched_barrier(0);
#pragma unroll
            for (int q = 0; q < 16; ++q) { const int m = mb + q; const u32x4 xw = xwv[q];
                const bf16x8 bh = *(const LAS bf16x8*)(bph + 32 * m), bl = *(const LAS bf16x8*)(bpl + 32 * m);
                const f32x4 xa = bf4_to_f32((u32x2){xw.x, xw.y}), xc = bf4_to_f32((u32x2){xw.z, xw.w});
                ss += ((xa.x * xa.x + xa.y * xa.y) + (xa.z * xa.z + xa.w * xa.w)) + ((xc.x * xc.x + xc.y * xc.y) + (xc.z * xc.z + xc.w * xc.w));
                const bf16x8 ax = __builtin_bit_cast(bf16x8, xw);
                acc0 = __builtin_amdgcn_mfma_f32_16x16x32_bf16(ax, bh, acc0, 0, 0, 0);
                acc1 = __builtin_amdgcn_mfma_f32_16x16x32_bf16(ax, bl, acc1, 0, 0, 0); }
        }
        const f32x4 acc = acc0 + acc1;
        wsc[C.lane] = ss;
#pragma unroll
        for (int r = 0; r < 4; ++r) wsc[64 + (4 * kq + r) * 17 + li] = acc[r];
        LDS_WAIT(); asm volatile("" ::: "memory");
        if (C.lane < 16) {
            const int row = row0 + C.lane;
            const float sst = (wsc[C.lane] + wsc[16 + C.lane]) + (wsc[32 + C.lane] + wsc[48 + C.lane]);
            const float rinv = 1.0f / sqrtf(sst * (1.0f / D) + EPS);
            float lg[16];
#pragma unroll
            for (int e = 0; e < 16; ++e) lg[e] = rinv * wsc[64 + C.lane * 17 + e] + bias2[bb * 16 + e];
            float mx = lg[0];
#pragma unroll
            for (int e = 1; e < 16; ++e) mx = fmaxf(mx, lg[e]);
            float sc[16], se = 0.f;
#pragma unroll
            for (int e = 0; e < 16; ++e) { sc[e] = expf(lg[e] - mx); se += sc[e]; }
            float sel[16];
#pragma unroll
            for (int e = 0; e < 16; ++e) { sc[e] = sc[e] / se; sel[e] = sc[e] + rbias[e]; }
            float bestgs = -3.4e38f; int bg = 0; float bs[4], bsc[4];
#pragma unroll
            for (int gg = 0; gg < 4; ++gg) {
                float m1 = -3.4e38f, m2 = -3.4e38f;
#pragma unroll
                for (int i = 0; i < 4; ++i) { const float x = sel[4 * gg + i]; if (x > m1) { m2 = m1; m1 = x; } else if (x > m2) m2 = x; }
                const float gs = m1 + m2;
                if (gs > bestgs) { bestgs = gs; bg = gg;
#pragma unroll
                    for (int i = 0; i < 4; ++i) { bs[i] = sel[4 * gg + i]; bsc[i] = sc[4 * gg + i]; } }
            }
            int i0 = 0; float b0 = bs[0];
#pragma unroll
            for (int i = 1; i < 4; ++i) if (bs[i] > b0) { b0 = bs[i]; i0 = i; }
            int i1 = -1; float b1 = -3.4e38f;
#pragma unroll
            for (int i = 0; i < 4; ++i) if (i != i0 && bs[i] > b1) { b1 = bs[i]; i1 = i; }
            float w0 = 0.f, w1 = 0.f;
#pragma unroll
            for (int i = 0; i < 4; ++i) { if (i == i0) w0 = bsc[i]; if (i == i1) w1 = bsc[i]; }
            const float wn = w0 + w1; w0 /= wn; w1 /= wn;
            const int lo = i0 < i1 ? i0 : i1, hi = i0 < i1 ? i1 : i0;
            const float wlo = i0 < i1 ? w0 : w1, whi = i0 < i1 ? w1 : w0;
            const int bin = bg * 6 + (lo * (7 - lo)) / 2 + (hi - lo - 1);
            const int slot = __hip_atomic_fetch_add(lcnt + bin, 1, __ATOMIC_RELAXED, __HIP_MEMORY_SCOPE_WORKGROUP);
            *(int4*)(tokinfo + (size_t)row * 4) = make_int4(bin | (C.bid << 8), slot, __float_as_int(wlo), __float_as_int(whi));
        }
        LDS_WAIT(); asm volatile("" ::: "memory");
    }
    __syncthreads();
    { const int te_ = C.wave * 64 + lane_id_opaque();
      if (te_ < NBIN && !C.dry) { const int n = lcnt[te_];
        WSP(int, WS_BLKBASE)[C.bid * 32 + te_] = n > 0 ? (int)__hip_atomic_fetch_add(cnt + te_ * 64, (unsigned)n, __ATOMIC_RELAXED, __HIP_MEMORY_SCOPE_AGENT) : 0; } }
}
__device__ __forceinline__ void phase_l5b(const Ctx& C, int l) {
    build_tiletab(C, l);
    const volatile LAS int* lc = (const volatile LAS int*)(C.lds + LDSCTL_OFF);
    const int gw = C.bid * NWAVES + C.wave, NGW = C.G * NWAVES;
    const float* mods = WSP(const float, WS_MODS) + (size_t)l * 9 * 6144;
    const bf16_t* xb = WSP(const bf16_t, WS_XBUF);
    const int* tokinfo = WSP(const int, WS_TOKINFO); const int* blkbase = WSP(const int, WS_BLKBASE);
    bf16_t* hs = WSP(bf16_t, WS_PHG); int* rowtok = WSP(int, WS_ROWTOK); float* roww = WSP(float, WS_ROWW);
    const int nrows = (l < DEPTH - 1) ? NTOK : NLAT;
    const int RPW = (nrows + NGW - 1) / NGW, r0 = gw * RPW, r1 = (r0 + RPW < nrows) ? r0 + RPW : nrows;
    f32x4 shv[4], scv[4]; int curb = -1;
#pragma unroll 1
    for (int rb = r0; rb < r1; rb += 9) {
        const int ql = C.lane < 9 ? C.lane : 8, rql = rb + ql < r1 ? rb + ql : r1 - 1;
        const int4 myti = *(const int4*)(tokinfo + (size_t)rql * 4);
        const int mybase = blkbase[(myti.x >> 8) * 32 + (myti.x & 255)];
        u32x2 nv[4];
#pragma unroll
        for (int j = 0; j < 4; ++j) nv[j] = *(const u32x2*)(xb + (size_t)rb * D + C.lane * 4 + 256 * j);
#pragma unroll
        for (int q = 0; q < 9; ++q) if (rb + q < r1) { const int row = rb + q;
            const int4 ti = make_int4(__builtin_amdgcn_readlane(myti.x, q), __builtin_amdgcn_readlane(myti.y, q), __builtin_amdgcn_readlane(myti.z, q), __builtin_amdgcn_readlane(myti.w, q));
            const int pos = lc[LC_OFFS + (ti.x & 255)] + __builtin_amdgcn_readlane(mybase, q) + ti.y;
            f32x4 v[4]; float ss = 0.f;
#pragma unroll
            for (int j = 0; j < 4; ++j) v[j] = bf4_to_f32(nv[j]);
            if (row + 1 < r1) {
#pragma unroll
                for (int j = 0; j < 4; ++j) nv[j] = *(const u32x2*)(xb + (size_t)(row + 1) * D + C.lane * 4 + 256 * j); }
            const int bb = bidx(row);
            if (bb != curb) { curb = bb; const float* md = mods + bb * 6144;
#pragma unroll
                for (int j = 0; j < 4; ++j) { const int k = C.lane * 4 + 256 * j; shv[j] = *(const f32x4*)(md + 3072 + k); scv[j] = *(const f32x4*)(md + 4096 + k) + 1.0f; } }
#pragma unroll
            for (int j = 0; j < 4; ++j) ss += (v[j].x * v[j].x + v[j].y * v[j].y) + (v[j].z * v[j].z + v[j].w * v[j].w);
            ss = wave_sum(ss); const float rinv = 1.0f / sqrtf(ss * (1.0f / D) + EPS);
#pragma unroll
            for (int j = 0; j < 4; ++j) { const int k = C.lane * 4 + 256 * j;
                const f32x4 o = v[j] * rinv * scv[j] + shv[j];
                *(u32x2*)(hs + (size_t)pos * D + k) = f32_to_bf4(o); }
            if (C.lane == 0) { rowtok[pos] = row; roww[pos * 2] = __int_as_float(ti.z); roww[pos * 2 + 1] = __int_as_float(ti.w); }
        }
    }
    if (C.bid < NBIN) { const int b = C.bid; const int start = lc[LC_OFFS + b], end = lc[LC_OFFS + b + 1];
        const int n = (int)__hip_atomic_load(WSP(unsigned, WS_CTL) + CW_CNT + (l * 32 + b) * 64, __ATOMIC_RELAXED, __HIP_MEMORY_SCOPE_AGENT);
        float zf_ = 0.f; asm volatile("" : "+v"(zf_));
        for (int p = start + n + C.tid; p < end; p += NTHR) { rowtok[p] = -1; roww[p * 2] = zf_; roww[p * 2 + 1] = zf_; } }
}

__device__ __forceinline__ void phase_final(const Ctx& C) {
    const int gw = C.bid * NWAVES + C.wave, NGW = C.G * NWAVES;
    const bf16_t* xb = WSP(const bf16_t, WS_XBUF); const float* fw = GIN(IN_FNW);
    const int RPW = (NLAT + NGW - 1) / NGW, r0 = gw * RPW, r1 = (r0 + RPW < NLAT) ? r0 + RPW : NLAT;
    f32x4 wv[4];
#pragma unroll
    for (int j = 0; j < 4; ++j) wv[j] = *(const f32x4*)(fw + C.lane * 4 + 256 * j);
    u32x2 nv[4];
    if (r0 < r1) {
#pragma unroll
        for (int j = 0; j < 4; ++j) nv[j] = *(const u32x2*)(xb + (size_t)r0 * D + C.lane * 4 + 256 * j); }
    for (int row = r0; row < r1; ++row) {
        f32x4 v[4]; float ss = 0.f;
#pragma unroll
        for (int j = 0; j < 4; ++j) v[j] = bf4_to_f32(nv[j]);
        if (row + 1 < r1) {
#pragma unroll
            for (int j = 0; j < 4; ++j) nv[j] = *(const u32x2*)(xb + (size_t)(row + 1) * D + C.lane * 4 + 256 * j); }
#pragma unroll
        for (int j = 0; j < 4; ++j) ss += (v[j].x * v[j].x + v[j].y * v[j].y) + (v[j].z * v[j].z + v[j].w * v[j].w);
        ss = wave_sum(ss); const float rinv = 1.0f / sqrtf(ss * (1.0f / D) + EPS);
#pragma unroll
        for (int j = 0; j < 4; ++j) { const int k = C.lane * 4 + 256 * j;
            *(f32x4*)(C.out + (size_t)row * D + k) = v[j] * rinv * wv[j]; }
    }
}

constexpr int PH_PER_LAYER = 8, N_PHASES = 2 + DEPTH * PH_PER_LAYER + 1;
__global__ void __launch_bounds__(NTHR, 2) trunk_fwd(Args args) {
    extern __shared__ __attribute__((aligned(16))) unsigned char lds[];
    Ctx C; C.in = (const CAS fptr_t*)__builtin_amdgcn_kernarg_segment_ptr(); C.out = args.out; C.ws = (GAS unsigned char*)args.ws; C.lds = (LAS unsigned char*)lds;
    C.tid = threadIdx.x; C.lane = C.tid & 63; C.wave = __builtin_amdgcn_readfirstlane(C.tid >> 6); C.G = gridDim.x; C.bid = blockIdx.x; C.rep = args.rep; C.dry = (args.rep + 1 < (args.pad & 255)) ? (args.pad >> 8) : 0;
    LAS unsigned char* ldsl0 = (LAS unsigned char*)lds;
    if (C.tid < 64) ((LAS unsigned*)(ldsl0 + LDSCTL_OFF))[C.tid] = 0u;
    __syncthreads();
    const int lo = args.ph_lo, hi = args.ph_hi;
    XcdBarrier bar; bar.bar = WSP(unsigned, WS_CTL) + CW_BAR; bar.x = 0; bar.st = (volatile LAS unsigned*)(ldsl0 + LDSCTL_OFF + LC_BAR);
    if (hi - lo > 1) bar = xcd_barrier_post(WSP(unsigned, WS_CTL) + CW_BAR, (volatile LAS unsigned*)(ldsl0 + LDSCTL_OFF + LC_BAR));
    { unsigned blo_ = __builtin_amdgcn_readfirstlane((unsigned)(unsigned long long)bar.bar), bhi_ = __builtin_amdgcn_readfirstlane((unsigned)((unsigned long long)bar.bar >> 32));
      asm volatile("" : "+s"(blo_), "+s"(bhi_)); bar.bar = (unsigned*)(((unsigned long long)bhi_ << 32) | blo_); }
#define FRESH_TID (C.wave * 64 + lane_id_opaque())
#define IN(k) (lo <= (k) && (k) < hi)
#define CPH(name) Ctx name = C; { int t_ = FRESH_TID; asm volatile("" : "+v"(t_)); name.tid = t_; name.lane = t_ & 63; }
#define SEAM(k) do { if (IN(k) && IN((k) + 1)) xcd_barrier(bar, FRESH_TID); } while (0)
#ifndef EN
#define EN 0xFFFF
#endif
    if ((EN & 1) && IN(0)) { phase0(C); SEAM(0); }
    if ((EN & 1) && IN(1)) {
        {
            const float* md = WSP(const float, WS_MODS); const float* rw = GIN(IN_RW); float* b2 = WSP(float, WS_BIAS2);
            for (int o = C.bid * NWAVES + C.wave; o < 4 * 9 * 16; o += C.G * NWAVES) { const int lr = o >> 4, e = o & 15; const float* sh = md + (size_t)lr * 6144 + 3072; float sacc = 0.f;
#pragma unroll
                for (int j = 0; j < 16; ++j) { const int k = C.lane + 64 * j; sacc += sh[k] * rw[k * 16 + e]; }
                sacc = wave_sum(sacc);
                if (C.lane == 0) b2[o] = sacc; }
        }
        SchedFilt S{C.G, C.bid};
        EpiFilt E{WSP(bf16_t, WS_HF), GIN(IN_B3)};
        pg8::gemm_phase<false>(ldsl0, S, E, (const char*)WSP(bf16_t, WS_W3T), (const char*)WSP(bf16_t, WS_HPAD), 128, 128, 128u * 128u * 2u, 128u * 128u * 2u, 2, FRESH_TID);
        { const int nf = 4 * 72, n2 = (nf > C.G && nf < 2 * C.G) ? nf - C.G : 0;
          if (n2 && C.bid >= n2) { __syncthreads(); Ctx CP = C; { int t_ = C.wave * 64 + lane_id_opaque(); asm volatile("" : "+v"(t_)); CP.tid = t_; CP.lane = t_ & 63; }
              convert_weights(CP, 0, 0, CV_I_IN + CV_I_OUT, (C.bid - n2) * NWAVES + C.wave, (C.G - n2) * NWAVES); } }
        SEAM(1);
    }
    const Ctx C0 = C;
#pragma unroll 1
    for (int l = 0; l < DEPTH; ++l) {
        const int p0 = 2 + l * PH_PER_LAYER;
        Ctx C = C0; { int t_ = C0.wave * 64 + lane_id_opaque(); asm volatile("" : "+v"(t_)); C.tid = t_; C.lane = t_ & 63; C.wave = __builtin_amdgcn_readfirstlane(t_ >> 6);
                      int b_ = C0.bid; asm volatile("" : "+s"(b_)); C.bid = b_; int g_ = C0.G; asm volatile("" : "+s"(g_)); C.G = g_; GAS unsigned char* w_ = C0.ws; asm volatile("" : "+s"(w_)); C.ws = w_;
                      const CAS fptr_t* i_ = C0.in; asm volatile("" : "+s"(i_)); C.in = i_;
                      LAS unsigned char* l_ = C0.lds; asm volatile("" : "+s"(l_)); C.lds = l_; }
        LAS unsigned char* const ldsl = C.lds;
        const float* modl = WSP(const float, WS_MODS) + (size_t)l * 9 * 6144;
        if ((EN & 2) && IN(p0 + 0)) { CPH(CP); phase_l1(CP, l); SEAM(p0 + 0); }
        if ((EN & 4) && IN(p0 + 1)) {
            { pg8::SchedDense S; S.init(NTOK / 256, NHG / 256, C.G, C.bid, D, D);
              EpiHG E{WSP(bf16_t, WS_PHG), WSP(const float, WS_LOWER) + l * 512};
              pg8::gemm_phase<false>(ldsl, S, E, (const char*)WSP(bf16_t, WS_R1), (const char*)(WSP(bf16_t, WS_WIN) + (size_t)NHY * D), D, D, 128u * D * 2u, 128u * D * 2u, D / 64, FRESH_TID); }
            { const int nhg = (NTOK / 256) * (NHG / 256), rem = nhg % C.G, nfree = rem ? C.G - rem : 0;
              if (nfree && C.bid >= rem) { pg8::SchedDense S; S.init(NHY / 256, NTOK / 256, C.G, C.bid, D, D); S.range(C.bid - rem, 1 << 20, nfree);
                EpiHY E{WSP(bf16_t, WS_PHYT)};
                pg8::gemm_phase<false>(ldsl, S, E, (const char*)WSP(bf16_t, WS_WIN), (const char*)WSP(bf16_t, WS_R1), D, D, 128u * D * 2u, 128u * D * 2u, D / 64, FRESH_TID); } }
            SEAM(p0 + 1);
        }
        if ((EN & 8) && IN(p0 + 2)) {
            const int nhg = (NTOK / 256) * (NHG / 256), rem = nhg % C.G, nfree = rem ? C.G - rem : 0, nhy = (NHY / 256) * (NTOK / 256);
            unsigned* hyd = WSP(unsigned, WS_CTL) + CW_HYD + l * 64 + C.rep * 16;
            if (C.bid >= 64) {
                pg8::SchedDense S; S.init(NHY / 256, NTOK / 256, C.G, C.bid, D, D); S.range((nfree < nhy ? nfree : nhy) + (C.bid - 64), C.G - 64, nhy);
                EpiHY E{WSP(bf16_t, WS_PHYT)};
                pg8::gemm_phase<false>(ldsl, S, E, (const char*)WSP(bf16_t, WS_WIN), (const char*)WSP(bf16_t, WS_R1), D, D, 128u * D * 2u, 128u * D * 2u, D / 64, FRESH_TID);
                asm volatile("s_waitcnt vmcnt(0)" ::: "memory");
                __syncthreads();
                if (C.wave * 64 + lane_id_opaque() == 0) __hip_atomic_fetch_add(hyd, 1u, __ATOMIC_RELAXED, __HIP_MEMORY_SCOPE_AGENT);
            }
            { CPH(CP); phase_l3(CP, l, hyd); }
            SEAM(p0 + 2);
        }
        if ((EN & 16) && IN(p0 + 3)) { CPH(CP); phase_l3b(CP, l); SEAM(p0 + 3); }
        if ((EN & 32) && IN(p0 + 4)) {
            const int nlat4 = (NLAT / 256) * (D / 256), nctx4 = l < DEPTH - 1 ? ((NTOK - NLAT) / 256) * (D / 256) : 0, NB0 = 32;
            unsigned* cA = WSP(unsigned, WS_CTL) + CW_L4 + l * 128 + C.rep * 16; unsigned* cB = cA + 64;
            EpiOut E{WSP(bf16_t, WS_XBUF), modl, C.dry};
#pragma unroll 1
            for (int pass = 0; pass < 2; ++pass) {
                const int nu = pass ? nctx4 : nlat4;
#pragma unroll 1
                for (int u = C.bid; u < nu; u += C.G) {
                    const int xcd = u & 7, slot = u >> 3;
                    pg8::SchedOne S{pass ? NLAT / 256 + xcd : xcd * 8 + (slot >> 2), pass ? slot : slot & 3, 256u * D * 2u, 256u * D * 2u};
                    pg8::gemm_phase<false>(ldsl, S, E, (const char*)WSP(bf16_t, WS_R1), (const char*)WSP(bf16_t, WS_WOUT), D, D, 128u * D * 2u, 128u * D * 2u, D / 64, FRESH_TID);
                    asm volatile("s_waitcnt vmcnt(0)" ::: "memory");
                    __syncthreads();
                    if (C.wave * 64 + lane_id_opaque() == 0) __hip_atomic_fetch_add(pass ? cB : cA, 1u, __ATOMIC_RELAXED, __HIP_MEMORY_SCOPE_AGENT);
                }
            }
            __syncthreads();
            { CPH(CP);
              if (C.bid >= NB0 || C.G <= NB0) { const int wl = (C.G > NB0 ? C.bid - NB0 : C.bid) * NWAVES + C.wave, nwl = (C.G > NB0 ? C.G - NB0 : C.G) * NWAVES;
                  phase_l5a(CP, l, wl, nwl, NLAT / 16, cA, (unsigned)nlat4);
                  if (C.G <= NB0 && nctx4) phase_l5a(CP, l, NLAT / 16 + C.bid * NWAVES + C.wave, C.G * NWAVES, NTOK / 16, cB, (unsigned)nctx4); }
              else phase_l5a(CP, l, NLAT / 16 + C.bid * 4 + C.wave, NB0 * 4, nctx4 ? NTOK / 16 : 0, cB, (unsigned)nctx4, 4); }
            __syncthreads();
            { CPH(CP); const int c0 = (nctx4 && C.G > NB0) ? NB0 : 0;
              if (C.bid >= c0) convert_weights(CP, l, CV_I_IN + CV_I_OUT, CV_NIT, (C.bid - c0) * NWAVES + C.wave, (C.G - c0) * NWAVES); }
            if (IN(p0 + 4) && IN(p0 + 6)) xcd_barrier(bar, FRESH_TID);
        }
        if ((EN & 128) && IN(p0 + 6)) { CPH(CP); phase_l5b(CP, l); SEAM(p0 + 6); }
        if ((EN & 256) && IN(p0 + 7)) {
            { CPH(CP); build_tiletab(CP, l); }
            const volatile LAS int* lc = (const volatile LAS int*)(ldsl + LDSCTL_OFF);
            const int n6 = 4 * lc[LC_T];
            unsigned* cnt6 = WSP(unsigned, WS_CTL) + CW_T6 + l * 96 * 64;
#pragma unroll 1
            for (int idx = C.bid; idx < n6; idx += C.G) {
                SchedUp1 S{idx, lc + LC_TILEBIN};
                EpiAct E{WSP(bf16_t, WS_R1), WSP(const float, WS_ROWW)};
                pg8::gemm_phase<false>(ldsl, S, E, (const char*)WSP(bf16_t, WS_PHG), (const char*)WSP(bf16_t, WS_WG), D, D, 128u * D * 2u, (unsigned)(WS_WU - WS_WG), D / 64, FRESH_TID);
                asm volatile("s_waitcnt vmcnt(0)" ::: "memory");
                __syncthreads();
                if (C.wave * 64 + lane_id_opaque() == 0) {
                    __hip_atomic_fetch_add(cnt6 + (idx >> 2) * 64, 1u, __ATOMIC_RELAXED, __HIP_MEMORY_SCOPE_AGENT); }
            }
            const int n2 = (n6 > C.G && n6 < 2 * C.G) ? n6 - C.G : 0, nearly = n6 < C.G ? n6 : C.G;
            const int jfirst = C.bid < n2 ? C.G + C.bid : C.bid - n2, jstep = C.bid < n2 ? (1 << 20) : C.G - n2, jend = C.bid < n2 ? n6 : (n2 ? nearly : n6);
#pragma unroll 1
            for (int j = jfirst; j < jend; j += jstep) {
                if (C.wave * 64 + lane_id_opaque() == 0) { unsigned* cw = cnt6 + (j >> 2) * 64; unsigned sp = 0;
                    while (__hip_atomic_load(cw, __ATOMIC_RELAXED, __HIP_MEMORY_SCOPE_AGENT) < 4u) { __builtin_amdgcn_s_sleep(2); if (++sp > (1u << 22)) break; }
                    __builtin_amdgcn_fence(__ATOMIC_ACQUIRE, "agent"); asm volatile("s_waitcnt vmcnt(0)" ::: "memory"); }
                __syncthreads();
                SchedDown1 S{j, lc + LC_TILEBIN};
                EpiDown E{WSP(bf16_t, WS_XBUF), WSP(const int, WS_ROWTOK), modl, C.dry};
                pg8::gemm_phase<true>(ldsl, S, E, (const char*)WSP(bf16_t, WS_R1), (const char*)WSP(bf16_t, WS_WD), 512, 256, 128u * 512u * 2u, 128u * 256u * 2u, 4, FRESH_TID);
            }
            SEAM(p0 + 7);
        }
    }
    if ((EN & 1024) && IN(N_PHASES - 1)) { Ctx CF = C0; CF.tid = C0.wave * 64 + lane_id_opaque(); CF.lane = CF.tid & 63; phase_final(CF); }
#undef IN
#undef SEAM
}

extern "C" void kernel_launch(void* const* d_in, const int* in_sizes, int n_in, void* d_out, int out_size, void* d_ws, size_t ws_size, hipStream_t stream) {
    static int grid = 0;
    if (grid == 0) {
        if (n_in != N_IN || in_sizes[0] != NLAT * D || out_size != NLAT * D || ws_size < WS_END) { fprintf(stderr, "kernel_launch: unexpected shapes / workspace (%d inputs, ws %zu < %zu)\n", n_in, ws_size, (size_t)WS_END); grid = -1; return; }
        int dev = 0, cus = 0, per_cu = 0;
        if (hipGetDevice(&dev) != hipSuccess || hipDeviceGetAttribute(&cus, hipDeviceAttributeMultiprocessorCount, dev) != hipSuccess) { grid = -1; return; }
        if (hipFuncSetAttribute((const void*)trunk_fwd, hipFuncAttributeMaxDynamicSharedMemorySize, LDS_BYTES) != hipSuccess) { fprintf(stderr, "kernel_launch: hipFuncSetAttribute failed\n"); grid = -1; return; }
        if (hipOccupancyMaxActiveBlocksPerMultiprocessor(&per_cu, (const void*)trunk_fwd, NTHR, LDS_BYTES) != hipSuccess || per_cu < 1) { fprintf(stderr, "kernel_launch: occupancy query says %d\n", per_cu); }
        (void)hipGetLastError();
        grid = cus;
    }
    if (grid < 0) return;
    (void)hipMemsetAsync((char*)d_ws + WS_CTL, 0, CTL_ZERO_BYTES, stream);
    Args a{};
    for (int i = 0; i < N_IN; ++i) a.in[i] = (const float*)d_in[i];
    a.out = (float*)d_out; a.ws = (unsigned char*)d_ws;
#if MK_PER_PHASE
    for (int p = 0; p < N_PHASES; ++p) { a.ph_lo = p; a.ph_hi = p + 1; const int kind = p == 0 ? 0 : (p == 1 ? 11 : (p == N_PHASES - 1 ? 10 : 1 + (p - 2) % PH_PER_LAYER));
        const int nrep = ((PROBE_HOST >> kind) & 1) ? 2 : 1; a.pad = nrep | (PROBE_SKIP << 8);
        for (int rep = 0; rep < nrep; ++rep) { a.rep = rep; hipLaunchKernelGGL(trunk_fwd, dim3(grid), dim3(NTHR), LDS_BYTES, stream, a); } }
#else
    a.ph_lo = 0; a.ph_hi = N_PHASES; a.rep = 0; a.pad = 1;
    hipLaunchKernelGGL(trunk_fwd, dim3(grid), dim3(NTHR), LDS_BYTES, stream, a);
#endif
}
```
